# Optimizing an MI355X kernel written in HIP

```python
import math
import jax, jax.numpy as jnp
from jax import lax
import numpy as np

D_MODEL = 1024
BATCH = 8
SEQ = 8192
DEPTH = 2

CTX_LEN = 256
GRID_W = 64
EPS = 1e-6
ROPE_BASE = 10000.0
Q_BLOCK = 128
f32 = jnp.float32

H_A = 4
DH_A = 64
DV_A = 2 * DH_A
A_W = H_A * DV_A
H_B = 4
DH_B = 128
B_W = H_B * DH_B
GDN_CHUNK = 64
CONV_K = 5
H_C = 8
DH_C = 128
WIN_R = 8
WIN_C = 16
MIX_ODD = H_C * DH_C

MIX_EVEN = A_W + B_W
EVEN_IN = 3 * A_W + 4 * B_W + 4 * H_B
EVEN_CUTS = [A_W, 2 * A_W, 3 * A_W, 3 * A_W + 3 * B_W, 3 * A_W + 4 * B_W]
FF_HIDDEN = ((8 * D_MODEL // 3 + 255) // 256) * 256
N_EVEN = (DEPTH + 1) // 2
N_ODD = DEPTH // 2

kernel_name = "hybrid_diffattn_gdn_natten_trunk"


def rms_norm(x, gain):
    xf = x.astype(f32)
    y = xf * lax.rsqrt(jnp.mean(xf * xf, axis=-1, keepdims=True) + EPS)
    return (y * gain.astype(f32)).astype(x.dtype)


def l2_norm(x):
    return x * lax.rsqrt(jnp.sum(x * x, axis=-1, keepdims=True) + EPS)


def heads(t, n):
    b, l, _ = t.shape
    return t.reshape(b, l, n, -1).transpose(0, 2, 1, 3)


def merge_heads(t):
    b, h, l, d = t.shape
    return t.transpose(0, 2, 1, 3).reshape(b, l, h * d)


def axial_rope(l, dim):
    n_freq = dim // 4
    inv = ROPE_BASE ** (-jnp.arange(n_freq, dtype=f32) / n_freq)
    t = jnp.arange(l)
    row = (t // GRID_W).astype(f32)
    col = (t % GRID_W).astype(f32)
    ang = jnp.concatenate([row[:, None] * inv, col[:, None] * inv], axis=-1)
    return jnp.cos(ang), jnp.sin(ang)


def apply_rope(x, cos, sin):
    xf = x.astype(f32).reshape(*x.shape[:-1], x.shape[-1] // 2, 2)
    x0, x1 = xf[..., 0], xf[..., 1]
    out = jnp.stack([x0 * cos - x1 * sin, x0 * sin + x1 * cos], axis=-1)
    return out.reshape(x.shape).astype(x.dtype)


def softmax_attention(q, k, v):
    s = jnp.einsum('bhqd,bhkd->bhqk', q, k).astype(f32) * (q.shape[-1] ** -0.5)
    return jnp.einsum('bhqk,bhkd->bhqd', jax.nn.softmax(s, axis=-1).astype(v.dtype), v)


def over_query_blocks(fn, qs):
    b, h, l, _ = qs[0].shape
    nb = l // Q_BLOCK
    blocked = tuple(jnp.moveaxis(t.reshape(b, h, nb, Q_BLOCK, t.shape[-1]), 2, 0) for t in qs)
    out = lax.map(lambda qq: fn(*qq), blocked)
    return jnp.moveaxis(out, 0, 2).reshape(b, h, l, out.shape[-1])


def diff_core(q1, q2, k1, k2, v, lam):
    scale = DH_A ** -0.5
    p1 = jax.nn.softmax(jnp.einsum('bhqd,bhkd->bhqk', q1, k1).astype(f32) * scale, axis=-1)
    p2 = jax.nn.softmax(jnp.einsum('bhqd,bhkd->bhqk', q2, k2).astype(f32) * scale, axis=-1)
    return jnp.einsum('bhqk,bhkd->bhqd', (p1 - lam * p2).astype(v.dtype), v)


def diff_attention(q, k, v, qc, kc, vc, qk_gain, lam_vec, subln, lam_init, cos, sin, ctx_out):
    lv = lam_vec.astype(f32)
    lam = jnp.exp(jnp.sum(lv[0] * lv[1])) - jnp.exp(jnp.sum(lv[2] * lv[3])) + lam_init

    def split_maps(t, gain, rope):
        t = heads(t, H_A)
        b, h, l, _ = t.shape
        t = rms_norm(t.reshape(b, h, l, 2, DH_A), gain)
        t1, t2 = t[..., 0, :], t[..., 1, :]
        if rope:
            t1, t2 = apply_rope(t1, cos, sin), apply_rope(t2, cos, sin)
        return t1, t2

    q1, q2 = split_maps(q, qk_gain[0], True)
    k1, k2 = split_maps(k, qk_gain[1], True)
    k1c, k2c = split_maps(kc, qk_gain[1], False)
    vh, vch = heads(v, H_A), heads(vc, H_A)
    k1a = jnp.concatenate([k1c, k1], axis=2)
    k2a = jnp.concatenate([k2c, k2], axis=2)
    va = jnp.concatenate([vch, vh], axis=2)
    o = over_query_blocks(lambda a, b_: diff_core(a, b_, k1a, k2a, va, lam), (q1, q2))

    def post(t):
        return merge_heads(rms_norm(t, subln) * (1.0 - lam_init))

    oc = None
    if ctx_out:
        q1c, q2c = split_maps(qc, qk_gain[0], False)
        oc = post(diff_core(q1c, q2c, k1c, k2c, vch, lam))
    return post(o), oc


def short_conv(t, w):
    c = t.shape[-1]
    y = lax.conv_general_dilated(t, w[:, None, :].astype(t.dtype), window_strides=(1,),
                                 padding=[(CONV_K // 2, CONV_K // 2)],
                                 dimension_numbers=('NWC', 'WIO', 'NWC'), feature_group_count=c)
    return jax.nn.silu(y)


def gdn_inputs(qkv, gates, conv_w, a_log, dt_bias):
    y = short_conv(qkv, conv_w).astype(f32)
    q, k, v = jnp.split(y, 3, axis=-1)
    q = l2_norm(heads(q, H_B)) * (DH_B ** -0.5)
    k = l2_norm(heads(k, H_B))
    v = heads(v, H_B)
    b, l, _ = gates.shape
    g = gates.astype(f32).transpose(0, 2, 1)
    beta = jax.nn.sigmoid(g[:, :2 * H_B]).reshape(b, 2, H_B, l)
    a = g[:, 2 * H_B:].reshape(b, 2, H_B, l)
    log_alpha = -jnp.exp(a_log.astype(f32))[None, :, :, None] * jax.nn.softplus(a + dt_bias.astype(f32)[None, :, :, None])
    return q, k, v, log_alpha, beta


def gated_delta_chunked(q, k, v, log_a, beta, s0):
    b, h, l, dk = q.shape
    dv = v.shape[-1]
    n = l // GDN_CHUNK
    rs = lambda t: t.reshape(b, h, n, GDN_CHUNK, *t.shape[3:])
    q, k, v, log_a, beta = rs(q), rs(k), rs(v), rs(log_a), rs(beta)
    g = jnp.cumsum(log_a, axis=-1)
    idx = jnp.arange(GDN_CHUNK)
    causal = idx[:, None] >= idx[None, :]
    strict = idx[:, None] > idx[None, :]
    decay = jnp.exp(jnp.where(causal, g[..., :, None] - g[..., None, :], -jnp.inf))
    kk = jnp.einsum('bhncd,bhnsd->bhncs', k, k)
    lmat = jnp.where(strict, beta[..., :, None] * decay * kk, 0.0)
    rhs = jnp.concatenate([beta[..., None] * v, (beta * jnp.exp(g))[..., None] * k], axis=-1)
    sol = lax.linalg.triangular_solve(jnp.eye(GDN_CHUNK, dtype=f32) + lmat, rhs,
                                      left_side=True, lower=True, unit_diagonal=True)
    u0, w = sol[..., :dv], sol[..., dv:]
    aqk = jnp.einsum('bhncd,bhnsd->bhncs', q, k) * decay
    qg = q * jnp.exp(g)[..., None]
    kg = k * jnp.exp(g[..., -1:] - g)[..., None]
    gl = jnp.exp(g[..., -1])

    def step(s, inp):
        u0_c, w_c, aqk_c, qg_c, kg_c, gl_c = inp
        u = u0_c - w_c @ s
        o = qg_c @ s + aqk_c @ u
        s = gl_c[..., None, None] * s + jnp.swapaxes(kg_c, -1, -2) @ u
        return s, o

    xs = tuple(jnp.moveaxis(t, 2, 0) for t in (u0, w, aqk, qg, kg, gl))
    s_fin, o = lax.scan(step, s0, xs)
    return jnp.moveaxis(o, 0, 2).reshape(b, h, l, dv), s_fin


def bidirectional_delta(lat, ctx):
    q, k, v, la, be = lat
    qc, kc, vc, lac, bec = ctx
    s0 = jnp.zeros((q.shape[0], H_B, DH_B, DH_B), f32)
    fl = lambda t: jnp.flip(t, axis=2)
    oc_f, s_f = gated_delta_chunked(qc, kc, vc, lac[:, 0], bec[:, 0], s0)
    oc_b, s_b = gated_delta_chunked(fl(qc), fl(kc), fl(vc), fl(lac[:, 1]), fl(bec[:, 1]), s0)
    o_f, _ = gated_delta_chunked(q, k, v, la[:, 0], be[:, 0], s_f)
    o_b, _ = gated_delta_chunked(fl(q), fl(k), fl(v), fl(la[:, 1]), fl(be[:, 1]), s_b)
    return o_f + fl(o_b), oc_f + fl(oc_b)


def gated_deltanet(qkv, gate, gates, qkv_c, gate_c, gates_c, conv_w, a_log, dt_bias, gain, ctx_out):
    lat = gdn_inputs(qkv, gates, conv_w, a_log, dt_bias)
    ctxi = gdn_inputs(qkv_c, gates_c, conv_w, a_log, dt_bias)
    o_lat, o_ctx = bidirectional_delta(lat, ctxi)

    def post(o, gg):
        b, l, _ = gg.shape
        o = rms_norm(o.transpose(0, 2, 1, 3), gain) * jax.nn.silu(gg.astype(f32).reshape(b, l, H_B, DH_B))
        return o.reshape(b, l, B_W).astype(gg.dtype)

    return post(o_lat, gate), (post(o_ctx, gate_c) if ctx_out else None)


def even_mixer(h, hc, w_in, w_out, qk_gain, lam_vec, subln, lam_init, conv_w, a_log, dt_bias,
               gdn_gain, cos, sin, ctx_out):
    qa, ka, va, qkv_b, g_b, gates_b = jnp.split(h @ w_in, EVEN_CUTS, axis=-1)
    qac, kac, vac, qkv_bc, g_bc, gates_bc = jnp.split(hc @ w_in, EVEN_CUTS, axis=-1)
    a_lat, a_ctx = diff_attention(qa, ka, va, qac, kac, vac, qk_gain, lam_vec, subln, lam_init,
                                  cos, sin, ctx_out)
    b_lat, b_ctx = gated_deltanet(qkv_b, g_b, gates_b, qkv_bc, g_bc, gates_bc, conv_w, a_log,
                                  dt_bias, gdn_gain, ctx_out)
    out = jnp.concatenate([a_lat, b_lat], axis=-1) @ w_out
    out_c = jnp.concatenate([a_ctx, b_ctx], axis=-1) @ w_out if ctx_out else None
    return out, out_c


def neighbourhood_attention(q, k, v, k_ctx, v_ctx, rpb):
    b, h, l, d = q.shape
    rows = l // GRID_W
    wr = min(WIN_R, rows)
    scale = d ** -0.5
    grid = lambda t: t.reshape(b, h, rows, GRID_W, d)
    qg, kg, vg = grid(q), grid(k), grid(v)
    cols = np.arange(GRID_W)
    c_start = np.clip(cols - WIN_C // 2, 0, GRID_W - WIN_C)
    col_mask = (cols[None, :] >= c_start[:, None]) & (cols[None, :] < c_start[:, None] + WIN_C)
    dc_idx = np.clip(cols[None, :] - cols[:, None] + WIN_C - 1, 0, 2 * WIN_C - 2)
    rpb_c = rpb[:, :, dc_idx]

    def row_block(r):
        r_start = jnp.clip(r - wr // 2, 0, rows - wr)
        q_r = lax.dynamic_index_in_dim(qg, r, axis=2, keepdims=False)
        k_b = lax.dynamic_slice_in_dim(kg, r_start, wr, axis=2)
        v_b = lax.dynamic_slice_in_dim(vg, r_start, wr, axis=2)
        dr_idx = r_start + jnp.arange(wr) - r + WIN_R - 1
        bias = jnp.take(rpb_c, dr_idx, axis=1).transpose(0, 2, 1, 3)
        s_lat = jnp.einsum('bhqd,bhrkd->bhqrk', q_r, k_b).astype(f32) * scale + bias.astype(f32)
        s_lat = jnp.where(col_mask[:, None, :], s_lat, -jnp.inf).reshape(b, h, GRID_W, wr * GRID_W)
        s_ctx = jnp.einsum('bhqd,bhkd->bhqk', q_r, k_ctx).astype(f32) * scale
        p = jax.nn.softmax(jnp.concatenate([s_lat, s_ctx], axis=-1), axis=-1).astype(v.dtype)
        p_lat = p[..., :wr * GRID_W].reshape(b, h, GRID_W, wr, GRID_W)
        return (jnp.einsum('bhqrk,bhrkd->bhqd', p_lat, v_b)
                + jnp.einsum('bhqk,bhkd->bhqd', p[..., wr * GRID_W:], v_ctx))

    out = lax.map(row_block, jnp.arange(rows))
    return jnp.moveaxis(out, 0, 2).reshape(b, h, l, d)


def odd_mixer(h, hc, w_in, w_out, qk_gain, rpb, ctx_out):
    q, k, v = jnp.split(h @ w_in, 3, axis=-1)
    kc, vc = jnp.split(hc @ w_in[:, MIX_ODD:], 2, axis=-1)
    q, k, v = rms_norm(heads(q, H_C), qk_gain[0]), rms_norm(heads(k, H_C), qk_gain[1]), heads(v, H_C)
    kc, vc = rms_norm(heads(kc, H_C), qk_gain[1]), heads(vc, H_C)
    out = merge_heads(neighbourhood_attention(q, k, v, kc, vc, rpb)) @ w_out
    out_c = None
    if ctx_out:
        qc = rms_norm(heads(hc @ w_in[:, :MIX_ODD], H_C), qk_gain[0])
        out_c = merge_heads(softmax_attention(qc, kc, vc)) @ w_out
    return out, out_c


def swiglu(h, w_in, w_out):
    gt, up = jnp.split(h @ w_in, 2, axis=-1)
    return (jax.nn.silu(gt) * up) @ w_out


def setup_inputs(seed: int = 0) -> dict:
    key = jax.random.key(seed)
    ks = jax.random.split(key, 24)
    d = D_MODEL
    nrm = lambda k, shape, s: jax.random.normal(k, shape, f32) * s
    dt = jnp.exp(jax.random.uniform(ks[17], (N_EVEN, 2, H_B), f32, math.log(1e-3), math.log(1e-1)))
    return {
        "x": nrm(ks[0], (BATCH, SEQ, d), 1.0),
        "c": nrm(ks[1], (BATCH, d), 1.0),
        "ctx": nrm(ks[2], (BATCH, CTX_LEN, d), 1.0),
        "c_ctx": nrm(ks[3], (d,), 1.0),
        "ada_w": nrm(ks[4], (DEPTH, d, 6 * d), 0.5 * d ** -0.5),
        "ada_b": nrm(ks[5], (DEPTH, 6 * d), 0.01),
        "norm_mix": 1.0 + nrm(ks[6], (DEPTH, d), 0.02),
        "norm_ffn": 1.0 + nrm(ks[7], (DEPTH, d), 0.02),
        "ffn_w_in": nrm(ks[8], (DEPTH, d, 2 * FF_HIDDEN), d ** -0.5),
        "ffn_w_out": nrm(ks[9], (DEPTH, FF_HIDDEN, d), FF_HIDDEN ** -0.5),
        "even_w_in": nrm(ks[10], (N_EVEN, d, EVEN_IN), d ** -0.5),
        "even_w_out": nrm(ks[11], (N_EVEN, MIX_EVEN, d), MIX_EVEN ** -0.5),
        "diff_qk_gain": 1.0 + nrm(ks[12], (N_EVEN, 2, DH_A), 0.02),
        "diff_lambda": nrm(ks[13], (N_EVEN, 4, DH_A), 0.1),
        "diff_subln": 1.0 + nrm(ks[14], (N_EVEN, DV_A), 0.02),
        "gdn_conv": nrm(ks[15], (N_EVEN, CONV_K, 3 * B_W), CONV_K ** -0.5),
        "gdn_a_log": jnp.log(jax.random.uniform(ks[16], (N_EVEN, 2, H_B), f32, 1.0, 16.0)),
        "gdn_dt_bias": dt + jnp.log(-jnp.expm1(-dt)),
        "gdn_norm": 1.0 + nrm(ks[18], (N_EVEN, DH_B), 0.02),
        "odd_w_in": nrm(ks[19], (N_ODD, d, 3 * MIX_ODD), d ** -0.5),
        "odd_w_out": nrm(ks[20], (N_ODD, MIX_ODD, d), MIX_ODD ** -0.5),
        "na_qk_gain": 1.0 + nrm(ks[21], (N_ODD, 2, DH_C), 0.02),
        "na_rpb": nrm(ks[22], (N_ODD, H_C, 2 * WIN_R - 1, 2 * WIN_C - 1), 0.02),
    }


def reference(x, c, ctx, c_ctx, ada_w, ada_b, norm_mix, norm_ffn, ffn_w_in, ffn_w_out,
              even_w_in, even_w_out, diff_qk_gain, diff_lambda, diff_subln, gdn_conv, gdn_a_log,
              gdn_dt_bias, gdn_norm, odd_w_in, odd_w_out, na_qk_gain, na_rpb):
    cos, sin = axial_rope(x.shape[1], DH_A)
    silu_c = jax.nn.silu(c)
    silu_cc = jax.nn.silu(c_ctx)
    for l in range(DEPTH):
        ctx_out = l < DEPTH - 1
        m = silu_c @ ada_w[l] + ada_b[l]
        mc = silu_cc @ ada_w[l] + ada_b[l]
        sh_m, sc_m, g_m, sh_f, sc_f, g_f = [t[:, None, :] for t in jnp.split(m, 6, axis=-1)]
        csh_m, csc_m, cg_m, csh_f, csc_f, cg_f = jnp.split(mc, 6)
        h = rms_norm(x, norm_mix[l]) * (1.0 + sc_m) + sh_m
        hc = rms_norm(ctx, norm_mix[l]) * (1.0 + csc_m) + csh_m
        if l % 2 == 0:
            e = l // 2
            lam_init = 0.8 - 0.6 * math.exp(-0.3 * l)
            o, oc = even_mixer(h, hc, even_w_in[e], even_w_out[e], diff_qk_gain[e], diff_lambda[e],
                               diff_subln[e], lam_init, gdn_conv[e], gdn_a_log[e], gdn_dt_bias[e],
                               gdn_norm[e], cos, sin, ctx_out)
        else:
            od = l // 2
            o, oc = odd_mixer(h, hc, odd_w_in[od], odd_w_out[od], na_qk_gain[od], na_rpb[od], ctx_out)
        x = x + g_m * o
        hf = rms_norm(x, norm_ffn[l]) * (1.0 + sc_f) + sh_f
        x = x + g_f * swiglu(hf, ffn_w_in[l], ffn_w_out[l])
        if ctx_out:
            ctx = ctx + cg_m * oc
            hcf = rms_norm(ctx, norm_ffn[l]) * (1.0 + csc_f) + csh_f
            ctx = ctx + cg_f * swiglu(hcf, ffn_w_in[l], ffn_w_out[l])
    return x
```

```cpp
#include <hip/hip_runtime.h>
#include <hip/hip_cooperative_groups.h>
#include <cstdio>
#include <cstdint>
namespace cg = cooperative_groups;

#define LAS __attribute__((address_space(3)))
typedef unsigned short bf16_t;
typedef short bf16x8 __attribute__((ext_vector_type(8)));
typedef short s16x4 __attribute__((ext_vector_type(4)));
typedef float f32x4 __attribute__((ext_vector_type(4)));
typedef float f32x16 __attribute__((ext_vector_type(16)));
typedef unsigned u32x4 __attribute__((ext_vector_type(4)));
typedef unsigned u32x2 __attribute__((ext_vector_type(2)));

#ifndef N_LAUNCH_MODE
#define N_LAUNCH_MODE 1
#endif

constexpr int DM = 1024, NLAT = 65536, NCTX = 2048, MTOT = NLAT + NCTX, SEQ = 8192, CTXL = 256, FF = 2816;
constexpr int EV_N = 3600, EV_NP = 3840, OD_N = 3072;
constexpr int NCHUNKP = 64 * 132;
constexpr int NTHREADS = 512;
constexpr int LDS_BYTES = 135168;

constexpr size_t al256(size_t x) { return (x + 255) / 256 * 256; }
constexpr size_t WS_W_EVIN = 0;
constexpr size_t WS_W_EVOUT = WS_W_EVIN + al256((size_t)EV_NP * DM * 2);
constexpr size_t WS_W_ODIN = WS_W_EVOUT + al256((size_t)DM * DM * 2);
constexpr size_t WS_W_ODOUT = WS_W_ODIN + al256((size_t)OD_N * DM * 2);
constexpr size_t WS_W_FFIN = WS_W_ODOUT + al256((size_t)DM * DM * 2);
constexpr size_t WS_W_FFOUT = WS_W_FFIN + al256((size_t)2 * 2 * FF * DM * 2);
constexpr size_t WS_MOD = WS_W_FFOUT + al256((size_t)2 * DM * FF * 2);
constexpr size_t WS_H = WS_MOD + al256((size_t)2 * 9 * 6144 * 4);
constexpr size_t WS_PROJ = WS_H + al256((size_t)MTOT * DM * 2);
constexpr size_t WS_MIX = WS_PROJ + al256((size_t)MTOT * EV_NP * 2);
constexpr size_t WS_T = WS_MIX + al256((size_t)MTOT * DM * 2);
constexpr size_t WS_AQK = WS_T + al256((size_t)NCHUNKP * 4096 * 2);
constexpr size_t WS_GV = WS_AQK + al256((size_t)NCHUNKP * 4096 * 2);
constexpr size_t WS_BV = WS_GV + al256((size_t)NCHUNKP * 64 * 4);
constexpr size_t WS_GATES = WS_BV + al256((size_t)NCHUNKP * 64 * 4);
constexpr size_t WS_CTXRES = WS_GATES + al256((size_t)MTOT * 16 * 4);
constexpr size_t WS_END = WS_CTXRES + al256((size_t)NCTX * DM * 4);

struct Params {
    const float *x, *c, *ctx, *c_ctx, *ada_w, *ada_b, *norm_mix, *norm_ffn, *ffn_w_in, *ffn_w_out, *even_w_in, *even_w_out,
        *diff_qk_gain, *diff_lambda, *diff_subln, *gdn_conv, *gdn_a_log, *gdn_dt_bias, *gdn_norm, *odd_w_in, *odd_w_out, *na_qk_gain, *na_rpb;
    float* out; unsigned char* ws; int ph_lo, ph_hi;
};

__device__ __forceinline__ float bf2f(bf16_t b) { return __uint_as_float(((unsigned)b) << 16); }
__device__ __forceinline__ bf16_t f2bf(float f) { unsigned u = __float_as_uint(f); u += 0x7FFFu + ((u >> 16) & 1u); return (bf16_t)(u >> 16); }
__device__ __forceinline__ unsigned cvtpk(float lo, float hi) { unsigned r; asm volatile("v_cvt_pk_bf16_f32 %0, %1, %2" : "=v"(r) : "v"(lo), "v"(hi)); return r; }
__device__ __forceinline__ float siluf(float v) { return v / (1.f + __expf(-v)); }
__device__ __forceinline__ void unpack8(bf16x8 v, float* f) {
#pragma unroll
    for (int i = 0; i < 8; ++i) f[i] = bf2f((bf16_t)v[i]);
}
__device__ __forceinline__ bf16x8 pack8(const float* f) {
    u32x4 w = {cvtpk(f[0], f[1]), cvtpk(f[2], f[3]), cvtpk(f[4], f[5]), cvtpk(f[6], f[7])};
    return *reinterpret_cast<bf16x8*>(&w);
}

namespace pg8 {
constexpr int BM = 256, BK = 64, HALF = 128, HTB = HALF * BK * 2, STAGE_BYTES = 8 * HTB, NXCD = 8, WGM = 8;
__host__ __device__ __forceinline__ int lds_byte(int r, int c) { const int st = (r >> 4) * 2 + (c >> 5), rr = r & 15, cc = c & 31, ob = rr * 64 + cc * 2; return st * 1024 + (ob ^ (((ob >> 9) & 1) << 5)); }
__host__ __device__ __forceinline__ void stage_rc(int b, int& R, int& C) { const int st = b / 1024, sb = b % 1024, swz = sb ^ (((sb >> 9) & 1) << 5); R = (st >> 1) * 16 + swz / 64; C = (st & 1) * 32 + (swz % 64) / 2; }
__host__ __device__ __forceinline__ int perm32(int rho) { const int n = rho >> 4, i = rho & 15; return 8 * (i >> 2) + 4 * n + (i & 3); }
struct Unit { int pm, pn; };
struct Gemm { const bf16_t* A; const bf16_t* Bt; int M, N, K; };
struct StaticOrder {
    int nM, nN, nwg, G, c;
    __device__ void init(int M, int N, int G_, int c_) { nM = M / BM; nN = N / BM; nwg = nM * nN; G = G_; c = c_; }
    __device__ bool next(int i, Unit& u) const {
        const long L = (long)i * G + c; if (L >= nwg) return false;
        int wgid = (int)L; { const int q = nwg / NXCD, r = nwg % NXCD, xcd = wgid % NXCD, off = wgid / NXCD; wgid = (xcd < r ? xcd * (q + 1) : r * (q + 1) + (xcd - r) * q) + off; }
        const int nig = WGM * nN, gid = wgid / nig, fm = gid * WGM, gsz = (nM - fm) < WGM ? (nM - fm) : WGM;
        u.pm = fm + ((wgid % nig) % gsz); u.pn = (wgid % nig) / gsz; return true;
    }
};
struct EpiBf16 {
    static constexpr bool PERM = true;
    bf16_t* O; int ldc;
    __device__ __forceinline__ void operator()(const f32x4 (&acc)[2][2][4][2], const Unit& u, int wr, int wc, int fr, int fq) const {
        const int row0 = u.pm * BM + wr * 64 + fr; const int col0 = u.pn * BM + wc * 32 + 8 * fq;
#pragma unroll
        for (int ai = 0; ai < 2; ++ai)
#pragma unroll
            for (int m = 0; m < 4; ++m) { bf16_t* rowp = O + (size_t)(row0 + ai * HALF + m * 16) * ldc + col0;
#pragma unroll
                for (int bj = 0; bj < 2; ++bj) { const f32x4 v0 = acc[ai][bj][m][0], v1 = acc[ai][bj][m][1];
                    u32x4 w; w.x = cvtpk(v0[0], v0[1]); w.y = cvtpk(v0[2], v0[3]); w.z = cvtpk(v1[0], v1[1]); w.w = cvtpk(v1[2], v1[3]);
                    *(u32x4*)(rowp + bj * HALF) = w; } }
    }
};
struct EpiSwiglu {
    static constexpr bool PERM = true;
    bf16_t* O; int ldc;
    __device__ __forceinline__ void operator()(const f32x4 (&acc)[2][2][4][2], const Unit& u, int wr, int wc, int fr, int fq) const {
        const int row0 = u.pm * BM + wr * 64 + fr; const int col0 = u.pn * HALF + wc * 32 + 8 * fq;
#pragma unroll
        for (int ai = 0; ai < 2; ++ai)
#pragma unroll
            for (int m = 0; m < 4; ++m) { bf16_t* rowp = O + (size_t)(row0 + ai * HALF + m * 16) * ldc + col0;
                float o[8];
#pragma unroll
                for (int n = 0; n < 2; ++n)
#pragma unroll
                    for (int j = 0; j < 4; ++j) { const float g = acc[ai][0][m][n][j], up = acc[ai][1][m][n][j]; o[n * 4 + j] = g / (1.f + __expf(-g)) * up; }
                u32x4 w; w.x = cvtpk(o[0], o[1]); w.y = cvtpk(o[2], o[3]); w.z = cvtpk(o[4], o[5]); w.w = cvtpk(o[6], o[7]);
                *(u32x4*)rowp = w; }
    }
};
struct EpiResid {
    static constexpr bool PERM = false;
    const float* resLat; const float* resCtx; float* outLat; float* outCtx; const float* modl; int goff;
    __device__ __forceinline__ void operator()(const f32x4 (&acc)[2][2][4][2], const Unit& u, int wr, int wc, int fr, int fq) const {
        const int rowt = u.pm * BM; const bool lat = rowt < NLAT;
        const float* res = lat ? resLat + (size_t)rowt * DM : resCtx + (size_t)(rowt - NLAT) * DM;
        float* out = lat ? outLat + (size_t)rowt * DM : outCtx + (size_t)(rowt - NLAT) * DM;
        const float* gate = modl + (size_t)(lat ? (rowt >> 13) : 8) * 6144 + goff;
        const int row0 = wr * 64 + fr, col0 = u.pn * BM + wc * 32 + 4 * fq;
        f32x4 gv[2][2];
#pragma unroll
        for (int bj = 0; bj < 2; ++bj)
#pragma unroll
            for (int n = 0; n < 2; ++n) gv[bj][n] = *(const f32x4*)(gate + col0 + bj * HALF + n * 16);
#pragma unroll
        for (int ai = 0; ai < 2; ++ai)
#pragma unroll
            for (int m = 0; m < 4; ++m) { const size_t off = (size_t)(row0 + ai * HALF + m * 16) * DM + col0;
#pragma unroll
                for (int bj = 0; bj < 2; ++bj)
#pragma unroll
                    for (int n = 0; n < 2; ++n) { const f32x4 r = *(const f32x4*)(res + off + bj * HALF + n * 16);
                        *(f32x4*)(out + off + bj * HALF + n * 16) = r + gv[bj][n] * acc[ai][bj][m][n]; } }
    }
};

template <class Epi, class Sched>
__device__ __forceinline__ void gemm_phase(LAS unsigned char* lds, const Gemm g, const Sched& S, const Epi& E) {
    const int tid = threadIdx.x, wid = __builtin_amdgcn_readfirstlane(tid >> 6), lane = tid & 63, wr = wid >> 2, wc = wid & 3, fr = lane & 15, fq = lane >> 4;
    const int K = g.K, nt = K / BK;
    unsigned voffA[2], voffB[2];
#pragma unroll
    for (int i = 0; i < 2; ++i) { int R, C; stage_rc(tid * 16 + i * 8192, R, C); const int Rb = Epi::PERM ? ((R & ~31) + perm32(R & 31)) : R;
        voffA[i] = (unsigned)(R * K + C) * 2u; voffB[i] = (unsigned)(Rb * K + C) * 2u; }
    const size_t kstep = (size_t)(BK * 2);
    const size_t hstep = (size_t)HALF * K * 2;
    const size_t tstep = 2 * hstep;
    const unsigned ldsw = (unsigned)wid * 1024u;
    const int aoff = lds_byte(wr * 64 + fr, fq * 8), boff = lds_byte(wc * 32 + fr, fq * 8);
#define PG8_SA(b, h) (((b) * 2 + (h)) * HTB)
#define PG8_SB(b, h) ((4 + (b) * 2 + (h)) * HTB)
#define PG8_STAGE(bufoff, gbase, voff) do { _Pragma("unroll") for (int _i = 0; _i < 2; ++_i) \
        __builtin_amdgcn_global_load_lds((const unsigned*)((const char*)(gbase) + (voff)[_i]), (LAS unsigned*)(lds + (bufoff) + ldsw + _i * 8192), 16, 0, 0); } while (0)
#define PG8_LDA(dst, b, h) do { _Pragma("unroll") for (int m = 0; m < 4; ++m) _Pragma("unroll") for (int k = 0; k < 2; ++k) dst[m][k] = *(const LAS bf16x8*)(lds + PG8_SA(b, h) + aoff + m * 2048 + k * 1024); } while (0)
#define PG8_LDB(dst, b, h) do { _Pragma("unroll") for (int n = 0; n < 2; ++n) _Pragma("unroll") for (int k = 0; k < 2; ++k) dst[n][k] = *(const LAS bf16x8*)(lds + PG8_SB(b, h) + boff + n * 2048 + k * 1024); } while (0)
#define PG8_MMA(ai, bj, At, Bt) do { __builtin_amdgcn_s_setprio(1); _Pragma("unroll") for (int m = 0; m < 4; ++m) _Pragma("unroll") for (int n = 0; n < 2; ++n) _Pragma("unroll") for (int k = 0; k < 2; ++k) \
        acc[ai][bj][m][n] = __builtin_amdgcn_mfma_f32_16x16x32_bf16(Bt[n][k], At[m][k], acc[ai][bj][m][n], 0, 0, 0); __builtin_amdgcn_s_setprio(0); } while (0)
#define PG8_WAIT_V(n) asm volatile("s_waitcnt vmcnt(" #n ")" ::: "memory")
#define PG8_WAIT_L(n) asm volatile("s_waitcnt lgkmcnt(" #n ")" ::: "memory")
#define PG8_BAR __builtin_amdgcn_s_barrier()
#define PG8_SCHED __builtin_amdgcn_sched_barrier(0)
    Unit cur, nxt; int ui = 0;
    if (!S.next(0, cur)) return;
    f32x4 acc[2][2][4][2];
#pragma unroll
    for (int a = 0; a < 2; ++a)
#pragma unroll
        for (int b = 0; b < 2; ++b)
#pragma unroll
            for (int m = 0; m < 4; ++m)
#pragma unroll
                for (int n = 0; n < 2; ++n) acc[a][b][m][n] = (f32x4){0.f, 0.f, 0.f, 0.f};
    bf16x8 At[4][2], B0[2][2], B1[2][2];
    const char* cA = (const char*)g.A + (size_t)cur.pm * tstep; const char* cB = (const char*)g.Bt + (size_t)cur.pn * tstep;
    PG8_STAGE(PG8_SB(0, 0), cB, voffB); PG8_STAGE(PG8_SA(0, 0), cA, voffA); PG8_STAGE(PG8_SB(0, 1), cB + hstep, voffB); PG8_STAGE(PG8_SA(0, 1), cA + hstep, voffA);
    if (wr == 1) PG8_BAR;
    PG8_WAIT_V(4); PG8_BAR;
    PG8_STAGE(PG8_SB(1, 0), cB + kstep, voffB); PG8_STAGE(PG8_SA(1, 0), cA + kstep, voffA); PG8_STAGE(PG8_SB(1, 1), cB + hstep + kstep, voffB);
    PG8_WAIT_V(6); PG8_BAR;
    for (;;) {
        const bool has_next = S.next(ui + 1, nxt);
        const char* nA = has_next ? (const char*)g.A + (size_t)nxt.pm * tstep : cA; const char* nB = has_next ? (const char*)g.Bt + (size_t)nxt.pn * tstep : cB;
        for (int t = 0; t < nt; t += 2) {
            const bool last = (t == nt - 2);
            const char* a1 = cA + (size_t)(t + 1) * kstep;
            const char* a2 = last ? nA : cA + (size_t)(t + 2) * kstep; const char* b2 = last ? nB : cB + (size_t)(t + 2) * kstep;
            const char* a3 = a2 + kstep; const char* b3 = b2 + kstep;
            PG8_LDB(B0, 0, 0); PG8_SCHED; PG8_LDA(At, 0, 0); PG8_STAGE(PG8_SA(1, 1), a1 + hstep, voffA);
            PG8_WAIT_L(8); PG8_BAR; PG8_WAIT_L(0); PG8_MMA(0, 0, At, B0); PG8_BAR; PG8_SCHED;
            PG8_LDB(B1, 0, 1); PG8_STAGE(PG8_SB(0, 0), b2, voffB);
            PG8_BAR; PG8_WAIT_L(0); PG8_MMA(0, 1, At, B1); PG8_BAR;
            PG8_LDA(At, 0, 1); PG8_STAGE(PG8_SA(0, 0), a2, voffA);
            PG8_BAR; PG8_WAIT_L(0); PG8_MMA(1, 0, At, B0); PG8_BAR; PG8_SCHED;
            PG8_STAGE(PG8_SB(0, 1), b2 + hstep, voffB);
            PG8_WAIT_V(6); PG8_BAR; PG8_MMA(1, 1, At, B1); PG8_BAR;
            PG8_LDB(B0, 1, 0); PG8_SCHED; PG8_LDA(At, 1, 0); PG8_STAGE(PG8_SA(0, 1), a2 + hstep, voffA);
            PG8_WAIT_L(8); PG8_BAR; PG8_WAIT_L(0); PG8_MMA(0, 0, At, B0); PG8_BAR; PG8_SCHED;
            PG8_LDB(B1, 1, 1); PG8_STAGE(PG8_SB(1, 0), b3, voffB);
            PG8_BAR; PG8_WAIT_L(0); PG8_MMA(0, 1, At, B1); PG8_BAR;
            PG8_LDA(At, 1, 1); PG8_STAGE(PG8_SA(1, 0), a3, voffA);
            PG8_BAR; PG8_WAIT_L(0); PG8_MMA(1, 0, At, B0); PG8_BAR; PG8_SCHED;
            PG8_STAGE(PG8_SB(1, 1), b3 + hstep, voffB);
            PG8_WAIT_V(6); PG8_BAR; PG8_MMA(1, 1, At, B1); PG8_BAR;
        }
        E(acc, cur, wr, wc, fr, fq);
        if (!has_next) break;
#pragma unroll
        for (int a = 0; a < 2; ++a)
#pragma unroll
            for (int b = 0; b < 2; ++b)
#pragma unroll
                for (int m = 0; m < 4; ++m)
#pragma unroll
                    for (int n = 0; n < 2; ++n) acc[a][b][m][n] = (f32x4){0.f, 0.f, 0.f, 0.f};
        cur = nxt; cA = nA; cB = nB; ++ui;
    }
    PG8_WAIT_V(0);
    if (wr == 0) PG8_BAR;
    PG8_BAR;
#undef PG8_SA
#undef PG8_SB
#undef PG8_STAGE
#undef PG8_LDA
#undef PG8_LDB
#undef PG8_MMA
#undef PG8_WAIT_V
#undef PG8_WAIT_L
#undef PG8_BAR
#undef PG8_SCHED
}
}

#define KSWZ(row, colB) ((row) * 256 + ((colB) ^ (((row) & 7) << 4)))
#define SBAR() __builtin_amdgcn_sched_barrier(0)
__device__ __forceinline__ int crow(int r, int hi) { return (r & 3) + 8 * (r >> 2) + 4 * hi; }
__device__ __forceinline__ int v_st(int k, int c) { const int kk = (k & ~0xC) | ((k & 4) << 1) | ((k & 8) >> 1); return ((kk >> 3) * 4 + (c >> 5)) * 512 + ((kk & 7) * 32 + (c & 31)) * 2; }
__device__ __forceinline__ int v_rd_base(int lane) { return ((lane & 3) << 3) | (((lane >> 2) & 3) << 6) | (((lane >> 4) & 1) << 5) | (((lane >> 5) & 1) << 8); }
constexpr int v_rd_off(int d0, int ks, int half) { return d0 * 512 + ks * 4096 + half * 2048; }
template <int OFF> __device__ __forceinline__ s16x4 tr_read(int vb) {
    s16x4 r; asm volatile("ds_read_b64_tr_b16 %0, %1 offset:%2" : "=&v"(r) : "v"(vb), "i"(OFF) : "memory"); return r;
}
template <int D0> __device__ __forceinline__ void pv_one(f32x16& od, int vb, bf16x8 pa0, bf16x8 pa1, bf16x8 pa2, bf16x8 pa3) {
    const s16x4 l0 = tr_read<v_rd_off(D0, 0, 0)>(vb), h0 = tr_read<v_rd_off(D0, 0, 1)>(vb), l1 = tr_read<v_rd_off(D0, 1, 0)>(vb), h1 = tr_read<v_rd_off(D0, 1, 1)>(vb);
    const s16x4 l2 = tr_read<v_rd_off(D0, 2, 0)>(vb), h2 = tr_read<v_rd_off(D0, 2, 1)>(vb), l3 = tr_read<v_rd_off(D0, 3, 0)>(vb), h3 = tr_read<v_rd_off(D0, 3, 1)>(vb);
    asm volatile("s_waitcnt lgkmcnt(0)" ::: "memory"); SBAR();
#define PK(L, H) (bf16x8){L[0], L[1], L[2], L[3], H[0], H[1], H[2], H[3]}
    od = __builtin_amdgcn_mfma_f32_32x32x16_bf16(pa0, PK(l0, h0), od, 0, 0, 0);
    od = __builtin_amdgcn_mfma_f32_32x32x16_bf16(pa1, PK(l1, h1), od, 0, 0, 0);
    od = __builtin_amdgcn_mfma_f32_32x32x16_bf16(pa2, PK(l2, h2), od, 0, 0, 0);
    od = __builtin_amdgcn_mfma_f32_32x32x16_bf16(pa3, PK(l3, h3), od, 0, 0, 0);
#undef PK
}
__device__ __forceinline__ void pv_d0(f32x16* o, int vb, bf16x8 pa0, bf16x8 pa1, bf16x8 pa2, bf16x8 pa3) {
    pv_one<0>(o[0], vb, pa0, pa1, pa2, pa3); pv_one<1>(o[1], vb, pa0, pa1, pa2, pa3); pv_one<2>(o[2], vb, pa0, pa1, pa2, pa3); pv_one<3>(o[3], vb, pa0, pa1, pa2, pa3);
}
#define PK4(P, BASE, OUT) do { unsigned a0 = cvtpk(P[BASE + 0], P[BASE + 1]), a1 = cvtpk(P[BASE + 2], P[BASE + 3]);   \
    unsigned b0 = cvtpk(P[BASE + 4], P[BASE + 5]), b1 = cvtpk(P[BASE + 6], P[BASE + 7]);                              \
    auto r0 = __builtin_amdgcn_permlane32_swap(a0, b0, false, false); auto r1 = __builtin_amdgcn_permlane32_swap(a1, b1, false, false); \
    u32x4 w = {r0[0], r1[0], r0[1], r1[1]}; OUT = *reinterpret_cast<bf16x8*>(&w); } while (0)
__device__ __forceinline__ float halfswap_add(float v) {
    auto rr = __builtin_amdgcn_permlane32_swap(__float_as_uint(v), __float_as_uint(v), false, false);
    return __uint_as_float(rr[0]) + __uint_as_float(rr[1]);
}

__device__ void ada_phase(const Params& p, unsigned char* lds) {
    float* sc = (float*)lds;
    float* red = (float*)(lds + 40960);
    float* mod = (float*)(p.ws + WS_MOD);
    const int tid = threadIdx.x;
    for (int j = blockIdx.x; j < 192; j += gridDim.x) {
        const int l = j / 96, n0 = (j % 96) * 64;
        for (int i = tid; i < 9 * 1024; i += NTHREADS) { const int r = i >> 10, k = i & 1023; const float v = r < 8 ? p.c[r * 1024 + k] : p.c_ctx[k]; sc[i] = v / (1.f + expf(-v)); }
        __syncthreads();
        const int col = tid & 63, ks = tid >> 6;
        float acc[9];
#pragma unroll
        for (int r = 0; r < 9; ++r) acc[r] = 0.f;
        const float* wp = p.ada_w + ((size_t)l * 1024 + ks * 128) * 6144 + n0 + col;
#pragma unroll 8
        for (int kk = 0; kk < 128; ++kk) { const float w = wp[(size_t)kk * 6144];
#pragma unroll
            for (int r = 0; r < 9; ++r) acc[r] += sc[r * 1024 + ks * 128 + kk] * w; }
#pragma unroll
        for (int r = 0; r < 9; ++r) red[(ks * 9 + r) * 64 + col] = acc[r];
        __syncthreads();
        for (int i = tid; i < 576; i += NTHREADS) { const int r = i >> 6, cc = i & 63; float s = p.ada_b[l * 6144 + n0 + cc];
            for (int k2 = 0; k2 < 8; ++k2) s += red[(k2 * 9 + r) * 64 + cc];
            mod[(size_t)(l * 9 + r) * 6144 + n0 + cc] = s; }
        __syncthreads();
    }
}
__device__ void wconv_phase(const Params& p, unsigned char* lds) {
    float* tl = (float*)lds;
    const int tid = threadIdx.x;
    const int T0 = 16 * 60, T1 = T0 + 16 * 16, T2 = T1 + 16 * 48, T3 = T2 + 16 * 16, T4 = T3 + 16 * 88, T5 = T4 + 16 * 88, T6 = T5 + 44 * 16, T7 = T6 + 44 * 16;
    for (int t = blockIdx.x; t < T7; t += gridDim.x) {
        const float* src; bf16_t* dst; int K, N, NP, mode = 0, tt;
        if (t < T0) { src = p.even_w_in; dst = (bf16_t*)(p.ws + WS_W_EVIN); K = 1024; N = EV_N; NP = EV_NP; tt = t; }
        else if (t < T1) { src = p.even_w_out; dst = (bf16_t*)(p.ws + WS_W_EVOUT); K = 1024; N = 1024; NP = 1024; tt = t - T0; }
        else if (t < T2) { src = p.odd_w_in; dst = (bf16_t*)(p.ws + WS_W_ODIN); K = 1024; N = OD_N; NP = OD_N; tt = t - T1; }
        else if (t < T3) { src = p.odd_w_out; dst = (bf16_t*)(p.ws + WS_W_ODOUT); K = 1024; N = 1024; NP = 1024; tt = t - T2; }
        else if (t < T4) { src = p.ffn_w_in; dst = (bf16_t*)(p.ws + WS_W_FFIN); K = 1024; N = 2 * FF; NP = 2 * FF; mode = 1; tt = t - T3; }
        else if (t < T5) { src = p.ffn_w_in + (size_t)1024 * 2 * FF; dst = (bf16_t*)(p.ws + WS_W_FFIN) + (size_t)2 * FF * 1024; K = 1024; N = 2 * FF; NP = 2 * FF; mode = 1; tt = t - T4; }
        else if (t < T6) { src = p.ffn_w_out; dst = (bf16_t*)(p.ws + WS_W_FFOUT); K = FF; N = 1024; NP = 1024; tt = t - T5; }
        else { src = p.ffn_w_out + (size_t)FF * 1024; dst = (bf16_t*)(p.ws + WS_W_FFOUT) + (size_t)1024 * FF; K = FF; N = 1024; NP = 1024; tt = t - T6; }
        const int nnt = NP / 64; const int k0 = (tt / nnt) * 64, n0 = (tt % nnt) * 64;
        int sn0;
        if (mode == 1) { const int tb = n0 >> 8, bj = (n0 >> 7) & 1, i0 = n0 & 127; sn0 = bj * FF + tb * 128 + i0; } else sn0 = n0;
        for (int e = tid; e < 4096; e += NTHREADS) { const int kk = e >> 6, nn = e & 63; const int sn = sn0 + nn;
            tl[kk * 65 + nn] = (sn < N) ? src[(size_t)(k0 + kk) * N + sn] : 0.f; }
        __syncthreads();
        for (int e = tid; e < 2048; e += NTHREADS) { const int nn = e >> 5, k2 = (e & 31) * 2;
            *(unsigned*)(dst + (size_t)(n0 + nn) * K + k0 + k2) = cvtpk(tl[k2 * 65 + nn], tl[(k2 + 1) * 65 + nn]); }
        __syncthreads();
    }
}

__device__ void norm_phase(const Params& p, const float* xlat, const float* xctx, int l, int which, int nrows) {
    const int lane = threadIdx.x & 63, wid = threadIdx.x >> 6;
    bf16_t* h = (bf16_t*)(p.ws + WS_H);
    const float* mod = (const float*)(p.ws + WS_MOD) + (size_t)l * 9 * 6144;
    const float* gain = (which ? p.norm_ffn : p.norm_mix) + l * 1024;
    const int shoff = which ? 3072 : 0, scoff = which ? 4096 : 1024;
    for (int row = blockIdx.x * 8 + wid; row < nrows; row += gridDim.x * 8) {
        const bool lat = row < NLAT;
        const float* src = lat ? xlat + (size_t)row * DM : xctx + (size_t)(row - NLAT) * DM;
        const float* mr = mod + (size_t)(lat ? (row >> 13) : 8) * 6144;
        f32x4 v[4]; float ss = 0.f;
#pragma unroll
        for (int i = 0; i < 4; ++i) { v[i] = *(const f32x4*)(src + lane * 4 + 256 * i); ss += v[i][0] * v[i][0] + v[i][1] * v[i][1] + v[i][2] * v[i][2] + v[i][3] * v[i][3]; }
#pragma unroll
        for (int o = 1; o < 64; o <<= 1) ss += __shfl_xor(ss, o);
        const float rstd = rsqrtf(ss * (1.f / 1024.f) + 1e-6f);
#pragma unroll
        for (int i = 0; i < 4; ++i) { const int c0 = lane * 4 + 256 * i;
            const f32x4 g = *(const f32x4*)(gain + c0), s1 = *(const f32x4*)(mr + scoff + c0), sh = *(const f32x4*)(mr + shoff + c0);
            float y[4];
#pragma unroll
            for (int j = 0; j < 4; ++j) y[j] = v[i][j] * rstd * g[j] * (1.f + s1[j]) + sh[j];
            u32x2 w; w.x = cvtpk(y[0], y[1]); w.y = cvtpk(y[2], y[3]);
            *(u32x2*)(h + (size_t)row * DM + c0) = w; }
    }
}

__device__ void prep0_phase(const Params& p) {
    const int lane = threadIdx.x & 63, wid = threadIdx.x >> 6;
    bf16_t* proj = (bf16_t*)(p.ws + WS_PROJ);
    bf16_t* qkvp = (bf16_t*)p.out;
    float* gbuf = (float*)(p.ws + WS_GATES);
    const int dsub = (lane & 7) * 8;
    const bool isrow = (lane & 7) < 4;
    float inv[4];
#pragma unroll
    for (int i = 0; i < 4; ++i) { const int pp = (lane & 7) * 4 + i; inv[i] = powf(10000.f, -(float)(pp & 15) / 16.f); }
    for (int row = blockIdx.x * 8 + wid; row < MTOT; row += gridDim.x * 8) {
        const bool lat = row < NLAT; const int t = lat ? (row & 8191) : ((row - NLAT) & 255); const int len = lat ? SEQ : CTXL;
        bf16_t* P = proj + (size_t)row * EV_NP;
        float cs[4], sn[4];
        if (lat) {
#pragma unroll
            for (int i = 0; i < 4; ++i) { const float ang = (isrow ? (float)(t >> 6) : (float)(t & 63)) * inv[i]; cs[i] = cosf(ang); sn[i] = sinf(ang); }
        } else {
#pragma unroll
            for (int i = 0; i < 4; ++i) { cs[i] = 1.f; sn[i] = 0.f; }
        }
#pragma unroll
        for (int which = 0; which < 2; ++which) {
            float v[8]; unpack8(*(const bf16x8*)(P + which * 512 + lane * 8), v);
            float ss = 0.f;
#pragma unroll
            for (int i = 0; i < 8; ++i) ss += v[i] * v[i];
            ss += __shfl_xor(ss, 1); ss += __shfl_xor(ss, 2); ss += __shfl_xor(ss, 4);
            const float rstd = rsqrtf(ss * (1.f / 64.f) + 1e-6f);
#pragma unroll
            for (int i = 0; i < 8; ++i) v[i] = v[i] * rstd * p.diff_qk_gain[which * 64 + dsub + i];
#pragma unroll
            for (int i = 0; i < 4; ++i) { const float x0 = v[2 * i], x1 = v[2 * i + 1]; v[2 * i] = x0 * cs[i] - x1 * sn[i]; v[2 * i + 1] = x0 * sn[i] + x1 * cs[i]; }
            if (which == 0) {
#pragma unroll
                for (int i = 0; i < 8; ++i) v[i] *= 0.125f * 1.4426950408889634f;
            }
            *(bf16x8*)(P + which * 512 + lane * 8) = pack8(v);
        }
#pragma unroll
        for (int i = 0; i < 3; ++i) {
            const int c0 = i * 512 + lane * 8;
            float y[8];
#pragma unroll
            for (int e = 0; e < 8; ++e) y[e] = 0.f;
#pragma unroll
            for (int j = 0; j < 5; ++j) { const int tt = t + j - 2;
                if (tt >= 0 && tt < len) { float xv[8]; unpack8(*(const bf16x8*)(proj + (size_t)(row + j - 2) * EV_NP + 1536 + c0), xv);
                    const f32x4 w0 = *(const f32x4*)(p.gdn_conv + j * 1536 + c0), w1 = *(const f32x4*)(p.gdn_conv + j * 1536 + c0 + 4);
#pragma unroll
                    for (int e = 0; e < 4; ++e) { y[e] += w0[e] * xv[e]; y[4 + e] += w1[e] * xv[4 + e]; } } }
#pragma unroll
            for (int e = 0; e < 8; ++e) y[e] = y[e] / (1.f + expf(-y[e]));
            if (i < 2) { float ss = 0.f;
#pragma unroll
                for (int e = 0; e < 8; ++e) ss += y[e] * y[e];
                ss += __shfl_xor(ss, 1); ss += __shfl_xor(ss, 2); ss += __shfl_xor(ss, 4); ss += __shfl_xor(ss, 8);
                const float s = rsqrtf(ss + 1e-6f) * (i == 0 ? 0.08838834764831845f : 1.f);
#pragma unroll
                for (int e = 0; e < 8; ++e) y[e] *= s; }
            *(bf16x8*)(qkvp + (size_t)row * 1536 + c0) = pack8(y);
        }
        if (lane < 16) { const float gv = bf2f(P[3584 + lane]); float o;
            if (lane < 8) o = 1.f / (1.f + expf(-gv));
            else { const float z = gv + p.gdn_dt_bias[lane - 8]; const float sp = z > 20.f ? z : log1pf(expf(z)); o = -expf(p.gdn_a_log[lane - 8]) * sp; }
            gbuf[(size_t)row * 16 + lane] = o; }
    }
}

__device__ __forceinline__ int gdn_row(int b, int pc, int tau, int dir) {
    const int tt = dir ? 63 - tau : tau;
    return pc < 4 ? NLAT + b * CTXL + pc * 64 + tt : b * SEQ + (pc - 4) * 64 + tt;
}
__device__ void gdn_pre_phase(const Params& p, unsigned char* lds) {
    const int lane = threadIdx.x & 63, wid = threadIdx.x >> 6;
    float* Lw = (float*)(lds + wid * 16896);
    float* gs = Lw + 4096; float* bs = gs + 64;
    const bf16_t* qkvp = (const bf16_t*)p.out;
    const float* gbuf = (const float*)(p.ws + WS_GATES);
    bf16_t* Tb = (bf16_t*)(p.ws + WS_T); bf16_t* Ab = (bf16_t*)(p.ws + WS_AQK);
    float* gv = (float*)(p.ws + WS_GV); float* bv = (float*)(p.ws + WS_BV);
    const int lane0 = lane;
    for (int cp = blockIdx.x * 8 + wid; cp < NCHUNKP; cp += gridDim.x * 8) {
        int lane = lane0; asm volatile("" : "+v"(lane));
        const int r32 = lane & 31, hi = lane >> 5;
        const int pc = cp % 132, ch = cp / 132, dir = ch & 1, h = (ch >> 1) & 3, b = ch >> 3;
        { const int R = gdn_row(b, pc, lane, dir);
          float g = gbuf[(size_t)R * 16 + 8 + dir * 4 + h]; const float be = gbuf[(size_t)R * 16 + dir * 4 + h];
#pragma unroll
          for (int o = 1; o < 64; o <<= 1) { const float t = __shfl_up(g, o); if (lane >= o) g += t; }
          gs[lane] = g; bs[lane] = be; gv[(size_t)cp * 64 + lane] = g; bv[(size_t)cp * 64 + lane] = be; }
        bf16x8 kf[2][8];
#pragma unroll
        for (int mi = 0; mi < 2; ++mi) { const size_t R = (size_t)gdn_row(b, pc, 32 * mi + r32, dir);
#pragma unroll
            for (int d0 = 0; d0 < 8; ++d0) kf[mi][d0] = *(const bf16x8*)(qkvp + R * 1536 + 512 + h * 128 + d0 * 16 + hi * 8); }
        bf16_t* Ao = Ab + (size_t)cp * 4096;
#pragma unroll
        for (int mi = 0; mi < 2; ++mi) {
            bf16x8 qf[8];
            { const size_t R = (size_t)gdn_row(b, pc, 32 * mi + r32, dir);
#pragma unroll
              for (int d0 = 0; d0 < 8; ++d0) qf[d0] = *(const bf16x8*)(qkvp + R * 1536 + h * 128 + d0 * 16 + hi * 8); }
#pragma unroll
            for (int ni = 0; ni <= mi; ++ni) {
                f32x16 ckk = {}, cqk = {};
#pragma unroll
                for (int d0 = 0; d0 < 8; ++d0) { ckk = __builtin_amdgcn_mfma_f32_32x32x16_bf16(kf[mi][d0], kf[ni][d0], ckk, 0, 0, 0);
                                                 cqk = __builtin_amdgcn_mfma_f32_32x32x16_bf16(qf[d0], kf[ni][d0], cqk, 0, 0, 0); }
                const int sg = 32 * ni + r32; const float gsg = gs[sg];
#pragma unroll
                for (int r = 0; r < 16; ++r) { const int tau = 32 * mi + crow(r, hi);
                    const float dec = tau >= sg ? expf(gs[tau] - gsg) : 0.f;
                    Lw[tau * 64 + sg] = tau > sg ? bs[tau] * dec * ckk[r] : 0.f;
                    Ao[tau * 64 + sg] = f2bf(cqk[r] * dec); }
                asm volatile("" ::: "memory");
            }
        }
#pragma unroll
        for (int r = 0; r < 16; ++r) Ao[crow(r, hi) * 64 + 32 + r32] = 0;
        float Tc[64];
#pragma unroll
        for (int i = 0; i < 64; ++i) { float a = (i == lane) ? 1.f : 0.f;
#pragma unroll
            for (int j = 0; j < i; ++j) a -= Lw[i * 64 + j] * Tc[j];
            Tc[i] = a; asm volatile("" ::: "memory"); }
        bf16_t* To = Tb + (size_t)cp * 4096;
#pragma unroll
        for (int i = 0; i < 64; ++i) To[i * 64 + lane] = f2bf(Tc[i]);
    }
}

constexpr int G_KA = 0, G_KV = 16384, G_QA = 32768, G_TT = 49152, G_AQ = G_TT + 9216, G_RT = G_AQ + 9216, G_UT = G_RT + 4608, G_UP = G_UT + 4608,
              G_ST = G_UP + 4608, G_VS = G_ST + 8704, G_GS = G_VS + 4096, G_BS = G_GS + 256, G_END = G_BS + 256;
__device__ void gdn_scan_phase(const Params& p, unsigned char* lds) {
    const int tid = threadIdx.x, lane = tid & 63, wid = tid >> 6, r32 = lane & 31, hi = lane >> 5;
    const bf16_t* qkvp = (const bf16_t*)p.out;
    const bf16_t* Tb = (const bf16_t*)(p.ws + WS_T); const bf16_t* Ab = (const bf16_t*)(p.ws + WS_AQK);
    const float* gv = (const float*)(p.ws + WS_GV); const float* bv = (const float*)(p.ws + WS_BV);
    bf16_t* obuf = (bf16_t*)(p.ws + WS_H);
    const float* gsl = (const float*)(lds + G_GS); const float* bsl = (const float*)(lds + G_BS);
    const int sr = tid >> 4, sc = (tid & 15) * 8;
    const int vb0 = (int)(uintptr_t)(lds + G_KV) + v_rd_base(lane);
    for (int wi = blockIdx.x; wi < 256; wi += gridDim.x) {
        const int chain = wi >> 2, cs = wi & 3, b = chain >> 3, h = (chain >> 1) & 3, dir = chain & 1;
        f32x16 Sacc = {};
        for (int i = tid; i < 8704 / 4; i += NTHREADS) ((unsigned*)(lds + G_ST))[i] = 0u;
        bf16x8 sk0, sk1, sq0, sq1, sT, sA, sV; float sg = 0.f;
#define GLOAD(step) do { const int pc_ = dir == 0 ? (step) : ((step) < 4 ? 3 - (step) : 4 + 127 - ((step) - 4)); \
        const size_t cp_ = (size_t)chain * 132 + pc_; \
        const size_t R0_ = (size_t)gdn_row(b, pc_, sr, dir), R1_ = (size_t)gdn_row(b, pc_, 32 + sr, dir); \
        sk0 = *(const bf16x8*)(qkvp + R0_ * 1536 + 512 + h * 128 + sc); sk1 = *(const bf16x8*)(qkvp + R1_ * 1536 + 512 + h * 128 + sc); \
        sq0 = *(const bf16x8*)(qkvp + R0_ * 1536 + h * 128 + sc); sq1 = *(const bf16x8*)(qkvp + R1_ * 1536 + h * 128 + sc); \
        sT = *(const bf16x8*)(Tb + cp_ * 4096 + tid * 8); sA = *(const bf16x8*)(Ab + cp_ * 4096 + tid * 8); \
        if (tid < 256) { const size_t Rv_ = (size_t)gdn_row(b, pc_, tid >> 2, dir); sV = *(const bf16x8*)(qkvp + Rv_ * 1536 + 1024 + h * 128 + cs * 32 + (tid & 3) * 8); } \
        if (tid < 64) sg = gv[cp_ * 64 + tid]; else if (tid < 128) sg = bv[cp_ * 64 + tid - 64]; } while (0)
#define GWRITE() do { *(bf16x8*)(lds + G_KA + KSWZ(sr, sc * 2)) = sk0; *(bf16x8*)(lds + G_KA + KSWZ(32 + sr, sc * 2)) = sk1; \
        *(bf16x8*)(lds + G_KV + v_st(sr, sc)) = sk0; *(bf16x8*)(lds + G_KV + v_st(32 + sr, sc)) = sk1; \
        *(bf16x8*)(lds + G_QA + KSWZ(sr, sc * 2)) = sq0; *(bf16x8*)(lds + G_QA + KSWZ(32 + sr, sc * 2)) = sq1; \
        *(bf16x8*)(lds + G_TT + (tid >> 3) * 144 + (tid & 7) * 16) = sT; *(bf16x8*)(lds + G_AQ + (tid >> 3) * 144 + (tid & 7) * 16) = sA; \
        if (tid < 256) *(bf16x8*)(lds + G_VS + (tid >> 2) * 64 + (tid & 3) * 16) = sV; \
        if (tid < 64) ((float*)(lds + G_GS))[tid] = sg; else if (tid < 128) ((float*)(lds + G_BS))[tid - 64] = sg; } while (0)
        GLOAD(0);
        for (int step = 0; step < 132; ++step) {
            GWRITE();
            __syncthreads();
            if (step + 1 < 132) GLOAD(step + 1);
            const int pc = dir == 0 ? step : (step < 4 ? 3 - step : 4 + 127 - (step - 4));
            f32x16 acc = {};
            const int mi = wid & 1;
            if (wid < 4) {
                const unsigned char* At = lds + (wid < 2 ? G_KA : G_QA);
#pragma unroll
                for (int d0 = 0; d0 < 8; ++d0) {
                    const bf16x8 a = *(const bf16x8*)(At + KSWZ(32 * mi + r32, (d0 * 16 + hi * 8) * 2));
                    const bf16x8 bb = *(const bf16x8*)(lds + G_ST + r32 * 272 + (d0 * 16 + hi * 8) * 2);
                    acc = __builtin_amdgcn_mfma_f32_32x32x16_bf16(a, bb, acc, 0, 0, 0); }
                if (wid < 2) {
#pragma unroll
                    for (int g4 = 0; g4 < 4; ++g4) { float rv[4];
#pragma unroll
                        for (int j = 0; j < 4; ++j) { const int tau = 32 * mi + 8 * g4 + 4 * hi + j;
                            const float vv = bf2f(*(const bf16_t*)(lds + G_VS + tau * 64 + r32 * 2));
                            rv[j] = bsl[tau] * (vv - expf(gsl[tau]) * acc[g4 * 4 + j]); }
                        u32x2 w; w.x = cvtpk(rv[0], rv[1]); w.y = cvtpk(rv[2], rv[3]);
                        *(u32x2*)(lds + G_RT + r32 * 144 + (32 * mi + 8 * g4 + 4 * hi) * 2) = w; }
                } else {
#pragma unroll
                    for (int r = 0; r < 16; ++r) acc[r] *= expf(gsl[32 * mi + crow(r, hi)]);
                }
            }
            __syncthreads();
            if (wid < 2) {
                f32x16 u = {};
#pragma unroll
                for (int s = 0; s < 4; ++s) {
                    const bf16x8 a = *(const bf16x8*)(lds + G_TT + (32 * mi + r32) * 144 + (16 * s + hi * 8) * 2);
                    const bf16x8 bb = *(const bf16x8*)(lds + G_RT + r32 * 144 + (16 * s + hi * 8) * 2);
                    u = __builtin_amdgcn_mfma_f32_32x32x16_bf16(a, bb, u, 0, 0, 0); }
                const float glast = gsl[63];
#pragma unroll
                for (int g4 = 0; g4 < 4; ++g4) { float uv[4], up[4];
#pragma unroll
                    for (int j = 0; j < 4; ++j) { const int tau = 32 * mi + 8 * g4 + 4 * hi + j; uv[j] = u[g4 * 4 + j]; up[j] = uv[j] * expf(glast - gsl[tau]); }
                    u32x2 w; w.x = cvtpk(uv[0], uv[1]); w.y = cvtpk(uv[2], uv[3]);
                    *(u32x2*)(lds + G_UT + r32 * 144 + (32 * mi + 8 * g4 + 4 * hi) * 2) = w;
                    u32x2 w2; w2.x = cvtpk(up[0], up[1]); w2.y = cvtpk(up[2], up[3]);
                    *(u32x2*)(lds + G_UP + r32 * 144 + (32 * mi + 8 * g4 + 4 * hi) * 2) = w2; }
            }
            __syncthreads();
            if (wid == 2 || wid == 3) {
#pragma unroll
                for (int s = 0; s < 4; ++s) {
                    const bf16x8 a = *(const bf16x8*)(lds + G_AQ + (32 * mi + r32) * 144 + (16 * s + hi * 8) * 2);
                    const bf16x8 bb = *(const bf16x8*)(lds + G_UT + r32 * 144 + (16 * s + hi * 8) * 2);
                    acc = __builtin_amdgcn_mfma_f32_32x32x16_bf16(a, bb, acc, 0, 0, 0); }
#pragma unroll
                for (int r = 0; r < 16; ++r) { const size_t R = (size_t)gdn_row(b, pc, 32 * mi + crow(r, hi), dir);
                    obuf[((size_t)dir * MTOT + R) * 512 + h * 128 + cs * 32 + r32] = f2bf(acc[r]); }
            } else if (wid >= 4) {
                const float gl = expf(gsl[63]);
#pragma unroll
                for (int r = 0; r < 16; ++r) Sacc[r] *= gl;
                const bf16x8 pa0 = *(const bf16x8*)(lds + G_UP + r32 * 144 + (0 + hi * 8) * 2), pa1 = *(const bf16x8*)(lds + G_UP + r32 * 144 + (16 + hi * 8) * 2),
                             pa2 = *(const bf16x8*)(lds + G_UP + r32 * 144 + (32 + hi * 8) * 2), pa3 = *(const bf16x8*)(lds + G_UP + r32 * 144 + (48 + hi * 8) * 2);
                const int d0 = wid - 4;
                if (d0 == 0) pv_one<0>(Sacc, vb0, pa0, pa1, pa2, pa3); else if (d0 == 1) pv_one<1>(Sacc, vb0, pa0, pa1, pa2, pa3);
                else if (d0 == 2) pv_one<2>(Sacc, vb0, pa0, pa1, pa2, pa3); else pv_one<3>(Sacc, vb0, pa0, pa1, pa2, pa3);
#pragma unroll
                for (int r = 0; r < 16; ++r) *(bf16_t*)(lds + G_ST + crow(r, hi) * 272 + (32 * d0 + r32) * 2) = f2bf(Sacc[r]);
            }
            __syncthreads();
        }
#undef GLOAD
#undef GWRITE
    }
}

__device__ void gdn_post_phase(const Params& p) {
    const int lane = threadIdx.x & 63, wid = threadIdx.x >> 6;
    const bf16_t* obuf = (const bf16_t*)(p.ws + WS_H);
    const bf16_t* proj = (const bf16_t*)(p.ws + WS_PROJ);
    bf16_t* mix = (bf16_t*)(p.ws + WS_MIX);
    const int d = (lane & 15) * 8;
    for (int row = blockIdx.x * 8 + wid; row < MTOT; row += gridDim.x * 8) {
        float a[8], bb[8], g[8], y[8];
        unpack8(*(const bf16x8*)(obuf + (size_t)row * 512 + lane * 8), a);
        unpack8(*(const bf16x8*)(obuf + ((size_t)MTOT + row) * 512 + lane * 8), bb);
        unpack8(*(const bf16x8*)(proj + (size_t)row * EV_NP + 3072 + lane * 8), g);
        float ss = 0.f;
#pragma unroll
        for (int i = 0; i < 8; ++i) { a[i] += bb[i]; ss += a[i] * a[i]; }
        ss += __shfl_xor(ss, 1); ss += __shfl_xor(ss, 2); ss += __shfl_xor(ss, 4); ss += __shfl_xor(ss, 8);
        const float rstd = rsqrtf(ss * (1.f / 128.f) + 1e-6f);
#pragma unroll
        for (int i = 0; i < 8; ++i) y[i] = a[i] * rstd * p.gdn_norm[d + i] * (g[i] / (1.f + expf(-g[i])));
        *(bf16x8*)(mix + (size_t)row * DM + 512 + lane * 8) = pack8(y);
    }
}

__device__ void diffattn_phase(const Params& p, unsigned char* lds) {
    const int tid = threadIdx.x, wid = tid >> 6, lane = tid & 63, r32 = lane & 31, hi = lane >> 5;
    const bf16_t* proj = (const bf16_t*)(p.ws + WS_PROJ);
    bf16_t* mix = (bf16_t*)(p.ws + WS_MIX);
    float gq = 0.f, gk = 0.f, s01 = 0.f, s23 = 0.f;
    for (int i = 0; i < 64; ++i) { gq = fmaxf(gq, fabsf(p.diff_qk_gain[i])); gk = fmaxf(gk, fabsf(p.diff_qk_gain[64 + i]));
        s01 += p.diff_lambda[i] * p.diff_lambda[64 + i]; s23 += p.diff_lambda[128 + i] * p.diff_lambda[192 + i]; }
    const float MC = 8.f * gq * gk * 1.4426950408889634f + 1.f;
    const float lam = expf(s01) - expf(s23) + 0.2f;
    unsigned char* Vl = lds; unsigned char* Kl = lds + 32768;
    float* X = (float*)(lds + 65536); float* li = (float*)(lds + 131072) + wid * 64;
    const int sr = tid >> 4, sc = (tid & 15) * 8, vst0 = v_st(sr, sc), vst1 = v_st(32 + sr, sc);
    const int vb0 = (int)(uintptr_t)Vl + v_rd_base(lane);
    const int map = wid >> 2, wq = wid & 3;
    for (int it = blockIdx.x; it < 2112; it += gridDim.x) {
        int b, h, NT, qrow0;
        if (it < 2048) { b = it >> 8; h = (it >> 6) & 3; const int qb = it & 63; NT = 132; qrow0 = b * SEQ + qb * 128; }
        else { const int j = it - 2048; b = j >> 3; h = (j >> 1) & 3; NT = 4; qrow0 = NLAT + b * CTXL + (j & 1) * 128; }
        bf16x8 qr[4];
        { const bf16_t* qp = proj + (size_t)(qrow0 + 32 * wq + r32) * EV_NP + h * 128 + map * 64 + hi * 8;
#pragma unroll
          for (int d0 = 0; d0 < 4; ++d0) qr[d0] = *(const bf16x8*)(qp + d0 * 16); }
        f32x16 o[4] = {}; float lsum = 0.f;
        bf16x8 vs0, vs1, ks0, ks1;
#define DLOAD(j) do { const size_t R0_ = (size_t)((j) < 4 ? NLAT + b * CTXL + 64 * (j) : b * SEQ + 64 * ((j) - 4)) + sr; \
        const bf16_t* pp_ = proj + R0_ * EV_NP + h * 128 + sc; \
        vs0 = *(const bf16x8*)(pp_ + 1024); vs1 = *(const bf16x8*)(pp_ + 1024 + (size_t)32 * EV_NP); \
        ks0 = *(const bf16x8*)(pp_ + 512); ks1 = *(const bf16x8*)(pp_ + 512 + (size_t)32 * EV_NP); } while (0)
#define DWRITE(bf) do { *(bf16x8*)(Vl + (bf) * 16384 + vst0) = vs0; *(bf16x8*)(Vl + (bf) * 16384 + vst1) = vs1; \
        *(bf16x8*)(Kl + (bf) * 16384 + KSWZ(sr, sc * 2)) = ks0; *(bf16x8*)(Kl + (bf) * 16384 + KSWZ(32 + sr, sc * 2)) = ks1; } while (0)
        DLOAD(0); DWRITE(0); __syncthreads();
        for (int j = 0; j < NT; ++j) {
            if (j + 1 < NT) DLOAD(j + 1);
            const int bf = j & 1;
            f32x16 p0 = {}, p1 = {};
            const unsigned char* Ks = Kl + bf * 16384;
#pragma unroll
            for (int d0 = 0; d0 < 4; ++d0) { const int cb = (map * 64 + d0 * 16 + hi * 8) * 2;
                const bf16x8 b0 = *(const bf16x8*)(Ks + KSWZ(r32, cb)), b1 = *(const bf16x8*)(Ks + KSWZ(32 + r32, cb));
                p0 = __builtin_amdgcn_mfma_f32_32x32x16_bf16(b0, qr[d0], p0, 0, 0, 0);
                p1 = __builtin_amdgcn_mfma_f32_32x32x16_bf16(b1, qr[d0], p1, 0, 0, 0); }
#pragma unroll
            for (int r = 0; r < 16; ++r) { p0[r] = __builtin_amdgcn_exp2f(p0[r] - MC); p1[r] = __builtin_amdgcn_exp2f(p1[r] - MC); lsum += p0[r] + p1[r]; }
            bf16x8 pa0, pa1, pa2, pa3;
            PK4(p0, 0, pa0); PK4(p0, 8, pa1); PK4(p1, 0, pa2); PK4(p1, 8, pa3);
            pv_d0(o, vb0 + bf * 16384, pa0, pa1, pa2, pa3);
            if (j + 1 < NT) DWRITE((j + 1) & 1);
            __syncthreads();
        }
#undef DLOAD
#undef DWRITE
        const float lt = halfswap_add(lsum);
        if (hi == 0) li[r32] = lt;
        asm volatile("s_waitcnt lgkmcnt(0)" ::: "memory");
        float rli[16];
#pragma unroll
        for (int r = 0; r < 16; ++r) rli[r] = 1.f / li[crow(r, hi)];
        if (map == 1) {
#pragma unroll
            for (int d0 = 0; d0 < 4; ++d0)
#pragma unroll
                for (int r = 0; r < 16; ++r) X[(wq * 64 + d0 * 16 + r) * 64 + lane] = o[d0][r] * rli[r] * lam;
        }
        __syncthreads();
        if (map == 0) {
#pragma unroll
            for (int d0 = 0; d0 < 4; ++d0)
#pragma unroll
                for (int r = 0; r < 16; ++r) o[d0][r] = o[d0][r] * rli[r] - X[(wq * 64 + d0 * 16 + r) * 64 + lane];
#pragma unroll
            for (int r = 0; r < 16; ++r) {
                float ss = o[0][r] * o[0][r] + o[1][r] * o[1][r] + o[2][r] * o[2][r] + o[3][r] * o[3][r];
                ss += __shfl_xor(ss, 1); ss += __shfl_xor(ss, 2); ss += __shfl_xor(ss, 4); ss += __shfl_xor(ss, 8); ss += __shfl_xor(ss, 16);
                const float rstd = rsqrtf(ss * (1.f / 128.f) + 1e-6f) * 0.8f;
                bf16_t* mp = mix + (size_t)(qrow0 + 32 * wq + crow(r, hi)) * DM + h * 128 + r32;
#pragma unroll
                for (int d0 = 0; d0 < 4; ++d0) mp[32 * d0] = f2bf(o[d0][r] * rstd * p.diff_subln[32 * d0 + r32]);
            }
        }
        __syncthreads();
    }
}

__device__ void natten_phase(const Params& p, unsigned char* lds) {
    const int tid = threadIdx.x, wid = tid >> 6, lane = tid & 63, r32 = lane & 31, hi = lane >> 5;
    const bf16_t* proj = (const bf16_t*)(p.ws + WS_PROJ);
    bf16_t* mix = (bf16_t*)(p.ws + WS_MIX);
    constexpr float L2E = 1.4426950408889634f;
    float gq = 0.f, gk = 0.f, rmax = 0.f;
    for (int i = 0; i < 128; ++i) { gq = fmaxf(gq, fabsf(p.na_qk_gain[i])); gk = fmaxf(gk, fabsf(p.na_qk_gain[128 + i])); }
    for (int i = 0; i < 8 * 15 * 31; ++i) rmax = fmaxf(rmax, fabsf(p.na_rpb[i]));
    const float MC = (11.313708499f * gq * gk + rmax) * L2E + 1.f;
    unsigned char* Vl = lds; unsigned char* Kl = lds + 32768;
    float* rpbs = (float*)(lds + 65536);
    float* li = (float*)(lds + 133120) + wid * 64;
    unsigned char* Qs = lds + 67584 + wid * 8192 + lane * 16;
    const int sr = tid >> 4, sc = (tid & 15) * 8, vst0 = v_st(sr, sc), vst1 = v_st(32 + sr, sc);
    const int vb0 = (int)(uintptr_t)Vl + v_rd_base(lane);
    const float* gkp = p.na_qk_gain + 128 + sc;
    for (int it = blockIdx.x; it < 2048; it += gridDim.x) {
        const int b = it >> 8, h = (it >> 5) & 7, rq = it & 31;
        const int grow = 4 * rq + (wid >> 1), qc = (wid & 1) * 32 + r32;
        const size_t qR = (size_t)b * SEQ + grow * 64 + qc;
        for (int i = tid; i < 465; i += NTHREADS) rpbs[i] = p.na_rpb[h * 465 + i] * L2E;
        { float ss = 0.f;
#pragma unroll
          for (int d0 = 0; d0 < 8; ++d0) { float qv[8]; unpack8(*(const bf16x8*)(proj + qR * OD_N + h * 128 + d0 * 16 + hi * 8), qv);
#pragma unroll
              for (int i = 0; i < 8; ++i) ss += qv[i] * qv[i]; }
          ss = halfswap_add(ss);
          const float rs = rsqrtf(ss * (1.f / 128.f) + 1e-6f) * 0.08838834764831845f * L2E;
#pragma unroll
          for (int d0 = 0; d0 < 8; ++d0) { float qv[8]; unpack8(*(const bf16x8*)(proj + qR * OD_N + h * 128 + d0 * 16 + hi * 8), qv);
#pragma unroll
              for (int i = 0; i < 8; ++i) qv[i] *= rs * p.na_qk_gain[d0 * 16 + hi * 8 + i];
              *(bf16x8*)(Qs + d0 * 1024) = pack8(qv); } }
        int lo = 4 * rq - 4; lo = lo < 0 ? 0 : (lo > 120 ? 120 : lo);
        int hi_r = 4 * rq + 3 - 4; hi_r = hi_r < 0 ? 0 : (hi_r > 120 ? 120 : hi_r); hi_r += 7;
        const int nlat = hi_r - lo + 1, NT = nlat + 4;
        int wsr = grow - 4; wsr = wsr < 0 ? 0 : (wsr > 120 ? 120 : wsr);
        int cst = qc - 8; cst = cst < 0 ? 0 : (cst > 48 ? 48 : cst);
        f32x16 o[4] = {}; float lsum = 0.f;
        bf16x8 vs0, vs1, ks0, ks1;
#define NLOAD(j) do { const size_t R0_ = (size_t)((j) < nlat ? b * SEQ + (lo + (j)) * 64 : NLAT + b * CTXL + 64 * ((j) - nlat)) + sr; \
        const bf16_t* pp_ = proj + R0_ * OD_N + h * 128 + sc; \
        vs0 = *(const bf16x8*)(pp_ + 2048); vs1 = *(const bf16x8*)(pp_ + 2048 + (size_t)32 * OD_N); \
        ks0 = *(const bf16x8*)(pp_ + 1024); ks1 = *(const bf16x8*)(pp_ + 1024 + (size_t)32 * OD_N); } while (0)
#define KNORM(kx) do { float f_[8]; unpack8(kx, f_); float ss_ = 0.f; _Pragma("unroll") for (int i_ = 0; i_ < 8; ++i_) ss_ += f_[i_] * f_[i_]; \
        ss_ += __shfl_xor(ss_, 1); ss_ += __shfl_xor(ss_, 2); ss_ += __shfl_xor(ss_, 4); ss_ += __shfl_xor(ss_, 8); \
        const float rs_ = rsqrtf(ss_ * (1.f / 128.f) + 1e-6f); _Pragma("unroll") for (int i_ = 0; i_ < 8; ++i_) f_[i_] *= rs_ * gkp[i_]; kx = pack8(f_); } while (0)
#define NWRITE(bf) do { KNORM(ks0); KNORM(ks1); *(bf16x8*)(Vl + (bf) * 16384 + vst0) = vs0; *(bf16x8*)(Vl + (bf) * 16384 + vst1) = vs1; \
        *(bf16x8*)(Kl + (bf) * 16384 + KSWZ(sr, sc * 2)) = ks0; *(bf16x8*)(Kl + (bf) * 16384 + KSWZ(32 + sr, sc * 2)) = ks1; } while (0)
        NLOAD(0); NWRITE(0); __syncthreads();
        for (int j = 0; j < NT; ++j) {
            if (j + 1 < NT) NLOAD(j + 1);
            const int bf = j & 1;
            const bool islat = j < nlat; const int kr = lo + j;
            const bool active = !islat || (kr >= wsr && kr <= wsr + 7);
            if (active) {
                f32x16 p0 = {}, p1 = {};
                const unsigned char* Ks = Kl + bf * 16384;
#pragma unroll
                for (int d0 = 0; d0 < 8; ++d0) { const int cb = (d0 * 16 + hi * 8) * 2;
                    const bf16x8 b0 = *(const bf16x8*)(Ks + KSWZ(r32, cb)), b1 = *(const bf16x8*)(Ks + KSWZ(32 + r32, cb));
                    const bf16x8 qd = *(const bf16x8*)(Qs + d0 * 1024);
                    p0 = __builtin_amdgcn_mfma_f32_32x32x16_bf16(b0, qd, p0, 0, 0, 0);
                    p1 = __builtin_amdgcn_mfma_f32_32x32x16_bf16(b1, qd, p1, 0, 0, 0); }
                if (islat) {
                    const float* rb = rpbs + (kr - grow + 7) * 31 + 15 - qc + 4 * hi;
                    const int mofs = 4 * hi - cst;
#pragma unroll
                    for (int r = 0; r < 16; ++r) {
                        const int kb = (r & 3) + 8 * (r >> 2);
                        const float e0 = __builtin_amdgcn_exp2f(p0[r] + rb[kb] - MC), e1 = __builtin_amdgcn_exp2f(p1[r] + rb[32 + kb] - MC);
                        p0[r] = ((unsigned)(kb + mofs) < 16u) ? e0 : 0.f; p1[r] = ((unsigned)(32 + kb + mofs) < 16u) ? e1 : 0.f;
                        lsum += p0[r] + p1[r]; }
                } else {
#pragma unroll
                    for (int r = 0; r < 16; ++r) { p0[r] = __builtin_amdgcn_exp2f(p0[r] - MC); p1[r] = __builtin_amdgcn_exp2f(p1[r] - MC); lsum += p0[r] + p1[r]; }
                }
                bf16x8 pa0, pa1, pa2, pa3;
                PK4(p0, 0, pa0); PK4(p0, 8, pa1); PK4(p1, 0, pa2); PK4(p1, 8, pa3);
                pv_d0(o, vb0 + bf * 16384, pa0, pa1, pa2, pa3);
            }
            if (j + 1 < NT) NWRITE((j + 1) & 1);
            __syncthreads();
        }
#undef NLOAD
#undef KNORM
#undef NWRITE
        const float lt = halfswap_add(lsum);
        if (hi == 0) li[r32] = lt;
        asm volatile("s_waitcnt lgkmcnt(0)" ::: "memory");
#pragma unroll
        for (int r = 0; r < 16; ++r) { const float rl = 1.f / li[crow(r, hi)];
            bf16_t* mp = mix + ((size_t)b * SEQ + grow * 64 + (wid & 1) * 32 + crow(r, hi)) * DM + h * 128 + r32;
#pragma unroll
            for (int d0 = 0; d0 < 4; ++d0) mp[32 * d0] = f2bf(o[d0][r] * rl); }
        __syncthreads();
    }
}

constexpr int NPH = 18;
__global__ void __launch_bounds__(NTHREADS, 2) fwd_megakernel(Params p) {
    extern __shared__ __attribute__((aligned(16))) unsigned char lds[];
    cg::grid_group grid = cg::this_grid();
    LAS unsigned char* ldsl = (LAS unsigned char*)lds;
    const int lo = p.ph_lo, hi = p.ph_hi;
#ifdef ONLY_PH
#define IN(k) (((ONLY_PH >> (k)) & 1) && lo <= (k) && (k) < hi)
#else
#define IN(k) (lo <= (k) && (k) < hi)
#endif
#define SEAM(k) do { if (IN(k) && IN((k) + 1)) grid.sync(); } while (0)
    unsigned char* ws = p.ws;
    const bf16_t* H = (const bf16_t*)(ws + WS_H);
    bf16_t* PROJ = (bf16_t*)(ws + WS_PROJ);
    const bf16_t* MIX = (const bf16_t*)(ws + WS_MIX);
    float* CTXRES = (float*)(ws + WS_CTXRES);
    const float* MOD = (const float*)(ws + WS_MOD);
    const int G = gridDim.x, c = blockIdx.x;

    if (IN(0)) { ada_phase(p, lds); wconv_phase(p, lds); }
    SEAM(0);
    if (IN(1)) norm_phase(p, p.x, p.ctx, 0, 0, MTOT);
    SEAM(1);
    if (IN(2)) { pg8::Gemm g{H, (const bf16_t*)(ws + WS_W_EVIN), MTOT, EV_NP, DM}; pg8::StaticOrder S; S.init(MTOT, EV_NP, G, c);
        pg8::EpiBf16 E{PROJ, EV_NP}; pg8::gemm_phase(ldsl, g, S, E); }
    SEAM(2);
    if (IN(3)) prep0_phase(p);
    SEAM(3);
    if (IN(4)) gdn_pre_phase(p, lds);
    SEAM(4);
    if (IN(5)) { gdn_scan_phase(p, lds); __syncthreads(); diffattn_phase(p, lds); }
    SEAM(5);
    if (IN(6)) gdn_post_phase(p);
    SEAM(6);
    if (IN(7)) { pg8::Gemm g{MIX, (const bf16_t*)(ws + WS_W_EVOUT), MTOT, DM, DM}; pg8::StaticOrder S; S.init(MTOT, DM, G, c);
        pg8::EpiResid E{p.x, p.ctx, p.out, CTXRES, MOD, 2048}; pg8::gemm_phase(ldsl, g, S, E); }
    SEAM(7);
    if (IN(8)) norm_phase(p, p.out, CTXRES, 0, 1, MTOT);
    SEAM(8);
    if (IN(9)) { pg8::Gemm g{H, (const bf16_t*)(ws + WS_W_FFIN), MTOT, 2 * FF, DM}; pg8::StaticOrder S; S.init(MTOT, 2 * FF, G, c);
        pg8::EpiSwiglu E{PROJ, FF}; pg8::gemm_phase(ldsl, g, S, E); }
    SEAM(9);
    if (IN(10)) { pg8::Gemm g{PROJ, (const bf16_t*)(ws + WS_W_FFOUT), MTOT, DM, FF}; pg8::StaticOrder S; S.init(MTOT, DM, G, c);
        pg8::EpiResid E{p.out, CTXRES, p.out, CTXRES, MOD, 5120}; pg8::gemm_phase(ldsl, g, S, E); }
    SEAM(10);
    if (IN(11)) norm_phase(p, p.out, CTXRES, 1, 0, MTOT);
    SEAM(11);
    if (IN(12)) { pg8::Gemm g{H, (const bf16_t*)(ws + WS_W_ODIN), MTOT, OD_N, DM}; pg8::StaticOrder S; S.init(MTOT, OD_N, G, c);
        pg8::EpiBf16 E{PROJ, OD_N}; pg8::gemm_phase(ldsl, g, S, E); }
    SEAM(12);
    if (IN(13)) natten_phase(p, lds);
    SEAM(13);
    if (IN(14)) { pg8::Gemm g{MIX, (const bf16_t*)(ws + WS_W_ODOUT), NLAT, DM, DM}; pg8::StaticOrder S; S.init(NLAT, DM, G, c);
        pg8::EpiResid E{p.out, CTXRES, p.out, CTXRES, MOD + 9 * 6144, 2048}; pg8::gemm_phase(ldsl, g, S, E); }
    SEAM(14);
    if (IN(15)) norm_phase(p, p.out, CTXRES, 1, 1, NLAT);
    SEAM(15);
    if (IN(16)) { pg8::Gemm g{H, (const bf16_t*)(ws + WS_W_FFIN) + (size_t)2 * FF * DM, NLAT, 2 * FF, DM}; pg8::StaticOrder S; S.init(NLAT, 2 * FF, G, c);
        pg8::EpiSwiglu E{PROJ, FF}; pg8::gemm_phase(ldsl, g, S, E); }
    SEAM(16);
    if (IN(17)) { pg8::Gemm g{PROJ, (const bf16_t*)(ws + WS_W_FFOUT) + (size_t)DM * FF, NLAT, DM, FF}; pg8::StaticOrder S; S.init(NLAT, DM, G, c);
        pg8::EpiResid E{p.out, CTXRES, p.out, CTXRES, MOD + 9 * 6144, 5120}; pg8::gemm_phase(ldsl, g, S, E); }
#undef IN
#undef SEAM
}

extern "C" void kernel_launch(void* const* d_in, const int* in_sizes, int n_in, void* d_out, int out_size, void* d_ws, size_t ws_size, hipStream_t stream) {
    static int grid = 0;
    if (grid == 0) {
        if (n_in != 23 || ws_size < WS_END) { fprintf(stderr, "kernel_launch: n_in %d ws %zu (need %zu)\n", n_in, ws_size, (size_t)WS_END); grid = -1; return; }
        int dev = 0, cus = 0, per_cu = 0;
        hipGetDevice(&dev); hipDeviceGetAttribute(&cus, hipDeviceAttributeMultiprocessorCount, dev);
        if (hipFuncSetAttribute((const void*)fwd_megakernel, hipFuncAttributeMaxDynamicSharedMemorySize, LDS_BYTES) != hipSuccess) { fprintf(stderr, "hipFuncSetAttribute failed\n"); grid = -1; return; }
        if (hipOccupancyMaxActiveBlocksPerMultiprocessor(&per_cu, (const void*)fwd_megakernel, NTHREADS, LDS_BYTES) != hipSuccess || per_cu < 1) per_cu = 1;
        (void)hipGetLastError();
        grid = cus * 1;
    }
    if (grid < 0) return;
    Params p{};
    const float** pp = (const float**)&p;
    for (int i = 0; i < 23; ++i) pp[i] = (const float*)d_in[i];
    p.out = (float*)d_out; p.ws = (unsigned char*)d_ws;
#if N_LAUNCH_MODE == 1
    p.ph_lo = 0; p.ph_hi = NPH;
    void* args[] = {&p};
    hipError_t e = hipLaunchCooperativeKernel((void*)fwd_megakernel, dim3(grid), dim3(NTHREADS), args, LDS_BYTES, stream);
    if (e != hipSuccess) fprintf(stderr, "cooperative launch failed: %s (grid %d)\n", hipGetErrorString(e), grid);
#else
    for (int k = 0; k < NPH; ++k) { p.ph_lo = k; p.ph_hi = k + 1;
        hipLaunchKernelGGL(fwd_megakernel, dim3(grid), dim3(NTHREADS), LDS_BYTES, stream, p); }
#endif
}
```

```cpp
#include <hip/hip_runtime.h>
#include <hip/hip_cooperative_groups.h>
#include <cstdio>
#include <cstdint>
namespace cg = cooperative_groups;

#define LAS __attribute__((address_space(3)))
typedef unsigned short bf16_t;
typedef short bf16x8 __attribute__((ext_vector_type(8)));
typedef short s16x4 __attribute__((ext_vector_type(4)));
typedef float f32x4 __attribute__((ext_vector_type(4)));
typedef float f32x16 __attribute__((ext_vector_type(16)));
typedef unsigned u32x4 __attribute__((ext_vector_type(4)));
typedef unsigned u32x2 __attribute__((ext_vector_type(2)));

#ifndef N_LAUNCH_MODE
#define N_LAUNCH_MODE 1
#endif

constexpr int DM = 1024, NLAT = 65536, NCTX = 2048, MTOT = NLAT + NCTX, SEQ = 8192, CTXL = 256, FF = 2816;
constexpr int EV_N = 3600, EV_NP = 3840, OD_N = 3072;
constexpr int NCHUNKP = 64 * 132;
constexpr int NTHREADS = 512;
constexpr int LDS_BYTES = 135168;

constexpr size_t al256(size_t x) { return (x + 255) / 256 * 256; }
constexpr size_t WS_W_EVIN = 0;
constexpr size_t WS_W_EVOUT = WS_W_EVIN + al256((size_t)EV_NP * DM * 2);
constexpr size_t WS_W_ODIN = WS_W_EVOUT + al256((size_t)DM * DM * 2);
constexpr size_t WS_W_ODOUT = WS_W_ODIN + al256((size_t)OD_N * DM * 2);
constexpr size_t WS_W_FFIN = WS_W_ODOUT + al256((size_t)DM * DM * 2);
constexpr size_t WS_W_FFOUT = WS_W_FFIN + al256((size_t)2 * 2 * FF * DM * 2);
constexpr size_t WS_MOD = WS_W_FFOUT + al256((size_t)2 * DM * FF * 2);
constexpr size_t WS_H = WS_MOD + al256((size_t)2 * 9 * 6144 * 4);
constexpr size_t WS_PROJ = WS_H + al256((size_t)MTOT * DM * 2);
constexpr size_t WS_MIX = WS_PROJ + al256((size_t)MTOT * EV_NP * 2);
constexpr size_t WS_T = WS_MIX + al256((size_t)MTOT * DM * 2);
constexpr size_t WS_AQK = WS_T + al256((size_t)NCHUNKP * 4096 * 2);
constexpr size_t WS_GV = WS_AQK + al256((size_t)NCHUNKP * 4096 * 2);
constexpr size_t WS_BV = WS_GV + al256((size_t)NCHUNKP * 64 * 4);
constexpr size_t WS_GATES = WS_BV + al256((size_t)NCHUNKP * 64 * 4);
constexpr size_t WS_CTXRES = WS_GATES + al256((size_t)MTOT * 16 * 4);
constexpr size_t WS_END = WS_CTXRES + al256((size_t)NCTX * DM * 4);

struct Params {
    const float *x, *c, *ctx, *c_ctx, *ada_w, *ada_b, *norm_mix, *norm_ffn, *ffn_w_in, *ffn_w_out, *even_w_in, *even_w_out,
        *diff_qk_gain, *diff_lambda, *diff_subln, *gdn_conv, *gdn_a_log, *gdn_dt_bias, *gdn_norm, *odd_w_in, *odd_w_out, *na_qk_gain, *na_rpb;
    float* out; unsigned char* ws; int ph_lo, ph_hi;
};

__device__ __forceinline__ float bf2f(bf16_t b) { return __uint_as_float(((unsigned)b) << 16); }
__device__ __forceinline__ bf16_t f2bf(float f) { unsigned u = __float_as_uint(f); u += 0x7FFFu + ((u >> 16) & 1u); return (bf16_t)(u >> 16); }
__device__ __forceinline__ unsigned cvtpk(float lo, float hi) { unsigned r; asm volatile("v_cvt_pk_bf16_f32 %0, %1, %2" : "=v"(r) : "v"(lo), "v"(hi)); return r; }
__device__ __forceinline__ float siluf(float v) { return v / (1.f + __expf(-v)); }
__device__ __forceinline__ void unpack8(bf16x8 v, float* f) {
#pragma unroll
    for (int i = 0; i < 8; ++i) f[i] = bf2f((bf16_t)v[i]);
}
__device__ __forceinline__ bf16x8 pack8(const float* f) {
    u32x4 w = {cvtpk(f[0], f[1]), cvtpk(f[2], f[3]), cvtpk(f[4], f[5]), cvtpk(f[6], f[7])};
    return *reinterpret_cast<bf16x8*>(&w);
}

namespace pg8 {
constexpr int BM = 256, BK = 64, HALF = 128, HTB = HALF * BK * 2, STAGE_BYTES = 8 * HTB, NXCD = 8, WGM = 8;
__host__ __device__ __forceinline__ int lds_byte(int r, int c) { const int st = (r >> 4) * 2 + (c >> 5), rr = r & 15, cc = c & 31, ob = rr * 64 + cc * 2; return st * 1024 + (ob ^ (((ob >> 9) & 1) << 5)); }
__host__ __device__ __forceinline__ void stage_rc(int b, int& R, int& C) { const int st = b / 1024, sb = b % 1024, swz = sb ^ (((sb >> 9) & 1) << 5); R = (st >> 1) * 16 + swz / 64; C = (st & 1) * 32 + (swz % 64) / 2; }
__host__ __device__ __forceinline__ int perm32(int rho) { const int n = rho >> 4, i = rho & 15; return 8 * (i >> 2) + 4 * n + (i & 3); }
struct Unit { int pm, pn; };
struct Gemm { const bf16_t* A; const bf16_t* Bt; int M, N, K; };
struct StaticOrder {
    int nM, nN, nwg, G, c;
    __device__ void init(int M, int N, int G_, int c_) { nM = M / BM; nN = N / BM; nwg = nM * nN; G = G_; c = c_; }
    __device__ bool next(int i, Unit& u) const {
        const long L = (long)i * G + c; if (L >= nwg) return false;
        int wgid = (int)L; { const int q = nwg / NXCD, r = nwg % NXCD, xcd = wgid % NXCD, off = wgid / NXCD; wgid = (xcd < r ? xcd * (q + 1) : r * (q + 1) + (xcd - r) * q) + off; }
        const int nig = WGM * nN, gid = wgid / nig, fm = gid * WGM, gsz = (nM - fm) < WGM ? (nM - fm) : WGM;
        u.pm = fm + ((wgid % nig) % gsz); u.pn = (wgid % nig) / gsz; return true;
    }
};
struct EpiBf16 {
    static constexpr bool PERM = true;
    bf16_t* O; int ldc;
    __device__ __forceinline__ void operator()(const f32x4 (&acc)[2][2][4][2], const Unit& u, int wr, int wc, int fr, int fq) const {
        const int row0 = u.pm * BM + wr * 64 + fr; const int col0 = u.pn * BM + wc * 32 + 8 * fq;
#pragma unroll
        for (int ai = 0; ai < 2; ++ai)
#pragma unroll
            for (int m = 0; m < 4; ++m) { bf16_t* rowp = O + (size_t)(row0 + ai * HALF + m * 16) * ldc + col0;
#pragma unroll
                for (int bj = 0; bj < 2; ++bj) { const f32x4 v0 = acc[ai][bj][m][0], v1 = acc[ai][bj][m][1];
                    u32x4 w; w.x = cvtpk(v0[0], v0[1]); w.y = cvtpk(v0[2], v0[3]); w.z = cvtpk(v1[0], v1[1]); w.w = cvtpk(v1[2], v1[3]);
                    *(u32x4*)(rowp + bj * HALF) = w; } }
    }
};
struct EpiSwiglu {
    static constexpr bool PERM = true;
    bf16_t* O; int ldc;
    __device__ __forceinline__ void operator()(const f32x4 (&acc)[2][2][4][2], const Unit& u, int wr, int wc, int fr, int fq) const {
        const int row0 = u.pm * BM + wr * 64 + fr; const int col0 = u.pn * HALF + wc * 32 + 8 * fq;
#pragma unroll
        for (int ai = 0; ai < 2; ++ai)
#pragma unroll
            for (int m = 0; m < 4; ++m) { bf16_t* rowp = O + (size_t)(row0 + ai * HALF + m * 16) * ldc + col0;
                float o[8];
#pragma unroll
                for (int n = 0; n < 2; ++n)
#pragma unroll
                    for (int j = 0; j < 4; ++j) { const float g = acc[ai][0][m][n][j], up = acc[ai][1][m][n][j]; o[n * 4 + j] = g / (1.f + __expf(-g)) * up; }
                u32x4 w; w.x = cvtpk(o[0], o[1]); w.y = cvtpk(o[2], o[3]); w.z = cvtpk(o[4], o[5]); w.w = cvtpk(o[6], o[7]);
                *(u32x4*)rowp = w; }
    }
};
struct EpiResid {
    static constexpr bool PERM = false;
    const float* resLat; const float* resCtx; float* outLat; float* outCtx; const float* modl; int goff;
    __device__ __forceinline__ void operator()(const f32x4 (&acc)[2][2][4][2], const Unit& u, int wr, int wc, int fr, int fq) const {
        const int rowt = u.pm * BM; const bool lat = rowt < NLAT;
        const float* res = lat ? resLat + (size_t)rowt * DM : resCtx + (size_t)(rowt - NLAT) * DM;
        float* out = lat ? outLat + (size_t)rowt * DM : outCtx + (size_t)(rowt - NLAT) * DM;
        const float* gate = modl + (size_t)(lat ? (rowt >> 13) : 8) * 6144 + goff;
        const int row0 = wr * 64 + fr, col0 = u.pn * BM + wc * 32 + 4 * fq;
        f32x4 gv[2][2];
#pragma unroll
        for (int bj = 0; bj < 2; ++bj)
#pragma unroll
            for (int n = 0; n < 2; ++n) gv[bj][n] = *(const f32x4*)(gate + col0 + bj * HALF + n * 16);
#pragma unroll
        for (int ai = 0; ai < 2; ++ai)
#pragma unroll
            for (int m = 0; m < 4; ++m) { const size_t off = (size_t)(row0 + ai * HALF + m * 16) * DM + col0;
#pragma unroll
                for (int bj = 0; bj < 2; ++bj)
#pragma unroll
                    for (int n = 0; n < 2; ++n) { const f32x4 r = *(const f32x4*)(res + off + bj * HALF + n * 16);
                        *(f32x4*)(out + off + bj * HALF + n * 16) = r + gv[bj][n] * acc[ai][bj][m][n]; } }
    }
};

template <class Epi, class Sched>
__device__ __forceinline__ void gemm_phase(LAS unsigned char* lds, const Gemm g, const Sched& S, const Epi& E) {
    const int tid = threadIdx.x, wid = __builtin_amdgcn_readfirstlane(tid >> 6), lane = tid & 63, wr = wid >> 2, wc = wid & 3, fr = lane & 15, fq = lane >> 4;
    const int K = g.K, nt = K / BK;
    unsigned voffA[2], voffB[2];
#pragma unroll
    for (int i = 0; i < 2; ++i) { int R, C; stage_rc(tid * 16 + i * 8192, R, C); const int Rb = Epi::PERM ? ((R & ~31) + perm32(R & 31)) : R;
        voffA[i] = (unsigned)(R * K + C) * 2u; voffB[i] = (unsigned)(Rb * K + C) * 2u; }
    const size_t kstep = (size_t)(BK * 2);
    const size_t hstep = (size_t)HALF * K * 2;
    const size_t tstep = 2 * hstep;
    const unsigned ldsw = (unsigned)wid * 1024u;
    const int aoff = lds_byte(wr * 64 + fr, fq * 8), boff = lds_byte(wc * 32 + fr, fq * 8);
#define PG8_SA(b, h) (((b) * 2 + (h)) * HTB)
#define PG8_SB(b, h) ((4 + (b) * 2 + (h)) * HTB)
#define PG8_STAGE(bufoff, gbase, voff) do { _Pragma("unroll") for (int _i = 0; _i < 2; ++_i) \
        __builtin_amdgcn_global_load_lds((const unsigned*)((const char*)(gbase) + (voff)[_i]), (LAS unsigned*)(lds + (bufoff) + ldsw + _i * 8192), 16, 0, 0); } while (0)
#define PG8_LDA(dst, b, h) do { _Pragma("unroll") for (int m = 0; m < 4; ++m) _Pragma("unroll") for (int k = 0; k < 2; ++k) dst[m][k] = *(const LAS bf16x8*)(lds + PG8_SA(b, h) + aoff + m * 2048 + k * 1024); } while (0)
#define PG8_LDB(dst, b, h) do { _Pragma("unroll") for (int n = 0; n < 2; ++n) _Pragma("unroll") for (int k = 0; k < 2; ++k) dst[n][k] = *(const LAS bf16x8*)(lds + PG8_SB(b, h) + boff + n * 2048 + k * 1024); } while (0)
#define PG8_MMA(ai, bj, At, Bt) do { __builtin_amdgcn_s_setprio(1); _Pragma("unroll") for (int m = 0; m < 4; ++m) _Pragma("unroll") for (int n = 0; n < 2; ++n) _Pragma("unroll") for (int k = 0; k < 2; ++k) \
        acc[ai][bj][m][n] = __builtin_amdgcn_mfma_f32_16x16x32_bf16(Bt[n][k], At[m][k], acc[ai][bj][m][n], 0, 0, 0); __builtin_amdgcn_s_setprio(0); } while (0)
#define PG8_WAIT_V(n) asm volatile("s_waitcnt vmcnt(" #n ")" ::: "memory")
#define PG8_WAIT_L(n) asm volatile("s_waitcnt lgkmcnt(" #n ")" ::: "memory")
#define PG8_BAR __builtin_amdgcn_s_barrier()
#define PG8_SCHED __builtin_amdgcn_sched_barrier(0)
    Unit cur, nxt; int ui = 0;
    if (!S.next(0, cur)) return;
    f32x4 acc[2][2][4][2];
#pragma unroll
    for (int a = 0; a < 2; ++a)
#pragma unroll
        for (int b = 0; b < 2; ++b)
#pragma unroll
            for (int m = 0; m < 4; ++m)
#pragma unroll
                for (int n = 0; n < 2; ++n) acc[a][b][m][n] = (f32x4){0.f, 0.f, 0.f, 0.f};
    bf16x8 At[4][2], B0[2][2], B1[2][2];
    const char* cA = (const char*)g.A + (size_t)cur.pm * tstep; const char* cB = (const char*)g.Bt + (size_t)cur.pn * tstep;
    PG8_STAGE(PG8_SB(0, 0), cB, voffB); PG8_STAGE(PG8_SA(0, 0), cA, voffA); PG8_STAGE(PG8_SB(0, 1), cB + hstep, voffB); PG8_STAGE(PG8_SA(0, 1), cA + hstep, voffA);
    if (wr == 1) PG8_BAR;
    PG8_WAIT_V(4); PG8_BAR;
    PG8_STAGE(PG8_SB(1, 0), cB + kstep, voffB); PG8_STAGE(PG8_SA(1, 0), cA + kstep, voffA); PG8_STAGE(PG8_SB(1, 1), cB + hstep + kstep, voffB);
    PG8_WAIT_V(6); PG8_BAR;
    for (;;) {
        const bool has_next = S.next(ui + 1, nxt);
        const char* nA = has_next ? (const char*)g.A + (size_t)nxt.pm * tstep : cA; const char* nB = has_next ? (const char*)g.Bt + (size_t)nxt.pn * tstep : cB;
        for (int t = 0; t < nt; t += 2) {
            const bool last = (t == nt - 2);
            const char* a1 = cA + (size_t)(t + 1) * kstep;
            const char* a2 = last ? nA : cA + (size_t)(t + 2) * kstep; const char* b2 = last ? nB : cB + (size_t)(t + 2) * kstep;
            const char* a3 = a2 + kstep; const char* b3 = b2 + kstep;
            PG8_LDB(B0, 0, 0); PG8_SCHED; PG8_LDA(At, 0, 0); PG8_STAGE(PG8_SA(1, 1), a1 + hstep, voffA);
            PG8_WAIT_L(8); PG8_BAR; PG8_WAIT_L(0); PG8_MMA(0, 0, At, B0); PG8_BAR; PG8_SCHED;
            PG8_LDB(B1, 0, 1); PG8_STAGE(PG8_SB(0, 0), b2, voffB);
            PG8_BAR; PG8_WAIT_L(0); PG8_MMA(0, 1, At, B1); PG8_BAR;
            PG8_LDA(At, 0, 1); PG8_STAGE(PG8_SA(0, 0), a2, voffA);
            PG8_BAR; PG8_WAIT_L(0); PG8_MMA(1, 0, At, B0); PG8_BAR; PG8_SCHED;
            PG8_STAGE(PG8_SB(0, 1), b2 + hstep, voffB);
            PG8_WAIT_V(6); PG8_BAR; PG8_MMA(1, 1, At, B1); PG8_BAR;
            PG8_LDB(B0, 1, 0); PG8_SCHED; PG8_LDA(At, 1, 0); PG8_STAGE(PG8_SA(0, 1), a2 + hstep, voffA);
            PG8_WAIT_L(8); PG8_BAR; PG8_WAIT_L(0); PG8_MMA(0, 0, At, B0); PG8_BAR; PG8_SCHED;
            PG8_LDB(B1, 1, 1); PG8_STAGE(PG8_SB(1, 0), b3, voffB);
            PG8_BAR; PG8_WAIT_L(0); PG8_MMA(0, 1, At, B1); PG8_BAR;
            PG8_LDA(At, 1, 1); PG8_STAGE(PG8_SA(1, 0), a3, voffA);
            PG8_BAR; PG8_WAIT_L(0); PG8_MMA(1, 0, At, B0); PG8_BAR; PG8_SCHED;
            PG8_STAGE(PG8_SB(1, 1), b3 + hstep, voffB);
            PG8_WAIT_V(6); PG8_BAR; PG8_MMA(1, 1, At, B1); PG8_BAR;
        }
        E(acc, cur, wr, wc, fr, fq);
        if (!has_next) break;
#pragma unroll
        for (int a = 0; a < 2; ++a)
#pragma unroll
            for (int b = 0; b < 2; ++b)
#pragma unroll
                for (int m = 0; m < 4; ++m)
#pragma unroll
                    for (int n = 0; n < 2; ++n) acc[a][b][m][n] = (f32x4){0.f, 0.f, 0.f, 0.f};
        cur = nxt; cA = nA; cB = nB; ++ui;
    }
    PG8_WAIT_V(0);
    if (wr == 0) PG8_BAR;
    PG8_BAR;
#undef PG8_SA
#undef PG8_SB
#undef PG8_STAGE
#undef PG8_LDA
#undef PG8_LDB
#undef PG8_MMA
#undef PG8_WAIT_V
#undef PG8_WAIT_L
#undef PG8_BAR
#undef PG8_SCHED
}
}

#define KSWZ(row, colB) ((row) * 256 + ((colB) ^ (((row) & 7) << 4)))
#define SBAR() __builtin_amdgcn_sched_barrier(0)
__device__ __forceinline__ int crow(int r, int hi) { return (r & 3) + 8 * (r >> 2) + 4 * hi; }
__device__ __forceinline__ int v_st(int k, int c) { const int kk = (k & ~0xC) | ((k & 4) << 1) | ((k & 8) >> 1); return ((kk >> 3) * 4 + (c >> 5)) * 512 + ((kk & 7) * 32 + (c & 31)) * 2; }
__device__ __forceinline__ int v_rd_base(int lane) { return ((lane & 3) << 3) | (((lane >> 2) & 3) << 6) | (((lane >> 4) & 1) << 5) | (((lane >> 5) & 1) << 8); }
constexpr int v_rd_off(int d0, int ks, int half) { return d0 * 512 + ks * 4096 + half * 2048; }
template <int OFF> __device__ __forceinline__ s16x4 tr_read(int vb) {
    s16x4 r; asm volatile("ds_read_b64_tr_b16 %0, %1 offset:%2" : "=&v"(r) : "v"(vb), "i"(OFF) : "memory"); return r;
}
template <int D0> __device__ __forceinline__ void pv_one(f32x16& od, int vb, bf16x8 pa0, bf16x8 pa1, bf16x8 pa2, bf16x8 pa3) {
    const s16x4 l0 = tr_read<v_rd_off(D0, 0, 0)>(vb), h0 = tr_read<v_rd_off(D0, 0, 1)>(vb), l1 = tr_read<v_rd_off(D0, 1, 0)>(vb), h1 = tr_read<v_rd_off(D0, 1, 1)>(vb);
    const s16x4 l2 = tr_read<v_rd_off(D0, 2, 0)>(vb), h2 = tr_read<v_rd_off(D0, 2, 1)>(vb), l3 = tr_read<v_rd_off(D0, 3, 0)>(vb), h3 = tr_read<v_rd_off(D0, 3, 1)>(vb);
    asm volatile("s_waitcnt lgkmcnt(0)" ::: "memory"); SBAR();
#define PK(L, H) (bf16x8){L[0], L[1], L[2], L[3], H[0], H[1], H[2], H[3]}
    od = __builtin_amdgcn_mfma_f32_32x32x16_bf16(pa0, PK(l0, h0), od, 0, 0, 0);
    od = __builtin_amdgcn_mfma_f32_32x32x16_bf16(pa1, PK(l1, h1), od, 0, 0, 0);
    od = __builtin_amdgcn_mfma_f32_32x32x16_bf16(pa2, PK(l2, h2), od, 0, 0, 0);
    od = __builtin_amdgcn_mfma_f32_32x32x16_bf16(pa3, PK(l3, h3), od, 0, 0, 0);
#undef PK
}
__device__ __forceinline__ void pv_d0(f32x16* o, int vb, bf16x8 pa0, bf16x8 pa1, bf16x8 pa2, bf16x8 pa3) {
    pv_one<0>(o[0], vb, pa0, pa1, pa2, pa3); pv_one<1>(o[1], vb, pa0, pa1, pa2, pa3); pv_one<2>(o[2], vb, pa0, pa1, pa2, pa3); pv_one<3>(o[3], vb, pa0, pa1, pa2, pa3);
}
#define PK4(P, BASE, OUT) do { unsigned a0 = cvtpk(P[BASE + 0], P[BASE + 1]), a1 = cvtpk(P[BASE + 2], P[BASE + 3]);   \
    unsigned b0 = cvtpk(P[BASE + 4], P[BASE + 5]), b1 = cvtpk(P[BASE + 6], P[BASE + 7]);                              \
    auto r0 = __builtin_amdgcn_permlane32_swap(a0, b0, false, false); auto r1 = __builtin_amdgcn_permlane32_swap(a1, b1, false, false); \
    u32x4 w = {r0[0], r1[0], r0[1], r1[1]}; OUT = *reinterpret_cast<bf16x8*>(&w); } while (0)
__device__ __forceinline__ float halfswap_add(float v) {
    auto rr = __builtin_amdgcn_permlane32_swap(__float_as_uint(v), __float_as_uint(v), false, false);
    return __uint_as_float(rr[0]) + __uint_as_float(rr[1]);
}

__device__ void ada_phase(const Params& p, unsigned char* lds) {
    float* sc = (float*)lds;
    float* red = (float*)(lds + 40960);
    float* mod = (float*)(p.ws + WS_MOD);
    const int tid = threadIdx.x;
    for (int j = blockIdx.x; j < 192; j += gridDim.x) {
        const int l = j / 96, n0 = (j % 96) * 64;
        for (int i = tid; i < 9 * 1024; i += NTHREADS) { const int r = i >> 10, k = i & 1023; const float v = r < 8 ? p.c[r * 1024 + k] : p.c_ctx[k]; sc[i] = v / (1.f + expf(-v)); }
        __syncthreads();
        const int col = tid & 63, ks = tid >> 6;
        float acc[9];
#pragma unroll
        for (int r = 0; r < 9; ++r) acc[r] = 0.f;
        const float* wp = p.ada_w + ((size_t)l * 1024 + ks * 128) * 6144 + n0 + col;
#pragma unroll 8
        for (int kk = 0; kk < 128; ++kk) { const float w = wp[(size_t)kk * 6144];
#pragma unroll
            for (int r = 0; r < 9; ++r) acc[r] += sc[r * 1024 + ks * 128 + kk] * w; }
#pragma unroll
        for (int r = 0; r < 9; ++r) red[(ks * 9 + r) * 64 + col] = acc[r];
        __syncthreads();
        for (int i = tid; i < 576; i += NTHREADS) { const int r = i >> 6, cc = i & 63; float s = p.ada_b[l * 6144 + n0 + cc];
            for (int k2 = 0; k2 < 8; ++k2) s += red[(k2 * 9 + r) * 64 + cc];
            mod[(size_t)(l * 9 + r) * 6144 + n0 + cc] = s; }
        __syncthreads();
    }
}
__device__ void wconv_phase(const Params& p, unsigned char* lds) {
    float* tl = (float*)lds;
    const int tid = threadIdx.x;
    const int T0 = 16 * 60, T1 = T0 + 16 * 16, T2 = T1 + 16 * 48, T3 = T2 + 16 * 16, T4 = T3 + 16 * 88, T5 = T4 + 16 * 88, T6 = T5 + 44 * 16, T7 = T6 + 44 * 16;
    for (int t = blockIdx.x; t < T7; t += gridDim.x) {
        const float* src; bf16_t* dst; int K, N, NP, mode = 0, tt;
        if (t < T0) { src = p.even_w_in; dst = (bf16_t*)(p.ws + WS_W_EVIN); K = 1024; N = EV_N; NP = EV_NP; tt = t; }
        else if (t < T1) { src = p.even_w_out; dst = (bf16_t*)(p.ws + WS_W_EVOUT); K = 1024; N = 1024; NP = 1024; tt = t - T0; }
        else if (t < T2) { src = p.odd_w_in; dst = (bf16_t*)(p.ws + WS_W_ODIN); K = 1024; N = OD_N; NP = OD_N; tt = t - T1; }
        else if (t < T3) { src = p.odd_w_out; dst = (bf16_t*)(p.ws + WS_W_ODOUT); K = 1024; N = 1024; NP = 1024; tt = t - T2; }
        else if (t < T4) { src = p.ffn_w_in; dst = (bf16_t*)(p.ws + WS_W_FFIN); K = 1024; N = 2 * FF; NP = 2 * FF; mode = 1; tt = t - T3; }
        else if (t < T5) { src = p.ffn_w_in + (size_t)1024 * 2 * FF; dst = (bf16_t*)(p.ws + WS_W_FFIN) + (size_t)2 * FF * 1024; K = 1024; N = 2 * FF; NP = 2 * FF; mode = 1; tt = t - T4; }
        else if (t < T6) { src = p.ffn_w_out; dst = (bf16_t*)(p.ws + WS_W_FFOUT); K = FF; N = 1024; NP = 1024; tt = t - T5; }
        else { src = p.ffn_w_out + (size_t)FF * 1024; dst = (bf16_t*)(p.ws + WS_W_FFOUT) + (size_t)1024 * FF; K = FF; N = 1024; NP = 1024; tt = t - T6; }
        const int nnt = NP / 64; const int k0 = (tt / nnt) * 64, n0 = (tt % nnt) * 64;
        int sn0;
        if (mode == 1) { const int tb = n0 >> 8, bj = (n0 >> 7) & 1, i0 = n0 & 127; sn0 = bj * FF + tb * 128 + i0; } else sn0 = n0;
        for (int e = tid; e < 4096; e += NTHREADS) { const int kk = e >> 6, nn = e & 63; const int sn = sn0 + nn;
            tl[kk * 65 + nn] = (sn < N) ? src[(size_t)(k0 + kk) * N + sn] : 0.f; }
        __syncthreads();
        for (int e = tid; e < 2048; e += NTHREADS) { const int nn = e >> 5, k2 = (e & 31) * 2;
            *(unsigned*)(dst + (size_t)(n0 + nn) * K + k0 + k2) = cvtpk(tl[k2 * 65 + nn], tl[(k2 + 1) * 65 + nn]); }
        __syncthreads();
    }
}

__device__ void norm_phase(const Params& p, const float* xlat, const float* xctx, int l, int which, int nrows) {
    const int lane = threadIdx.x & 63, wid = threadIdx.x >> 6;
    bf16_t* h = (bf16_t*)(p.ws + WS_H);
    const float* mod = (const float*)(p.ws + WS_MOD) + (size_t)l * 9 * 6144;
    const float* gain = (which ? p.norm_ffn : p.norm_mix) + l * 1024;
    const int shoff = which ? 3072 : 0, scoff = which ? 4096 : 1024;
    for (int row = blockIdx.x * 8 + wid; row < nrows; row += gridDim.x * 8) {
        const bool lat = row < NLAT;
        const float* src = lat ? xlat + (size_t)row * DM : xctx + (size_t)(row - NLAT) * DM;
        const float* mr = mod + (size_t)(lat ? (row >> 13) : 8) * 6144;
        f32x4 v[4]; float ss = 0.f;
#pragma unroll
        for (int i = 0; i < 4; ++i) { v[i] = *(const f32x4*)(src + lane * 4 + 256 * i); ss += v[i][0] * v[i][0] + v[i][1] * v[i][1] + v[i][2] * v[i][2] + v[i][3] * v[i][3]; }
#pragma unroll
        for (int o = 1; o < 64; o <<= 1) ss += __shfl_xor(ss, o);
        const float rstd = rsqrtf(ss * (1.f / 1024.f) + 1e-6f);
#pragma unroll
        for (int i = 0; i < 4; ++i) { const int c0 = lane * 4 + 256 * i;
            const f32x4 g = *(const f32x4*)(gain + c0), s1 = *(const f32x4*)(mr + scoff + c0), sh = *(const f32x4*)(mr + shoff + c0);
            float y[4];
#pragma unroll
            for (int j = 0; j < 4; ++j) y[j] = v[i][j] * rstd * g[j] * (1.f + s1[j]) + sh[j];
            u32x2 w; w.x = cvtpk(y[0], y[1]); w.y = cvtpk(y[2], y[3]);
            *(u32x2*)(h + (size_t)row * DM + c0) = w; }
    }
}

__device__ void prep0_phase(const Params& p) {
    const int lane = threadIdx.x & 63, wid = threadIdx.x >> 6;
    bf16_t* proj = (bf16_t*)(p.ws + WS_PROJ);
    bf16_t* qkvp = (bf16_t*)p.out;
    float* gbuf = (float*)(p.ws + WS_GATES);
    const int dsub = (lane & 7) * 8;
    const bool isrow = (lane & 7) < 4;
    float inv[4];
#pragma unroll
    for (int i = 0; i < 4; ++i) { const int pp = (lane & 7) * 4 + i; inv[i] = powf(10000.f, -(float)(pp & 15) / 16.f); }
    for (int row = blockIdx.x * 8 + wid; row < MTOT; row += gridDim.x * 8) {
        const bool lat = row < NLAT; const int t = lat ? (row & 8191) : ((row - NLAT) & 255); const int len = lat ? SEQ : CTXL;
        bf16_t* P = proj + (size_t)row * EV_NP;
        float cs[4], sn[4];
        if (lat) {
#pragma unroll
            for (int i = 0; i < 4; ++i) { const float ang = (isrow ? (float)(t >> 6) : (float)(t & 63)) * inv[i]; cs[i] = cosf(ang); sn[i] = sinf(ang); }
        } else {
#pragma unroll
            for (int i = 0; i < 4; ++i) { cs[i] = 1.f; sn[i] = 0.f; }
        }
#pragma unroll
        for (int which = 0; which < 2; ++which) {
            float v[8]; unpack8(*(const bf16x8*)(P + which * 512 + lane * 8), v);
            float ss = 0.f;
#pragma unroll
            for (int i = 0; i < 8; ++i) ss += v[i] * v[i];
            ss += __shfl_xor(ss, 1); ss += __shfl_xor(ss, 2); ss += __shfl_xor(ss, 4);
            const float rstd = rsqrtf(ss * (1.f / 64.f) + 1e-6f);
#pragma unroll
            for (int i = 0; i < 8; ++i) v[i] = v[i] * rstd * p.diff_qk_gain[which * 64 + dsub + i];
#pragma unroll
            for (int i = 0; i < 4; ++i) { const float x0 = v[2 * i], x1 = v[2 * i + 1]; v[2 * i] = x0 * cs[i] - x1 * sn[i]; v[2 * i + 1] = x0 * sn[i] + x1 * cs[i]; }
            if (which == 0) {
#pragma unroll
                for (int i = 0; i < 8; ++i) v[i] *= 0.125f * 1.4426950408889634f;
            }
            *(bf16x8*)(P + which * 512 + lane * 8) = pack8(v);
        }
#pragma unroll
        for (int i = 0; i < 3; ++i) {
            const int c0 = i * 512 + lane * 8;
            float y[8];
#pragma unroll
            for (int e = 0; e < 8; ++e) y[e] = 0.f;
#pragma unroll
            for (int j = 0; j < 5; ++j) { const int tt = t + j - 2;
                if (tt >= 0 && tt < len) { float xv[8]; unpack8(*(const bf16x8*)(proj + (size_t)(row + j - 2) * EV_NP + 1536 + c0), xv);
                    const f32x4 w0 = *(const f32x4*)(p.gdn_conv + j * 1536 + c0), w1 = *(const f32x4*)(p.gdn_conv + j * 1536 + c0 + 4);
#pragma unroll
                    for (int e = 0; e < 4; ++e) { y[e] += w0[e] * xv[e]; y[4 + e] += w1[e] * xv[4 + e]; } } }
#pragma unroll
            for (int e = 0; e < 8; ++e) y[e] = y[e] / (1.f + expf(-y[e]));
            if (i < 2) { float ss = 0.f;
#pragma unroll
                for (int e = 0; e < 8; ++e) ss += y[e] * y[e];
                ss += __shfl_xor(ss, 1); ss += __shfl_xor(ss, 2); ss += __shfl_xor(ss, 4); ss += __shfl_xor(ss, 8);
                const float s = rsqrtf(ss + 1e-6f) * (i == 0 ? 0.08838834764831845f : 1.f);
#pragma unroll
                for (int e = 0; e < 8; ++e) y[e] *= s; }
            *(bf16x8*)(qkvp + (size_t)row * 1536 + c0) = pack8(y);
        }
        if (lane < 16) { const float gv = bf2f(P[3584 + lane]); float o;
            if (lane < 8) o = 1.f / (1.f + expf(-gv));
            else { const float z = gv + p.gdn_dt_bias[lane - 8]; const float sp = z > 20.f ? z : log1pf(expf(z)); o = -expf(p.gdn_a_log[lane - 8]) * sp; }
            gbuf[(size_t)row * 16 + lane] = o; }
    }
}

__device__ __forceinline__ int gdn_row(int b, int pc, int tau, int dir) {
    const int tt = dir ? 63 - tau : tau;
    return pc < 4 ? NLAT + b * CTXL + pc * 64 + tt : b * SEQ + (pc - 4) * 64 + tt;
}
__device__ void gdn_pre_phase(const Params& p, unsigned char* lds) {
    const int lane = threadIdx.x & 63, wid = threadIdx.x >> 6;
    float* Lw = (float*)(lds + wid * 16896);
    float* gs = Lw + 4096; float* bs = gs + 64;
    const bf16_t* qkvp = (const bf16_t*)p.out;
    const float* gbuf = (const float*)(p.ws + WS_GATES);
    bf16_t* Tb = (bf16_t*)(p.ws + WS_T); bf16_t* Ab = (bf16_t*)(p.ws + WS_AQK);
    float* gv = (float*)(p.ws + WS_GV); float* bv = (float*)(p.ws + WS_BV);
    const int lane0 = lane;
    for (int cp = blockIdx.x * 8 + wid; cp < NCHUNKP; cp += gridDim.x * 8) {
        int lane = lane0; asm volatile("" : "+v"(lane));
        const int r32 = lane & 31, hi = lane >> 5;
        const int pc = cp % 132, ch = cp / 132, dir = ch & 1, h = (ch >> 1) & 3, b = ch >> 3;
        { const int R = gdn_row(b, pc, lane, dir);
          float g = gbuf[(size_t)R * 16 + 8 + dir * 4 + h]; const float be = gbuf[(size_t)R * 16 + dir * 4 + h];
#pragma unroll
          for (int o = 1; o < 64; o <<= 1) { const float t = __shfl_up(g, o); if (lane >= o) g += t; }
          gs[lane] = g; bs[lane] = be; gv[(size_t)cp * 64 + lane] = g; bv[(size_t)cp * 64 + lane] = be; }
        bf16x8 kf[2][8];
#pragma unroll
        for (int mi = 0; mi < 2; ++mi) { const size_t R = (size_t)gdn_row(b, pc, 32 * mi + r32, dir);
#pragma unroll
            for (int d0 = 0; d0 < 8; ++d0) kf[mi][d0] = *(const bf16x8*)(qkvp + R * 1536 + 512 + h * 128 + d0 * 16 + hi * 8); }
        bf16_t* Ao = Ab + (size_t)cp * 4096;
#pragma unroll
        for (int mi = 0; mi < 2; ++mi) {
            bf16x8 qf[8];
            { const size_t R = (size_t)gdn_row(b, pc, 32 * mi + r32, dir);
#pragma unroll
              for (int d0 = 0; d0 < 8; ++d0) qf[d0] = *(const bf16x8*)(qkvp + R * 1536 + h * 128 + d0 * 16 + hi * 8); }
#pragma unroll
            for (int ni = 0; ni <= mi; ++ni) {
                f32x16 ckk = {}, cqk = {};
#pragma unroll
                for (int d0 = 0; d0 < 8; ++d0) { ckk = __builtin_amdgcn_mfma_f32_32x32x16_bf16(kf[mi][d0], kf[ni][d0], ckk, 0, 0, 0);
                                                 cqk = __builtin_amdgcn_mfma_f32_32x32x16_bf16(qf[d0], kf[ni][d0], cqk, 0, 0, 0); }
                const int sg = 32 * ni + r32; const float gsg = gs[sg];
#pragma unroll
                for (int r = 0; r < 16; ++r) { const int tau = 32 * mi + crow(r, hi);
                    const float dec = tau >= sg ? expf(gs[tau] - gsg) : 0.f;
                    Lw[tau * 64 + sg] = tau > sg ? bs[tau] * dec * ckk[r] : 0.f;
                    Ao[tau * 64 + sg] = f2bf(cqk[r] * dec); }
                asm volatile("" ::: "memory");
            }
        }
#pragma unroll
        for (int r = 0; r < 16; ++r) Ao[crow(r, hi) * 64 + 32 + r32] = 0;
        float Tc[64];
#pragma unroll
        for (int i = 0; i < 64; ++i) { float a = (i == lane) ? 1.f : 0.f;
#pragma unroll
            for (int j = 0; j < i; ++j) a -= Lw[i * 64 + j] * Tc[j];
            Tc[i] = a; asm volatile("" ::: "memory"); }
        bf16_t* To = Tb + (size_t)cp * 4096;
#pragma unroll
        for (int i = 0; i < 64; ++i) To[i * 64 + lane] = f2bf(Tc[i]);
    }
}

constexpr int G_KA = 0, G_KV = 16384, G_QA = 32768, G_TT = 49152, G_AQ = G_TT + 9216, G_RT = G_AQ + 9216, G_UT = G_RT + 4608, G_UP = G_UT + 4608,
              G_ST = G_UP + 4608, G_ST2 = G_ST + 8704, G_VS = G_ST2 + 8704, G_GS = G_VS + 4096, G_BS = G_GS + 256, G_END = G_BS + 256;
__device__ void gdn_scan_phase(const Params& p, unsigned char* lds) {
    const int tid = threadIdx.x, lane = tid & 63, wid = tid >> 6, r32 = lane & 31, hi = lane >> 5;
    const bf16_t* qkvp = (const bf16_t*)p.out;
    const bf16_t* Tb = (const bf16_t*)(p.ws + WS_T); const bf16_t* Ab = (const bf16_t*)(p.ws + WS_AQK);
    const float* gv = (const float*)(p.ws + WS_GV); const float* bv = (const float*)(p.ws + WS_BV);
    bf16_t* obuf = (bf16_t*)(p.ws + WS_H);
    const float* gsl = (const float*)(lds + G_GS); const float* bsl = (const float*)(lds + G_BS);
    const int sr = tid >> 4, sc = (tid & 15) * 8;
    const int vb0 = (int)(uintptr_t)(lds + G_KV) + v_rd_base(lane);
    for (int wi = blockIdx.x; wi < 256; wi += gridDim.x) {
        const int chain = wi >> 2, cs = wi & 3, b = chain >> 3, h = (chain >> 1) & 3, dir = chain & 1;
        f32x16 Sacc = {};
        for (int i = tid; i < 2 * 8704 / 4; i += NTHREADS) ((unsigned*)(lds + G_ST))[i] = 0u;
        bf16x8 sk0, sk1, sq0, sq1, sT, sA, sV; float sg = 0.f;
#define GLOAD(step) do { const int pc_ = dir == 0 ? (step) : ((step) < 4 ? 3 - (step) : 4 + 127 - ((step) - 4)); \
        const size_t cp_ = (size_t)chain * 132 + pc_; \
        const size_t R0_ = (size_t)gdn_row(b, pc_, sr, dir), R1_ = (size_t)gdn_row(b, pc_, 32 + sr, dir); \
        sk0 = *(const bf16x8*)(qkvp + R0_ * 1536 + 512 + h * 128 + sc); sk1 = *(const bf16x8*)(qkvp + R1_ * 1536 + 512 + h * 128 + sc); \
        sq0 = *(const bf16x8*)(qkvp + R0_ * 1536 + h * 128 + sc); sq1 = *(const bf16x8*)(qkvp + R1_ * 1536 + h * 128 + sc); \
        sT = *(const bf16x8*)(Tb + cp_ * 4096 + tid * 8); sA = *(const bf16x8*)(Ab + cp_ * 4096 + tid * 8); \
        if (tid < 256) { const size_t Rv_ = (size_t)gdn_row(b, pc_, tid >> 2, dir); sV = *(const bf16x8*)(qkvp + Rv_ * 1536 + 1024 + h * 128 + cs * 32 + (tid & 3) * 8); } \
        if (tid < 64) sg = gv[cp_ * 64 + tid]; else if (tid < 128) sg = bv[cp_ * 64 + tid - 64]; } while (0)
#define GWRITE() do { *(bf16x8*)(lds + G_KA + KSWZ(sr, sc * 2)) = sk0; *(bf16x8*)(lds + G_KA + KSWZ(32 + sr, sc * 2)) = sk1; \
        *(bf16x8*)(lds + G_KV + v_st(sr, sc)) = sk0; *(bf16x8*)(lds + G_KV + v_st(32 + sr, sc)) = sk1; \
        *(bf16x8*)(lds + G_QA + KSWZ(sr, sc * 2)) = sq0; *(bf16x8*)(lds + G_QA + KSWZ(32 + sr, sc * 2)) = sq1; \
        *(bf16x8*)(lds + G_TT + (tid >> 3) * 144 + (tid & 7) * 16) = sT; *(bf16x8*)(lds + G_AQ + (tid >> 3) * 144 + (tid & 7) * 16) = sA; \
        if (tid < 256) *(bf16x8*)(lds + G_VS + (tid >> 2) * 64 + (tid & 3) * 16) = sV; \
        if (tid < 64) ((float*)(lds + G_GS))[tid] = sg; else if (tid < 128) ((float*)(lds + G_BS))[tid - 64] = sg; } while (0)
        GLOAD(0);
        for (int step = 0; step < 132; ++step) {
            GWRITE();
            __syncthreads();
            if (step + 1 < 132) GLOAD(step + 1);
            const int pc = dir == 0 ? step : (step < 4 ? 3 - step : 4 + 127 - (step - 4));
            f32x16 acc = {};
            const int mi = wid & 1;
            if (wid < 4) {
                const unsigned char* At = lds + (wid < 2 ? G_KA : G_QA);
#pragma unroll
                for (int d0 = 0; d0 < 8; ++d0) {
                    const bf16x8 a = *(const bf16x8*)(At + KSWZ(32 * mi + r32, (d0 * 16 + hi * 8) * 2));
                    const bf16x8 bb = *(const bf16x8*)(lds + G_ST + r32 * 272 + (d0 * 16 + hi * 8) * 2);
                    const bf16x8 bl = *(const bf16x8*)(lds + G_ST2 + r32 * 272 + (d0 * 16 + hi * 8) * 2);
                    acc = __builtin_amdgcn_mfma_f32_32x32x16_bf16(a, bb, acc, 0, 0, 0);
                    acc = __builtin_amdgcn_mfma_f32_32x32x16_bf16(a, bl, acc, 0, 0, 0); }
                if (wid < 2) {
#pragma unroll
                    for (int g4 = 0; g4 < 4; ++g4) { float rv[4];
#pragma unroll
                        for (int j = 0; j < 4; ++j) { const int tau = 32 * mi + 8 * g4 + 4 * hi + j;
                            const float vv = bf2f(*(const bf16_t*)(lds + G_VS + tau * 64 + r32 * 2));
                            rv[j] = bsl[tau] * (vv - expf(gsl[tau]) * acc[g4 * 4 + j]); }
                        u32x2 w; w.x = cvtpk(rv[0], rv[1]); w.y = cvtpk(rv[2], rv[3]);
                        *(u32x2*)(lds + G_RT + r32 * 144 + (32 * mi + 8 * g4 + 4 * hi) * 2) = w; }
                } else {
#pragma unroll
                    for (int r = 0; r < 16; ++r) acc[r] *= expf(gsl[32 * mi + crow(r, hi)]);
                }
            }
            __syncthreads();
            if (wid < 2) {
                f32x16 u = {};
#pragma unroll
                for (int s = 0; s < 4; ++s) {
                    const bf16x8 a = *(const bf16x8*)(lds + G_TT + (32 * mi + r32) * 144 + (16 * s + hi * 8) * 2);
                    const bf16x8 bb = *(const bf16x8*)(lds + G_RT + r32 * 144 + (16 * s + hi * 8) * 2);
                    u = __builtin_amdgcn_mfma_f32_32x32x16_bf16(a, bb, u, 0, 0, 0); }
                const float glast = gsl[63];
#pragma unroll
                for (int g4 = 0; g4 < 4; ++g4) { float uv[4], up[4];
#pragma unroll
                    for (int j = 0; j < 4; ++j) { const int tau = 32 * mi + 8 * g4 + 4 * hi + j; uv[j] = u[g4 * 4 + j]; up[j] = uv[j] * expf(glast - gsl[tau]); }
                    u32x2 w; w.x = cvtpk(uv[0], uv[1]); w.y = cvtpk(uv[2], uv[3]);
                    *(u32x2*)(lds + G_UT + r32 * 144 + (32 * mi + 8 * g4 + 4 * hi) * 2) = w;
                    u32x2 w2; w2.x = cvtpk(up[0], up[1]); w2.y = cvtpk(up[2], up[3]);
                    *(u32x2*)(lds + G_UP + r32 * 144 + (32 * mi + 8 * g4 + 4 * hi) * 2) = w2; }
            }
            __syncthreads();
            if (wid == 2 || wid == 3) {
#pragma unroll
                for (int s = 0; s < 4; ++s) {
                    const bf16x8 a = *(const bf16x8*)(lds + G_AQ + (32 * mi + r32) * 144 + (16 * s + hi * 8) * 2);
                    const bf16x8 bb = *(const bf16x8*)(lds + G_UT + r32 * 144 + (16 * s + hi * 8) * 2);
                    acc = __builtin_amdgcn_mfma_f32_32x32x16_bf16(a, bb, acc, 0, 0, 0); }
#pragma unroll
                for (int r = 0; r < 16; ++r) { const size_t R = (size_t)gdn_row(b, pc, 32 * mi + crow(r, hi), dir);
                    obuf[((size_t)dir * MTOT + R) * 512 + h * 128 + cs * 32 + r32] = f2bf(acc[r]); }
            } else if (wid >= 4) {
                const float gl = expf(gsl[63]);
#pragma unroll
                for (int r = 0; r < 16; ++r) Sacc[r] *= gl;
                const bf16x8 pa0 = *(const bf16x8*)(lds + G_UP + r32 * 144 + (0 + hi * 8) * 2), pa1 = *(const bf16x8*)(lds + G_UP + r32 * 144 + (16 + hi * 8) * 2),
                             pa2 = *(const bf16x8*)(lds + G_UP + r32 * 144 + (32 + hi * 8) * 2), pa3 = *(const bf16x8*)(lds + G_UP + r32 * 144 + (48 + hi * 8) * 2);
                const int d0 = wid - 4;
                if (d0 == 0) pv_one<0>(Sacc, vb0, pa0, pa1, pa2, pa3); else if (d0 == 1) pv_one<1>(Sacc, vb0, pa0, pa1, pa2, pa3);
                else if (d0 == 2) pv_one<2>(Sacc, vb0, pa0, pa1, pa2, pa3); else pv_one<3>(Sacc, vb0, pa0, pa1, pa2, pa3);
#pragma unroll
                for (int r = 0; r < 16; ++r) { const bf16_t sh = f2bf(Sacc[r]);
                    *(bf16_t*)(lds + G_ST + crow(r, hi) * 272 + (32 * d0 + r32) * 2) = sh;
                    *(bf16_t*)(lds + G_ST2 + crow(r, hi) * 272 + (32 * d0 + r32) * 2) = f2bf(Sacc[r] - bf2f(sh)); }
            }
            __syncthreads();
        }
#undef GLOAD
#undef GWRITE
    }
}

__device__ void gdn_post_phase(const Params& p) {
    const int lane = threadIdx.x & 63, wid = threadIdx.x >> 6;
    const bf16_t* obuf = (const bf16_t*)(p.ws + WS_H);
    const bf16_t* proj = (const bf16_t*)(p.ws + WS_PROJ);
    bf16_t* mix = (bf16_t*)(p.ws + WS_MIX);
    const int d = (lane & 15) * 8;
    for (int row = blockIdx.x * 8 + wid; row < MTOT; row += gridDim.x * 8) {
        float a[8], bb[8], g[8], y[8];
        unpack8(*(const bf16x8*)(obuf + (size_t)row * 512 + lane * 8), a);
        unpack8(*(const bf16x8*)(obuf + ((size_t)MTOT + row) * 512 + lane * 8), bb);
        unpack8(*(const bf16x8*)(proj + (size_t)row * EV_NP + 3072 + lane * 8), g);
        float ss = 0.f;
#pragma unroll
        for (int i = 0; i < 8; ++i) { a[i] += bb[i]; ss += a[i] * a[i]; }
        ss += __shfl_xor(ss, 1); ss += __shfl_xor(ss, 2); ss += __shfl_xor(ss, 4); ss += __shfl_xor(ss, 8);
        const float rstd = rsqrtf(ss * (1.f / 128.f) + 1e-6f);
#pragma unroll
        for (int i = 0; i < 8; ++i) y[i] = a[i] * rstd * p.gdn_norm[d + i] * (g[i] / (1.f + expf(-g[i])));
        *(bf16x8*)(mix + (size_t)row * DM + 512 + lane * 8) = pack8(y);
    }
}

__device__ void diffattn_phase(const Params& p, unsigned char* lds) {
    const int tid = threadIdx.x, wid = tid >> 6, lane = tid & 63, r32 = lane & 31, hi = lane >> 5;
    const bf16_t* proj = (const bf16_t*)(p.ws + WS_PROJ);
    bf16_t* mix = (bf16_t*)(p.ws + WS_MIX);
    float s01 = 0.f, s23 = 0.f;
    for (int i = 0; i < 64; ++i) { s01 += p.diff_lambda[i] * p.diff_lambda[64 + i]; s23 += p.diff_lambda[128 + i] * p.diff_lambda[192 + i]; }
    const float lam = expf(s01) - expf(s23) + 0.2f;
    float* X = (float*)lds; float* li = (float*)(lds + 131072) + wid * 64;
    const int sr = tid >> 4, sc = (tid & 15) * 8, vst0 = v_st(sr, sc), vst1 = v_st(32 + sr, sc);
    const int ksw0 = KSWZ(sr, sc * 2), ksw1 = KSWZ(32 + sr, sc * 2);
    const int vbase = (int)(uintptr_t)lds + v_rd_base(lane);
    const int map = wid >> 2, wq = wid & 3;
    unsigned char* Qs = lds + 98304 + wid * 4096 + lane * 16;
    for (int it = blockIdx.x; it < 2112; it += gridDim.x) {
        int b, h, NT, qrow0;
        if (it < 2048) { b = it >> 8; h = (it >> 6) & 3; const int qb = it & 63; NT = 132; qrow0 = b * SEQ + qb * 128; }
        else { const int j = it - 2048; b = j >> 3; h = (j >> 1) & 3; NT = 4; qrow0 = NLAT + b * CTXL + (j & 1) * 128; }
        { const bf16_t* qp = proj + (size_t)(qrow0 + 32 * wq + r32) * EV_NP + h * 128 + map * 64 + hi * 8;
#pragma unroll
          for (int d0 = 0; d0 < 4; ++d0) *(bf16x8*)(Qs + d0 * 1024) = *(const bf16x8*)(qp + d0 * 16); }
        f32x16 o[4] = {}; float lsum = 0.f;
        bf16x8 vs0, vs1, ks0, ks1;
#define DLOAD(j) do { const size_t R0_ = (size_t)((j) < 4 ? NLAT + b * CTXL + 64 * (j) : b * SEQ + 64 * ((j) - 4)) + sr; \
        const bf16_t* pp_ = proj + R0_ * EV_NP + h * 128 + sc; \
        vs0 = *(const bf16x8*)(pp_ + 1024); vs1 = *(const bf16x8*)(pp_ + 1024 + (size_t)32 * EV_NP); \
        ks0 = *(const bf16x8*)(pp_ + 512); ks1 = *(const bf16x8*)(pp_ + 512 + (size_t)32 * EV_NP); } while (0)
#define DWRITE(bo) do { *(bf16x8*)(lds + (bo) + vst0) = vs0; *(bf16x8*)(lds + (bo) + vst1) = vs1; \
        *(bf16x8*)(lds + (bo) + 16384 + ksw0) = ks0; *(bf16x8*)(lds + (bo) + 16384 + ksw1) = ks1; } while (0)
#define DQK(P0, P1, bo) do { P0 = (f32x16){}; P1 = (f32x16){}; const unsigned char* Ks_ = lds + (bo) + 16384; \
        _Pragma("unroll") for (int d0 = 0; d0 < 4; ++d0) { const int cb_ = (map * 64 + d0 * 16 + hi * 8) * 2; \
            const bf16x8 b0_ = *(const bf16x8*)(Ks_ + KSWZ(r32, cb_)), b1_ = *(const bf16x8*)(Ks_ + KSWZ(32 + r32, cb_)); \
            const bf16x8 qd_ = *(const bf16x8*)(Qs + d0 * 1024); \
            P0 = __builtin_amdgcn_mfma_f32_32x32x16_bf16(b0_, qd_, P0, 0, 0, 0); \
            P1 = __builtin_amdgcn_mfma_f32_32x32x16_bf16(b1_, qd_, P1, 0, 0, 0); } } while (0)
#define DSM(P0, P1) do { _Pragma("unroll") for (int r = 0; r < 16; ++r) { P0[r] = __builtin_amdgcn_exp2f(P0[r]); P1[r] = __builtin_amdgcn_exp2f(P1[r]); lsum += P0[r] + P1[r]; } \
        PK4(P0, 0, pa0); PK4(P0, 8, pa1); PK4(P1, 0, pa2); PK4(P1, 8, pa3); } while (0)
#define DSTEP(N0, N1, O0, O1, j) do { if ((j) + 1 < NT) DLOAD((j) + 1); \
        DQK(N0, N1, bcur); DSM(O0, O1); pv_d0(o, vbase + bprev, pa0, pa1, pa2, pa3); \
        if ((j) + 1 < NT) DWRITE(bnext); __syncthreads(); \
        { const int t_ = bprev; bprev = bcur; bcur = bnext; bnext = t_; } } while (0)
        f32x16 pA0, pA1, pB0, pB1; bf16x8 pa0, pa1, pa2, pa3;
        DLOAD(0); DWRITE(0); DLOAD(1); DWRITE(32768); __syncthreads();
        DQK(pA0, pA1, 0);
        int bprev = 0, bcur = 32768, bnext = 65536;
        for (int j = 1; j + 1 < NT; j += 2) { DSTEP(pB0, pB1, pA0, pA1, j); DSTEP(pA0, pA1, pB0, pB1, j + 1); }
        DSTEP(pB0, pB1, pA0, pA1, NT - 1);
        DSM(pB0, pB1); pv_d0(o, vbase + bprev, pa0, pa1, pa2, pa3);
        __syncthreads();
#undef DLOAD
#undef DWRITE
#undef DQK
#undef DSM
#undef DSTEP
        const float lt = halfswap_add(lsum);
        if (hi == 0) li[r32] = lt;
        asm volatile("s_waitcnt lgkmcnt(0)" ::: "memory");
        float rli[16];
#pragma unroll
        for (int r = 0; r < 16; ++r) rli[r] = 1.f / li[crow(r, hi)];
        if (map == 1) {
#pragma unroll
            for (int d0 = 0; d0 < 4; ++d0)
#pragma unroll
                for (int r = 0; r < 16; ++r) X[(wq * 64 + d0 * 16 + r) * 64 + lane] = o[d0][r] * rli[r] * lam;
        }
        __syncthreads();
        if (map == 0) {
#pragma unroll
            for (int d0 = 0; d0 < 4; ++d0)
#pragma unroll
                for (int r = 0; r < 16; ++r) o[d0][r] = o[d0][r] * rli[r] - X[(wq * 64 + d0 * 16 + r) * 64 + lane];
#pragma unroll
            for (int r = 0; r < 16; ++r) {
                float ss = o[0][r] * o[0][r] + o[1][r] * o[1][r] + o[2][r] * o[2][r] + o[3][r] * o[3][r];
                ss += __shfl_xor(ss, 1); ss += __shfl_xor(ss, 2); ss += __shfl_xor(ss, 4); ss += __shfl_xor(ss, 8); ss += __shfl_xor(ss, 16);
                const float rstd = rsqrtf(ss * (1.f / 128.f) + 1e-6f) * 0.8f;
                bf16_t* mp = mix + (size_t)(qrow0 + 32 * wq + crow(r, hi)) * DM + h * 128 + r32;
#pragma unroll
                for (int d0 = 0; d0 < 4; ++d0) mp[32 * d0] = f2bf(o[d0][r] * rstd * p.diff_subln[32 * d0 + r32]);
            }
        }
        __syncthreads();
    }
}

__device__ void natten_phase(const Params& p, unsigned char* lds) {
    const int tid = threadIdx.x, wid = tid >> 6, lane = tid & 63, r32 = lane & 31, hi = lane >> 5;
    const bf16_t* proj = (const bf16_t*)(p.ws + WS_PROJ);
    bf16_t* mix = (bf16_t*)(p.ws + WS_MIX);
    constexpr float L2E = 1.4426950408889634f;
    unsigned char* Vl = lds; unsigned char* Kl = lds + 32768;
    float* rpbs = (float*)(lds + 65536);
    float* li = (float*)(lds + 133120) + wid * 64;
    unsigned char* Qs = lds + 67584 + wid * 8192 + lane * 16;
    const int sr = tid >> 4, sc = (tid & 15) * 8, vst0 = v_st(sr, sc), vst1 = v_st(32 + sr, sc);
    const int vb0 = (int)(uintptr_t)Vl + v_rd_base(lane);
    const float* gkp = p.na_qk_gain + 128 + sc;
    for (int it = blockIdx.x; it < 2048; it += gridDim.x) {
        const int b = it >> 8, h = (it >> 5) & 7, rq = it & 31;
        const int grow = 4 * rq + (wid >> 1), qc = (wid & 1) * 32 + r32;
        const size_t qR = (size_t)b * SEQ + grow * 64 + qc;
        for (int i = tid; i < 465; i += NTHREADS) rpbs[i] = p.na_rpb[h * 465 + i] * L2E;
        { float ss = 0.f;
#pragma unroll
          for (int d0 = 0; d0 < 8; ++d0) { float qv[8]; unpack8(*(const bf16x8*)(proj + qR * OD_N + h * 128 + d0 * 16 + hi * 8), qv);
#pragma unroll
              for (int i = 0; i < 8; ++i) ss += qv[i] * qv[i]; }
          ss = halfswap_add(ss);
          const float rs = rsqrtf(ss * (1.f / 128.f) + 1e-6f) * 0.08838834764831845f * L2E;
#pragma unroll
          for (int d0 = 0; d0 < 8; ++d0) { float qv[8]; unpack8(*(const bf16x8*)(proj + qR * OD_N + h * 128 + d0 * 16 + hi * 8), qv);
#pragma unroll
              for (int i = 0; i < 8; ++i) qv[i] *= rs * p.na_qk_gain[d0 * 16 + hi * 8 + i];
              *(bf16x8*)(Qs + d0 * 1024) = pack8(qv); } }
        int lo = 4 * rq - 4; lo = lo < 0 ? 0 : (lo > 120 ? 120 : lo);
        int hi_r = 4 * rq + 3 - 4; hi_r = hi_r < 0 ? 0 : (hi_r > 120 ? 120 : hi_r); hi_r += 7;
        const int nlat = hi_r - lo + 1, NT = nlat + 4;
        int wsr = grow - 4; wsr = wsr < 0 ? 0 : (wsr > 120 ? 120 : wsr);
        int cst = qc - 8; cst = cst < 0 ? 0 : (cst > 48 ? 48 : cst);
        f32x16 o[4] = {}; float lsum = 0.f;
        bf16x8 vs0, vs1, ks0, ks1;
#define NLOAD(j) do { const size_t R0_ = (size_t)((j) < nlat ? b * SEQ + (lo + (j)) * 64 : NLAT + b * CTXL + 64 * ((j) - nlat)) + sr; \
        const bf16_t* pp_ = proj + R0_ * OD_N + h * 128 + sc; \
        vs0 = *(const bf16x8*)(pp_ + 2048); vs1 = *(const bf16x8*)(pp_ + 2048 + (size_t)32 * OD_N); \
        ks0 = *(const bf16x8*)(pp_ + 1024); ks1 = *(const bf16x8*)(pp_ + 1024 + (size_t)32 * OD_N); } while (0)
#define KNORM(kx) do { float f_[8]; unpack8(kx, f_); float ss_ = 0.f; _Pragma("unroll") for (int i_ = 0; i_ < 8; ++i_) ss_ += f_[i_] * f_[i_]; \
        ss_ += __shfl_xor(ss_, 1); ss_ += __shfl_xor(ss_, 2); ss_ += __shfl_xor(ss_, 4); ss_ += __shfl_xor(ss_, 8); \
        const float rs_ = rsqrtf(ss_ * (1.f / 128.f) + 1e-6f); _Pragma("unroll") for (int i_ = 0; i_ < 8; ++i_) f_[i_] *= rs_ * gkp[i_]; kx = pack8(f_); } while (0)
#define NWRITE(bf) do { KNORM(ks0); KNORM(ks1); *(bf16x8*)(Vl + (bf) * 16384 + vst0) = vs0; *(bf16x8*)(Vl + (bf) * 16384 + vst1) = vs1; \
        *(bf16x8*)(Kl + (bf) * 16384 + KSWZ(sr, sc * 2)) = ks0; *(bf16x8*)(Kl + (bf) * 16384 + KSWZ(32 + sr, sc * 2)) = ks1; } while (0)
        NLOAD(0); NWRITE(0); __syncthreads();
        for (int j = 0; j < NT; ++j) {
            if (j + 1 < NT) NLOAD(j + 1);
            const int bf = j & 1;
            const bool islat = j < nlat; const int kr = lo + j;
            const bool active = !islat || (kr >= wsr && kr <= wsr + 7);
            if (active) {
                f32x16 p0 = {}, p1 = {};
                const unsigned char* Ks = Kl + bf * 16384;
#pragma unroll
                for (int d0 = 0; d0 < 8; ++d0) { const int cb = (d0 * 16 + hi * 8) * 2;
                    const bf16x8 b0 = *(const bf16x8*)(Ks + KSWZ(r32, cb)), b1 = *(const bf16x8*)(Ks + KSWZ(32 + r32, cb));
                    const bf16x8 qd = *(const bf16x8*)(Qs + d0 * 1024);
                    p0 = __builtin_amdgcn_mfma_f32_32x32x16_bf16(b0, qd, p0, 0, 0, 0);
                    p1 = __builtin_amdgcn_mfma_f32_32x32x16_bf16(b1, qd, p1, 0, 0, 0); }
                if (islat) {
                    const float* rb = rpbs + (kr - grow + 7) * 31 + 15 - qc + 4 * hi;
                    const int mofs = 4 * hi - cst;
#pragma unroll
                    for (int r = 0; r < 16; ++r) {
                        const int kb = (r & 3) + 8 * (r >> 2);
                        const float e0 = __builtin_amdgcn_exp2f(p0[r] + rb[kb]), e1 = __builtin_amdgcn_exp2f(p1[r] + rb[32 + kb]);
                        p0[r] = ((unsigned)(kb + mofs) < 16u) ? e0 : 0.f; p1[r] = ((unsigned)(32 + kb + mofs) < 16u) ? e1 : 0.f;
                        lsum += p0[r] + p1[r]; }
                } else {
#pragma unroll
                    for (int r = 0; r < 16; ++r) { p0[r] = __builtin_amdgcn_exp2f(p0[r]); p1[r] = __builtin_amdgcn_exp2f(p1[r]); lsum += p0[r] + p1[r]; }
                }
                bf16x8 pa0, pa1, pa2, pa3;
                PK4(p0, 0, pa0); PK4(p0, 8, pa1); PK4(p1, 0, pa2); PK4(p1, 8, pa3);
                pv_d0(o, vb0 + bf * 16384, pa0, pa1, pa2, pa3);
            }
            if (j + 1 < NT) NWRITE((j + 1) & 1);
            __syncthreads();
        }
#undef NLOAD
#undef KNORM
#undef NWRITE
        const float lt = halfswap_add(lsum);
        if (hi == 0) li[r32] = lt;
        asm volatile("s_waitcnt lgkmcnt(0)" ::: "memory");
#pragma unroll
        for (int r = 0; r < 16; ++r) { const float rl = 1.f / li[crow(r, hi)];
            bf16_t* mp = mix + ((size_t)b * SEQ + grow * 64 + (wid & 1) * 32 + crow(r, hi)) * DM + h * 128 + r32;
#pragma unroll
            for (int d0 = 0; d0 < 4; ++d0) mp[32 * d0] = f2bf(o[d0][r] * rl); }
        __syncthreads();
    }
}

constexpr int NPH = 18;
__global__ void __launch_bounds__(NTHREADS, 2) fwd_megakernel(Params p) {
    extern __shared__ __attribute__((aligned(16))) unsigned char lds[];
    cg::grid_group grid = cg::this_grid();
    LAS unsigned char* ldsl = (LAS unsigned char*)lds;
    const int lo = p.ph_lo, hi = p.ph_hi;
#ifdef ONLY_PH
#define IN(k) (((ONLY_PH >> (k)) & 1) && lo <= (k) && (k) < hi)
#else
#define IN(k) (lo <= (k) && (k) < hi)
#endif
#define SEAM(k) do { if (IN(k) && IN((k) + 1)) grid.sync(); } while (0)
    unsigned char* ws = p.ws;
    const bf16_t* H = (const bf16_t*)(ws + WS_H);
    bf16_t* PROJ = (bf16_t*)(ws + WS_PROJ);
    const bf16_t* MIX = (const bf16_t*)(ws + WS_MIX);
    float* CTXRES = (float*)(ws + WS_CTXRES);
    const float* MOD = (const float*)(ws + WS_MOD);
    const int G = gridDim.x, c = blockIdx.x;

    if (IN(0)) { ada_phase(p, lds); wconv_phase(p, lds); }
    SEAM(0);
    if (IN(1)) norm_phase(p, p.x, p.ctx, 0, 0, MTOT);
    SEAM(1);
    if (IN(2)) { pg8::Gemm g{H, (const bf16_t*)(ws + WS_W_EVIN), MTOT, EV_NP, DM}; pg8::StaticOrder S; S.init(MTOT, EV_NP, G, c);
        pg8::EpiBf16 E{PROJ, EV_NP}; pg8::gemm_phase(ldsl, g, S, E); }
    SEAM(2);
    if (IN(3)) prep0_phase(p);
    SEAM(3);
    if (IN(4)) gdn_pre_phase(p, lds);
    SEAM(4);
    if (IN(5)) { gdn_scan_phase(p, lds); __syncthreads(); diffattn_phase(p, lds); }
    SEAM(5);
    if (IN(6)) gdn_post_phase(p);
    SEAM(6);
    if (IN(7)) { pg8::Gemm g{MIX, (const bf16_t*)(ws + WS_W_EVOUT), MTOT, DM, DM}; pg8::StaticOrder S; S.init(MTOT, DM, G, c);
        pg8::EpiResid E{p.x, p.ctx, p.out, CTXRES, MOD, 2048}; pg8::gemm_phase(ldsl, g, S, E); }
    SEAM(7);
    if (IN(8)) norm_phase(p, p.out, CTXRES, 0, 1, MTOT);
    SEAM(8);
    if (IN(9)) { pg8::Gemm g{H, (const bf16_t*)(ws + WS_W_FFIN), MTOT, 2 * FF, DM}; pg8::StaticOrder S; S.init(MTOT, 2 * FF, G, c);
        pg8::EpiSwiglu E{PROJ, FF}; pg8::gemm_phase(ldsl, g, S, E); }
    SEAM(9);
    if (IN(10)) { pg8::Gemm g{PROJ, (const bf16_t*)(ws + WS_W_FFOUT), MTOT, DM, FF}; pg8::StaticOrder S; S.init(MTOT, DM, G, c);
        pg8::EpiResid E{p.out, CTXRES, p.out, CTXRES, MOD, 5120}; pg8::gemm_phase(ldsl, g, S, E); }
    SEAM(10);
    if (IN(11)) norm_phase(p, p.out, CTXRES, 1, 0, MTOT);
    SEAM(11);
    if (IN(12)) { pg8::Gemm g{H, (const bf16_t*)(ws + WS_W_ODIN), MTOT, OD_N, DM}; pg8::StaticOrder S; S.init(MTOT, OD_N, G, c);
        pg8::EpiBf16 E{PROJ, OD_N}; pg8::gemm_phase(ldsl, g, S, E); }
    SEAM(12);
    if (IN(13)) natten_phase(p, lds);
    SEAM(13);
    if (IN(14)) { pg8::Gemm g{MIX, (const bf16_t*)(ws + WS_W_ODOUT), NLAT, DM, DM}; pg8::StaticOrder S; S.init(NLAT, DM, G, c);
        pg8::EpiResid E{p.out, CTXRES, p.out, CTXRES, MOD + 9 * 6144, 2048}; pg8::gemm_phase(ldsl, g, S, E); }
    SEAM(14);
    if (IN(15)) norm_phase(p, p.out, CTXRES, 1, 1, NLAT);
    SEAM(15);
    if (IN(16)) { pg8::Gemm g{H, (const bf16_t*)(ws + WS_W_FFIN) + (size_t)2 * FF * DM, NLAT, 2 * FF, DM}; pg8::StaticOrder S; S.init(NLAT, 2 * FF, G, c);
        pg8::EpiSwiglu E{PROJ, FF}; pg8::gemm_phase(ldsl, g, S, E); }
    SEAM(16);
    if (IN(17)) { pg8::Gemm g{PROJ, (const bf16_t*)(ws + WS_W_FFOUT) + (size_t)DM * FF, NLAT, DM, FF}; pg8::StaticOrder S; S.init(NLAT, DM, G, c);
        pg8::EpiResid E{p.out, CTXRES, p.out, CTXRES, MOD + 9 * 6144, 5120}; pg8::gemm_phase(ldsl, g, S, E); }
#undef IN
#undef SEAM
}

extern "C" void kernel_launch(void* const* d_in, const int* in_sizes, int n_in, void* d_out, int out_size, void* d_ws, size_t ws_size, hipStream_t stream) {
    static int grid = 0;
    if (grid == 0) {
        if (n_in != 23 || ws_size < WS_END) { fprintf(stderr, "kernel_launch: n_in %d ws %zu (need %zu)\n", n_in, ws_size, (size_t)WS_END); grid = -1; return; }
        int dev = 0, cus = 0, per_cu = 0;
        hipGetDevice(&dev); hipDeviceGetAttribute(&cus, hipDeviceAttributeMultiprocessorCount, dev);
        if (hipFuncSetAttribute((const void*)fwd_megakernel, hipFuncAttributeMaxDynamicSharedMemorySize, LDS_BYTES) != hipSuccess) { fprintf(stderr, "hipFuncSetAttribute failed\n"); grid = -1; return; }
        if (hipOccupancyMaxActiveBlocksPerMultiprocessor(&per_cu, (const void*)fwd_megakernel, NTHREADS, LDS_BYTES) != hipSuccess || per_cu < 1) per_cu = 1;
        (void)hipGetLastError();
        grid = cus * 1;
    }
    if (grid < 0) return;
    Params p{};
    const float** pp = (const float**)&p;
    for (int i = 0; i < 23; ++i) pp[i] = (const float*)d_in[i];
    p.out = (float*)d_out; p.ws = (unsigned char*)d_ws;
#if N_LAUNCH_MODE == 1
    p.ph_lo = 0; p.ph_hi = NPH;
    void* args[] = {&p};
    hipError_t e = hipLaunchCooperativeKernel((void*)fwd_megakernel, dim3(grid), dim3(NTHREADS), args, LDS_BYTES, stream);
    if (e != hipSuccess) fprintf(stderr, "cooperative launch failed: %s (grid %d)\n", hipGetErrorString(e), grid);
#else
    for (int k = 0; k < NPH; ++k) { p.ph_lo = k; p.ph_hi = k + 1;
        hipLaunchKernelGGL(fwd_megakernel, dim3(grid), dim3(NTHREADS), LDS_BYTES, stream, p); }
#endif
}
```

```cpp
#include <hip/hip_runtime.h>
#include <hip/hip_cooperative_groups.h>
#include <cstdio>
#include <cstdint>
namespace cg = cooperative_groups;

#define LAS __attribute__((address_space(3)))
typedef unsigned short bf16_t;
typedef short bf16x8 __attribute__((ext_vector_type(8)));
typedef short s16x4 __attribute__((ext_vector_type(4)));
typedef float f32x4 __attribute__((ext_vector_type(4)));
typedef float f32x16 __attribute__((ext_vector_type(16)));
typedef unsigned u32x4 __attribute__((ext_vector_type(4)));
typedef unsigned u32x2 __attribute__((ext_vector_type(2)));

#ifndef N_LAUNCH_MODE
#define N_LAUNCH_MODE 1
#endif

constexpr int DM = 1024, NLAT = 65536, NCTX = 2048, MTOT = NLAT + NCTX, SEQ = 8192, CTXL = 256, FF = 2816;
constexpr int EV_N = 3600, EV_NP = 3840, OD_N = 3072;
constexpr int NCHUNKP = 64 * 132;
constexpr int NTHREADS = 512;
constexpr int LDS_BYTES = 135168 + 16;

constexpr size_t al256(size_t x) { return (x + 255) / 256 * 256; }
constexpr size_t WS_W_EVIN = 0;
constexpr size_t WS_W_EVOUT = WS_W_EVIN + al256((size_t)EV_NP * DM * 2);
constexpr size_t WS_W_ODIN = WS_W_EVOUT + al256((size_t)DM * DM * 2);
constexpr size_t WS_W_ODOUT = WS_W_ODIN + al256((size_t)OD_N * DM * 2);
constexpr size_t WS_W_FFIN = WS_W_ODOUT + al256((size_t)DM * DM * 2);
constexpr size_t WS_W_FFOUT = WS_W_FFIN + al256((size_t)2 * 2 * FF * DM * 2);
constexpr size_t WS_MOD = WS_W_FFOUT + al256((size_t)2 * DM * FF * 2);
constexpr size_t WS_H = WS_MOD + al256((size_t)2 * 9 * 6144 * 4);
constexpr size_t WS_PROJ = WS_H + al256((size_t)MTOT * DM * 2);
constexpr size_t WS_MIX = WS_PROJ + al256((size_t)MTOT * EV_NP * 2);
constexpr size_t WS_T = WS_MIX + al256((size_t)MTOT * DM * 2);
constexpr size_t WS_AQK = WS_T + al256((size_t)NCHUNKP * 4096 * 2);
constexpr size_t WS_GV = WS_AQK + al256((size_t)NCHUNKP * 4096 * 2);
constexpr size_t WS_BV = WS_GV + al256((size_t)NCHUNKP * 64 * 4);
constexpr size_t WS_GATES = WS_BV + al256((size_t)NCHUNKP * 64 * 4);
constexpr size_t WS_CTXRES = WS_GATES + al256((size_t)MTOT * 16 * 4);
constexpr size_t WS_BAR = WS_CTXRES + al256((size_t)NCTX * DM * 4);
constexpr size_t WS_END = WS_BAR + 16384;

struct Params {
    const float *x, *c, *ctx, *c_ctx, *ada_w, *ada_b, *norm_mix, *norm_ffn, *ffn_w_in, *ffn_w_out, *even_w_in, *even_w_out,
        *diff_qk_gain, *diff_lambda, *diff_subln, *gdn_conv, *gdn_a_log, *gdn_dt_bias, *gdn_norm, *odd_w_in, *odd_w_out, *na_qk_gain, *na_rpb;
    float* out; unsigned char* ws; int ph_lo, ph_hi;
};

__device__ __forceinline__ float bf2f(bf16_t b) { return __uint_as_float(((unsigned)b) << 16); }
__device__ __forceinline__ bf16_t f2bf(float f) { unsigned u = __float_as_uint(f); u += 0x7FFFu + ((u >> 16) & 1u); return (bf16_t)(u >> 16); }
__device__ __forceinline__ unsigned cvtpk(float lo, float hi) { unsigned r; asm volatile("v_cvt_pk_bf16_f32 %0, %1, %2" : "=v"(r) : "v"(lo), "v"(hi)); return r; }
__device__ __forceinline__ float siluf(float v) { return v / (1.f + __expf(-v)); }
__device__ __forceinline__ void unpack8(bf16x8 v, float* f) {
#pragma unroll
    for (int i = 0; i < 8; ++i) f[i] = bf2f((bf16_t)v[i]);
}
__device__ __forceinline__ bf16x8 pack8(const float* f) {
    u32x4 w = {cvtpk(f[0], f[1]), cvtpk(f[2], f[3]), cvtpk(f[4], f[5]), cvtpk(f[6], f[7])};
    return *reinterpret_cast<bf16x8*>(&w);
}

namespace pg8 {
constexpr int BM = 256, BK = 64, HALF = 128, HTB = HALF * BK * 2, STAGE_BYTES = 8 * HTB, NXCD = 8, WGM = 8;
__host__ __device__ __forceinline__ int lds_byte(int r, int c) { const int st = (r >> 4) * 2 + (c >> 5), rr = r & 15, cc = c & 31, ob = rr * 64 + cc * 2; return st * 1024 + (ob ^ (((ob >> 9) & 1) << 5)); }
__host__ __device__ __forceinline__ void stage_rc(int b, int& R, int& C) { const int st = b / 1024, sb = b % 1024, swz = sb ^ (((sb >> 9) & 1) << 5); R = (st >> 1) * 16 + swz / 64; C = (st & 1) * 32 + (swz % 64) / 2; }
__host__ __device__ __forceinline__ int perm32(int rho) { const int n = rho >> 4, i = rho & 15; return 8 * (i >> 2) + 4 * n + (i & 3); }
struct Unit { int pm, pn; };
struct Gemm { const bf16_t* A; const bf16_t* Bt; int M, N, K; };
struct StaticOrder {
    int nM, nN, nwg, G, c;
    __device__ void init(int M, int N, int G_, int c_) { nM = M / BM; nN = N / BM; nwg = nM * nN; G = G_; c = c_; }
    __device__ bool next(int i, Unit& u) const {
        const long L = (long)i * G + c; if (L >= nwg) return false;
        int wgid = (int)L; { const int q = nwg / NXCD, r = nwg % NXCD, xcd = wgid % NXCD, off = wgid / NXCD; wgid = (xcd < r ? xcd * (q + 1) : r * (q + 1) + (xcd - r) * q) + off; }
        const int nig = WGM * nN, gid = wgid / nig, fm = gid * WGM, gsz = (nM - fm) < WGM ? (nM - fm) : WGM;
        u.pm = fm + ((wgid % nig) % gsz); u.pn = (wgid % nig) / gsz; return true;
    }
};
struct EpiBf16 {
    static constexpr bool PERM = true;
    bf16_t* O; int ldc;
    __device__ __forceinline__ void operator()(const f32x4 (&acc)[2][2][4][2], const Unit& u, int wr, int wc, int fr, int fq) const {
        const int row0 = u.pm * BM + wr * 64 + fr; const int col0 = u.pn * BM + wc * 32 + 8 * fq;
#pragma unroll
        for (int ai = 0; ai < 2; ++ai)
#pragma unroll
            for (int m = 0; m < 4; ++m) { bf16_t* rowp = O + (size_t)(row0 + ai * HALF + m * 16) * ldc + col0;
#pragma unroll
                for (int bj = 0; bj < 2; ++bj) { const f32x4 v0 = acc[ai][bj][m][0], v1 = acc[ai][bj][m][1];
                    u32x4 w; w.x = cvtpk(v0[0], v0[1]); w.y = cvtpk(v0[2], v0[3]); w.z = cvtpk(v1[0], v1[1]); w.w = cvtpk(v1[2], v1[3]);
                    *(u32x4*)(rowp + bj * HALF) = w; } }
    }
};
struct EpiSwiglu {
    static constexpr bool PERM = true;
    bf16_t* O; int ldc;
    __device__ __forceinline__ void operator()(const f32x4 (&acc)[2][2][4][2], const Unit& u, int wr, int wc, int fr, int fq) const {
        const int row0 = u.pm * BM + wr * 64 + fr; const int col0 = u.pn * HALF + wc * 32 + 8 * fq;
#pragma unroll
        for (int ai = 0; ai < 2; ++ai)
#pragma unroll
            for (int m = 0; m < 4; ++m) { bf16_t* rowp = O + (size_t)(row0 + ai * HALF + m * 16) * ldc + col0;
                float o[8];
#pragma unroll
                for (int n = 0; n < 2; ++n)
#pragma unroll
                    for (int j = 0; j < 4; ++j) { const float g = acc[ai][0][m][n][j], up = acc[ai][1][m][n][j]; o[n * 4 + j] = g / (1.f + __expf(-g)) * up; }
                u32x4 w; w.x = cvtpk(o[0], o[1]); w.y = cvtpk(o[2], o[3]); w.z = cvtpk(o[4], o[5]); w.w = cvtpk(o[6], o[7]);
                *(u32x4*)rowp = w; }
    }
};
struct EpiResid {
    static constexpr bool PERM = false;
    const float* resLat; const float* resCtx; float* outLat; float* outCtx; const float* modl; int goff;
    __device__ __forceinline__ void operator()(const f32x4 (&acc)[2][2][4][2], const Unit& u, int wr, int wc, int fr, int fq) const {
        const int rowt = u.pm * BM; const bool lat = rowt < NLAT;
        const float* res = lat ? resLat + (size_t)rowt * DM : resCtx + (size_t)(rowt - NLAT) * DM;
        float* out = lat ? outLat + (size_t)rowt * DM : outCtx + (size_t)(rowt - NLAT) * DM;
        const float* gate = modl + (size_t)(lat ? (rowt >> 13) : 8) * 6144 + goff;
        const int row0 = wr * 64 + fr, col0 = u.pn * BM + wc * 32 + 4 * fq;
        f32x4 gv[2][2];
#pragma unroll
        for (int bj = 0; bj < 2; ++bj)
#pragma unroll
            for (int n = 0; n < 2; ++n) gv[bj][n] = *(const f32x4*)(gate + col0 + bj * HALF + n * 16);
#pragma unroll
        for (int ai = 0; ai < 2; ++ai)
#pragma unroll
            for (int m = 0; m < 4; ++m) { const size_t off = (size_t)(row0 + ai * HALF + m * 16) * DM + col0;
#pragma unroll
                for (int bj = 0; bj < 2; ++bj)
#pragma unroll
                    for (int n = 0; n < 2; ++n) { const f32x4 r = *(const f32x4*)(res + off + bj * HALF + n * 16);
                        *(f32x4*)(out + off + bj * HALF + n * 16) = r + gv[bj][n] * acc[ai][bj][m][n]; } }
    }
};

template <class Epi, class Sched>
__device__ __forceinline__ void gemm_phase(LAS unsigned char* lds, const Gemm g, const Sched& S, const Epi& E) {
    const int tid = threadIdx.x, wid = __builtin_amdgcn_readfirstlane(tid >> 6), lane = tid & 63, wr = wid >> 2, wc = wid & 3, fr = lane & 15, fq = lane >> 4;
    const int K = g.K, nt = K / BK;
    unsigned voffA[2], voffB[2];
#pragma unroll
    for (int i = 0; i < 2; ++i) { int R, C; stage_rc(tid * 16 + i * 8192, R, C); const int Rb = Epi::PERM ? ((R & ~31) + perm32(R & 31)) : R;
        voffA[i] = (unsigned)(R * K + C) * 2u; voffB[i] = (unsigned)(Rb * K + C) * 2u; }
    const size_t kstep = (size_t)(BK * 2);
    const size_t hstep = (size_t)HALF * K * 2;
    const size_t tstep = 2 * hstep;
    const unsigned ldsw = (unsigned)wid * 1024u;
    const int aoff = lds_byte(wr * 64 + fr, fq * 8), boff = lds_byte(wc * 32 + fr, fq * 8);
#define PG8_SA(b, h) (((b) * 2 + (h)) * HTB)
#define PG8_SB(b, h) ((4 + (b) * 2 + (h)) * HTB)
#define PG8_STAGE(bufoff, gbase, voff) do { _Pragma("unroll") for (int _i = 0; _i < 2; ++_i) \
        __builtin_amdgcn_global_load_lds((const unsigned*)((const char*)(gbase) + (voff)[_i]), (LAS unsigned*)(lds + (bufoff) + ldsw + _i * 8192), 16, 0, 0); } while (0)
#define PG8_LDA(dst, b, h) do { _Pragma("unroll") for (int m = 0; m < 4; ++m) _Pragma("unroll") for (int k = 0; k < 2; ++k) dst[m][k] = *(const LAS bf16x8*)(lds + PG8_SA(b, h) + aoff + m * 2048 + k * 1024); } while (0)
#define PG8_LDB(dst, b, h) do { _Pragma("unroll") for (int n = 0; n < 2; ++n) _Pragma("unroll") for (int k = 0; k < 2; ++k) dst[n][k] = *(const LAS bf16x8*)(lds + PG8_SB(b, h) + boff + n * 2048 + k * 1024); } while (0)
#define PG8_MMA(ai, bj, At, Bt) do { __builtin_amdgcn_s_setprio(1); _Pragma("unroll") for (int m = 0; m < 4; ++m) _Pragma("unroll") for (int n = 0; n < 2; ++n) _Pragma("unroll") for (int k = 0; k < 2; ++k) \
        acc[ai][bj][m][n] = __builtin_amdgcn_mfma_f32_16x16x32_bf16(Bt[n][k], At[m][k], acc[ai][bj][m][n], 0, 0, 0); __builtin_amdgcn_s_setprio(0); } while (0)
#define PG8_WAIT_V(n) asm volatile("s_waitcnt vmcnt(" #n ")" ::: "memory")
#define PG8_WAIT_L(n) asm volatile("s_waitcnt lgkmcnt(" #n ")" ::: "memory")
#define PG8_BAR __builtin_amdgcn_s_barrier()
#define PG8_SCHED __builtin_amdgcn_sched_barrier(0)
    Unit cur, nxt; int ui = 0;
    if (!S.next(0, cur)) return;
    f32x4 acc[2][2][4][2];
#pragma unroll
    for (int a = 0; a < 2; ++a)
#pragma unroll
        for (int b = 0; b < 2; ++b)
#pragma unroll
            for (int m = 0; m < 4; ++m)
#pragma unroll
                for (int n = 0; n < 2; ++n) acc[a][b][m][n] = (f32x4){0.f, 0.f, 0.f, 0.f};
    bf16x8 At[4][2], B0[2][2], B1[2][2];
    const char* cA = (const char*)g.A + (size_t)cur.pm * tstep; const char* cB = (const char*)g.Bt + (size_t)cur.pn * tstep;
    PG8_STAGE(PG8_SB(0, 0), cB, voffB); PG8_STAGE(PG8_SA(0, 0), cA, voffA); PG8_STAGE(PG8_SB(0, 1), cB + hstep, voffB); PG8_STAGE(PG8_SA(0, 1), cA + hstep, voffA);
    if (wr == 1) PG8_BAR;
    PG8_WAIT_V(4); PG8_BAR;
    PG8_STAGE(PG8_SB(1, 0), cB + kstep, voffB); PG8_STAGE(PG8_SA(1, 0), cA + kstep, voffA); PG8_STAGE(PG8_SB(1, 1), cB + hstep + kstep, voffB);
    PG8_WAIT_V(6); PG8_BAR;
    for (;;) {
        const bool has_next = S.next(ui + 1, nxt);
        const char* nA = has_next ? (const char*)g.A + (size_t)nxt.pm * tstep : cA; const char* nB = has_next ? (const char*)g.Bt + (size_t)nxt.pn * tstep : cB;
        for (int t = 0; t < nt; t += 2) {
            const bool last = (t == nt - 2);
            const char* a1 = cA + (size_t)(t + 1) * kstep;
            const char* a2 = last ? nA : cA + (size_t)(t + 2) * kstep; const char* b2 = last ? nB : cB + (size_t)(t + 2) * kstep;
            const char* a3 = a2 + kstep; const char* b3 = b2 + kstep;
            PG8_LDB(B0, 0, 0); PG8_SCHED; PG8_LDA(At, 0, 0); PG8_STAGE(PG8_SA(1, 1), a1 + hstep, voffA);
            PG8_WAIT_L(8); PG8_BAR; PG8_WAIT_L(0); PG8_MMA(0, 0, At, B0); PG8_BAR; PG8_SCHED;
            PG8_LDB(B1, 0, 1); PG8_STAGE(PG8_SB(0, 0), b2, voffB);
            PG8_BAR; PG8_WAIT_L(0); PG8_MMA(0, 1, At, B1); PG8_BAR;
            PG8_LDA(At, 0, 1); PG8_STAGE(PG8_SA(0, 0), a2, voffA);
            PG8_BAR; PG8_WAIT_L(0); PG8_MMA(1, 0, At, B0); PG8_BAR; PG8_SCHED;
            PG8_STAGE(PG8_SB(0, 1), b2 + hstep, voffB);
            PG8_WAIT_V(6); PG8_BAR; PG8_MMA(1, 1, At, B1); PG8_BAR;
            PG8_LDB(B0, 1, 0); PG8_SCHED; PG8_LDA(At, 1, 0); PG8_STAGE(PG8_SA(0, 1), a2 + hstep, voffA);
            PG8_WAIT_L(8); PG8_BAR; PG8_WAIT_L(0); PG8_MMA(0, 0, At, B0); PG8_BAR; PG8_SCHED;
            PG8_LDB(B1, 1, 1); PG8_STAGE(PG8_SB(1, 0), b3, voffB);
            PG8_BAR; PG8_WAIT_L(0); PG8_MMA(0, 1, At, B1); PG8_BAR;
            PG8_LDA(At, 1, 1); PG8_STAGE(PG8_SA(1, 0), a3, voffA);
            PG8_BAR; PG8_WAIT_L(0); PG8_MMA(1, 0, At, B0); PG8_BAR; PG8_SCHED;
            PG8_STAGE(PG8_SB(1, 1), b3 + hstep, voffB);
            PG8_WAIT_V(6); PG8_BAR; PG8_MMA(1, 1, At, B1); PG8_BAR;
        }
        E(acc, cur, wr, wc, fr, fq);
        if (!has_next) break;
#pragma unroll
        for (int a = 0; a < 2; ++a)
#pragma unroll
            for (int b = 0; b < 2; ++b)
#pragma unroll
                for (int m = 0; m < 4; ++m)
#pragma unroll
                    for (int n = 0; n < 2; ++n) acc[a][b][m][n] = (f32x4){0.f, 0.f, 0.f, 0.f};
        cur = nxt; cA = nA; cB = nB; ++ui;
    }
    PG8_WAIT_V(0);
    if (wr == 0) PG8_BAR;
    PG8_BAR;
#undef PG8_SA
#undef PG8_SB
#undef PG8_STAGE
#undef PG8_LDA
#undef PG8_LDB
#undef PG8_MMA
#undef PG8_WAIT_V
#undef PG8_WAIT_L
#undef PG8_BAR
#undef PG8_SCHED
}
}

#define KSWZ(row, colB) ((row) * 256 + ((colB) ^ (((row) & 7) << 4)))
#define SBAR() __builtin_amdgcn_sched_barrier(0)
__device__ __forceinline__ int crow(int r, int hi) { return (r & 3) + 8 * (r >> 2) + 4 * hi; }
__device__ __forceinline__ int v_st(int k, int c) { const int kk = (k & ~0xC) | ((k & 4) << 1) | ((k & 8) >> 1); return ((kk >> 3) * 4 + (c >> 5)) * 512 + ((kk & 7) * 32 + (c & 31)) * 2; }
__device__ __forceinline__ int v_rd_base(int lane) { return ((lane & 3) << 3) | (((lane >> 2) & 3) << 6) | (((lane >> 4) & 1) << 5) | (((lane >> 5) & 1) << 8); }
constexpr int v_rd_off(int d0, int ks, int half) { return d0 * 512 + ks * 4096 + half * 2048; }
template <int OFF> __device__ __forceinline__ s16x4 tr_read(int vb) {
    s16x4 r; asm volatile("ds_read_b64_tr_b16 %0, %1 offset:%2" : "=&v"(r) : "v"(vb), "i"(OFF) : "memory"); return r;
}
template <int D0> __device__ __forceinline__ void pv_one(f32x16& od, int vb, bf16x8 pa0, bf16x8 pa1, bf16x8 pa2, bf16x8 pa3) {
    const s16x4 l0 = tr_read<v_rd_off(D0, 0, 0)>(vb), h0 = tr_read<v_rd_off(D0, 0, 1)>(vb), l1 = tr_read<v_rd_off(D0, 1, 0)>(vb), h1 = tr_read<v_rd_off(D0, 1, 1)>(vb);
    const s16x4 l2 = tr_read<v_rd_off(D0, 2, 0)>(vb), h2 = tr_read<v_rd_off(D0, 2, 1)>(vb), l3 = tr_read<v_rd_off(D0, 3, 0)>(vb), h3 = tr_read<v_rd_off(D0, 3, 1)>(vb);
    asm volatile("s_waitcnt lgkmcnt(0)" ::: "memory"); SBAR();
#define PK(L, H) (bf16x8){L[0], L[1], L[2], L[3], H[0], H[1], H[2], H[3]}
    od = __builtin_amdgcn_mfma_f32_32x32x16_bf16(pa0, PK(l0, h0), od, 0, 0, 0);
    od = __builtin_amdgcn_mfma_f32_32x32x16_bf16(pa1, PK(l1, h1), od, 0, 0, 0);
    od = __builtin_amdgcn_mfma_f32_32x32x16_bf16(pa2, PK(l2, h2), od, 0, 0, 0);
    od = __builtin_amdgcn_mfma_f32_32x32x16_bf16(pa3, PK(l3, h3), od, 0, 0, 0);
#undef PK
}
__device__ __forceinline__ void pv_d0(f32x16* o, int vb, bf16x8 pa0, bf16x8 pa1, bf16x8 pa2, bf16x8 pa3) {
    pv_one<0>(o[0], vb, pa0, pa1, pa2, pa3); pv_one<1>(o[1], vb, pa0, pa1, pa2, pa3); pv_one<2>(o[2], vb, pa0, pa1, pa2, pa3); pv_one<3>(o[3], vb, pa0, pa1, pa2, pa3);
}
#define PK4(P, BASE, OUT) do { unsigned a0 = cvtpk(P[BASE + 0], P[BASE + 1]), a1 = cvtpk(P[BASE + 2], P[BASE + 3]);   \
    unsigned b0 = cvtpk(P[BASE + 4], P[BASE + 5]), b1 = cvtpk(P[BASE + 6], P[BASE + 7]);                              \
    auto r0 = __builtin_amdgcn_permlane32_swap(a0, b0, false, false); auto r1 = __builtin_amdgcn_permlane32_swap(a1, b1, false, false); \
    u32x4 w = {r0[0], r1[0], r0[1], r1[1]}; OUT = *reinterpret_cast<bf16x8*>(&w); } while (0)
__device__ __forceinline__ float halfswap_add(float v) {
    auto rr = __builtin_amdgcn_permlane32_swap(__float_as_uint(v), __float_as_uint(v), false, false);
    return __uint_as_float(rr[0]) + __uint_as_float(rr[1]);
}

__device__ __forceinline__ void ada_phase(const Params& p, unsigned char* lds) {
    float* sc = (float*)lds;
    float* red = (float*)(lds + 40960);
    float* mod = (float*)(p.ws + WS_MOD);
    const int tid = threadIdx.x;
    for (int j = blockIdx.x; j < 192; j += gridDim.x) {
        const int l = j / 96, n0 = (j % 96) * 64;
        for (int i = tid; i < 9 * 1024; i += NTHREADS) { const int r = i >> 10, k = i & 1023; const float v = r < 8 ? p.c[r * 1024 + k] : p.c_ctx[k]; sc[i] = v / (1.f + expf(-v)); }
        __syncthreads();
        const int col = tid & 63, ks = tid >> 6;
        float acc[9];
#pragma unroll
        for (int r = 0; r < 9; ++r) acc[r] = 0.f;
        const float* wp = p.ada_w + ((size_t)l * 1024 + ks * 128) * 6144 + n0 + col;
#pragma unroll 8
        for (int kk = 0; kk < 128; ++kk) { const float w = wp[(size_t)kk * 6144];
#pragma unroll
            for (int r = 0; r < 9; ++r) acc[r] += sc[r * 1024 + ks * 128 + kk] * w; }
#pragma unroll
        for (int r = 0; r < 9; ++r) red[(ks * 9 + r) * 64 + col] = acc[r];
        __syncthreads();
        for (int i = tid; i < 576; i += NTHREADS) { const int r = i >> 6, cc = i & 63; float s = p.ada_b[l * 6144 + n0 + cc];
            for (int k2 = 0; k2 < 8; ++k2) s += red[(k2 * 9 + r) * 64 + cc];
            mod[(size_t)(l * 9 + r) * 6144 + n0 + cc] = s; }
        __syncthreads();
    }
}
__device__ __forceinline__ void wconv_phase(const Params& p, unsigned char* lds) {
    float* tl = (float*)lds;
    const int tid = threadIdx.x;
    const int T0 = 16 * 60, T1 = T0 + 16 * 16, T2 = T1 + 16 * 48, T3 = T2 + 16 * 16, T4 = T3 + 16 * 88, T5 = T4 + 16 * 88, T6 = T5 + 44 * 16, T7 = T6 + 44 * 16;
    for (int t = blockIdx.x; t < T7; t += gridDim.x) {
        const float* src; bf16_t* dst; int K, N, NP, mode = 0, tt;
        if (t < T0) { src = p.even_w_in; dst = (bf16_t*)(p.ws + WS_W_EVIN); K = 1024; N = EV_N; NP = EV_NP; tt = t; }
        else if (t < T1) { src = p.even_w_out; dst = (bf16_t*)(p.ws + WS_W_EVOUT); K = 1024; N = 1024; NP = 1024; tt = t - T0; }
        else if (t < T2) { src = p.odd_w_in; dst = (bf16_t*)(p.ws + WS_W_ODIN); K = 1024; N = OD_N; NP = OD_N; tt = t - T1; }
        else if (t < T3) { src = p.odd_w_out; dst = (bf16_t*)(p.ws + WS_W_ODOUT); K = 1024; N = 1024; NP = 1024; tt = t - T2; }
        else if (t < T4) { src = p.ffn_w_in; dst = (bf16_t*)(p.ws + WS_W_FFIN); K = 1024; N = 2 * FF; NP = 2 * FF; mode = 1; tt = t - T3; }
        else if (t < T5) { src = p.ffn_w_in + (size_t)1024 * 2 * FF; dst = (bf16_t*)(p.ws + WS_W_FFIN) + (size_t)2 * FF * 1024; K = 1024; N = 2 * FF; NP = 2 * FF; mode = 1; tt = t - T4; }
        else if (t < T6) { src = p.ffn_w_out; dst = (bf16_t*)(p.ws + WS_W_FFOUT); K = FF; N = 1024; NP = 1024; tt = t - T5; }
        else { src = p.ffn_w_out + (size_t)FF * 1024; dst = (bf16_t*)(p.ws + WS_W_FFOUT) + (size_t)1024 * FF; K = FF; N = 1024; NP = 1024; tt = t - T6; }
        const int nnt = NP / 64; const int k0 = (tt / nnt) * 64, n0 = (tt % nnt) * 64;
        int sn0;
        if (mode == 1) { const int tb = n0 >> 8, bj = (n0 >> 7) & 1, i0 = n0 & 127; sn0 = bj * FF + tb * 128 + i0; } else sn0 = n0;
        for (int e = tid; e < 4096; e += NTHREADS) { const int kk = e >> 6, nn = e & 63; const int sn = sn0 + nn;
            tl[kk * 65 + nn] = (sn < N) ? src[(size_t)(k0 + kk) * N + sn] : 0.f; }
        __syncthreads();
        for (int e = tid; e < 2048; e += NTHREADS) { const int nn = e >> 5, k2 = (e & 31) * 2;
            *(unsigned*)(dst + (size_t)(n0 + nn) * K + k0 + k2) = cvtpk(tl[k2 * 65 + nn], tl[(k2 + 1) * 65 + nn]); }
        __syncthreads();
    }
}

__device__ __forceinline__ void norm_phase(const Params& p, const float* xlat, const float* xctx, int l, int which, int nrows) {
    const int lane = threadIdx.x & 63, wid = threadIdx.x >> 6;
    bf16_t* h = (bf16_t*)(p.ws + WS_H);
    const float* mod = (const float*)(p.ws + WS_MOD) + (size_t)l * 9 * 6144;
    const float* gain = (which ? p.norm_ffn : p.norm_mix) + l * 1024;
    const int shoff = which ? 3072 : 0, scoff = which ? 4096 : 1024;
    for (int row = blockIdx.x * 8 + wid; row < nrows; row += gridDim.x * 8) {
        const bool lat = row < NLAT;
        const float* src = lat ? xlat + (size_t)row * DM : xctx + (size_t)(row - NLAT) * DM;
        const float* mr = mod + (size_t)(lat ? (row >> 13) : 8) * 6144;
        f32x4 v[4]; float ss = 0.f;
#pragma unroll
        for (int i = 0; i < 4; ++i) { v[i] = *(const f32x4*)(src + lane * 4 + 256 * i); ss += v[i][0] * v[i][0] + v[i][1] * v[i][1] + v[i][2] * v[i][2] + v[i][3] * v[i][3]; }
#pragma unroll
        for (int o = 1; o < 64; o <<= 1) ss += __shfl_xor(ss, o);
        const float rstd = rsqrtf(ss * (1.f / 1024.f) + 1e-6f);
#pragma unroll
        for (int i = 0; i < 4; ++i) { const int c0 = lane * 4 + 256 * i;
            const f32x4 g = *(const f32x4*)(gain + c0), s1 = *(const f32x4*)(mr + scoff + c0), sh = *(const f32x4*)(mr + shoff + c0);
            float y[4];
#pragma unroll
            for (int j = 0; j < 4; ++j) y[j] = v[i][j] * rstd * g[j] * (1.f + s1[j]) + sh[j];
            u32x2 w; w.x = cvtpk(y[0], y[1]); w.y = cvtpk(y[2], y[3]);
            *(u32x2*)(h + (size_t)row * DM + c0) = w; }
    }
}

__device__ __forceinline__ void prep0_phase(const Params& p) {
    const int lane = threadIdx.x & 63, wid = threadIdx.x >> 6;
    bf16_t* proj = (bf16_t*)(p.ws + WS_PROJ);
    bf16_t* qkvp = (bf16_t*)p.out;
    float* gbuf = (float*)(p.ws + WS_GATES);
    const int dsub = (lane & 7) * 8;
    const bool isrow = (lane & 7) < 4;
    float inv[4];
#pragma unroll
    for (int i = 0; i < 4; ++i) { const int pp = (lane & 7) * 4 + i; inv[i] = powf(10000.f, -(float)(pp & 15) / 16.f); }
    for (int row = blockIdx.x * 8 + wid; row < MTOT; row += gridDim.x * 8) {
        const bool lat = row < NLAT; const int t = lat ? (row & 8191) : ((row - NLAT) & 255); const int len = lat ? SEQ : CTXL;
        bf16_t* P = proj + (size_t)row * EV_NP;
        float cs[4], sn[4];
        if (lat) {
#pragma unroll
            for (int i = 0; i < 4; ++i) { const float ang = (isrow ? (float)(t >> 6) : (float)(t & 63)) * inv[i]; cs[i] = cosf(ang); sn[i] = sinf(ang); }
        } else {
#pragma unroll
            for (int i = 0; i < 4; ++i) { cs[i] = 1.f; sn[i] = 0.f; }
        }
#pragma unroll
        for (int which = 0; which < 2; ++which) {
            float v[8]; unpack8(*(const bf16x8*)(P + which * 512 + lane * 8), v);
            float ss = 0.f;
#pragma unroll
            for (int i = 0; i < 8; ++i) ss += v[i] * v[i];
            ss += __shfl_xor(ss, 1); ss += __shfl_xor(ss, 2); ss += __shfl_xor(ss, 4);
            const float rstd = rsqrtf(ss * (1.f / 64.f) + 1e-6f);
#pragma unroll
            for (int i = 0; i < 8; ++i) v[i] = v[i] * rstd * p.diff_qk_gain[which * 64 + dsub + i];
#pragma unroll
            for (int i = 0; i < 4; ++i) { const float x0 = v[2 * i], x1 = v[2 * i + 1]; v[2 * i] = x0 * cs[i] - x1 * sn[i]; v[2 * i + 1] = x0 * sn[i] + x1 * cs[i]; }
            if (which == 0) {
#pragma unroll
                for (int i = 0; i < 8; ++i) v[i] *= 0.125f * 1.4426950408889634f;
            }
            *(bf16x8*)(P + which * 512 + lane * 8) = pack8(v);
        }
#pragma unroll
        for (int i = 0; i < 3; ++i) {
            const int c0 = i * 512 + lane * 8;
            float y[8];
#pragma unroll
            for (int e = 0; e < 8; ++e) y[e] = 0.f;
#pragma unroll
            for (int j = 0; j < 5; ++j) { const int tt = t + j - 2;
                if (tt >= 0 && tt < len) { float xv[8]; unpack8(*(const bf16x8*)(proj + (size_t)(row + j - 2) * EV_NP + 1536 + c0), xv);
                    const f32x4 w0 = *(const f32x4*)(p.gdn_conv + j * 1536 + c0), w1 = *(const f32x4*)(p.gdn_conv + j * 1536 + c0 + 4);
#pragma unroll
                    for (int e = 0; e < 4; ++e) { y[e] += w0[e] * xv[e]; y[4 + e] += w1[e] * xv[4 + e]; } } }
#pragma unroll
            for (int e = 0; e < 8; ++e) y[e] = y[e] / (1.f + expf(-y[e]));
            if (i < 2) { float ss = 0.f;
#pragma unroll
                for (int e = 0; e < 8; ++e) ss += y[e] * y[e];
                ss += __shfl_xor(ss, 1); ss += __shfl_xor(ss, 2); ss += __shfl_xor(ss, 4); ss += __shfl_xor(ss, 8);
                const float s = rsqrtf(ss + 1e-6f) * (i == 0 ? 0.08838834764831845f : 1.f);
#pragma unroll
                for (int e = 0; e < 8; ++e) y[e] *= s; }
            *(bf16x8*)(qkvp + (size_t)row * 1536 + c0) = pack8(y);
        }
        if (lane < 16) { const float gv = bf2f(P[3584 + lane]); float o;
            if (lane < 8) o = 1.f / (1.f + expf(-gv));
            else { const float z = gv + p.gdn_dt_bias[lane - 8]; const float sp = z > 20.f ? z : log1pf(expf(z)); o = -expf(p.gdn_a_log[lane - 8]) * sp; }
            gbuf[(size_t)row * 16 + lane] = o; }
    }
}

__device__ __forceinline__ int gdn_row(int b, int pc, int tau, int dir) {
    const int tt = dir ? 63 - tau : tau;
    return pc < 4 ? NLAT + b * CTXL + pc * 64 + tt : b * SEQ + (pc - 4) * 64 + tt;
}
__device__ __forceinline__ void gdn_pre_phase(const Params& p, unsigned char* lds) {
    const int lane = threadIdx.x & 63, wid = threadIdx.x >> 6;
    float* Lw = (float*)(lds + wid * 16896);
    float* gs = Lw + 4096; float* bs = gs + 64;
    const bf16_t* qkvp = (const bf16_t*)p.out;
    const float* gbuf = (const float*)(p.ws + WS_GATES);
    bf16_t* Tb = (bf16_t*)(p.ws + WS_T); bf16_t* Ab = (bf16_t*)(p.ws + WS_AQK);
    float* gv = (float*)(p.ws + WS_GV); float* bv = (float*)(p.ws + WS_BV);
    const int lane0 = lane;
    for (int cp = blockIdx.x * 8 + wid; cp < NCHUNKP; cp += gridDim.x * 8) {
        int lane = lane0; asm volatile("" : "+v"(lane));
        const int r32 = lane & 31, hi = lane >> 5;
        const int pc = cp % 132, ch = cp / 132, dir = ch & 1, h = (ch >> 1) & 3, b = ch >> 3;
        { const int R = gdn_row(b, pc, lane, dir);
          float g = gbuf[(size_t)R * 16 + 8 + dir * 4 + h]; const float be = gbuf[(size_t)R * 16 + dir * 4 + h];
#pragma unroll
          for (int o = 1; o < 64; o <<= 1) { const float t = __shfl_up(g, o); if (lane >= o) g += t; }
          gs[lane] = g; bs[lane] = be; gv[(size_t)cp * 64 + lane] = g; bv[(size_t)cp * 64 + lane] = be; }
        bf16x8 kf[2][8];
#pragma unroll
        for (int mi = 0; mi < 2; ++mi) { const size_t R = (size_t)gdn_row(b, pc, 32 * mi + r32, dir);
#pragma unroll
            for (int d0 = 0; d0 < 8; ++d0) kf[mi][d0] = *(const bf16x8*)(qkvp + R * 1536 + 512 + h * 128 + d0 * 16 + hi * 8); }
        bf16_t* Ao = Ab + (size_t)cp * 4096;
#pragma unroll
        for (int mi = 0; mi < 2; ++mi) {
            bf16x8 qf[8];
            { const size_t R = (size_t)gdn_row(b, pc, 32 * mi + r32, dir);
#pragma unroll
              for (int d0 = 0; d0 < 8; ++d0) qf[d0] = *(const bf16x8*)(qkvp + R * 1536 + h * 128 + d0 * 16 + hi * 8); }
#pragma unroll
            for (int ni = 0; ni <= mi; ++ni) {
                f32x16 ckk = {}, cqk = {};
#pragma unroll
                for (int d0 = 0; d0 < 8; ++d0) { ckk = __builtin_amdgcn_mfma_f32_32x32x16_bf16(kf[mi][d0], kf[ni][d0], ckk, 0, 0, 0);
                                                 cqk = __builtin_amdgcn_mfma_f32_32x32x16_bf16(qf[d0], kf[ni][d0], cqk, 0, 0, 0); }
                const int sg = 32 * ni + r32; const float gsg = gs[sg];
#pragma unroll
                for (int r = 0; r < 16; ++r) { const int tau = 32 * mi + crow(r, hi);
                    const float dec = tau >= sg ? expf(gs[tau] - gsg) : 0.f;
                    Lw[tau * 64 + sg] = tau > sg ? bs[tau] * dec * ckk[r] : 0.f;
                    Ao[tau * 64 + sg] = f2bf(cqk[r] * dec); }
                asm volatile("" ::: "memory");
            }
        }
#pragma unroll
        for (int r = 0; r < 16; ++r) Ao[crow(r, hi) * 64 + 32 + r32] = 0;
        float Tc[64];
#pragma unroll
        for (int i = 0; i < 64; ++i) { float a = (i == lane) ? 1.f : 0.f;
#pragma unroll
            for (int j = 0; j < i; ++j) a -= Lw[i * 64 + j] * Tc[j];
            Tc[i] = a; asm volatile("" ::: "memory"); }
        bf16_t* To = Tb + (size_t)cp * 4096;
#pragma unroll
        for (int i = 0; i < 64; ++i) To[i * 64 + lane] = f2bf(Tc[i]);
    }
}

constexpr int G_KA = 0, G_KV = 16384, G_QA = 32768, G_TT = 49152, G_AQ = G_TT + 9216, G_RT = G_AQ + 9216, G_UT = G_RT + 4608, G_UP = G_UT + 4608,
              G_ST = G_UP + 4608, G_ST2 = G_ST + 8704, G_VS = G_ST2 + 8704, G_GS = G_VS + 4096, G_BS = G_GS + 256, G_END = G_BS + 256;
__device__ __forceinline__ void gdn_scan_phase(const Params& p, unsigned char* lds) {
    const int tid = threadIdx.x, lane = tid & 63, wid = tid >> 6, r32 = lane & 31, hi = lane >> 5;
    const bf16_t* qkvp = (const bf16_t*)p.out;
    const bf16_t* Tb = (const bf16_t*)(p.ws + WS_T); const bf16_t* Ab = (const bf16_t*)(p.ws + WS_AQK);
    const float* gv = (const float*)(p.ws + WS_GV); const float* bv = (const float*)(p.ws + WS_BV);
    bf16_t* obuf = (bf16_t*)(p.ws + WS_H);
    const float* gsl = (const float*)(lds + G_GS); const float* bsl = (const float*)(lds + G_BS);
    const int sr = tid >> 4, sc = (tid & 15) * 8;
    const int vb0 = (int)(uintptr_t)(lds + G_KV) + v_rd_base(lane);
    for (int wi = blockIdx.x; wi < 256; wi += gridDim.x) {
        const int chain = wi >> 2, cs = wi & 3, b = chain >> 3, h = (chain >> 1) & 3, dir = chain & 1;
        f32x16 Sacc = {};
        for (int i = tid; i < 2 * 8704 / 4; i += NTHREADS) ((unsigned*)(lds + G_ST))[i] = 0u;
        bf16x8 sk0, sk1, sq0, sq1, sT, sA, sV; float sg = 0.f;
#define GLOAD(step) do { const int pc_ = dir == 0 ? (step) : ((step) < 4 ? 3 - (step) : 4 + 127 - ((step) - 4)); \
        const size_t cp_ = (size_t)chain * 132 + pc_; \
        const size_t R0_ = (size_t)gdn_row(b, pc_, sr, dir), R1_ = (size_t)gdn_row(b, pc_, 32 + sr, dir); \
        sk0 = *(const bf16x8*)(qkvp + R0_ * 1536 + 512 + h * 128 + sc); sk1 = *(const bf16x8*)(qkvp + R1_ * 1536 + 512 + h * 128 + sc); \
        sq0 = *(const bf16x8*)(qkvp + R0_ * 1536 + h * 128 + sc); sq1 = *(const bf16x8*)(qkvp + R1_ * 1536 + h * 128 + sc); \
        sT = *(const bf16x8*)(Tb + cp_ * 4096 + tid * 8); sA = *(const bf16x8*)(Ab + cp_ * 4096 + tid * 8); \
        if (tid < 256) { const size_t Rv_ = (size_t)gdn_row(b, pc_, tid >> 2, dir); sV = *(const bf16x8*)(qkvp + Rv_ * 1536 + 1024 + h * 128 + cs * 32 + (tid & 3) * 8); } \
        if (tid < 64) sg = gv[cp_ * 64 + tid]; else if (tid < 128) sg = bv[cp_ * 64 + tid - 64]; } while (0)
#define GWRITE() do { *(bf16x8*)(lds + G_KA + KSWZ(sr, sc * 2)) = sk0; *(bf16x8*)(lds + G_KA + KSWZ(32 + sr, sc * 2)) = sk1; \
        *(bf16x8*)(lds + G_KV + v_st(sr, sc)) = sk0; *(bf16x8*)(lds + G_KV + v_st(32 + sr, sc)) = sk1; \
        *(bf16x8*)(lds + G_QA + KSWZ(sr, sc * 2)) = sq0; *(bf16x8*)(lds + G_QA + KSWZ(32 + sr, sc * 2)) = sq1; \
        *(bf16x8*)(lds + G_TT + (tid >> 3) * 144 + (tid & 7) * 16) = sT; *(bf16x8*)(lds + G_AQ + (tid >> 3) * 144 + (tid & 7) * 16) = sA; \
        if (tid < 256) *(bf16x8*)(lds + G_VS + (tid >> 2) * 64 + (tid & 3) * 16) = sV; \
        if (tid < 64) ((float*)(lds + G_GS))[tid] = sg; else if (tid < 128) ((float*)(lds + G_BS))[tid - 64] = sg; } while (0)
        GLOAD(0);
        for (int step = 0; step < 132; ++step) {
            GWRITE();
            __syncthreads();
            if (step + 1 < 132) GLOAD(step + 1);
            const int pc = dir == 0 ? step : (step < 4 ? 3 - step : 4 + 127 - (step - 4));
            f32x16 acc = {};
            const int mi = wid & 1;
            if (wid < 4) {
                const unsigned char* At = lds + (wid < 2 ? G_KA : G_QA);
#pragma unroll
                for (int d0 = 0; d0 < 8; ++d0) {
                    const bf16x8 a = *(const bf16x8*)(At + KSWZ(32 * mi + r32, (d0 * 16 + hi * 8) * 2));
                    const bf16x8 bb = *(const bf16x8*)(lds + G_ST + r32 * 272 + (d0 * 16 + hi * 8) * 2);
                    const bf16x8 bl = *(const bf16x8*)(lds + G_ST2 + r32 * 272 + (d0 * 16 + hi * 8) * 2);
                    acc = __builtin_amdgcn_mfma_f32_32x32x16_bf16(a, bb, acc, 0, 0, 0);
                    acc = __builtin_amdgcn_mfma_f32_32x32x16_bf16(a, bl, acc, 0, 0, 0); }
                if (wid < 2) {
#pragma unroll
                    for (int g4 = 0; g4 < 4; ++g4) { float rv[4];
#pragma unroll
                        for (int j = 0; j < 4; ++j) { const int tau = 32 * mi + 8 * g4 + 4 * hi + j;
                            const float vv = bf2f(*(const bf16_t*)(lds + G_VS + tau * 64 + r32 * 2));
                            rv[j] = bsl[tau] * (vv - expf(gsl[tau]) * acc[g4 * 4 + j]); }
                        u32x2 w; w.x = cvtpk(rv[0], rv[1]); w.y = cvtpk(rv[2], rv[3]);
                        *(u32x2*)(lds + G_RT + r32 * 144 + (32 * mi + 8 * g4 + 4 * hi) * 2) = w; }
                } else {
#pragma unroll
                    for (int r = 0; r < 16; ++r) acc[r] *= expf(gsl[32 * mi + crow(r, hi)]);
                }
            }
            __syncthreads();
            if (wid < 2) {
                f32x16 u = {};
#pragma unroll
                for (int s = 0; s < 4; ++s) {
                    const bf16x8 a = *(const bf16x8*)(lds + G_TT + (32 * mi + r32) * 144 + (16 * s + hi * 8) * 2);
                    const bf16x8 bb = *(const bf16x8*)(lds + G_RT + r32 * 144 + (16 * s + hi * 8) * 2);
                    u = __builtin_amdgcn_mfma_f32_32x32x16_bf16(a, bb, u, 0, 0, 0); }
                const float glast = gsl[63];
#pragma unroll
                for (int g4 = 0; g4 < 4; ++g4) { float uv[4], up[4];
#pragma unroll
                    for (int j = 0; j < 4; ++j) { const int tau = 32 * mi + 8 * g4 + 4 * hi + j; uv[j] = u[g4 * 4 + j]; up[j] = uv[j] * expf(glast - gsl[tau]); }
                    u32x2 w; w.x = cvtpk(uv[0], uv[1]); w.y = cvtpk(uv[2], uv[3]);
                    *(u32x2*)(lds + G_UT + r32 * 144 + (32 * mi + 8 * g4 + 4 * hi) * 2) = w;
                    u32x2 w2; w2.x = cvtpk(up[0], up[1]); w2.y = cvtpk(up[2], up[3]);
                    *(u32x2*)(lds + G_UP + r32 * 144 + (32 * mi + 8 * g4 + 4 * hi) * 2) = w2; }
            }
            __syncthreads();
            if (wid == 2 || wid == 3) {
#pragma unroll
                for (int s = 0; s < 4; ++s) {
                    const bf16x8 a = *(const bf16x8*)(lds + G_AQ + (32 * mi + r32) * 144 + (16 * s + hi * 8) * 2);
                    const bf16x8 bb = *(const bf16x8*)(lds + G_UT + r32 * 144 + (16 * s + hi * 8) * 2);
                    acc = __builtin_amdgcn_mfma_f32_32x32x16_bf16(a, bb, acc, 0, 0, 0); }
#pragma unroll
                for (int r = 0; r < 16; ++r) { const size_t R = (size_t)gdn_row(b, pc, 32 * mi + crow(r, hi), dir);
                    obuf[((size_t)dir * MTOT + R) * 512 + h * 128 + cs * 32 + r32] = f2bf(acc[r]); }
            } else if (wid >= 4) {
                const float gl = expf(gsl[63]);
#pragma unroll
                for (int r = 0; r < 16; ++r) Sacc[r] *= gl;
                const bf16x8 pa0 = *(const bf16x8*)(lds + G_UP + r32 * 144 + (0 + hi * 8) * 2), pa1 = *(const bf16x8*)(lds + G_UP + r32 * 144 + (16 + hi * 8) * 2),
                             pa2 = *(const bf16x8*)(lds + G_UP + r32 * 144 + (32 + hi * 8) * 2), pa3 = *(const bf16x8*)(lds + G_UP + r32 * 144 + (48 + hi * 8) * 2);
                const int d0 = wid - 4;
                if (d0 == 0) pv_one<0>(Sacc, vb0, pa0, pa1, pa2, pa3); else if (d0 == 1) pv_one<1>(Sacc, vb0, pa0, pa1, pa2, pa3);
                else if (d0 == 2) pv_one<2>(Sacc, vb0, pa0, pa1, pa2, pa3); else pv_one<3>(Sacc, vb0, pa0, pa1, pa2, pa3);
#pragma unroll
                for (int r = 0; r < 16; ++r) { const bf16_t sh = f2bf(Sacc[r]);
                    *(bf16_t*)(lds + G_ST + crow(r, hi) * 272 + (32 * d0 + r32) * 2) = sh;
                    *(bf16_t*)(lds + G_ST2 + crow(r, hi) * 272 + (32 * d0 + r32) * 2) = f2bf(Sacc[r] - bf2f(sh)); }
            }
            __syncthreads();
        }
#undef GLOAD
#undef GWRITE
    }
}

__device__ __forceinline__ void gdn_post_phase(const Params& p) {
    const int lane = threadIdx.x & 63, wid = threadIdx.x >> 6;
    const bf16_t* obuf = (const bf16_t*)(p.ws + WS_H);
    const bf16_t* proj = (const bf16_t*)(p.ws + WS_PROJ);
    bf16_t* mix = (bf16_t*)(p.ws + WS_MIX);
    const int d = (lane & 15) * 8;
    for (int row = blockIdx.x * 8 + wid; row < MTOT; row += gridDim.x * 8) {
        float a[8], bb[8], g[8], y[8];
        unpack8(*(const bf16x8*)(obuf + (size_t)row * 512 + lane * 8), a);
        unpack8(*(const bf16x8*)(obuf + ((size_t)MTOT + row) * 512 + lane * 8), bb);
        unpack8(*(const bf16x8*)(proj + (size_t)row * EV_NP + 3072 + lane * 8), g);
        float ss = 0.f;
#pragma unroll
        for (int i = 0; i < 8; ++i) { a[i] += bb[i]; ss += a[i] * a[i]; }
        ss += __shfl_xor(ss, 1); ss += __shfl_xor(ss, 2); ss += __shfl_xor(ss, 4); ss += __shfl_xor(ss, 8);
        const float rstd = rsqrtf(ss * (1.f / 128.f) + 1e-6f);
#pragma unroll
        for (int i = 0; i < 8; ++i) y[i] = a[i] * rstd * p.gdn_norm[d + i] * (g[i] / (1.f + expf(-g[i])));
        *(bf16x8*)(mix + (size_t)row * DM + 512 + lane * 8) = pack8(y);
    }
}

__device__ __forceinline__ void diffattn_phase(const Params& p, unsigned char* lds) {
    const int tid = threadIdx.x, wid = tid >> 6, lane = tid & 63, r32 = lane & 31, hi = lane >> 5;
    const bf16_t* proj = (const bf16_t*)(p.ws + WS_PROJ);
    bf16_t* mix = (bf16_t*)(p.ws + WS_MIX);
    float s01 = 0.f, s23 = 0.f;
    for (int i = 0; i < 64; ++i) { s01 += p.diff_lambda[i] * p.diff_lambda[64 + i]; s23 += p.diff_lambda[128 + i] * p.diff_lambda[192 + i]; }
    const float lam = expf(s01) - expf(s23) + 0.2f;
    float* X = (float*)lds; float* li = (float*)(lds + 131072) + wid * 64;
    const int sr = tid >> 4, sc = (tid & 15) * 8, vst0 = v_st(sr, sc), vst1 = v_st(32 + sr, sc);
    const int ksw0 = KSWZ(sr, sc * 2), ksw1 = KSWZ(32 + sr, sc * 2);
    const int vbase = (int)(uintptr_t)lds + v_rd_base(lane);
    const int map = wid >> 2, wq = wid & 3;
    unsigned char* Qs = lds + 98304 + wid * 4096 + lane * 16;
    for (int it = blockIdx.x; it < 2112; it += gridDim.x) {
        int b, h, NT, qrow0;
        if (it < 2048) { b = it >> 8; h = (it >> 6) & 3; const int qb = it & 63; NT = 132; qrow0 = b * SEQ + qb * 128; }
        else { const int j = it - 2048; b = j >> 3; h = (j >> 1) & 3; NT = 4; qrow0 = NLAT + b * CTXL + (j & 1) * 128; }
        { const bf16_t* qp = proj + (size_t)(qrow0 + 32 * wq + r32) * EV_NP + h * 128 + map * 64 + hi * 8;
#pragma unroll
          for (int d0 = 0; d0 < 4; ++d0) *(bf16x8*)(Qs + d0 * 1024) = *(const bf16x8*)(qp + d0 * 16); }
        f32x16 o[4] = {}; float lsum = 0.f;
        bf16x8 vs0, vs1, ks0, ks1;
#define DLOAD(j) do { const size_t R0_ = (size_t)((j) < 4 ? NLAT + b * CTXL + 64 * (j) : b * SEQ + 64 * ((j) - 4)) + sr; \
        const bf16_t* pp_ = proj + R0_ * EV_NP + h * 128 + sc; \
        vs0 = *(const bf16x8*)(pp_ + 1024); vs1 = *(const bf16x8*)(pp_ + 1024 + (size_t)32 * EV_NP); \
        ks0 = *(const bf16x8*)(pp_ + 512); ks1 = *(const bf16x8*)(pp_ + 512 + (size_t)32 * EV_NP); } while (0)
#define DWRITE(bo) do { *(bf16x8*)(lds + (bo) + vst0) = vs0; *(bf16x8*)(lds + (bo) + vst1) = vs1; \
        *(bf16x8*)(lds + (bo) + 16384 + ksw0) = ks0; *(bf16x8*)(lds + (bo) + 16384 + ksw1) = ks1; } while (0)
#define DQK(P0, P1, bo) do { P0 = (f32x16){}; P1 = (f32x16){}; const unsigned char* Ks_ = lds + (bo) + 16384; \
        _Pragma("unroll") for (int d0 = 0; d0 < 4; ++d0) { const int cb_ = (map * 64 + d0 * 16 + hi * 8) * 2; \
            const bf16x8 b0_ = *(const bf16x8*)(Ks_ + KSWZ(r32, cb_)), b1_ = *(const bf16x8*)(Ks_ + KSWZ(32 + r32, cb_)); \
            const bf16x8 qd_ = *(const bf16x8*)(Qs + d0 * 1024); \
            P0 = __builtin_amdgcn_mfma_f32_32x32x16_bf16(b0_, qd_, P0, 0, 0, 0); \
            P1 = __builtin_amdgcn_mfma_f32_32x32x16_bf16(b1_, qd_, P1, 0, 0, 0); } } while (0)
#define DSM(P0, P1) do { _Pragma("unroll") for (int r = 0; r < 16; ++r) { P0[r] = __builtin_amdgcn_exp2f(P0[r]); P1[r] = __builtin_amdgcn_exp2f(P1[r]); lsum += P0[r] + P1[r]; } \
        PK4(P0, 0, pa0); PK4(P0, 8, pa1); PK4(P1, 0, pa2); PK4(P1, 8, pa3); } while (0)
#define DSTEP(N0, N1, O0, O1, j) do { if ((j) + 1 < NT) DLOAD((j) + 1); \
        DQK(N0, N1, bcur); DSM(O0, O1); pv_d0(o, vbase + bprev, pa0, pa1, pa2, pa3); \
        if ((j) + 1 < NT) DWRITE(bnext); __syncthreads(); \
        { const int t_ = bprev; bprev = bcur; bcur = bnext; bnext = t_; } } while (0)
        f32x16 pA0, pA1, pB0, pB1; bf16x8 pa0, pa1, pa2, pa3;
        DLOAD(0); DWRITE(0); DLOAD(1); DWRITE(32768); __syncthreads();
        DQK(pA0, pA1, 0);
        int bprev = 0, bcur = 32768, bnext = 65536;
        for (int j = 1; j + 1 < NT; j += 2) { DSTEP(pB0, pB1, pA0, pA1, j); DSTEP(pA0, pA1, pB0, pB1, j + 1); }
        DSTEP(pB0, pB1, pA0, pA1, NT - 1);
        DSM(pB0, pB1); pv_d0(o, vbase + bprev, pa0, pa1, pa2, pa3);
        __syncthreads();
#undef DLOAD
#undef DWRITE
#undef DQK
#undef DSM
#undef DSTEP
        const float lt = halfswap_add(lsum);
        if (hi == 0) li[r32] = lt;
        asm volatile("s_waitcnt lgkmcnt(0)" ::: "memory");
        float rli[16];
#pragma unroll
        for (int r = 0; r < 16; ++r) rli[r] = 1.f / li[crow(r, hi)];
        if (map == 1) {
#pragma unroll
            for (int d0 = 0; d0 < 4; ++d0)
#pragma unroll
                for (int r = 0; r < 16; ++r) X[(wq * 64 + d0 * 16 + r) * 64 + lane] = o[d0][r] * rli[r] * lam;
        }
        __syncthreads();
        if (map == 0) {
#pragma unroll
            for (int d0 = 0; d0 < 4; ++d0)
#pragma unroll
                for (int r = 0; r < 16; ++r) o[d0][r] = o[d0][r] * rli[r] - X[(wq * 64 + d0 * 16 + r) * 64 + lane];
#pragma unroll
            for (int r = 0; r < 16; ++r) {
                float ss = o[0][r] * o[0][r] + o[1][r] * o[1][r] + o[2][r] * o[2][r] + o[3][r] * o[3][r];
                ss += __shfl_xor(ss, 1); ss += __shfl_xor(ss, 2); ss += __shfl_xor(ss, 4); ss += __shfl_xor(ss, 8); ss += __shfl_xor(ss, 16);
                const float rstd = rsqrtf(ss * (1.f / 128.f) + 1e-6f) * 0.8f;
                bf16_t* mp = mix + (size_t)(qrow0 + 32 * wq + crow(r, hi)) * DM + h * 128 + r32;
#pragma unroll
                for (int d0 = 0; d0 < 4; ++d0) mp[32 * d0] = f2bf(o[d0][r] * rstd * p.diff_subln[32 * d0 + r32]);
            }
        }
        __syncthreads();
    }
}

__device__ __forceinline__ void natten_phase(const Params& p, unsigned char* lds) {
    const int tid = threadIdx.x, wid = tid >> 6, lane = tid & 63, r32 = lane & 31, hi = lane >> 5;
    const bf16_t* proj = (const bf16_t*)(p.ws + WS_PROJ);
    bf16_t* mix = (bf16_t*)(p.ws + WS_MIX);
    constexpr float L2E = 1.4426950408889634f;
    unsigned char* Vl = lds; unsigned char* Kl = lds + 32768;
    float* rpbs = (float*)(lds + 65536);
    float* li = (float*)(lds + 133120) + wid * 64;
    unsigned char* Qs = lds + 67584 + wid * 8192 + lane * 16;
    const int sr = tid >> 4, sc = (tid & 15) * 8, vst0 = v_st(sr, sc), vst1 = v_st(32 + sr, sc);
    const int vb0 = (int)(uintptr_t)Vl + v_rd_base(lane);
    const float* gkp = p.na_qk_gain + 128 + sc;
    for (int it = blockIdx.x; it < 2048; it += gridDim.x) {
        const int b = it >> 8, h = (it >> 5) & 7, rq = it & 31;
        const int grow = 4 * rq + (wid >> 1), qc = (wid & 1) * 32 + r32;
        const size_t qR = (size_t)b * SEQ + grow * 64 + qc;
        for (int i = tid; i < 465; i += NTHREADS) rpbs[i] = p.na_rpb[h * 465 + i] * L2E;
        { float ss = 0.f;
#pragma unroll
          for (int d0 = 0; d0 < 8; ++d0) { float qv[8]; unpack8(*(const bf16x8*)(proj + qR * OD_N + h * 128 + d0 * 16 + hi * 8), qv);
#pragma unroll
              for (int i = 0; i < 8; ++i) ss += qv[i] * qv[i]; }
          ss = halfswap_add(ss);
          const float rs = rsqrtf(ss * (1.f / 128.f) + 1e-6f) * 0.08838834764831845f * L2E;
#pragma unroll
          for (int d0 = 0; d0 < 8; ++d0) { float qv[8]; unpack8(*(const bf16x8*)(proj + qR * OD_N + h * 128 + d0 * 16 + hi * 8), qv);
#pragma unroll
              for (int i = 0; i < 8; ++i) qv[i] *= rs * p.na_qk_gain[d0 * 16 + hi * 8 + i];
              *(bf16x8*)(Qs + d0 * 1024) = pack8(qv); } }
        int lo = 4 * rq - 4; lo = lo < 0 ? 0 : (lo > 120 ? 120 : lo);
        int hi_r = 4 * rq + 3 - 4; hi_r = hi_r < 0 ? 0 : (hi_r > 120 ? 120 : hi_r); hi_r += 7;
        const int nlat = hi_r - lo + 1, NT = nlat + 4;
        int wsr = grow - 4; wsr = wsr < 0 ? 0 : (wsr > 120 ? 120 : wsr);
        int cst = qc - 8; cst = cst < 0 ? 0 : (cst > 48 ? 48 : cst);
        f32x16 o[4] = {}; float lsum = 0.f;
        bf16x8 vs0, vs1, ks0, ks1;
#define NLOAD(j) do { const size_t R0_ = (size_t)((j) < nlat ? b * SEQ + (lo + (j)) * 64 : NLAT + b * CTXL + 64 * ((j) - nlat)) + sr; \
        const bf16_t* pp_ = proj + R0_ * OD_N + h * 128 + sc; \
        vs0 = *(const bf16x8*)(pp_ + 2048); vs1 = *(const bf16x8*)(pp_ + 2048 + (size_t)32 * OD_N); \
        ks0 = *(const bf16x8*)(pp_ + 1024); ks1 = *(const bf16x8*)(pp_ + 1024 + (size_t)32 * OD_N); } while (0)
#define KNORM(kx) do { float f_[8]; unpack8(kx, f_); float ss_ = 0.f; _Pragma("unroll") for (int i_ = 0; i_ < 8; ++i_) ss_ += f_[i_] * f_[i_]; \
        ss_ += __shfl_xor(ss_, 1); ss_ += __shfl_xor(ss_, 2); ss_ += __shfl_xor(ss_, 4); ss_ += __shfl_xor(ss_, 8); \
        const float rs_ = rsqrtf(ss_ * (1.f / 128.f) + 1e-6f); _Pragma("unroll") for (int i_ = 0; i_ < 8; ++i_) f_[i_] *= rs_ * gkp[i_]; kx = pack8(f_); } while (0)
#define NWRITE(bf) do { KNORM(ks0); KNORM(ks1); *(bf16x8*)(Vl + (bf) * 16384 + vst0) = vs0; *(bf16x8*)(Vl + (bf) * 16384 + vst1) = vs1; \
        *(bf16x8*)(Kl + (bf) * 16384 + KSWZ(sr, sc * 2)) = ks0; *(bf16x8*)(Kl + (bf) * 16384 + KSWZ(32 + sr, sc * 2)) = ks1; } while (0)
        NLOAD(0); NWRITE(0); __syncthreads();
        for (int j = 0; j < NT; ++j) {
            if (j + 1 < NT) NLOAD(j + 1);
            const int bf = j & 1;
            const bool islat = j < nlat; const int kr = lo + j;
            const bool active = !islat || (kr >= wsr && kr <= wsr + 7);
            if (active) {
                f32x16 p0 = {}, p1 = {};
                const unsigned char* Ks = Kl + bf * 16384;
#pragma unroll
                for (int d0 = 0; d0 < 8; ++d0) { const int cb = (d0 * 16 + hi * 8) * 2;
                    const bf16x8 b0 = *(const bf16x8*)(Ks + KSWZ(r32, cb)), b1 = *(const bf16x8*)(Ks + KSWZ(32 + r32, cb));
                    const bf16x8 qd = *(const bf16x8*)(Qs + d0 * 1024);
                    p0 = __builtin_amdgcn_mfma_f32_32x32x16_bf16(b0, qd, p0, 0, 0, 0);
                    p1 = __builtin_amdgcn_mfma_f32_32x32x16_bf16(b1, qd, p1, 0, 0, 0); }
                if (islat) {
                    const float* rb = rpbs + (kr - grow + 7) * 31 + 15 - qc + 4 * hi;
                    const int mofs = 4 * hi - cst;
#pragma unroll
                    for (int r = 0; r < 16; ++r) {
                        const int kb = (r & 3) + 8 * (r >> 2);
                        const float e0 = __builtin_amdgcn_exp2f(p0[r] + rb[kb]), e1 = __builtin_amdgcn_exp2f(p1[r] + rb[32 + kb]);
                        p0[r] = ((unsigned)(kb + mofs) < 16u) ? e0 : 0.f; p1[r] = ((unsigned)(32 + kb + mofs) < 16u) ? e1 : 0.f;
                        lsum += p0[r] + p1[r]; }
                } else {
#pragma unroll
                    for (int r = 0; r < 16; ++r) { p0[r] = __builtin_amdgcn_exp2f(p0[r]); p1[r] = __builtin_amdgcn_exp2f(p1[r]); lsum += p0[r] + p1[r]; }
                }
                bf16x8 pa0, pa1, pa2, pa3;
                PK4(p0, 0, pa0); PK4(p0, 8, pa1); PK4(p1, 0, pa2); PK4(p1, 8, pa3);
                pv_d0(o, vb0 + bf * 16384, pa0, pa1, pa2, pa3);
            }
            if (j + 1 < NT) NWRITE((j + 1) & 1);
            __syncthreads();
        }
#undef NLOAD
#undef KNORM
#undef NWRITE
        const float lt = halfswap_add(lsum);
        if (hi == 0) li[r32] = lt;
        asm volatile("s_waitcnt lgkmcnt(0)" ::: "memory");
#pragma unroll
        for (int r = 0; r < 16; ++r) { const float rl = 1.f / li[crow(r, hi)];
            bf16_t* mp = mix + ((size_t)b * SEQ + grow * 64 + (wid & 1) * 32 + crow(r, hi)) * DM + h * 128 + r32;
#pragma unroll
            for (int d0 = 0; d0 < 4; ++d0) mp[32 * d0] = f2bf(o[d0][r] * rl); }
        __syncthreads();
    }
}

#define XB_TMO      128
#define XB_XCNT(j)  (256  + 64 * (j))
#define XB_XSUB(j)  (1280 + 64 * (j))
#define XB_XGEN(j)  (2304 + 64 * (j))
#define XB_TOP      3328
#define XB_TOPGEN   3392
#define XCD_BAR_WORDS 3456
#define XB_SPIN_CAP (1u << 22)
__device__ __forceinline__ unsigned xb_ld(unsigned* p)              { return __hip_atomic_load(p, __ATOMIC_RELAXED, __HIP_MEMORY_SCOPE_AGENT); }
__device__ __forceinline__ unsigned xb_add(unsigned* p, unsigned v) { return __hip_atomic_fetch_add(p, v, __ATOMIC_RELAXED, __HIP_MEMORY_SCOPE_AGENT); }
__device__ __forceinline__ unsigned xb_xcc_id() { return (unsigned)__builtin_amdgcn_s_getreg((3 << 11) | 20) & 0xFu; }
#define XB_SPIN(cond, bar) do { unsigned _sp = 0; while (cond) { __builtin_amdgcn_s_sleep(1); \
    if ((++_sp & 255u) == 0u) { if (xb_ld(&(bar)[XB_TMO])) break; if (_sp > XB_SPIN_CAP) { atomicAdd(&(bar)[XB_TMO], 1u); break; } } } } while (0)
struct XcdBarrier { unsigned* bar; unsigned x; volatile LAS unsigned* st; };
__device__ __forceinline__ XcdBarrier xcd_barrier_post(unsigned* bar, volatile LAS unsigned* st) {
    XcdBarrier b; b.bar = bar; b.x = xb_xcc_id(); b.st = st;
    if (threadIdx.x == 0) (void)xb_add(&bar[XB_XCNT(b.x)], 1u);
    return b;
}
__device__ __forceinline__ void xcd_barrier_complete(unsigned* bar, unsigned x, unsigned& nloc, unsigned& nx) {
    const unsigned G = gridDim.x * gridDim.y * gridDim.z;
    unsigned sum, cnt, mine, sp = 0u;
    for (;;) {
        sum = 0u; cnt = 0u; mine = 0u;
#pragma unroll
        for (unsigned j = 0; j < 16; ++j) { const unsigned c = xb_ld(&bar[XB_XCNT(j)]); sum += c; cnt += (c > 0u) ? 1u : 0u; mine = (j == x) ? c : mine; }
        if (sum == G) break;
        __builtin_amdgcn_s_sleep(1);
        if ((++sp & 255u) == 0u) { if (xb_ld(&bar[XB_TMO])) break; if (sp > XB_SPIN_CAP) { atomicAdd(&bar[XB_TMO], 1u); break; } }
    }
    nloc = mine > 0u ? mine : 1u; nx = cnt > 0u ? cnt : 1u;
}
__device__ __forceinline__ void xcd_barrier(const XcdBarrier& b) {
    asm volatile("s_waitcnt vmcnt(0)" ::: "memory");
    __syncthreads();
    if (threadIdx.x == 0) {
        unsigned* bar = b.bar;
        __builtin_amdgcn_s_waitcnt(0);
        unsigned nloc = b.st[0], nx = b.st[1];
        if (nloc == 0u) { xcd_barrier_complete(bar, b.x, nloc, nx); b.st[0] = nloc; b.st[1] = nx; }
        const unsigned old = xb_add(&bar[XB_XSUB(b.x)], 1u);
        const unsigned gen = old / nloc;
        if (old + 1u == (gen + 1u) * nloc) {
            __builtin_amdgcn_fence(__ATOMIC_RELEASE, "agent");
            asm volatile("s_waitcnt vmcnt(0)" ::: "memory");
            const unsigned og = xb_add(&bar[XB_TOP], 1u);
            const unsigned tg = og / nx;
            if (og + 1u == (tg + 1u) * nx) xb_add(&bar[XB_TOPGEN], 1u);
            else XB_SPIN(xb_ld(&bar[XB_TOPGEN]) == tg, bar);
            __builtin_amdgcn_fence(__ATOMIC_ACQUIRE, "agent");
            xb_add(&bar[XB_XGEN(b.x)], 1u);
            asm volatile("s_waitcnt vmcnt(0)" ::: "memory");
        } else {
            XB_SPIN(xb_ld(&bar[XB_XGEN(b.x)]) == gen, bar);
            __builtin_amdgcn_fence(__ATOMIC_ACQUIRE, "agent");
            asm volatile("s_waitcnt vmcnt(0)" ::: "memory");
        }
    }
    __syncthreads();
}

#ifndef PROBE_REP
#define PROBE_REP 0
#endif
#define REP(k) for (int rep_ = 0; rep_ < (((PROBE_REP >> (k)) & 1) ? 2 : 1); ++rep_)
constexpr int NPH = 18;
__global__ void __launch_bounds__(NTHREADS, 2) fwd_megakernel(Params p) {
    extern __shared__ __attribute__((aligned(16))) unsigned char lds[];
    cg::grid_group grid = cg::this_grid();
    LAS unsigned char* ldsl = (LAS unsigned char*)lds;
    const int lo = p.ph_lo, hi = p.ph_hi;
#ifdef ONLY_PH
#define IN(k) (((ONLY_PH >> (k)) & 1) && lo <= (k) && (k) < hi)
#else
#define IN(k) (lo <= (k) && (k) < hi)
#endif
#define SEAM(k) do { if (IN(k) && IN((k) + 1)) { if ((k) == 0) grid.sync(); else { XcdBarrier xb_; xb_.bar = (unsigned*)(p.ws + WS_BAR); xb_.x = xb_xcc_id(); xb_.st = (volatile LAS unsigned*)(ldsl + 135168); xcd_barrier(xb_); } } } while (0)
    unsigned char* ws = p.ws;
    const bf16_t* H = (const bf16_t*)(ws + WS_H);
    bf16_t* PROJ = (bf16_t*)(ws + WS_PROJ);
    const bf16_t* MIX = (const bf16_t*)(ws + WS_MIX);
    float* CTXRES = (float*)(ws + WS_CTXRES);
    const float* MOD = (const float*)(ws + WS_MOD);
    const int G = gridDim.x, c = blockIdx.x;
    if (threadIdx.x < 4) ((volatile LAS unsigned*)(ldsl + 135168))[threadIdx.x] = 0u;
    __syncthreads();
    (void)xcd_barrier_post((unsigned*)(ws + WS_BAR), (volatile LAS unsigned*)(ldsl + 135168));

    if (IN(0)) REP(0) { ada_phase(p, lds); wconv_phase(p, lds); }
    SEAM(0);
    if (IN(1)) REP(1) norm_phase(p, p.x, p.ctx, 0, 0, MTOT);
    SEAM(1);
    if (IN(2)) REP(2) { pg8::Gemm g{H, (const bf16_t*)(ws + WS_W_EVIN), MTOT, EV_NP, DM}; pg8::StaticOrder S; S.init(MTOT, EV_NP, G, c);
        pg8::EpiBf16 E{PROJ, EV_NP}; pg8::gemm_phase(ldsl, g, S, E); }
    SEAM(2);
    if (IN(3)) prep0_phase(p);
    SEAM(3);
    if (IN(4)) REP(4) gdn_pre_phase(p, lds);
    SEAM(4);
    if (IN(5)) { REP(20) { gdn_scan_phase(p, lds); __syncthreads(); } REP(5) { diffattn_phase(p, lds); __syncthreads(); } }
    SEAM(5);
    if (IN(6)) REP(6) gdn_post_phase(p);
    SEAM(6);
    if (IN(7)) REP(7) { pg8::Gemm g{MIX, (const bf16_t*)(ws + WS_W_EVOUT), MTOT, DM, DM}; pg8::StaticOrder S; S.init(MTOT, DM, G, c);
        pg8::EpiResid E{p.x, p.ctx, p.out, CTXRES, MOD, 2048}; pg8::gemm_phase(ldsl, g, S, E); }
    SEAM(7);
    if (IN(8)) norm_phase(p, p.out, CTXRES, 0, 1, MTOT);
    SEAM(8);
    if (IN(9)) REP(9) { pg8::Gemm g{H, (const bf16_t*)(ws + WS_W_FFIN), MTOT, 2 * FF, DM}; pg8::StaticOrder S; S.init(MTOT, 2 * FF, G, c);
        pg8::EpiSwiglu E{PROJ, FF}; pg8::gemm_phase(ldsl, g, S, E); }
    SEAM(9);
    if (IN(10)) { pg8::Gemm g{PROJ, (const bf16_t*)(ws + WS_W_FFOUT), MTOT, DM, FF}; pg8::StaticOrder S; S.init(MTOT, DM, G, c);
        pg8::EpiResid E{p.out, CTXRES, p.out, CTXRES, MOD, 5120}; pg8::gemm_phase(ldsl, g, S, E); }
    SEAM(10);
    if (IN(11)) norm_phase(p, p.out, CTXRES, 1, 0, MTOT);
    SEAM(11);
    if (IN(12)) { pg8::Gemm g{H, (const bf16_t*)(ws + WS_W_ODIN), MTOT, OD_N, DM}; pg8::StaticOrder S; S.init(MTOT, OD_N, G, c);
        pg8::EpiBf16 E{PROJ, OD_N}; pg8::gemm_phase(ldsl, g, S, E); }
    SEAM(12);
    if (IN(13)) { natten_phase(p, lds); if ((PROBE_REP >> 13) & 1) { __syncthreads(); natten_phase(p, lds); } }
    SEAM(13);
    if (IN(14)) { pg8::Gemm g{MIX, (const bf16_t*)(ws + WS_W_ODOUT), NLAT, DM, DM}; pg8::StaticOrder S; S.init(NLAT, DM, G, c);
        pg8::EpiResid E{p.out, CTXRES, p.out, CTXRES, MOD + 9 * 6144, 2048}; pg8::gemm_phase(ldsl, g, S, E); }
    SEAM(14);
    if (IN(15)) norm_phase(p, p.out, CTXRES, 1, 1, NLAT);
    SEAM(15);
    if (IN(16)) { pg8::Gemm g{H, (const bf16_t*)(ws + WS_W_FFIN) + (size_t)2 * FF * DM, NLAT, 2 * FF, DM}; pg8::StaticOrder S; S.init(NLAT, 2 * FF, G, c);
        pg8::EpiSwiglu E{PROJ, FF}; pg8::gemm_phase(ldsl, g, S, E); }
    SEAM(16);
    if (IN(17)) { pg8::Gemm g{PROJ, (const bf16_t*)(ws + WS_W_FFOUT) + (size_t)DM * FF, NLAT, DM, FF}; pg8::StaticOrder S; S.init(NLAT, DM, G, c);
        pg8::EpiResid E{p.out, CTXRES, p.out, CTXRES, MOD + 9 * 6144, 5120}; pg8::gemm_phase(ldsl, g, S, E); }
#undef IN
#undef SEAM
}

extern "C" void kernel_launch(void* const* d_in, const int* in_sizes, int n_in, void* d_out, int out_size, void* d_ws, size_t ws_size, hipStream_t stream) {
    static int grid = 0;
    if (grid == 0) {
        if (n_in != 23 || ws_size < WS_END) { fprintf(stderr, "kernel_launch: n_in %d ws %zu (need %zu)\n", n_in, ws_size, (size_t)WS_END); grid = -1; return; }
        int dev = 0, cus = 0, per_cu = 0;
        hipGetDevice(&dev); hipDeviceGetAttribute(&cus, hipDeviceAttributeMultiprocessorCount, dev);
        if (hipFuncSetAttribute((const void*)fwd_megakernel, hipFuncAttributeMaxDynamicSharedMemorySize, LDS_BYTES) != hipSuccess) { fprintf(stderr, "hipFuncSetAttribute failed\n"); grid = -1; return; }
        if (hipOccupancyMaxActiveBlocksPerMultiprocessor(&per_cu, (const void*)fwd_megakernel, NTHREADS, LDS_BYTES) != hipSuccess || per_cu < 1) per_cu = 1;
        (void)hipGetLastError();
        grid = cus * 1;
    }
    if (grid < 0) return;
    if (hipMemsetAsync((char*)d_ws + WS_BAR, 0, 16384, stream) != hipSuccess) { fprintf(stderr, "memset failed\n"); return; }
    Params p{};
    const float** pp = (const float**)&p;
    for (int i = 0; i < 23; ++i) pp[i] = (const float*)d_in[i];
    p.out = (float*)d_out; p.ws = (unsigned char*)d_ws;
#if N_LAUNCH_MODE == 1
    p.ph_lo = 0; p.ph_hi = NPH;
    void* args[] = {&p};
    hipError_t e = hipLaunchCooperativeKernel((void*)fwd_megakernel, dim3(grid), dim3(NTHREADS), args, LDS_BYTES, stream);
    if (e != hipSuccess) fprintf(stderr, "cooperative launch failed: %s (grid %d)\n", hipGetErrorString(e), grid);
#else
    for (int k = 0; k < NPH; ++k) { p.ph_lo = k; p.ph_hi = k + 1;
        hipLaunchKernelGGL(fwd_megakernel, dim3(grid), dim3(NTHREADS), LDS_BYTES, stream, p); }
#endif
}
```

```cpp
#include <hip/hip_runtime.h>
#include <hip/hip_cooperative_groups.h>
#include <cstdio>
#include <cstdint>
namespace cg = cooperative_groups;

#define LAS __attribute__((address_space(3)))
typedef unsigned short bf16_t;
typedef short bf16x8 __attribute__((ext_vector_type(8)));
typedef short s16x4 __attribute__((ext_vector_type(4)));
typedef float f32x4 __attribute__((ext_vector_type(4)));
typedef float f32x16 __attribute__((ext_vector_type(16)));
typedef unsigned u32x4 __attribute__((ext_vector_type(4)));
typedef unsigned u32x2 __attribute__((ext_vector_type(2)));

#ifndef N_LAUNCH_MODE
#define N_LAUNCH_MODE 1
#endif

constexpr int DM = 1024, NLAT = 65536, NCTX = 2048, MTOT = NLAT + NCTX, SEQ = 8192, CTXL = 256, FF = 2816;
constexpr int EV_N = 3600, EV_NP = 3840, OD_N = 3072;
constexpr int NCHUNKP = 64 * 132;
constexpr int NTHREADS = 512;
constexpr int LDS_BYTES = 135168 + 16;

constexpr size_t al256(size_t x) { return (x + 255) / 256 * 256; }
constexpr size_t WS_W_EVIN = 0;
constexpr size_t WS_W_EVOUT = WS_W_EVIN + al256((size_t)EV_NP * DM * 2);
constexpr size_t WS_W_ODIN = WS_W_EVOUT + al256((size_t)DM * DM * 2);
constexpr size_t WS_W_ODOUT = WS_W_ODIN + al256((size_t)OD_N * DM * 2);
constexpr size_t WS_W_FFIN = WS_W_ODOUT + al256((size_t)DM * DM * 2);
constexpr size_t WS_W_FFOUT = WS_W_FFIN + al256((size_t)2 * 2 * FF * DM * 2);
constexpr size_t WS_MOD = WS_W_FFOUT + al256((size_t)2 * DM * FF * 2);
constexpr size_t WS_H = WS_MOD + al256((size_t)2 * 9 * 6144 * 4);
constexpr size_t WS_PROJ = WS_H + al256((size_t)MTOT * DM * 2);
constexpr size_t WS_MIX = WS_PROJ + al256((size_t)MTOT * EV_NP * 2);
constexpr size_t WS_T = WS_MIX + al256((size_t)MTOT * DM * 2);
constexpr size_t WS_AQK = WS_T + al256((size_t)NCHUNKP * 4096 * 2);
constexpr size_t WS_GV = WS_AQK + al256((size_t)NCHUNKP * 4096 * 2);
constexpr size_t WS_BV = WS_GV + al256((size_t)NCHUNKP * 64 * 4);
constexpr size_t WS_EL = WS_BV + al256((size_t)NCHUNKP * 64 * 4);
constexpr size_t WS_GATES = WS_EL + al256((size_t)NCHUNKP * 64 * 4);
constexpr size_t WS_CTXRES = WS_GATES + al256((size_t)MTOT * 16 * 4);
constexpr size_t WS_BAR = WS_CTXRES + al256((size_t)NCTX * DM * 4);
constexpr size_t WS_END = WS_BAR + 16384;

struct Params {
    const float *x, *c, *ctx, *c_ctx, *ada_w, *ada_b, *norm_mix, *norm_ffn, *ffn_w_in, *ffn_w_out, *even_w_in, *even_w_out,
        *diff_qk_gain, *diff_lambda, *diff_subln, *gdn_conv, *gdn_a_log, *gdn_dt_bias, *gdn_norm, *odd_w_in, *odd_w_out, *na_qk_gain, *na_rpb;
    float* out; unsigned char* ws; int ph_lo, ph_hi;
};

__device__ __forceinline__ float bf2f(bf16_t b) { return __uint_as_float(((unsigned)b) << 16); }
__device__ __forceinline__ bf16_t f2bf(float f) { unsigned u = __float_as_uint(f); u += 0x7FFFu + ((u >> 16) & 1u); return (bf16_t)(u >> 16); }
__device__ __forceinline__ unsigned cvtpk(float lo, float hi) { unsigned r; asm volatile("v_cvt_pk_bf16_f32 %0, %1, %2" : "=v"(r) : "v"(lo), "v"(hi)); return r; }
__device__ __forceinline__ float siluf(float v) { return v / (1.f + __expf(-v)); }
__device__ __forceinline__ void unpack8(bf16x8 v, float* f) {
#pragma unroll
    for (int i = 0; i < 8; ++i) f[i] = bf2f((bf16_t)v[i]);
}
__device__ __forceinline__ bf16x8 pack8(const float* f) {
    u32x4 w = {cvtpk(f[0], f[1]), cvtpk(f[2], f[3]), cvtpk(f[4], f[5]), cvtpk(f[6], f[7])};
    return *reinterpret_cast<bf16x8*>(&w);
}

namespace pg8 {
constexpr int BM = 256, BK = 64, HALF = 128, HTB = HALF * BK * 2, STAGE_BYTES = 8 * HTB, NXCD = 8, WGM = 8;
__host__ __device__ __forceinline__ int lds_byte(int r, int c) { const int st = (r >> 4) * 2 + (c >> 5), rr = r & 15, cc = c & 31, ob = rr * 64 + cc * 2; return st * 1024 + (ob ^ (((ob >> 9) & 1) << 5)); }
__host__ __device__ __forceinline__ void stage_rc(int b, int& R, int& C) { const int st = b / 1024, sb = b % 1024, swz = sb ^ (((sb >> 9) & 1) << 5); R = (st >> 1) * 16 + swz / 64; C = (st & 1) * 32 + (swz % 64) / 2; }
__host__ __device__ __forceinline__ int perm32(int rho) { const int n = rho >> 4, i = rho & 15; return 8 * (i >> 2) + 4 * n + (i & 3); }
struct Unit { int pm, pn; };
struct Gemm { const bf16_t* A; const bf16_t* Bt; int M, N, K; };
struct StaticOrder {
    int nM, nN, nwg, G, c;
    __device__ void init(int M, int N, int G_, int c_) { nM = M / BM; nN = N / BM; nwg = nM * nN; G = G_; c = c_; }
    __device__ bool next(int i, Unit& u) const {
        const long L = (long)i * G + c; if (L >= nwg) return false;
        int wgid = (int)L; { const int q = nwg / NXCD, r = nwg % NXCD, xcd = wgid % NXCD, off = wgid / NXCD; wgid = (xcd < r ? xcd * (q + 1) : r * (q + 1) + (xcd - r) * q) + off; }
        const int nig = WGM * nN, gid = wgid / nig, fm = gid * WGM, gsz = (nM - fm) < WGM ? (nM - fm) : WGM;
        u.pm = fm + ((wgid % nig) % gsz); u.pn = (wgid % nig) / gsz; return true;
    }
};
struct EpiBf16 {
    static constexpr bool PERM = true;
    bf16_t* O; int ldc;
    __device__ __forceinline__ void operator()(const f32x4 (&acc)[2][2][4][2], const Unit& u, int wr, int wc, int fr, int fq) const {
        const int row0 = u.pm * BM + wr * 64 + fr; const int col0 = u.pn * BM + wc * 32 + 8 * fq;
#pragma unroll
        for (int ai = 0; ai < 2; ++ai)
#pragma unroll
            for (int m = 0; m < 4; ++m) { bf16_t* rowp = O + (size_t)(row0 + ai * HALF + m * 16) * ldc + col0;
#pragma unroll
                for (int bj = 0; bj < 2; ++bj) { const f32x4 v0 = acc[ai][bj][m][0], v1 = acc[ai][bj][m][1];
                    u32x4 w; w.x = cvtpk(v0[0], v0[1]); w.y = cvtpk(v0[2], v0[3]); w.z = cvtpk(v1[0], v1[1]); w.w = cvtpk(v1[2], v1[3]);
                    *(u32x4*)(rowp + bj * HALF) = w; } }
    }
};
struct EpiSwiglu {
    static constexpr bool PERM = true;
    bf16_t* O; int ldc;
    __device__ __forceinline__ void operator()(const f32x4 (&acc)[2][2][4][2], const Unit& u, int wr, int wc, int fr, int fq) const {
        const int row0 = u.pm * BM + wr * 64 + fr; const int col0 = u.pn * HALF + wc * 32 + 8 * fq;
#pragma unroll
        for (int ai = 0; ai < 2; ++ai)
#pragma unroll
            for (int m = 0; m < 4; ++m) { bf16_t* rowp = O + (size_t)(row0 + ai * HALF + m * 16) * ldc + col0;
                float o[8];
#pragma unroll
                for (int n = 0; n < 2; ++n)
#pragma unroll
                    for (int j = 0; j < 4; ++j) { const float g = acc[ai][0][m][n][j], up = acc[ai][1][m][n][j]; o[n * 4 + j] = g / (1.f + __expf(-g)) * up; }
                u32x4 w; w.x = cvtpk(o[0], o[1]); w.y = cvtpk(o[2], o[3]); w.z = cvtpk(o[4], o[5]); w.w = cvtpk(o[6], o[7]);
                *(u32x4*)rowp = w; }
    }
};
struct EpiResid {
    static constexpr bool PERM = false;
    const float* resLat; const float* resCtx; float* outLat; float* outCtx; const float* modl; int goff;
    __device__ __forceinline__ void operator()(const f32x4 (&acc)[2][2][4][2], const Unit& u, int wr, int wc, int fr, int fq) const {
        const int rowt = u.pm * BM; const bool lat = rowt < NLAT;
        const float* res = lat ? resLat + (size_t)rowt * DM : resCtx + (size_t)(rowt - NLAT) * DM;
        float* out = lat ? outLat + (size_t)rowt * DM : outCtx + (size_t)(rowt - NLAT) * DM;
        const float* gate = modl + (size_t)(lat ? (rowt >> 13) : 8) * 6144 + goff;
        const int row0 = wr * 64 + fr, col0 = u.pn * BM + wc * 32 + 4 * fq;
        f32x4 gv[2][2];
#pragma unroll
        for (int bj = 0; bj < 2; ++bj)
#pragma unroll
            for (int n = 0; n < 2; ++n) gv[bj][n] = *(const f32x4*)(gate + col0 + bj * HALF + n * 16);
#pragma unroll
        for (int ai = 0; ai < 2; ++ai)
#pragma unroll
            for (int m = 0; m < 4; ++m) { const size_t off = (size_t)(row0 + ai * HALF + m * 16) * DM + col0;
#pragma unroll
                for (int bj = 0; bj < 2; ++bj)
#pragma unroll
                    for (int n = 0; n < 2; ++n) { const f32x4 r = *(const f32x4*)(res + off + bj * HALF + n * 16);
                        *(f32x4*)(out + off + bj * HALF + n * 16) = r + gv[bj][n] * acc[ai][bj][m][n]; } }
    }
};

template <class Epi, class Sched>
__device__ __forceinline__ void gemm_phase(LAS unsigned char* lds, const Gemm g, const Sched& S, const Epi& E) {
    const int tid = threadIdx.x, wid = __builtin_amdgcn_readfirstlane(tid >> 6), lane = tid & 63, wr = wid >> 2, wc = wid & 3, fr = lane & 15, fq = lane >> 4;
    const int K = g.K, nt = K / BK;
    unsigned voffA[2], voffB[2];
#pragma unroll
    for (int i = 0; i < 2; ++i) { int R, C; stage_rc(tid * 16 + i * 8192, R, C); const int Rb = Epi::PERM ? ((R & ~31) + perm32(R & 31)) : R;
        voffA[i] = (unsigned)(R * K + C) * 2u; voffB[i] = (unsigned)(Rb * K + C) * 2u; }
    const size_t kstep = (size_t)(BK * 2);
    const size_t hstep = (size_t)HALF * K * 2;
    const size_t tstep = 2 * hstep;
    const unsigned ldsw = (unsigned)wid * 1024u;
    const int aoff = lds_byte(wr * 64 + fr, fq * 8), boff = lds_byte(wc * 32 + fr, fq * 8);
#define PG8_SA(b, h) (((b) * 2 + (h)) * HTB)
#define PG8_SB(b, h) ((4 + (b) * 2 + (h)) * HTB)
#define PG8_STAGE(bufoff, gbase, voff) do { _Pragma("unroll") for (int _i = 0; _i < 2; ++_i) \
        __builtin_amdgcn_global_load_lds((const unsigned*)((const char*)(gbase) + (voff)[_i]), (LAS unsigned*)(lds + (bufoff) + ldsw + _i * 8192), 16, 0, 0); } while (0)
#define PG8_LDA(dst, b, h) do { _Pragma("unroll") for (int m = 0; m < 4; ++m) _Pragma("unroll") for (int k = 0; k < 2; ++k) dst[m][k] = *(const LAS bf16x8*)(lds + PG8_SA(b, h) + aoff + m * 2048 + k * 1024); } while (0)
#define PG8_LDB(dst, b, h) do { _Pragma("unroll") for (int n = 0; n < 2; ++n) _Pragma("unroll") for (int k = 0; k < 2; ++k) dst[n][k] = *(const LAS bf16x8*)(lds + PG8_SB(b, h) + boff + n * 2048 + k * 1024); } while (0)
#define PG8_MMA(ai, bj, At, Bt) do { __builtin_amdgcn_s_setprio(1); _Pragma("unroll") for (int m = 0; m < 4; ++m) _Pragma("unroll") for (int n = 0; n < 2; ++n) _Pragma("unroll") for (int k = 0; k < 2; ++k) \
        acc[ai][bj][m][n] = __builtin_amdgcn_mfma_f32_16x16x32_bf16(Bt[n][k], At[m][k], acc[ai][bj][m][n], 0, 0, 0); __builtin_amdgcn_s_setprio(0); } while (0)
#define PG8_WAIT_V(n) asm volatile("s_waitcnt vmcnt(" #n ")" ::: "memory")
#define PG8_WAIT_L(n) asm volatile("s_waitcnt lgkmcnt(" #n ")" ::: "memory")
#define PG8_BAR __builtin_amdgcn_s_barrier()
#define PG8_SCHED __builtin_amdgcn_sched_barrier(0)
    Unit cur, nxt; int ui = 0;
    if (!S.next(0, cur)) return;
    f32x4 acc[2][2][4][2];
#pragma unroll
    for (int a = 0; a < 2; ++a)
#pragma unroll
        for (int b = 0; b < 2; ++b)
#pragma unroll
            for (int m = 0; m < 4; ++m)
#pragma unroll
                for (int n = 0; n < 2; ++n) acc[a][b][m][n] = (f32x4){0.f, 0.f, 0.f, 0.f};
    bf16x8 At[4][2], B0[2][2], B1[2][2];
    const char* cA = (const char*)g.A + (size_t)cur.pm * tstep; const char* cB = (const char*)g.Bt + (size_t)cur.pn * tstep;
    PG8_STAGE(PG8_SB(0, 0), cB, voffB); PG8_STAGE(PG8_SA(0, 0), cA, voffA); PG8_STAGE(PG8_SB(0, 1), cB + hstep, voffB); PG8_STAGE(PG8_SA(0, 1), cA + hstep, voffA);
    if (wr == 1) PG8_BAR;
    PG8_WAIT_V(4); PG8_BAR;
    PG8_STAGE(PG8_SB(1, 0), cB + kstep, voffB); PG8_STAGE(PG8_SA(1, 0), cA + kstep, voffA); PG8_STAGE(PG8_SB(1, 1), cB + hstep + kstep, voffB);
    PG8_WAIT_V(6); PG8_BAR;
    for (;;) {
        const bool has_next = S.next(ui + 1, nxt);
        const char* nA = has_next ? (const char*)g.A + (size_t)nxt.pm * tstep : cA; const char* nB = has_next ? (const char*)g.Bt + (size_t)nxt.pn * tstep : cB;
        for (int t = 0; t < nt; t += 2) {
            const bool last = (t == nt - 2);
            const char* a1 = cA + (size_t)(t + 1) * kstep;
            const char* a2 = last ? nA : cA + (size_t)(t + 2) * kstep; const char* b2 = last ? nB : cB + (size_t)(t + 2) * kstep;
            const char* a3 = a2 + kstep; const char* b3 = b2 + kstep;
            PG8_LDB(B0, 0, 0); PG8_SCHED; PG8_LDA(At, 0, 0); PG8_STAGE(PG8_SA(1, 1), a1 + hstep, voffA);
            PG8_WAIT_L(8); PG8_BAR; PG8_WAIT_L(0); PG8_MMA(0, 0, At, B0); PG8_BAR; PG8_SCHED;
            PG8_LDB(B1, 0, 1); PG8_STAGE(PG8_SB(0, 0), b2, voffB);
            PG8_BAR; PG8_WAIT_L(0); PG8_MMA(0, 1, At, B1); PG8_BAR;
            PG8_LDA(At, 0, 1); PG8_STAGE(PG8_SA(0, 0), a2, voffA);
            PG8_BAR; PG8_WAIT_L(0); PG8_MMA(1, 0, At, B0); PG8_BAR; PG8_SCHED;
            PG8_STAGE(PG8_SB(0, 1), b2 + hstep, voffB);
            PG8_WAIT_V(6); PG8_BAR; PG8_MMA(1, 1, At, B1); PG8_BAR;
            PG8_LDB(B0, 1, 0); PG8_SCHED; PG8_LDA(At, 1, 0); PG8_STAGE(PG8_SA(0, 1), a2 + hstep, voffA);
            PG8_WAIT_L(8); PG8_BAR; PG8_WAIT_L(0); PG8_MMA(0, 0, At, B0); PG8_BAR; PG8_SCHED;
            PG8_LDB(B1, 1, 1); PG8_STAGE(PG8_SB(1, 0), b3, voffB);
            PG8_BAR; PG8_WAIT_L(0); PG8_MMA(0, 1, At, B1); PG8_BAR;
            PG8_LDA(At, 1, 1); PG8_STAGE(PG8_SA(1, 0), a3, voffA);
            PG8_BAR; PG8_WAIT_L(0); PG8_MMA(1, 0, At, B0); PG8_BAR; PG8_SCHED;
            PG8_STAGE(PG8_SB(1, 1), b3 + hstep, voffB);
            PG8_WAIT_V(6); PG8_BAR; PG8_MMA(1, 1, At, B1); PG8_BAR;
        }
        E(acc, cur, wr, wc, fr, fq);
        if (!has_next) break;
#pragma unroll
        for (int a = 0; a < 2; ++a)
#pragma unroll
            for (int b = 0; b < 2; ++b)
#pragma unroll
                for (int m = 0; m < 4; ++m)
#pragma unroll
                    for (int n = 0; n < 2; ++n) acc[a][b][m][n] = (f32x4){0.f, 0.f, 0.f, 0.f};
        cur = nxt; cA = nA; cB = nB; ++ui;
    }
    PG8_WAIT_V(0);
    if (wr == 0) PG8_BAR;
    PG8_BAR;
#undef PG8_SA
#undef PG8_SB
#undef PG8_STAGE
#undef PG8_LDA
#undef PG8_LDB
#undef PG8_MMA
#undef PG8_WAIT_V
#undef PG8_WAIT_L
#undef PG8_BAR
#undef PG8_SCHED
}
}

#define KSWZ(row, colB) ((row) * 256 + ((colB) ^ (((row) & 7) << 4)))
#define SBAR() __builtin_amdgcn_sched_barrier(0)
__device__ __forceinline__ int crow(int r, int hi) { return (r & 3) + 8 * (r >> 2) + 4 * hi; }
__device__ __forceinline__ int v_st(int k, int c) { const int kk = (k & ~0xC) | ((k & 4) << 1) | ((k & 8) >> 1); return ((kk >> 3) * 4 + (c >> 5)) * 512 + ((kk & 7) * 32 + (c & 31)) * 2; }
__device__ __forceinline__ int v_rd_base(int lane) { return ((lane & 3) << 3) | (((lane >> 2) & 3) << 6) | (((lane >> 4) & 1) << 5) | (((lane >> 5) & 1) << 8); }
constexpr int v_rd_off(int d0, int ks, int half) { return d0 * 512 + ks * 4096 + half * 2048; }
template <int OFF> __device__ __forceinline__ s16x4 tr_read(int vb) {
    s16x4 r; asm volatile("ds_read_b64_tr_b16 %0, %1 offset:%2" : "=&v"(r) : "v"(vb), "i"(OFF) : "memory"); return r;
}
template <int D0> __device__ __forceinline__ void pv_one(f32x16& od, int vb, bf16x8 pa0, bf16x8 pa1, bf16x8 pa2, bf16x8 pa3) {
    const s16x4 l0 = tr_read<v_rd_off(D0, 0, 0)>(vb), h0 = tr_read<v_rd_off(D0, 0, 1)>(vb), l1 = tr_read<v_rd_off(D0, 1, 0)>(vb), h1 = tr_read<v_rd_off(D0, 1, 1)>(vb);
    const s16x4 l2 = tr_read<v_rd_off(D0, 2, 0)>(vb), h2 = tr_read<v_rd_off(D0, 2, 1)>(vb), l3 = tr_read<v_rd_off(D0, 3, 0)>(vb), h3 = tr_read<v_rd_off(D0, 3, 1)>(vb);
    asm volatile("s_waitcnt lgkmcnt(0)" ::: "memory"); SBAR();
#define PK(L, H) (bf16x8){L[0], L[1], L[2], L[3], H[0], H[1], H[2], H[3]}
    od = __builtin_amdgcn_mfma_f32_32x32x16_bf16(pa0, PK(l0, h0), od, 0, 0, 0);
    od = __builtin_amdgcn_mfma_f32_32x32x16_bf16(pa1, PK(l1, h1), od, 0, 0, 0);
    od = __builtin_amdgcn_mfma_f32_32x32x16_bf16(pa2, PK(l2, h2), od, 0, 0, 0);
    od = __builtin_amdgcn_mfma_f32_32x32x16_bf16(pa3, PK(l3, h3), od, 0, 0, 0);
#undef PK
}
__device__ __forceinline__ void pv_d0(f32x16* o, int vb, bf16x8 pa0, bf16x8 pa1, bf16x8 pa2, bf16x8 pa3) {
    pv_one<0>(o[0], vb, pa0, pa1, pa2, pa3); pv_one<1>(o[1], vb, pa0, pa1, pa2, pa3); pv_one<2>(o[2], vb, pa0, pa1, pa2, pa3); pv_one<3>(o[3], vb, pa0, pa1, pa2, pa3);
}
#define PK4(P, BASE, OUT) do { unsigned a0 = cvtpk(P[BASE + 0], P[BASE + 1]), a1 = cvtpk(P[BASE + 2], P[BASE + 3]);   \
    unsigned b0 = cvtpk(P[BASE + 4], P[BASE + 5]), b1 = cvtpk(P[BASE + 6], P[BASE + 7]);                              \
    auto r0 = __builtin_amdgcn_permlane32_swap(a0, b0, false, false); auto r1 = __builtin_amdgcn_permlane32_swap(a1, b1, false, false); \
    u32x4 w = {r0[0], r1[0], r0[1], r1[1]}; OUT = *reinterpret_cast<bf16x8*>(&w); } while (0)
__device__ __forceinline__ float halfswap_add(float v) {
    auto rr = __builtin_amdgcn_permlane32_swap(__float_as_uint(v), __float_as_uint(v), false, false);
    return __uint_as_float(rr[0]) + __uint_as_float(rr[1]);
}

__device__ __forceinline__ void ada_phase(const Params& p, unsigned char* lds) {
    float* sc = (float*)lds;
    float* red = (float*)(lds + 40960);
    float* mod = (float*)(p.ws + WS_MOD);
    const int tid = threadIdx.x;
    for (int j = blockIdx.x; j < 192; j += gridDim.x) {
        const int l = j / 96, n0 = (j % 96) * 64;
        for (int i = tid; i < 9 * 1024; i += NTHREADS) { const int r = i >> 10, k = i & 1023; const float v = r < 8 ? p.c[r * 1024 + k] : p.c_ctx[k]; sc[i] = v / (1.f + expf(-v)); }
        __syncthreads();
        const int col = tid & 63, ks = tid >> 6;
        float acc[9];
#pragma unroll
        for (int r = 0; r < 9; ++r) acc[r] = 0.f;
        const float* wp = p.ada_w + ((size_t)l * 1024 + ks * 128) * 6144 + n0 + col;
#pragma unroll 8
        for (int kk = 0; kk < 128; ++kk) { const float w = wp[(size_t)kk * 6144];
#pragma unroll
            for (int r = 0; r < 9; ++r) acc[r] += sc[r * 1024 + ks * 128 + kk] * w; }
#pragma unroll
        for (int r = 0; r < 9; ++r) red[(ks * 9 + r) * 64 + col] = acc[r];
        __syncthreads();
        for (int i = tid; i < 576; i += NTHREADS) { const int r = i >> 6, cc = i & 63; float s = p.ada_b[l * 6144 + n0 + cc];
            for (int k2 = 0; k2 < 8; ++k2) s += red[(k2 * 9 + r) * 64 + cc];
            mod[(size_t)(l * 9 + r) * 6144 + n0 + cc] = s; }
        __syncthreads();
    }
}
__device__ __forceinline__ void wconv_phase(const Params& p, unsigned char* lds) {
    float* tl = (float*)lds;
    const int tid = threadIdx.x;
    const int T0 = 16 * 60, T1 = T0 + 16 * 16, T2 = T1 + 16 * 48, T3 = T2 + 16 * 16, T4 = T3 + 16 * 88, T5 = T4 + 16 * 88, T6 = T5 + 44 * 16, T7 = T6 + 44 * 16;
    for (int t = blockIdx.x; t < T7; t += gridDim.x) {
        const float* src; bf16_t* dst; int K, N, NP, mode = 0, tt;
        if (t < T0) { src = p.even_w_in; dst = (bf16_t*)(p.ws + WS_W_EVIN); K = 1024; N = EV_N; NP = EV_NP; tt = t; }
        else if (t < T1) { src = p.even_w_out; dst = (bf16_t*)(p.ws + WS_W_EVOUT); K = 1024; N = 1024; NP = 1024; tt = t - T0; }
        else if (t < T2) { src = p.odd_w_in; dst = (bf16_t*)(p.ws + WS_W_ODIN); K = 1024; N = OD_N; NP = OD_N; tt = t - T1; }
        else if (t < T3) { src = p.odd_w_out; dst = (bf16_t*)(p.ws + WS_W_ODOUT); K = 1024; N = 1024; NP = 1024; tt = t - T2; }
        else if (t < T4) { src = p.ffn_w_in; dst = (bf16_t*)(p.ws + WS_W_FFIN); K = 1024; N = 2 * FF; NP = 2 * FF; mode = 1; tt = t - T3; }
        else if (t < T5) { src = p.ffn_w_in + (size_t)1024 * 2 * FF; dst = (bf16_t*)(p.ws + WS_W_FFIN) + (size_t)2 * FF * 1024; K = 1024; N = 2 * FF; NP = 2 * FF; mode = 1; tt = t - T4; }
        else if (t < T6) { src = p.ffn_w_out; dst = (bf16_t*)(p.ws + WS_W_FFOUT); K = FF; N = 1024; NP = 1024; tt = t - T5; }
        else { src = p.ffn_w_out + (size_t)FF * 1024; dst = (bf16_t*)(p.ws + WS_W_FFOUT) + (size_t)1024 * FF; K = FF; N = 1024; NP = 1024; tt = t - T6; }
        const int nnt = NP / 64; const int k0 = (tt / nnt) * 64, n0 = (tt % nnt) * 64;
        int sn0;
        if (mode == 1) { const int tb = n0 >> 8, bj = (n0 >> 7) & 1, i0 = n0 & 127; sn0 = bj * FF + tb * 128 + i0; } else sn0 = n0;
        for (int e = tid; e < 4096; e += NTHREADS) { const int kk = e >> 6, nn = e & 63; const int sn = sn0 + nn;
            tl[kk * 65 + nn] = (sn < N) ? src[(size_t)(k0 + kk) * N + sn] : 0.f; }
        __syncthreads();
        for (int e = tid; e < 2048; e += NTHREADS) { const int nn = e >> 5, k2 = (e & 31) * 2;
            *(unsigned*)(dst + (size_t)(n0 + nn) * K + k0 + k2) = cvtpk(tl[k2 * 65 + nn], tl[(k2 + 1) * 65 + nn]); }
        __syncthreads();
    }
}

__device__ __forceinline__ void norm_phase(const Params& p, const float* xlat, const float* xctx, int l, int which, int nrows) {
    const int lane = threadIdx.x & 63, wid = threadIdx.x >> 6;
    bf16_t* h = (bf16_t*)(p.ws + WS_H);
    const float* mod = (const float*)(p.ws + WS_MOD) + (size_t)l * 9 * 6144;
    const float* gain = (which ? p.norm_ffn : p.norm_mix) + l * 1024;
    const int shoff = which ? 3072 : 0, scoff = which ? 4096 : 1024;
    for (int row = blockIdx.x * 8 + wid; row < nrows; row += gridDim.x * 8) {
        const bool lat = row < NLAT;
        const float* src = lat ? xlat + (size_t)row * DM : xctx + (size_t)(row - NLAT) * DM;
        const float* mr = mod + (size_t)(lat ? (row >> 13) : 8) * 6144;
        f32x4 v[4]; float ss = 0.f;
#pragma unroll
        for (int i = 0; i < 4; ++i) { v[i] = *(const f32x4*)(src + lane * 4 + 256 * i); ss += v[i][0] * v[i][0] + v[i][1] * v[i][1] + v[i][2] * v[i][2] + v[i][3] * v[i][3]; }
#pragma unroll
        for (int o = 1; o < 64; o <<= 1) ss += __shfl_xor(ss, o);
        const float rstd = rsqrtf(ss * (1.f / 1024.f) + 1e-6f);
#pragma unroll
        for (int i = 0; i < 4; ++i) { const int c0 = lane * 4 + 256 * i;
            const f32x4 g = *(const f32x4*)(gain + c0), s1 = *(const f32x4*)(mr + scoff + c0), sh = *(const f32x4*)(mr + shoff + c0);
            float y[4];
#pragma unroll
            for (int j = 0; j < 4; ++j) y[j] = v[i][j] * rstd * g[j] * (1.f + s1[j]) + sh[j];
            u32x2 w; w.x = cvtpk(y[0], y[1]); w.y = cvtpk(y[2], y[3]);
            *(u32x2*)(h + (size_t)row * DM + c0) = w; }
    }
}

__device__ __forceinline__ void prep0_phase(const Params& p) {
    const int lane = threadIdx.x & 63, wid = threadIdx.x >> 6;
    bf16_t* proj = (bf16_t*)(p.ws + WS_PROJ);
    bf16_t* qkvp = (bf16_t*)p.out;
    float* gbuf = (float*)(p.ws + WS_GATES);
    const int dsub = (lane & 7) * 8;
    const bool isrow = (lane & 7) < 4;
    float inv[4];
#pragma unroll
    for (int i = 0; i < 4; ++i) { const int pp = (lane & 7) * 4 + i; inv[i] = powf(10000.f, -(float)(pp & 15) / 16.f); }
    for (int row = blockIdx.x * 8 + wid; row < MTOT; row += gridDim.x * 8) {
        const bool lat = row < NLAT; const int t = lat ? (row & 8191) : ((row - NLAT) & 255); const int len = lat ? SEQ : CTXL;
        bf16_t* P = proj + (size_t)row * EV_NP;
        float cs[4], sn[4];
        if (lat) {
#pragma unroll
            for (int i = 0; i < 4; ++i) { const float ang = (isrow ? (float)(t >> 6) : (float)(t & 63)) * inv[i]; cs[i] = cosf(ang); sn[i] = sinf(ang); }
        } else {
#pragma unroll
            for (int i = 0; i < 4; ++i) { cs[i] = 1.f; sn[i] = 0.f; }
        }
#pragma unroll
        for (int which = 0; which < 2; ++which) {
            float v[8]; unpack8(*(const bf16x8*)(P + which * 512 + lane * 8), v);
            float ss = 0.f;
#pragma unroll
            for (int i = 0; i < 8; ++i) ss += v[i] * v[i];
            ss += __shfl_xor(ss, 1); ss += __shfl_xor(ss, 2); ss += __shfl_xor(ss, 4);
            const float rstd = rsqrtf(ss * (1.f / 64.f) + 1e-6f);
#pragma unroll
            for (int i = 0; i < 8; ++i) v[i] = v[i] * rstd * p.diff_qk_gain[which * 64 + dsub + i];
#pragma unroll
            for (int i = 0; i < 4; ++i) { const float x0 = v[2 * i], x1 = v[2 * i + 1]; v[2 * i] = x0 * cs[i] - x1 * sn[i]; v[2 * i + 1] = x0 * sn[i] + x1 * cs[i]; }
            if (which == 0) {
#pragma unroll
                for (int i = 0; i < 8; ++i) v[i] *= 0.125f * 1.4426950408889634f;
            }
            *(bf16x8*)(P + which * 512 + lane * 8) = pack8(v);
        }
#pragma unroll
        for (int i = 0; i < 3; ++i) {
            const int c0 = i * 512 + lane * 8;
            float y[8];
#pragma unroll
            for (int e = 0; e < 8; ++e) y[e] = 0.f;
#pragma unroll
            for (int j = 0; j < 5; ++j) { const int tt = t + j - 2;
                if (tt >= 0 && tt < len) { float xv[8]; unpack8(*(const bf16x8*)(proj + (size_t)(row + j - 2) * EV_NP + 1536 + c0), xv);
                    const f32x4 w0 = *(const f32x4*)(p.gdn_conv + j * 1536 + c0), w1 = *(const f32x4*)(p.gdn_conv + j * 1536 + c0 + 4);
#pragma unroll
                    for (int e = 0; e < 4; ++e) { y[e] += w0[e] * xv[e]; y[4 + e] += w1[e] * xv[4 + e]; } } }
#pragma unroll
            for (int e = 0; e < 8; ++e) y[e] = y[e] / (1.f + expf(-y[e]));
            if (i < 2) { float ss = 0.f;
#pragma unroll
                for (int e = 0; e < 8; ++e) ss += y[e] * y[e];
                ss += __shfl_xor(ss, 1); ss += __shfl_xor(ss, 2); ss += __shfl_xor(ss, 4); ss += __shfl_xor(ss, 8);
                const float s = rsqrtf(ss + 1e-6f) * (i == 0 ? 0.08838834764831845f : 1.f);
#pragma unroll
                for (int e = 0; e < 8; ++e) y[e] *= s; }
            *(bf16x8*)(qkvp + (size_t)row * 1536 + c0) = pack8(y);
        }
        if (lane < 16) { const float gv = bf2f(P[3584 + lane]); float o;
            if (lane < 8) o = 1.f / (1.f + expf(-gv));
            else { const float z = gv + p.gdn_dt_bias[lane - 8]; const float sp = z > 20.f ? z : log1pf(expf(z)); o = -expf(p.gdn_a_log[lane - 8]) * sp; }
            gbuf[(size_t)row * 16 + lane] = o; }
    }
}

__device__ __forceinline__ int gdn_row(int b, int pc, int tau, int dir) {
    const int tt = dir ? 63 - tau : tau;
    return pc < 4 ? NLAT + b * CTXL + pc * 64 + tt : b * SEQ + (pc - 4) * 64 + tt;
}
__device__ __forceinline__ void gdn_pre_phase(const Params& p, unsigned char* lds) {
    const int lane = threadIdx.x & 63, wid = threadIdx.x >> 6;
    float* Lw = (float*)(lds + wid * 16896);
    float* gs = Lw + 4096; float* bs = gs + 64;
    const bf16_t* qkvp = (const bf16_t*)p.out;
    const float* gbuf = (const float*)(p.ws + WS_GATES);
    bf16_t* Tb = (bf16_t*)(p.ws + WS_T); bf16_t* Ab = (bf16_t*)(p.ws + WS_AQK);
    float* gv = (float*)(p.ws + WS_GV); float* bv = (float*)(p.ws + WS_BV);
    const int lane0 = lane;
    for (int cp = blockIdx.x * 8 + wid; cp < NCHUNKP; cp += gridDim.x * 8) {
        int lane = lane0; asm volatile("" : "+v"(lane));
        const int r32 = lane & 31, hi = lane >> 5;
        const int pc = cp % 132, ch = cp / 132, dir = ch & 1, h = (ch >> 1) & 3, b = ch >> 3;
        { const int R = gdn_row(b, pc, lane, dir);
          float g = gbuf[(size_t)R * 16 + 8 + dir * 4 + h]; const float be = gbuf[(size_t)R * 16 + dir * 4 + h];
#pragma unroll
          for (int o = 1; o < 64; o <<= 1) { const float t = __shfl_up(g, o); if (lane >= o) g += t; }
          gs[lane] = g; bs[lane] = be; const float gl_ = __shfl(g, 63); gv[(size_t)cp * 64 + lane] = expf(g); bv[(size_t)cp * 64 + lane] = be; ((float*)(p.ws + WS_EL))[(size_t)cp * 64 + lane] = expf(gl_ - g); }
        bf16x8 kf[2][8];
#pragma unroll
        for (int mi = 0; mi < 2; ++mi) { const size_t R = (size_t)gdn_row(b, pc, 32 * mi + r32, dir);
#pragma unroll
            for (int d0 = 0; d0 < 8; ++d0) kf[mi][d0] = *(const bf16x8*)(qkvp + R * 1536 + 512 + h * 128 + d0 * 16 + hi * 8); }
        bf16_t* Ao = Ab + (size_t)cp * 4096;
#pragma unroll
        for (int mi = 0; mi < 2; ++mi) {
            bf16x8 qf[8];
            { const size_t R = (size_t)gdn_row(b, pc, 32 * mi + r32, dir);
#pragma unroll
              for (int d0 = 0; d0 < 8; ++d0) qf[d0] = *(const bf16x8*)(qkvp + R * 1536 + h * 128 + d0 * 16 + hi * 8); }
#pragma unroll
            for (int ni = 0; ni <= mi; ++ni) {
                f32x16 ckk = {}, cqk = {};
#pragma unroll
                for (int d0 = 0; d0 < 8; ++d0) { ckk = __builtin_amdgcn_mfma_f32_32x32x16_bf16(kf[mi][d0], kf[ni][d0], ckk, 0, 0, 0);
                                                 cqk = __builtin_amdgcn_mfma_f32_32x32x16_bf16(qf[d0], kf[ni][d0], cqk, 0, 0, 0); }
                const int sg = 32 * ni + r32; const float gsg = gs[sg];
#pragma unroll
                for (int r = 0; r < 16; ++r) { const int tau = 32 * mi + crow(r, hi);
                    const float dec = tau >= sg ? expf(gs[tau] - gsg) : 0.f;
                    Lw[tau * 64 + sg] = tau > sg ? bs[tau] * dec * ckk[r] : 0.f;
                    Ao[tau * 64 + sg] = f2bf(cqk[r] * dec); }
                asm volatile("" ::: "memory");
            }
        }
#pragma unroll
        for (int r = 0; r < 16; ++r) Ao[crow(r, hi) * 64 + 32 + r32] = 0;
        float Tc[64];
#pragma unroll
        for (int i = 0; i < 64; ++i) { float a = (i == lane) ? 1.f : 0.f;
#pragma unroll
            for (int j = 0; j < i; ++j) a -= Lw[i * 64 + j] * Tc[j];
            Tc[i] = a; asm volatile("" ::: "memory"); }
        bf16_t* To = Tb + (size_t)cp * 4096;
#pragma unroll
        for (int i = 0; i < 64; ++i) To[i * 64 + lane] = f2bf(Tc[i]);
    }
}

constexpr int G_KV = 0, G_QA = 16384, G_TT = 32768, G_AQ = G_TT + 9216, G_RT = G_AQ + 9216, G_UT = G_RT + 4608, G_UP = G_UT + 4608,
              G_ST = G_UP + 4608, G_VS = G_ST + 8704, G_GS = G_VS + 4096, G_BS = G_GS + 256, G_EL = G_BS + 256, G_END = G_EL + 256;
__device__ __forceinline__ void gdn_scan_phase(const Params& p, unsigned char* lds) {
    const int tid = threadIdx.x, lane0 = tid & 63, wid = tid >> 6;
    const bf16_t* qkvp = (const bf16_t*)p.out;
    const bf16_t* Tb = (const bf16_t*)(p.ws + WS_T); const bf16_t* Ab = (const bf16_t*)(p.ws + WS_AQK);
    const float* gv = (const float*)(p.ws + WS_GV); const float* bv = (const float*)(p.ws + WS_BV);
    bf16_t* obuf = (bf16_t*)(p.ws + WS_H);
    const float* gsl = (const float*)(lds + G_GS); const float* bsl = (const float*)(lds + G_BS); const float* esl = (const float*)(lds + G_EL);
    const int sr = tid >> 4, sc = (tid & 15) * 8;
    for (int wi = blockIdx.x; wi < 256; wi += gridDim.x) {
        const int chain = wi >> 2, cs = wi & 3, b = chain >> 3, h = (chain >> 1) & 3, dir = chain & 1;
        f32x16 Sacc = {};
        for (int i = tid; i < 8704 / 4; i += NTHREADS) ((unsigned*)(lds + G_ST))[i] = 0u;
        bf16x8 sk0, sk1, sq0, sq1, sT, sA, sV; float sg = 0.f;
#define GLOAD(step) do { const int pc_ = dir == 0 ? (step) : ((step) < 4 ? 3 - (step) : 4 + 127 - ((step) - 4)); \
        const size_t cp_ = (size_t)chain * 132 + pc_; \
        const size_t R0_ = (size_t)gdn_row(b, pc_, sr, dir), R1_ = (size_t)gdn_row(b, pc_, 32 + sr, dir); \
        sk0 = *(const bf16x8*)(qkvp + R0_ * 1536 + 512 + h * 128 + sc); sk1 = *(const bf16x8*)(qkvp + R1_ * 1536 + 512 + h * 128 + sc); \
        sq0 = *(const bf16x8*)(qkvp + R0_ * 1536 + h * 128 + sc); sq1 = *(const bf16x8*)(qkvp + R1_ * 1536 + h * 128 + sc); \
        sT = *(const bf16x8*)(Tb + cp_ * 4096 + tid * 8); sA = *(const bf16x8*)(Ab + cp_ * 4096 + tid * 8); \
        if (tid < 256) { const size_t Rv_ = (size_t)gdn_row(b, pc_, tid >> 2, dir); sV = *(const bf16x8*)(qkvp + Rv_ * 1536 + 1024 + h * 128 + cs * 32 + (tid & 3) * 8); } \
        if (tid < 64) sg = gv[cp_ * 64 + tid]; else if (tid < 128) sg = bv[cp_ * 64 + tid - 64]; else if (tid < 192) sg = ((const float*)(p.ws + WS_EL))[cp_ * 64 + tid - 128]; } while (0)
#define GWRITE() do { *(bf16x8*)(lds + G_KV + v_st(sr, sc)) = sk0; *(bf16x8*)(lds + G_KV + v_st(32 + sr, sc)) = sk1; \
        *(bf16x8*)(lds + G_QA + KSWZ(sr, sc * 2)) = sq0; *(bf16x8*)(lds + G_QA + KSWZ(32 + sr, sc * 2)) = sq1; \
        *(bf16x8*)(lds + G_TT + (tid >> 3) * 144 + (tid & 7) * 16) = sT; *(bf16x8*)(lds + G_AQ + (tid >> 3) * 144 + (tid & 7) * 16) = sA; \
        if (tid < 256) *(bf16x8*)(lds + G_VS + (tid >> 2) * 64 + (tid & 3) * 16) = sV; \
        if (tid < 192) ((float*)(lds + G_GS))[tid] = sg; } while (0)
        GLOAD(0);
        for (int step = 0; step < 132; ++step) {
            GWRITE();
            __syncthreads();
            if (step + 1 < 132) GLOAD(step + 1);
            int lane = lane0; asm volatile("" : "+v"(lane));
            const int r32 = lane & 31, hi = lane >> 5;
            const int vb0 = (int)(uintptr_t)(lds + G_KV) + v_rd_base(lane);
            const int pc = dir == 0 ? step : (step < 4 ? 3 - step : 4 + 127 - (step - 4));
            f32x16 acc = {};
            const int mi = wid & 1;
            if (wid < 4) {
                f32x16 acc2 = {};
                if (wid < 2) {
#pragma unroll
                    for (int d0 = 0; d0 < 8; d0 += 2) {
                        const bf16x8 a0 = *(const bf16x8*)(lds + G_KV + v_st(32 * mi + r32, d0 * 16 + hi * 8)), a1 = *(const bf16x8*)(lds + G_KV + v_st(32 * mi + r32, d0 * 16 + 16 + hi * 8));
                        const bf16x8 b0 = *(const bf16x8*)(lds + G_ST + r32 * 272 + (d0 * 16 + hi * 8) * 2), b1 = *(const bf16x8*)(lds + G_ST + r32 * 272 + (d0 * 16 + 16 + hi * 8) * 2);
                        acc = __builtin_amdgcn_mfma_f32_32x32x16_bf16(a0, b0, acc, 0, 0, 0);
                        acc2 = __builtin_amdgcn_mfma_f32_32x32x16_bf16(a1, b1, acc2, 0, 0, 0); }
                } else {
#pragma unroll
                    for (int d0 = 0; d0 < 8; d0 += 2) {
                        const bf16x8 a0 = *(const bf16x8*)(lds + G_QA + KSWZ(32 * mi + r32, (d0 * 16 + hi * 8) * 2)), a1 = *(const bf16x8*)(lds + G_QA + KSWZ(32 * mi + r32, (d0 * 16 + 16 + hi * 8) * 2));
                        const bf16x8 b0 = *(const bf16x8*)(lds + G_ST + r32 * 272 + (d0 * 16 + hi * 8) * 2), b1 = *(const bf16x8*)(lds + G_ST + r32 * 272 + (d0 * 16 + 16 + hi * 8) * 2);
                        acc = __builtin_amdgcn_mfma_f32_32x32x16_bf16(a0, b0, acc, 0, 0, 0);
                        acc2 = __builtin_amdgcn_mfma_f32_32x32x16_bf16(a1, b1, acc2, 0, 0, 0); }
                }
#pragma unroll
                for (int r = 0; r < 16; ++r) acc[r] += acc2[r];
                if (wid < 2) {
#pragma unroll
                    for (int g4 = 0; g4 < 4; ++g4) { float rv[4];
#pragma unroll
                        for (int j = 0; j < 4; ++j) { const int tau = 32 * mi + 8 * g4 + 4 * hi + j;
                            const float vv = bf2f(*(const bf16_t*)(lds + G_VS + tau * 64 + r32 * 2));
                            rv[j] = bsl[tau] * (vv - gsl[tau] * acc[g4 * 4 + j]); }
                        u32x2 w; w.x = cvtpk(rv[0], rv[1]); w.y = cvtpk(rv[2], rv[3]);
                        *(u32x2*)(lds + G_RT + r32 * 144 + (32 * mi + 8 * g4 + 4 * hi) * 2) = w; }
                } else {
#pragma unroll
                    for (int r = 0; r < 16; ++r) acc[r] *= gsl[32 * mi + crow(r, hi)];
                }
            }
            __syncthreads();
            if (wid < 2) {
                f32x16 u = {}, u2 = {};
#pragma unroll
                for (int s = 0; s < 4; s += 2) {
                    const bf16x8 a0 = *(const bf16x8*)(lds + G_TT + (32 * mi + r32) * 144 + (16 * s + hi * 8) * 2), a1 = *(const bf16x8*)(lds + G_TT + (32 * mi + r32) * 144 + (16 * s + 16 + hi * 8) * 2);
                    const bf16x8 b0 = *(const bf16x8*)(lds + G_RT + r32 * 144 + (16 * s + hi * 8) * 2), b1 = *(const bf16x8*)(lds + G_RT + r32 * 144 + (16 * s + 16 + hi * 8) * 2);
                    u = __builtin_amdgcn_mfma_f32_32x32x16_bf16(a0, b0, u, 0, 0, 0);
                    u2 = __builtin_amdgcn_mfma_f32_32x32x16_bf16(a1, b1, u2, 0, 0, 0); }
#pragma unroll
                for (int r = 0; r < 16; ++r) u[r] += u2[r];
#pragma unroll
                for (int g4 = 0; g4 < 4; ++g4) { float uv[4], up[4];
#pragma unroll
                    for (int j = 0; j < 4; ++j) { const int tau = 32 * mi + 8 * g4 + 4 * hi + j; uv[j] = u[g4 * 4 + j]; up[j] = uv[j] * esl[tau]; }
                    u32x2 w; w.x = cvtpk(uv[0], uv[1]); w.y = cvtpk(uv[2], uv[3]);
                    *(u32x2*)(lds + G_UT + r32 * 144 + (32 * mi + 8 * g4 + 4 * hi) * 2) = w;
                    u32x2 w2; w2.x = cvtpk(up[0], up[1]); w2.y = cvtpk(up[2], up[3]);
                    *(u32x2*)(lds + G_UP + r32 * 144 + (32 * mi + 8 * g4 + 4 * hi) * 2) = w2; }
            }
            __syncthreads();
            if (wid == 2 || wid == 3) {
#pragma unroll
                for (int s = 0; s < 4; ++s) {
                    const bf16x8 a = *(const bf16x8*)(lds + G_AQ + (32 * mi + r32) * 144 + (16 * s + hi * 8) * 2);
                    const bf16x8 bb = *(const bf16x8*)(lds + G_UT + r32 * 144 + (16 * s + hi * 8) * 2);
                    acc = __builtin_amdgcn_mfma_f32_32x32x16_bf16(a, bb, acc, 0, 0, 0); }
#pragma unroll
                for (int r = 0; r < 16; ++r) { const size_t R = (size_t)gdn_row(b, pc, 32 * mi + crow(r, hi), dir);
                    obuf[((size_t)dir * MTOT + R) * 512 + h * 128 + cs * 32 + r32] = f2bf(acc[r]); }
            } else if (wid >= 4) {
                const float gl = gsl[63];
#pragma unroll
                for (int r = 0; r < 16; ++r) Sacc[r] *= gl;
                const bf16x8 pa0 = *(const bf16x8*)(lds + G_UP + r32 * 144 + (0 + hi * 8) * 2), pa1 = *(const bf16x8*)(lds + G_UP + r32 * 144 + (16 + hi * 8) * 2),
                             pa2 = *(const bf16x8*)(lds + G_UP + r32 * 144 + (32 + hi * 8) * 2), pa3 = *(const bf16x8*)(lds + G_UP + r32 * 144 + (48 + hi * 8) * 2);
                const int d0 = wid - 4;
                if (d0 == 0) pv_one<0>(Sacc, vb0, pa0, pa1, pa2, pa3); else if (d0 == 1) pv_one<1>(Sacc, vb0, pa0, pa1, pa2, pa3);
                else if (d0 == 2) pv_one<2>(Sacc, vb0, pa0, pa1, pa2, pa3); else pv_one<3>(Sacc, vb0, pa0, pa1, pa2, pa3);
#pragma unroll
                for (int r = 0; r < 16; ++r) *(bf16_t*)(lds + G_ST + crow(r, hi) * 272 + (32 * d0 + r32) * 2) = f2bf(Sacc[r]);
            }
            __syncthreads();
        }
#undef GLOAD
#undef GWRITE
    }
}

__device__ __forceinline__ void gdn_post_phase(const Params& p) {
    const int lane = threadIdx.x & 63, wid = threadIdx.x >> 6;
    const bf16_t* obuf = (const bf16_t*)(p.ws + WS_H);
    const bf16_t* proj = (const bf16_t*)(p.ws + WS_PROJ);
    bf16_t* mix = (bf16_t*)(p.ws + WS_MIX);
    const int d = (lane & 15) * 8;
    for (int row = blockIdx.x * 8 + wid; row < MTOT; row += gridDim.x * 8) {
        float a[8], bb[8], g[8], y[8];
        unpack8(*(const bf16x8*)(obuf + (size_t)row * 512 + lane * 8), a);
        unpack8(*(const bf16x8*)(obuf + ((size_t)MTOT + row) * 512 + lane * 8), bb);
        unpack8(*(const bf16x8*)(proj + (size_t)row * EV_NP + 3072 + lane * 8), g);
        float ss = 0.f;
#pragma unroll
        for (int i = 0; i < 8; ++i) { a[i] += bb[i]; ss += a[i] * a[i]; }
        ss += __shfl_xor(ss, 1); ss += __shfl_xor(ss, 2); ss += __shfl_xor(ss, 4); ss += __shfl_xor(ss, 8);
        const float rstd = rsqrtf(ss * (1.f / 128.f) + 1e-6f);
#pragma unroll
        for (int i = 0; i < 8; ++i) y[i] = a[i] * rstd * p.gdn_norm[d + i] * (g[i] / (1.f + expf(-g[i])));
        *(bf16x8*)(mix + (size_t)row * DM + 512 + lane * 8) = pack8(y);
    }
}

__device__ __forceinline__ void diffattn_phase(const Params& p, unsigned char* lds) {
    const int tid = threadIdx.x, wid = tid >> 6, lane = tid & 63, r32 = lane & 31, hi = lane >> 5;
    const bf16_t* proj = (const bf16_t*)(p.ws + WS_PROJ);
    bf16_t* mix = (bf16_t*)(p.ws + WS_MIX);
    float s01 = 0.f, s23 = 0.f;
    for (int i = 0; i < 64; ++i) { s01 += p.diff_lambda[i] * p.diff_lambda[64 + i]; s23 += p.diff_lambda[128 + i] * p.diff_lambda[192 + i]; }
    const float lam = expf(s01) - expf(s23) + 0.2f;
    float* X = (float*)lds; float* li = (float*)(lds + 131072) + wid * 64;
    LAS unsigned char* ldsl = (LAS unsigned char*)lds;
    int koff[2], voff[2];
#pragma unroll
    for (int i = 0; i < 2; ++i) {
        const int g = i * 512 + tid;
        { const int row = g >> 4, cg = (g & 15) ^ (row & 7); koff[i] = row * EV_NP + cg * 8; }
        { const int o = g * 16, st = o >> 9, w = o & 511, kk = (st >> 2) * 8 + (w >> 6);
          const int k = (kk & ~0xC) | ((kk & 4) << 1) | ((kk & 8) >> 1), cc = (st & 3) * 32 + ((w & 63) >> 4) * 8; voff[i] = k * EV_NP + cc; }
    }
    const int vbase = (int)(uintptr_t)lds + v_rd_base(lane);
    const int map = wid >> 2, wq = wid & 3;
    unsigned char* Qs = lds + 98304 + wid * 4096 + lane * 16;
    for (int it = blockIdx.x; it < 2112; it += gridDim.x) {
        int b, h, NT, qrow0;
        if (it < 2048) { b = it >> 8; h = (it >> 6) & 3; const int qb = it & 63; NT = 132; qrow0 = b * SEQ + qb * 128; }
        else { const int j = it - 2048; b = j >> 3; h = (j >> 1) & 3; NT = 4; qrow0 = NLAT + b * CTXL + (j & 1) * 128; }
        { const bf16_t* qp = proj + (size_t)(qrow0 + 32 * wq + r32) * EV_NP + h * 128 + map * 64 + hi * 8;
#pragma unroll
          for (int d0 = 0; d0 < 4; ++d0) *(bf16x8*)(Qs + d0 * 1024) = *(const bf16x8*)(qp + d0 * 16); }
        f32x16 o[4] = {}; float lsum = 0.f;
#define DDMA(j, bo) do { const bf16_t* pp_ = proj + (size_t)((j) < 4 ? NLAT + b * CTXL + 64 * (j) : b * SEQ + 64 * ((j) - 4)) * EV_NP + h * 128; \
        _Pragma("unroll") for (int i_ = 0; i_ < 2; ++i_) { \
            __builtin_amdgcn_global_load_lds((const unsigned*)(pp_ + 1024 + voff[i_]), (LAS unsigned*)(ldsl + (bo) + i_ * 8192 + wid * 1024), 16, 0, 0); \
            __builtin_amdgcn_global_load_lds((const unsigned*)(pp_ + 512 + koff[i_]), (LAS unsigned*)(ldsl + (bo) + 16384 + i_ * 8192 + wid * 1024), 16, 0, 0); } } while (0)
#define DQK(P0, P1, bo) do { P0 = (f32x16){}; P1 = (f32x16){}; const unsigned char* Ks_ = lds + (bo) + 16384; \
        _Pragma("unroll") for (int d0 = 0; d0 < 4; ++d0) { const int cb_ = (map * 64 + d0 * 16 + hi * 8) * 2; \
            const bf16x8 b0_ = *(const bf16x8*)(Ks_ + KSWZ(r32, cb_)), b1_ = *(const bf16x8*)(Ks_ + KSWZ(32 + r32, cb_)); \
            const bf16x8 qd_ = *(const bf16x8*)(Qs + d0 * 1024); \
            P0 = __builtin_amdgcn_mfma_f32_32x32x16_bf16(b0_, qd_, P0, 0, 0, 0); \
            P1 = __builtin_amdgcn_mfma_f32_32x32x16_bf16(b1_, qd_, P1, 0, 0, 0); } } while (0)
#define DSM(P0, P1) do { _Pragma("unroll") for (int r = 0; r < 16; ++r) { P0[r] = __builtin_amdgcn_exp2f(P0[r]); P1[r] = __builtin_amdgcn_exp2f(P1[r]); lsum += P0[r] + P1[r]; } \
        PK4(P0, 0, pa0); PK4(P0, 8, pa1); PK4(P1, 0, pa2); PK4(P1, 8, pa3); } while (0)
#define DSTEP(N0, N1, O0, O1, j) do { if ((j) + 1 < NT) DDMA((j) + 1, bnext); \
        DQK(N0, N1, bcur); DSM(O0, O1); pv_d0(o, vbase + bprev, pa0, pa1, pa2, pa3); \
        asm volatile("s_waitcnt vmcnt(0)" ::: "memory"); __syncthreads(); \
        { const int t_ = bprev; bprev = bcur; bcur = bnext; bnext = t_; } } while (0)
        f32x16 pA0, pA1, pB0, pB1; bf16x8 pa0, pa1, pa2, pa3;
        DDMA(0, 0); DDMA(1, 32768); asm volatile("s_waitcnt vmcnt(0)" ::: "memory"); __syncthreads();
        DQK(pA0, pA1, 0);
        int bprev = 0, bcur = 32768, bnext = 65536;
        for (int j = 1; j + 1 < NT; j += 2) { DSTEP(pB0, pB1, pA0, pA1, j); DSTEP(pA0, pA1, pB0, pB1, j + 1); }
        DSTEP(pB0, pB1, pA0, pA1, NT - 1);
        DSM(pB0, pB1); pv_d0(o, vbase + bprev, pa0, pa1, pa2, pa3);
        __syncthreads();
#undef DDMA
#undef DQK
#undef DSM
#undef DSTEP
        const float lt = halfswap_add(lsum);
        if (hi == 0) li[r32] = lt;
        asm volatile("s_waitcnt lgkmcnt(0)" ::: "memory");
        float rli[16];
#pragma unroll
        for (int r = 0; r < 16; ++r) rli[r] = 1.f / li[crow(r, hi)];
        if (map == 1) {
#pragma unroll
            for (int d0 = 0; d0 < 4; ++d0)
#pragma unroll
                for (int r = 0; r < 16; ++r) X[(wq * 64 + d0 * 16 + r) * 64 + lane] = o[d0][r] * rli[r] * lam;
        }
        __syncthreads();
        if (map == 0) {
#pragma unroll
            for (int d0 = 0; d0 < 4; ++d0)
#pragma unroll
                for (int r = 0; r < 16; ++r) o[d0][r] = o[d0][r] * rli[r] - X[(wq * 64 + d0 * 16 + r) * 64 + lane];
#pragma unroll
            for (int r = 0; r < 16; ++r) {
                float ss = o[0][r] * o[0][r] + o[1][r] * o[1][r] + o[2][r] * o[2][r] + o[3][r] * o[3][r];
                ss += __shfl_xor(ss, 1); ss += __shfl_xor(ss, 2); ss += __shfl_xor(ss, 4); ss += __shfl_xor(ss, 8); ss += __shfl_xor(ss, 16);
                const float rstd = rsqrtf(ss * (1.f / 128.f) + 1e-6f) * 0.8f;
                bf16_t* mp = mix + (size_t)(qrow0 + 32 * wq + crow(r, hi)) * DM + h * 128 + r32;
#pragma unroll
                for (int d0 = 0; d0 < 4; ++d0) mp[32 * d0] = f2bf(o[d0][r] * rstd * p.diff_subln[32 * d0 + r32]);
            }
        }
        __syncthreads();
    }
}

__device__ __forceinline__ void natten_phase(const Params& p, unsigned char* lds) {
    const int tid = threadIdx.x, wid = tid >> 6, lane = tid & 63, r32 = lane & 31, hi = lane >> 5;
    const bf16_t* proj = (const bf16_t*)(p.ws + WS_PROJ);
    bf16_t* mix = (bf16_t*)(p.ws + WS_MIX);
    constexpr float L2E = 1.4426950408889634f;
    unsigned char* Vl = lds; unsigned char* Kl = lds + 32768;
    float* rpbs = (float*)(lds + 65536);
    float* li = (float*)(lds + 133120) + wid * 64;
    unsigned char* Qs = lds + 67584 + wid * 8192 + lane * 16;
    const int sr = tid >> 4, sc = (tid & 15) * 8, vst0 = v_st(sr, sc), vst1 = v_st(32 + sr, sc);
    const int vb0 = (int)(uintptr_t)Vl + v_rd_base(lane);
    const float* gkp = p.na_qk_gain + 128 + sc;
    for (int it = blockIdx.x; it < 2048; it += gridDim.x) {
        const int b = it >> 8, h = (it >> 5) & 7, rq = it & 31;
        const int grow = 4 * rq + (wid >> 1), qc = (wid & 1) * 32 + r32;
        const size_t qR = (size_t)b * SEQ + grow * 64 + qc;
        for (int i = tid; i < 465; i += NTHREADS) rpbs[i] = p.na_rpb[h * 465 + i] * L2E;
        { float ss = 0.f;
#pragma unroll
          for (int d0 = 0; d0 < 8; ++d0) { float qv[8]; unpack8(*(const bf16x8*)(proj + qR * OD_N + h * 128 + d0 * 16 + hi * 8), qv);
#pragma unroll
              for (int i = 0; i < 8; ++i) ss += qv[i] * qv[i]; }
          ss = halfswap_add(ss);
          const float rs = rsqrtf(ss * (1.f / 128.f) + 1e-6f) * 0.08838834764831845f * L2E;
#pragma unroll
          for (int d0 = 0; d0 < 8; ++d0) { float qv[8]; unpack8(*(const bf16x8*)(proj + qR * OD_N + h * 128 + d0 * 16 + hi * 8), qv);
#pragma unroll
              for (int i = 0; i < 8; ++i) qv[i] *= rs * p.na_qk_gain[d0 * 16 + hi * 8 + i];
              *(bf16x8*)(Qs + d0 * 1024) = pack8(qv); } }
        int lo = 4 * rq - 4; lo = lo < 0 ? 0 : (lo > 120 ? 120 : lo);
        int hi_r = 4 * rq + 3 - 4; hi_r = hi_r < 0 ? 0 : (hi_r > 120 ? 120 : hi_r); hi_r += 7;
        const int nlat = hi_r - lo + 1, NT = nlat + 4;
        int wsr = grow - 4; wsr = wsr < 0 ? 0 : (wsr > 120 ? 120 : wsr);
        int cst = qc - 8; cst = cst < 0 ? 0 : (cst > 48 ? 48 : cst);
        f32x16 o[4] = {}; float lsum = 0.f;
        bf16x8 vs0, vs1, ks0, ks1;
#define NLOAD(j) do { const size_t R0_ = (size_t)((j) < nlat ? b * SEQ + (lo + (j)) * 64 : NLAT + b * CTXL + 64 * ((j) - nlat)) + sr; \
        const bf16_t* pp_ = proj + R0_ * OD_N + h * 128 + sc; \
        vs0 = *(const bf16x8*)(pp_ + 2048); vs1 = *(const bf16x8*)(pp_ + 2048 + (size_t)32 * OD_N); \
        ks0 = *(const bf16x8*)(pp_ + 1024); ks1 = *(const bf16x8*)(pp_ + 1024 + (size_t)32 * OD_N); } while (0)
#define KNORM(kx) do { float f_[8]; unpack8(kx, f_); float ss_ = 0.f; _Pragma("unroll") for (int i_ = 0; i_ < 8; ++i_) ss_ += f_[i_] * f_[i_]; \
        ss_ += __shfl_xor(ss_, 1); ss_ += __shfl_xor(ss_, 2); ss_ += __shfl_xor(ss_, 4); ss_ += __shfl_xor(ss_, 8); \
        const float rs_ = rsqrtf(ss_ * (1.f / 128.f) + 1e-6f); _Pragma("unroll") for (int i_ = 0; i_ < 8; ++i_) f_[i_] *= rs_ * gkp[i_]; kx = pack8(f_); } while (0)
#define NWRITE(bf) do { KNORM(ks0); KNORM(ks1); *(bf16x8*)(Vl + (bf) * 16384 + vst0) = vs0; *(bf16x8*)(Vl + (bf) * 16384 + vst1) = vs1; \
        *(bf16x8*)(Kl + (bf) * 16384 + KSWZ(sr, sc * 2)) = ks0; *(bf16x8*)(Kl + (bf) * 16384 + KSWZ(32 + sr, sc * 2)) = ks1; } while (0)
        NLOAD(0); NWRITE(0); __syncthreads();
        for (int j = 0; j < NT; ++j) {
            if (j + 1 < NT) NLOAD(j + 1);
            const int bf = j & 1;
            const bool islat = j < nlat; const int kr = lo + j;
            const bool active = !islat || (kr >= wsr && kr <= wsr + 7);
            if (active) {
                f32x16 p0 = {}, p1 = {};
                const unsigned char* Ks = Kl + bf * 16384;
#pragma unroll
                for (int d0 = 0; d0 < 8; ++d0) { const int cb = (d0 * 16 + hi * 8) * 2;
                    const bf16x8 b0 = *(const bf16x8*)(Ks + KSWZ(r32, cb)), b1 = *(const bf16x8*)(Ks + KSWZ(32 + r32, cb));
                    const bf16x8 qd = *(const bf16x8*)(Qs + d0 * 1024);
                    p0 = __builtin_amdgcn_mfma_f32_32x32x16_bf16(b0, qd, p0, 0, 0, 0);
                    p1 = __builtin_amdgcn_mfma_f32_32x32x16_bf16(b1, qd, p1, 0, 0, 0); }
                if (islat) {
                    const float* rb = rpbs + (kr - grow + 7) * 31 + 15 - qc + 4 * hi;
                    const int mofs = 4 * hi - cst;
#pragma unroll
                    for (int r = 0; r < 16; ++r) {
                        const int kb = (r & 3) + 8 * (r >> 2);
                        const float e0 = __builtin_amdgcn_exp2f(p0[r] + rb[kb]), e1 = __builtin_amdgcn_exp2f(p1[r] + rb[32 + kb]);
                        p0[r] = ((unsigned)(kb + mofs) < 16u) ? e0 : 0.f; p1[r] = ((unsigned)(32 + kb + mofs) < 16u) ? e1 : 0.f;
                        lsum += p0[r] + p1[r]; }
                } else {
#pragma unroll
                    for (int r = 0; r < 16; ++r) { p0[r] = __builtin_amdgcn_exp2f(p0[r]); p1[r] = __builtin_amdgcn_exp2f(p1[r]); lsum += p0[r] + p1[r]; }
                }
                bf16x8 pa0, pa1, pa2, pa3;
                PK4(p0, 0, pa0); PK4(p0, 8, pa1); PK4(p1, 0, pa2); PK4(p1, 8, pa3);
                pv_d0(o, vb0 + bf * 16384, pa0, pa1, pa2, pa3);
            }
            if (j + 1 < NT) NWRITE((j + 1) & 1);
            __syncthreads();
        }
#undef NLOAD
#undef KNORM
#undef NWRITE
        const float lt = halfswap_add(lsum);
        if (hi == 0) li[r32] = lt;
        asm volatile("s_waitcnt lgkmcnt(0)" ::: "memory");
#pragma unroll
        for (int r = 0; r < 16; ++r) { const float rl = 1.f / li[crow(r, hi)];
            bf16_t* mp = mix + ((size_t)b * SEQ + grow * 64 + (wid & 1) * 32 + crow(r, hi)) * DM + h * 128 + r32;
#pragma unroll
            for (int d0 = 0; d0 < 4; ++d0) mp[32 * d0] = f2bf(o[d0][r] * rl); }
        __syncthreads();
    }
}

#define XB_TMO      128
#define XB_XCNT(j)  (256  + 64 * (j))
#define XB_XSUB(j)  (1280 + 64 * (j))
#define XB_XGEN(j)  (2304 + 64 * (j))
#define XB_TOP      3328
#define XB_TOPGEN   3392
#define XCD_BAR_WORDS 3456
#define XB_SPIN_CAP (1u << 22)
__device__ __forceinline__ unsigned xb_ld(unsigned* p)              { return __hip_atomic_load(p, __ATOMIC_RELAXED, __HIP_MEMORY_SCOPE_AGENT); }
__device__ __forceinline__ unsigned xb_add(unsigned* p, unsigned v) { return __hip_atomic_fetch_add(p, v, __ATOMIC_RELAXED, __HIP_MEMORY_SCOPE_AGENT); }
__device__ __forceinline__ unsigned xb_xcc_id() { return (unsigned)__builtin_amdgcn_s_getreg((3 << 11) | 20) & 0xFu; }
#define XB_SPIN(cond, bar) do { unsigned _sp = 0; while (cond) { __builtin_amdgcn_s_sleep(1); \
    if ((++_sp & 255u) == 0u) { if (xb_ld(&(bar)[XB_TMO])) break; if (_sp > XB_SPIN_CAP) { atomicAdd(&(bar)[XB_TMO], 1u); break; } } } } while (0)
struct XcdBarrier { unsigned* bar; unsigned x; volatile LAS unsigned* st; };
__device__ __forceinline__ XcdBarrier xcd_barrier_post(unsigned* bar, volatile LAS unsigned* st) {
    XcdBarrier b; b.bar = bar; b.x = xb_xcc_id(); b.st = st;
    if (threadIdx.x == 0) (void)xb_add(&bar[XB_XCNT(b.x)], 1u);
    return b;
}
__device__ __forceinline__ void xcd_barrier_complete(unsigned* bar, unsigned x, unsigned& nloc, unsigned& nx) {
    const unsigned G = gridDim.x * gridDim.y * gridDim.z;
    unsigned sum, cnt, mine, sp = 0u;
    for (;;) {
        sum = 0u; cnt = 0u; mine = 0u;
#pragma unroll
        for (unsigned j = 0; j < 16; ++j) { const unsigned c = xb_ld(&bar[XB_XCNT(j)]); sum += c; cnt += (c > 0u) ? 1u : 0u; mine = (j == x) ? c : mine; }
        if (sum == G) break;
        __builtin_amdgcn_s_sleep(1);
        if ((++sp & 255u) == 0u) { if (xb_ld(&bar[XB_TMO])) break; if (sp > XB_SPIN_CAP) { atomicAdd(&bar[XB_TMO], 1u); break; } }
    }
    nloc = mine > 0u ? mine : 1u; nx = cnt > 0u ? cnt : 1u;
}
__device__ __forceinline__ void xcd_barrier(const XcdBarrier& b) {
    asm volatile("s_waitcnt vmcnt(0)" ::: "memory");
    __syncthreads();
    if (threadIdx.x == 0) {
        unsigned* bar = b.bar;
        __builtin_amdgcn_s_waitcnt(0);
        unsigned nloc = b.st[0], nx = b.st[1];
        if (nloc == 0u) { xcd_barrier_complete(bar, b.x, nloc, nx); b.st[0] = nloc; b.st[1] = nx; }
        const unsigned old = xb_add(&bar[XB_XSUB(b.x)], 1u);
        const unsigned gen = old / nloc;
        if (old + 1u == (gen + 1u) * nloc) {
            __builtin_amdgcn_fence(__ATOMIC_RELEASE, "agent");
            asm volatile("s_waitcnt vmcnt(0)" ::: "memory");
            const unsigned og = xb_add(&bar[XB_TOP], 1u);
            const unsigned tg = og / nx;
            if (og + 1u == (tg + 1u) * nx) xb_add(&bar[XB_TOPGEN], 1u);
            else XB_SPIN(xb_ld(&bar[XB_TOPGEN]) == tg, bar);
            __builtin_amdgcn_fence(__ATOMIC_ACQUIRE, "agent");
            xb_add(&bar[XB_XGEN(b.x)], 1u);
            asm volatile("s_waitcnt vmcnt(0)" ::: "memory");
        } else {
            XB_SPIN(xb_ld(&bar[XB_XGEN(b.x)]) == gen, bar);
            __builtin_amdgcn_fence(__ATOMIC_ACQUIRE, "agent");
            asm volatile("s_waitcnt vmcnt(0)" ::: "memory");
        }
    }
    __syncthreads();
}

#ifndef PROBE_REP
#define PROBE_REP 0
#endif
#define REP(k) for (int rep_ = 0; rep_ < (((PROBE_REP >> (k)) & 1) ? 2 : 1); ++rep_)
constexpr int NPH = 18;
__global__ void __launch_bounds__(NTHREADS, 2) fwd_megakernel(Params p) {
    extern __shared__ __attribute__((aligned(16))) unsigned char lds[];
    cg::grid_group grid = cg::this_grid();
    LAS unsigned char* ldsl = (LAS unsigned char*)lds;
    const int lo = p.ph_lo, hi = p.ph_hi;
#ifdef ONLY_PH
#define IN(k) (((ONLY_PH >> (k)) & 1) && lo <= (k) && (k) < hi)
#else
#define IN(k) (lo <= (k) && (k) < hi)
#endif
#define SEAM(k) do { if (IN(k) && IN((k) + 1)) { if ((k) == 0) grid.sync(); else { XcdBarrier xb_; xb_.bar = (unsigned*)(p.ws + WS_BAR); xb_.x = xb_xcc_id(); xb_.st = (volatile LAS unsigned*)(ldsl + 135168); xcd_barrier(xb_); } } } while (0)
    unsigned char* ws = p.ws;
    const bf16_t* H = (const bf16_t*)(ws + WS_H);
    bf16_t* PROJ = (bf16_t*)(ws + WS_PROJ);
    const bf16_t* MIX = (const bf16_t*)(ws + WS_MIX);
    float* CTXRES = (float*)(ws + WS_CTXRES);
    const float* MOD = (const float*)(ws + WS_MOD);
    const int G = gridDim.x, c = blockIdx.x;
    if (threadIdx.x < 4) ((volatile LAS unsigned*)(ldsl + 135168))[threadIdx.x] = 0u;
    __syncthreads();
    (void)xcd_barrier_post((unsigned*)(ws + WS_BAR), (volatile LAS unsigned*)(ldsl + 135168));

    if (IN(0)) REP(0) { ada_phase(p, lds); wconv_phase(p, lds); }
    SEAM(0);
    if (IN(1)) REP(1) norm_phase(p, p.x, p.ctx, 0, 0, MTOT);
    SEAM(1);
    if (IN(2)) REP(2) { pg8::Gemm g{H, (const bf16_t*)(ws + WS_W_EVIN), MTOT, EV_NP, DM}; pg8::StaticOrder S; S.init(MTOT, EV_NP, G, c);
        pg8::EpiBf16 E{PROJ, EV_NP}; pg8::gemm_phase(ldsl, g, S, E); }
    SEAM(2);
    if (IN(3)) prep0_phase(p);
    SEAM(3);
    if (IN(4)) REP(4) gdn_pre_phase(p, lds);
    SEAM(4);
    if (IN(5)) {
#ifndef SKIP_SCAN
        REP(20) { gdn_scan_phase(p, lds); __syncthreads(); }
#endif
#ifndef SKIP_DA
        REP(5) { diffattn_phase(p, lds); __syncthreads(); }
#endif
    }
    SEAM(5);
    if (IN(6)) REP(6) gdn_post_phase(p);
    SEAM(6);
    if (IN(7)) REP(7) { pg8::Gemm g{MIX, (const bf16_t*)(ws + WS_W_EVOUT), MTOT, DM, DM}; pg8::StaticOrder S; S.init(MTOT, DM, G, c);
        pg8::EpiResid E{p.x, p.ctx, p.out, CTXRES, MOD, 2048}; pg8::gemm_phase(ldsl, g, S, E); }
    SEAM(7);
    if (IN(8)) norm_phase(p, p.out, CTXRES, 0, 1, MTOT);
    SEAM(8);
    if (IN(9)) REP(9) { pg8::Gemm g{H, (const bf16_t*)(ws + WS_W_FFIN), MTOT, 2 * FF, DM}; pg8::StaticOrder S; S.init(MTOT, 2 * FF, G, c);
        pg8::EpiSwiglu E{PROJ, FF}; pg8::gemm_phase(ldsl, g, S, E); }
    SEAM(9);
    if (IN(10)) { pg8::Gemm g{PROJ, (const bf16_t*)(ws + WS_W_FFOUT), MTOT, DM, FF}; pg8::StaticOrder S; S.init(MTOT, DM, G, c);
        pg8::EpiResid E{p.out, CTXRES, p.out, CTXRES, MOD, 5120}; pg8::gemm_phase(ldsl, g, S, E); }
    SEAM(10);
    if (IN(11)) norm_phase(p, p.out, CTXRES, 1, 0, MTOT);
    SEAM(11);
    if (IN(12)) { pg8::Gemm g{H, (const bf16_t*)(ws + WS_W_ODIN), MTOT, OD_N, DM}; pg8::StaticOrder S; S.init(MTOT, OD_N, G, c);
        pg8::EpiBf16 E{PROJ, OD_N}; pg8::gemm_phase(ldsl, g, S, E); }
    SEAM(12);
    if (IN(13)) { natten_phase(p, lds); if ((PROBE_REP >> 13) & 1) { __syncthreads(); natten_phase(p, lds); } }
    SEAM(13);
    if (IN(14)) { pg8::Gemm g{MIX, (const bf16_t*)(ws + WS_W_ODOUT), NLAT, DM, DM}; pg8::StaticOrder S; S.init(NLAT, DM, G, c);
        pg8::EpiResid E{p.out, CTXRES, p.out, CTXRES, MOD + 9 * 6144, 2048}; pg8::gemm_phase(ldsl, g, S, E); }
    SEAM(14);
    if (IN(15)) norm_phase(p, p.out, CTXRES, 1, 1, NLAT);
    SEAM(15);
    if (IN(16)) { pg8::Gemm g{H, (const bf16_t*)(ws + WS_W_FFIN) + (size_t)2 * FF * DM, NLAT, 2 * FF, DM}; pg8::StaticOrder S; S.init(NLAT, 2 * FF, G, c);
        pg8::EpiSwiglu E{PROJ, FF}; pg8::gemm_phase(ldsl, g, S, E); }
    SEAM(16);
    if (IN(17)) { pg8::Gemm g{PROJ, (const bf16_t*)(ws + WS_W_FFOUT) + (size_t)DM * FF, NLAT, DM, FF}; pg8::StaticOrder S; S.init(NLAT, DM, G, c);
        pg8::EpiResid E{p.out, CTXRES, p.out, CTXRES, MOD + 9 * 6144, 5120}; pg8::gemm_phase(ldsl, g, S, E); }
#undef IN
#undef SEAM
}

extern "C" void kernel_launch(void* const* d_in, const int* in_sizes, int n_in, void* d_out, int out_size, void* d_ws, size_t ws_size, hipStream_t stream) {
    static int grid = 0;
    if (grid == 0) {
        if (n_in != 23 || ws_size < WS_END) { fprintf(stderr, "kernel_launch: n_in %d ws %zu (need %zu)\n", n_in, ws_size, (size_t)WS_END); grid = -1; return; }
        int dev = 0, cus = 0, per_cu = 0;
        hipGetDevice(&dev); hipDeviceGetAttribute(&cus, hipDeviceAttributeMultiprocessorCount, dev);
        if (hipFuncSetAttribute((const void*)fwd_megakernel, hipFuncAttributeMaxDynamicSharedMemorySize, LDS_BYTES) != hipSuccess) { fprintf(stderr, "hipFuncSetAttribute failed\n"); grid = -1; return; }
        if (hipOccupancyMaxActiveBlocksPerMultiprocessor(&per_cu, (const void*)fwd_megakernel, NTHREADS, LDS_BYTES) != hipSuccess || per_cu < 1) per_cu = 1;
        (void)hipGetLastError();
        grid = cus * 1;
    }
    if (grid < 0) return;
    if (hipMemsetAsync((char*)d_ws + WS_BAR, 0, 16384, stream) != hipSuccess) { fprintf(stderr, "memset failed\n"); return; }
    Params p{};
    const float** pp = (const float**)&p;
    for (int i = 0; i < 23; ++i) pp[i] = (const float*)d_in[i];
    p.out = (float*)d_out; p.ws = (unsigned char*)d_ws;
#if N_LAUNCH_MODE == 1
    p.ph_lo = 0; p.ph_hi = NPH;
    void* args[] = {&p};
    hipError_t e = hipLaunchCooperativeKernel((void*)fwd_megakernel, dim3(grid), dim3(NTHREADS), args, LDS_BYTES, stream);
    if (e != hipSuccess) fprintf(stderr, "cooperative launch failed: %s (grid %d)\n", hipGetErrorString(e), grid);
#else
    for (int k = 0; k < NPH; ++k) { p.ph_lo = k; p.ph_hi = k + 1;
        hipLaunchKernelGGL(fwd_megakernel, dim3(grid), dim3(NTHREADS), LDS_BYTES, stream, p); }
#endif
}
```

```cpp
#include <hip/hip_runtime.h>
#include <hip/hip_cooperative_groups.h>
#include <cstdio>
#include <cstdint>
namespace cg = cooperative_groups;

#define LAS __attribute__((address_space(3)))
typedef unsigned short bf16_t;
typedef short bf16x8 __attribute__((ext_vector_type(8)));
typedef short s16x4 __attribute__((ext_vector_type(4)));
typedef float f32x4 __attribute__((ext_vector_type(4)));
typedef float f32x16 __attribute__((ext_vector_type(16)));
typedef unsigned u32x4 __attribute__((ext_vector_type(4)));
typedef unsigned u32x2 __attribute__((ext_vector_type(2)));

#ifndef N_LAUNCH_MODE
#define N_LAUNCH_MODE 1
#endif

constexpr int DM = 1024, NLAT = 65536, NCTX = 2048, MTOT = NLAT + NCTX, SEQ = 8192, CTXL = 256, FF = 2816;
constexpr int EV_N = 3600, EV_NP = 3840, OD_N = 3072;
constexpr int NCHUNKP = 64 * 132;
constexpr int NTHREADS = 512;
constexpr int LDS_BYTES = 135168 + 16;

constexpr size_t al256(size_t x) { return (x + 255) / 256 * 256; }
constexpr size_t WS_W_EVIN = 0;
constexpr size_t WS_W_EVOUT = WS_W_EVIN + al256((size_t)EV_NP * DM * 2);
constexpr size_t WS_W_ODIN = WS_W_EVOUT + al256((size_t)DM * DM * 2);
constexpr size_t WS_W_ODOUT = WS_W_ODIN + al256((size_t)OD_N * DM * 2);
constexpr size_t WS_W_FFIN = WS_W_ODOUT + al256((size_t)DM * DM * 2);
constexpr size_t WS_W_FFOUT = WS_W_FFIN + al256((size_t)2 * 2 * FF * DM * 2);
constexpr size_t WS_MOD = WS_W_FFOUT + al256((size_t)2 * DM * FF * 2);
constexpr size_t WS_H = WS_MOD + al256((size_t)2 * 9 * 6144 * 4);
constexpr size_t WS_PROJ = WS_H + al256((size_t)MTOT * DM * 2);
constexpr size_t WS_MIX = WS_PROJ + al256((size_t)MTOT * EV_NP * 2);
constexpr size_t WS_T = WS_MIX + al256((size_t)MTOT * DM * 2);
constexpr size_t WS_AQK = WS_T + al256((size_t)NCHUNKP * 4096 * 2);
constexpr size_t WS_GV = WS_AQK + al256((size_t)NCHUNKP * 4096 * 2);
constexpr size_t WS_BV = WS_GV + al256((size_t)NCHUNKP * 64 * 4);
constexpr size_t WS_EL = WS_BV + al256((size_t)NCHUNKP * 64 * 4);
constexpr size_t WS_GATES = WS_EL + al256((size_t)NCHUNKP * 64 * 4);
constexpr size_t WS_CTXRES = WS_GATES + al256((size_t)MTOT * 16 * 4);
constexpr size_t WS_BAR = WS_CTXRES + al256((size_t)NCTX * DM * 4);
constexpr size_t WS_ROPE = WS_BAR + 16384;
constexpr size_t WS_END = WS_ROPE + (size_t)2 * SEQ * 32 * 4;

struct Params {
    const float *x, *c, *ctx, *c_ctx, *ada_w, *ada_b, *norm_mix, *norm_ffn, *ffn_w_in, *ffn_w_out, *even_w_in, *even_w_out,
        *diff_qk_gain, *diff_lambda, *diff_subln, *gdn_conv, *gdn_a_log, *gdn_dt_bias, *gdn_norm, *odd_w_in, *odd_w_out, *na_qk_gain, *na_rpb;
    float* out; unsigned char* ws; int ph_lo, ph_hi;
};

__device__ __forceinline__ float bf2f(bf16_t b) { return __uint_as_float(((unsigned)b) << 16); }
__device__ __forceinline__ bf16_t f2bf(float f) { unsigned u = __float_as_uint(f); u += 0x7FFFu + ((u >> 16) & 1u); return (bf16_t)(u >> 16); }
__device__ __forceinline__ unsigned cvtpk(float lo, float hi) { unsigned r; asm volatile("v_cvt_pk_bf16_f32 %0, %1, %2" : "=v"(r) : "v"(lo), "v"(hi)); return r; }
__device__ __forceinline__ float siluf(float v) { return v / (1.f + __expf(-v)); }
__device__ __forceinline__ void unpack8(bf16x8 v, float* f) {
#pragma unroll
    for (int i = 0; i < 8; ++i) f[i] = bf2f((bf16_t)v[i]);
}
__device__ __forceinline__ bf16x8 pack8(const float* f) {
    u32x4 w = {cvtpk(f[0], f[1]), cvtpk(f[2], f[3]), cvtpk(f[4], f[5]), cvtpk(f[6], f[7])};
    return *reinterpret_cast<bf16x8*>(&w);
}

namespace pg8 {
constexpr int BM = 256, BK = 64, HALF = 128, HTB = HALF * BK * 2, STAGE_BYTES = 8 * HTB, NXCD = 8, WGM = 8;
__host__ __device__ __forceinline__ int lds_byte(int r, int c) { const int st = (r >> 4) * 2 + (c >> 5), rr = r & 15, cc = c & 31, ob = rr * 64 + cc * 2; return st * 1024 + (ob ^ (((ob >> 9) & 1) << 5)); }
__host__ __device__ __forceinline__ void stage_rc(int b, int& R, int& C) { const int st = b / 1024, sb = b % 1024, swz = sb ^ (((sb >> 9) & 1) << 5); R = (st >> 1) * 16 + swz / 64; C = (st & 1) * 32 + (swz % 64) / 2; }
__host__ __device__ __forceinline__ int perm32(int rho) { const int n = rho >> 4, i = rho & 15; return 8 * (i >> 2) + 4 * n + (i & 3); }
struct Unit { int pm, pn; };
struct Gemm { const bf16_t* A; const bf16_t* Bt; int M, N, K; };
struct StaticOrder {
    int nM, nN, nwg, G, c;
    __device__ void init(int M, int N, int G_, int c_) { nM = M / BM; nN = N / BM; nwg = nM * nN; G = G_; c = c_; }
    __device__ bool next(int i, Unit& u) const {
        const long L = (long)i * G + c; if (L >= nwg) return false;
        int wgid = (int)L; { const int q = nwg / NXCD, r = nwg % NXCD, xcd = wgid % NXCD, off = wgid / NXCD; wgid = (xcd < r ? xcd * (q + 1) : r * (q + 1) + (xcd - r) * q) + off; }
        const int nig = WGM * nN, gid = wgid / nig, fm = gid * WGM, gsz = (nM - fm) < WGM ? (nM - fm) : WGM;
        u.pm = fm + ((wgid % nig) % gsz); u.pn = (wgid % nig) / gsz; return true;
    }
};
struct EpiBf16 {
    static constexpr bool PERM = true;
    bf16_t* O; int ldc;
    __device__ __forceinline__ void operator()(const f32x4 (&acc)[2][2][4][2], const Unit& u, int wr, int wc, int fr, int fq) const {
        const int row0 = u.pm * BM + wr * 64 + fr; const int col0 = u.pn * BM + wc * 32 + 8 * fq;
#pragma unroll
        for (int ai = 0; ai < 2; ++ai)
#pragma unroll
            for (int m = 0; m < 4; ++m) { bf16_t* rowp = O + (size_t)(row0 + ai * HALF + m * 16) * ldc + col0;
#pragma unroll
                for (int bj = 0; bj < 2; ++bj) { const f32x4 v0 = acc[ai][bj][m][0], v1 = acc[ai][bj][m][1];
                    u32x4 w; w.x = cvtpk(v0[0], v0[1]); w.y = cvtpk(v0[2], v0[3]); w.z = cvtpk(v1[0], v1[1]); w.w = cvtpk(v1[2], v1[3]);
                    *(u32x4*)(rowp + bj * HALF) = w; } }
    }
};
struct EpiSwiglu {
    static constexpr bool PERM = true;
    bf16_t* O; int ldc;
    __device__ __forceinline__ void operator()(const f32x4 (&acc)[2][2][4][2], const Unit& u, int wr, int wc, int fr, int fq) const {
        const int row0 = u.pm * BM + wr * 64 + fr; const int col0 = u.pn * HALF + wc * 32 + 8 * fq;
#pragma unroll
        for (int ai = 0; ai < 2; ++ai)
#pragma unroll
            for (int m = 0; m < 4; ++m) { bf16_t* rowp = O + (size_t)(row0 + ai * HALF + m * 16) * ldc + col0;
                float o[8];
#pragma unroll
                for (int n = 0; n < 2; ++n)
#pragma unroll
                    for (int j = 0; j < 4; ++j) { const float g = acc[ai][0][m][n][j], up = acc[ai][1][m][n][j]; o[n * 4 + j] = g / (1.f + __expf(-g)) * up; }
                u32x4 w; w.x = cvtpk(o[0], o[1]); w.y = cvtpk(o[2], o[3]); w.z = cvtpk(o[4], o[5]); w.w = cvtpk(o[6], o[7]);
                *(u32x4*)rowp = w; }
    }
};
struct EpiResid {
    static constexpr bool PERM = false;
    const float* resLat; const float* resCtx; float* outLat; float* outCtx; const float* modl; int goff;
    __device__ __forceinline__ void operator()(const f32x4 (&acc)[2][2][4][2], const Unit& u, int wr, int wc, int fr, int fq) const {
        const int rowt = u.pm * BM; const bool lat = rowt < NLAT;
        const float* res = lat ? resLat + (size_t)rowt * DM : resCtx + (size_t)(rowt - NLAT) * DM;
        float* out = lat ? outLat + (size_t)rowt * DM : outCtx + (size_t)(rowt - NLAT) * DM;
        const float* gate = modl + (size_t)(lat ? (rowt >> 13) : 8) * 6144 + goff;
        const int row0 = wr * 64 + fr, col0 = u.pn * BM + wc * 32 + 4 * fq;
        f32x4 gv[2][2];
#pragma unroll
        for (int bj = 0; bj < 2; ++bj)
#pragma unroll
            for (int n = 0; n < 2; ++n) gv[bj][n] = *(const f32x4*)(gate + col0 + bj * HALF + n * 16);
#pragma unroll
        for (int ai = 0; ai < 2; ++ai)
#pragma unroll
            for (int m = 0; m < 4; ++m) { const size_t off = (size_t)(row0 + ai * HALF + m * 16) * DM + col0;
#pragma unroll
                for (int bj = 0; bj < 2; ++bj)
#pragma unroll
                    for (int n = 0; n < 2; ++n) { const f32x4 r = *(const f32x4*)(res + off + bj * HALF + n * 16);
                        *(f32x4*)(out + off + bj * HALF + n * 16) = r + gv[bj][n] * acc[ai][bj][m][n]; } }
    }
};

template <class Epi, class Sched>
__device__ __forceinline__ void gemm_phase(LAS unsigned char* lds, const Gemm g, const Sched& S, const Epi& E) {
    const int tid = threadIdx.x, wid = __builtin_amdgcn_readfirstlane(tid >> 6), lane = tid & 63, wr = wid >> 2, wc = wid & 3, fr = lane & 15, fq = lane >> 4;
    const int K = g.K, nt = K / BK;
    unsigned voffA[2], voffB[2];
#pragma unroll
    for (int i = 0; i < 2; ++i) { int R, C; stage_rc(tid * 16 + i * 8192, R, C); const int Rb = Epi::PERM ? ((R & ~31) + perm32(R & 31)) : R;
        voffA[i] = (unsigned)(R * K + C) * 2u; voffB[i] = (unsigned)(Rb * K + C) * 2u; }
    const size_t kstep = (size_t)(BK * 2);
    const size_t hstep = (size_t)HALF * K * 2;
    const size_t tstep = 2 * hstep;
    const unsigned ldsw = (unsigned)wid * 1024u;
    const int aoff = lds_byte(wr * 64 + fr, fq * 8), boff = lds_byte(wc * 32 + fr, fq * 8);
#define PG8_SA(b, h) (((b) * 2 + (h)) * HTB)
#define PG8_SB(b, h) ((4 + (b) * 2 + (h)) * HTB)
#define PG8_STAGE(bufoff, gbase, voff) do { _Pragma("unroll") for (int _i = 0; _i < 2; ++_i) \
        __builtin_amdgcn_global_load_lds((const unsigned*)((const char*)(gbase) + (voff)[_i]), (LAS unsigned*)(lds + (bufoff) + ldsw + _i * 8192), 16, 0, 0); } while (0)
#define PG8_LDA(dst, b, h) do { _Pragma("unroll") for (int m = 0; m < 4; ++m) _Pragma("unroll") for (int k = 0; k < 2; ++k) dst[m][k] = *(const LAS bf16x8*)(lds + PG8_SA(b, h) + aoff + m * 2048 + k * 1024); } while (0)
#define PG8_LDB(dst, b, h) do { _Pragma("unroll") for (int n = 0; n < 2; ++n) _Pragma("unroll") for (int k = 0; k < 2; ++k) dst[n][k] = *(const LAS bf16x8*)(lds + PG8_SB(b, h) + boff + n * 2048 + k * 1024); } while (0)
#define PG8_MMA(ai, bj, At, Bt) do { __builtin_amdgcn_s_setprio(1); _Pragma("unroll") for (int m = 0; m < 4; ++m) _Pragma("unroll") for (int n = 0; n < 2; ++n) _Pragma("unroll") for (int k = 0; k < 2; ++k) \
        acc[ai][bj][m][n] = __builtin_amdgcn_mfma_f32_16x16x32_bf16(Bt[n][k], At[m][k], acc[ai][bj][m][n], 0, 0, 0); __builtin_amdgcn_s_setprio(0); } while (0)
#define PG8_WAIT_V(n) asm volatile("s_waitcnt vmcnt(" #n ")" ::: "memory")
#define PG8_WAIT_L(n) asm volatile("s_waitcnt lgkmcnt(" #n ")" ::: "memory")
#define PG8_BAR __builtin_amdgcn_s_barrier()
#define PG8_SCHED __builtin_amdgcn_sched_barrier(0)
    Unit cur, nxt; int ui = 0;
    if (!S.next(0, cur)) return;
    f32x4 acc[2][2][4][2];
#pragma unroll
    for (int a = 0; a < 2; ++a)
#pragma unroll
        for (int b = 0; b < 2; ++b)
#pragma unroll
            for (int m = 0; m < 4; ++m)
#pragma unroll
                for (int n = 0; n < 2; ++n) acc[a][b][m][n] = (f32x4){0.f, 0.f, 0.f, 0.f};
    bf16x8 At[4][2], B0[2][2], B1[2][2];
    const char* cA = (const char*)g.A + (size_t)cur.pm * tstep; const char* cB = (const char*)g.Bt + (size_t)cur.pn * tstep;
    PG8_STAGE(PG8_SB(0, 0), cB, voffB); PG8_STAGE(PG8_SA(0, 0), cA, voffA); PG8_STAGE(PG8_SB(0, 1), cB + hstep, voffB); PG8_STAGE(PG8_SA(0, 1), cA + hstep, voffA);
    if (wr == 1) PG8_BAR;
    PG8_WAIT_V(4); PG8_BAR;
    PG8_STAGE(PG8_SB(1, 0), cB + kstep, voffB); PG8_STAGE(PG8_SA(1, 0), cA + kstep, voffA); PG8_STAGE(PG8_SB(1, 1), cB + hstep + kstep, voffB);
    PG8_WAIT_V(6); PG8_BAR;
    for (;;) {
        const bool has_next = S.next(ui + 1, nxt);
        const char* nA = has_next ? (const char*)g.A + (size_t)nxt.pm * tstep : cA; const char* nB = has_next ? (const char*)g.Bt + (size_t)nxt.pn * tstep : cB;
        for (int t = 0; t < nt; t += 2) {
            const bool last = (t == nt - 2);
            const char* a1 = cA + (size_t)(t + 1) * kstep;
            const char* a2 = last ? nA : cA + (size_t)(t + 2) * kstep; const char* b2 = last ? nB : cB + (size_t)(t + 2) * kstep;
            const char* a3 = a2 + kstep; const char* b3 = b2 + kstep;
            PG8_LDB(B0, 0, 0); PG8_SCHED; PG8_LDA(At, 0, 0); PG8_STAGE(PG8_SA(1, 1), a1 + hstep, voffA);
            PG8_WAIT_L(8); PG8_BAR; PG8_WAIT_L(0); PG8_MMA(0, 0, At, B0); PG8_BAR; PG8_SCHED;
            PG8_LDB(B1, 0, 1); PG8_STAGE(PG8_SB(0, 0), b2, voffB);
            PG8_BAR; PG8_WAIT_L(0); PG8_MMA(0, 1, At, B1); PG8_BAR;
            PG8_LDA(At, 0, 1); PG8_STAGE(PG8_SA(0, 0), a2, voffA);
            PG8_BAR; PG8_WAIT_L(0); PG8_MMA(1, 0, At, B0); PG8_BAR; PG8_SCHED;
            PG8_STAGE(PG8_SB(0, 1), b2 + hstep, voffB);
            PG8_WAIT_V(6); PG8_BAR; PG8_MMA(1, 1, At, B1); PG8_BAR;
            PG8_LDB(B0, 1, 0); PG8_SCHED; PG8_LDA(At, 1, 0); PG8_STAGE(PG8_SA(0, 1), a2 + hstep, voffA);
            PG8_WAIT_L(8); PG8_BAR; PG8_WAIT_L(0); PG8_MMA(0, 0, At, B0); PG8_BAR; PG8_SCHED;
            PG8_LDB(B1, 1, 1); PG8_STAGE(PG8_SB(1, 0), b3, voffB);
            PG8_BAR; PG8_WAIT_L(0); PG8_MMA(0, 1, At, B1); PG8_BAR;
            PG8_LDA(At, 1, 1); PG8_STAGE(PG8_SA(1, 0), a3, voffA);
            PG8_BAR; PG8_WAIT_L(0); PG8_MMA(1, 0, At, B0); PG8_BAR; PG8_SCHED;
            PG8_STAGE(PG8_SB(1, 1), b3 + hstep, voffB);
            PG8_WAIT_V(6); PG8_BAR; PG8_MMA(1, 1, At, B1); PG8_BAR;
        }
        E(acc, cur, wr, wc, fr, fq);
        if (!has_next) break;
#pragma unroll
        for (int a = 0; a < 2; ++a)
#pragma unroll
            for (int b = 0; b < 2; ++b)
#pragma unroll
                for (int m = 0; m < 4; ++m)
#pragma unroll
                    for (int n = 0; n < 2; ++n) acc[a][b][m][n] = (f32x4){0.f, 0.f, 0.f, 0.f};
        cur = nxt; cA = nA; cB = nB; ++ui;
    }
    PG8_WAIT_V(0);
    if (wr == 0) PG8_BAR;
    PG8_BAR;
#undef PG8_SA
#undef PG8_SB
#undef PG8_STAGE
#undef PG8_LDA
#undef PG8_LDB
#undef PG8_MMA
#undef PG8_WAIT_V
#undef PG8_WAIT_L
#undef PG8_BAR
#undef PG8_SCHED
}
}

#define KSWZ(row, colB) ((row) * 256 + ((colB) ^ (((row) & 7) << 4)))
#define SBAR() __builtin_amdgcn_sched_barrier(0)
__device__ __forceinline__ int crow(int r, int hi) { return (r & 3) + 8 * (r >> 2) + 4 * hi; }
__device__ __forceinline__ int v_st(int k, int c) { const int kk = (k & ~0xC) | ((k & 4) << 1) | ((k & 8) >> 1); return ((kk >> 3) * 4 + (c >> 5)) * 512 + ((kk & 7) * 32 + (c & 31)) * 2; }
__device__ __forceinline__ int v_rd_base(int lane) { return ((lane & 3) << 3) | (((lane >> 2) & 3) << 6) | (((lane >> 4) & 1) << 5) | (((lane >> 5) & 1) << 8); }
constexpr int v_rd_off(int d0, int ks, int half) { return d0 * 512 + ks * 4096 + half * 2048; }
template <int OFF> __device__ __forceinline__ s16x4 tr_read(int vb) {
    s16x4 r; asm volatile("ds_read_b64_tr_b16 %0, %1 offset:%2" : "=&v"(r) : "v"(vb), "i"(OFF) : "memory"); return r;
}
template <int D0> __device__ __forceinline__ void pv_one(f32x16& od, int vb, bf16x8 pa0, bf16x8 pa1, bf16x8 pa2, bf16x8 pa3) {
    const s16x4 l0 = tr_read<v_rd_off(D0, 0, 0)>(vb), h0 = tr_read<v_rd_off(D0, 0, 1)>(vb), l1 = tr_read<v_rd_off(D0, 1, 0)>(vb), h1 = tr_read<v_rd_off(D0, 1, 1)>(vb);
    const s16x4 l2 = tr_read<v_rd_off(D0, 2, 0)>(vb), h2 = tr_read<v_rd_off(D0, 2, 1)>(vb), l3 = tr_read<v_rd_off(D0, 3, 0)>(vb), h3 = tr_read<v_rd_off(D0, 3, 1)>(vb);
    asm volatile("s_waitcnt lgkmcnt(0)" ::: "memory"); SBAR();
#define PK(L, H) (bf16x8){L[0], L[1], L[2], L[3], H[0], H[1], H[2], H[3]}
    od = __builtin_amdgcn_mfma_f32_32x32x16_bf16(pa0, PK(l0, h0), od, 0, 0, 0);
    od = __builtin_amdgcn_mfma_f32_32x32x16_bf16(pa1, PK(l1, h1), od, 0, 0, 0);
    od = __builtin_amdgcn_mfma_f32_32x32x16_bf16(pa2, PK(l2, h2), od, 0, 0, 0);
    od = __builtin_amdgcn_mfma_f32_32x32x16_bf16(pa3, PK(l3, h3), od, 0, 0, 0);
#undef PK
}
__device__ __forceinline__ void pv_d0(f32x16* o, int vb, bf16x8 pa0, bf16x8 pa1, bf16x8 pa2, bf16x8 pa3) {
    pv_one<0>(o[0], vb, pa0, pa1, pa2, pa3); pv_one<1>(o[1], vb, pa0, pa1, pa2, pa3); pv_one<2>(o[2], vb, pa0, pa1, pa2, pa3); pv_one<3>(o[3], vb, pa0, pa1, pa2, pa3);
}
#define PK4(P, BASE, OUT) do { unsigned a0 = cvtpk(P[BASE + 0], P[BASE + 1]), a1 = cvtpk(P[BASE + 2], P[BASE + 3]);   \
    unsigned b0 = cvtpk(P[BASE + 4], P[BASE + 5]), b1 = cvtpk(P[BASE + 6], P[BASE + 7]);                              \
    auto r0 = __builtin_amdgcn_permlane32_swap(a0, b0, false, false); auto r1 = __builtin_amdgcn_permlane32_swap(a1, b1, false, false); \
    u32x4 w = {r0[0], r1[0], r0[1], r1[1]}; OUT = *reinterpret_cast<bf16x8*>(&w); } while (0)
__device__ __forceinline__ float halfswap_add(float v) {
    auto rr = __builtin_amdgcn_permlane32_swap(__float_as_uint(v), __float_as_uint(v), false, false);
    return __uint_as_float(rr[0]) + __uint_as_float(rr[1]);
}

__device__ __forceinline__ void ada_phase(const Params& p, unsigned char* lds) {
    float* sc = (float*)lds;
    float* red = (float*)(lds + 40960);
    float* mod = (float*)(p.ws + WS_MOD);
    const int tid = threadIdx.x;
    for (int j = blockIdx.x; j < 192; j += gridDim.x) {
        const int l = j / 96, n0 = (j % 96) * 64;
        for (int i = tid; i < 9 * 1024; i += NTHREADS) { const int r = i >> 10, k = i & 1023; const float v = r < 8 ? p.c[r * 1024 + k] : p.c_ctx[k]; sc[i] = v / (1.f + expf(-v)); }
        __syncthreads();
        const int col = tid & 63, ks = tid >> 6;
        float acc[9];
#pragma unroll
        for (int r = 0; r < 9; ++r) acc[r] = 0.f;
        const float* wp = p.ada_w + ((size_t)l * 1024 + ks * 128) * 6144 + n0 + col;
#pragma unroll 8
        for (int kk = 0; kk < 128; ++kk) { const float w = wp[(size_t)kk * 6144];
#pragma unroll
            for (int r = 0; r < 9; ++r) acc[r] += sc[r * 1024 + ks * 128 + kk] * w; }
#pragma unroll
        for (int r = 0; r < 9; ++r) red[(ks * 9 + r) * 64 + col] = acc[r];
        __syncthreads();
        for (int i = tid; i < 576; i += NTHREADS) { const int r = i >> 6, cc = i & 63; float s = p.ada_b[l * 6144 + n0 + cc];
            for (int k2 = 0; k2 < 8; ++k2) s += red[(k2 * 9 + r) * 64 + cc];
            mod[(size_t)(l * 9 + r) * 6144 + n0 + cc] = s; }
        __syncthreads();
    }
}
__device__ __forceinline__ void wconv_phase(const Params& p, unsigned char* lds) {
    float* tl = (float*)lds;
    const int tid = threadIdx.x;
    const int T0 = 16 * 60, T1 = T0 + 16 * 16, T2 = T1 + 16 * 48, T3 = T2 + 16 * 16, T4 = T3 + 16 * 88, T5 = T4 + 16 * 88, T6 = T5 + 44 * 16, T7 = T6 + 44 * 16;
    for (int t = blockIdx.x; t < T7; t += gridDim.x) {
        const float* src; bf16_t* dst; int K, N, NP, mode = 0, tt;
        if (t < T0) { src = p.even_w_in; dst = (bf16_t*)(p.ws + WS_W_EVIN); K = 1024; N = EV_N; NP = EV_NP; tt = t; }
        else if (t < T1) { src = p.even_w_out; dst = (bf16_t*)(p.ws + WS_W_EVOUT); K = 1024; N = 1024; NP = 1024; tt = t - T0; }
        else if (t < T2) { src = p.odd_w_in; dst = (bf16_t*)(p.ws + WS_W_ODIN); K = 1024; N = OD_N; NP = OD_N; tt = t - T1; }
        else if (t < T3) { src = p.odd_w_out; dst = (bf16_t*)(p.ws + WS_W_ODOUT); K = 1024; N = 1024; NP = 1024; tt = t - T2; }
        else if (t < T4) { src = p.ffn_w_in; dst = (bf16_t*)(p.ws + WS_W_FFIN); K = 1024; N = 2 * FF; NP = 2 * FF; mode = 1; tt = t - T3; }
        else if (t < T5) { src = p.ffn_w_in + (size_t)1024 * 2 * FF; dst = (bf16_t*)(p.ws + WS_W_FFIN) + (size_t)2 * FF * 1024; K = 1024; N = 2 * FF; NP = 2 * FF; mode = 1; tt = t - T4; }
        else if (t < T6) { src = p.ffn_w_out; dst = (bf16_t*)(p.ws + WS_W_FFOUT); K = FF; N = 1024; NP = 1024; tt = t - T5; }
        else { src = p.ffn_w_out + (size_t)FF * 1024; dst = (bf16_t*)(p.ws + WS_W_FFOUT) + (size_t)1024 * FF; K = FF; N = 1024; NP = 1024; tt = t - T6; }
        const int nnt = NP / 64; const int k0 = (tt / nnt) * 64, n0 = (tt % nnt) * 64;
        int sn0;
        if (mode == 1) { const int tb = n0 >> 8, bj = (n0 >> 7) & 1, i0 = n0 & 127; sn0 = bj * FF + tb * 128 + i0; } else sn0 = n0;
        for (int e = tid; e < 4096; e += NTHREADS) { const int kk = e >> 6, nn = e & 63; const int sn = sn0 + nn;
            tl[kk * 65 + nn] = (sn < N) ? src[(size_t)(k0 + kk) * N + sn] : 0.f; }
        __syncthreads();
        for (int e = tid; e < 2048; e += NTHREADS) { const int nn = e >> 5, k2 = (e & 31) * 2;
            *(unsigned*)(dst + (size_t)(n0 + nn) * K + k0 + k2) = cvtpk(tl[k2 * 65 + nn], tl[(k2 + 1) * 65 + nn]); }
        __syncthreads();
    }
}

__device__ __forceinline__ void norm_phase(const Params& p, const float* xlat, const float* xctx, int l, int which, int nrows) {
    const int lane = threadIdx.x & 63, wid = threadIdx.x >> 6;
    bf16_t* h = (bf16_t*)(p.ws + WS_H);
    const float* mod = (const float*)(p.ws + WS_MOD) + (size_t)l * 9 * 6144;
    const float* gain = (which ? p.norm_ffn : p.norm_mix) + l * 1024;
    const int shoff = which ? 3072 : 0, scoff = which ? 4096 : 1024;
    for (int row = blockIdx.x * 8 + wid; row < nrows; row += gridDim.x * 8) {
        const bool lat = row < NLAT;
        const float* src = lat ? xlat + (size_t)row * DM : xctx + (size_t)(row - NLAT) * DM;
        const float* mr = mod + (size_t)(lat ? (row >> 13) : 8) * 6144;
        f32x4 v[4]; float ss = 0.f;
#pragma unroll
        for (int i = 0; i < 4; ++i) { v[i] = *(const f32x4*)(src + lane * 4 + 256 * i); ss += v[i][0] * v[i][0] + v[i][1] * v[i][1] + v[i][2] * v[i][2] + v[i][3] * v[i][3]; }
#pragma unroll
        for (int o = 1; o < 64; o <<= 1) ss += __shfl_xor(ss, o);
        const float rstd = rsqrtf(ss * (1.f / 1024.f) + 1e-6f);
#pragma unroll
        for (int i = 0; i < 4; ++i) { const int c0 = lane * 4 + 256 * i;
            const f32x4 g = *(const f32x4*)(gain + c0), s1 = *(const f32x4*)(mr + scoff + c0), sh = *(const f32x4*)(mr + shoff + c0);
            float y[4];
#pragma unroll
            for (int j = 0; j < 4; ++j) y[j] = v[i][j] * rstd * g[j] * (1.f + s1[j]) + sh[j];
            u32x2 w; w.x = cvtpk(y[0], y[1]); w.y = cvtpk(y[2], y[3]);
            *(u32x2*)(h + (size_t)row * DM + c0) = w; }
    }
}

__device__ __forceinline__ void prep0_phase(const Params& p) {
    const int lane0 = threadIdx.x & 63, wid = threadIdx.x >> 6;
    bf16_t* proj = (bf16_t*)(p.ws + WS_PROJ);
    bf16_t* qkvp = (bf16_t*)p.out;
    float* gbuf = (float*)(p.ws + WS_GATES);
    const float* ropec = (const float*)(p.ws + WS_ROPE); const float* ropes = ropec + SEQ * 32;
    constexpr int RB = 8;
    for (int blk = blockIdx.x * 8 + wid; blk < MTOT / RB; blk += gridDim.x * 8) {
        int lane = lane0; asm volatile("" : "+v"(lane));
        const int row0 = blk * RB; const bool lat = row0 < NLAT; const int t0 = lat ? (row0 & 8191) : ((row0 - NLAT) & 255); const int len = lat ? SEQ : CTXL;
        const int dsub = (lane & 7) * 8;
        {
            float gq[8], gk[8];
#pragma unroll
            for (int i = 0; i < 8; ++i) { gq[i] = p.diff_qk_gain[dsub + i] * (0.125f * 1.4426950408889634f); gk[i] = p.diff_qk_gain[64 + dsub + i]; }
            for (int i = 0; i < RB; ++i) {
                bf16_t* P = proj + (size_t)(row0 + i) * EV_NP;
                f32x4 c4 = {1.f, 1.f, 1.f, 1.f}, s4 = {0.f, 0.f, 0.f, 0.f};
                if (lat) { c4 = *(const f32x4*)(ropec + (t0 + i) * 32 + (lane & 7) * 4); s4 = *(const f32x4*)(ropes + (t0 + i) * 32 + (lane & 7) * 4); }
#pragma unroll
                for (int which = 0; which < 2; ++which) {
                    float v[8]; unpack8(*(const bf16x8*)(P + which * 512 + lane * 8), v);
                    float ss = 0.f;
#pragma unroll
                    for (int e = 0; e < 8; ++e) ss += v[e] * v[e];
                    ss += __shfl_xor(ss, 1); ss += __shfl_xor(ss, 2); ss += __shfl_xor(ss, 4);
                    const float rstd = rsqrtf(ss * (1.f / 64.f) + 1e-6f);
#pragma unroll
                    for (int e = 0; e < 8; ++e) v[e] = v[e] * rstd * (which ? gk[e] : gq[e]);
#pragma unroll
                    for (int e = 0; e < 4; ++e) { const float x0 = v[2 * e], x1 = v[2 * e + 1]; v[2 * e] = x0 * c4[e] - x1 * s4[e]; v[2 * e + 1] = x0 * s4[e] + x1 * c4[e]; }
                    *(bf16x8*)(P + which * 512 + lane * 8) = pack8(v);
                }
            }
        }
#pragma unroll 1
        for (int g = 0; g < 3; ++g) {
            const int c0 = g * 512 + lane * 8;
            float w[5][8];
#pragma unroll
            for (int j = 0; j < 5; ++j) { const f32x4 w0 = *(const f32x4*)(p.gdn_conv + j * 1536 + c0), w1 = *(const f32x4*)(p.gdn_conv + j * 1536 + c0 + 4);
#pragma unroll
                for (int e = 0; e < 4; ++e) { w[j][e] = w0[e]; w[j][4 + e] = w1[e]; } }
            float xm2[8], xm1[8], x0[8], xp1[8], xp2[8];
            const bf16_t* src = proj + (size_t)row0 * EV_NP + 1536 + c0;
#define LDROW(dst, dt) do { if (t0 + (dt) >= 0 && t0 + (dt) < len) unpack8(*(const bf16x8*)(src + (ptrdiff_t)(dt) * EV_NP), dst); else { _Pragma("unroll") for (int e_ = 0; e_ < 8; ++e_) dst[e_] = 0.f; } } while (0)
            LDROW(xm2, -2); LDROW(xm1, -1); LDROW(x0, 0); LDROW(xp1, 1);
            const float nsc = g == 0 ? 0.08838834764831845f : 1.f;
            for (int i = 0; i < RB; ++i) {
                LDROW(xp2, i + 2);
                float y[8];
#pragma unroll
                for (int e = 0; e < 8; ++e) { y[e] = w[0][e] * xm2[e] + w[1][e] * xm1[e] + w[2][e] * x0[e] + w[3][e] * xp1[e] + w[4][e] * xp2[e]; y[e] = y[e] / (1.f + __expf(-y[e])); }
                if (g < 2) { float ss = 0.f;
#pragma unroll
                    for (int e = 0; e < 8; ++e) ss += y[e] * y[e];
                    ss += __shfl_xor(ss, 1); ss += __shfl_xor(ss, 2); ss += __shfl_xor(ss, 4); ss += __shfl_xor(ss, 8);
                    const float sc_ = rsqrtf(ss + 1e-6f) * nsc;
#pragma unroll
                    for (int e = 0; e < 8; ++e) y[e] *= sc_; }
                *(bf16x8*)(qkvp + (size_t)(row0 + i) * 1536 + c0) = pack8(y);
#pragma unroll
                for (int e = 0; e < 8; ++e) { xm2[e] = xm1[e]; xm1[e] = x0[e]; x0[e] = xp1[e]; xp1[e] = xp2[e]; }
            }
#undef LDROW
        }
#pragma unroll
        for (int k = 0; k < RB / 4; ++k) { const int idx = lane + 64 * k, i = idx >> 4, gi = idx & 15;
            const float gvv = bf2f(proj[(size_t)(row0 + i) * EV_NP + 3584 + gi]); float o;
            if (gi < 8) o = 1.f / (1.f + expf(-gvv));
            else { const float z = gvv + p.gdn_dt_bias[gi - 8]; const float sp = z > 20.f ? z : log1pf(expf(z)); o = -expf(p.gdn_a_log[gi - 8]) * sp; }
            gbuf[(size_t)(row0 + i) * 16 + gi] = o; }
    }
}

__device__ __forceinline__ int gdn_row(int b, int pc, int tau, int dir) {
    const int tt = dir ? 63 - tau : tau;
    return pc < 4 ? NLAT + b * CTXL + pc * 64 + tt : b * SEQ + (pc - 4) * 64 + tt;
}
__device__ __forceinline__ void gdn_pre_phase(const Params& p, unsigned char* lds) {
    const int lane = threadIdx.x & 63, wid = threadIdx.x >> 6;
    float* Lw = (float*)(lds + wid * 16896);
    float* gs = Lw + 4096; float* bs = gs + 64;
    const bf16_t* qkvp = (const bf16_t*)p.out;
    const float* gbuf = (const float*)(p.ws + WS_GATES);
    bf16_t* Tb = (bf16_t*)(p.ws + WS_T); bf16_t* Ab = (bf16_t*)(p.ws + WS_AQK);
    float* gv = (float*)(p.ws + WS_GV); float* bv = (float*)(p.ws + WS_BV);
    const int lane0 = lane;
    for (int cp = blockIdx.x * 8 + wid; cp < NCHUNKP; cp += gridDim.x * 8) {
        int lane = lane0; asm volatile("" : "+v"(lane));
        const int r32 = lane & 31, hi = lane >> 5;
        const int pc = cp % 132, ch = cp / 132, dir = ch & 1, h = (ch >> 1) & 3, b = ch >> 3;
        { const int R = gdn_row(b, pc, lane, dir);
          float g = gbuf[(size_t)R * 16 + 8 + dir * 4 + h]; const float be = gbuf[(size_t)R * 16 + dir * 4 + h];
#pragma unroll
          for (int o = 1; o < 64; o <<= 1) { const float t = __shfl_up(g, o); if (lane >= o) g += t; }
          gs[lane] = g; bs[lane] = be; const float gl_ = __shfl(g, 63); gv[(size_t)cp * 64 + lane] = expf(g); bv[(size_t)cp * 64 + lane] = be; ((float*)(p.ws + WS_EL))[(size_t)cp * 64 + lane] = expf(gl_ - g); }
        bf16x8 kf[2][8];
#pragma unroll
        for (int mi = 0; mi < 2; ++mi) { const size_t R = (size_t)gdn_row(b, pc, 32 * mi + r32, dir);
#pragma unroll
            for (int d0 = 0; d0 < 8; ++d0) kf[mi][d0] = *(const bf16x8*)(qkvp + R * 1536 + 512 + h * 128 + d0 * 16 + hi * 8); }
        bf16_t* Ao = Ab + (size_t)cp * 4096;
#pragma unroll
        for (int mi = 0; mi < 2; ++mi) {
            bf16x8 qf[8];
            { const size_t R = (size_t)gdn_row(b, pc, 32 * mi + r32, dir);
#pragma unroll
              for (int d0 = 0; d0 < 8; ++d0) qf[d0] = *(const bf16x8*)(qkvp + R * 1536 + h * 128 + d0 * 16 + hi * 8); }
#pragma unroll
            for (int ni = 0; ni <= mi; ++ni) {
                f32x16 ckk = {}, cqk = {};
#pragma unroll
                for (int d0 = 0; d0 < 8; ++d0) { ckk = __builtin_amdgcn_mfma_f32_32x32x16_bf16(kf[mi][d0], kf[ni][d0], ckk, 0, 0, 0);
                                                 cqk = __builtin_amdgcn_mfma_f32_32x32x16_bf16(qf[d0], kf[ni][d0], cqk, 0, 0, 0); }
                const int sg = 32 * ni + r32; const float gsg = gs[sg];
#pragma unroll
                for (int r = 0; r < 16; ++r) { const int tau = 32 * mi + crow(r, hi);
                    const float dec = tau >= sg ? expf(gs[tau] - gsg) : 0.f;
                    Lw[tau * 64 + sg] = tau > sg ? bs[tau] * dec * ckk[r] : 0.f;
                    Ao[tau * 64 + sg] = f2bf(cqk[r] * dec); }
                asm volatile("" ::: "memory");
            }
        }
#pragma unroll
        for (int r = 0; r < 16; ++r) Ao[crow(r, hi) * 64 + 32 + r32] = 0;
        float Tc[64];
#pragma unroll
        for (int i = 0; i < 64; ++i) { float a = (i == lane) ? 1.f : 0.f;
#pragma unroll
            for (int j = 0; j < i; ++j) a -= Lw[i * 64 + j] * Tc[j];
            Tc[i] = a; asm volatile("" ::: "memory"); }
        bf16_t* To = Tb + (size_t)cp * 4096;
#pragma unroll
        for (int i = 0; i < 64; ++i) To[i * 64 + lane] = f2bf(Tc[i]);
    }
}

constexpr int G_KV = 0, G_QA = 16384, G_TT = 32768, G_AQ = G_TT + 9216, G_RT = G_AQ + 9216, G_UT = G_RT + 4608, G_UP = G_UT + 4608,
              G_ST = G_UP + 4608, G_VS = G_ST + 8704, G_GS = G_VS + 4096, G_BS = G_GS + 256, G_EL = G_BS + 256, G_END = G_EL + 256;
__device__ __forceinline__ void gdn_scan_phase(const Params& p, unsigned char* lds) {
    const int tid = threadIdx.x, lane0 = tid & 63, wid = tid >> 6;
    const bf16_t* qkvp = (const bf16_t*)p.out;
    const bf16_t* Tb = (const bf16_t*)(p.ws + WS_T); const bf16_t* Ab = (const bf16_t*)(p.ws + WS_AQK);
    const float* gv = (const float*)(p.ws + WS_GV); const float* bv = (const float*)(p.ws + WS_BV);
    bf16_t* obuf = (bf16_t*)(p.ws + WS_H);
    const float* gsl = (const float*)(lds + G_GS); const float* bsl = (const float*)(lds + G_BS); const float* esl = (const float*)(lds + G_EL);
    const int sr = tid >> 4, sc = (tid & 15) * 8;
    const int vblk = (gridDim.x % 8 == 0) ? (int)((blockIdx.x & 7) * (gridDim.x >> 3) + (blockIdx.x >> 3)) : (int)blockIdx.x;
    for (int wi = vblk; wi < 256; wi += gridDim.x) {
        const int chain = wi >> 2, cs = wi & 3, b = chain >> 3, h = (chain >> 1) & 3, dir = chain & 1;
        f32x16 Sacc = {};
        for (int i = tid; i < 8704 / 4; i += NTHREADS) ((unsigned*)(lds + G_ST))[i] = 0u;
        bf16x8 sk0, sk1, sq0, sq1, sT, sA, sV; float sg = 0.f;
#define GLOAD(step) do { const int pc_ = dir == 0 ? (step) : ((step) < 4 ? 3 - (step) : 4 + 127 - ((step) - 4)); \
        const size_t cp_ = (size_t)chain * 132 + pc_; \
        const size_t R0_ = (size_t)gdn_row(b, pc_, sr, dir), R1_ = (size_t)gdn_row(b, pc_, 32 + sr, dir); \
        sk0 = *(const bf16x8*)(qkvp + R0_ * 1536 + 512 + h * 128 + sc); sk1 = *(const bf16x8*)(qkvp + R1_ * 1536 + 512 + h * 128 + sc); \
        sq0 = *(const bf16x8*)(qkvp + R0_ * 1536 + h * 128 + sc); sq1 = *(const bf16x8*)(qkvp + R1_ * 1536 + h * 128 + sc); \
        sT = *(const bf16x8*)(Tb + cp_ * 4096 + tid * 8); sA = *(const bf16x8*)(Ab + cp_ * 4096 + tid * 8); \
        if (tid < 256) { const size_t Rv_ = (size_t)gdn_row(b, pc_, tid >> 2, dir); sV = *(const bf16x8*)(qkvp + Rv_ * 1536 + 1024 + h * 128 + cs * 32 + (tid & 3) * 8); } \
        if (tid < 64) sg = gv[cp_ * 64 + tid]; else if (tid < 128) sg = bv[cp_ * 64 + tid - 64]; else if (tid < 192) sg = ((const float*)(p.ws + WS_EL))[cp_ * 64 + tid - 128]; } while (0)
#define GWRITE() do { *(bf16x8*)(lds + G_KV + v_st(sr, sc)) = sk0; *(bf16x8*)(lds + G_KV + v_st(32 + sr, sc)) = sk1; \
        *(bf16x8*)(lds + G_QA + KSWZ(sr, sc * 2)) = sq0; *(bf16x8*)(lds + G_QA + KSWZ(32 + sr, sc * 2)) = sq1; \
        *(bf16x8*)(lds + G_TT + (tid >> 3) * 144 + (tid & 7) * 16) = sT; *(bf16x8*)(lds + G_AQ + (tid >> 3) * 144 + (tid & 7) * 16) = sA; \
        if (tid < 256) *(bf16x8*)(lds + G_VS + (tid >> 2) * 64 + (tid & 3) * 16) = sV; \
        if (tid < 192) ((float*)(lds + G_GS))[tid] = sg; } while (0)
        GLOAD(0);
        for (int step = 0; step < 132; ++step) {
            GWRITE();
            __syncthreads();
            if (step + 1 < 132) GLOAD(step + 1);
            int lane = lane0; asm volatile("" : "+v"(lane));
            const int r32 = lane & 31, hi = lane >> 5;
            const int vb0 = (int)(uintptr_t)(lds + G_KV) + v_rd_base(lane);
            const int pc = dir == 0 ? step : (step < 4 ? 3 - step : 4 + 127 - (step - 4));
            f32x16 acc = {};
            const int mi = wid & 1;
            if (wid < 4) {
                f32x16 acc2 = {};
                if (wid < 2) {
#pragma unroll
                    for (int d0 = 0; d0 < 8; d0 += 2) {
                        const bf16x8 a0 = *(const bf16x8*)(lds + G_KV + v_st(32 * mi + r32, d0 * 16 + hi * 8)), a1 = *(const bf16x8*)(lds + G_KV + v_st(32 * mi + r32, d0 * 16 + 16 + hi * 8));
                        const bf16x8 b0 = *(const bf16x8*)(lds + G_ST + r32 * 272 + (d0 * 16 + hi * 8) * 2), b1 = *(const bf16x8*)(lds + G_ST + r32 * 272 + (d0 * 16 + 16 + hi * 8) * 2);
                        acc = __builtin_amdgcn_mfma_f32_32x32x16_bf16(a0, b0, acc, 0, 0, 0);
                        acc2 = __builtin_amdgcn_mfma_f32_32x32x16_bf16(a1, b1, acc2, 0, 0, 0); }
                } else {
#pragma unroll
                    for (int d0 = 0; d0 < 8; d0 += 2) {
                        const bf16x8 a0 = *(const bf16x8*)(lds + G_QA + KSWZ(32 * mi + r32, (d0 * 16 + hi * 8) * 2)), a1 = *(const bf16x8*)(lds + G_QA + KSWZ(32 * mi + r32, (d0 * 16 + 16 + hi * 8) * 2));
                        const bf16x8 b0 = *(const bf16x8*)(lds + G_ST + r32 * 272 + (d0 * 16 + hi * 8) * 2), b1 = *(const bf16x8*)(lds + G_ST + r32 * 272 + (d0 * 16 + 16 + hi * 8) * 2);
                        acc = __builtin_amdgcn_mfma_f32_32x32x16_bf16(a0, b0, acc, 0, 0, 0);
                        acc2 = __builtin_amdgcn_mfma_f32_32x32x16_bf16(a1, b1, acc2, 0, 0, 0); }
                }
#pragma unroll
                for (int r = 0; r < 16; ++r) acc[r] += acc2[r];
                if (wid < 2) {
#pragma unroll
                    for (int g4 = 0; g4 < 4; ++g4) { float rv[4];
#pragma unroll
                        for (int j = 0; j < 4; ++j) { const int tau = 32 * mi + 8 * g4 + 4 * hi + j;
                            const float vv = bf2f(*(const bf16_t*)(lds + G_VS + tau * 64 + r32 * 2));
                            rv[j] = bsl[tau] * (vv - gsl[tau] * acc[g4 * 4 + j]); }
                        u32x2 w; w.x = cvtpk(rv[0], rv[1]); w.y = cvtpk(rv[2], rv[3]);
                        *(u32x2*)(lds + G_RT + r32 * 144 + (32 * mi + 8 * g4 + 4 * hi) * 2) = w; }
                } else {
#pragma unroll
                    for (int r = 0; r < 16; ++r) acc[r] *= gsl[32 * mi + crow(r, hi)];
                }
            }
            __syncthreads();
            if (wid < 2) {
                f32x16 u = {}, u2 = {};
#pragma unroll
                for (int s = 0; s < 4; s += 2) {
                    const bf16x8 a0 = *(const bf16x8*)(lds + G_TT + (32 * mi + r32) * 144 + (16 * s + hi * 8) * 2), a1 = *(const bf16x8*)(lds + G_TT + (32 * mi + r32) * 144 + (16 * s + 16 + hi * 8) * 2);
                    const bf16x8 b0 = *(const bf16x8*)(lds + G_RT + r32 * 144 + (16 * s + hi * 8) * 2), b1 = *(const bf16x8*)(lds + G_RT + r32 * 144 + (16 * s + 16 + hi * 8) * 2);
                    u = __builtin_amdgcn_mfma_f32_32x32x16_bf16(a0, b0, u, 0, 0, 0);
                    u2 = __builtin_amdgcn_mfma_f32_32x32x16_bf16(a1, b1, u2, 0, 0, 0); }
#pragma unroll
                for (int r = 0; r < 16; ++r) u[r] += u2[r];
#pragma unroll
                for (int g4 = 0; g4 < 4; ++g4) { float uv[4], up[4];
#pragma unroll
                    for (int j = 0; j < 4; ++j) { const int tau = 32 * mi + 8 * g4 + 4 * hi + j; uv[j] = u[g4 * 4 + j]; up[j] = uv[j] * esl[tau]; }
                    u32x2 w; w.x = cvtpk(uv[0], uv[1]); w.y = cvtpk(uv[2], uv[3]);
                    *(u32x2*)(lds + G_UT + r32 * 144 + (32 * mi + 8 * g4 + 4 * hi) * 2) = w;
                    u32x2 w2; w2.x = cvtpk(up[0], up[1]); w2.y = cvtpk(up[2], up[3]);
                    *(u32x2*)(lds + G_UP + r32 * 144 + (32 * mi + 8 * g4 + 4 * hi) * 2) = w2; }
            }
            __syncthreads();
            if (wid == 2 || wid == 3) {
#pragma unroll
                for (int s = 0; s < 4; ++s) {
                    const bf16x8 a = *(const bf16x8*)(lds + G_AQ + (32 * mi + r32) * 144 + (16 * s + hi * 8) * 2);
                    const bf16x8 bb = *(const bf16x8*)(lds + G_UT + r32 * 144 + (16 * s + hi * 8) * 2);
                    acc = __builtin_amdgcn_mfma_f32_32x32x16_bf16(a, bb, acc, 0, 0, 0); }
#pragma unroll
                for (int r = 0; r < 16; ++r) { const size_t R = (size_t)gdn_row(b, pc, 32 * mi + crow(r, hi), dir);
                    obuf[((size_t)dir * MTOT + R) * 512 + h * 128 + cs * 32 + r32] = f2bf(acc[r]); }
            } else if (wid >= 4) {
                const float gl = gsl[63];
#pragma unroll
                for (int r = 0; r < 16; ++r) Sacc[r] *= gl;
                const bf16x8 pa0 = *(const bf16x8*)(lds + G_UP + r32 * 144 + (0 + hi * 8) * 2), pa1 = *(const bf16x8*)(lds + G_UP + r32 * 144 + (16 + hi * 8) * 2),
                             pa2 = *(const bf16x8*)(lds + G_UP + r32 * 144 + (32 + hi * 8) * 2), pa3 = *(const bf16x8*)(lds + G_UP + r32 * 144 + (48 + hi * 8) * 2);
                const int d0 = wid - 4;
                if (d0 == 0) pv_one<0>(Sacc, vb0, pa0, pa1, pa2, pa3); else if (d0 == 1) pv_one<1>(Sacc, vb0, pa0, pa1, pa2, pa3);
                else if (d0 == 2) pv_one<2>(Sacc, vb0, pa0, pa1, pa2, pa3); else pv_one<3>(Sacc, vb0, pa0, pa1, pa2, pa3);
#pragma unroll
                for (int r = 0; r < 16; ++r) *(bf16_t*)(lds + G_ST + crow(r, hi) * 272 + (32 * d0 + r32) * 2) = f2bf(Sacc[r]);
            }
            __syncthreads();
        }
#undef GLOAD
#undef GWRITE
    }
}

__device__ __forceinline__ void gdn_post_phase(const Params& p) {
    const int lane = threadIdx.x & 63, wid = threadIdx.x >> 6;
    const bf16_t* obuf = (const bf16_t*)(p.ws + WS_H);
    const bf16_t* proj = (const bf16_t*)(p.ws + WS_PROJ);
    bf16_t* mix = (bf16_t*)(p.ws + WS_MIX);
    const int d = (lane & 15) * 8;
    for (int row = blockIdx.x * 8 + wid; row < MTOT; row += gridDim.x * 8) {
        float a[8], bb[8], g[8], y[8];
        unpack8(*(const bf16x8*)(obuf + (size_t)row * 512 + lane * 8), a);
        unpack8(*(const bf16x8*)(obuf + ((size_t)MTOT + row) * 512 + lane * 8), bb);
        unpack8(*(const bf16x8*)(proj + (size_t)row * EV_NP + 3072 + lane * 8), g);
        float ss = 0.f;
#pragma unroll
        for (int i = 0; i < 8; ++i) { a[i] += bb[i]; ss += a[i] * a[i]; }
        ss += __shfl_xor(ss, 1); ss += __shfl_xor(ss, 2); ss += __shfl_xor(ss, 4); ss += __shfl_xor(ss, 8);
        const float rstd = rsqrtf(ss * (1.f / 128.f) + 1e-6f);
#pragma unroll
        for (int i = 0; i < 8; ++i) y[i] = a[i] * rstd * p.gdn_norm[d + i] * (g[i] / (1.f + expf(-g[i])));
        *(bf16x8*)(mix + (size_t)row * DM + 512 + lane * 8) = pack8(y);
    }
}

__device__ __forceinline__ void diffattn_phase(const Params& p, unsigned char* lds) {
    const int tid = threadIdx.x, wid = tid >> 6, lane = tid & 63, r32 = lane & 31, hi = lane >> 5;
    const bf16_t* proj = (const bf16_t*)(p.ws + WS_PROJ);
    bf16_t* mix = (bf16_t*)(p.ws + WS_MIX);
    float s01 = 0.f, s23 = 0.f;
    for (int i = 0; i < 64; ++i) { s01 += p.diff_lambda[i] * p.diff_lambda[64 + i]; s23 += p.diff_lambda[128 + i] * p.diff_lambda[192 + i]; }
    const float lam = expf(s01) - expf(s23) + 0.2f;
    float* X = (float*)lds; float* li = (float*)(lds + 131072) + wid * 64;
    LAS unsigned char* ldsl = (LAS unsigned char*)lds;
    int koff[2], voff[2];
#pragma unroll
    for (int i = 0; i < 2; ++i) {
        const int g = i * 512 + tid;
        { const int row = g >> 4, cg = (g & 15) ^ (row & 7); koff[i] = row * EV_NP + cg * 8; }
        { const int o = g * 16, st = o >> 9, w = o & 511, kk = (st >> 2) * 8 + (w >> 6);
          const int k = (kk & ~0xC) | ((kk & 4) << 1) | ((kk & 8) >> 1), cc = (st & 3) * 32 + ((w & 63) >> 4) * 8; voff[i] = k * EV_NP + cc; }
    }
    const int vbase = (int)(uintptr_t)lds + v_rd_base(lane);
    const int map = wid >> 2, wq = wid & 3;
    unsigned char* Qs = lds + 98304 + wid * 4096 + lane * 16;
    const int vblk = (gridDim.x % 8 == 0) ? (int)((blockIdx.x & 7) * (gridDim.x >> 3) + (blockIdx.x >> 3)) : (int)blockIdx.x;
    for (int it = vblk; it < 2112; it += gridDim.x) {
        int b, h, NT, qrow0;
        if (it < 2048) { b = it >> 8; h = (it >> 6) & 3; const int qb = it & 63; NT = 132; qrow0 = b * SEQ + qb * 128; }
        else { const int j = it - 2048; b = j >> 3; h = (j >> 1) & 3; NT = 4; qrow0 = NLAT + b * CTXL + (j & 1) * 128; }
        { const bf16_t* qp = proj + (size_t)(qrow0 + 32 * wq + r32) * EV_NP + h * 128 + map * 64 + hi * 8;
#pragma unroll
          for (int d0 = 0; d0 < 4; ++d0) *(bf16x8*)(Qs + d0 * 1024) = *(const bf16x8*)(qp + d0 * 16); }
        f32x16 o[4] = {}; float lsum = 0.f;
#define DDMA(j, bo) do { const bf16_t* pp_ = proj + (size_t)((j) < 4 ? NLAT + b * CTXL + 64 * (j) : b * SEQ + 64 * ((j) - 4)) * EV_NP + h * 128; \
        _Pragma("unroll") for (int i_ = 0; i_ < 2; ++i_) { \
            __builtin_amdgcn_global_load_lds((const unsigned*)(pp_ + 1024 + voff[i_]), (LAS unsigned*)(ldsl + (bo) + i_ * 8192 + wid * 1024), 16, 0, 0); \
            __builtin_amdgcn_global_load_lds((const unsigned*)(pp_ + 512 + koff[i_]), (LAS unsigned*)(ldsl + (bo) + 16384 + i_ * 8192 + wid * 1024), 16, 0, 0); } } while (0)
#define DQK(P0, P1, bo) do { P0 = (f32x16){}; P1 = (f32x16){}; const unsigned char* Ks_ = lds + (bo) + 16384; \
        _Pragma("unroll") for (int d0 = 0; d0 < 4; ++d0) { const int cb_ = (map * 64 + d0 * 16 + hi * 8) * 2; \
            const bf16x8 b0_ = *(const bf16x8*)(Ks_ + KSWZ(r32, cb_)), b1_ = *(const bf16x8*)(Ks_ + KSWZ(32 + r32, cb_)); \
            const bf16x8 qd_ = *(const bf16x8*)(Qs + d0 * 1024); \
            P0 = __builtin_amdgcn_mfma_f32_32x32x16_bf16(b0_, qd_, P0, 0, 0, 0); \
            P1 = __builtin_amdgcn_mfma_f32_32x32x16_bf16(b1_, qd_, P1, 0, 0, 0); } } while (0)
#define DSM(P0, P1) do { _Pragma("unroll") for (int r = 0; r < 16; ++r) { P0[r] = __builtin_amdgcn_exp2f(P0[r]); P1[r] = __builtin_amdgcn_exp2f(P1[r]); lsum += P0[r] + P1[r]; } \
        PK4(P0, 0, pa0); PK4(P0, 8, pa1); PK4(P1, 0, pa2); PK4(P1, 8, pa3); } while (0)
#define DSTEP(N0, N1, O0, O1, j) do { if ((j) + 1 < NT) DDMA((j) + 1, bnext); \
        DQK(N0, N1, bcur); DSM(O0, O1); pv_d0(o, vbase + bprev, pa0, pa1, pa2, pa3); \
        asm volatile("s_waitcnt vmcnt(0)" ::: "memory"); __syncthreads(); \
        { const int t_ = bprev; bprev = bcur; bcur = bnext; bnext = t_; } } while (0)
        f32x16 pA0, pA1, pB0, pB1; bf16x8 pa0, pa1, pa2, pa3;
        DDMA(0, 0); DDMA(1, 32768); asm volatile("s_waitcnt vmcnt(0)" ::: "memory"); __syncthreads();
        DQK(pA0, pA1, 0);
        int bprev = 0, bcur = 32768, bnext = 65536;
        for (int j = 1; j + 1 < NT; j += 2) { DSTEP(pB0, pB1, pA0, pA1, j); DSTEP(pA0, pA1, pB0, pB1, j + 1); }
        DSTEP(pB0, pB1, pA0, pA1, NT - 1);
        DSM(pB0, pB1); pv_d0(o, vbase + bprev, pa0, pa1, pa2, pa3);
        __syncthreads();
#undef DDMA
#undef DQK
#undef DSM
#undef DSTEP
        const float lt = halfswap_add(lsum);
        if (hi == 0) li[r32] = lt;
        asm volatile("s_waitcnt lgkmcnt(0)" ::: "memory");
        float rli[16];
#pragma unroll
        for (int r = 0; r < 16; ++r) rli[r] = 1.f / li[crow(r, hi)];
        if (map == 1) {
#pragma unroll
            for (int d0 = 0; d0 < 4; ++d0)
#pragma unroll
                for (int r = 0; r < 16; ++r) X[(wq * 64 + d0 * 16 + r) * 64 + lane] = o[d0][r] * rli[r] * lam;
        }
        __syncthreads();
        if (map == 0) {
#pragma unroll
            for (int d0 = 0; d0 < 4; ++d0)
#pragma unroll
                for (int r = 0; r < 16; ++r) o[d0][r] = o[d0][r] * rli[r] - X[(wq * 64 + d0 * 16 + r) * 64 + lane];
#pragma unroll
            for (int r = 0; r < 16; ++r) {
                float ss = o[0][r] * o[0][r] + o[1][r] * o[1][r] + o[2][r] * o[2][r] + o[3][r] * o[3][r];
                ss += __shfl_xor(ss, 1); ss += __shfl_xor(ss, 2); ss += __shfl_xor(ss, 4); ss += __shfl_xor(ss, 8); ss += __shfl_xor(ss, 16);
                const float rstd = rsqrtf(ss * (1.f / 128.f) + 1e-6f) * 0.8f;
                bf16_t* mp = mix + (size_t)(qrow0 + 32 * wq + crow(r, hi)) * DM + h * 128 + r32;
#pragma unroll
                for (int d0 = 0; d0 < 4; ++d0) mp[32 * d0] = f2bf(o[d0][r] * rstd * p.diff_subln[32 * d0 + r32]);
            }
        }
        __syncthreads();
    }
}

__device__ __forceinline__ void natten_phase(const Params& p, unsigned char* lds) {
    const int tid = threadIdx.x, wid = tid >> 6, lane = tid & 63, r32 = lane & 31, hi = lane >> 5;
    const bf16_t* proj = (const bf16_t*)(p.ws + WS_PROJ);
    bf16_t* mix = (bf16_t*)(p.ws + WS_MIX);
    constexpr float L2E = 1.4426950408889634f;
    unsigned char* Vl = lds; unsigned char* Kl = lds + 32768;
    float* rpbs = (float*)(lds + 65536);
    float* li = (float*)(lds + 133120) + wid * 64;
    unsigned char* Qs = lds + 67584 + wid * 8192 + lane * 16;
    const int sr = tid >> 4, sc = (tid & 15) * 8, vst0 = v_st(sr, sc), vst1 = v_st(32 + sr, sc);
    const int vb0 = (int)(uintptr_t)Vl + v_rd_base(lane);
    const float* gkp = p.na_qk_gain + 128 + sc;
    const int vblk = (gridDim.x % 8 == 0) ? (int)((blockIdx.x & 7) * (gridDim.x >> 3) + (blockIdx.x >> 3)) : (int)blockIdx.x;
    for (int it = vblk; it < 2048; it += gridDim.x) {
        const int b = it >> 8, h = (it >> 5) & 7, rq = it & 31;
        const int grow = 4 * rq + (wid >> 1), qc = (wid & 1) * 32 + r32;
        const size_t qR = (size_t)b * SEQ + grow * 64 + qc;
        for (int i = tid; i < 465; i += NTHREADS) rpbs[i] = p.na_rpb[h * 465 + i] * L2E;
        { float ss = 0.f;
#pragma unroll
          for (int d0 = 0; d0 < 8; ++d0) { float qv[8]; unpack8(*(const bf16x8*)(proj + qR * OD_N + h * 128 + d0 * 16 + hi * 8), qv);
#pragma unroll
              for (int i = 0; i < 8; ++i) ss += qv[i] * qv[i]; }
          ss = halfswap_add(ss);
          const float rs = rsqrtf(ss * (1.f / 128.f) + 1e-6f) * 0.08838834764831845f * L2E;
#pragma unroll
          for (int d0 = 0; d0 < 8; ++d0) { float qv[8]; unpack8(*(const bf16x8*)(proj + qR * OD_N + h * 128 + d0 * 16 + hi * 8), qv);
#pragma unroll
              for (int i = 0; i < 8; ++i) qv[i] *= rs * p.na_qk_gain[d0 * 16 + hi * 8 + i];
              *(bf16x8*)(Qs + d0 * 1024) = pack8(qv); } }
        int lo = 4 * rq - 4; lo = lo < 0 ? 0 : (lo > 120 ? 120 : lo);
        int hi_r = 4 * rq + 3 - 4; hi_r = hi_r < 0 ? 0 : (hi_r > 120 ? 120 : hi_r); hi_r += 7;
        const int nlat = hi_r - lo + 1, NT = nlat + 4;
        int wsr = grow - 4; wsr = wsr < 0 ? 0 : (wsr > 120 ? 120 : wsr);
        int cst = qc - 8; cst = cst < 0 ? 0 : (cst > 48 ? 48 : cst);
        f32x16 o[4] = {}; float lsum = 0.f;
        bf16x8 vs0, vs1, ks0, ks1;
#define NLOAD(j) do { const size_t R0_ = (size_t)((j) < nlat ? b * SEQ + (lo + (j)) * 64 : NLAT + b * CTXL + 64 * ((j) - nlat)) + sr; \
        const bf16_t* pp_ = proj + R0_ * OD_N + h * 128 + sc; \
        vs0 = *(const bf16x8*)(pp_ + 2048); vs1 = *(const bf16x8*)(pp_ + 2048 + (size_t)32 * OD_N); \
        ks0 = *(const bf16x8*)(pp_ + 1024); ks1 = *(const bf16x8*)(pp_ + 1024 + (size_t)32 * OD_N); } while (0)
#define KNORM(kx) do { float f_[8]; unpack8(kx, f_); float ss_ = 0.f; _Pragma("unroll") for (int i_ = 0; i_ < 8; ++i_) ss_ += f_[i_] * f_[i_]; \
        ss_ += __shfl_xor(ss_, 1); ss_ += __shfl_xor(ss_, 2); ss_ += __shfl_xor(ss_, 4); ss_ += __shfl_xor(ss_, 8); \
        const float rs_ = rsqrtf(ss_ * (1.f / 128.f) + 1e-6f); _Pragma("unroll") for (int i_ = 0; i_ < 8; ++i_) f_[i_] *= rs_ * gkp[i_]; kx = pack8(f_); } while (0)
#define NWRITE(bf) do { KNORM(ks0); KNORM(ks1); *(bf16x8*)(Vl + (bf) * 16384 + vst0) = vs0; *(bf16x8*)(Vl + (bf) * 16384 + vst1) = vs1; \
        *(bf16x8*)(Kl + (bf) * 16384 + KSWZ(sr, sc * 2)) = ks0; *(bf16x8*)(Kl + (bf) * 16384 + KSWZ(32 + sr, sc * 2)) = ks1; } while (0)
        NLOAD(0); NWRITE(0); __syncthreads();
        for (int j = 0; j < NT; ++j) {
            if (j + 1 < NT) NLOAD(j + 1);
            const int bf = j & 1;
            const bool islat = j < nlat; const int kr = lo + j;
            const bool active = !islat || (kr >= wsr && kr <= wsr + 7);
            if (active) {
                f32x16 p0 = {}, p1 = {};
                const unsigned char* Ks = Kl + bf * 16384;
#pragma unroll
                for (int d0 = 0; d0 < 8; ++d0) { const int cb = (d0 * 16 + hi * 8) * 2;
                    const bf16x8 b0 = *(const bf16x8*)(Ks + KSWZ(r32, cb)), b1 = *(const bf16x8*)(Ks + KSWZ(32 + r32, cb));
                    const bf16x8 qd = *(const bf16x8*)(Qs + d0 * 1024);
                    p0 = __builtin_amdgcn_mfma_f32_32x32x16_bf16(b0, qd, p0, 0, 0, 0);
                    p1 = __builtin_amdgcn_mfma_f32_32x32x16_bf16(b1, qd, p1, 0, 0, 0); }
                if (islat) {
                    const float* rb = rpbs + (kr - grow + 7) * 31 + 15 - qc + 4 * hi;
                    const int mofs = 4 * hi - cst;
#pragma unroll
                    for (int r = 0; r < 16; ++r) {
                        const int kb = (r & 3) + 8 * (r >> 2);
                        const float e0 = __builtin_amdgcn_exp2f(p0[r] + rb[kb]), e1 = __builtin_amdgcn_exp2f(p1[r] + rb[32 + kb]);
                        p0[r] = ((unsigned)(kb + mofs) < 16u) ? e0 : 0.f; p1[r] = ((unsigned)(32 + kb + mofs) < 16u) ? e1 : 0.f;
                        lsum += p0[r] + p1[r]; }
                } else {
#pragma unroll
                    for (int r = 0; r < 16; ++r) { p0[r] = __builtin_amdgcn_exp2f(p0[r]); p1[r] = __builtin_amdgcn_exp2f(p1[r]); lsum += p0[r] + p1[r]; }
                }
                bf16x8 pa0, pa1, pa2, pa3;
                PK4(p0, 0, pa0); PK4(p0, 8, pa1); PK4(p1, 0, pa2); PK4(p1, 8, pa3);
                pv_d0(o, vb0 + bf * 16384, pa0, pa1, pa2, pa3);
            }
            if (j + 1 < NT) NWRITE((j + 1) & 1);
            __syncthreads();
        }
#undef NLOAD
#undef KNORM
#undef NWRITE
        const float lt = halfswap_add(lsum);
        if (hi == 0) li[r32] = lt;
        asm volatile("s_waitcnt lgkmcnt(0)" ::: "memory");
#pragma unroll
        for (int r = 0; r < 16; ++r) { const float rl = 1.f / li[crow(r, hi)];
            bf16_t* mp = mix + ((size_t)b * SEQ + grow * 64 + (wid & 1) * 32 + crow(r, hi)) * DM + h * 128 + r32;
#pragma unroll
            for (int d0 = 0; d0 < 4; ++d0) mp[32 * d0] = f2bf(o[d0][r] * rl); }
        __syncthreads();
    }
}

#define XB_TMO      128
#define XB_XCNT(j)  (256  + 64 * (j))
#define XB_XSUB(j)  (1280 + 64 * (j))
#define XB_XGEN(j)  (2304 + 64 * (j))
#define XB_TOP      3328
#define XB_TOPGEN   3392
#define XCD_BAR_WORDS 3456
#define XB_SPIN_CAP (1u << 22)
__device__ __forceinline__ unsigned xb_ld(unsigned* p)              { return __hip_atomic_load(p, __ATOMIC_RELAXED, __HIP_MEMORY_SCOPE_AGENT); }
__device__ __forceinline__ unsigned xb_add(unsigned* p, unsigned v) { return __hip_atomic_fetch_add(p, v, __ATOMIC_RELAXED, __HIP_MEMORY_SCOPE_AGENT); }
__device__ __forceinline__ unsigned xb_xcc_id() { return (unsigned)__builtin_amdgcn_s_getreg((3 << 11) | 20) & 0xFu; }
#define XB_SPIN(cond, bar) do { unsigned _sp = 0; while (cond) { __builtin_amdgcn_s_sleep(1); \
    if ((++_sp & 255u) == 0u) { if (xb_ld(&(bar)[XB_TMO])) break; if (_sp > XB_SPIN_CAP) { atomicAdd(&(bar)[XB_TMO], 1u); break; } } } } while (0)
struct XcdBarrier { unsigned* bar; unsigned x; volatile LAS unsigned* st; };
__device__ __forceinline__ XcdBarrier xcd_barrier_post(unsigned* bar, volatile LAS unsigned* st) {
    XcdBarrier b; b.bar = bar; b.x = xb_xcc_id(); b.st = st;
    if (threadIdx.x == 0) (void)xb_add(&bar[XB_XCNT(b.x)], 1u);
    return b;
}
__device__ __forceinline__ void xcd_barrier_complete(unsigned* bar, unsigned x, unsigned& nloc, unsigned& nx) {
    const unsigned G = gridDim.x * gridDim.y * gridDim.z;
    unsigned sum, cnt, mine, sp = 0u;
    for (;;) {
        sum = 0u; cnt = 0u; mine = 0u;
#pragma unroll
        for (unsigned j = 0; j < 16; ++j) { const unsigned c = xb_ld(&bar[XB_XCNT(j)]); sum += c; cnt += (c > 0u) ? 1u : 0u; mine = (j == x) ? c : mine; }
        if (sum == G) break;
        __builtin_amdgcn_s_sleep(1);
        if ((++sp & 255u) == 0u) { if (xb_ld(&bar[XB_TMO])) break; if (sp > XB_SPIN_CAP) { atomicAdd(&bar[XB_TMO], 1u); break; } }
    }
    nloc = mine > 0u ? mine : 1u; nx = cnt > 0u ? cnt : 1u;
}
__device__ __forceinline__ void xcd_barrier(const XcdBarrier& b) {
    asm volatile("s_waitcnt vmcnt(0)" ::: "memory");
    __syncthreads();
    if (threadIdx.x == 0) {
        unsigned* bar = b.bar;
        __builtin_amdgcn_s_waitcnt(0);
        unsigned nloc = b.st[0], nx = b.st[1];
        if (nloc == 0u) { xcd_barrier_complete(bar, b.x, nloc, nx); b.st[0] = nloc; b.st[1] = nx; }
        const unsigned old = xb_add(&bar[XB_XSUB(b.x)], 1u);
        const unsigned gen = old / nloc;
        if (old + 1u == (gen + 1u) * nloc) {
            __builtin_amdgcn_fence(__ATOMIC_RELEASE, "agent");
            asm volatile("s_waitcnt vmcnt(0)" ::: "memory");
            const unsigned og = xb_add(&bar[XB_TOP], 1u);
            const unsigned tg = og / nx;
            if (og + 1u == (tg + 1u) * nx) xb_add(&bar[XB_TOPGEN], 1u);
            else XB_SPIN(xb_ld(&bar[XB_TOPGEN]) == tg, bar);
            __builtin_amdgcn_fence(__ATOMIC_ACQUIRE, "agent");
            xb_add(&bar[XB_XGEN(b.x)], 1u);
            asm volatile("s_waitcnt vmcnt(0)" ::: "memory");
        } else {
            XB_SPIN(xb_ld(&bar[XB_XGEN(b.x)]) == gen, bar);
            __builtin_amdgcn_fence(__ATOMIC_ACQUIRE, "agent");
            asm volatile("s_waitcnt vmcnt(0)" ::: "memory");
        }
    }
    __syncthreads();
}

#ifndef PROBE_REP
#define PROBE_REP 0
#endif
#define REP(k) for (int rep_ = 0; rep_ < (((PROBE_REP >> (k)) & 1) ? 2 : 1); ++rep_)
constexpr int NPH = 18;
__global__ void __launch_bounds__(NTHREADS, 2) fwd_megakernel(Params p) {
    extern __shared__ __attribute__((aligned(16))) unsigned char lds[];
    cg::grid_group grid = cg::this_grid();
    LAS unsigned char* ldsl = (LAS unsigned char*)lds;
    const int lo = p.ph_lo, hi = p.ph_hi;
#ifdef ONLY_PH
#define IN(k) (((ONLY_PH >> (k)) & 1) && lo <= (k) && (k) < hi)
#else
#define IN(k) (lo <= (k) && (k) < hi)
#endif
#define SEAM(k) do { if (IN(k) && IN((k) + 1)) { if ((k) == 0) grid.sync(); else { XcdBarrier xb_; xb_.bar = (unsigned*)(p.ws + WS_BAR); xb_.x = xb_xcc_id(); xb_.st = (volatile LAS unsigned*)(ldsl + 135168); xcd_barrier(xb_); } } } while (0)
    unsigned char* ws = p.ws;
    const bf16_t* H = (const bf16_t*)(ws + WS_H);
    bf16_t* PROJ = (bf16_t*)(ws + WS_PROJ);
    const bf16_t* MIX = (const bf16_t*)(ws + WS_MIX);
    float* CTXRES = (float*)(ws + WS_CTXRES);
    const float* MOD = (const float*)(ws + WS_MOD);
    const int G = gridDim.x, c = blockIdx.x;
    if (threadIdx.x < 4) ((volatile LAS unsigned*)(ldsl + 135168))[threadIdx.x] = 0u;
    __syncthreads();
    (void)xcd_barrier_post((unsigned*)(ws + WS_BAR), (volatile LAS unsigned*)(ldsl + 135168));

    if (IN(0)) REP(0) { ada_phase(p, lds); wconv_phase(p, lds);
        { float* rc = (float*)(ws + WS_ROPE); float* rs = rc + SEQ * 32;
          for (int e = blockIdx.x * NTHREADS + threadIdx.x; e < SEQ * 32; e += gridDim.x * NTHREADS) { const int t = e >> 5, pp = e & 31;
              const float inv = powf(10000.f, -(float)(pp & 15) / 16.f); const float ang = (pp < 16 ? (float)(t >> 6) : (float)(t & 63)) * inv;
              rc[e] = cosf(ang); rs[e] = sinf(ang); } } }
    SEAM(0);
    if (IN(1)) REP(1) norm_phase(p, p.x, p.ctx, 0, 0, MTOT);
    SEAM(1);
    if (IN(2)) REP(2) { pg8::Gemm g{H, (const bf16_t*)(ws + WS_W_EVIN), MTOT, EV_NP, DM}; pg8::StaticOrder S; S.init(MTOT, EV_NP, G, c);
        pg8::EpiBf16 E{PROJ, EV_NP}; pg8::gemm_phase(ldsl, g, S, E); }
    SEAM(2);
    if (IN(3)) prep0_phase(p);
    SEAM(3);
    if (IN(4)) REP(4) gdn_pre_phase(p, lds);
    SEAM(4);
    if (IN(5)) {
#ifndef SKIP_SCAN
        REP(20) { gdn_scan_phase(p, lds); __syncthreads(); }
#endif
#ifndef SKIP_DA
        REP(5) { diffattn_phase(p, lds); __syncthreads(); }
#endif
    }
    SEAM(5);
    if (IN(6)) REP(6) gdn_post_phase(p);
    SEAM(6);
    if (IN(7)) REP(7) { pg8::Gemm g{MIX, (const bf16_t*)(ws + WS_W_EVOUT), MTOT, DM, DM}; pg8::StaticOrder S; S.init(MTOT, DM, G, c);
        pg8::EpiResid E{p.x, p.ctx, p.out, CTXRES, MOD, 2048}; pg8::gemm_phase(ldsl, g, S, E); }
    SEAM(7);
    if (IN(8)) norm_phase(p, p.out, CTXRES, 0, 1, MTOT);
    SEAM(8);
    if (IN(9)) REP(9) { pg8::Gemm g{H, (const bf16_t*)(ws + WS_W_FFIN), MTOT, 2 * FF, DM}; pg8::StaticOrder S; S.init(MTOT, 2 * FF, G, c);
        pg8::EpiSwiglu E{PROJ, FF}; pg8::gemm_phase(ldsl, g, S, E); }
    SEAM(9);
    if (IN(10)) { pg8::Gemm g{PROJ, (const bf16_t*)(ws + WS_W_FFOUT), MTOT, DM, FF}; pg8::StaticOrder S; S.init(MTOT, DM, G, c);
        pg8::EpiResid E{p.out, CTXRES, p.out, CTXRES, MOD, 5120}; pg8::gemm_phase(ldsl, g, S, E); }
    SEAM(10);
    if (IN(11)) norm_phase(p, p.out, CTXRES, 1, 0, MTOT);
    SEAM(11);
    if (IN(12)) { pg8::Gemm g{H, (const bf16_t*)(ws + WS_W_ODIN), MTOT, OD_N, DM}; pg8::StaticOrder S; S.init(MTOT, OD_N, G, c);
        pg8::EpiBf16 E{PROJ, OD_N}; pg8::gemm_phase(ldsl, g, S, E); }
    SEAM(12);
    if (IN(13)) { natten_phase(p, lds); if ((PROBE_REP >> 13) & 1) { __syncthreads(); natten_phase(p, lds); } }
    SEAM(13);
    if (IN(14)) { pg8::Gemm g{MIX, (const bf16_t*)(ws + WS_W_ODOUT), NLAT, DM, DM}; pg8::StaticOrder S; S.init(NLAT, DM, G, c);
        pg8::EpiResid E{p.out, CTXRES, p.out, CTXRES, MOD + 9 * 6144, 2048}; pg8::gemm_phase(ldsl, g, S, E); }
    SEAM(14);
    if (IN(15)) norm_phase(p, p.out, CTXRES, 1, 1, NLAT);
    SEAM(15);
    if (IN(16)) { pg8::Gemm g{H, (const bf16_t*)(ws + WS_W_FFIN) + (size_t)2 * FF * DM, NLAT, 2 * FF, DM}; pg8::StaticOrder S; S.init(NLAT, 2 * FF, G, c);
        pg8::EpiSwiglu E{PROJ, FF}; pg8::gemm_phase(ldsl, g, S, E); }
    SEAM(16);
    if (IN(17)) { pg8::Gemm g{PROJ, (const bf16_t*)(ws + WS_W_FFOUT) + (size_t)DM * FF, NLAT, DM, FF}; pg8::StaticOrder S; S.init(NLAT, DM, G, c);
        pg8::EpiResid E{p.out, CTXRES, p.out, CTXRES, MOD + 9 * 6144, 5120}; pg8::gemm_phase(ldsl, g, S, E); }
#undef IN
#undef SEAM
}

extern "C" void kernel_launch(void* const* d_in, const int* in_sizes, int n_in, void* d_out, int out_size, void* d_ws, size_t ws_size, hipStream_t stream) {
    static int grid = 0;
    if (grid == 0) {
        if (n_in != 23 || ws_size < WS_END) { fprintf(stderr, "kernel_launch: n_in %d ws %zu (need %zu)\n", n_in, ws_size, (size_t)WS_END); grid = -1; return; }
        int dev = 0, cus = 0, per_cu = 0;
        hipGetDevice(&dev); hipDeviceGetAttribute(&cus, hipDeviceAttributeMultiprocessorCount, dev);
        if (hipFuncSetAttribute((const void*)fwd_megakernel, hipFuncAttributeMaxDynamicSharedMemorySize, LDS_BYTES) != hipSuccess) { fprintf(stderr, "hipFuncSetAttribute failed\n"); grid = -1; return; }
        if (hipOccupancyMaxActiveBlocksPerMultiprocessor(&per_cu, (const void*)fwd_megakernel, NTHREADS, LDS_BYTES) != hipSuccess || per_cu < 1) per_cu = 1;
        (void)hipGetLastError();
        grid = cus * 1;
    }
    if (grid < 0) return;
    if (hipMemsetAsync((char*)d_ws + WS_BAR, 0, 16384, stream) != hipSuccess) { fprintf(stderr, "memset failed\n"); return; }
    Params p{};
    const float** pp = (const float**)&p;
    for (int i = 0; i < 23; ++i) pp[i] = (const float*)d_in[i];
    p.out = (float*)d_out; p.ws = (unsigned char*)d_ws;
#if N_LAUNCH_MODE == 1
    p.ph_lo = 0; p.ph_hi = NPH;
    void* args[] = {&p};
    hipError_t e = hipLaunchCooperativeKernel((void*)fwd_megakernel, dim3(grid), dim3(NTHREADS), args, LDS_BYTES, stream);
    if (e != hipSuccess) fprintf(stderr, "cooperative launch failed: %s (grid %d)\n", hipGetErrorString(e), grid);
#else
    for (int k = 0; k < NPH; ++k) { p.ph_lo = k; p.ph_hi = k + 1;
        hipLaunchKernelGGL(fwd_megakernel, dim3(grid), dim3(NTHREADS), LDS_BYTES, stream, p); }
#endif
}
```

```cpp
#include <hip/hip_runtime.h>
#include <hip/hip_cooperative_groups.h>
#include <cstdio>
#include <cstdint>
namespace cg = cooperative_groups;

#define LAS __attribute__((address_space(3)))
typedef unsigned short bf16_t;
typedef short bf16x8 __attribute__((ext_vector_type(8)));
typedef short s16x4 __attribute__((ext_vector_type(4)));
typedef float f32x4 __attribute__((ext_vector_type(4)));
typedef float f32x16 __attribute__((ext_vector_type(16)));
typedef unsigned u32x4 __attribute__((ext_vector_type(4)));
typedef unsigned u32x2 __attribute__((ext_vector_type(2)));

#ifndef N_LAUNCH_MODE
#define N_LAUNCH_MODE 1
#endif

constexpr int DM = 1024, NLAT = 65536, NCTX = 2048, MTOT = NLAT + NCTX, SEQ = 8192, CTXL = 256, FF = 2816;
constexpr int EV_N = 3600, EV_NP = 3840, OD_N = 3072;
constexpr int NCHUNKP = 64 * 132;
constexpr int NTHREADS = 512;
constexpr int LDS_BYTES = 135168 + 16;

constexpr size_t al256(size_t x) { return (x + 255) / 256 * 256; }
constexpr size_t WS_W_EVIN = 0;
constexpr size_t WS_W_EVOUT = WS_W_EVIN + al256((size_t)EV_NP * DM * 2);
constexpr size_t WS_W_ODIN = WS_W_EVOUT + al256((size_t)DM * DM * 2);
constexpr size_t WS_W_ODOUT = WS_W_ODIN + al256((size_t)OD_N * DM * 2);
constexpr size_t WS_W_FFIN = WS_W_ODOUT + al256((size_t)DM * DM * 2);
constexpr size_t WS_W_FFOUT = WS_W_FFIN + al256((size_t)2 * 2 * FF * DM * 2);
constexpr size_t WS_MOD = WS_W_FFOUT + al256((size_t)2 * DM * FF * 2);
constexpr size_t WS_H = WS_MOD + al256((size_t)2 * 9 * 6144 * 4);
constexpr size_t WS_PROJ = WS_H + al256((size_t)MTOT * DM * 2);
constexpr size_t WS_MIX = WS_PROJ + al256((size_t)MTOT * EV_NP * 2);
constexpr size_t WS_T = WS_MIX + al256((size_t)MTOT * DM * 2);
constexpr size_t WS_AQK = WS_T + al256((size_t)NCHUNKP * 4096 * 2);
constexpr size_t WS_GV = WS_AQK + al256((size_t)NCHUNKP * 4096 * 2);
constexpr size_t WS_BV = WS_GV + al256((size_t)NCHUNKP * 64 * 4);
constexpr size_t WS_EL = WS_BV + al256((size_t)NCHUNKP * 64 * 4);
constexpr size_t WS_GATES = WS_EL + al256((size_t)NCHUNKP * 64 * 4);
constexpr size_t WS_CTXRES = WS_GATES + al256((size_t)MTOT * 16 * 4);
constexpr size_t WS_BAR = WS_CTXRES + al256((size_t)NCTX * DM * 4);
constexpr size_t WS_ROPE = WS_BAR + 16384;
constexpr size_t WS_END = WS_ROPE + (size_t)2 * SEQ * 32 * 4;

struct Params {
    const float *x, *c, *ctx, *c_ctx, *ada_w, *ada_b, *norm_mix, *norm_ffn, *ffn_w_in, *ffn_w_out, *even_w_in, *even_w_out,
        *diff_qk_gain, *diff_lambda, *diff_subln, *gdn_conv, *gdn_a_log, *gdn_dt_bias, *gdn_norm, *odd_w_in, *odd_w_out, *na_qk_gain, *na_rpb;
    float* out; unsigned char* ws; int ph_lo, ph_hi;
};

__device__ __forceinline__ float bf2f(bf16_t b) { return __uint_as_float(((unsigned)b) << 16); }
__device__ __forceinline__ bf16_t f2bf(float f) { unsigned u = __float_as_uint(f); u += 0x7FFFu + ((u >> 16) & 1u); return (bf16_t)(u >> 16); }
__device__ __forceinline__ unsigned cvtpk(float lo, float hi) { unsigned r; asm volatile("v_cvt_pk_bf16_f32 %0, %1, %2" : "=v"(r) : "v"(lo), "v"(hi)); return r; }
__device__ __forceinline__ float siluf(float v) { return v / (1.f + __expf(-v)); }
__device__ __forceinline__ void unpack8(bf16x8 v, float* f) {
#pragma unroll
    for (int i = 0; i < 8; ++i) f[i] = bf2f((bf16_t)v[i]);
}
__device__ __forceinline__ bf16x8 pack8(const float* f) {
    u32x4 w = {cvtpk(f[0], f[1]), cvtpk(f[2], f[3]), cvtpk(f[4], f[5]), cvtpk(f[6], f[7])};
    return *reinterpret_cast<bf16x8*>(&w);
}

namespace pg8 {
constexpr int BM = 256, BK = 64, HALF = 128, HTB = HALF * BK * 2, STAGE_BYTES = 8 * HTB, NXCD = 8, WGM = 8;
__host__ __device__ __forceinline__ int lds_byte(int r, int c) { const int st = (r >> 4) * 2 + (c >> 5), rr = r & 15, cc = c & 31, ob = rr * 64 + cc * 2; return st * 1024 + (ob ^ (((ob >> 9) & 1) << 5)); }
__host__ __device__ __forceinline__ void stage_rc(int b, int& R, int& C) { const int st = b / 1024, sb = b % 1024, swz = sb ^ (((sb >> 9) & 1) << 5); R = (st >> 1) * 16 + swz / 64; C = (st & 1) * 32 + (swz % 64) / 2; }
__host__ __device__ __forceinline__ int perm32(int rho) { const int n = rho >> 4, i = rho & 15; return 8 * (i >> 2) + 4 * n + (i & 3); }
struct Unit { int pm, pn; };
struct Gemm { const bf16_t* A; const bf16_t* Bt; int M, N, K; };
struct StaticOrder {
    int nM, nN, nwg, G, c;
    __device__ void init(int M, int N, int G_, int c_) { nM = M / BM; nN = N / BM; nwg = nM * nN; G = G_; c = c_; }
    __device__ bool next(int i, Unit& u) const {
        const long L = (long)i * G + c; if (L >= nwg) return false;
        int wgid = (int)L; { const int q = nwg / NXCD, r = nwg % NXCD, xcd = wgid % NXCD, off = wgid / NXCD; wgid = (xcd < r ? xcd * (q + 1) : r * (q + 1) + (xcd - r) * q) + off; }
        const int nig = WGM * nN, gid = wgid / nig, fm = gid * WGM, gsz = (nM - fm) < WGM ? (nM - fm) : WGM;
        u.pm = fm + ((wgid % nig) % gsz); u.pn = (wgid % nig) / gsz; return true;
    }
};
struct EpiBf16 {
    static constexpr bool PERM = true;
    bf16_t* O; int ldc;
    __device__ __forceinline__ void operator()(const f32x4 (&acc)[2][2][4][2], const Unit& u, int wr, int wc, int fr, int fq) const {
        const int row0 = u.pm * BM + wr * 64 + fr; const int col0 = u.pn * BM + wc * 32 + 8 * fq;
#pragma unroll
        for (int ai = 0; ai < 2; ++ai)
#pragma unroll
            for (int m = 0; m < 4; ++m) { bf16_t* rowp = O + (size_t)(row0 + ai * HALF + m * 16) * ldc + col0;
#pragma unroll
                for (int bj = 0; bj < 2; ++bj) { const f32x4 v0 = acc[ai][bj][m][0], v1 = acc[ai][bj][m][1];
                    u32x4 w; w.x = cvtpk(v0[0], v0[1]); w.y = cvtpk(v0[2], v0[3]); w.z = cvtpk(v1[0], v1[1]); w.w = cvtpk(v1[2], v1[3]);
                    *(u32x4*)(rowp + bj * HALF) = w; } }
    }
};
struct EpiSwiglu {
    static constexpr bool PERM = true;
    bf16_t* O; int ldc;
    __device__ __forceinline__ void operator()(const f32x4 (&acc)[2][2][4][2], const Unit& u, int wr, int wc, int fr, int fq) const {
        const int row0 = u.pm * BM + wr * 64 + fr; const int col0 = u.pn * HALF + wc * 32 + 8 * fq;
#pragma unroll
        for (int ai = 0; ai < 2; ++ai)
#pragma unroll
            for (int m = 0; m < 4; ++m) { bf16_t* rowp = O + (size_t)(row0 + ai * HALF + m * 16) * ldc + col0;
                float o[8];
#pragma unroll
                for (int n = 0; n < 2; ++n)
#pragma unroll
                    for (int j = 0; j < 4; ++j) { const float g = acc[ai][0][m][n][j], up = acc[ai][1][m][n][j]; o[n * 4 + j] = g / (1.f + __expf(-g)) * up; }
                u32x4 w; w.x = cvtpk(o[0], o[1]); w.y = cvtpk(o[2], o[3]); w.z = cvtpk(o[4], o[5]); w.w = cvtpk(o[6], o[7]);
                *(u32x4*)rowp = w; }
    }
};
struct EpiResid {
    static constexpr bool PERM = false;
    const float* resLat; const float* resCtx; float* outLat; float* outCtx; const float* modl; int goff;
    __device__ __forceinline__ void operator()(const f32x4 (&acc)[2][2][4][2], const Unit& u, int wr, int wc, int fr, int fq) const {
        const int rowt = u.pm * BM; const bool lat = rowt < NLAT;
        const float* res = lat ? resLat + (size_t)rowt * DM : resCtx + (size_t)(rowt - NLAT) * DM;
        float* out = lat ? outLat + (size_t)rowt * DM : outCtx + (size_t)(rowt - NLAT) * DM;
        const float* gate = modl + (size_t)(lat ? (rowt >> 13) : 8) * 6144 + goff;
        const int row0 = wr * 64 + fr, col0 = u.pn * BM + wc * 32 + 4 * fq;
        f32x4 gv[2][2];
#pragma unroll
        for (int bj = 0; bj < 2; ++bj)
#pragma unroll
            for (int n = 0; n < 2; ++n) gv[bj][n] = *(const f32x4*)(gate + col0 + bj * HALF + n * 16);
#pragma unroll
        for (int ai = 0; ai < 2; ++ai)
#pragma unroll
            for (int m = 0; m < 4; ++m) { const size_t off = (size_t)(row0 + ai * HALF + m * 16) * DM + col0;
#pragma unroll
                for (int bj = 0; bj < 2; ++bj)
#pragma unroll
                    for (int n = 0; n < 2; ++n) { const f32x4 r = *(const f32x4*)(res + off + bj * HALF + n * 16);
                        *(f32x4*)(out + off + bj * HALF + n * 16) = r + gv[bj][n] * acc[ai][bj][m][n]; } }
    }
};

template <class Epi, class Sched>
__device__ __forceinline__ void gemm_phase(LAS unsigned char* lds, const Gemm g, const Sched& S, const Epi& E) {
    const int tid = threadIdx.x, wid = __builtin_amdgcn_readfirstlane(tid >> 6), lane = tid & 63, wr = wid >> 2, wc = wid & 3, fr = lane & 15, fq = lane >> 4;
    const int K = g.K, nt = K / BK;
    unsigned voffA[2], voffB[2];
#pragma unroll
    for (int i = 0; i < 2; ++i) { int R, C; stage_rc(tid * 16 + i * 8192, R, C); const int Rb = Epi::PERM ? ((R & ~31) + perm32(R & 31)) : R;
        voffA[i] = (unsigned)(R * K + C) * 2u; voffB[i] = (unsigned)(Rb * K + C) * 2u; }
    const size_t kstep = (size_t)(BK * 2);
    const size_t hstep = (size_t)HALF * K * 2;
    const size_t tstep = 2 * hstep;
    const unsigned ldsw = (unsigned)wid * 1024u;
    const int aoff = lds_byte(wr * 64 + fr, fq * 8), boff = lds_byte(wc * 32 + fr, fq * 8);
#define PG8_SA(b, h) (((b) * 2 + (h)) * HTB)
#define PG8_SB(b, h) ((4 + (b) * 2 + (h)) * HTB)
#define PG8_STAGE(bufoff, gbase, voff) do { _Pragma("unroll") for (int _i = 0; _i < 2; ++_i) \
        __builtin_amdgcn_global_load_lds((const unsigned*)((const char*)(gbase) + (voff)[_i]), (LAS unsigned*)(lds + (bufoff) + ldsw + _i * 8192), 16, 0, 0); } while (0)
#define PG8_LDA(dst, b, h) do { _Pragma("unroll") for (int m = 0; m < 4; ++m) _Pragma("unroll") for (int k = 0; k < 2; ++k) dst[m][k] = *(const LAS bf16x8*)(lds + PG8_SA(b, h) + aoff + m * 2048 + k * 1024); } while (0)
#define PG8_LDB(dst, b, h) do { _Pragma("unroll") for (int n = 0; n < 2; ++n) _Pragma("unroll") for (int k = 0; k < 2; ++k) dst[n][k] = *(const LAS bf16x8*)(lds + PG8_SB(b, h) + boff + n * 2048 + k * 1024); } while (0)
#define PG8_MMA(ai, bj, At, Bt) do { __builtin_amdgcn_s_setprio(1); _Pragma("unroll") for (int m = 0; m < 4; ++m) _Pragma("unroll") for (int n = 0; n < 2; ++n) _Pragma("unroll") for (int k = 0; k < 2; ++k) \
        acc[ai][bj][m][n] = __builtin_amdgcn_mfma_f32_16x16x32_bf16(Bt[n][k], At[m][k], acc[ai][bj][m][n], 0, 0, 0); __builtin_amdgcn_s_setprio(0); } while (0)
#define PG8_WAIT_V(n) asm volatile("s_waitcnt vmcnt(" #n ")" ::: "memory")
#define PG8_WAIT_L(n) asm volatile("s_waitcnt lgkmcnt(" #n ")" ::: "memory")
#define PG8_BAR __builtin_amdgcn_s_barrier()
#define PG8_SCHED __builtin_amdgcn_sched_barrier(0)
    Unit cur, nxt; int ui = 0;
    if (!S.next(0, cur)) return;
    f32x4 acc[2][2][4][2];
#pragma unroll
    for (int a = 0; a < 2; ++a)
#pragma unroll
        for (int b = 0; b < 2; ++b)
#pragma unroll
            for (int m = 0; m < 4; ++m)
#pragma unroll
                for (int n = 0; n < 2; ++n) acc[a][b][m][n] = (f32x4){0.f, 0.f, 0.f, 0.f};
    bf16x8 At[4][2], B0[2][2], B1[2][2];
    const char* cA = (const char*)g.A + (size_t)cur.pm * tstep; const char* cB = (const char*)g.Bt + (size_t)cur.pn * tstep;
    PG8_STAGE(PG8_SB(0, 0), cB, voffB); PG8_STAGE(PG8_SA(0, 0), cA, voffA); PG8_STAGE(PG8_SB(0, 1), cB + hstep, voffB); PG8_STAGE(PG8_SA(0, 1), cA + hstep, voffA);
    if (wr == 1) PG8_BAR;
    PG8_WAIT_V(4); PG8_BAR;
    PG8_STAGE(PG8_SB(1, 0), cB + kstep, voffB); PG8_STAGE(PG8_SA(1, 0), cA + kstep, voffA); PG8_STAGE(PG8_SB(1, 1), cB + hstep + kstep, voffB);
    PG8_WAIT_V(6); PG8_BAR;
    for (;;) {
        const bool has_next = S.next(ui + 1, nxt);
        const char* nA = has_next ? (const char*)g.A + (size_t)nxt.pm * tstep : cA; const char* nB = has_next ? (const char*)g.Bt + (size_t)nxt.pn * tstep : cB;
        for (int t = 0; t < nt; t += 2) {
            const bool last = (t == nt - 2);
            const char* a1 = cA + (size_t)(t + 1) * kstep;
            const char* a2 = last ? nA : cA + (size_t)(t + 2) * kstep; const char* b2 = last ? nB : cB + (size_t)(t + 2) * kstep;
            const char* a3 = a2 + kstep; const char* b3 = b2 + kstep;
            PG8_LDB(B0, 0, 0); PG8_SCHED; PG8_LDA(At, 0, 0); PG8_STAGE(PG8_SA(1, 1), a1 + hstep, voffA);
            PG8_WAIT_L(8); PG8_BAR; PG8_WAIT_L(0); PG8_MMA(0, 0, At, B0); PG8_BAR; PG8_SCHED;
            PG8_LDB(B1, 0, 1); PG8_STAGE(PG8_SB(0, 0), b2, voffB);
            PG8_BAR; PG8_WAIT_L(0); PG8_MMA(0, 1, At, B1); PG8_BAR;
            PG8_LDA(At, 0, 1); PG8_STAGE(PG8_SA(0, 0), a2, voffA);
            PG8_BAR; PG8_WAIT_L(0); PG8_MMA(1, 0, At, B0); PG8_BAR; PG8_SCHED;
            PG8_STAGE(PG8_SB(0, 1), b2 + hstep, voffB);
            PG8_WAIT_V(6); PG8_BAR; PG8_MMA(1, 1, At, B1); PG8_BAR;
            PG8_LDB(B0, 1, 0); PG8_SCHED; PG8_LDA(At, 1, 0); PG8_STAGE(PG8_SA(0, 1), a2 + hstep, voffA);
            PG8_WAIT_L(8); PG8_BAR; PG8_WAIT_L(0); PG8_MMA(0, 0, At, B0); PG8_BAR; PG8_SCHED;
            PG8_LDB(B1, 1, 1); PG8_STAGE(PG8_SB(1, 0), b3, voffB);
            PG8_BAR; PG8_WAIT_L(0); PG8_MMA(0, 1, At, B1); PG8_BAR;
            PG8_LDA(At, 1, 1); PG8_STAGE(PG8_SA(1, 0), a3, voffA);
            PG8_BAR; PG8_WAIT_L(0); PG8_MMA(1, 0, At, B0); PG8_BAR; PG8_SCHED;
            PG8_STAGE(PG8_SB(1, 1), b3 + hstep, voffB);
            PG8_WAIT_V(6); PG8_BAR; PG8_MMA(1, 1, At, B1); PG8_BAR;
        }
        E(acc, cur, wr, wc, fr, fq);
        if (!has_next) break;
#pragma unroll
        for (int a = 0; a < 2; ++a)
#pragma unroll
            for (int b = 0; b < 2; ++b)
#pragma unroll
                for (int m = 0; m < 4; ++m)
#pragma unroll
                    for (int n = 0; n < 2; ++n) acc[a][b][m][n] = (f32x4){0.f, 0.f, 0.f, 0.f};
        cur = nxt; cA = nA; cB = nB; ++ui;
    }
    PG8_WAIT_V(0);
    if (wr == 0) PG8_BAR;
    PG8_BAR;
#undef PG8_SA
#undef PG8_SB
#undef PG8_STAGE
#undef PG8_LDA
#undef PG8_LDB
#undef PG8_MMA
#undef PG8_WAIT_V
#undef PG8_WAIT_L
#undef PG8_BAR
#undef PG8_SCHED
}
}

#define KSWZ(row, colB) ((row) * 256 + ((colB) ^ (((row) & 7) << 4)))
#define SBAR() __builtin_amdgcn_sched_barrier(0)
__device__ __forceinline__ int crow(int r, int hi) { return (r & 3) + 8 * (r >> 2) + 4 * hi; }
__device__ __forceinline__ int v_st(int k, int c) { const int kk = (k & ~0xC) | ((k & 4) << 1) | ((k & 8) >> 1); return ((kk >> 3) * 4 + (c >> 5)) * 512 + ((kk & 7) * 32 + (c & 31)) * 2; }
__device__ __forceinline__ int v_rd_base(int lane) { return ((lane & 3) << 3) | (((lane >> 2) & 3) << 6) | (((lane >> 4) & 1) << 5) | (((lane >> 5) & 1) << 8); }
constexpr int v_rd_off(int d0, int ks, int half) { return d0 * 512 + ks * 4096 + half * 2048; }
template <int OFF> __device__ __forceinline__ s16x4 tr_read(int vb) {
    s16x4 r; asm volatile("ds_read_b64_tr_b16 %0, %1 offset:%2" : "=&v"(r) : "v"(vb), "i"(OFF) : "memory"); return r;
}
template <int D0> __device__ __forceinline__ void pv_one(f32x16& od, int vb, bf16x8 pa0, bf16x8 pa1, bf16x8 pa2, bf16x8 pa3) {
    const s16x4 l0 = tr_read<v_rd_off(D0, 0, 0)>(vb), h0 = tr_read<v_rd_off(D0, 0, 1)>(vb), l1 = tr_read<v_rd_off(D0, 1, 0)>(vb), h1 = tr_read<v_rd_off(D0, 1, 1)>(vb);
    const s16x4 l2 = tr_read<v_rd_off(D0, 2, 0)>(vb), h2 = tr_read<v_rd_off(D0, 2, 1)>(vb), l3 = tr_read<v_rd_off(D0, 3, 0)>(vb), h3 = tr_read<v_rd_off(D0, 3, 1)>(vb);
    asm volatile("s_waitcnt lgkmcnt(0)" ::: "memory"); SBAR();
#define PK(L, H) (bf16x8){L[0], L[1], L[2], L[3], H[0], H[1], H[2], H[3]}
    od = __builtin_amdgcn_mfma_f32_32x32x16_bf16(pa0, PK(l0, h0), od, 0, 0, 0);
    od = __builtin_amdgcn_mfma_f32_32x32x16_bf16(pa1, PK(l1, h1), od, 0, 0, 0);
    od = __builtin_amdgcn_mfma_f32_32x32x16_bf16(pa2, PK(l2, h2), od, 0, 0, 0);
    od = __builtin_amdgcn_mfma_f32_32x32x16_bf16(pa3, PK(l3, h3), od, 0, 0, 0);
#undef PK
}
__device__ __forceinline__ void pv_d0(f32x16* o, int vb, bf16x8 pa0, bf16x8 pa1, bf16x8 pa2, bf16x8 pa3) {
    pv_one<0>(o[0], vb, pa0, pa1, pa2, pa3); pv_one<1>(o[1], vb, pa0, pa1, pa2, pa3); pv_one<2>(o[2], vb, pa0, pa1, pa2, pa3); pv_one<3>(o[3], vb, pa0, pa1, pa2, pa3);
}
#define PK4(P, BASE, OUT) do { unsigned a0 = cvtpk(P[BASE + 0], P[BASE + 1]), a1 = cvtpk(P[BASE + 2], P[BASE + 3]);   \
    unsigned b0 = cvtpk(P[BASE + 4], P[BASE + 5]), b1 = cvtpk(P[BASE + 6], P[BASE + 7]);                              \
    auto r0 = __builtin_amdgcn_permlane32_swap(a0, b0, false, false); auto r1 = __builtin_amdgcn_permlane32_swap(a1, b1, false, false); \
    u32x4 w = {r0[0], r1[0], r0[1], r1[1]}; OUT = *reinterpret_cast<bf16x8*>(&w); } while (0)
__device__ __forceinline__ float halfswap_add(float v) {
    auto rr = __builtin_amdgcn_permlane32_swap(__float_as_uint(v), __float_as_uint(v), false, false);
    return __uint_as_float(rr[0]) + __uint_as_float(rr[1]);
}

__device__ __forceinline__ void ada_phase(const Params& p, unsigned char* lds) {
    float* sc = (float*)lds;
    float* red = (float*)(lds + 40960);
    float* mod = (float*)(p.ws + WS_MOD);
    const int tid = threadIdx.x;
    for (int j = blockIdx.x; j < 192; j += gridDim.x) {
        const int l = j / 96, n0 = (j % 96) * 64;
        for (int i = tid; i < 9 * 1024; i += NTHREADS) { const int r = i >> 10, k = i & 1023; const float v = r < 8 ? p.c[r * 1024 + k] : p.c_ctx[k]; sc[i] = v / (1.f + expf(-v)); }
        __syncthreads();
        const int col = tid & 63, ks = tid >> 6;
        float acc[9];
#pragma unroll
        for (int r = 0; r < 9; ++r) acc[r] = 0.f;
        const float* wp = p.ada_w + ((size_t)l * 1024 + ks * 128) * 6144 + n0 + col;
#pragma unroll 8
        for (int kk = 0; kk < 128; ++kk) { const float w = wp[(size_t)kk * 6144];
#pragma unroll
            for (int r = 0; r < 9; ++r) acc[r] += sc[r * 1024 + ks * 128 + kk] * w; }
#pragma unroll
        for (int r = 0; r < 9; ++r) red[(ks * 9 + r) * 64 + col] = acc[r];
        __syncthreads();
        for (int i = tid; i < 576; i += NTHREADS) { const int r = i >> 6, cc = i & 63; float s = p.ada_b[l * 6144 + n0 + cc];
            for (int k2 = 0; k2 < 8; ++k2) s += red[(k2 * 9 + r) * 64 + cc];
            mod[(size_t)(l * 9 + r) * 6144 + n0 + cc] = s; }
        __syncthreads();
    }
}
__device__ __forceinline__ void wconv_phase(const Params& p, unsigned char* lds) {
    float* tl = (float*)lds;
    const int tid = threadIdx.x;
    const int T0 = 16 * 60, T1 = T0 + 16 * 16, T2 = T1 + 16 * 48, T3 = T2 + 16 * 16, T4 = T3 + 16 * 88, T5 = T4 + 16 * 88, T6 = T5 + 44 * 16, T7 = T6 + 44 * 16;
    for (int t = blockIdx.x; t < T7; t += gridDim.x) {
        const float* src; bf16_t* dst; int K, N, NP, mode = 0, tt;
        if (t < T0) { src = p.even_w_in; dst = (bf16_t*)(p.ws + WS_W_EVIN); K = 1024; N = EV_N; NP = EV_NP; tt = t; }
        else if (t < T1) { src = p.even_w_out; dst = (bf16_t*)(p.ws + WS_W_EVOUT); K = 1024; N = 1024; NP = 1024; tt = t - T0; }
        else if (t < T2) { src = p.odd_w_in; dst = (bf16_t*)(p.ws + WS_W_ODIN); K = 1024; N = OD_N; NP = OD_N; tt = t - T1; }
        else if (t < T3) { src = p.odd_w_out; dst = (bf16_t*)(p.ws + WS_W_ODOUT); K = 1024; N = 1024; NP = 1024; tt = t - T2; }
        else if (t < T4) { src = p.ffn_w_in; dst = (bf16_t*)(p.ws + WS_W_FFIN); K = 1024; N = 2 * FF; NP = 2 * FF; mode = 1; tt = t - T3; }
        else if (t < T5) { src = p.ffn_w_in + (size_t)1024 * 2 * FF; dst = (bf16_t*)(p.ws + WS_W_FFIN) + (size_t)2 * FF * 1024; K = 1024; N = 2 * FF; NP = 2 * FF; mode = 1; tt = t - T4; }
        else if (t < T6) { src = p.ffn_w_out; dst = (bf16_t*)(p.ws + WS_W_FFOUT); K = FF; N = 1024; NP = 1024; tt = t - T5; }
        else { src = p.ffn_w_out + (size_t)FF * 1024; dst = (bf16_t*)(p.ws + WS_W_FFOUT) + (size_t)1024 * FF; K = FF; N = 1024; NP = 1024; tt = t - T6; }
        const int nnt = NP / 64; const int k0 = (tt / nnt) * 64, n0 = (tt % nnt) * 64;
        int sn0;
        if (mode == 1) { const int tb = n0 >> 8, bj = (n0 >> 7) & 1, i0 = n0 & 127; sn0 = bj * FF + tb * 128 + i0; } else sn0 = n0;
        for (int e = tid; e < 4096; e += NTHREADS) { const int kk = e >> 6, nn = e & 63; const int sn = sn0 + nn;
            tl[kk * 65 + nn] = (sn < N) ? src[(size_t)(k0 + kk) * N + sn] : 0.f; }
        __syncthreads();
        for (int e = tid; e < 2048; e += NTHREADS) { const int nn = e >> 5, k2 = (e & 31) * 2;
            *(unsigned*)(dst + (size_t)(n0 + nn) * K + k0 + k2) = cvtpk(tl[k2 * 65 + nn], tl[(k2 + 1) * 65 + nn]); }
        __syncthreads();
    }
}

__device__ __forceinline__ void norm_phase(const Params& p, const float* xlat, const float* xctx, int l, int which, int nrows) {
    const int lane = threadIdx.x & 63, wid = threadIdx.x >> 6;
    bf16_t* h = (bf16_t*)(p.ws + WS_H);
    const float* mod = (const float*)(p.ws + WS_MOD) + (size_t)l * 9 * 6144;
    const float* gain = (which ? p.norm_ffn : p.norm_mix) + l * 1024;
    const int shoff = which ? 3072 : 0, scoff = which ? 4096 : 1024;
    for (int row = blockIdx.x * 8 + wid; row < nrows; row += gridDim.x * 8) {
        const bool lat = row < NLAT;
        const float* src = lat ? xlat + (size_t)row * DM : xctx + (size_t)(row - NLAT) * DM;
        const float* mr = mod + (size_t)(lat ? (row >> 13) : 8) * 6144;
        f32x4 v[4]; float ss = 0.f;
#pragma unroll
        for (int i = 0; i < 4; ++i) { v[i] = *(const f32x4*)(src + lane * 4 + 256 * i); ss += v[i][0] * v[i][0] + v[i][1] * v[i][1] + v[i][2] * v[i][2] + v[i][3] * v[i][3]; }
#pragma unroll
        for (int o = 1; o < 64; o <<= 1) ss += __shfl_xor(ss, o);
        const float rstd = rsqrtf(ss * (1.f / 1024.f) + 1e-6f);
#pragma unroll
        for (int i = 0; i < 4; ++i) { const int c0 = lane * 4 + 256 * i;
            const f32x4 g = *(const f32x4*)(gain + c0), s1 = *(const f32x4*)(mr + scoff + c0), sh = *(const f32x4*)(mr + shoff + c0);
            float y[4];
#pragma unroll
            for (int j = 0; j < 4; ++j) y[j] = v[i][j] * rstd * g[j] * (1.f + s1[j]) + sh[j];
            u32x2 w; w.x = cvtpk(y[0], y[1]); w.y = cvtpk(y[2], y[3]);
            *(u32x2*)(h + (size_t)row * DM + c0) = w; }
    }
}

__device__ __forceinline__ void prep0_phase(const Params& p) {
    const int lane0 = threadIdx.x & 63, wid = threadIdx.x >> 6;
    bf16_t* proj = (bf16_t*)(p.ws + WS_PROJ);
    bf16_t* qkvp = (bf16_t*)p.out;
    float* gbuf = (float*)(p.ws + WS_GATES);
    const float* ropec = (const float*)(p.ws + WS_ROPE); const float* ropes = ropec + SEQ * 32;
    constexpr int RB = 8;
    for (int blk = blockIdx.x * 8 + wid; blk < MTOT / RB; blk += gridDim.x * 8) {
        int lane = lane0; asm volatile("" : "+v"(lane));
        const int row0 = blk * RB; const bool lat = row0 < NLAT; const int t0 = lat ? (row0 & 8191) : ((row0 - NLAT) & 255); const int len = lat ? SEQ : CTXL;
        const int dsub = (lane & 7) * 8;
        {
            float gq[8], gk[8];
#pragma unroll
            for (int i = 0; i < 8; ++i) { gq[i] = p.diff_qk_gain[dsub + i] * (0.125f * 1.4426950408889634f); gk[i] = p.diff_qk_gain[64 + dsub + i]; }
            for (int i = 0; i < RB; ++i) {
                bf16_t* P = proj + (size_t)(row0 + i) * EV_NP;
                f32x4 c4 = {1.f, 1.f, 1.f, 1.f}, s4 = {0.f, 0.f, 0.f, 0.f};
                if (lat) { c4 = *(const f32x4*)(ropec + (t0 + i) * 32 + (lane & 7) * 4); s4 = *(const f32x4*)(ropes + (t0 + i) * 32 + (lane & 7) * 4); }
#pragma unroll
                for (int which = 0; which < 2; ++which) {
                    float v[8]; unpack8(*(const bf16x8*)(P + which * 512 + lane * 8), v);
                    float ss = 0.f;
#pragma unroll
                    for (int e = 0; e < 8; ++e) ss += v[e] * v[e];
                    ss += __shfl_xor(ss, 1); ss += __shfl_xor(ss, 2); ss += __shfl_xor(ss, 4);
                    const float rstd = rsqrtf(ss * (1.f / 64.f) + 1e-6f);
#pragma unroll
                    for (int e = 0; e < 8; ++e) v[e] = v[e] * rstd * (which ? gk[e] : gq[e]);
#pragma unroll
                    for (int e = 0; e < 4; ++e) { const float x0 = v[2 * e], x1 = v[2 * e + 1]; v[2 * e] = x0 * c4[e] - x1 * s4[e]; v[2 * e + 1] = x0 * s4[e] + x1 * c4[e]; }
                    *(bf16x8*)(P + which * 512 + lane * 8) = pack8(v);
                }
            }
        }
#pragma unroll 1
        for (int g = 0; g < 3; ++g) {
            const int c0 = g * 512 + lane * 8;
            float w[5][8];
#pragma unroll
            for (int j = 0; j < 5; ++j) { const f32x4 w0 = *(const f32x4*)(p.gdn_conv + j * 1536 + c0), w1 = *(const f32x4*)(p.gdn_conv + j * 1536 + c0 + 4);
#pragma unroll
                for (int e = 0; e < 4; ++e) { w[j][e] = w0[e]; w[j][4 + e] = w1[e]; } }
            float xm2[8], xm1[8], x0[8], xp1[8], xp2[8];
            const bf16_t* src = proj + (size_t)row0 * EV_NP + 1536 + c0;
#define LDROW(dst, dt) do { if (t0 + (dt) >= 0 && t0 + (dt) < len) unpack8(*(const bf16x8*)(src + (ptrdiff_t)(dt) * EV_NP), dst); else { _Pragma("unroll") for (int e_ = 0; e_ < 8; ++e_) dst[e_] = 0.f; } } while (0)
            LDROW(xm2, -2); LDROW(xm1, -1); LDROW(x0, 0); LDROW(xp1, 1);
            const float nsc = g == 0 ? 0.08838834764831845f : 1.f;
            for (int i = 0; i < RB; ++i) {
                LDROW(xp2, i + 2);
                float y[8];
#pragma unroll
                for (int e = 0; e < 8; ++e) { y[e] = w[0][e] * xm2[e] + w[1][e] * xm1[e] + w[2][e] * x0[e] + w[3][e] * xp1[e] + w[4][e] * xp2[e]; y[e] = y[e] / (1.f + __expf(-y[e])); }
                if (g < 2) { float ss = 0.f;
#pragma unroll
                    for (int e = 0; e < 8; ++e) ss += y[e] * y[e];
                    ss += __shfl_xor(ss, 1); ss += __shfl_xor(ss, 2); ss += __shfl_xor(ss, 4); ss += __shfl_xor(ss, 8);
                    const float sc_ = rsqrtf(ss + 1e-6f) * nsc;
#pragma unroll
                    for (int e = 0; e < 8; ++e) y[e] *= sc_; }
                *(bf16x8*)(qkvp + (size_t)(row0 + i) * 1536 + c0) = pack8(y);
#pragma unroll
                for (int e = 0; e < 8; ++e) { xm2[e] = xm1[e]; xm1[e] = x0[e]; x0[e] = xp1[e]; xp1[e] = xp2[e]; }
            }
#undef LDROW
        }
#pragma unroll
        for (int k = 0; k < RB / 4; ++k) { const int idx = lane + 64 * k, i = idx >> 4, gi = idx & 15;
            const float gvv = bf2f(proj[(size_t)(row0 + i) * EV_NP + 3584 + gi]); float o;
            if (gi < 8) o = 1.f / (1.f + expf(-gvv));
            else { const float z = gvv + p.gdn_dt_bias[gi - 8]; const float sp = z > 20.f ? z : log1pf(expf(z)); o = -expf(p.gdn_a_log[gi - 8]) * sp; }
            gbuf[(size_t)(row0 + i) * 16 + gi] = o; }
    }
}

__device__ __forceinline__ int gdn_row(int b, int pc, int tau, int dir) {
    const int tt = dir ? 63 - tau : tau;
    return pc < 4 ? NLAT + b * CTXL + pc * 64 + tt : b * SEQ + (pc - 4) * 64 + tt;
}
__device__ __forceinline__ void gdn_pre_phase(const Params& p, unsigned char* lds) {
    const int lane = threadIdx.x & 63, wid = threadIdx.x >> 6;
    float* Lw = (float*)(lds + wid * 16896);
    float* gs = Lw + 4096; float* bs = gs + 64;
    const bf16_t* qkvp = (const bf16_t*)p.out;
    const float* gbuf = (const float*)(p.ws + WS_GATES);
    bf16_t* Tb = (bf16_t*)(p.ws + WS_T); bf16_t* Ab = (bf16_t*)(p.ws + WS_AQK);
    float* gv = (float*)(p.ws + WS_GV); float* bv = (float*)(p.ws + WS_BV);
    const int lane0 = lane;
    for (int cp = blockIdx.x * 8 + wid; cp < NCHUNKP; cp += gridDim.x * 8) {
        int lane = lane0; asm volatile("" : "+v"(lane));
        const int r32 = lane & 31, hi = lane >> 5;
        const int pc = cp % 132, ch = cp / 132, dir = ch & 1, h = (ch >> 1) & 3, b = ch >> 3;
        { const int R = gdn_row(b, pc, lane, dir);
          float g = gbuf[(size_t)R * 16 + 8 + dir * 4 + h]; const float be = gbuf[(size_t)R * 16 + dir * 4 + h];
#pragma unroll
          for (int o = 1; o < 64; o <<= 1) { const float t = __shfl_up(g, o); if (lane >= o) g += t; }
          gs[lane] = g; bs[lane] = be; const float gl_ = __shfl(g, 63); gv[(size_t)cp * 64 + lane] = expf(g); bv[(size_t)cp * 64 + lane] = be; ((float*)(p.ws + WS_EL))[(size_t)cp * 64 + lane] = expf(gl_ - g); }
        bf16x8 kf[2][8];
#pragma unroll
        for (int mi = 0; mi < 2; ++mi) { const size_t R = (size_t)gdn_row(b, pc, 32 * mi + r32, dir);
#pragma unroll
            for (int d0 = 0; d0 < 8; ++d0) kf[mi][d0] = *(const bf16x8*)(qkvp + R * 1536 + 512 + h * 128 + d0 * 16 + hi * 8); }
        bf16_t* Ao = Ab + (size_t)cp * 4096;
#pragma unroll
        for (int mi = 0; mi < 2; ++mi) {
            bf16x8 qf[8];
            { const size_t R = (size_t)gdn_row(b, pc, 32 * mi + r32, dir);
#pragma unroll
              for (int d0 = 0; d0 < 8; ++d0) qf[d0] = *(const bf16x8*)(qkvp + R * 1536 + h * 128 + d0 * 16 + hi * 8); }
#pragma unroll
            for (int ni = 0; ni <= mi; ++ni) {
                f32x16 ckk = {}, cqk = {};
#pragma unroll
                for (int d0 = 0; d0 < 8; ++d0) { ckk = __builtin_amdgcn_mfma_f32_32x32x16_bf16(kf[mi][d0], kf[ni][d0], ckk, 0, 0, 0);
                                                 cqk = __builtin_amdgcn_mfma_f32_32x32x16_bf16(qf[d0], kf[ni][d0], cqk, 0, 0, 0); }
                const int sg = 32 * ni + r32; const float gsg = gs[sg];
#pragma unroll
                for (int r = 0; r < 16; ++r) { const int tau = 32 * mi + crow(r, hi);
                    const float dec = tau >= sg ? expf(gs[tau] - gsg) : 0.f;
                    Lw[tau * 64 + sg] = tau > sg ? bs[tau] * dec * ckk[r] : 0.f;
                    Ao[tau * 64 + sg] = f2bf(cqk[r] * dec); }
                asm volatile("" ::: "memory");
            }
        }
#pragma unroll
        for (int r = 0; r < 16; ++r) Ao[crow(r, hi) * 64 + 32 + r32] = 0;
        float Tc[64];
#pragma unroll
        for (int i = 0; i < 64; ++i) { float a = (i == lane) ? 1.f : 0.f;
#pragma unroll
            for (int j = 0; j < i; ++j) a -= Lw[i * 64 + j] * Tc[j];
            Tc[i] = a; asm volatile("" ::: "memory"); }
        bf16_t* To = Tb + (size_t)cp * 4096;
#pragma unroll
        for (int i = 0; i < 64; ++i) To[i * 64 + lane] = f2bf(Tc[i]);
    }
}

constexpr int G_KV = 0, G_QA = 16384, G_TT = 32768, G_AQ = G_TT + 9216, G_RT = G_AQ + 9216, G_UT = G_RT + 4608, G_UP = G_UT + 4608,
              G_ST = G_UP + 4608, G_VS = G_ST + 8704, G_GS = G_VS + 4096, G_BS = G_GS + 256, G_EL = G_BS + 256, G_END = G_EL + 256;
__device__ __forceinline__ void gdn_scan_phase(const Params& p, unsigned char* lds) {
    const int tid = threadIdx.x, lane0 = tid & 63, wid = tid >> 6;
    const bf16_t* qkvp = (const bf16_t*)p.out;
    const bf16_t* Tb = (const bf16_t*)(p.ws + WS_T); const bf16_t* Ab = (const bf16_t*)(p.ws + WS_AQK);
    const float* gv = (const float*)(p.ws + WS_GV); const float* bv = (const float*)(p.ws + WS_BV);
    bf16_t* obuf = (bf16_t*)(p.ws + WS_H);
    const float* gsl = (const float*)(lds + G_GS); const float* bsl = (const float*)(lds + G_BS); const float* esl = (const float*)(lds + G_EL);
    const int sr = tid >> 4, sc = (tid & 15) * 8;
    const int vblk = (gridDim.x % 8 == 0) ? (int)((blockIdx.x & 7) * (gridDim.x >> 3) + (blockIdx.x >> 3)) : (int)blockIdx.x;
    for (int wi = vblk; wi < 256; wi += gridDim.x) {
        const int chain = wi >> 2, cs = wi & 3, b = chain >> 3, h = (chain >> 1) & 3, dir = chain & 1;
        f32x16 Sacc = {};
        for (int i = tid; i < 8704 / 4; i += NTHREADS) ((unsigned*)(lds + G_ST))[i] = 0u;
        bf16x8 sk0, sk1, sq0, sq1, sT, sA, sV; float sg = 0.f;
#define GLOAD(step) do { const int pc_ = dir == 0 ? (step) : ((step) < 4 ? 3 - (step) : 4 + 127 - ((step) - 4)); \
        const size_t cp_ = (size_t)chain * 132 + pc_; \
        const size_t R0_ = (size_t)gdn_row(b, pc_, sr, dir), R1_ = (size_t)gdn_row(b, pc_, 32 + sr, dir); \
        sk0 = *(const bf16x8*)(qkvp + R0_ * 1536 + 512 + h * 128 + sc); sk1 = *(const bf16x8*)(qkvp + R1_ * 1536 + 512 + h * 128 + sc); \
        sq0 = *(const bf16x8*)(qkvp + R0_ * 1536 + h * 128 + sc); sq1 = *(const bf16x8*)(qkvp + R1_ * 1536 + h * 128 + sc); \
        sT = *(const bf16x8*)(Tb + cp_ * 4096 + tid * 8); sA = *(const bf16x8*)(Ab + cp_ * 4096 + tid * 8); \
        if (tid < 256) { const size_t Rv_ = (size_t)gdn_row(b, pc_, tid >> 2, dir); sV = *(const bf16x8*)(qkvp + Rv_ * 1536 + 1024 + h * 128 + cs * 32 + (tid & 3) * 8); } \
        if (tid < 64) sg = gv[cp_ * 64 + tid]; else if (tid < 128) sg = bv[cp_ * 64 + tid - 64]; else if (tid < 192) sg = ((const float*)(p.ws + WS_EL))[cp_ * 64 + tid - 128]; } while (0)
#define GWRITE() do { *(bf16x8*)(lds + G_KV + v_st(sr, sc)) = sk0; *(bf16x8*)(lds + G_KV + v_st(32 + sr, sc)) = sk1; \
        *(bf16x8*)(lds + G_QA + KSWZ(sr, sc * 2)) = sq0; *(bf16x8*)(lds + G_QA + KSWZ(32 + sr, sc * 2)) = sq1; \
        *(bf16x8*)(lds + G_TT + (tid >> 3) * 144 + (tid & 7) * 16) = sT; *(bf16x8*)(lds + G_AQ + (tid >> 3) * 144 + (tid & 7) * 16) = sA; \
        if (tid < 256) *(bf16x8*)(lds + G_VS + (tid >> 2) * 64 + (tid & 3) * 16) = sV; \
        if (tid < 192) ((float*)(lds + G_GS))[tid] = sg; } while (0)
        GLOAD(0);
        for (int step = 0; step < 132; ++step) {
            GWRITE();
            __syncthreads();
            if (step + 1 < 132) GLOAD(step + 1);
            int lane = lane0; asm volatile("" : "+v"(lane));
            const int r32 = lane & 31, hi = lane >> 5;
            const int vb0 = (int)(uintptr_t)(lds + G_KV) + v_rd_base(lane);
            const int pc = dir == 0 ? step : (step < 4 ? 3 - step : 4 + 127 - (step - 4));
            f32x16 acc = {};
            const int mi = wid & 1;
            if (wid < 4) {
                f32x16 acc2 = {};
                if (wid < 2) {
#pragma unroll
                    for (int d0 = 0; d0 < 8; d0 += 2) {
                        const bf16x8 a0 = *(const bf16x8*)(lds + G_KV + v_st(32 * mi + r32, d0 * 16 + hi * 8)), a1 = *(const bf16x8*)(lds + G_KV + v_st(32 * mi + r32, d0 * 16 + 16 + hi * 8));
                        const bf16x8 b0 = *(const bf16x8*)(lds + G_ST + r32 * 272 + (d0 * 16 + hi * 8) * 2), b1 = *(const bf16x8*)(lds + G_ST + r32 * 272 + (d0 * 16 + 16 + hi * 8) * 2);
                        acc = __builtin_amdgcn_mfma_f32_32x32x16_bf16(a0, b0, acc, 0, 0, 0);
                        acc2 = __builtin_amdgcn_mfma_f32_32x32x16_bf16(a1, b1, acc2, 0, 0, 0); }
                } else {
#pragma unroll
                    for (int d0 = 0; d0 < 8; d0 += 2) {
                        const bf16x8 a0 = *(const bf16x8*)(lds + G_QA + KSWZ(32 * mi + r32, (d0 * 16 + hi * 8) * 2)), a1 = *(const bf16x8*)(lds + G_QA + KSWZ(32 * mi + r32, (d0 * 16 + 16 + hi * 8) * 2));
                        const bf16x8 b0 = *(const bf16x8*)(lds + G_ST + r32 * 272 + (d0 * 16 + hi * 8) * 2), b1 = *(const bf16x8*)(lds + G_ST + r32 * 272 + (d0 * 16 + 16 + hi * 8) * 2);
                        acc = __builtin_amdgcn_mfma_f32_32x32x16_bf16(a0, b0, acc, 0, 0, 0);
                        acc2 = __builtin_amdgcn_mfma_f32_32x32x16_bf16(a1, b1, acc2, 0, 0, 0); }
                }
#pragma unroll
                for (int r = 0; r < 16; ++r) acc[r] += acc2[r];
                if (wid < 2) {
#pragma unroll
                    for (int g4 = 0; g4 < 4; ++g4) { float rv[4];
#pragma unroll
                        for (int j = 0; j < 4; ++j) { const int tau = 32 * mi + 8 * g4 + 4 * hi + j;
                            const float vv = bf2f(*(const bf16_t*)(lds + G_VS + tau * 64 + r32 * 2));
                            rv[j] = bsl[tau] * (vv - gsl[tau] * acc[g4 * 4 + j]); }
                        u32x2 w; w.x = cvtpk(rv[0], rv[1]); w.y = cvtpk(rv[2], rv[3]);
                        *(u32x2*)(lds + G_RT + r32 * 144 + (32 * mi + 8 * g4 + 4 * hi) * 2) = w; }
                } else {
#pragma unroll
                    for (int r = 0; r < 16; ++r) acc[r] *= gsl[32 * mi + crow(r, hi)];
                }
            }
            __syncthreads();
            if (wid < 2) {
                f32x16 u = {}, u2 = {};
#pragma unroll
                for (int s = 0; s < 4; s += 2) {
                    const bf16x8 a0 = *(const bf16x8*)(lds + G_TT + (32 * mi + r32) * 144 + (16 * s + hi * 8) * 2), a1 = *(const bf16x8*)(lds + G_TT + (32 * mi + r32) * 144 + (16 * s + 16 + hi * 8) * 2);
                    const bf16x8 b0 = *(const bf16x8*)(lds + G_RT + r32 * 144 + (16 * s + hi * 8) * 2), b1 = *(const bf16x8*)(lds + G_RT + r32 * 144 + (16 * s + 16 + hi * 8) * 2);
                    u = __builtin_amdgcn_mfma_f32_32x32x16_bf16(a0, b0, u, 0, 0, 0);
                    u2 = __builtin_amdgcn_mfma_f32_32x32x16_bf16(a1, b1, u2, 0, 0, 0); }
#pragma unroll
                for (int r = 0; r < 16; ++r) u[r] += u2[r];
#pragma unroll
                for (int g4 = 0; g4 < 4; ++g4) { float uv[4], up[4];
#pragma unroll
                    for (int j = 0; j < 4; ++j) { const int tau = 32 * mi + 8 * g4 + 4 * hi + j; uv[j] = u[g4 * 4 + j]; up[j] = uv[j] * esl[tau]; }
                    u32x2 w; w.x = cvtpk(uv[0], uv[1]); w.y = cvtpk(uv[2], uv[3]);
                    *(u32x2*)(lds + G_UT + r32 * 144 + (32 * mi + 8 * g4 + 4 * hi) * 2) = w;
                    u32x2 w2; w2.x = cvtpk(up[0], up[1]); w2.y = cvtpk(up[2], up[3]);
                    *(u32x2*)(lds + G_UP + r32 * 144 + (32 * mi + 8 * g4 + 4 * hi) * 2) = w2; }
            }
            __syncthreads();
            if (wid == 2 || wid == 3) {
#pragma unroll
                for (int s = 0; s < 4; ++s) {
                    const bf16x8 a = *(const bf16x8*)(lds + G_AQ + (32 * mi + r32) * 144 + (16 * s + hi * 8) * 2);
                    const bf16x8 bb = *(const bf16x8*)(lds + G_UT + r32 * 144 + (16 * s + hi * 8) * 2);
                    acc = __builtin_amdgcn_mfma_f32_32x32x16_bf16(a, bb, acc, 0, 0, 0); }
#pragma unroll
                for (int r = 0; r < 16; ++r) { const size_t R = (size_t)gdn_row(b, pc, 32 * mi + crow(r, hi), dir);
                    obuf[((size_t)dir * MTOT + R) * 512 + h * 128 + cs * 32 + r32] = f2bf(acc[r]); }
            } else if (wid >= 4) {
                const float gl = gsl[63];
#pragma unroll
                for (int r = 0; r < 16; ++r) Sacc[r] *= gl;
                const bf16x8 pa0 = *(const bf16x8*)(lds + G_UP + r32 * 144 + (0 + hi * 8) * 2), pa1 = *(const bf16x8*)(lds + G_UP + r32 * 144 + (16 + hi * 8) * 2),
                             pa2 = *(const bf16x8*)(lds + G_UP + r32 * 144 + (32 + hi * 8) * 2), pa3 = *(const bf16x8*)(lds + G_UP + r32 * 144 + (48 + hi * 8) * 2);
                const int d0 = wid - 4;
                if (d0 == 0) pv_one<0>(Sacc, vb0, pa0, pa1, pa2, pa3); else if (d0 == 1) pv_one<1>(Sacc, vb0, pa0, pa1, pa2, pa3);
                else if (d0 == 2) pv_one<2>(Sacc, vb0, pa0, pa1, pa2, pa3); else pv_one<3>(Sacc, vb0, pa0, pa1, pa2, pa3);
#pragma unroll
                for (int r = 0; r < 16; ++r) *(bf16_t*)(lds + G_ST + crow(r, hi) * 272 + (32 * d0 + r32) * 2) = f2bf(Sacc[r]);
            }
            __syncthreads();
        }
#undef GLOAD
#undef GWRITE
    }
}

__device__ __forceinline__ void gdn_post_phase(const Params& p) {
    const int lane = threadIdx.x & 63, wid = threadIdx.x >> 6;
    const bf16_t* obuf = (const bf16_t*)(p.ws + WS_H);
    const bf16_t* proj = (const bf16_t*)(p.ws + WS_PROJ);
    bf16_t* mix = (bf16_t*)(p.ws + WS_MIX);
    const int d = (lane & 15) * 8;
    for (int row = blockIdx.x * 8 + wid; row < MTOT; row += gridDim.x * 8) {
        float a[8], bb[8], g[8], y[8];
        unpack8(*(const bf16x8*)(obuf + (size_t)row * 512 + lane * 8), a);
        unpack8(*(const bf16x8*)(obuf + ((size_t)MTOT + row) * 512 + lane * 8), bb);
        unpack8(*(const bf16x8*)(proj + (size_t)row * EV_NP + 3072 + lane * 8), g);
        float ss = 0.f;
#pragma unroll
        for (int i = 0; i < 8; ++i) { a[i] += bb[i]; ss += a[i] * a[i]; }
        ss += __shfl_xor(ss, 1); ss += __shfl_xor(ss, 2); ss += __shfl_xor(ss, 4); ss += __shfl_xor(ss, 8);
        const float rstd = rsqrtf(ss * (1.f / 128.f) + 1e-6f);
#pragma unroll
        for (int i = 0; i < 8; ++i) y[i] = a[i] * rstd * p.gdn_norm[d + i] * (g[i] / (1.f + expf(-g[i])));
        *(bf16x8*)(mix + (size_t)row * DM + 512 + lane * 8) = pack8(y);
    }
}

__device__ __forceinline__ void diffattn_phase(const Params& p, unsigned char* lds) {
    const int tid = threadIdx.x, wid = tid >> 6, lane = tid & 63, r32 = lane & 31, hi = lane >> 5;
    const bf16_t* proj = (const bf16_t*)(p.ws + WS_PROJ);
    bf16_t* mix = (bf16_t*)(p.ws + WS_MIX);
    float s01 = 0.f, s23 = 0.f;
    for (int i = 0; i < 64; ++i) { s01 += p.diff_lambda[i] * p.diff_lambda[64 + i]; s23 += p.diff_lambda[128 + i] * p.diff_lambda[192 + i]; }
    const float lam = expf(s01) - expf(s23) + 0.2f;
    float* X = (float*)lds; float* li = (float*)(lds + 131072) + wid * 64;
    LAS unsigned char* ldsl = (LAS unsigned char*)lds;
    int koff[2], voff[2];
#pragma unroll
    for (int i = 0; i < 2; ++i) {
        const int g = i * 512 + tid;
        { const int row = g >> 4, cg = (g & 15) ^ (row & 7); koff[i] = row * EV_NP + cg * 8; }
        { const int o = g * 16, st = o >> 9, w = o & 511, kk = (st >> 2) * 8 + (w >> 6);
          const int k = (kk & ~0xC) | ((kk & 4) << 1) | ((kk & 8) >> 1), cc = (st & 3) * 32 + ((w & 63) >> 4) * 8; voff[i] = k * EV_NP + cc; }
    }
    const int vbase = (int)(uintptr_t)lds + v_rd_base(lane);
    const int map = wid >> 2, wq = wid & 3;
    unsigned char* Qs = lds + 98304 + wid * 4096 + lane * 16;
    const int vblk = (gridDim.x % 8 == 0) ? (int)((blockIdx.x & 7) * (gridDim.x >> 3) + (blockIdx.x >> 3)) : (int)blockIdx.x;
    for (int it = vblk; it < 2112; it += gridDim.x) {
        int b, h, NT, qrow0;
        if (it < 2048) { b = it >> 8; h = (it >> 6) & 3; const int qb = it & 63; NT = 132; qrow0 = b * SEQ + qb * 128; }
        else { const int j = it - 2048; b = j >> 3; h = (j >> 1) & 3; NT = 4; qrow0 = NLAT + b * CTXL + (j & 1) * 128; }
        { const bf16_t* qp = proj + (size_t)(qrow0 + 32 * wq + r32) * EV_NP + h * 128 + map * 64 + hi * 8;
#pragma unroll
          for (int d0 = 0; d0 < 4; ++d0) *(bf16x8*)(Qs + d0 * 1024) = *(const bf16x8*)(qp + d0 * 16); }
        f32x16 o[4] = {}; float lsum = 0.f;
#define DDMA(j, bo) do { const bf16_t* pp_ = proj + (size_t)((j) < 4 ? NLAT + b * CTXL + 64 * (j) : b * SEQ + 64 * ((j) - 4)) * EV_NP + h * 128; \
        _Pragma("unroll") for (int i_ = 0; i_ < 2; ++i_) { \
            __builtin_amdgcn_global_load_lds((const unsigned*)(pp_ + 1024 + voff[i_]), (LAS unsigned*)(ldsl + (bo) + i_ * 8192 + wid * 1024), 16, 0, 0); \
            __builtin_amdgcn_global_load_lds((const unsigned*)(pp_ + 512 + koff[i_]), (LAS unsigned*)(ldsl + (bo) + 16384 + i_ * 8192 + wid * 1024), 16, 0, 0); } } while (0)
#define DQK(P0, P1, bo) do { P0 = (f32x16){}; P1 = (f32x16){}; const unsigned char* Ks_ = lds + (bo) + 16384; \
        _Pragma("unroll") for (int d0 = 0; d0 < 4; ++d0) { const int cb_ = (map * 64 + d0 * 16 + hi * 8) * 2; \
            const bf16x8 b0_ = *(const bf16x8*)(Ks_ + KSWZ(r32, cb_)), b1_ = *(const bf16x8*)(Ks_ + KSWZ(32 + r32, cb_)); \
            const bf16x8 qd_ = *(const bf16x8*)(Qs + d0 * 1024); \
            P0 = __builtin_amdgcn_mfma_f32_32x32x16_bf16(b0_, qd_, P0, 0, 0, 0); \
            P1 = __builtin_amdgcn_mfma_f32_32x32x16_bf16(b1_, qd_, P1, 0, 0, 0); } } while (0)
#define DSM(P0, P1) do { _Pragma("unroll") for (int r = 0; r < 16; ++r) { P0[r] = __builtin_amdgcn_exp2f(P0[r]); P1[r] = __builtin_amdgcn_exp2f(P1[r]); lsum += P0[r] + P1[r]; } \
        PK4(P0, 0, pa0); PK4(P0, 8, pa1); PK4(P1, 0, pa2); PK4(P1, 8, pa3); } while (0)
#define DTAIL_() asm volatile("s_waitcnt vmcnt(0)" ::: "memory"); __syncthreads(); { const int t_ = bprev; bprev = bcur; bcur = bnext; bnext = t_; }
#define DSTEP_A(N0, N1, O0, O1, j) do { if ((j) + 1 < NT) DDMA((j) + 1, bnext); \
        DQK(N0, N1, bcur); DSM(O0, O1); pv_d0(o, vbase + bprev, pa0, pa1, pa2, pa3); DTAIL_() } while (0)
#define DSTEP_B(N0, N1, O0, O1, j) do { if ((j) + 1 < NT) DDMA((j) + 1, bnext); \
        DSM(O0, O1); pv_d0(o, vbase + bprev, pa0, pa1, pa2, pa3); SBAR(); DQK(N0, N1, bcur); DTAIL_() } while (0)
        f32x16 pA0, pA1, pB0, pB1; bf16x8 pa0, pa1, pa2, pa3;
        DDMA(0, 0); DDMA(1, 32768); asm volatile("s_waitcnt vmcnt(0)" ::: "memory"); __syncthreads();
        DQK(pA0, pA1, 0);
        int bprev = 0, bcur = 32768, bnext = 65536;
        if (map == 0) {
            for (int j = 1; j + 1 < NT; j += 2) { DSTEP_A(pB0, pB1, pA0, pA1, j); DSTEP_A(pA0, pA1, pB0, pB1, j + 1); }
            DSTEP_A(pB0, pB1, pA0, pA1, NT - 1);
        } else {
            for (int j = 1; j + 1 < NT; j += 2) { DSTEP_B(pB0, pB1, pA0, pA1, j); DSTEP_B(pA0, pA1, pB0, pB1, j + 1); }
            DSTEP_B(pB0, pB1, pA0, pA1, NT - 1);
        }
        DSM(pB0, pB1); pv_d0(o, vbase + bprev, pa0, pa1, pa2, pa3);
        __syncthreads();
#undef DDMA
#undef DQK
#undef DSM
#undef DSTEP_A
#undef DSTEP_B
#undef DTAIL_
        const float lt = halfswap_add(lsum);
        if (hi == 0) li[r32] = lt;
        asm volatile("s_waitcnt lgkmcnt(0)" ::: "memory");
        float rli[16];
#pragma unroll
        for (int r = 0; r < 16; ++r) rli[r] = 1.f / li[crow(r, hi)];
        if (map == 1) {
#pragma unroll
            for (int d0 = 0; d0 < 4; ++d0)
#pragma unroll
                for (int r = 0; r < 16; ++r) X[(wq * 64 + d0 * 16 + r) * 64 + lane] = o[d0][r] * rli[r] * lam;
        }
        __syncthreads();
        if (map == 0) {
#pragma unroll
            for (int d0 = 0; d0 < 4; ++d0)
#pragma unroll
                for (int r = 0; r < 16; ++r) o[d0][r] = o[d0][r] * rli[r] - X[(wq * 64 + d0 * 16 + r) * 64 + lane];
#pragma unroll
            for (int r = 0; r < 16; ++r) {
                float ss = o[0][r] * o[0][r] + o[1][r] * o[1][r] + o[2][r] * o[2][r] + o[3][r] * o[3][r];
                ss += __shfl_xor(ss, 1); ss += __shfl_xor(ss, 2); ss += __shfl_xor(ss, 4); ss += __shfl_xor(ss, 8); ss += __shfl_xor(ss, 16);
                const float rstd = rsqrtf(ss * (1.f / 128.f) + 1e-6f) * 0.8f;
                bf16_t* mp = mix + (size_t)(qrow0 + 32 * wq + crow(r, hi)) * DM + h * 128 + r32;
#pragma unroll
                for (int d0 = 0; d0 < 4; ++d0) mp[32 * d0] = f2bf(o[d0][r] * rstd * p.diff_subln[32 * d0 + r32]);
            }
        }
        __syncthreads();
    }
}

__device__ __forceinline__ void natten_phase(const Params& p, unsigned char* lds) {
    const int tid = threadIdx.x, wid = tid >> 6, lane = tid & 63, r32 = lane & 31, hi = lane >> 5;
    const bf16_t* proj = (const bf16_t*)(p.ws + WS_PROJ);
    bf16_t* mix = (bf16_t*)(p.ws + WS_MIX);
    constexpr float L2E = 1.4426950408889634f;
    unsigned char* Vl = lds; unsigned char* Kl = lds + 32768;
    float* rpbs = (float*)(lds + 65536);
    float* li = (float*)(lds + 133120) + wid * 64;
    unsigned char* Qs = lds + 67584 + wid * 8192 + lane * 16;
    const int sr = tid >> 4, sc = (tid & 15) * 8, vst0 = v_st(sr, sc), vst1 = v_st(32 + sr, sc);
    const int vb0 = (int)(uintptr_t)Vl + v_rd_base(lane);
    const float* gkp = p.na_qk_gain + 128 + sc;
    const int vblk = (gridDim.x % 8 == 0) ? (int)((blockIdx.x & 7) * (gridDim.x >> 3) + (blockIdx.x >> 3)) : (int)blockIdx.x;
    for (int it = vblk; it < 2048; it += gridDim.x) {
        const int b = it >> 8, h = (it >> 5) & 7, rq = it & 31;
        const int grow = 4 * rq + (wid >> 1), qc = (wid & 1) * 32 + r32;
        const size_t qR = (size_t)b * SEQ + grow * 64 + qc;
        for (int i = tid; i < 465; i += NTHREADS) rpbs[i] = p.na_rpb[h * 465 + i] * L2E;
        { float ss = 0.f;
#pragma unroll
          for (int d0 = 0; d0 < 8; ++d0) { float qv[8]; unpack8(*(const bf16x8*)(proj + qR * OD_N + h * 128 + d0 * 16 + hi * 8), qv);
#pragma unroll
              for (int i = 0; i < 8; ++i) ss += qv[i] * qv[i]; }
          ss = halfswap_add(ss);
          const float rs = rsqrtf(ss * (1.f / 128.f) + 1e-6f) * 0.08838834764831845f * L2E;
#pragma unroll
          for (int d0 = 0; d0 < 8; ++d0) { float qv[8]; unpack8(*(const bf16x8*)(proj + qR * OD_N + h * 128 + d0 * 16 + hi * 8), qv);
#pragma unroll
              for (int i = 0; i < 8; ++i) qv[i] *= rs * p.na_qk_gain[d0 * 16 + hi * 8 + i];
              *(bf16x8*)(Qs + d0 * 1024) = pack8(qv); } }
        int lo = 4 * rq - 4; lo = lo < 0 ? 0 : (lo > 120 ? 120 : lo);
        int hi_r = 4 * rq + 3 - 4; hi_r = hi_r < 0 ? 0 : (hi_r > 120 ? 120 : hi_r); hi_r += 7;
        const int nlat = hi_r - lo + 1, NT = nlat + 4;
        int wsr = grow - 4; wsr = wsr < 0 ? 0 : (wsr > 120 ? 120 : wsr);
        int cst = qc - 8; cst = cst < 0 ? 0 : (cst > 48 ? 48 : cst);
        f32x16 o[4] = {}; float lsum = 0.f;
        bf16x8 vs0, vs1, ks0, ks1;
#define NLOAD(j) do { const size_t R0_ = (size_t)((j) < nlat ? b * SEQ + (lo + (j)) * 64 : NLAT + b * CTXL + 64 * ((j) - nlat)) + sr; \
        const bf16_t* pp_ = proj + R0_ * OD_N + h * 128 + sc; \
        vs0 = *(const bf16x8*)(pp_ + 2048); vs1 = *(const bf16x8*)(pp_ + 2048 + (size_t)32 * OD_N); \
        ks0 = *(const bf16x8*)(pp_ + 1024); ks1 = *(const bf16x8*)(pp_ + 1024 + (size_t)32 * OD_N); } while (0)
#define KNORM(kx) do { float f_[8]; unpack8(kx, f_); float ss_ = 0.f; _Pragma("unroll") for (int i_ = 0; i_ < 8; ++i_) ss_ += f_[i_] * f_[i_]; \
        ss_ += __shfl_xor(ss_, 1); ss_ += __shfl_xor(ss_, 2); ss_ += __shfl_xor(ss_, 4); ss_ += __shfl_xor(ss_, 8); \
        const float rs_ = rsqrtf(ss_ * (1.f / 128.f) + 1e-6f); _Pragma("unroll") for (int i_ = 0; i_ < 8; ++i_) f_[i_] *= rs_ * gkp[i_]; kx = pack8(f_); } while (0)
#define NWRITE(bf) do { KNORM(ks0); KNORM(ks1); *(bf16x8*)(Vl + (bf) * 16384 + vst0) = vs0; *(bf16x8*)(Vl + (bf) * 16384 + vst1) = vs1; \
        *(bf16x8*)(Kl + (bf) * 16384 + KSWZ(sr, sc * 2)) = ks0; *(bf16x8*)(Kl + (bf) * 16384 + KSWZ(32 + sr, sc * 2)) = ks1; } while (0)
        NLOAD(0); NWRITE(0); __syncthreads();
        for (int j = 0; j < NT; ++j) {
            if (j + 1 < NT) NLOAD(j + 1);
            const int bf = j & 1;
            const bool islat = j < nlat; const int kr = lo + j;
            const bool active = !islat || (kr >= wsr && kr <= wsr + 7);
            if (active) {
                f32x16 p0 = {}, p1 = {};
                const unsigned char* Ks = Kl + bf * 16384;
#pragma unroll
                for (int d0 = 0; d0 < 8; ++d0) { const int cb = (d0 * 16 + hi * 8) * 2;
                    const bf16x8 b0 = *(const bf16x8*)(Ks + KSWZ(r32, cb)), b1 = *(const bf16x8*)(Ks + KSWZ(32 + r32, cb));
                    const bf16x8 qd = *(const bf16x8*)(Qs + d0 * 1024);
                    p0 = __builtin_amdgcn_mfma_f32_32x32x16_bf16(b0, qd, p0, 0, 0, 0);
                    p1 = __builtin_amdgcn_mfma_f32_32x32x16_bf16(b1, qd, p1, 0, 0, 0); }
                if (islat) {
                    const float* rb = rpbs + (kr - grow + 7) * 31 + 15 - qc + 4 * hi;
                    const int mofs = 4 * hi - cst;
#pragma unroll
                    for (int r = 0; r < 16; ++r) {
                        const int kb = (r & 3) + 8 * (r >> 2);
                        const float e0 = __builtin_amdgcn_exp2f(p0[r] + rb[kb]), e1 = __builtin_amdgcn_exp2f(p1[r] + rb[32 + kb]);
                        p0[r] = ((unsigned)(kb + mofs) < 16u) ? e0 : 0.f; p1[r] = ((unsigned)(32 + kb + mofs) < 16u) ? e1 : 0.f;
                        lsum += p0[r] + p1[r]; }
                } else {
#pragma unroll
                    for (int r = 0; r < 16; ++r) { p0[r] = __builtin_amdgcn_exp2f(p0[r]); p1[r] = __builtin_amdgcn_exp2f(p1[r]); lsum += p0[r] + p1[r]; }
                }
                bf16x8 pa0, pa1, pa2, pa3;
                PK4(p0, 0, pa0); PK4(p0, 8, pa1); PK4(p1, 0, pa2); PK4(p1, 8, pa3);
                pv_d0(o, vb0 + bf * 16384, pa0, pa1, pa2, pa3);
            }
            if (j + 1 < NT) NWRITE((j + 1) & 1);
            __syncthreads();
        }
#undef NLOAD
#undef KNORM
#undef NWRITE
        const float lt = halfswap_add(lsum);
        if (hi == 0) li[r32] = lt;
        asm volatile("s_waitcnt lgkmcnt(0)" ::: "memory");
#pragma unroll
        for (int r = 0; r < 16; ++r) { const float rl = 1.f / li[crow(r, hi)];
            bf16_t* mp = mix + ((size_t)b * SEQ + grow * 64 + (wid & 1) * 32 + crow(r, hi)) * DM + h * 128 + r32;
#pragma unroll
            for (int d0 = 0; d0 < 4; ++d0) mp[32 * d0] = f2bf(o[d0][r] * rl); }
        __syncthreads();
    }
}

#define XB_TMO      128
#define XB_XCNT(j)  (256  + 64 * (j))
#define XB_XSUB(j)  (1280 + 64 * (j))
#define XB_XGEN(j)  (2304 + 64 * (j))
#define XB_TOP      3328
#define XB_TOPGEN   3392
#define XCD_BAR_WORDS 3456
#define XB_SPIN_CAP (1u << 22)
__device__ __forceinline__ unsigned xb_ld(unsigned* p)              { return __hip_atomic_load(p, __ATOMIC_RELAXED, __HIP_MEMORY_SCOPE_AGENT); }
__device__ __forceinline__ unsigned xb_add(unsigned* p, unsigned v) { return __hip_atomic_fetch_add(p, v, __ATOMIC_RELAXED, __HIP_MEMORY_SCOPE_AGENT); }
__device__ __forceinline__ unsigned xb_xcc_id() { return (unsigned)__builtin_amdgcn_s_getreg((3 << 11) | 20) & 0xFu; }
#define XB_SPIN(cond, bar) do { unsigned _sp = 0; while (cond) { __builtin_amdgcn_s_sleep(1); \
    if ((++_sp & 255u) == 0u) { if (xb_ld(&(bar)[XB_TMO])) break; if (_sp > XB_SPIN_CAP) { atomicAdd(&(bar)[XB_TMO], 1u); break; } } } } while (0)
struct XcdBarrier { unsigned* bar; unsigned x; volatile LAS unsigned* st; };
__device__ __forceinline__ XcdBarrier xcd_barrier_post(unsigned* bar, volatile LAS unsigned* st) {
    XcdBarrier b; b.bar = bar; b.x = xb_xcc_id(); b.st = st;
    if (threadIdx.x == 0) (void)xb_add(&bar[XB_XCNT(b.x)], 1u);
    return b;
}
__device__ __forceinline__ void xcd_barrier_complete(unsigned* bar, unsigned x, unsigned& nloc, unsigned& nx) {
    const unsigned G = gridDim.x * gridDim.y * gridDim.z;
    unsigned sum, cnt, mine, sp = 0u;
    for (;;) {
        sum = 0u; cnt = 0u; mine = 0u;
#pragma unroll
        for (unsigned j = 0; j < 16; ++j) { const unsigned c = xb_ld(&bar[XB_XCNT(j)]); sum += c; cnt += (c > 0u) ? 1u : 0u; mine = (j == x) ? c : mine; }
        if (sum == G) break;
        __builtin_amdgcn_s_sleep(1);
        if ((++sp & 255u) == 0u) { if (xb_ld(&bar[XB_TMO])) break; if (sp > XB_SPIN_CAP) { atomicAdd(&bar[XB_TMO], 1u); break; } }
    }
    nloc = mine > 0u ? mine : 1u; nx = cnt > 0u ? cnt : 1u;
}
__device__ __forceinline__ void xcd_barrier(const XcdBarrier& b) {
    asm volatile("s_waitcnt vmcnt(0)" ::: "memory");
    __syncthreads();
    if (threadIdx.x == 0) {
        unsigned* bar = b.bar;
        __builtin_amdgcn_s_waitcnt(0);
        unsigned nloc = b.st[0], nx = b.st[1];
        if (nloc == 0u) { xcd_barrier_complete(bar, b.x, nloc, nx); b.st[0] = nloc; b.st[1] = nx; }
        const unsigned old = xb_add(&bar[XB_XSUB(b.x)], 1u);
        const unsigned gen = old / nloc;
        if (old + 1u == (gen + 1u) * nloc) {
            __builtin_amdgcn_fence(__ATOMIC_RELEASE, "agent");
            asm volatile("s_waitcnt vmcnt(0)" ::: "memory");
            const unsigned og = xb_add(&bar[XB_TOP], 1u);
            const unsigned tg = og / nx;
            if (og + 1u == (tg + 1u) * nx) xb_add(&bar[XB_TOPGEN], 1u);
            else XB_SPIN(xb_ld(&bar[XB_TOPGEN]) == tg, bar);
            __builtin_amdgcn_fence(__ATOMIC_ACQUIRE, "agent");
            xb_add(&bar[XB_XGEN(b.x)], 1u);
            asm volatile("s_waitcnt vmcnt(0)" ::: "memory");
        } else {
            XB_SPIN(xb_ld(&bar[XB_XGEN(b.x)]) == gen, bar);
            __builtin_amdgcn_fence(__ATOMIC_ACQUIRE, "agent");
            asm volatile("s_waitcnt vmcnt(0)" ::: "memory");
        }
    }
    __syncthreads();
}

#ifndef PROBE_REP
#define PROBE_REP 0
#endif
#define REP(k) for (int rep_ = 0; rep_ < (((PROBE_REP >> (k)) & 1) ? 2 : 1); ++rep_)
constexpr int NPH = 18;
__global__ void __launch_bounds__(NTHREADS, 2) fwd_megakernel(Params p) {
    extern __shared__ __attribute__((aligned(16))) unsigned char lds[];
    cg::grid_group grid = cg::this_grid();
    LAS unsigned char* ldsl = (LAS unsigned char*)lds;
    const int lo = p.ph_lo, hi = p.ph_hi;
#ifdef ONLY_PH
#define IN(k) (((ONLY_PH >> (k)) & 1) && lo <= (k) && (k) < hi)
#else
#define IN(k) (lo <= (k) && (k) < hi)
#endif
#define SEAM(k) do { if (IN(k) && IN((k) + 1)) { if ((k) == 0) grid.sync(); else { XcdBarrier xb_; xb_.bar = (unsigned*)(p.ws + WS_BAR); xb_.x = xb_xcc_id(); xb_.st = (volatile LAS unsigned*)(ldsl + 135168); xcd_barrier(xb_); } } } while (0)
    unsigned char* ws = p.ws;
    const bf16_t* H = (const bf16_t*)(ws + WS_H);
    bf16_t* PROJ = (bf16_t*)(ws + WS_PROJ);
    const bf16_t* MIX = (const bf16_t*)(ws + WS_MIX);
    float* CTXRES = (float*)(ws + WS_CTXRES);
    const float* MOD = (const float*)(ws + WS_MOD);
    const int G = gridDim.x, c = blockIdx.x;
    if (threadIdx.x < 4) ((volatile LAS unsigned*)(ldsl + 135168))[threadIdx.x] = 0u;
    __syncthreads();
    (void)xcd_barrier_post((unsigned*)(ws + WS_BAR), (volatile LAS unsigned*)(ldsl + 135168));

    if (IN(0)) REP(0) { ada_phase(p, lds); wconv_phase(p, lds);
        { float* rc = (float*)(ws + WS_ROPE); float* rs = rc + SEQ * 32;
          for (int e = blockIdx.x * NTHREADS + threadIdx.x; e < SEQ * 32; e += gridDim.x * NTHREADS) { const int t = e >> 5, pp = e & 31;
              const float inv = powf(10000.f, -(float)(pp & 15) / 16.f); const float ang = (pp < 16 ? (float)(t >> 6) : (float)(t & 63)) * inv;
              rc[e] = cosf(ang); rs[e] = sinf(ang); } } }
    SEAM(0);
    if (IN(1)) REP(1) norm_phase(p, p.x, p.ctx, 0, 0, MTOT);
    SEAM(1);
    if (IN(2)) REP(2) { pg8::Gemm g{H, (const bf16_t*)(ws + WS_W_EVIN), MTOT, EV_NP, DM}; pg8::StaticOrder S; S.init(MTOT, EV_NP, G, c);
        pg8::EpiBf16 E{PROJ, EV_NP}; pg8::gemm_phase(ldsl, g, S, E); }
    SEAM(2);
    if (IN(3)) prep0_phase(p);
    SEAM(3);
    if (IN(4)) REP(4) gdn_pre_phase(p, lds);
    SEAM(4);
    if (IN(5)) {
#ifndef SKIP_SCAN
        REP(20) { gdn_scan_phase(p, lds); __syncthreads(); }
#endif
#ifndef SKIP_DA
        REP(5) { diffattn_phase(p, lds); __syncthreads(); }
#endif
    }
    SEAM(5);
    if (IN(6)) REP(6) gdn_post_phase(p);
    SEAM(6);
    if (IN(7)) REP(7) { pg8::Gemm g{MIX, (const bf16_t*)(ws + WS_W_EVOUT), MTOT, DM, DM}; pg8::StaticOrder S; S.init(MTOT, DM, G, c);
        pg8::EpiResid E{p.x, p.ctx, p.out, CTXRES, MOD, 2048}; pg8::gemm_phase(ldsl, g, S, E); }
    SEAM(7);
    if (IN(8)) norm_phase(p, p.out, CTXRES, 0, 1, MTOT);
    SEAM(8);
    if (IN(9)) REP(9) { pg8::Gemm g{H, (const bf16_t*)(ws + WS_W_FFIN), MTOT, 2 * FF, DM}; pg8::StaticOrder S; S.init(MTOT, 2 * FF, G, c);
        pg8::EpiSwiglu E{PROJ, FF}; pg8::gemm_phase(ldsl, g, S, E); }
    SEAM(9);
    if (IN(10)) { pg8::Gemm g{PROJ, (const bf16_t*)(ws + WS_W_FFOUT), MTOT, DM, FF}; pg8::StaticOrder S; S.init(MTOT, DM, G, c);
        pg8::EpiResid E{p.out, CTXRES, p.out, CTXRES, MOD, 5120}; pg8::gemm_phase(ldsl, g, S, E); }
    SEAM(10);
    if (IN(11)) norm_phase(p, p.out, CTXRES, 1, 0, MTOT);
    SEAM(11);
    if (IN(12)) { pg8::Gemm g{H, (const bf16_t*)(ws + WS_W_ODIN), MTOT, OD_N, DM}; pg8::StaticOrder S; S.init(MTOT, OD_N, G, c);
        pg8::EpiBf16 E{PROJ, OD_N}; pg8::gemm_phase(ldsl, g, S, E); }
    SEAM(12);
    if (IN(13)) { natten_phase(p, lds); if ((PROBE_REP >> 13) & 1) { __syncthreads(); natten_phase(p, lds); } }
    SEAM(13);
    if (IN(14)) { pg8::Gemm g{MIX, (const bf16_t*)(ws + WS_W_ODOUT), NLAT, DM, DM}; pg8::StaticOrder S; S.init(NLAT, DM, G, c);
        pg8::EpiResid E{p.out, CTXRES, p.out, CTXRES, MOD + 9 * 6144, 2048}; pg8::gemm_phase(ldsl, g, S, E); }
    SEAM(14);
    if (IN(15)) norm_phase(p, p.out, CTXRES, 1, 1, NLAT);
    SEAM(15);
    if (IN(16)) { pg8::Gemm g{H, (const bf16_t*)(ws + WS_W_FFIN) + (size_t)2 * FF * DM, NLAT, 2 * FF, DM}; pg8::StaticOrder S; S.init(NLAT, 2 * FF, G, c);
        pg8::EpiSwiglu E{PROJ, FF}; pg8::gemm_phase(ldsl, g, S, E); }
    SEAM(16);
    if (IN(17)) { pg8::Gemm g{PROJ, (const bf16_t*)(ws + WS_W_FFOUT) + (size_t)DM * FF, NLAT, DM, FF}; pg8::StaticOrder S; S.init(NLAT, DM, G, c);
        pg8::EpiResid E{p.out, CTXRES, p.out, CTXRES, MOD + 9 * 6144, 5120}; pg8::gemm_phase(ldsl, g, S, E); }
#undef IN
#undef SEAM
}

extern "C" void kernel_launch(void* const* d_in, const int* in_sizes, int n_in, void* d_out, int out_size, void* d_ws, size_t ws_size, hipStream_t stream) {
    static int grid = 0;
    if (grid == 0) {
        if (n_in != 23 || ws_size < WS_END) { fprintf(stderr, "kernel_launch: n_in %d ws %zu (need %zu)\n", n_in, ws_size, (size_t)WS_END); grid = -1; return; }
        int dev = 0, cus = 0, per_cu = 0;
        hipGetDevice(&dev); hipDeviceGetAttribute(&cus, hipDeviceAttributeMultiprocessorCount, dev);
        if (hipFuncSetAttribute((const void*)fwd_megakernel, hipFuncAttributeMaxDynamicSharedMemorySize, LDS_BYTES) != hipSuccess) { fprintf(stderr, "hipFuncSetAttribute failed\n"); grid = -1; return; }
        if (hipOccupancyMaxActiveBlocksPerMultiprocessor(&per_cu, (const void*)fwd_megakernel, NTHREADS, LDS_BYTES) != hipSuccess || per_cu < 1) per_cu = 1;
        (void)hipGetLastError();
        grid = cus * 1;
    }
    if (grid < 0) return;
    if (hipMemsetAsync((char*)d_ws + WS_BAR, 0, 16384, stream) != hipSuccess) { fprintf(stderr, "memset failed\n"); return; }
    Params p{};
    const float** pp = (const float**)&p;
    for (int i = 0; i < 23; ++i) pp[i] = (const float*)d_in[i];
    p.out = (float*)d_out; p.ws = (unsigned char*)d_ws;
#if N_LAUNCH_MODE == 1
    p.ph_lo = 0; p.ph_hi = NPH;
    void* args[] = {&p};
    hipError_t e = hipLaunchCooperativeKernel((void*)fwd_megakernel, dim3(grid), dim3(NTHREADS), args, LDS_BYTES, stream);
    if (e != hipSuccess) fprintf(stderr, "cooperative launch failed: %s (grid %d)\n", hipGetErrorString(e), grid);
#else
    for (int k = 0; k < NPH; ++k) { p.ph_lo = k; p.ph_hi = k + 1;
        hipLaunchKernelGGL(fwd_megakernel, dim3(grid), dim3(NTHREADS), LDS_BYTES, stream, p); }
#endif
}
```

```cpp
#include <hip/hip_runtime.h>
#include <hip/hip_cooperative_groups.h>
#include <cstdio>
#include <cstdint>
namespace cg = cooperative_groups;

#define LAS __attribute__((address_space(3)))
typedef unsigned short bf16_t;
typedef short bf16x8 __attribute__((ext_vector_type(8)));
typedef short s16x4 __attribute__((ext_vector_type(4)));
typedef float f32x4 __attribute__((ext_vector_type(4)));
typedef float f32x16 __attribute__((ext_vector_type(16)));
typedef unsigned u32x4 __attribute__((ext_vector_type(4)));
typedef unsigned u32x2 __attribute__((ext_vector_type(2)));

#ifndef N_LAUNCH_MODE
#define N_LAUNCH_MODE 1
#endif

constexpr int DM = 1024, NLAT = 65536, NCTX = 2048, MTOT = NLAT + NCTX, SEQ = 8192, CTXL = 256, FF = 2816;
constexpr int EV_N = 3600, EV_NP = 3840, OD_N = 3072;
constexpr int NCHUNKP = 64 * 132;
constexpr int NTHREADS = 512;
constexpr int LDS_BYTES = 135168 + 16;

constexpr size_t al256(size_t x) { return (x + 255) / 256 * 256; }
constexpr size_t WS_W_EVIN = 0;
constexpr size_t WS_W_EVOUT = WS_W_EVIN + al256((size_t)EV_NP * DM * 2);
constexpr size_t WS_W_ODIN = WS_W_EVOUT + al256((size_t)DM * DM * 2);
constexpr size_t WS_W_ODOUT = WS_W_ODIN + al256((size_t)OD_N * DM * 2);
constexpr size_t WS_W_FFIN = WS_W_ODOUT + al256((size_t)DM * DM * 2);
constexpr size_t WS_W_FFOUT = WS_W_FFIN + al256((size_t)2 * 2 * FF * DM * 2);
constexpr size_t WS_MOD = WS_W_FFOUT + al256((size_t)2 * DM * FF * 2);
constexpr size_t WS_H = WS_MOD + al256((size_t)2 * 9 * 6144 * 4);
constexpr size_t WS_PROJ = WS_H + al256((size_t)MTOT * DM * 2);
constexpr size_t WS_MIX = WS_PROJ + al256((size_t)MTOT * EV_NP * 2);
constexpr size_t WS_T = WS_MIX + al256((size_t)MTOT * DM * 2);
constexpr size_t WS_AQK = WS_T + al256((size_t)NCHUNKP * 4096 * 2);
constexpr size_t WS_GV = WS_AQK + al256((size_t)NCHUNKP * 4096 * 2);
constexpr size_t WS_BV = WS_GV + al256((size_t)NCHUNKP * 64 * 4);
constexpr size_t WS_EL = WS_BV + al256((size_t)NCHUNKP * 64 * 4);
constexpr size_t WS_GATES = WS_EL + al256((size_t)NCHUNKP * 64 * 4);
constexpr size_t WS_CTXRES = WS_GATES + al256((size_t)MTOT * 16 * 4);
constexpr size_t WS_BAR = WS_CTXRES + al256((size_t)NCTX * DM * 4);
constexpr size_t WS_ROPE = WS_BAR + 16384;
constexpr size_t WS_END = WS_ROPE + (size_t)2 * SEQ * 32 * 4;

struct Params {
    const float *x, *c, *ctx, *c_ctx, *ada_w, *ada_b, *norm_mix, *norm_ffn, *ffn_w_in, *ffn_w_out, *even_w_in, *even_w_out,
        *diff_qk_gain, *diff_lambda, *diff_subln, *gdn_conv, *gdn_a_log, *gdn_dt_bias, *gdn_norm, *odd_w_in, *odd_w_out, *na_qk_gain, *na_rpb;
    float* out; unsigned char* ws; int ph_lo, ph_hi;
};

__device__ __forceinline__ float bf2f(bf16_t b) { return __uint_as_float(((unsigned)b) << 16); }
__device__ __forceinline__ bf16_t f2bf(float f) { unsigned u = __float_as_uint(f); u += 0x7FFFu + ((u >> 16) & 1u); return (bf16_t)(u >> 16); }
__device__ __forceinline__ unsigned cvtpk(float lo, float hi) { unsigned r; asm volatile("v_cvt_pk_bf16_f32 %0, %1, %2" : "=v"(r) : "v"(lo), "v"(hi)); return r; }
__device__ __forceinline__ float siluf(float v) { return v / (1.f + __expf(-v)); }
__device__ __forceinline__ void unpack8(bf16x8 v, float* f) {
#pragma unroll
    for (int i = 0; i < 8; ++i) f[i] = bf2f((bf16_t)v[i]);
}
__device__ __forceinline__ bf16x8 pack8(const float* f) {
    u32x4 w = {cvtpk(f[0], f[1]), cvtpk(f[2], f[3]), cvtpk(f[4], f[5]), cvtpk(f[6], f[7])};
    return *reinterpret_cast<bf16x8*>(&w);
}

namespace pg8 {
constexpr int BM = 256, BK = 64, HALF = 128, HTB = HALF * BK * 2, STAGE_BYTES = 8 * HTB, NXCD = 8, WGM = 8;
__host__ __device__ __forceinline__ int lds_byte(int r, int c) { const int st = (r >> 4) * 2 + (c >> 5), rr = r & 15, cc = c & 31, ob = rr * 64 + cc * 2; return st * 1024 + (ob ^ (((ob >> 9) & 1) << 5)); }
__host__ __device__ __forceinline__ void stage_rc(int b, int& R, int& C) { const int st = b / 1024, sb = b % 1024, swz = sb ^ (((sb >> 9) & 1) << 5); R = (st >> 1) * 16 + swz / 64; C = (st & 1) * 32 + (swz % 64) / 2; }
__host__ __device__ __forceinline__ int perm32(int rho) { const int n = rho >> 4, i = rho & 15; return 8 * (i >> 2) + 4 * n + (i & 3); }
struct Unit { int pm, pn; };
struct Gemm { const bf16_t* A; const bf16_t* Bt; int M, N, K; };
struct StaticOrder {
    int nM, nN, nwg, G, c;
    __device__ void init(int M, int N, int G_, int c_) { nM = M / BM; nN = N / BM; nwg = nM * nN; G = G_; c = c_; }
    __device__ bool next(int i, Unit& u) const {
        const long L = (long)i * G + c; if (L >= nwg) return false;
        int wgid = (int)L; { const int q = nwg / NXCD, r = nwg % NXCD, xcd = wgid % NXCD, off = wgid / NXCD; wgid = (xcd < r ? xcd * (q + 1) : r * (q + 1) + (xcd - r) * q) + off; }
        const int nig = WGM * nN, gid = wgid / nig, fm = gid * WGM, gsz = (nM - fm) < WGM ? (nM - fm) : WGM;
        u.pm = fm + ((wgid % nig) % gsz); u.pn = (wgid % nig) / gsz; return true;
    }
};
struct EpiBf16 {
    static constexpr bool PERM = true;
    bf16_t* O; int ldc;
    __device__ __forceinline__ void operator()(const f32x4 (&acc)[2][2][4][2], const Unit& u, int wr, int wc, int fr, int fq) const {
        const int row0 = u.pm * BM + wr * 64 + fr; const int col0 = u.pn * BM + wc * 32 + 8 * fq;
#pragma unroll
        for (int ai = 0; ai < 2; ++ai)
#pragma unroll
            for (int m = 0; m < 4; ++m) { bf16_t* rowp = O + (size_t)(row0 + ai * HALF + m * 16) * ldc + col0;
#pragma unroll
                for (int bj = 0; bj < 2; ++bj) { const f32x4 v0 = acc[ai][bj][m][0], v1 = acc[ai][bj][m][1];
                    u32x4 w; w.x = cvtpk(v0[0], v0[1]); w.y = cvtpk(v0[2], v0[3]); w.z = cvtpk(v1[0], v1[1]); w.w = cvtpk(v1[2], v1[3]);
                    *(u32x4*)(rowp + bj * HALF) = w; } }
    }
};
struct EpiSwiglu {
    static constexpr bool PERM = true;
    bf16_t* O; int ldc;
    __device__ __forceinline__ void operator()(const f32x4 (&acc)[2][2][4][2], const Unit& u, int wr, int wc, int fr, int fq) const {
        const int row0 = u.pm * BM + wr * 64 + fr; const int col0 = u.pn * HALF + wc * 32 + 8 * fq;
#pragma unroll
        for (int ai = 0; ai < 2; ++ai)
#pragma unroll
            for (int m = 0; m < 4; ++m) { bf16_t* rowp = O + (size_t)(row0 + ai * HALF + m * 16) * ldc + col0;
                float o[8];
#pragma unroll
                for (int n = 0; n < 2; ++n)
#pragma unroll
                    for (int j = 0; j < 4; ++j) { const float g = acc[ai][0][m][n][j], up = acc[ai][1][m][n][j]; o[n * 4 + j] = g / (1.f + __expf(-g)) * up; }
                u32x4 w; w.x = cvtpk(o[0], o[1]); w.y = cvtpk(o[2], o[3]); w.z = cvtpk(o[4], o[5]); w.w = cvtpk(o[6], o[7]);
                *(u32x4*)rowp = w; }
    }
};
struct EpiResid {
    static constexpr bool PERM = false;
    const float* resLat; const float* resCtx; float* outLat; float* outCtx; const float* modl; int goff;
    __device__ __forceinline__ void operator()(const f32x4 (&acc)[2][2][4][2], const Unit& u, int wr, int wc, int fr, int fq) const {
        const int rowt = u.pm * BM; const bool lat = rowt < NLAT;
        const float* res = lat ? resLat + (size_t)rowt * DM : resCtx + (size_t)(rowt - NLAT) * DM;
        float* out = lat ? outLat + (size_t)rowt * DM : outCtx + (size_t)(rowt - NLAT) * DM;
        const float* gate = modl + (size_t)(lat ? (rowt >> 13) : 8) * 6144 + goff;
        const int row0 = wr * 64 + fr, col0 = u.pn * BM + wc * 32 + 4 * fq;
        f32x4 gv[2][2];
#pragma unroll
        for (int bj = 0; bj < 2; ++bj)
#pragma unroll
            for (int n = 0; n < 2; ++n) gv[bj][n] = *(const f32x4*)(gate + col0 + bj * HALF + n * 16);
#pragma unroll
        for (int ai = 0; ai < 2; ++ai)
#pragma unroll
            for (int m = 0; m < 4; ++m) { const size_t off = (size_t)(row0 + ai * HALF + m * 16) * DM + col0;
#pragma unroll
                for (int bj = 0; bj < 2; ++bj)
#pragma unroll
                    for (int n = 0; n < 2; ++n) { const f32x4 r = *(const f32x4*)(res + off + bj * HALF + n * 16);
                        *(f32x4*)(out + off + bj * HALF + n * 16) = r + gv[bj][n] * acc[ai][bj][m][n]; } }
    }
};

template <class Epi, class Sched>
__device__ __forceinline__ void gemm_phase(LAS unsigned char* lds, const Gemm g, const Sched& S, const Epi& E) {
    const int tid = threadIdx.x, wid = __builtin_amdgcn_readfirstlane(tid >> 6), lane = tid & 63, wr = wid >> 2, wc = wid & 3, fr = lane & 15, fq = lane >> 4;
    const int K = g.K, nt = K / BK;
    unsigned voffA[2], voffB[2];
#pragma unroll
    for (int i = 0; i < 2; ++i) { int R, C; stage_rc(tid * 16 + i * 8192, R, C); const int Rb = Epi::PERM ? ((R & ~31) + perm32(R & 31)) : R;
        voffA[i] = (unsigned)(R * K + C) * 2u; voffB[i] = (unsigned)(Rb * K + C) * 2u; }
    const size_t kstep = (size_t)(BK * 2);
    const size_t hstep = (size_t)HALF * K * 2;
    const size_t tstep = 2 * hstep;
    const unsigned ldsw = (unsigned)wid * 1024u;
    const int aoff = lds_byte(wr * 64 + fr, fq * 8), boff = lds_byte(wc * 32 + fr, fq * 8);
#define PG8_SA(b, h) (((b) * 2 + (h)) * HTB)
#define PG8_SB(b, h) ((4 + (b) * 2 + (h)) * HTB)
#define PG8_STAGE(bufoff, gbase, voff) do { _Pragma("unroll") for (int _i = 0; _i < 2; ++_i) \
        __builtin_amdgcn_global_load_lds((const unsigned*)((const char*)(gbase) + (voff)[_i]), (LAS unsigned*)(lds + (bufoff) + ldsw + _i * 8192), 16, 0, 0); } while (0)
#define PG8_LDA(dst, b, h) do { _Pragma("unroll") for (int m = 0; m < 4; ++m) _Pragma("unroll") for (int k = 0; k < 2; ++k) dst[m][k] = *(const LAS bf16x8*)(lds + PG8_SA(b, h) + aoff + m * 2048 + k * 1024); } while (0)
#define PG8_LDB(dst, b, h) do { _Pragma("unroll") for (int n = 0; n < 2; ++n) _Pragma("unroll") for (int k = 0; k < 2; ++k) dst[n][k] = *(const LAS bf16x8*)(lds + PG8_SB(b, h) + boff + n * 2048 + k * 1024); } while (0)
#define PG8_MMA(ai, bj, At, Bt) do { __builtin_amdgcn_s_setprio(1); _Pragma("unroll") for (int m = 0; m < 4; ++m) _Pragma("unroll") for (int n = 0; n < 2; ++n) _Pragma("unroll") for (int k = 0; k < 2; ++k) \
        acc[ai][bj][m][n] = __builtin_amdgcn_mfma_f32_16x16x32_bf16(Bt[n][k], At[m][k], acc[ai][bj][m][n], 0, 0, 0); __builtin_amdgcn_s_setprio(0); } while (0)
#define PG8_WAIT_V(n) asm volatile("s_waitcnt vmcnt(" #n ")" ::: "memory")
#define PG8_WAIT_L(n) asm volatile("s_waitcnt lgkmcnt(" #n ")" ::: "memory")
#define PG8_BAR __builtin_amdgcn_s_barrier()
#define PG8_SCHED __builtin_amdgcn_sched_barrier(0)
    Unit cur, nxt; int ui = 0;
    if (!S.next(0, cur)) return;
    f32x4 acc[2][2][4][2];
#pragma unroll
    for (int a = 0; a < 2; ++a)
#pragma unroll
        for (int b = 0; b < 2; ++b)
#pragma unroll
            for (int m = 0; m < 4; ++m)
#pragma unroll
                for (int n = 0; n < 2; ++n) acc[a][b][m][n] = (f32x4){0.f, 0.f, 0.f, 0.f};
    bf16x8 At[4][2], B0[2][2], B1[2][2];
    const char* cA = (const char*)g.A + (size_t)cur.pm * tstep; const char* cB = (const char*)g.Bt + (size_t)cur.pn * tstep;
    PG8_STAGE(PG8_SB(0, 0), cB, voffB); PG8_STAGE(PG8_SA(0, 0), cA, voffA); PG8_STAGE(PG8_SB(0, 1), cB + hstep, voffB); PG8_STAGE(PG8_SA(0, 1), cA + hstep, voffA);
    if (wr == 1) PG8_BAR;
    PG8_WAIT_V(4); PG8_BAR;
    PG8_STAGE(PG8_SB(1, 0), cB + kstep, voffB); PG8_STAGE(PG8_SA(1, 0), cA + kstep, voffA); PG8_STAGE(PG8_SB(1, 1), cB + hstep + kstep, voffB);
    PG8_WAIT_V(6); PG8_BAR;
    for (;;) {
        const bool has_next = S.next(ui + 1, nxt);
        const char* nA = has_next ? (const char*)g.A + (size_t)nxt.pm * tstep : cA; const char* nB = has_next ? (const char*)g.Bt + (size_t)nxt.pn * tstep : cB;
        for (int t = 0; t < nt; t += 2) {
            const bool last = (t == nt - 2);
            const char* a1 = cA + (size_t)(t + 1) * kstep;
            const char* a2 = last ? nA : cA + (size_t)(t + 2) * kstep; const char* b2 = last ? nB : cB + (size_t)(t + 2) * kstep;
            const char* a3 = a2 + kstep; const char* b3 = b2 + kstep;
            PG8_LDB(B0, 0, 0); PG8_SCHED; PG8_LDA(At, 0, 0); PG8_STAGE(PG8_SA(1, 1), a1 + hstep, voffA);
            PG8_WAIT_L(8); PG8_BAR; PG8_WAIT_L(0); PG8_MMA(0, 0, At, B0); PG8_BAR; PG8_SCHED;
            PG8_LDB(B1, 0, 1); PG8_STAGE(PG8_SB(0, 0), b2, voffB);
            PG8_BAR; PG8_WAIT_L(0); PG8_MMA(0, 1, At, B1); PG8_BAR;
            PG8_LDA(At, 0, 1); PG8_STAGE(PG8_SA(0, 0), a2, voffA);
            PG8_BAR; PG8_WAIT_L(0); PG8_MMA(1, 0, At, B0); PG8_BAR; PG8_SCHED;
            PG8_STAGE(PG8_SB(0, 1), b2 + hstep, voffB);
            PG8_WAIT_V(6); PG8_BAR; PG8_MMA(1, 1, At, B1); PG8_BAR;
            PG8_LDB(B0, 1, 0); PG8_SCHED; PG8_LDA(At, 1, 0); PG8_STAGE(PG8_SA(0, 1), a2 + hstep, voffA);
            PG8_WAIT_L(8); PG8_BAR; PG8_WAIT_L(0); PG8_MMA(0, 0, At, B0); PG8_BAR; PG8_SCHED;
            PG8_LDB(B1, 1, 1); PG8_STAGE(PG8_SB(1, 0), b3, voffB);
            PG8_BAR; PG8_WAIT_L(0); PG8_MMA(0, 1, At, B1); PG8_BAR;
            PG8_LDA(At, 1, 1); PG8_STAGE(PG8_SA(1, 0), a3, voffA);
            PG8_BAR; PG8_WAIT_L(0); PG8_MMA(1, 0, At, B0); PG8_BAR; PG8_SCHED;
            PG8_STAGE(PG8_SB(1, 1), b3 + hstep, voffB);
            PG8_WAIT_V(6); PG8_BAR; PG8_MMA(1, 1, At, B1); PG8_BAR;
        }
        E(acc, cur, wr, wc, fr, fq);
        if (!has_next) break;
#pragma unroll
        for (int a = 0; a < 2; ++a)
#pragma unroll
            for (int b = 0; b < 2; ++b)
#pragma unroll
                for (int m = 0; m < 4; ++m)
#pragma unroll
                    for (int n = 0; n < 2; ++n) acc[a][b][m][n] = (f32x4){0.f, 0.f, 0.f, 0.f};
        cur = nxt; cA = nA; cB = nB; ++ui;
    }
    PG8_WAIT_V(0);
    if (wr == 0) PG8_BAR;
    PG8_BAR;
#undef PG8_SA
#undef PG8_SB
#undef PG8_STAGE
#undef PG8_LDA
#undef PG8_LDB
#undef PG8_MMA
#undef PG8_WAIT_V
#undef PG8_WAIT_L
#undef PG8_BAR
#undef PG8_SCHED
}
}

#define KSWZ(row, colB) ((row) * 256 + ((colB) ^ (((row) & 7) << 4)))
#define SBAR() __builtin_amdgcn_sched_barrier(0)
__device__ __forceinline__ int crow(int r, int hi) { return (r & 3) + 8 * (r >> 2) + 4 * hi; }
__device__ __forceinline__ int v_st(int k, int c) { const int kk = (k & ~0xC) | ((k & 4) << 1) | ((k & 8) >> 1); return ((kk >> 3) * 4 + (c >> 5)) * 512 + ((kk & 7) * 32 + (c & 31)) * 2; }
__device__ __forceinline__ int v_rd_base(int lane) { return ((lane & 3) << 3) | (((lane >> 2) & 3) << 6) | (((lane >> 4) & 1) << 5) | (((lane >> 5) & 1) << 8); }
constexpr int v_rd_off(int d0, int ks, int half) { return d0 * 512 + ks * 4096 + half * 2048; }
template <int OFF> __device__ __forceinline__ s16x4 tr_read(int vb) {
    s16x4 r; asm volatile("ds_read_b64_tr_b16 %0, %1 offset:%2" : "=&v"(r) : "v"(vb), "i"(OFF) : "memory"); return r;
}
template <int D0> __device__ __forceinline__ void pv_one(f32x16& od, int vb, bf16x8 pa0, bf16x8 pa1, bf16x8 pa2, bf16x8 pa3) {
    const s16x4 l0 = tr_read<v_rd_off(D0, 0, 0)>(vb), h0 = tr_read<v_rd_off(D0, 0, 1)>(vb), l1 = tr_read<v_rd_off(D0, 1, 0)>(vb), h1 = tr_read<v_rd_off(D0, 1, 1)>(vb);
    const s16x4 l2 = tr_read<v_rd_off(D0, 2, 0)>(vb), h2 = tr_read<v_rd_off(D0, 2, 1)>(vb), l3 = tr_read<v_rd_off(D0, 3, 0)>(vb), h3 = tr_read<v_rd_off(D0, 3, 1)>(vb);
    asm volatile("s_waitcnt lgkmcnt(0)" ::: "memory"); SBAR();
#define PK(L, H) (bf16x8){L[0], L[1], L[2], L[3], H[0], H[1], H[2], H[3]}
    od = __builtin_amdgcn_mfma_f32_32x32x16_bf16(pa0, PK(l0, h0), od, 0, 0, 0);
    od = __builtin_amdgcn_mfma_f32_32x32x16_bf16(pa1, PK(l1, h1), od, 0, 0, 0);
    od = __builtin_amdgcn_mfma_f32_32x32x16_bf16(pa2, PK(l2, h2), od, 0, 0, 0);
    od = __builtin_amdgcn_mfma_f32_32x32x16_bf16(pa3, PK(l3, h3), od, 0, 0, 0);
#undef PK
}
__device__ __forceinline__ void pv_d0(f32x16* o, int vb, bf16x8 pa0, bf16x8 pa1, bf16x8 pa2, bf16x8 pa3) {
    pv_one<0>(o[0], vb, pa0, pa1, pa2, pa3); pv_one<1>(o[1], vb, pa0, pa1, pa2, pa3); pv_one<2>(o[2], vb, pa0, pa1, pa2, pa3); pv_one<3>(o[3], vb, pa0, pa1, pa2, pa3);
}
#define PK4(P, BASE, OUT) do { unsigned a0 = cvtpk(P[BASE + 0], P[BASE + 1]), a1 = cvtpk(P[BASE + 2], P[BASE + 3]);   \
    unsigned b0 = cvtpk(P[BASE + 4], P[BASE + 5]), b1 = cvtpk(P[BASE + 6], P[BASE + 7]);                              \
    auto r0 = __builtin_amdgcn_permlane32_swap(a0, b0, false, false); auto r1 = __builtin_amdgcn_permlane32_swap(a1, b1, false, false); \
    u32x4 w = {r0[0], r1[0], r0[1], r1[1]}; OUT = *reinterpret_cast<bf16x8*>(&w); } while (0)
__device__ __forceinline__ float halfswap_add(float v) {
    auto rr = __builtin_amdgcn_permlane32_swap(__float_as_uint(v), __float_as_uint(v), false, false);
    return __uint_as_float(rr[0]) + __uint_as_float(rr[1]);
}

__device__ __forceinline__ void ada_phase(const Params& p, unsigned char* lds) {
    float* sc = (float*)lds;
    float* red = (float*)(lds + 40960);
    float* mod = (float*)(p.ws + WS_MOD);
    const int tid = threadIdx.x;
    for (int j = blockIdx.x; j < 192; j += gridDim.x) {
        const int l = j / 96, n0 = (j % 96) * 64;
        for (int i = tid; i < 9 * 1024; i += NTHREADS) { const int r = i >> 10, k = i & 1023; const float v = r < 8 ? p.c[r * 1024 + k] : p.c_ctx[k]; sc[i] = v / (1.f + expf(-v)); }
        __syncthreads();
        const int col = tid & 63, ks = tid >> 6;
        float acc[9];
#pragma unroll
        for (int r = 0; r < 9; ++r) acc[r] = 0.f;
        const float* wp = p.ada_w + ((size_t)l * 1024 + ks * 128) * 6144 + n0 + col;
#pragma unroll 8
        for (int kk = 0; kk < 128; ++kk) { const float w = wp[(size_t)kk * 6144];
#pragma unroll
            for (int r = 0; r < 9; ++r) acc[r] += sc[r * 1024 + ks * 128 + kk] * w; }
#pragma unroll
        for (int r = 0; r < 9; ++r) red[(ks * 9 + r) * 64 + col] = acc[r];
        __syncthreads();
        for (int i = tid; i < 576; i += NTHREADS) { const int r = i >> 6, cc = i & 63; float s = p.ada_b[l * 6144 + n0 + cc];
            for (int k2 = 0; k2 < 8; ++k2) s += red[(k2 * 9 + r) * 64 + cc];
            mod[(size_t)(l * 9 + r) * 6144 + n0 + cc] = s; }
        __syncthreads();
    }
}
__device__ __forceinline__ void wconv_phase(const Params& p, unsigned char* lds) {
    float* tl = (float*)lds;
    const int tid = threadIdx.x;
    const int T0 = 16 * 60, T1 = T0 + 16 * 16, T2 = T1 + 16 * 48, T3 = T2 + 16 * 16, T4 = T3 + 16 * 88, T5 = T4 + 16 * 88, T6 = T5 + 44 * 16, T7 = T6 + 44 * 16;
    for (int t = blockIdx.x; t < T7; t += gridDim.x) {
        const float* src; bf16_t* dst; int K, N, NP, mode = 0, tt;
        if (t < T0) { src = p.even_w_in; dst = (bf16_t*)(p.ws + WS_W_EVIN); K = 1024; N = EV_N; NP = EV_NP; tt = t; }
        else if (t < T1) { src = p.even_w_out; dst = (bf16_t*)(p.ws + WS_W_EVOUT); K = 1024; N = 1024; NP = 1024; tt = t - T0; }
        else if (t < T2) { src = p.odd_w_in; dst = (bf16_t*)(p.ws + WS_W_ODIN); K = 1024; N = OD_N; NP = OD_N; tt = t - T1; }
        else if (t < T3) { src = p.odd_w_out; dst = (bf16_t*)(p.ws + WS_W_ODOUT); K = 1024; N = 1024; NP = 1024; tt = t - T2; }
        else if (t < T4) { src = p.ffn_w_in; dst = (bf16_t*)(p.ws + WS_W_FFIN); K = 1024; N = 2 * FF; NP = 2 * FF; mode = 1; tt = t - T3; }
        else if (t < T5) { src = p.ffn_w_in + (size_t)1024 * 2 * FF; dst = (bf16_t*)(p.ws + WS_W_FFIN) + (size_t)2 * FF * 1024; K = 1024; N = 2 * FF; NP = 2 * FF; mode = 1; tt = t - T4; }
        else if (t < T6) { src = p.ffn_w_out; dst = (bf16_t*)(p.ws + WS_W_FFOUT); K = FF; N = 1024; NP = 1024; tt = t - T5; }
        else { src = p.ffn_w_out + (size_t)FF * 1024; dst = (bf16_t*)(p.ws + WS_W_FFOUT) + (size_t)1024 * FF; K = FF; N = 1024; NP = 1024; tt = t - T6; }
        const int nnt = NP / 64; const int k0 = (tt / nnt) * 64, n0 = (tt % nnt) * 64;
        int sn0;
        if (mode == 1) { const int tb = n0 >> 8, bj = (n0 >> 7) & 1, i0 = n0 & 127; sn0 = bj * FF + tb * 128 + i0; } else sn0 = n0;
        for (int e = tid; e < 4096; e += NTHREADS) { const int kk = e >> 6, nn = e & 63; const int sn = sn0 + nn;
            tl[kk * 65 + nn] = (sn < N) ? src[(size_t)(k0 + kk) * N + sn] : 0.f; }
        __syncthreads();
        for (int e = tid; e < 2048; e += NTHREADS) { const int nn = e >> 5, k2 = (e & 31) * 2;
            *(unsigned*)(dst + (size_t)(n0 + nn) * K + k0 + k2) = cvtpk(tl[k2 * 65 + nn], tl[(k2 + 1) * 65 + nn]); }
        __syncthreads();
    }
}

__device__ __forceinline__ void norm_phase(const Params& p, const float* xlat, const float* xctx, int l, int which, int nrows) {
    const int lane = threadIdx.x & 63, wid = threadIdx.x >> 6;
    bf16_t* h = (bf16_t*)(p.ws + WS_H);
    const float* mod = (const float*)(p.ws + WS_MOD) + (size_t)l * 9 * 6144;
    const float* gain = (which ? p.norm_ffn : p.norm_mix) + l * 1024;
    const int shoff = which ? 3072 : 0, scoff = which ? 4096 : 1024;
    for (int row = blockIdx.x * 8 + wid; row < nrows; row += gridDim.x * 8) {
        const bool lat = row < NLAT;
        const float* src = lat ? xlat + (size_t)row * DM : xctx + (size_t)(row - NLAT) * DM;
        const float* mr = mod + (size_t)(lat ? (row >> 13) : 8) * 6144;
        f32x4 v[4]; float ss = 0.f;
#pragma unroll
        for (int i = 0; i < 4; ++i) { v[i] = *(const f32x4*)(src + lane * 4 + 256 * i); ss += v[i][0] * v[i][0] + v[i][1] * v[i][1] + v[i][2] * v[i][2] + v[i][3] * v[i][3]; }
#pragma unroll
        for (int o = 1; o < 64; o <<= 1) ss += __shfl_xor(ss, o);
        const float rstd = rsqrtf(ss * (1.f / 1024.f) + 1e-6f);
#pragma unroll
        for (int i = 0; i < 4; ++i) { const int c0 = lane * 4 + 256 * i;
            const f32x4 g = *(const f32x4*)(gain + c0), s1 = *(const f32x4*)(mr + scoff + c0), sh = *(const f32x4*)(mr + shoff + c0);
            float y[4];
#pragma unroll
            for (int j = 0; j < 4; ++j) y[j] = v[i][j] * rstd * g[j] * (1.f + s1[j]) + sh[j];
            u32x2 w; w.x = cvtpk(y[0], y[1]); w.y = cvtpk(y[2], y[3]);
            *(u32x2*)(h + (size_t)row * DM + c0) = w; }
    }
}

__device__ __forceinline__ void prep0_phase(const Params& p) {
    const int lane0 = threadIdx.x & 63, wid = threadIdx.x >> 6;
    bf16_t* proj = (bf16_t*)(p.ws + WS_PROJ);
    bf16_t* qkvp = (bf16_t*)p.out;
    float* gbuf = (float*)(p.ws + WS_GATES);
    const float* ropec = (const float*)(p.ws + WS_ROPE); const float* ropes = ropec + SEQ * 32;
    constexpr int RB = 8;
    for (int blk = blockIdx.x * 8 + wid; blk < MTOT / RB; blk += gridDim.x * 8) {
        int lane = lane0; asm volatile("" : "+v"(lane));
        const int row0 = blk * RB; const bool lat = row0 < NLAT; const int t0 = lat ? (row0 & 8191) : ((row0 - NLAT) & 255); const int len = lat ? SEQ : CTXL;
        const int dsub = (lane & 7) * 8;
        {
            float gq[8], gk[8];
#pragma unroll
            for (int i = 0; i < 8; ++i) { gq[i] = p.diff_qk_gain[dsub + i] * (0.125f * 1.4426950408889634f); gk[i] = p.diff_qk_gain[64 + dsub + i]; }
            for (int i = 0; i < RB; ++i) {
                bf16_t* P = proj + (size_t)(row0 + i) * EV_NP;
                f32x4 c4 = {1.f, 1.f, 1.f, 1.f}, s4 = {0.f, 0.f, 0.f, 0.f};
                if (lat) { c4 = *(const f32x4*)(ropec + (t0 + i) * 32 + (lane & 7) * 4); s4 = *(const f32x4*)(ropes + (t0 + i) * 32 + (lane & 7) * 4); }
#pragma unroll
                for (int which = 0; which < 2; ++which) {
                    float v[8]; unpack8(*(const bf16x8*)(P + which * 512 + lane * 8), v);
                    float ss = 0.f;
#pragma unroll
                    for (int e = 0; e < 8; ++e) ss += v[e] * v[e];
                    ss += __shfl_xor(ss, 1); ss += __shfl_xor(ss, 2); ss += __shfl_xor(ss, 4);
                    const float rstd = rsqrtf(ss * (1.f / 64.f) + 1e-6f);
#pragma unroll
                    for (int e = 0; e < 8; ++e) v[e] = v[e] * rstd * (which ? gk[e] : gq[e]);
#pragma unroll
                    for (int e = 0; e < 4; ++e) { const float x0 = v[2 * e], x1 = v[2 * e + 1]; v[2 * e] = x0 * c4[e] - x1 * s4[e]; v[2 * e + 1] = x0 * s4[e] + x1 * c4[e]; }
                    *(bf16x8*)(P + which * 512 + lane * 8) = pack8(v);
                }
            }
        }
#pragma unroll 1
        for (int g = 0; g < 3; ++g) {
            const int c0 = g * 512 + lane * 8;
            float w[5][8];
#pragma unroll
            for (int j = 0; j < 5; ++j) { const f32x4 w0 = *(const f32x4*)(p.gdn_conv + j * 1536 + c0), w1 = *(const f32x4*)(p.gdn_conv + j * 1536 + c0 + 4);
#pragma unroll
                for (int e = 0; e < 4; ++e) { w[j][e] = w0[e]; w[j][4 + e] = w1[e]; } }
            float xm2[8], xm1[8], x0[8], xp1[8], xp2[8];
            const bf16_t* src = proj + (size_t)row0 * EV_NP + 1536 + c0;
#define LDROW(dst, dt) do { if (t0 + (dt) >= 0 && t0 + (dt) < len) unpack8(*(const bf16x8*)(src + (ptrdiff_t)(dt) * EV_NP), dst); else { _Pragma("unroll") for (int e_ = 0; e_ < 8; ++e_) dst[e_] = 0.f; } } while (0)
            LDROW(xm2, -2); LDROW(xm1, -1); LDROW(x0, 0); LDROW(xp1, 1);
            const float nsc = g == 0 ? 0.08838834764831845f : 1.f;
            for (int i = 0; i < RB; ++i) {
                LDROW(xp2, i + 2);
                float y[8];
#pragma unroll
                for (int e = 0; e < 8; ++e) { y[e] = w[0][e] * xm2[e] + w[1][e] * xm1[e] + w[2][e] * x0[e] + w[3][e] * xp1[e] + w[4][e] * xp2[e]; y[e] = y[e] / (1.f + __expf(-y[e])); }
                if (g < 2) { float ss = 0.f;
#pragma unroll
                    for (int e = 0; e < 8; ++e) ss += y[e] * y[e];
                    ss += __shfl_xor(ss, 1); ss += __shfl_xor(ss, 2); ss += __shfl_xor(ss, 4); ss += __shfl_xor(ss, 8);
                    const float sc_ = rsqrtf(ss + 1e-6f) * nsc;
#pragma unroll
                    for (int e = 0; e < 8; ++e) y[e] *= sc_; }
                *(bf16x8*)(qkvp + (size_t)(row0 + i) * 1536 + c0) = pack8(y);
#pragma unroll
                for (int e = 0; e < 8; ++e) { xm2[e] = xm1[e]; xm1[e] = x0[e]; x0[e] = xp1[e]; xp1[e] = xp2[e]; }
            }
#undef LDROW
        }
#pragma unroll
        for (int k = 0; k < RB / 4; ++k) { const int idx = lane + 64 * k, i = idx >> 4, gi = idx & 15;
            const float gvv = bf2f(proj[(size_t)(row0 + i) * EV_NP + 3584 + gi]); float o;
            if (gi < 8) o = 1.f / (1.f + expf(-gvv));
            else { const float z = gvv + p.gdn_dt_bias[gi - 8]; const float sp = z > 20.f ? z : log1pf(expf(z)); o = -expf(p.gdn_a_log[gi - 8]) * sp; }
            gbuf[(size_t)(row0 + i) * 16 + gi] = o; }
    }
}

__device__ __forceinline__ int gdn_row(int b, int pc, int tau, int dir) {
    const int tt = dir ? 63 - tau : tau;
    return pc < 4 ? NLAT + b * CTXL + pc * 64 + tt : b * SEQ + (pc - 4) * 64 + tt;
}
__device__ __forceinline__ void gdn_pre_phase(const Params& p, unsigned char* lds) {
    const int lane = threadIdx.x & 63, wid = threadIdx.x >> 6;
    float* Lw = (float*)(lds + wid * 16896);
    float* gs = Lw + 4096; float* bs = gs + 64;
    const bf16_t* qkvp = (const bf16_t*)p.out;
    const float* gbuf = (const float*)(p.ws + WS_GATES);
    bf16_t* Tb = (bf16_t*)(p.ws + WS_T); bf16_t* Ab = (bf16_t*)(p.ws + WS_AQK);
    float* gv = (float*)(p.ws + WS_GV); float* bv = (float*)(p.ws + WS_BV);
    const int lane0 = lane;
    for (int cp = blockIdx.x * 8 + wid; cp < NCHUNKP; cp += gridDim.x * 8) {
        int lane = lane0; asm volatile("" : "+v"(lane));
        const int r32 = lane & 31, hi = lane >> 5;
        const int pc = cp % 132, ch = cp / 132, dir = ch & 1, h = (ch >> 1) & 3, b = ch >> 3;
        { const int R = gdn_row(b, pc, lane, dir);
          float g = gbuf[(size_t)R * 16 + 8 + dir * 4 + h]; const float be = gbuf[(size_t)R * 16 + dir * 4 + h];
#pragma unroll
          for (int o = 1; o < 64; o <<= 1) { const float t = __shfl_up(g, o); if (lane >= o) g += t; }
          gs[lane] = g; bs[lane] = be; const float gl_ = __shfl(g, 63); gv[(size_t)cp * 64 + lane] = expf(g); bv[(size_t)cp * 64 + lane] = be; ((float*)(p.ws + WS_EL))[(size_t)cp * 64 + lane] = expf(gl_ - g); }
        bf16x8 kf[2][8];
#pragma unroll
        for (int mi = 0; mi < 2; ++mi) { const size_t R = (size_t)gdn_row(b, pc, 32 * mi + r32, dir);
#pragma unroll
            for (int d0 = 0; d0 < 8; ++d0) kf[mi][d0] = *(const bf16x8*)(qkvp + R * 1536 + 512 + h * 128 + d0 * 16 + hi * 8); }
        bf16_t* Ao = Ab + (size_t)cp * 4096;
#pragma unroll
        for (int mi = 0; mi < 2; ++mi) {
            bf16x8 qf[8];
            { const size_t R = (size_t)gdn_row(b, pc, 32 * mi + r32, dir);
#pragma unroll
              for (int d0 = 0; d0 < 8; ++d0) qf[d0] = *(const bf16x8*)(qkvp + R * 1536 + h * 128 + d0 * 16 + hi * 8); }
#pragma unroll
            for (int ni = 0; ni <= mi; ++ni) {
                f32x16 ckk = {}, cqk = {};
#pragma unroll
                for (int d0 = 0; d0 < 8; ++d0) { ckk = __builtin_amdgcn_mfma_f32_32x32x16_bf16(kf[mi][d0], kf[ni][d0], ckk, 0, 0, 0);
                                                 cqk = __builtin_amdgcn_mfma_f32_32x32x16_bf16(qf[d0], kf[ni][d0], cqk, 0, 0, 0); }
                const int sg = 32 * ni + r32; const float gsg = gs[sg];
#pragma unroll
                for (int r = 0; r < 16; ++r) { const int tau = 32 * mi + crow(r, hi);
                    const float dec = tau >= sg ? expf(gs[tau] - gsg) : 0.f;
                    Lw[tau * 64 + sg] = tau > sg ? bs[tau] * dec * ckk[r] : 0.f;
                    Ao[tau * 64 + sg] = f2bf(cqk[r] * dec); }
                asm volatile("" ::: "memory");
            }
        }
#pragma unroll
        for (int r = 0; r < 16; ++r) Ao[crow(r, hi) * 64 + 32 + r32] = 0;
        float Tc[64];
#pragma unroll
        for (int i = 0; i < 64; ++i) { float a = (i == lane) ? 1.f : 0.f;
#pragma unroll
            for (int j = 0; j < i; ++j) a -= Lw[i * 64 + j] * Tc[j];
            Tc[i] = a; asm volatile("" ::: "memory"); }
        bf16_t* To = Tb + (size_t)cp * 4096;
#pragma unroll
        for (int i = 0; i < 64; ++i) To[i * 64 + lane] = f2bf(Tc[i]);
    }
}

constexpr int G_KV = 0, G_QA = 16384, G_TT = 32768, G_AQ = G_TT + 9216, G_RT = G_AQ + 9216, G_UT = G_RT + 4608, G_UP = G_UT + 4608,
              G_ST = G_UP + 4608, G_VS = G_ST + 8704, G_GS = G_VS + 4096, G_BS = G_GS + 256, G_EL = G_BS + 256, G_END = G_EL + 256;
__device__ __forceinline__ void gdn_scan_phase(const Params& p, unsigned char* lds) {
    const int tid = threadIdx.x, lane0 = tid & 63, wid = tid >> 6;
    const bf16_t* qkvp = (const bf16_t*)p.out;
    const bf16_t* Tb = (const bf16_t*)(p.ws + WS_T); const bf16_t* Ab = (const bf16_t*)(p.ws + WS_AQK);
    const float* gv = (const float*)(p.ws + WS_GV); const float* bv = (const float*)(p.ws + WS_BV);
    bf16_t* obuf = (bf16_t*)(p.ws + WS_H);
    const float* gsl = (const float*)(lds + G_GS); const float* bsl = (const float*)(lds + G_BS); const float* esl = (const float*)(lds + G_EL);
    const int sr = tid >> 4, sc = (tid & 15) * 8;
    const int vblk = (gridDim.x % 8 == 0) ? (int)((blockIdx.x & 7) * (gridDim.x >> 3) + (blockIdx.x >> 3)) : (int)blockIdx.x;
    for (int wi = vblk; wi < 256; wi += gridDim.x) {
        const int chain = wi >> 2, cs = wi & 3, b = chain >> 3, h = (chain >> 1) & 3, dir = chain & 1;
        f32x16 Sacc = {};
        for (int i = tid; i < 8704 / 4; i += NTHREADS) ((unsigned*)(lds + G_ST))[i] = 0u;
        bf16x8 sk0, sk1, sq0, sq1, sT, sA, sV; float sg = 0.f;
#define GLOAD(step) do { const int pc_ = dir == 0 ? (step) : ((step) < 4 ? 3 - (step) : 4 + 127 - ((step) - 4)); \
        const size_t cp_ = (size_t)chain * 132 + pc_; \
        const size_t R0_ = (size_t)gdn_row(b, pc_, sr, dir), R1_ = (size_t)gdn_row(b, pc_, 32 + sr, dir); \
        sk0 = *(const bf16x8*)(qkvp + R0_ * 1536 + 512 + h * 128 + sc); sk1 = *(const bf16x8*)(qkvp + R1_ * 1536 + 512 + h * 128 + sc); \
        sq0 = *(const bf16x8*)(qkvp + R0_ * 1536 + h * 128 + sc); sq1 = *(const bf16x8*)(qkvp + R1_ * 1536 + h * 128 + sc); \
        sT = *(const bf16x8*)(Tb + cp_ * 4096 + tid * 8); sA = *(const bf16x8*)(Ab + cp_ * 4096 + tid * 8); \
        if (tid < 256) { const size_t Rv_ = (size_t)gdn_row(b, pc_, tid >> 2, dir); sV = *(const bf16x8*)(qkvp + Rv_ * 1536 + 1024 + h * 128 + cs * 32 + (tid & 3) * 8); } \
        if (tid < 64) sg = gv[cp_ * 64 + tid]; else if (tid < 128) sg = bv[cp_ * 64 + tid - 64]; else if (tid < 192) sg = ((const float*)(p.ws + WS_EL))[cp_ * 64 + tid - 128]; } while (0)
#define GWRITE() do { *(bf16x8*)(lds + G_KV + v_st(sr, sc)) = sk0; *(bf16x8*)(lds + G_KV + v_st(32 + sr, sc)) = sk1; \
        *(bf16x8*)(lds + G_QA + KSWZ(sr, sc * 2)) = sq0; *(bf16x8*)(lds + G_QA + KSWZ(32 + sr, sc * 2)) = sq1; \
        *(bf16x8*)(lds + G_TT + (tid >> 3) * 144 + (tid & 7) * 16) = sT; *(bf16x8*)(lds + G_AQ + (tid >> 3) * 144 + (tid & 7) * 16) = sA; \
        if (tid < 256) *(bf16x8*)(lds + G_VS + (tid >> 2) * 64 + (tid & 3) * 16) = sV; \
        if (tid < 192) ((float*)(lds + G_GS))[tid] = sg; } while (0)
        GLOAD(0);
        for (int step = 0; step < 132; ++step) {
            GWRITE();
            __syncthreads();
            if (step + 1 < 132) GLOAD(step + 1);
            int lane = lane0; asm volatile("" : "+v"(lane));
            const int r32 = lane & 31, hi = lane >> 5;
            const int vb0 = (int)(uintptr_t)(lds + G_KV) + v_rd_base(lane);
            const int pc = dir == 0 ? step : (step < 4 ? 3 - step : 4 + 127 - (step - 4));
            f32x16 acc = {};
            const int mi = wid & 1;
            if (wid < 4) {
                f32x16 acc2 = {};
                if (wid < 2) {
#pragma unroll
                    for (int d0 = 0; d0 < 8; d0 += 2) {
                        const bf16x8 a0 = *(const bf16x8*)(lds + G_KV + v_st(32 * mi + r32, d0 * 16 + hi * 8)), a1 = *(const bf16x8*)(lds + G_KV + v_st(32 * mi + r32, d0 * 16 + 16 + hi * 8));
                        const bf16x8 b0 = *(const bf16x8*)(lds + G_ST + r32 * 272 + (d0 * 16 + hi * 8) * 2), b1 = *(const bf16x8*)(lds + G_ST + r32 * 272 + (d0 * 16 + 16 + hi * 8) * 2);
                        acc = __builtin_amdgcn_mfma_f32_32x32x16_bf16(a0, b0, acc, 0, 0, 0);
                        acc2 = __builtin_amdgcn_mfma_f32_32x32x16_bf16(a1, b1, acc2, 0, 0, 0); }
                } else {
#pragma unroll
                    for (int d0 = 0; d0 < 8; d0 += 2) {
                        const bf16x8 a0 = *(const bf16x8*)(lds + G_QA + KSWZ(32 * mi + r32, (d0 * 16 + hi * 8) * 2)), a1 = *(const bf16x8*)(lds + G_QA + KSWZ(32 * mi + r32, (d0 * 16 + 16 + hi * 8) * 2));
                        const bf16x8 b0 = *(const bf16x8*)(lds + G_ST + r32 * 272 + (d0 * 16 + hi * 8) * 2), b1 = *(const bf16x8*)(lds + G_ST + r32 * 272 + (d0 * 16 + 16 + hi * 8) * 2);
                        acc = __builtin_amdgcn_mfma_f32_32x32x16_bf16(a0, b0, acc, 0, 0, 0);
                        acc2 = __builtin_amdgcn_mfma_f32_32x32x16_bf16(a1, b1, acc2, 0, 0, 0); }
                }
#pragma unroll
                for (int r = 0; r < 16; ++r) acc[r] += acc2[r];
                if (wid < 2) {
#pragma unroll
                    for (int g4 = 0; g4 < 4; ++g4) { float rv[4];
#pragma unroll
                        for (int j = 0; j < 4; ++j) { const int tau = 32 * mi + 8 * g4 + 4 * hi + j;
                            const float vv = bf2f(*(const bf16_t*)(lds + G_VS + tau * 64 + r32 * 2));
                            rv[j] = bsl[tau] * (vv - gsl[tau] * acc[g4 * 4 + j]); }
                        u32x2 w; w.x = cvtpk(rv[0], rv[1]); w.y = cvtpk(rv[2], rv[3]);
                        *(u32x2*)(lds + G_RT + r32 * 144 + (32 * mi + 8 * g4 + 4 * hi) * 2) = w; }
                } else {
#pragma unroll
                    for (int r = 0; r < 16; ++r) acc[r] *= gsl[32 * mi + crow(r, hi)];
                }
            }
            __syncthreads();
            if (wid < 2) {
                f32x16 u = {}, u2 = {};
#pragma unroll
                for (int s = 0; s < 4; s += 2) {
                    const bf16x8 a0 = *(const bf16x8*)(lds + G_TT + (32 * mi + r32) * 144 + (16 * s + hi * 8) * 2), a1 = *(const bf16x8*)(lds + G_TT + (32 * mi + r32) * 144 + (16 * s + 16 + hi * 8) * 2);
                    const bf16x8 b0 = *(const bf16x8*)(lds + G_RT + r32 * 144 + (16 * s + hi * 8) * 2), b1 = *(const bf16x8*)(lds + G_RT + r32 * 144 + (16 * s + 16 + hi * 8) * 2);
                    u = __builtin_amdgcn_mfma_f32_32x32x16_bf16(a0, b0, u, 0, 0, 0);
                    u2 = __builtin_amdgcn_mfma_f32_32x32x16_bf16(a1, b1, u2, 0, 0, 0); }
#pragma unroll
                for (int r = 0; r < 16; ++r) u[r] += u2[r];
#pragma unroll
                for (int g4 = 0; g4 < 4; ++g4) { float uv[4], up[4];
#pragma unroll
                    for (int j = 0; j < 4; ++j) { const int tau = 32 * mi + 8 * g4 + 4 * hi + j; uv[j] = u[g4 * 4 + j]; up[j] = uv[j] * esl[tau]; }
                    u32x2 w; w.x = cvtpk(uv[0], uv[1]); w.y = cvtpk(uv[2], uv[3]);
                    *(u32x2*)(lds + G_UT + r32 * 144 + (32 * mi + 8 * g4 + 4 * hi) * 2) = w;
                    u32x2 w2; w2.x = cvtpk(up[0], up[1]); w2.y = cvtpk(up[2], up[3]);
                    *(u32x2*)(lds + G_UP + r32 * 144 + (32 * mi + 8 * g4 + 4 * hi) * 2) = w2; }
            }
            __syncthreads();
            if (wid == 2 || wid == 3) {
#pragma unroll
                for (int s = 0; s < 4; ++s) {
                    const bf16x8 a = *(const bf16x8*)(lds + G_AQ + (32 * mi + r32) * 144 + (16 * s + hi * 8) * 2);
                    const bf16x8 bb = *(const bf16x8*)(lds + G_UT + r32 * 144 + (16 * s + hi * 8) * 2);
                    acc = __builtin_amdgcn_mfma_f32_32x32x16_bf16(a, bb, acc, 0, 0, 0); }
#pragma unroll
                for (int r = 0; r < 16; ++r) { const size_t R = (size_t)gdn_row(b, pc, 32 * mi + crow(r, hi), dir);
                    obuf[((size_t)dir * MTOT + R) * 512 + h * 128 + cs * 32 + r32] = f2bf(acc[r]); }
            } else if (wid >= 4) {
                const float gl = gsl[63];
#pragma unroll
                for (int r = 0; r < 16; ++r) Sacc[r] *= gl;
                const bf16x8 pa0 = *(const bf16x8*)(lds + G_UP + r32 * 144 + (0 + hi * 8) * 2), pa1 = *(const bf16x8*)(lds + G_UP + r32 * 144 + (16 + hi * 8) * 2),
                             pa2 = *(const bf16x8*)(lds + G_UP + r32 * 144 + (32 + hi * 8) * 2), pa3 = *(const bf16x8*)(lds + G_UP + r32 * 144 + (48 + hi * 8) * 2);
                const int d0 = wid - 4;
                if (d0 == 0) pv_one<0>(Sacc, vb0, pa0, pa1, pa2, pa3); else if (d0 == 1) pv_one<1>(Sacc, vb0, pa0, pa1, pa2, pa3);
                else if (d0 == 2) pv_one<2>(Sacc, vb0, pa0, pa1, pa2, pa3); else pv_one<3>(Sacc, vb0, pa0, pa1, pa2, pa3);
#pragma unroll
                for (int r = 0; r < 16; ++r) *(bf16_t*)(lds + G_ST + crow(r, hi) * 272 + (32 * d0 + r32) * 2) = f2bf(Sacc[r]);
            }
            __syncthreads();
        }
#undef GLOAD
#undef GWRITE
    }
}

__device__ __forceinline__ void gdn_post_phase(const Params& p) {
    const int lane = threadIdx.x & 63, wid = threadIdx.x >> 6;
    const bf16_t* obuf = (const bf16_t*)(p.ws + WS_H);
    const bf16_t* proj = (const bf16_t*)(p.ws + WS_PROJ);
    bf16_t* mix = (bf16_t*)(p.ws + WS_MIX);
    const int d = (lane & 15) * 8;
    for (int row = blockIdx.x * 8 + wid; row < MTOT; row += gridDim.x * 8) {
        float a[8], bb[8], g[8], y[8];
        unpack8(*(const bf16x8*)(obuf + (size_t)row * 512 + lane * 8), a);
        unpack8(*(const bf16x8*)(obuf + ((size_t)MTOT + row) * 512 + lane * 8), bb);
        unpack8(*(const bf16x8*)(proj + (size_t)row * EV_NP + 3072 + lane * 8), g);
        float ss = 0.f;
#pragma unroll
        for (int i = 0; i < 8; ++i) { a[i] += bb[i]; ss += a[i] * a[i]; }
        ss += __shfl_xor(ss, 1); ss += __shfl_xor(ss, 2); ss += __shfl_xor(ss, 4); ss += __shfl_xor(ss, 8);
        const float rstd = rsqrtf(ss * (1.f / 128.f) + 1e-6f);
#pragma unroll
        for (int i = 0; i < 8; ++i) y[i] = a[i] * rstd * p.gdn_norm[d + i] * (g[i] / (1.f + expf(-g[i])));
        *(bf16x8*)(mix + (size_t)row * DM + 512 + lane * 8) = pack8(y);
    }
}

__device__ __forceinline__ void diffattn_phase(const Params& p, unsigned char* lds) {
    const int tid = threadIdx.x, wid = tid >> 6, lane = tid & 63, r32 = lane & 31, hi = lane >> 5;
    const bf16_t* proj = (const bf16_t*)(p.ws + WS_PROJ);
    bf16_t* mix = (bf16_t*)(p.ws + WS_MIX);
    float s01 = 0.f, s23 = 0.f;
    for (int i = 0; i < 64; ++i) { s01 += p.diff_lambda[i] * p.diff_lambda[64 + i]; s23 += p.diff_lambda[128 + i] * p.diff_lambda[192 + i]; }
    const float lam = expf(s01) - expf(s23) + 0.2f;
    float* X = (float*)lds; float* li = (float*)(lds + 131072) + wid * 64;
    LAS unsigned char* ldsl = (LAS unsigned char*)lds;
    int koff[2], voff[2];
#pragma unroll
    for (int i = 0; i < 2; ++i) {
        const int g = i * 512 + tid;
        { const int row = g >> 4, cg = (g & 15) ^ (row & 7); koff[i] = row * EV_NP + cg * 8; }
        { const int o = g * 16, st = o >> 9, w = o & 511, kk = (st >> 2) * 8 + (w >> 6);
          const int k = (kk & ~0xC) | ((kk & 4) << 1) | ((kk & 8) >> 1), cc = (st & 3) * 32 + ((w & 63) >> 4) * 8; voff[i] = k * EV_NP + cc; }
    }
    const int vbase = (int)(uintptr_t)lds + v_rd_base(lane);
    const int map = wid >> 2, wq = wid & 3;
    unsigned char* Qs = lds + 98304 + wid * 4096 + lane * 16;
    const int vblk = (gridDim.x % 8 == 0) ? (int)((blockIdx.x & 7) * (gridDim.x >> 3) + (blockIdx.x >> 3)) : (int)blockIdx.x;
    for (int it = vblk; it < 2112; it += gridDim.x) {
        int b, h, NT, qrow0;
        if (it < 2048) { b = it >> 8; h = (it >> 6) & 3; const int qb = it & 63; NT = 132; qrow0 = b * SEQ + qb * 128; }
        else { const int j = it - 2048; b = j >> 3; h = (j >> 1) & 3; NT = 4; qrow0 = NLAT + b * CTXL + (j & 1) * 128; }
        bf16x8 qr[4];
        { const bf16_t* qp = proj + (size_t)(qrow0 + 32 * wq + r32) * EV_NP + h * 128 + map * 64 + hi * 8;
#pragma unroll
          for (int d0 = 0; d0 < 4; ++d0) qr[d0] = *(const bf16x8*)(qp + d0 * 16); }
        f32x16 o[4] = {}; float lsum = 0.f;
#define DDMA(j, bo) do { const bf16_t* pp_ = proj + (size_t)((j) < 4 ? NLAT + b * CTXL + 64 * (j) : b * SEQ + 64 * ((j) - 4)) * EV_NP + h * 128; \
        _Pragma("unroll") for (int i_ = 0; i_ < 2; ++i_) { \
            __builtin_amdgcn_global_load_lds((const unsigned*)(pp_ + 1024 + voff[i_]), (LAS unsigned*)(ldsl + (bo) + i_ * 8192 + wid * 1024), 16, 0, 0); \
            __builtin_amdgcn_global_load_lds((const unsigned*)(pp_ + 512 + koff[i_]), (LAS unsigned*)(ldsl + (bo) + 16384 + i_ * 8192 + wid * 1024), 16, 0, 0); } } while (0)
#define DQK(P0, P1, bo) do { P0 = (f32x16){}; P1 = (f32x16){}; const unsigned char* Ks_ = lds + (bo) + 16384; \
        _Pragma("unroll") for (int d0 = 0; d0 < 4; ++d0) { const int cb_ = (map * 64 + d0 * 16 + hi * 8) * 2; \
            const bf16x8 b0_ = *(const bf16x8*)(Ks_ + KSWZ(r32, cb_)), b1_ = *(const bf16x8*)(Ks_ + KSWZ(32 + r32, cb_)); \
            P0 = __builtin_amdgcn_mfma_f32_32x32x16_bf16(b0_, qr[d0], P0, 0, 0, 0); \
            P1 = __builtin_amdgcn_mfma_f32_32x32x16_bf16(b1_, qr[d0], P1, 0, 0, 0); } } while (0)
#define DSM(P0, P1) do { _Pragma("unroll") for (int r = 0; r < 16; ++r) { P0[r] = __builtin_amdgcn_exp2f(P0[r]); P1[r] = __builtin_amdgcn_exp2f(P1[r]); lsum += P0[r] + P1[r]; } \
        PK4(P0, 0, pa0); PK4(P0, 8, pa1); PK4(P1, 0, pa2); PK4(P1, 8, pa3); } while (0)
#define DTAIL_() asm volatile("s_waitcnt vmcnt(0)" ::: "memory"); __syncthreads(); { const int t_ = bprev; bprev = bcur; bcur = bnext; bnext = t_; }
#define DSTEP_A(N0, N1, O0, O1, j) do { if ((j) + 1 < NT) DDMA((j) + 1, bnext); \
        DQK(N0, N1, bcur); DSM(O0, O1); pv_d0(o, vbase + bprev, pa0, pa1, pa2, pa3); DTAIL_() } while (0)
#define DSTEP_B(N0, N1, O0, O1, j) do { if ((j) + 1 < NT) DDMA((j) + 1, bnext); \
        DSM(O0, O1); pv_d0(o, vbase + bprev, pa0, pa1, pa2, pa3); SBAR(); DQK(N0, N1, bcur); DTAIL_() } while (0)
        f32x16 pA0, pA1, pB0, pB1; bf16x8 pa0, pa1, pa2, pa3;
        DDMA(0, 0); DDMA(1, 32768); asm volatile("s_waitcnt vmcnt(0)" ::: "memory"); __syncthreads();
        DQK(pA0, pA1, 0);
        int bprev = 0, bcur = 32768, bnext = 65536;
        if (map == 0) {
            for (int j = 1; j + 1 < NT; j += 2) { DSTEP_A(pB0, pB1, pA0, pA1, j); DSTEP_A(pA0, pA1, pB0, pB1, j + 1); }
            DSTEP_A(pB0, pB1, pA0, pA1, NT - 1);
        } else {
            for (int j = 1; j + 1 < NT; j += 2) { DSTEP_B(pB0, pB1, pA0, pA1, j); DSTEP_B(pA0, pA1, pB0, pB1, j + 1); }
            DSTEP_B(pB0, pB1, pA0, pA1, NT - 1);
        }
        DSM(pB0, pB1); pv_d0(o, vbase + bprev, pa0, pa1, pa2, pa3);
        __syncthreads();
#undef DDMA
#undef DQK
#undef DSM
#undef DSTEP_A
#undef DSTEP_B
#undef DTAIL_
        const float lt = halfswap_add(lsum);
        if (hi == 0) li[r32] = lt;
        asm volatile("s_waitcnt lgkmcnt(0)" ::: "memory");
        float rli[16];
#pragma unroll
        for (int r = 0; r < 16; ++r) rli[r] = 1.f / li[crow(r, hi)];
        if (map == 1) {
#pragma unroll
            for (int d0 = 0; d0 < 4; ++d0)
#pragma unroll
                for (int r = 0; r < 16; ++r) X[(wq * 64 + d0 * 16 + r) * 64 + lane] = o[d0][r] * rli[r] * lam;
        }
        __syncthreads();
        if (map == 0) {
#pragma unroll
            for (int d0 = 0; d0 < 4; ++d0)
#pragma unroll
                for (int r = 0; r < 16; ++r) o[d0][r] = o[d0][r] * rli[r] - X[(wq * 64 + d0 * 16 + r) * 64 + lane];
#pragma unroll
            for (int r = 0; r < 16; ++r) {
                float ss = o[0][r] * o[0][r] + o[1][r] * o[1][r] + o[2][r] * o[2][r] + o[3][r] * o[3][r];
                ss += __shfl_xor(ss, 1); ss += __shfl_xor(ss, 2); ss += __shfl_xor(ss, 4); ss += __shfl_xor(ss, 8); ss += __shfl_xor(ss, 16);
                const float rstd = rsqrtf(ss * (1.f / 128.f) + 1e-6f) * 0.8f;
                bf16_t* mp = mix + (size_t)(qrow0 + 32 * wq + crow(r, hi)) * DM + h * 128 + r32;
#pragma unroll
                for (int d0 = 0; d0 < 4; ++d0) mp[32 * d0] = f2bf(o[d0][r] * rstd * p.diff_subln[32 * d0 + r32]);
            }
        }
        __syncthreads();
    }
}

__device__ __forceinline__ void natten_phase(const Params& p, unsigned char* lds) {
    const int tid = threadIdx.x, wid = tid >> 6, lane = tid & 63, r32 = lane & 31, hi = lane >> 5;
    const bf16_t* proj = (const bf16_t*)(p.ws + WS_PROJ);
    bf16_t* mix = (bf16_t*)(p.ws + WS_MIX);
    constexpr float L2E = 1.4426950408889634f;
    unsigned char* Vl = lds; unsigned char* Kl = lds + 32768;
    float* rpbs = (float*)(lds + 65536);
    float* li = (float*)(lds + 133120) + wid * 64;
    unsigned char* Qs = lds + 67584 + wid * 8192 + lane * 16;
    const int sr = tid >> 4, sc = (tid & 15) * 8, vst0 = v_st(sr, sc), vst1 = v_st(32 + sr, sc);
    const int vb0 = (int)(uintptr_t)Vl + v_rd_base(lane);
    const float* gkp = p.na_qk_gain + 128 + sc;
    const int vblk = (gridDim.x % 8 == 0) ? (int)((blockIdx.x & 7) * (gridDim.x >> 3) + (blockIdx.x >> 3)) : (int)blockIdx.x;
    for (int it = vblk; it < 2048; it += gridDim.x) {
        const int b = it >> 8, h = (it >> 5) & 7, rq = it & 31;
        const int grow = 4 * rq + (wid >> 1), qc = (wid & 1) * 32 + r32;
        const size_t qR = (size_t)b * SEQ + grow * 64 + qc;
        for (int i = tid; i < 465; i += NTHREADS) rpbs[i] = p.na_rpb[h * 465 + i] * L2E;
        { float ss = 0.f;
#pragma unroll
          for (int d0 = 0; d0 < 8; ++d0) { float qv[8]; unpack8(*(const bf16x8*)(proj + qR * OD_N + h * 128 + d0 * 16 + hi * 8), qv);
#pragma unroll
              for (int i = 0; i < 8; ++i) ss += qv[i] * qv[i]; }
          ss = halfswap_add(ss);
          const float rs = rsqrtf(ss * (1.f / 128.f) + 1e-6f) * 0.08838834764831845f * L2E;
#pragma unroll
          for (int d0 = 0; d0 < 8; ++d0) { float qv[8]; unpack8(*(const bf16x8*)(proj + qR * OD_N + h * 128 + d0 * 16 + hi * 8), qv);
#pragma unroll
              for (int i = 0; i < 8; ++i) qv[i] *= rs * p.na_qk_gain[d0 * 16 + hi * 8 + i];
              *(bf16x8*)(Qs + d0 * 1024) = pack8(qv); } }
        int lo = 4 * rq - 4; lo = lo < 0 ? 0 : (lo > 120 ? 120 : lo);
        int hi_r = 4 * rq + 3 - 4; hi_r = hi_r < 0 ? 0 : (hi_r > 120 ? 120 : hi_r); hi_r += 7;
        const int nlat = hi_r - lo + 1, NT = nlat + 4;
        int wsr = grow - 4; wsr = wsr < 0 ? 0 : (wsr > 120 ? 120 : wsr);
        int cst = qc - 8; cst = cst < 0 ? 0 : (cst > 48 ? 48 : cst);
        f32x16 o[4] = {}; float lsum = 0.f;
        bf16x8 vs0, vs1, ks0, ks1;
#define NLOAD(j) do { const size_t R0_ = (size_t)((j) < nlat ? b * SEQ + (lo + (j)) * 64 : NLAT + b * CTXL + 64 * ((j) - nlat)) + sr; \
        const bf16_t* pp_ = proj + R0_ * OD_N + h * 128 + sc; \
        vs0 = *(const bf16x8*)(pp_ + 2048); vs1 = *(const bf16x8*)(pp_ + 2048 + (size_t)32 * OD_N); \
        ks0 = *(const bf16x8*)(pp_ + 1024); ks1 = *(const bf16x8*)(pp_ + 1024 + (size_t)32 * OD_N); } while (0)
#define KNORM(kx) do { float f_[8]; unpack8(kx, f_); float ss_ = 0.f; _Pragma("unroll") for (int i_ = 0; i_ < 8; ++i_) ss_ += f_[i_] * f_[i_]; \
        ss_ += __shfl_xor(ss_, 1); ss_ += __shfl_xor(ss_, 2); ss_ += __shfl_xor(ss_, 4); ss_ += __shfl_xor(ss_, 8); \
        const float rs_ = rsqrtf(ss_ * (1.f / 128.f) + 1e-6f); _Pragma("unroll") for (int i_ = 0; i_ < 8; ++i_) f_[i_] *= rs_ * gkp[i_]; kx = pack8(f_); } while (0)
#define NWRITE(bf) do { KNORM(ks0); KNORM(ks1); *(bf16x8*)(Vl + (bf) * 16384 + vst0) = vs0; *(bf16x8*)(Vl + (bf) * 16384 + vst1) = vs1; \
        *(bf16x8*)(Kl + (bf) * 16384 + KSWZ(sr, sc * 2)) = ks0; *(bf16x8*)(Kl + (bf) * 16384 + KSWZ(32 + sr, sc * 2)) = ks1; } while (0)
        NLOAD(0); NWRITE(0); __syncthreads();
        for (int j = 0; j < NT; ++j) {
            if (j + 1 < NT) NLOAD(j + 1);
            const int bf = j & 1;
            const bool islat = j < nlat; const int kr = lo + j;
            const bool active = !islat || (kr >= wsr && kr <= wsr + 7);
            if (active) {
                f32x16 p0 = {}, p1 = {};
                const unsigned char* Ks = Kl + bf * 16384;
#pragma unroll
                for (int d0 = 0; d0 < 8; ++d0) { const int cb = (d0 * 16 + hi * 8) * 2;
                    const bf16x8 b0 = *(const bf16x8*)(Ks + KSWZ(r32, cb)), b1 = *(const bf16x8*)(Ks + KSWZ(32 + r32, cb));
                    const bf16x8 qd = *(const bf16x8*)(Qs + d0 * 1024);
                    p0 = __builtin_amdgcn_mfma_f32_32x32x16_bf16(b0, qd, p0, 0, 0, 0);
                    p1 = __builtin_amdgcn_mfma_f32_32x32x16_bf16(b1, qd, p1, 0, 0, 0); }
                if (islat) {
                    const float* rb = rpbs + (kr - grow + 7) * 31 + 15 - qc + 4 * hi;
                    const int mofs = 4 * hi - cst;
#pragma unroll
                    for (int r = 0; r < 16; ++r) {
                        const int kb = (r & 3) + 8 * (r >> 2);
                        const float e0 = __builtin_amdgcn_exp2f(p0[r] + rb[kb]), e1 = __builtin_amdgcn_exp2f(p1[r] + rb[32 + kb]);
                        p0[r] = ((unsigned)(kb + mofs) < 16u) ? e0 : 0.f; p1[r] = ((unsigned)(32 + kb + mofs) < 16u) ? e1 : 0.f;
                        lsum += p0[r] + p1[r]; }
                } else {
#pragma unroll
                    for (int r = 0; r < 16; ++r) { p0[r] = __builtin_amdgcn_exp2f(p0[r]); p1[r] = __builtin_amdgcn_exp2f(p1[r]); lsum += p0[r] + p1[r]; }
                }
                bf16x8 pa0, pa1, pa2, pa3;
                PK4(p0, 0, pa0); PK4(p0, 8, pa1); PK4(p1, 0, pa2); PK4(p1, 8, pa3);
                pv_d0(o, vb0 + bf * 16384, pa0, pa1, pa2, pa3);
            }
            if (j + 1 < NT) NWRITE((j + 1) & 1);
            __syncthreads();
        }
#undef NLOAD
#undef KNORM
#undef NWRITE
        const float lt = halfswap_add(lsum);
        if (hi == 0) li[r32] = lt;
        asm volatile("s_waitcnt lgkmcnt(0)" ::: "memory");
#pragma unroll
        for (int r = 0; r < 16; ++r) { const float rl = 1.f / li[crow(r, hi)];
            bf16_t* mp = mix + ((size_t)b * SEQ + grow * 64 + (wid & 1) * 32 + crow(r, hi)) * DM + h * 128 + r32;
#pragma unroll
            for (int d0 = 0; d0 < 4; ++d0) mp[32 * d0] = f2bf(o[d0][r] * rl); }
        __syncthreads();
    }
}

#define XB_TMO      128
#define XB_XCNT(j)  (256  + 64 * (j))
#define XB_XSUB(j)  (1280 + 64 * (j))
#define XB_XGEN(j)  (2304 + 64 * (j))
#define XB_TOP      3328
#define XB_TOPGEN   3392
#define XCD_BAR_WORDS 3456
#define XB_SPIN_CAP (1u << 22)
__device__ __forceinline__ unsigned xb_ld(unsigned* p)              { return __hip_atomic_load(p, __ATOMIC_RELAXED, __HIP_MEMORY_SCOPE_AGENT); }
__device__ __forceinline__ unsigned xb_add(unsigned* p, unsigned v) { return __hip_atomic_fetch_add(p, v, __ATOMIC_RELAXED, __HIP_MEMORY_SCOPE_AGENT); }
__device__ __forceinline__ unsigned xb_xcc_id() { return (unsigned)__builtin_amdgcn_s_getreg((3 << 11) | 20) & 0xFu; }
#define XB_SPIN(cond, bar) do { unsigned _sp = 0; while (cond) { __builtin_amdgcn_s_sleep(1); \
    if ((++_sp & 255u) == 0u) { if (xb_ld(&(bar)[XB_TMO])) break; if (_sp > XB_SPIN_CAP) { atomicAdd(&(bar)[XB_TMO], 1u); break; } } } } while (0)
struct XcdBarrier { unsigned* bar; unsigned x; volatile LAS unsigned* st; };
__device__ __forceinline__ XcdBarrier xcd_barrier_post(unsigned* bar, volatile LAS unsigned* st) {
    XcdBarrier b; b.bar = bar; b.x = xb_xcc_id(); b.st = st;
    if (threadIdx.x == 0) (void)xb_add(&bar[XB_XCNT(b.x)], 1u);
    return b;
}
__device__ __forceinline__ void xcd_barrier_complete(unsigned* bar, unsigned x, unsigned& nloc, unsigned& nx) {
    const unsigned G = gridDim.x * gridDim.y * gridDim.z;
    unsigned sum, cnt, mine, sp = 0u;
    for (;;) {
        sum = 0u; cnt = 0u; mine = 0u;
#pragma unroll
        for (unsigned j = 0; j < 16; ++j) { const unsigned c = xb_ld(&bar[XB_XCNT(j)]); sum += c; cnt += (c > 0u) ? 1u : 0u; mine = (j == x) ? c : mine; }
        if (sum == G) break;
        __builtin_amdgcn_s_sleep(1);
        if ((++sp & 255u) == 0u) { if (xb_ld(&bar[XB_TMO])) break; if (sp > XB_SPIN_CAP) { atomicAdd(&bar[XB_TMO], 1u); break; } }
    }
    nloc = mine > 0u ? mine : 1u; nx = cnt > 0u ? cnt : 1u;
}
__device__ __forceinline__ void xcd_barrier(const XcdBarrier& b) {
    asm volatile("s_waitcnt vmcnt(0)" ::: "memory");
    __syncthreads();
    if (threadIdx.x == 0) {
        unsigned* bar = b.bar;
        __builtin_amdgcn_s_waitcnt(0);
        unsigned nloc = b.st[0], nx = b.st[1];
        if (nloc == 0u) { xcd_barrier_complete(bar, b.x, nloc, nx); b.st[0] = nloc; b.st[1] = nx; }
        const unsigned old = xb_add(&bar[XB_XSUB(b.x)], 1u);
        const unsigned gen = old / nloc;
        if (old + 1u == (gen + 1u) * nloc) {
            __builtin_amdgcn_fence(__ATOMIC_RELEASE, "agent");
            asm volatile("s_waitcnt vmcnt(0)" ::: "memory");
            const unsigned og = xb_add(&bar[XB_TOP], 1u);
            const unsigned tg = og / nx;
            if (og + 1u == (tg + 1u) * nx) xb_add(&bar[XB_TOPGEN], 1u);
            else XB_SPIN(xb_ld(&bar[XB_TOPGEN]) == tg, bar);
            __builtin_amdgcn_fence(__ATOMIC_ACQUIRE, "agent");
            xb_add(&bar[XB_XGEN(b.x)], 1u);
            asm volatile("s_waitcnt vmcnt(0)" ::: "memory");
        } else {
            XB_SPIN(xb_ld(&bar[XB_XGEN(b.x)]) == gen, bar);
            __builtin_amdgcn_fence(__ATOMIC_ACQUIRE, "agent");
            asm volatile("s_waitcnt vmcnt(0)" ::: "memory");
        }
    }
    __syncthreads();
}

#ifndef PROBE_REP
#define PROBE_REP 0
#endif
#define REP(k) for (int rep_ = 0; rep_ < (((PROBE_REP >> (k)) & 1) ? 2 : 1); ++rep_)
constexpr int NPH = 18;
__global__ void __launch_bounds__(NTHREADS, 2) fwd_megakernel(Params p) {
    extern __shared__ __attribute__((aligned(16))) unsigned char lds[];
    cg::grid_group grid = cg::this_grid();
    LAS unsigned char* ldsl = (LAS unsigned char*)lds;
    const int lo = p.ph_lo, hi = p.ph_hi;
#ifdef ONLY_PH
#define IN(k) (((ONLY_PH >> (k)) & 1) && lo <= (k) && (k) < hi)
#else
#define IN(k) (lo <= (k) && (k) < hi)
#endif
#define SEAM(k) do { if (IN(k) && IN((k) + 1)) { if ((k) == 0) grid.sync(); else { XcdBarrier xb_; xb_.bar = (unsigned*)(p.ws + WS_BAR); xb_.x = xb_xcc_id(); xb_.st = (volatile LAS unsigned*)(ldsl + 135168); xcd_barrier(xb_); } } } while (0)
    unsigned char* ws = p.ws;
    const bf16_t* H = (const bf16_t*)(ws + WS_H);
    bf16_t* PROJ = (bf16_t*)(ws + WS_PROJ);
    const bf16_t* MIX = (const bf16_t*)(ws + WS_MIX);
    float* CTXRES = (float*)(ws + WS_CTXRES);
    const float* MOD = (const float*)(ws + WS_MOD);
    const int G = gridDim.x, c = blockIdx.x;
    if (threadIdx.x < 4) ((volatile LAS unsigned*)(ldsl + 135168))[threadIdx.x] = 0u;
    __syncthreads();
    (void)xcd_barrier_post((unsigned*)(ws + WS_BAR), (volatile LAS unsigned*)(ldsl + 135168));

    if (IN(0)) REP(0) { ada_phase(p, lds); wconv_phase(p, lds);
        { float* rc = (float*)(ws + WS_ROPE); float* rs = rc + SEQ * 32;
          for (int e = blockIdx.x * NTHREADS + threadIdx.x; e < SEQ * 32; e += gridDim.x * NTHREADS) { const int t = e >> 5, pp = e & 31;
              const float inv = powf(10000.f, -(float)(pp & 15) / 16.f); const float ang = (pp < 16 ? (float)(t >> 6) : (float)(t & 63)) * inv;
              rc[e] = cosf(ang); rs[e] = sinf(ang); } } }
    SEAM(0);
    if (IN(1)) REP(1) norm_phase(p, p.x, p.ctx, 0, 0, MTOT);
    SEAM(1);
    if (IN(2)) REP(2) { pg8::Gemm g{H, (const bf16_t*)(ws + WS_W_EVIN), MTOT, EV_NP, DM}; pg8::StaticOrder S; S.init(MTOT, EV_NP, G, c);
        pg8::EpiBf16 E{PROJ, EV_NP}; pg8::gemm_phase(ldsl, g, S, E); }
    SEAM(2);
    if (IN(3)) prep0_phase(p);
    SEAM(3);
    if (IN(4)) REP(4) gdn_pre_phase(p, lds);
    SEAM(4);
    if (IN(5)) {
#ifndef SKIP_SCAN
        REP(20) { gdn_scan_phase(p, lds); __syncthreads(); }
#endif
#ifndef SKIP_DA
        REP(5) { diffattn_phase(p, lds); __syncthreads(); }
#endif
    }
    SEAM(5);
    if (IN(6)) REP(6) gdn_post_phase(p);
    SEAM(6);
    if (IN(7)) REP(7) { pg8::Gemm g{MIX, (const bf16_t*)(ws + WS_W_EVOUT), MTOT, DM, DM}; pg8::StaticOrder S; S.init(MTOT, DM, G, c);
        pg8::EpiResid E{p.x, p.ctx, p.out, CTXRES, MOD, 2048}; pg8::gemm_phase(ldsl, g, S, E); }
    SEAM(7);
    if (IN(8)) norm_phase(p, p.out, CTXRES, 0, 1, MTOT);
    SEAM(8);
    if (IN(9)) REP(9) { pg8::Gemm g{H, (const bf16_t*)(ws + WS_W_FFIN), MTOT, 2 * FF, DM}; pg8::StaticOrder S; S.init(MTOT, 2 * FF, G, c);
        pg8::EpiSwiglu E{PROJ, FF}; pg8::gemm_phase(ldsl, g, S, E); }
    SEAM(9);
    if (IN(10)) { pg8::Gemm g{PROJ, (const bf16_t*)(ws + WS_W_FFOUT), MTOT, DM, FF}; pg8::StaticOrder S; S.init(MTOT, DM, G, c);
        pg8::EpiResid E{p.out, CTXRES, p.out, CTXRES, MOD, 5120}; pg8::gemm_phase(ldsl, g, S, E); }
    SEAM(10);
    if (IN(11)) norm_phase(p, p.out, CTXRES, 1, 0, MTOT);
    SEAM(11);
    if (IN(12)) { pg8::Gemm g{H, (const bf16_t*)(ws + WS_W_ODIN), MTOT, OD_N, DM}; pg8::StaticOrder S; S.init(MTOT, OD_N, G, c);
        pg8::EpiBf16 E{PROJ, OD_N}; pg8::gemm_phase(ldsl, g, S, E); }
    SEAM(12);
    if (IN(13)) { natten_phase(p, lds); if ((PROBE_REP >> 13) & 1) { __syncthreads(); natten_phase(p, lds); } }
    SEAM(13);
    if (IN(14)) { pg8::Gemm g{MIX, (const bf16_t*)(ws + WS_W_ODOUT), NLAT, DM, DM}; pg8::StaticOrder S; S.init(NLAT, DM, G, c);
        pg8::EpiResid E{p.out, CTXRES, p.out, CTXRES, MOD + 9 * 6144, 2048}; pg8::gemm_phase(ldsl, g, S, E); }
    SEAM(14);
    if (IN(15)) norm_phase(p, p.out, CTXRES, 1, 1, NLAT);
    SEAM(15);
    if (IN(16)) { pg8::Gemm g{H, (const bf16_t*)(ws + WS_W_FFIN) + (size_t)2 * FF * DM, NLAT, 2 * FF, DM}; pg8::StaticOrder S; S.init(NLAT, 2 * FF, G, c);
        pg8::EpiSwiglu E{PROJ, FF}; pg8::gemm_phase(ldsl, g, S, E); }
    SEAM(16);
    if (IN(17)) { pg8::Gemm g{PROJ, (const bf16_t*)(ws + WS_W_FFOUT) + (size_t)DM * FF, NLAT, DM, FF}; pg8::StaticOrder S; S.init(NLAT, DM, G, c);
        pg8::EpiResid E{p.out, CTXRES, p.out, CTXRES, MOD + 9 * 6144, 5120}; pg8::gemm_phase(ldsl, g, S, E); }
#undef IN
#undef SEAM
}

extern "C" void kernel_launch(void* const* d_in, const int* in_sizes, int n_in, void* d_out, int out_size, void* d_ws, size_t ws_size, hipStream_t stream) {
    static int grid = 0;
    if (grid == 0) {
        if (n_in != 23 || ws_size < WS_END) { fprintf(stderr, "kernel_launch: n_in %d ws %zu (need %zu)\n", n_in, ws_size, (size_t)WS_END); grid = -1; return; }
        int dev = 0, cus = 0, per_cu = 0;
        hipGetDevice(&dev); hipDeviceGetAttribute(&cus, hipDeviceAttributeMultiprocessorCount, dev);
        if (hipFuncSetAttribute((const void*)fwd_megakernel, hipFuncAttributeMaxDynamicSharedMemorySize, LDS_BYTES) != hipSuccess) { fprintf(stderr, "hipFuncSetAttribute failed\n"); grid = -1; return; }
        if (hipOccupancyMaxActiveBlocksPerMultiprocessor(&per_cu, (const void*)fwd_megakernel, NTHREADS, LDS_BYTES) != hipSuccess || per_cu < 1) per_cu = 1;
        (void)hipGetLastError();
        grid = cus * 1;
    }
    if (grid < 0) return;
    if (hipMemsetAsync((char*)d_ws + WS_BAR, 0, 16384, stream) != hipSuccess) { fprintf(stderr, "memset failed\n"); return; }
    Params p{};
    const float** pp = (const float**)&p;
    for (int i = 0; i < 23; ++i) pp[i] = (const float*)d_in[i];
    p.out = (float*)d_out; p.ws = (unsigned char*)d_ws;
#if N_LAUNCH_MODE == 1
    p.ph_lo = 0; p.ph_hi = NPH;
    void* args[] = {&p};
    hipError_t e = hipLaunchCooperativeKernel((void*)fwd_megakernel, dim3(grid), dim3(NTHREADS), args, LDS_BYTES, stream);
    if (e != hipSuccess) fprintf(stderr, "cooperative launch failed: %s (grid %d)\n", hipGetErrorString(e), grid);
#else
    for (int k = 0; k < NPH; ++k) { p.ph_lo = k; p.ph_hi = k + 1;
        hipLaunchKernelGGL(fwd_megakernel, dim3(grid), dim3(NTHREADS), LDS_BYTES, stream, p); }
#endif
}
```

```cpp
#include <hip/hip_runtime.h>
#include <hip/hip_cooperative_groups.h>
#include <cstdio>
#include <cstdint>
namespace cg = cooperative_groups;

#define LAS __attribute__((address_space(3)))
typedef unsigned short bf16_t;
typedef short bf16x8 __attribute__((ext_vector_type(8)));
typedef short s16x4 __attribute__((ext_vector_type(4)));
typedef float f32x4 __attribute__((ext_vector_type(4)));
typedef float f32x16 __attribute__((ext_vector_type(16)));
typedef unsigned u32x4 __attribute__((ext_vector_type(4)));
typedef unsigned u32x2 __attribute__((ext_vector_type(2)));

#ifndef N_LAUNCH_MODE
#define N_LAUNCH_MODE 1
#endif

constexpr int DM = 1024, NLAT = 65536, NCTX = 2048, MTOT = NLAT + NCTX, SEQ = 8192, CTXL = 256, FF = 2816;
constexpr int EV_N = 3600, EV_NP = 3840, OD_N = 3072;
constexpr int NCHUNKP = 64 * 132;
constexpr int NTHREADS = 512;
constexpr int LDS_BYTES = 135168 + 16;

constexpr size_t al256(size_t x) { return (x + 255) / 256 * 256; }
constexpr size_t WS_W_EVIN = 0;
constexpr size_t WS_W_EVOUT = WS_W_EVIN + al256((size_t)EV_NP * DM * 2);
constexpr size_t WS_W_ODIN = WS_W_EVOUT + al256((size_t)DM * DM * 2);
constexpr size_t WS_W_ODOUT = WS_W_ODIN + al256((size_t)OD_N * DM * 2);
constexpr size_t WS_W_FFIN = WS_W_ODOUT + al256((size_t)DM * DM * 2);
constexpr size_t WS_W_FFOUT = WS_W_FFIN + al256((size_t)2 * 2 * FF * DM * 2);
constexpr size_t WS_MOD = WS_W_FFOUT + al256((size_t)2 * DM * FF * 2);
constexpr size_t WS_H = WS_MOD + al256((size_t)2 * 9 * 6144 * 4);
constexpr size_t WS_PROJ = WS_H + al256((size_t)MTOT * DM * 2);
constexpr size_t WS_MIX = WS_PROJ + al256((size_t)MTOT * EV_NP * 2);
constexpr size_t WS_T = WS_MIX + al256((size_t)MTOT * DM * 2);
constexpr size_t WS_AQK = WS_T + al256((size_t)NCHUNKP * 4096 * 2);
constexpr size_t WS_GV = WS_AQK + al256((size_t)NCHUNKP * 4096 * 2);
constexpr size_t WS_BV = WS_GV + al256((size_t)NCHUNKP * 64 * 4);
constexpr size_t WS_EL = WS_BV + al256((size_t)NCHUNKP * 64 * 4);
constexpr size_t WS_GATES = WS_EL + al256((size_t)NCHUNKP * 64 * 4);
constexpr size_t WS_CTXRES = WS_GATES + al256((size_t)MTOT * 16 * 4);
constexpr size_t WS_BAR = WS_CTXRES + al256((size_t)NCTX * DM * 4);
constexpr size_t WS_ROPE = WS_BAR + 16384;
constexpr size_t WS_END = WS_ROPE + (size_t)2 * SEQ * 32 * 4;

struct Params {
    const float *x, *c, *ctx, *c_ctx, *ada_w, *ada_b, *norm_mix, *norm_ffn, *ffn_w_in, *ffn_w_out, *even_w_in, *even_w_out,
        *diff_qk_gain, *diff_lambda, *diff_subln, *gdn_conv, *gdn_a_log, *gdn_dt_bias, *gdn_norm, *odd_w_in, *odd_w_out, *na_qk_gain, *na_rpb;
    float* out; unsigned char* ws; int ph_lo, ph_hi;
};

__device__ __forceinline__ float bf2f(bf16_t b) { return __uint_as_float(((unsigned)b) << 16); }
__device__ __forceinline__ bf16_t f2bf(float f) { unsigned u = __float_as_uint(f); u += 0x7FFFu + ((u >> 16) & 1u); return (bf16_t)(u >> 16); }
__device__ __forceinline__ unsigned cvtpk(float lo, float hi) { unsigned r; asm volatile("v_cvt_pk_bf16_f32 %0, %1, %2" : "=v"(r) : "v"(lo), "v"(hi)); return r; }
__device__ __forceinline__ float siluf(float v) { return v / (1.f + __expf(-v)); }
__device__ __forceinline__ void unpack8(bf16x8 v, float* f) {
#pragma unroll
    for (int i = 0; i < 8; ++i) f[i] = bf2f((bf16_t)v[i]);
}
__device__ __forceinline__ bf16x8 pack8(const float* f) {
    u32x4 w = {cvtpk(f[0], f[1]), cvtpk(f[2], f[3]), cvtpk(f[4], f[5]), cvtpk(f[6], f[7])};
    return *reinterpret_cast<bf16x8*>(&w);
}

namespace pg8 {
constexpr int BM = 256, BK = 64, HALF = 128, HTB = HALF * BK * 2, STAGE_BYTES = 8 * HTB, NXCD = 8, WGM = 8;
__host__ __device__ __forceinline__ int lds_byte(int r, int c) { const int st = (r >> 4) * 2 + (c >> 5), rr = r & 15, cc = c & 31, ob = rr * 64 + cc * 2; return st * 1024 + (ob ^ (((ob >> 9) & 1) << 5)); }
__host__ __device__ __forceinline__ void stage_rc(int b, int& R, int& C) { const int st = b / 1024, sb = b % 1024, swz = sb ^ (((sb >> 9) & 1) << 5); R = (st >> 1) * 16 + swz / 64; C = (st & 1) * 32 + (swz % 64) / 2; }
__host__ __device__ __forceinline__ int perm32(int rho) { const int n = rho >> 4, i = rho & 15; return 8 * (i >> 2) + 4 * n + (i & 3); }
struct Unit { int pm, pn; };
struct Gemm { const bf16_t* A; const bf16_t* Bt; int M, N, K; };
struct StaticOrder {
    int nM, nN, nwg, G, c;
    __device__ void init(int M, int N, int G_, int c_) { nM = M / BM; nN = N / BM; nwg = nM * nN; G = G_; c = c_; }
    __device__ bool next(int i, Unit& u) const {
        const long L = (long)i * G + c; if (L >= nwg) return false;
        int wgid = (int)L; { const int q = nwg / NXCD, r = nwg % NXCD, xcd = wgid % NXCD, off = wgid / NXCD; wgid = (xcd < r ? xcd * (q + 1) : r * (q + 1) + (xcd - r) * q) + off; }
        const int nig = WGM * nN, gid = wgid / nig, fm = gid * WGM, gsz = (nM - fm) < WGM ? (nM - fm) : WGM;
        u.pm = fm + ((wgid % nig) % gsz); u.pn = (wgid % nig) / gsz; return true;
    }
};
struct EpiBf16 {
    static constexpr bool PERM = true;
    bf16_t* O; int ldc;
    __device__ __forceinline__ void operator()(const f32x4 (&acc)[2][2][4][2], const Unit& u, int wr, int wc, int fr, int fq) const {
        const int row0 = u.pm * BM + wr * 64 + fr; const int col0 = u.pn * BM + wc * 32 + 8 * fq;
#pragma unroll
        for (int ai = 0; ai < 2; ++ai)
#pragma unroll
            for (int m = 0; m < 4; ++m) { bf16_t* rowp = O + (size_t)(row0 + ai * HALF + m * 16) * ldc + col0;
#pragma unroll
                for (int bj = 0; bj < 2; ++bj) { const f32x4 v0 = acc[ai][bj][m][0], v1 = acc[ai][bj][m][1];
                    u32x4 w; w.x = cvtpk(v0[0], v0[1]); w.y = cvtpk(v0[2], v0[3]); w.z = cvtpk(v1[0], v1[1]); w.w = cvtpk(v1[2], v1[3]);
                    *(u32x4*)(rowp + bj * HALF) = w; } }
    }
};
struct EpiSwiglu {
    static constexpr bool PERM = true;
    bf16_t* O; int ldc;
    __device__ __forceinline__ void operator()(const f32x4 (&acc)[2][2][4][2], const Unit& u, int wr, int wc, int fr, int fq) const {
        const int row0 = u.pm * BM + wr * 64 + fr; const int col0 = u.pn * HALF + wc * 32 + 8 * fq;
#pragma unroll
        for (int ai = 0; ai < 2; ++ai)
#pragma unroll
            for (int m = 0; m < 4; ++m) { bf16_t* rowp = O + (size_t)(row0 + ai * HALF + m * 16) * ldc + col0;
                float o[8];
#pragma unroll
                for (int n = 0; n < 2; ++n)
#pragma unroll
                    for (int j = 0; j < 4; ++j) { const float g = acc[ai][0][m][n][j], up = acc[ai][1][m][n][j]; o[n * 4 + j] = g / (1.f + __expf(-g)) * up; }
                u32x4 w; w.x = cvtpk(o[0], o[1]); w.y = cvtpk(o[2], o[3]); w.z = cvtpk(o[4], o[5]); w.w = cvtpk(o[6], o[7]);
                *(u32x4*)rowp = w; }
    }
};
struct EpiResid {
    static constexpr bool PERM = false;
    const float* resLat; const float* resCtx; float* outLat; float* outCtx; const float* modl; int goff;
    __device__ __forceinline__ void operator()(const f32x4 (&acc)[2][2][4][2], const Unit& u, int wr, int wc, int fr, int fq) const {
        const int rowt = u.pm * BM; const bool lat = rowt < NLAT;
        const float* res = lat ? resLat + (size_t)rowt * DM : resCtx + (size_t)(rowt - NLAT) * DM;
        float* out = lat ? outLat + (size_t)rowt * DM : outCtx + (size_t)(rowt - NLAT) * DM;
        const float* gate = modl + (size_t)(lat ? (rowt >> 13) : 8) * 6144 + goff;
        const int row0 = wr * 64 + fr, col0 = u.pn * BM + wc * 32 + 4 * fq;
        f32x4 gv[2][2];
#pragma unroll
        for (int bj = 0; bj < 2; ++bj)
#pragma unroll
            for (int n = 0; n < 2; ++n) gv[bj][n] = *(const f32x4*)(gate + col0 + bj * HALF + n * 16);
#pragma unroll
        for (int ai = 0; ai < 2; ++ai)
#pragma unroll
            for (int m = 0; m < 4; ++m) { const size_t off = (size_t)(row0 + ai * HALF + m * 16) * DM + col0;
#pragma unroll
                for (int bj = 0; bj < 2; ++bj)
#pragma unroll
                    for (int n = 0; n < 2; ++n) { const f32x4 r = *(const f32x4*)(res + off + bj * HALF + n * 16);
                        *(f32x4*)(out + off + bj * HALF + n * 16) = r + gv[bj][n] * acc[ai][bj][m][n]; } }
    }
};

template <class Epi, class Sched>
__device__ __forceinline__ void gemm_phase(LAS unsigned char* lds, const Gemm g, const Sched& S, const Epi& E) {
    const int tid = threadIdx.x, wid = __builtin_amdgcn_readfirstlane(tid >> 6), lane = tid & 63, wr = wid >> 2, wc = wid & 3, fr = lane & 15, fq = lane >> 4;
    const int K = g.K, nt = K / BK;
    unsigned voffA[2], voffB[2];
#pragma unroll
    for (int i = 0; i < 2; ++i) { int R, C; stage_rc(tid * 16 + i * 8192, R, C); const int Rb = Epi::PERM ? ((R & ~31) + perm32(R & 31)) : R;
        voffA[i] = (unsigned)(R * K + C) * 2u; voffB[i] = (unsigned)(Rb * K + C) * 2u; }
    const size_t kstep = (size_t)(BK * 2);
    const size_t hstep = (size_t)HALF * K * 2;
    const size_t tstep = 2 * hstep;
    const unsigned ldsw = (unsigned)wid * 1024u;
    const int aoff = lds_byte(wr * 64 + fr, fq * 8), boff = lds_byte(wc * 32 + fr, fq * 8);
#define PG8_SA(b, h) (((b) * 2 + (h)) * HTB)
#define PG8_SB(b, h) ((4 + (b) * 2 + (h)) * HTB)
#define PG8_STAGE(bufoff, gbase, voff) do { _Pragma("unroll") for (int _i = 0; _i < 2; ++_i) \
        __builtin_amdgcn_global_load_lds((const unsigned*)((const char*)(gbase) + (voff)[_i]), (LAS unsigned*)(lds + (bufoff) + ldsw + _i * 8192), 16, 0, 0); } while (0)
#define PG8_LDA(dst, b, h) do { _Pragma("unroll") for (int m = 0; m < 4; ++m) _Pragma("unroll") for (int k = 0; k < 2; ++k) dst[m][k] = *(const LAS bf16x8*)(lds + PG8_SA(b, h) + aoff + m * 2048 + k * 1024); } while (0)
#define PG8_LDB(dst, b, h) do { _Pragma("unroll") for (int n = 0; n < 2; ++n) _Pragma("unroll") for (int k = 0; k < 2; ++k) dst[n][k] = *(const LAS bf16x8*)(lds + PG8_SB(b, h) + boff + n * 2048 + k * 1024); } while (0)
#define PG8_MMA(ai, bj, At, Bt) do { __builtin_amdgcn_s_setprio(1); _Pragma("unroll") for (int m = 0; m < 4; ++m) _Pragma("unroll") for (int n = 0; n < 2; ++n) _Pragma("unroll") for (int k = 0; k < 2; ++k) \
        acc[ai][bj][m][n] = __builtin_amdgcn_mfma_f32_16x16x32_bf16(Bt[n][k], At[m][k], acc[ai][bj][m][n], 0, 0, 0); __builtin_amdgcn_s_setprio(0); } while (0)
#define PG8_WAIT_V(n) asm volatile("s_waitcnt vmcnt(" #n ")" ::: "memory")
#define PG8_WAIT_L(n) asm volatile("s_waitcnt lgkmcnt(" #n ")" ::: "memory")
#define PG8_BAR __builtin_amdgcn_s_barrier()
#define PG8_SCHED __builtin_amdgcn_sched_barrier(0)
    Unit cur, nxt; int ui = 0;
    if (!S.next(0, cur)) return;
    f32x4 acc[2][2][4][2];
#pragma unroll
    for (int a = 0; a < 2; ++a)
#pragma unroll
        for (int b = 0; b < 2; ++b)
#pragma unroll
            for (int m = 0; m < 4; ++m)
#pragma unroll
                for (int n = 0; n < 2; ++n) acc[a][b][m][n] = (f32x4){0.f, 0.f, 0.f, 0.f};
    bf16x8 At[4][2], B0[2][2], B1[2][2];
    const char* cA = (const char*)g.A + (size_t)cur.pm * tstep; const char* cB = (const char*)g.Bt + (size_t)cur.pn * tstep;
    PG8_STAGE(PG8_SB(0, 0), cB, voffB); PG8_STAGE(PG8_SA(0, 0), cA, voffA); PG8_STAGE(PG8_SB(0, 1), cB + hstep, voffB); PG8_STAGE(PG8_SA(0, 1), cA + hstep, voffA);
    if (wr == 1) PG8_BAR;
    PG8_WAIT_V(4); PG8_BAR;
    PG8_STAGE(PG8_SB(1, 0), cB + kstep, voffB); PG8_STAGE(PG8_SA(1, 0), cA + kstep, voffA); PG8_STAGE(PG8_SB(1, 1), cB + hstep + kstep, voffB);
    PG8_WAIT_V(6); PG8_BAR;
    for (;;) {
        const bool has_next = S.next(ui + 1, nxt);
        const char* nA = has_next ? (const char*)g.A + (size_t)nxt.pm * tstep : cA; const char* nB = has_next ? (const char*)g.Bt + (size_t)nxt.pn * tstep : cB;
        for (int t = 0; t < nt; t += 2) {
            const bool last = (t == nt - 2);
            const char* a1 = cA + (size_t)(t + 1) * kstep;
            const char* a2 = last ? nA : cA + (size_t)(t + 2) * kstep; const char* b2 = last ? nB : cB + (size_t)(t + 2) * kstep;
            const char* a3 = a2 + kstep; const char* b3 = b2 + kstep;
            PG8_LDB(B0, 0, 0); PG8_SCHED; PG8_LDA(At, 0, 0); PG8_STAGE(PG8_SA(1, 1), a1 + hstep, voffA);
            PG8_WAIT_L(8); PG8_BAR; PG8_WAIT_L(0); PG8_MMA(0, 0, At, B0); PG8_BAR; PG8_SCHED;
            PG8_LDB(B1, 0, 1); PG8_STAGE(PG8_SB(0, 0), b2, voffB);
            PG8_BAR; PG8_WAIT_L(0); PG8_MMA(0, 1, At, B1); PG8_BAR;
            PG8_LDA(At, 0, 1); PG8_STAGE(PG8_SA(0, 0), a2, voffA);
            PG8_BAR; PG8_WAIT_L(0); PG8_MMA(1, 0, At, B0); PG8_BAR; PG8_SCHED;
            PG8_STAGE(PG8_SB(0, 1), b2 + hstep, voffB);
            PG8_WAIT_V(6); PG8_BAR; PG8_MMA(1, 1, At, B1); PG8_BAR;
            PG8_LDB(B0, 1, 0); PG8_SCHED; PG8_LDA(At, 1, 0); PG8_STAGE(PG8_SA(0, 1), a2 + hstep, voffA);
            PG8_WAIT_L(8); PG8_BAR; PG8_WAIT_L(0); PG8_MMA(0, 0, At, B0); PG8_BAR; PG8_SCHED;
            PG8_LDB(B1, 1, 1); PG8_STAGE(PG8_SB(1, 0), b3, voffB);
            PG8_BAR; PG8_WAIT_L(0); PG8_MMA(0, 1, At, B1); PG8_BAR;
            PG8_LDA(At, 1, 1); PG8_STAGE(PG8_SA(1, 0), a3, voffA);
            PG8_BAR; PG8_WAIT_L(0); PG8_MMA(1, 0, At, B0); PG8_BAR; PG8_SCHED;
            PG8_STAGE(PG8_SB(1, 1), b3 + hstep, voffB);
            PG8_WAIT_V(6); PG8_BAR; PG8_MMA(1, 1, At, B1); PG8_BAR;
        }
        E(acc, cur, wr, wc, fr, fq);
        if (!has_next) break;
#pragma unroll
        for (int a = 0; a < 2; ++a)
#pragma unroll
            for (int b = 0; b < 2; ++b)
#pragma unroll
                for (int m = 0; m < 4; ++m)
#pragma unroll
                    for (int n = 0; n < 2; ++n) acc[a][b][m][n] = (f32x4){0.f, 0.f, 0.f, 0.f};
        cur = nxt; cA = nA; cB = nB; ++ui;
    }
    PG8_WAIT_V(0);
    if (wr == 0) PG8_BAR;
    PG8_BAR;
#undef PG8_SA
#undef PG8_SB
#undef PG8_STAGE
#undef PG8_LDA
#undef PG8_LDB
#undef PG8_MMA
#undef PG8_WAIT_V
#undef PG8_WAIT_L
#undef PG8_BAR
#undef PG8_SCHED
}
}

#define KSWZ(row, colB) ((row) * 256 + ((colB) ^ (((row) & 7) << 4)))
#define SBAR() __builtin_amdgcn_sched_barrier(0)
__device__ __forceinline__ int crow(int r, int hi) { return (r & 3) + 8 * (r >> 2) + 4 * hi; }
__device__ __forceinline__ int v_st(int k, int c) { const int kk = (k & ~0xC) | ((k & 4) << 1) | ((k & 8) >> 1); return ((kk >> 3) * 4 + (c >> 5)) * 512 + ((kk & 7) * 32 + (c & 31)) * 2; }
__device__ __forceinline__ int v_rd_base(int lane) { return ((lane & 3) << 3) | (((lane >> 2) & 3) << 6) | (((lane >> 4) & 1) << 5) | (((lane >> 5) & 1) << 8); }
constexpr int v_rd_off(int d0, int ks, int half) { return d0 * 512 + ks * 4096 + half * 2048; }
template <int OFF> __device__ __forceinline__ s16x4 tr_read(int vb) {
    s16x4 r; asm volatile("ds_read_b64_tr_b16 %0, %1 offset:%2" : "=&v"(r) : "v"(vb), "i"(OFF) : "memory"); return r;
}
template <int D0> __device__ __forceinline__ void pv_one(f32x16& od, int vb, bf16x8 pa0, bf16x8 pa1, bf16x8 pa2, bf16x8 pa3) {
    const s16x4 l0 = tr_read<v_rd_off(D0, 0, 0)>(vb), h0 = tr_read<v_rd_off(D0, 0, 1)>(vb), l1 = tr_read<v_rd_off(D0, 1, 0)>(vb), h1 = tr_read<v_rd_off(D0, 1, 1)>(vb);
    const s16x4 l2 = tr_read<v_rd_off(D0, 2, 0)>(vb), h2 = tr_read<v_rd_off(D0, 2, 1)>(vb), l3 = tr_read<v_rd_off(D0, 3, 0)>(vb), h3 = tr_read<v_rd_off(D0, 3, 1)>(vb);
    asm volatile("s_waitcnt lgkmcnt(0)" ::: "memory"); SBAR();
#define PK(L, H) (bf16x8){L[0], L[1], L[2], L[3], H[0], H[1], H[2], H[3]}
    od = __builtin_amdgcn_mfma_f32_32x32x16_bf16(pa0, PK(l0, h0), od, 0, 0, 0);
    od = __builtin_amdgcn_mfma_f32_32x32x16_bf16(pa1, PK(l1, h1), od, 0, 0, 0);
    od = __builtin_amdgcn_mfma_f32_32x32x16_bf16(pa2, PK(l2, h2), od, 0, 0, 0);
    od = __builtin_amdgcn_mfma_f32_32x32x16_bf16(pa3, PK(l3, h3), od, 0, 0, 0);
#undef PK
}
__device__ __forceinline__ void pv_d0(f32x16* o, int vb, bf16x8 pa0, bf16x8 pa1, bf16x8 pa2, bf16x8 pa3) {
    pv_one<0>(o[0], vb, pa0, pa1, pa2, pa3); pv_one<1>(o[1], vb, pa0, pa1, pa2, pa3); pv_one<2>(o[2], vb, pa0, pa1, pa2, pa3); pv_one<3>(o[3], vb, pa0, pa1, pa2, pa3);
}
#define PK4(P, BASE, OUT) do { unsigned a0 = cvtpk(P[BASE + 0], P[BASE + 1]), a1 = cvtpk(P[BASE + 2], P[BASE + 3]);   \
    unsigned b0 = cvtpk(P[BASE + 4], P[BASE + 5]), b1 = cvtpk(P[BASE + 6], P[BASE + 7]);                              \
    auto r0 = __builtin_amdgcn_permlane32_swap(a0, b0, false, false); auto r1 = __builtin_amdgcn_permlane32_swap(a1, b1, false, false); \
    u32x4 w = {r0[0], r1[0], r0[1], r1[1]}; OUT = *reinterpret_cast<bf16x8*>(&w); } while (0)
__device__ __forceinline__ float halfswap_add(float v) {
    auto rr = __builtin_amdgcn_permlane32_swap(__float_as_uint(v), __float_as_uint(v), false, false);
    return __uint_as_float(rr[0]) + __uint_as_float(rr[1]);
}

__device__ __forceinline__ void ada_phase(const Params& p, unsigned char* lds) {
    float* sc = (float*)lds;
    float* red = (float*)(lds + 40960);
    float* mod = (float*)(p.ws + WS_MOD);
    const int tid = threadIdx.x;
    for (int j = blockIdx.x; j < 192; j += gridDim.x) {
        const int l = j / 96, n0 = (j % 96) * 64;
        for (int i = tid; i < 9 * 1024; i += NTHREADS) { const int r = i >> 10, k = i & 1023; const float v = r < 8 ? p.c[r * 1024 + k] : p.c_ctx[k]; sc[i] = v / (1.f + expf(-v)); }
        __syncthreads();
        const int col = tid & 63, ks = tid >> 6;
        float acc[9];
#pragma unroll
        for (int r = 0; r < 9; ++r) acc[r] = 0.f;
        const float* wp = p.ada_w + ((size_t)l * 1024 + ks * 128) * 6144 + n0 + col;
#pragma unroll 8
        for (int kk = 0; kk < 128; ++kk) { const float w = wp[(size_t)kk * 6144];
#pragma unroll
            for (int r = 0; r < 9; ++r) acc[r] += sc[r * 1024 + ks * 128 + kk] * w; }
#pragma unroll
        for (int r = 0; r < 9; ++r) red[(ks * 9 + r) * 64 + col] = acc[r];
        __syncthreads();
        for (int i = tid; i < 576; i += NTHREADS) { const int r = i >> 6, cc = i & 63; float s = p.ada_b[l * 6144 + n0 + cc];
            for (int k2 = 0; k2 < 8; ++k2) s += red[(k2 * 9 + r) * 64 + cc];
            mod[(size_t)(l * 9 + r) * 6144 + n0 + cc] = s; }
        __syncthreads();
    }
}
__device__ __forceinline__ void wconv_phase(const Params& p, unsigned char* lds) {
    float* tl = (float*)lds;
    const int tid = threadIdx.x;
    const int T0 = 16 * 60, T1 = T0 + 16 * 16, T2 = T1 + 16 * 48, T3 = T2 + 16 * 16, T4 = T3 + 16 * 88, T5 = T4 + 16 * 88, T6 = T5 + 44 * 16, T7 = T6 + 44 * 16;
    for (int t = blockIdx.x; t < T7; t += gridDim.x) {
        const float* src; bf16_t* dst; int K, N, NP, mode = 0, tt;
        if (t < T0) { src = p.even_w_in; dst = (bf16_t*)(p.ws + WS_W_EVIN); K = 1024; N = EV_N; NP = EV_NP; tt = t; }
        else if (t < T1) { src = p.even_w_out; dst = (bf16_t*)(p.ws + WS_W_EVOUT); K = 1024; N = 1024; NP = 1024; tt = t - T0; }
        else if (t < T2) { src = p.odd_w_in; dst = (bf16_t*)(p.ws + WS_W_ODIN); K = 1024; N = OD_N; NP = OD_N; tt = t - T1; }
        else if (t < T3) { src = p.odd_w_out; dst = (bf16_t*)(p.ws + WS_W_ODOUT); K = 1024; N = 1024; NP = 1024; tt = t - T2; }
        else if (t < T4) { src = p.ffn_w_in; dst = (bf16_t*)(p.ws + WS_W_FFIN); K = 1024; N = 2 * FF; NP = 2 * FF; mode = 1; tt = t - T3; }
        else if (t < T5) { src = p.ffn_w_in + (size_t)1024 * 2 * FF; dst = (bf16_t*)(p.ws + WS_W_FFIN) + (size_t)2 * FF * 1024; K = 1024; N = 2 * FF; NP = 2 * FF; mode = 1; tt = t - T4; }
        else if (t < T6) { src = p.ffn_w_out; dst = (bf16_t*)(p.ws + WS_W_FFOUT); K = FF; N = 1024; NP = 1024; tt = t - T5; }
        else { src = p.ffn_w_out + (size_t)FF * 1024; dst = (bf16_t*)(p.ws + WS_W_FFOUT) + (size_t)1024 * FF; K = FF; N = 1024; NP = 1024; tt = t - T6; }
        const int nnt = NP / 64; const int k0 = (tt / nnt) * 64, n0 = (tt % nnt) * 64;
        int sn0;
        if (mode == 1) { const int tb = n0 >> 8, bj = (n0 >> 7) & 1, i0 = n0 & 127; sn0 = bj * FF + tb * 128 + i0; } else sn0 = n0;
        for (int e = tid; e < 4096; e += NTHREADS) { const int kk = e >> 6, nn = e & 63; const int sn = sn0 + nn;
            tl[kk * 65 + nn] = (sn < N) ? src[(size_t)(k0 + kk) * N + sn] : 0.f; }
        __syncthreads();
        for (int e = tid; e < 2048; e += NTHREADS) { const int nn = e >> 5, k2 = (e & 31) * 2;
            *(unsigned*)(dst + (size_t)(n0 + nn) * K + k0 + k2) = cvtpk(tl[k2 * 65 + nn], tl[(k2 + 1) * 65 + nn]); }
        __syncthreads();
    }
}

__device__ __forceinline__ void norm_phase(const Params& p, const float* xlat, const float* xctx, int l, int which, int nrows) {
    const int lane = threadIdx.x & 63, wid = threadIdx.x >> 6;
    bf16_t* h = (bf16_t*)(p.ws + WS_H);
    const float* mod = (const float*)(p.ws + WS_MOD) + (size_t)l * 9 * 6144;
    const float* gain = (which ? p.norm_ffn : p.norm_mix) + l * 1024;
    const int shoff = which ? 3072 : 0, scoff = which ? 4096 : 1024;
    const int stride = gridDim.x * 8;
    for (int row = blockIdx.x * 8 + wid; row < nrows; row += 2 * stride) {
        const int rowB = row + stride; const bool hasB = rowB < nrows;
        const float* srcA = row < NLAT ? xlat + (size_t)row * DM : xctx + (size_t)(row - NLAT) * DM;
        const float* srcB = hasB ? (rowB < NLAT ? xlat + (size_t)rowB * DM : xctx + (size_t)(rowB - NLAT) * DM) : srcA;
        f32x4 va[4], vb[4];
#pragma unroll
        for (int i = 0; i < 4; ++i) { va[i] = *(const f32x4*)(srcA + lane * 4 + 256 * i); vb[i] = *(const f32x4*)(srcB + lane * 4 + 256 * i); }
#pragma unroll
        for (int rr = 0; rr < 2; ++rr) {
            if (rr == 1 && !hasB) break;
            const int r = rr ? rowB : row;
            const float* mr = mod + (size_t)(r < NLAT ? (r >> 13) : 8) * 6144;
            float ss = 0.f;
#pragma unroll
            for (int i = 0; i < 4; ++i) { const f32x4 v = rr ? vb[i] : va[i]; ss += v[0] * v[0] + v[1] * v[1] + v[2] * v[2] + v[3] * v[3]; }
#pragma unroll
            for (int o = 1; o < 64; o <<= 1) ss += __shfl_xor(ss, o);
            const float rstd = rsqrtf(ss * (1.f / 1024.f) + 1e-6f);
#pragma unroll
            for (int i = 0; i < 4; ++i) { const int c0 = lane * 4 + 256 * i; const f32x4 v = rr ? vb[i] : va[i];
                const f32x4 g = *(const f32x4*)(gain + c0), s1 = *(const f32x4*)(mr + scoff + c0), sh = *(const f32x4*)(mr + shoff + c0);
                float y[4];
#pragma unroll
                for (int j = 0; j < 4; ++j) y[j] = v[j] * rstd * g[j] * (1.f + s1[j]) + sh[j];
                u32x2 w; w.x = cvtpk(y[0], y[1]); w.y = cvtpk(y[2], y[3]);
                *(u32x2*)(h + (size_t)r * DM + c0) = w; }
        }
    }
}

__device__ __forceinline__ void prep0_phase(const Params& p) {
    const int lane0 = threadIdx.x & 63, wid = threadIdx.x >> 6;
    bf16_t* proj = (bf16_t*)(p.ws + WS_PROJ);
    bf16_t* qkvp = (bf16_t*)p.out;
    float* gbuf = (float*)(p.ws + WS_GATES);
    const float* ropec = (const float*)(p.ws + WS_ROPE); const float* ropes = ropec + SEQ * 32;
    constexpr int RB = 8;
    for (int blk = blockIdx.x * 8 + wid; blk < MTOT / RB; blk += gridDim.x * 8) {
        int lane = lane0; asm volatile("" : "+v"(lane));
        const int row0 = blk * RB; const bool lat = row0 < NLAT; const int t0 = lat ? (row0 & 8191) : ((row0 - NLAT) & 255); const int len = lat ? SEQ : CTXL;
        const int dsub = (lane & 7) * 8;
        {
            float gq[8], gk[8];
#pragma unroll
            for (int i = 0; i < 8; ++i) { gq[i] = p.diff_qk_gain[dsub + i] * (0.125f * 1.4426950408889634f); gk[i] = p.diff_qk_gain[64 + dsub + i]; }
            for (int i = 0; i < RB; ++i) {
                bf16_t* P = proj + (size_t)(row0 + i) * EV_NP;
                f32x4 c4 = {1.f, 1.f, 1.f, 1.f}, s4 = {0.f, 0.f, 0.f, 0.f};
                if (lat) { c4 = *(const f32x4*)(ropec + (t0 + i) * 32 + (lane & 7) * 4); s4 = *(const f32x4*)(ropes + (t0 + i) * 32 + (lane & 7) * 4); }
#pragma unroll
                for (int which = 0; which < 2; ++which) {
                    float v[8]; unpack8(*(const bf16x8*)(P + which * 512 + lane * 8), v);
                    float ss = 0.f;
#pragma unroll
                    for (int e = 0; e < 8; ++e) ss += v[e] * v[e];
                    ss += __shfl_xor(ss, 1); ss += __shfl_xor(ss, 2); ss += __shfl_xor(ss, 4);
                    const float rstd = rsqrtf(ss * (1.f / 64.f) + 1e-6f);
#pragma unroll
                    for (int e = 0; e < 8; ++e) v[e] = v[e] * rstd * (which ? gk[e] : gq[e]);
#pragma unroll
                    for (int e = 0; e < 4; ++e) { const float x0 = v[2 * e], x1 = v[2 * e + 1]; v[2 * e] = x0 * c4[e] - x1 * s4[e]; v[2 * e + 1] = x0 * s4[e] + x1 * c4[e]; }
                    *(bf16x8*)(P + which * 512 + lane * 8) = pack8(v);
                }
            }
        }
#pragma unroll 1
        for (int g = 0; g < 3; ++g) {
            const int c0 = g * 512 + lane * 8;
            float w[5][8];
#pragma unroll
            for (int j = 0; j < 5; ++j) { const f32x4 w0 = *(const f32x4*)(p.gdn_conv + j * 1536 + c0), w1 = *(const f32x4*)(p.gdn_conv + j * 1536 + c0 + 4);
#pragma unroll
                for (int e = 0; e < 4; ++e) { w[j][e] = w0[e]; w[j][4 + e] = w1[e]; } }
            float xm2[8], xm1[8], x0[8], xp1[8], xp2[8];
            const bf16_t* src = proj + (size_t)row0 * EV_NP + 1536 + c0;
#define LDROW(dst, dt) do { if (t0 + (dt) >= 0 && t0 + (dt) < len) unpack8(*(const bf16x8*)(src + (ptrdiff_t)(dt) * EV_NP), dst); else { _Pragma("unroll") for (int e_ = 0; e_ < 8; ++e_) dst[e_] = 0.f; } } while (0)
            LDROW(xm2, -2); LDROW(xm1, -1); LDROW(x0, 0); LDROW(xp1, 1);
            const float nsc = g == 0 ? 0.08838834764831845f : 1.f;
            for (int i = 0; i < RB; ++i) {
                LDROW(xp2, i + 2);
                float y[8];
#pragma unroll
                for (int e = 0; e < 8; ++e) { y[e] = w[0][e] * xm2[e] + w[1][e] * xm1[e] + w[2][e] * x0[e] + w[3][e] * xp1[e] + w[4][e] * xp2[e]; y[e] = y[e] / (1.f + __expf(-y[e])); }
                if (g < 2) { float ss = 0.f;
#pragma unroll
                    for (int e = 0; e < 8; ++e) ss += y[e] * y[e];
                    ss += __shfl_xor(ss, 1); ss += __shfl_xor(ss, 2); ss += __shfl_xor(ss, 4); ss += __shfl_xor(ss, 8);
                    const float sc_ = rsqrtf(ss + 1e-6f) * nsc;
#pragma unroll
                    for (int e = 0; e < 8; ++e) y[e] *= sc_; }
                *(bf16x8*)(qkvp + (size_t)(row0 + i) * 1536 + c0) = pack8(y);
#pragma unroll
                for (int e = 0; e < 8; ++e) { xm2[e] = xm1[e]; xm1[e] = x0[e]; x0[e] = xp1[e]; xp1[e] = xp2[e]; }
            }
#undef LDROW
        }
#pragma unroll
        for (int k = 0; k < RB / 4; ++k) { const int idx = lane + 64 * k, i = idx >> 4, gi = idx & 15;
            const float gvv = bf2f(proj[(size_t)(row0 + i) * EV_NP + 3584 + gi]); float o;
            if (gi < 8) o = 1.f / (1.f + expf(-gvv));
            else { const float z = gvv + p.gdn_dt_bias[gi - 8]; const float sp = z > 20.f ? z : log1pf(expf(z)); o = -expf(p.gdn_a_log[gi - 8]) * sp; }
            gbuf[(size_t)(row0 + i) * 16 + gi] = o; }
    }
}

__device__ __forceinline__ int gdn_row(int b, int pc, int tau, int dir) {
    const int tt = dir ? 63 - tau : tau;
    return pc < 4 ? NLAT + b * CTXL + pc * 64 + tt : b * SEQ + (pc - 4) * 64 + tt;
}
__device__ __forceinline__ void gdn_pre_phase(const Params& p, unsigned char* lds) {
    const int lane = threadIdx.x & 63, wid = threadIdx.x >> 6;
    float* Lw = (float*)(lds + wid * 16896);
    float* gs = Lw + 4096; float* bs = gs + 64;
    const bf16_t* qkvp = (const bf16_t*)p.out;
    const float* gbuf = (const float*)(p.ws + WS_GATES);
    bf16_t* Tb = (bf16_t*)(p.ws + WS_T); bf16_t* Ab = (bf16_t*)(p.ws + WS_AQK);
    float* gv = (float*)(p.ws + WS_GV); float* bv = (float*)(p.ws + WS_BV);
    const int lane0 = lane;
    for (int cp = blockIdx.x * 8 + wid; cp < NCHUNKP; cp += gridDim.x * 8) {
        int lane = lane0; asm volatile("" : "+v"(lane));
        const int r32 = lane & 31, hi = lane >> 5;
        const int pc = cp % 132, ch = cp / 132, dir = ch & 1, h = (ch >> 1) & 3, b = ch >> 3;
        { const int R = gdn_row(b, pc, lane, dir);
          float g = gbuf[(size_t)R * 16 + 8 + dir * 4 + h]; const float be = gbuf[(size_t)R * 16 + dir * 4 + h];
#pragma unroll
          for (int o = 1; o < 64; o <<= 1) { const float t = __shfl_up(g, o); if (lane >= o) g += t; }
          gs[lane] = g; bs[lane] = be; const float gl_ = __shfl(g, 63); gv[(size_t)cp * 64 + lane] = expf(g); bv[(size_t)cp * 64 + lane] = be; ((float*)(p.ws + WS_EL))[(size_t)cp * 64 + lane] = expf(gl_ - g); }
        bf16x8 kf[2][8];
#pragma unroll
        for (int mi = 0; mi < 2; ++mi) { const size_t R = (size_t)gdn_row(b, pc, 32 * mi + r32, dir);
#pragma unroll
            for (int d0 = 0; d0 < 8; ++d0) kf[mi][d0] = *(const bf16x8*)(qkvp + R * 1536 + 512 + h * 128 + d0 * 16 + hi * 8); }
        bf16_t* Ao = Ab + (size_t)cp * 4096;
#pragma unroll
        for (int mi = 0; mi < 2; ++mi) {
            bf16x8 qf[8];
            { const size_t R = (size_t)gdn_row(b, pc, 32 * mi + r32, dir);
#pragma unroll
              for (int d0 = 0; d0 < 8; ++d0) qf[d0] = *(const bf16x8*)(qkvp + R * 1536 + h * 128 + d0 * 16 + hi * 8); }
#pragma unroll
            for (int ni = 0; ni <= mi; ++ni) {
                f32x16 ckk = {}, cqk = {};
#pragma unroll
                for (int d0 = 0; d0 < 8; ++d0) { ckk = __builtin_amdgcn_mfma_f32_32x32x16_bf16(kf[mi][d0], kf[ni][d0], ckk, 0, 0, 0);
                                                 cqk = __builtin_amdgcn_mfma_f32_32x32x16_bf16(qf[d0], kf[ni][d0], cqk, 0, 0, 0); }
                const int sg = 32 * ni + r32; const float gsg = gs[sg];
#pragma unroll
                for (int r = 0; r < 16; ++r) { const int tau = 32 * mi + crow(r, hi);
                    const float dec = tau >= sg ? expf(gs[tau] - gsg) : 0.f;
                    Lw[tau * 64 + sg] = tau > sg ? bs[tau] * dec * ckk[r] : 0.f;
                    Ao[tau * 64 + sg] = f2bf(cqk[r] * dec); }
                asm volatile("" ::: "memory");
            }
        }
#pragma unroll
        for (int r = 0; r < 16; ++r) Ao[crow(r, hi) * 64 + 32 + r32] = 0;
        float Tc[64];
#pragma unroll
        for (int i = 0; i < 64; ++i) { float a = (i == lane) ? 1.f : 0.f;
#pragma unroll
            for (int j = 0; j < i; ++j) a -= Lw[i * 64 + j] * Tc[j];
            Tc[i] = a; asm volatile("" ::: "memory"); }
        bf16_t* To = Tb + (size_t)cp * 4096;
#pragma unroll
        for (int i = 0; i < 64; ++i) To[i * 64 + lane] = f2bf(Tc[i]);
    }
}

constexpr int G_KV = 0, G_QA = 16384, G_TT = 32768, G_AQ = G_TT + 9216, G_RT = G_AQ + 9216, G_UT = G_RT + 4608, G_UP = G_UT + 4608,
              G_ST = G_UP + 4608, G_VS = G_ST + 8704, G_GS = G_VS + 4096, G_BS = G_GS + 256, G_EL = G_BS + 256, G_END = G_EL + 256;
__device__ __forceinline__ void gdn_scan_phase(const Params& p, unsigned char* lds) {
    const int tid = threadIdx.x, lane0 = tid & 63, wid = tid >> 6;
    const bf16_t* qkvp = (const bf16_t*)p.out;
    const bf16_t* Tb = (const bf16_t*)(p.ws + WS_T); const bf16_t* Ab = (const bf16_t*)(p.ws + WS_AQK);
    const float* gv = (const float*)(p.ws + WS_GV); const float* bv = (const float*)(p.ws + WS_BV);
    bf16_t* obuf = (bf16_t*)(p.ws + WS_H);
    const float* gsl = (const float*)(lds + G_GS); const float* bsl = (const float*)(lds + G_BS); const float* esl = (const float*)(lds + G_EL);
    const int sr = tid >> 4, sc = (tid & 15) * 8;
    const int vblk = (gridDim.x % 8 == 0) ? (int)((blockIdx.x & 7) * (gridDim.x >> 3) + (blockIdx.x >> 3)) : (int)blockIdx.x;
    for (int wi = vblk; wi < 256; wi += gridDim.x) {
        const int chain = wi >> 2, cs = wi & 3, b = chain >> 3, h = (chain >> 1) & 3, dir = chain & 1;
        f32x16 Sacc = {};
        for (int i = tid; i < 8704 / 4; i += NTHREADS) ((unsigned*)(lds + G_ST))[i] = 0u;
        bf16x8 sk0, sk1, sq0, sq1, sT, sA, sV; float sg = 0.f;
#define GLOAD(step) do { const int pc_ = dir == 0 ? (step) : ((step) < 4 ? 3 - (step) : 4 + 127 - ((step) - 4)); \
        const size_t cp_ = (size_t)chain * 132 + pc_; \
        const size_t R0_ = (size_t)gdn_row(b, pc_, sr, dir), R1_ = (size_t)gdn_row(b, pc_, 32 + sr, dir); \
        sk0 = *(const bf16x8*)(qkvp + R0_ * 1536 + 512 + h * 128 + sc); sk1 = *(const bf16x8*)(qkvp + R1_ * 1536 + 512 + h * 128 + sc); \
        sq0 = *(const bf16x8*)(qkvp + R0_ * 1536 + h * 128 + sc); sq1 = *(const bf16x8*)(qkvp + R1_ * 1536 + h * 128 + sc); \
        sT = *(const bf16x8*)(Tb + cp_ * 4096 + tid * 8); sA = *(const bf16x8*)(Ab + cp_ * 4096 + tid * 8); \
        if (tid < 256) { const size_t Rv_ = (size_t)gdn_row(b, pc_, tid >> 2, dir); sV = *(const bf16x8*)(qkvp + Rv_ * 1536 + 1024 + h * 128 + cs * 32 + (tid & 3) * 8); } \
        if (tid < 64) sg = gv[cp_ * 64 + tid]; else if (tid < 128) sg = bv[cp_ * 64 + tid - 64]; else if (tid < 192) sg = ((const float*)(p.ws + WS_EL))[cp_ * 64 + tid - 128]; } while (0)
#define GWRITE() do { *(bf16x8*)(lds + G_KV + v_st(sr, sc)) = sk0; *(bf16x8*)(lds + G_KV + v_st(32 + sr, sc)) = sk1; \
        *(bf16x8*)(lds + G_QA + KSWZ(sr, sc * 2)) = sq0; *(bf16x8*)(lds + G_QA + KSWZ(32 + sr, sc * 2)) = sq1; \
        *(bf16x8*)(lds + G_TT + (tid >> 3) * 144 + (tid & 7) * 16) = sT; *(bf16x8*)(lds + G_AQ + (tid >> 3) * 144 + (tid & 7) * 16) = sA; \
        if (tid < 256) *(bf16x8*)(lds + G_VS + (tid >> 2) * 64 + (tid & 3) * 16) = sV; \
        if (tid < 192) ((float*)(lds + G_GS))[tid] = sg; } while (0)
        GLOAD(0);
        for (int step = 0; step < 132; ++step) {
            GWRITE();
            __syncthreads();
            if (step + 1 < 132) GLOAD(step + 1);
            int lane = lane0; asm volatile("" : "+v"(lane));
            const int r32 = lane & 31, hi = lane >> 5;
            const int vb0 = (int)(uintptr_t)(lds + G_KV) + v_rd_base(lane);
            const int pc = dir == 0 ? step : (step < 4 ? 3 - step : 4 + 127 - (step - 4));
            f32x16 acc = {};
            const int mi = wid & 1;
            if (wid < 4) {
                f32x16 acc2 = {};
                if (wid < 2) {
#pragma unroll
                    for (int d0 = 0; d0 < 8; d0 += 2) {
                        const bf16x8 a0 = *(const bf16x8*)(lds + G_KV + v_st(32 * mi + r32, d0 * 16 + hi * 8)), a1 = *(const bf16x8*)(lds + G_KV + v_st(32 * mi + r32, d0 * 16 + 16 + hi * 8));
                        const bf16x8 b0 = *(const bf16x8*)(lds + G_ST + r32 * 272 + (d0 * 16 + hi * 8) * 2), b1 = *(const bf16x8*)(lds + G_ST + r32 * 272 + (d0 * 16 + 16 + hi * 8) * 2);
                        acc = __builtin_amdgcn_mfma_f32_32x32x16_bf16(a0, b0, acc, 0, 0, 0);
                        acc2 = __builtin_amdgcn_mfma_f32_32x32x16_bf16(a1, b1, acc2, 0, 0, 0); }
                } else {
#pragma unroll
                    for (int d0 = 0; d0 < 8; d0 += 2) {
                        const bf16x8 a0 = *(const bf16x8*)(lds + G_QA + KSWZ(32 * mi + r32, (d0 * 16 + hi * 8) * 2)), a1 = *(const bf16x8*)(lds + G_QA + KSWZ(32 * mi + r32, (d0 * 16 + 16 + hi * 8) * 2));
                        const bf16x8 b0 = *(const bf16x8*)(lds + G_ST + r32 * 272 + (d0 * 16 + hi * 8) * 2), b1 = *(const bf16x8*)(lds + G_ST + r32 * 272 + (d0 * 16 + 16 + hi * 8) * 2);
                        acc = __builtin_amdgcn_mfma_f32_32x32x16_bf16(a0, b0, acc, 0, 0, 0);
                        acc2 = __builtin_amdgcn_mfma_f32_32x32x16_bf16(a1, b1, acc2, 0, 0, 0); }
                }
#pragma unroll
                for (int r = 0; r < 16; ++r) acc[r] += acc2[r];
                if (wid < 2) {
#pragma unroll
                    for (int g4 = 0; g4 < 4; ++g4) { float rv[4];
#pragma unroll
                        for (int j = 0; j < 4; ++j) { const int tau = 32 * mi + 8 * g4 + 4 * hi + j;
                            const float vv = bf2f(*(const bf16_t*)(lds + G_VS + tau * 64 + r32 * 2));
                            rv[j] = bsl[tau] * (vv - gsl[tau] * acc[g4 * 4 + j]); }
                        u32x2 w; w.x = cvtpk(rv[0], rv[1]); w.y = cvtpk(rv[2], rv[3]);
                        *(u32x2*)(lds + G_RT + r32 * 144 + (32 * mi + 8 * g4 + 4 * hi) * 2) = w; }
                } else {
#pragma unroll
                    for (int r = 0; r < 16; ++r) acc[r] *= gsl[32 * mi + crow(r, hi)];
                }
            }
            __syncthreads();
            if (wid < 2) {
                f32x16 u = {}, u2 = {};
#pragma unroll
                for (int s = 0; s < 4; s += 2) {
                    const bf16x8 a0 = *(const bf16x8*)(lds + G_TT + (32 * mi + r32) * 144 + (16 * s + hi * 8) * 2), a1 = *(const bf16x8*)(lds + G_TT + (32 * mi + r32) * 144 + (16 * s + 16 + hi * 8) * 2);
                    const bf16x8 b0 = *(const bf16x8*)(lds + G_RT + r32 * 144 + (16 * s + hi * 8) * 2), b1 = *(const bf16x8*)(lds + G_RT + r32 * 144 + (16 * s + 16 + hi * 8) * 2);
                    u = __builtin_amdgcn_mfma_f32_32x32x16_bf16(a0, b0, u, 0, 0, 0);
                    u2 = __builtin_amdgcn_mfma_f32_32x32x16_bf16(a1, b1, u2, 0, 0, 0); }
#pragma unroll
                for (int r = 0; r < 16; ++r) u[r] += u2[r];
#pragma unroll
                for (int g4 = 0; g4 < 4; ++g4) { float uv[4], up[4];
#pragma unroll
                    for (int j = 0; j < 4; ++j) { const int tau = 32 * mi + 8 * g4 + 4 * hi + j; uv[j] = u[g4 * 4 + j]; up[j] = uv[j] * esl[tau]; }
                    u32x2 w; w.x = cvtpk(uv[0], uv[1]); w.y = cvtpk(uv[2], uv[3]);
                    *(u32x2*)(lds + G_UT + r32 * 144 + (32 * mi + 8 * g4 + 4 * hi) * 2) = w;
                    u32x2 w2; w2.x = cvtpk(up[0], up[1]); w2.y = cvtpk(up[2], up[3]);
                    *(u32x2*)(lds + G_UP + r32 * 144 + (32 * mi + 8 * g4 + 4 * hi) * 2) = w2; }
            }
            __syncthreads();
            if (wid == 2 || wid == 3) {
#pragma unroll
                for (int s = 0; s < 4; ++s) {
                    const bf16x8 a = *(const bf16x8*)(lds + G_AQ + (32 * mi + r32) * 144 + (16 * s + hi * 8) * 2);
                    const bf16x8 bb = *(const bf16x8*)(lds + G_UT + r32 * 144 + (16 * s + hi * 8) * 2);
                    acc = __builtin_amdgcn_mfma_f32_32x32x16_bf16(a, bb, acc, 0, 0, 0); }
#pragma unroll
                for (int r = 0; r < 16; ++r) { const size_t R = (size_t)gdn_row(b, pc, 32 * mi + crow(r, hi), dir);
                    obuf[((size_t)dir * MTOT + R) * 512 + h * 128 + cs * 32 + r32] = f2bf(acc[r]); }
            } else if (wid >= 4) {
                const float gl = gsl[63];
#pragma unroll
                for (int r = 0; r < 16; ++r) Sacc[r] *= gl;
                const bf16x8 pa0 = *(const bf16x8*)(lds + G_UP + r32 * 144 + (0 + hi * 8) * 2), pa1 = *(const bf16x8*)(lds + G_UP + r32 * 144 + (16 + hi * 8) * 2),
                             pa2 = *(const bf16x8*)(lds + G_UP + r32 * 144 + (32 + hi * 8) * 2), pa3 = *(const bf16x8*)(lds + G_UP + r32 * 144 + (48 + hi * 8) * 2);
                const int d0 = wid - 4;
                if (d0 == 0) pv_one<0>(Sacc, vb0, pa0, pa1, pa2, pa3); else if (d0 == 1) pv_one<1>(Sacc, vb0, pa0, pa1, pa2, pa3);
                else if (d0 == 2) pv_one<2>(Sacc, vb0, pa0, pa1, pa2, pa3); else pv_one<3>(Sacc, vb0, pa0, pa1, pa2, pa3);
#pragma unroll
                for (int r = 0; r < 16; ++r) *(bf16_t*)(lds + G_ST + crow(r, hi) * 272 + (32 * d0 + r32) * 2) = f2bf(Sacc[r]);
            }
            __syncthreads();
        }
#undef GLOAD
#undef GWRITE
    }
}

__device__ __forceinline__ void gdn_post_phase(const Params& p) {
    const int lane = threadIdx.x & 63, wid = threadIdx.x >> 6;
    const bf16_t* obuf = (const bf16_t*)(p.ws + WS_H);
    const bf16_t* proj = (const bf16_t*)(p.ws + WS_PROJ);
    bf16_t* mix = (bf16_t*)(p.ws + WS_MIX);
    const int d = (lane & 15) * 8;
    for (int row = blockIdx.x * 8 + wid; row < MTOT; row += gridDim.x * 8) {
        float a[8], bb[8], g[8], y[8];
        unpack8(*(const bf16x8*)(obuf + (size_t)row * 512 + lane * 8), a);
        unpack8(*(const bf16x8*)(obuf + ((size_t)MTOT + row) * 512 + lane * 8), bb);
        unpack8(*(const bf16x8*)(proj + (size_t)row * EV_NP + 3072 + lane * 8), g);
        float ss = 0.f;
#pragma unroll
        for (int i = 0; i < 8; ++i) { a[i] += bb[i]; ss += a[i] * a[i]; }
        ss += __shfl_xor(ss, 1); ss += __shfl_xor(ss, 2); ss += __shfl_xor(ss, 4); ss += __shfl_xor(ss, 8);
        const float rstd = rsqrtf(ss * (1.f / 128.f) + 1e-6f);
#pragma unroll
        for (int i = 0; i < 8; ++i) y[i] = a[i] * rstd * p.gdn_norm[d + i] * (g[i] / (1.f + expf(-g[i])));
        *(bf16x8*)(mix + (size_t)row * DM + 512 + lane * 8) = pack8(y);
    }
}

__device__ __forceinline__ void diffattn_phase(const Params& p, unsigned char* lds) {
    const int tid = threadIdx.x, wid = tid >> 6, lane = tid & 63, r32 = lane & 31, hi = lane >> 5;
    const bf16_t* proj = (const bf16_t*)(p.ws + WS_PROJ);
    bf16_t* mix = (bf16_t*)(p.ws + WS_MIX);
    float s01 = 0.f, s23 = 0.f;
    for (int i = 0; i < 64; ++i) { s01 += p.diff_lambda[i] * p.diff_lambda[64 + i]; s23 += p.diff_lambda[128 + i] * p.diff_lambda[192 + i]; }
    const float lam = expf(s01) - expf(s23) + 0.2f;
    float* X = (float*)lds; float* li = (float*)(lds + 131072) + wid * 64;
    LAS unsigned char* ldsl = (LAS unsigned char*)lds;
    int koff[2], voff[2];
#pragma unroll
    for (int i = 0; i < 2; ++i) {
        const int g = i * 512 + tid;
        { const int row = g >> 4, cg = (g & 15) ^ (row & 7); koff[i] = row * EV_NP + cg * 8; }
        { const int o = g * 16, st = o >> 9, w = o & 511, kk = (st >> 2) * 8 + (w >> 6);
          const int k = (kk & ~0xC) | ((kk & 4) << 1) | ((kk & 8) >> 1), cc = (st & 3) * 32 + ((w & 63) >> 4) * 8; voff[i] = k * EV_NP + cc; }
    }
    const int vbase = (int)(uintptr_t)lds + v_rd_base(lane);
    const int map = wid >> 2, wq = wid & 3;
    unsigned char* Qs = lds + 98304 + wid * 4096 + lane * 16;
    const int vblk = (gridDim.x % 8 == 0) ? (int)((blockIdx.x & 7) * (gridDim.x >> 3) + (blockIdx.x >> 3)) : (int)blockIdx.x;
    for (int it = vblk; it < 2112; it += gridDim.x) {
        int b, h, NT, qrow0;
        if (it < 2048) { b = it >> 8; h = (it >> 6) & 3; const int qb = it & 63; NT = 132; qrow0 = b * SEQ + qb * 128; }
        else { const int j = it - 2048; b = j >> 3; h = (j >> 1) & 3; NT = 4; qrow0 = NLAT + b * CTXL + (j & 1) * 128; }
        bf16x8 qr[4];
        { const bf16_t* qp = proj + (size_t)(qrow0 + 32 * wq + r32) * EV_NP + h * 128 + map * 64 + hi * 8;
#pragma unroll
          for (int d0 = 0; d0 < 4; ++d0) qr[d0] = *(const bf16x8*)(qp + d0 * 16); }
        f32x16 o[4] = {}; float lsum = 0.f;
#define DDMA(j, bo) do { const bf16_t* pp_ = proj + (size_t)((j) < 4 ? NLAT + b * CTXL + 64 * (j) : b * SEQ + 64 * ((j) - 4)) * EV_NP + h * 128; \
        _Pragma("unroll") for (int i_ = 0; i_ < 2; ++i_) { \
            __builtin_amdgcn_global_load_lds((const unsigned*)(pp_ + 1024 + voff[i_]), (LAS unsigned*)(ldsl + (bo) + i_ * 8192 + wid * 1024), 16, 0, 0); \
            __builtin_amdgcn_global_load_lds((const unsigned*)(pp_ + 512 + koff[i_]), (LAS unsigned*)(ldsl + (bo) + 16384 + i_ * 8192 + wid * 1024), 16, 0, 0); } } while (0)
#define DQK(P0, P1, bo) do { P0 = (f32x16){}; P1 = (f32x16){}; const unsigned char* Ks_ = lds + (bo) + 16384; \
        _Pragma("unroll") for (int d0 = 0; d0 < 4; ++d0) { const int cb_ = (map * 64 + d0 * 16 + hi * 8) * 2; \
            const bf16x8 b0_ = *(const bf16x8*)(Ks_ + KSWZ(r32, cb_)), b1_ = *(const bf16x8*)(Ks_ + KSWZ(32 + r32, cb_)); \
            P0 = __builtin_amdgcn_mfma_f32_32x32x16_bf16(b0_, qr[d0], P0, 0, 0, 0); \
            P1 = __builtin_amdgcn_mfma_f32_32x32x16_bf16(b1_, qr[d0], P1, 0, 0, 0); } } while (0)
#define DSM(P0, P1) do { _Pragma("unroll") for (int r = 0; r < 16; ++r) { P0[r] = __builtin_amdgcn_exp2f(P0[r]); P1[r] = __builtin_amdgcn_exp2f(P1[r]); lsum += P0[r] + P1[r]; } \
        PK4(P0, 0, pa0); PK4(P0, 8, pa1); PK4(P1, 0, pa2); PK4(P1, 8, pa3); } while (0)
#define DTAIL_() asm volatile("s_waitcnt vmcnt(0)" ::: "memory"); __syncthreads(); { const int t_ = bprev; bprev = bcur; bcur = bnext; bnext = t_; }
#define DSTEP_A(N0, N1, O0, O1, j) do { if ((j) + 1 < NT) DDMA((j) + 1, bnext); \
        DQK(N0, N1, bcur); DSM(O0, O1); pv_d0(o, vbase + bprev, pa0, pa1, pa2, pa3); DTAIL_() } while (0)
#define DSTEP_B(N0, N1, O0, O1, j) do { if ((j) + 1 < NT) DDMA((j) + 1, bnext); \
        DSM(O0, O1); pv_d0(o, vbase + bprev, pa0, pa1, pa2, pa3); SBAR(); DQK(N0, N1, bcur); DTAIL_() } while (0)
        f32x16 pA0, pA1, pB0, pB1; bf16x8 pa0, pa1, pa2, pa3;
        DDMA(0, 0); DDMA(1, 32768); asm volatile("s_waitcnt vmcnt(0)" ::: "memory"); __syncthreads();
        DQK(pA0, pA1, 0);
        int bprev = 0, bcur = 32768, bnext = 65536;
        if (map == 0) {
            for (int j = 1; j + 1 < NT; j += 2) { DSTEP_A(pB0, pB1, pA0, pA1, j); DSTEP_A(pA0, pA1, pB0, pB1, j + 1); }
            DSTEP_A(pB0, pB1, pA0, pA1, NT - 1);
        } else {
            for (int j = 1; j + 1 < NT; j += 2) { DSTEP_B(pB0, pB1, pA0, pA1, j); DSTEP_B(pA0, pA1, pB0, pB1, j + 1); }
            DSTEP_B(pB0, pB1, pA0, pA1, NT - 1);
        }
        DSM(pB0, pB1); pv_d0(o, vbase + bprev, pa0, pa1, pa2, pa3);
        __syncthreads();
#undef DDMA
#undef DQK
#undef DSM
#undef DSTEP_A
#undef DSTEP_B
#undef DTAIL_
        const float lt = halfswap_add(lsum);
        if (hi == 0) li[r32] = lt;
        asm volatile("s_waitcnt lgkmcnt(0)" ::: "memory");
        float rli[16];
#pragma unroll
        for (int r = 0; r < 16; ++r) rli[r] = 1.f / li[crow(r, hi)];
        if (map == 1) {
#pragma unroll
            for (int d0 = 0; d0 < 4; ++d0)
#pragma unroll
                for (int r = 0; r < 16; ++r) X[(wq * 64 + d0 * 16 + r) * 64 + lane] = o[d0][r] * rli[r] * lam;
        }
        __syncthreads();
        if (map == 0) {
#pragma unroll
            for (int d0 = 0; d0 < 4; ++d0)
#pragma unroll
                for (int r = 0; r < 16; ++r) o[d0][r] = o[d0][r] * rli[r] - X[(wq * 64 + d0 * 16 + r) * 64 + lane];
#pragma unroll
            for (int r = 0; r < 16; ++r) {
                float ss = o[0][r] * o[0][r] + o[1][r] * o[1][r] + o[2][r] * o[2][r] + o[3][r] * o[3][r];
                ss += __shfl_xor(ss, 1); ss += __shfl_xor(ss, 2); ss += __shfl_xor(ss, 4); ss += __shfl_xor(ss, 8); ss += __shfl_xor(ss, 16);
                const float rstd = rsqrtf(ss * (1.f / 128.f) + 1e-6f) * 0.8f;
                bf16_t* mp = mix + (size_t)(qrow0 + 32 * wq + crow(r, hi)) * DM + h * 128 + r32;
#pragma unroll
                for (int d0 = 0; d0 < 4; ++d0) mp[32 * d0] = f2bf(o[d0][r] * rstd * p.diff_subln[32 * d0 + r32]);
            }
        }
        __syncthreads();
    }
}

__device__ __forceinline__ void natten_phase(const Params& p, unsigned char* lds) {
    const int tid = threadIdx.x, wid = tid >> 6, lane = tid & 63, r32 = lane & 31, hi = lane >> 5;
    const bf16_t* proj = (const bf16_t*)(p.ws + WS_PROJ);
    bf16_t* mix = (bf16_t*)(p.ws + WS_MIX);
    constexpr float L2E = 1.4426950408889634f;
    unsigned char* Vl = lds; unsigned char* Kl = lds + 32768;
    float* rpbs = (float*)(lds + 65536);
    float* li = (float*)(lds + 133120) + wid * 64;
    unsigned char* Qs = lds + 67584 + wid * 8192 + lane * 16;
    const int sr = tid >> 4, sc = (tid & 15) * 8, vst0 = v_st(sr, sc), vst1 = v_st(32 + sr, sc);
    const int vb0 = (int)(uintptr_t)Vl + v_rd_base(lane);
    const float* gkp = p.na_qk_gain + 128 + sc;
    const int vblk = (gridDim.x % 8 == 0) ? (int)((blockIdx.x & 7) * (gridDim.x >> 3) + (blockIdx.x >> 3)) : (int)blockIdx.x;
    for (int it = vblk; it < 2048; it += gridDim.x) {
        const int b = it >> 8, h = (it >> 5) & 7, rq = it & 31;
        const int grow = 4 * rq + (wid >> 1), qc = (wid & 1) * 32 + r32;
        const size_t qR = (size_t)b * SEQ + grow * 64 + qc;
        for (int i = tid; i < 465; i += NTHREADS) rpbs[i] = p.na_rpb[h * 465 + i] * L2E;
        { float ss = 0.f;
#pragma unroll
          for (int d0 = 0; d0 < 8; ++d0) { float qv[8]; unpack8(*(const bf16x8*)(proj + qR * OD_N + h * 128 + d0 * 16 + hi * 8), qv);
#pragma unroll
              for (int i = 0; i < 8; ++i) ss += qv[i] * qv[i]; }
          ss = halfswap_add(ss);
          const float rs = rsqrtf(ss * (1.f / 128.f) + 1e-6f) * 0.08838834764831845f * L2E;
#pragma unroll
          for (int d0 = 0; d0 < 8; ++d0) { float qv[8]; unpack8(*(const bf16x8*)(proj + qR * OD_N + h * 128 + d0 * 16 + hi * 8), qv);
#pragma unroll
              for (int i = 0; i < 8; ++i) qv[i] *= rs * p.na_qk_gain[d0 * 16 + hi * 8 + i];
              *(bf16x8*)(Qs + d0 * 1024) = pack8(qv); } }
        int lo = 4 * rq - 4; lo = lo < 0 ? 0 : (lo > 120 ? 120 : lo);
        int hi_r = 4 * rq + 3 - 4; hi_r = hi_r < 0 ? 0 : (hi_r > 120 ? 120 : hi_r); hi_r += 7;
        const int nlat = hi_r - lo + 1, NT = nlat + 4;
        int wsr = grow - 4; wsr = wsr < 0 ? 0 : (wsr > 120 ? 120 : wsr);
        int cst = qc - 8; cst = cst < 0 ? 0 : (cst > 48 ? 48 : cst);
        f32x16 o[4] = {}; float lsum = 0.f;
        bf16x8 vs0, vs1, ks0, ks1;
#define NLOAD(j) do { const size_t R0_ = (size_t)((j) < nlat ? b * SEQ + (lo + (j)) * 64 : NLAT + b * CTXL + 64 * ((j) - nlat)) + sr; \
        const bf16_t* pp_ = proj + R0_ * OD_N + h * 128 + sc; \
        vs0 = *(const bf16x8*)(pp_ + 2048); vs1 = *(const bf16x8*)(pp_ + 2048 + (size_t)32 * OD_N); \
        ks0 = *(const bf16x8*)(pp_ + 1024); ks1 = *(const bf16x8*)(pp_ + 1024 + (size_t)32 * OD_N); } while (0)
#define KNORM(kx) do { float f_[8]; unpack8(kx, f_); float ss_ = 0.f; _Pragma("unroll") for (int i_ = 0; i_ < 8; ++i_) ss_ += f_[i_] * f_[i_]; \
        ss_ += __shfl_xor(ss_, 1); ss_ += __shfl_xor(ss_, 2); ss_ += __shfl_xor(ss_, 4); ss_ += __shfl_xor(ss_, 8); \
        const float rs_ = rsqrtf(ss_ * (1.f / 128.f) + 1e-6f); _Pragma("unroll") for (int i_ = 0; i_ < 8; ++i_) f_[i_] *= rs_ * gkp[i_]; kx = pack8(f_); } while (0)
#define NWRITE(bf) do { KNORM(ks0); KNORM(ks1); *(bf16x8*)(Vl + (bf) * 16384 + vst0) = vs0; *(bf16x8*)(Vl + (bf) * 16384 + vst1) = vs1; \
        *(bf16x8*)(Kl + (bf) * 16384 + KSWZ(sr, sc * 2)) = ks0; *(bf16x8*)(Kl + (bf) * 16384 + KSWZ(32 + sr, sc * 2)) = ks1; } while (0)
        NLOAD(0); NWRITE(0); __syncthreads();
        for (int j = 0; j < NT; ++j) {
            if (j + 1 < NT) NLOAD(j + 1);
            const int bf = j & 1;
            const bool islat = j < nlat; const int kr = lo + j;
            const bool active = !islat || (kr >= wsr && kr <= wsr + 7);
            if (active) {
                f32x16 p0 = {}, p1 = {};
                const unsigned char* Ks = Kl + bf * 16384;
#pragma unroll
                for (int d0 = 0; d0 < 8; ++d0) { const int cb = (d0 * 16 + hi * 8) * 2;
                    const bf16x8 b0 = *(const bf16x8*)(Ks + KSWZ(r32, cb)), b1 = *(const bf16x8*)(Ks + KSWZ(32 + r32, cb));
                    const bf16x8 qd = *(const bf16x8*)(Qs + d0 * 1024);
                    p0 = __builtin_amdgcn_mfma_f32_32x32x16_bf16(b0, qd, p0, 0, 0, 0);
                    p1 = __builtin_amdgcn_mfma_f32_32x32x16_bf16(b1, qd, p1, 0, 0, 0); }
                if (islat) {
                    const float* rb = rpbs + (kr - grow + 7) * 31 + 15 - qc + 4 * hi;
                    const int mofs = 4 * hi - cst;
#pragma unroll
                    for (int r = 0; r < 16; ++r) {
                        const int kb = (r & 3) + 8 * (r >> 2);
                        const float e0 = __builtin_amdgcn_exp2f(p0[r] + rb[kb]), e1 = __builtin_amdgcn_exp2f(p1[r] + rb[32 + kb]);
                        p0[r] = ((unsigned)(kb + mofs) < 16u) ? e0 : 0.f; p1[r] = ((unsigned)(32 + kb + mofs) < 16u) ? e1 : 0.f;
                        lsum += p0[r] + p1[r]; }
                } else {
#pragma unroll
                    for (int r = 0; r < 16; ++r) { p0[r] = __builtin_amdgcn_exp2f(p0[r]); p1[r] = __builtin_amdgcn_exp2f(p1[r]); lsum += p0[r] + p1[r]; }
                }
                bf16x8 pa0, pa1, pa2, pa3;
                PK4(p0, 0, pa0); PK4(p0, 8, pa1); PK4(p1, 0, pa2); PK4(p1, 8, pa3);
                pv_d0(o, vb0 + bf * 16384, pa0, pa1, pa2, pa3);
            }
            if (j + 1 < NT) NWRITE((j + 1) & 1);
            __syncthreads();
        }
#undef NLOAD
#undef KNORM
#undef NWRITE
        const float lt = halfswap_add(lsum);
        if (hi == 0) li[r32] = lt;
        asm volatile("s_waitcnt lgkmcnt(0)" ::: "memory");
#pragma unroll
        for (int r = 0; r < 16; ++r) { const float rl = 1.f / li[crow(r, hi)];
            bf16_t* mp = mix + ((size_t)b * SEQ + grow * 64 + (wid & 1) * 32 + crow(r, hi)) * DM + h * 128 + r32;
#pragma unroll
            for (int d0 = 0; d0 < 4; ++d0) mp[32 * d0] = f2bf(o[d0][r] * rl); }
        __syncthreads();
    }
}

#define XB_TMO      128
#define XB_XCNT(j)  (256  + 64 * (j))
#define XB_XSUB(j)  (1280 + 64 * (j))
#define XB_XGEN(j)  (2304 + 64 * (j))
#define XB_TOP      3328
#define XB_TOPGEN   3392
#define XCD_BAR_WORDS 3456
#define XB_SPIN_CAP (1u << 22)
__device__ __forceinline__ unsigned xb_ld(unsigned* p)              { return __hip_atomic_load(p, __ATOMIC_RELAXED, __HIP_MEMORY_SCOPE_AGENT); }
__device__ __forceinline__ unsigned xb_add(unsigned* p, unsigned v) { return __hip_atomic_fetch_add(p, v, __ATOMIC_RELAXED, __HIP_MEMORY_SCOPE_AGENT); }
__device__ __forceinline__ unsigned xb_xcc_id() { return (unsigned)__builtin_amdgcn_s_getreg((3 << 11) | 20) & 0xFu; }
#define XB_SPIN(cond, bar) do { unsigned _sp = 0; while (cond) { __builtin_amdgcn_s_sleep(1); \
    if ((++_sp & 255u) == 0u) { if (xb_ld(&(bar)[XB_TMO])) break; if (_sp > XB_SPIN_CAP) { atomicAdd(&(bar)[XB_TMO], 1u); break; } } } } while (0)
struct XcdBarrier { unsigned* bar; unsigned x; volatile LAS unsigned* st; };
__device__ __forceinline__ XcdBarrier xcd_barrier_post(unsigned* bar, volatile LAS unsigned* st) {
    XcdBarrier b; b.bar = bar; b.x = xb_xcc_id(); b.st = st;
    if (threadIdx.x == 0) (void)xb_add(&bar[XB_XCNT(b.x)], 1u);
    return b;
}
__device__ __forceinline__ void xcd_barrier_complete(unsigned* bar, unsigned x, unsigned& nloc, unsigned& nx) {
    const unsigned G = gridDim.x * gridDim.y * gridDim.z;
    unsigned sum, cnt, mine, sp = 0u;
    for (;;) {
        sum = 0u; cnt = 0u; mine = 0u;
#pragma unroll
        for (unsigned j = 0; j < 16; ++j) { const unsigned c = xb_ld(&bar[XB_XCNT(j)]); sum += c; cnt += (c > 0u) ? 1u : 0u; mine = (j == x) ? c : mine; }
        if (sum == G) break;
        __builtin_amdgcn_s_sleep(1);
        if ((++sp & 255u) == 0u) { if (xb_ld(&bar[XB_TMO])) break; if (sp > XB_SPIN_CAP) { atomicAdd(&bar[XB_TMO], 1u); break; } }
    }
    nloc = mine > 0u ? mine : 1u; nx = cnt > 0u ? cnt : 1u;
}
__device__ __forceinline__ void xcd_barrier(const XcdBarrier& b) {
    asm volatile("s_waitcnt vmcnt(0)" ::: "memory");
    __syncthreads();
    if (threadIdx.x == 0) {
        unsigned* bar = b.bar;
        __builtin_amdgcn_s_waitcnt(0);
        unsigned nloc = b.st[0], nx = b.st[1];
        if (nloc == 0u) { xcd_barrier_complete(bar, b.x, nloc, nx); b.st[0] = nloc; b.st[1] = nx; }
        const unsigned old = xb_add(&bar[XB_XSUB(b.x)], 1u);
        const unsigned gen = old / nloc;
        if (old + 1u == (gen + 1u) * nloc) {
            __builtin_amdgcn_fence(__ATOMIC_RELEASE, "agent");
            asm volatile("s_waitcnt vmcnt(0)" ::: "memory");
            const unsigned og = xb_add(&bar[XB_TOP], 1u);
            const unsigned tg = og / nx;
            if (og + 1u == (tg + 1u) * nx) xb_add(&bar[XB_TOPGEN], 1u);
            else XB_SPIN(xb_ld(&bar[XB_TOPGEN]) == tg, bar);
            __builtin_amdgcn_fence(__ATOMIC_ACQUIRE, "agent");
            xb_add(&bar[XB_XGEN(b.x)], 1u);
            asm volatile("s_waitcnt vmcnt(0)" ::: "memory");
        } else {
            XB_SPIN(xb_ld(&bar[XB_XGEN(b.x)]) == gen, bar);
            __builtin_amdgcn_fence(__ATOMIC_ACQUIRE, "agent");
            asm volatile("s_waitcnt vmcnt(0)" ::: "memory");
        }
    }
    __syncthreads();
}

#ifndef PROBE_REP
#define PROBE_REP 0
#endif
#define REP(k) for (int rep_ = 0; rep_ < (((PROBE_REP >> (k)) & 1) ? 2 : 1); ++rep_)
constexpr int NPH = 18;
__global__ void __launch_bounds__(NTHREADS, 2) fwd_megakernel(Params p) {
    extern __shared__ __attribute__((aligned(16))) unsigned char lds[];
    cg::grid_group grid = cg::this_grid();
    LAS unsigned char* ldsl = (LAS unsigned char*)lds;
    const int lo = p.ph_lo, hi = p.ph_hi;
#ifdef ONLY_PH
#define IN(k) (((ONLY_PH >> (k)) & 1) && lo <= (k) && (k) < hi)
#else
#define IN(k) (lo <= (k) && (k) < hi)
#endif
#define SEAM(k) do { if (IN(k) && IN((k) + 1)) { if ((k) == 0) grid.sync(); else { XcdBarrier xb_; xb_.bar = (unsigned*)(p.ws + WS_BAR); xb_.x = xb_xcc_id(); xb_.st = (volatile LAS unsigned*)(ldsl + 135168); xcd_barrier(xb_); } } } while (0)
    unsigned char* ws = p.ws;
    const bf16_t* H = (const bf16_t*)(ws + WS_H);
    bf16_t* PROJ = (bf16_t*)(ws + WS_PROJ);
    const bf16_t* MIX = (const bf16_t*)(ws + WS_MIX);
    float* CTXRES = (float*)(ws + WS_CTXRES);
    const float* MOD = (const float*)(ws + WS_MOD);
    const int G = gridDim.x, c = blockIdx.x;
    if (threadIdx.x < 4) ((volatile LAS unsigned*)(ldsl + 135168))[threadIdx.x] = 0u;
    __syncthreads();
    (void)xcd_barrier_post((unsigned*)(ws + WS_BAR), (volatile LAS unsigned*)(ldsl + 135168));

    if (IN(0)) REP(0) { ada_phase(p, lds); wconv_phase(p, lds);
        { float* rc = (float*)(ws + WS_ROPE); float* rs = rc + SEQ * 32;
          for (int e = blockIdx.x * NTHREADS + threadIdx.x; e < SEQ * 32; e += gridDim.x * NTHREADS) { const int t = e >> 5, pp = e & 31;
              const float inv = powf(10000.f, -(float)(pp & 15) / 16.f); const float ang = (pp < 16 ? (float)(t >> 6) : (float)(t & 63)) * inv;
              rc[e] = cosf(ang); rs[e] = sinf(ang); } } }
    SEAM(0);
    if (IN(1)) REP(1) norm_phase(p, p.x, p.ctx, 0, 0, MTOT);
    SEAM(1);
    if (IN(2)) REP(2) { pg8::Gemm g{H, (const bf16_t*)(ws + WS_W_EVIN), MTOT, EV_NP, DM}; pg8::StaticOrder S; S.init(MTOT, EV_NP, G, c);
        pg8::EpiBf16 E{PROJ, EV_NP}; pg8::gemm_phase(ldsl, g, S, E); }
    SEAM(2);
    if (IN(3)) prep0_phase(p);
    SEAM(3);
    if (IN(4)) REP(4) gdn_pre_phase(p, lds);
    SEAM(4);
    if (IN(5)) {
#ifndef SKIP_SCAN
        REP(20) { gdn_scan_phase(p, lds); __syncthreads(); }
#endif
#ifndef SKIP_DA
        REP(5) { diffattn_phase(p, lds); __syncthreads(); }
#endif
    }
    SEAM(5);
    if (IN(6)) REP(6) gdn_post_phase(p);
    SEAM(6);
    if (IN(7)) REP(7) { pg8::Gemm g{MIX, (const bf16_t*)(ws + WS_W_EVOUT), MTOT, DM, DM}; pg8::StaticOrder S; S.init(MTOT, DM, G, c);
        pg8::EpiResid E{p.x, p.ctx, p.out, CTXRES, MOD, 2048}; pg8::gemm_phase(ldsl, g, S, E); }
    SEAM(7);
    if (IN(8)) norm_phase(p, p.out, CTXRES, 0, 1, MTOT);
    SEAM(8);
    if (IN(9)) REP(9) { pg8::Gemm g{H, (const bf16_t*)(ws + WS_W_FFIN), MTOT, 2 * FF, DM}; pg8::StaticOrder S; S.init(MTOT, 2 * FF, G, c);
        pg8::EpiSwiglu E{PROJ, FF}; pg8::gemm_phase(ldsl, g, S, E); }
    SEAM(9);
    if (IN(10)) { pg8::Gemm g{PROJ, (const bf16_t*)(ws + WS_W_FFOUT), MTOT, DM, FF}; pg8::StaticOrder S; S.init(MTOT, DM, G, c);
        pg8::EpiResid E{p.out, CTXRES, p.out, CTXRES, MOD, 5120}; pg8::gemm_phase(ldsl, g, S, E); }
    SEAM(10);
    if (IN(11)) norm_phase(p, p.out, CTXRES, 1, 0, MTOT);
    SEAM(11);
    if (IN(12)) { pg8::Gemm g{H, (const bf16_t*)(ws + WS_W_ODIN), MTOT, OD_N, DM}; pg8::StaticOrder S; S.init(MTOT, OD_N, G, c);
        pg8::EpiBf16 E{PROJ, OD_N}; pg8::gemm_phase(ldsl, g, S, E); }
    SEAM(12);
    if (IN(13)) { natten_phase(p, lds); if ((PROBE_REP >> 13) & 1) { __syncthreads(); natten_phase(p, lds); } }
    SEAM(13);
    if (IN(14)) { pg8::Gemm g{MIX, (const bf16_t*)(ws + WS_W_ODOUT), NLAT, DM, DM}; pg8::StaticOrder S; S.init(NLAT, DM, G, c);
        pg8::EpiResid E{p.out, CTXRES, p.out, CTXRES, MOD + 9 * 6144, 2048}; pg8::gemm_phase(ldsl, g, S, E); }
    SEAM(14);
    if (IN(15)) norm_phase(p, p.out, CTXRES, 1, 1, NLAT);
    SEAM(15);
    if (IN(16)) { pg8::Gemm g{H, (const bf16_t*)(ws + WS_W_FFIN) + (size_t)2 * FF * DM, NLAT, 2 * FF, DM}; pg8::StaticOrder S; S.init(NLAT, 2 * FF, G, c);
        pg8::EpiSwiglu E{PROJ, FF}; pg8::gemm_phase(ldsl, g, S, E); }
    SEAM(16);
    if (IN(17)) { pg8::Gemm g{PROJ, (const bf16_t*)(ws + WS_W_FFOUT) + (size_t)DM * FF, NLAT, DM, FF}; pg8::StaticOrder S; S.init(NLAT, DM, G, c);
        pg8::EpiResid E{p.out, CTXRES, p.out, CTXRES, MOD + 9 * 6144, 5120}; pg8::gemm_phase(ldsl, g, S, E); }
#undef IN
#undef SEAM
}

extern "C" void kernel_launch(void* const* d_in, const int* in_sizes, int n_in, void* d_out, int out_size, void* d_ws, size_t ws_size, hipStream_t stream) {
    static int grid = 0;
    if (grid == 0) {
        if (n_in != 23 || ws_size < WS_END) { fprintf(stderr, "kernel_launch: n_in %d ws %zu (need %zu)\n", n_in, ws_size, (size_t)WS_END); grid = -1; return; }
        int dev = 0, cus = 0, per_cu = 0;
        hipGetDevice(&dev); hipDeviceGetAttribute(&cus, hipDeviceAttributeMultiprocessorCount, dev);
        if (hipFuncSetAttribute((const void*)fwd_megakernel, hipFuncAttributeMaxDynamicSharedMemorySize, LDS_BYTES) != hipSuccess) { fprintf(stderr, "hipFuncSetAttribute failed\n"); grid = -1; return; }
        if (hipOccupancyMaxActiveBlocksPerMultiprocessor(&per_cu, (const void*)fwd_megakernel, NTHREADS, LDS_BYTES) != hipSuccess || per_cu < 1) per_cu = 1;
        (void)hipGetLastError();
        grid = cus * 1;
    }
    if (grid < 0) return;
    if (hipMemsetAsync((char*)d_ws + WS_BAR, 0, 16384, stream) != hipSuccess) { fprintf(stderr, "memset failed\n"); return; }
    Params p{};
    const float** pp = (const float**)&p;
    for (int i = 0; i < 23; ++i) pp[i] = (const float*)d_in[i];
    p.out = (float*)d_out; p.ws = (unsigned char*)d_ws;
#if N_LAUNCH_MODE == 1
    p.ph_lo = 0; p.ph_hi = NPH;
    void* args[] = {&p};
    hipError_t e = hipLaunchCooperativeKernel((void*)fwd_megakernel, dim3(grid), dim3(NTHREADS), args, LDS_BYTES, stream);
    if (e != hipSuccess) fprintf(stderr, "cooperative launch failed: %s (grid %d)\n", hipGetErrorString(e), grid);
#else
    for (int k = 0; k < NPH; ++k) { p.ph_lo = k; p.ph_hi = k + 1;
        hipLaunchKernelGGL(fwd_megakernel, dim3(grid), dim3(NTHREADS), LDS_BYTES, stream, p); }
#endif
}
```

```cpp
#include <hip/hip_runtime.h>
#include <hip/hip_cooperative_groups.h>
#include <cstdio>
#include <cstdint>
namespace cg = cooperative_groups;

#define LAS __attribute__((address_space(3)))
typedef unsigned short bf16_t;
typedef short bf16x8 __attribute__((ext_vector_type(8)));
typedef short s16x4 __attribute__((ext_vector_type(4)));
typedef float f32x4 __attribute__((ext_vector_type(4)));
typedef float f32x16 __attribute__((ext_vector_type(16)));
typedef unsigned u32x4 __attribute__((ext_vector_type(4)));
typedef unsigned u32x2 __attribute__((ext_vector_type(2)));

#ifndef N_LAUNCH_MODE
#define N_LAUNCH_MODE 1
#endif

constexpr int DM = 1024, NLAT = 65536, NCTX = 2048, MTOT = NLAT + NCTX, SEQ = 8192, CTXL = 256, FF = 2816;
constexpr int EV_N = 3600, EV_NP = 3840, OD_N = 3072;
constexpr int NCHUNKP = 64 * 132;
constexpr int NTHREADS = 512;
constexpr int LDS_BYTES = 135168 + 16;

constexpr size_t al256(size_t x) { return (x + 255) / 256 * 256; }
constexpr size_t WS_W_EVIN = 0;
constexpr size_t WS_W_EVOUT = WS_W_EVIN + al256((size_t)EV_NP * DM * 2);
constexpr size_t WS_W_ODIN = WS_W_EVOUT + al256((size_t)DM * DM * 2);
constexpr size_t WS_W_ODOUT = WS_W_ODIN + al256((size_t)OD_N * DM * 2);
constexpr size_t WS_W_FFIN = WS_W_ODOUT + al256((size_t)DM * DM * 2);
constexpr size_t WS_W_FFOUT = WS_W_FFIN + al256((size_t)2 * 2 * FF * DM * 2);
constexpr size_t WS_MOD = WS_W_FFOUT + al256((size_t)2 * DM * FF * 2);
constexpr size_t WS_H = WS_MOD + al256((size_t)2 * 9 * 6144 * 4);
constexpr size_t WS_PROJ = WS_H + al256((size_t)MTOT * DM * 2);
constexpr size_t WS_MIX = WS_PROJ + al256((size_t)MTOT * EV_NP * 2);
constexpr size_t WS_T = WS_MIX + al256((size_t)MTOT * DM * 2);
constexpr size_t WS_AQK = WS_T + al256((size_t)NCHUNKP * 4096 * 2);
constexpr size_t WS_GV = WS_AQK + al256((size_t)NCHUNKP * 4096 * 2);
constexpr size_t WS_BV = WS_GV + al256((size_t)NCHUNKP * 64 * 4);
constexpr size_t WS_EL = WS_BV + al256((size_t)NCHUNKP * 64 * 4);
constexpr size_t WS_GATES = WS_EL + al256((size_t)NCHUNKP * 64 * 4);
constexpr size_t WS_CTXRES = WS_GATES + al256((size_t)MTOT * 16 * 4);
constexpr size_t WS_BAR = WS_CTXRES + al256((size_t)NCTX * DM * 4);
constexpr size_t WS_ROPE = WS_BAR + 16384;
constexpr size_t WS_END = WS_ROPE + (size_t)2 * SEQ * 32 * 4;

struct Params {
    const float *x, *c, *ctx, *c_ctx, *ada_w, *ada_b, *norm_mix, *norm_ffn, *ffn_w_in, *ffn_w_out, *even_w_in, *even_w_out,
        *diff_qk_gain, *diff_lambda, *diff_subln, *gdn_conv, *gdn_a_log, *gdn_dt_bias, *gdn_norm, *odd_w_in, *odd_w_out, *na_qk_gain, *na_rpb;
    float* out; unsigned char* ws; int ph_lo, ph_hi;
};

__device__ __forceinline__ float bf2f(bf16_t b) { return __uint_as_float(((unsigned)b) << 16); }
__device__ __forceinline__ bf16_t f2bf(float f) { unsigned u = __float_as_uint(f); u += 0x7FFFu + ((u >> 16) & 1u); return (bf16_t)(u >> 16); }
__device__ __forceinline__ unsigned cvtpk(float lo, float hi) { unsigned r; asm volatile("v_cvt_pk_bf16_f32 %0, %1, %2" : "=v"(r) : "v"(lo), "v"(hi)); return r; }
__device__ __forceinline__ float siluf(float v) { return v / (1.f + __expf(-v)); }
__device__ __forceinline__ void unpack8(bf16x8 v, float* f) {
#pragma unroll
    for (int i = 0; i < 8; ++i) f[i] = bf2f((bf16_t)v[i]);
}
__device__ __forceinline__ bf16x8 pack8(const float* f) {
    u32x4 w = {cvtpk(f[0], f[1]), cvtpk(f[2], f[3]), cvtpk(f[4], f[5]), cvtpk(f[6], f[7])};
    return *reinterpret_cast<bf16x8*>(&w);
}

namespace pg8 {
constexpr int BM = 256, BK = 64, HALF = 128, HTB = HALF * BK * 2, STAGE_BYTES = 8 * HTB, NXCD = 8, WGM = 8;
__host__ __device__ __forceinline__ int lds_byte(int r, int c) { const int st = (r >> 4) * 2 + (c >> 5), rr = r & 15, cc = c & 31, ob = rr * 64 + cc * 2; return st * 1024 + (ob ^ (((ob >> 9) & 1) << 5)); }
__host__ __device__ __forceinline__ void stage_rc(int b, int& R, int& C) { const int st = b / 1024, sb = b % 1024, swz = sb ^ (((sb >> 9) & 1) << 5); R = (st >> 1) * 16 + swz / 64; C = (st & 1) * 32 + (swz % 64) / 2; }
__host__ __device__ __forceinline__ int perm32(int rho) { const int n = rho >> 4, i = rho & 15; return 8 * (i >> 2) + 4 * n + (i & 3); }
struct Unit { int pm, pn; };
struct Gemm { const bf16_t* A; const bf16_t* Bt; int M, N, K; };
struct StaticOrder {
    int nM, nN, nwg, G, c;
    __device__ void init(int M, int N, int G_, int c_) { nM = M / BM; nN = N / BM; nwg = nM * nN; G = G_; c = c_; }
    __device__ bool next(int i, Unit& u) const {
        const long L = (long)i * G + c; if (L >= nwg) return false;
        int wgid = (int)L; { const int q = nwg / NXCD, r = nwg % NXCD, xcd = wgid % NXCD, off = wgid / NXCD; wgid = (xcd < r ? xcd * (q + 1) : r * (q + 1) + (xcd - r) * q) + off; }
        const int nig = WGM * nN, gid = wgid / nig, fm = gid * WGM, gsz = (nM - fm) < WGM ? (nM - fm) : WGM;
        u.pm = fm + ((wgid % nig) % gsz); u.pn = (wgid % nig) / gsz; return true;
    }
};
struct EpiBf16 {
    static constexpr bool PERM = true;
    bf16_t* O; int ldc;
    __device__ __forceinline__ void operator()(const f32x4 (&acc)[2][2][4][2], const Unit& u, int wr, int wc, int fr, int fq) const {
        const int row0 = u.pm * BM + wr * 64 + fr; const int col0 = u.pn * BM + wc * 32 + 8 * fq;
#pragma unroll
        for (int ai = 0; ai < 2; ++ai)
#pragma unroll
            for (int m = 0; m < 4; ++m) { bf16_t* rowp = O + (size_t)(row0 + ai * HALF + m * 16) * ldc + col0;
#pragma unroll
                for (int bj = 0; bj < 2; ++bj) { const f32x4 v0 = acc[ai][bj][m][0], v1 = acc[ai][bj][m][1];
                    u32x4 w; w.x = cvtpk(v0[0], v0[1]); w.y = cvtpk(v0[2], v0[3]); w.z = cvtpk(v1[0], v1[1]); w.w = cvtpk(v1[2], v1[3]);
                    *(u32x4*)(rowp + bj * HALF) = w; } }
    }
};
struct EpiSwiglu {
    static constexpr bool PERM = true;
    bf16_t* O; int ldc;
    __device__ __forceinline__ void operator()(const f32x4 (&acc)[2][2][4][2], const Unit& u, int wr, int wc, int fr, int fq) const {
        const int row0 = u.pm * BM + wr * 64 + fr; const int col0 = u.pn * HALF + wc * 32 + 8 * fq;
#pragma unroll
        for (int ai = 0; ai < 2; ++ai)
#pragma unroll
            for (int m = 0; m < 4; ++m) { bf16_t* rowp = O + (size_t)(row0 + ai * HALF + m * 16) * ldc + col0;
                float o[8];
#pragma unroll
                for (int n = 0; n < 2; ++n)
#pragma unroll
                    for (int j = 0; j < 4; ++j) { const float g = acc[ai][0][m][n][j], up = acc[ai][1][m][n][j]; o[n * 4 + j] = g * __builtin_amdgcn_rcpf(1.f + __expf(-g)) * up; }
                u32x4 w; w.x = cvtpk(o[0], o[1]); w.y = cvtpk(o[2], o[3]); w.z = cvtpk(o[4], o[5]); w.w = cvtpk(o[6], o[7]);
                *(u32x4*)rowp = w; }
    }
};
struct EpiResid {
    static constexpr bool PERM = false;
    const float* resLat; const float* resCtx; float* outLat; float* outCtx; const float* modl; int goff;
    __device__ __forceinline__ void operator()(const f32x4 (&acc)[2][2][4][2], const Unit& u, int wr, int wc, int fr, int fq) const {
        const int rowt = u.pm * BM; const bool lat = rowt < NLAT;
        const float* res = lat ? resLat + (size_t)rowt * DM : resCtx + (size_t)(rowt - NLAT) * DM;
        float* out = lat ? outLat + (size_t)rowt * DM : outCtx + (size_t)(rowt - NLAT) * DM;
        const float* gate = modl + (size_t)(lat ? (rowt >> 13) : 8) * 6144 + goff;
        const int row0 = wr * 64 + fr, col0 = u.pn * BM + wc * 32 + 4 * fq;
        f32x4 gv[2][2];
#pragma unroll
        for (int bj = 0; bj < 2; ++bj)
#pragma unroll
            for (int n = 0; n < 2; ++n) gv[bj][n] = *(const f32x4*)(gate + col0 + bj * HALF + n * 16);
#pragma unroll
        for (int ai = 0; ai < 2; ++ai)
#pragma unroll
            for (int m = 0; m < 4; ++m) { const size_t off = (size_t)(row0 + ai * HALF + m * 16) * DM + col0;
#pragma unroll
                for (int bj = 0; bj < 2; ++bj)
#pragma unroll
                    for (int n = 0; n < 2; ++n) { const f32x4 r = *(const f32x4*)(res + off + bj * HALF + n * 16);
                        *(f32x4*)(out + off + bj * HALF + n * 16) = r + gv[bj][n] * acc[ai][bj][m][n]; } }
    }
};

template <class Epi, class Sched>
__device__ __forceinline__ void gemm_phase(LAS unsigned char* lds, const Gemm g, const Sched& S, const Epi& E) {
    const int tid = threadIdx.x, wid = __builtin_amdgcn_readfirstlane(tid >> 6), lane = tid & 63, wr = wid >> 2, wc = wid & 3, fr = lane & 15, fq = lane >> 4;
    const int K = g.K, nt = K / BK;
    unsigned voffA[2], voffB[2];
#pragma unroll
    for (int i = 0; i < 2; ++i) { int R, C; stage_rc(tid * 16 + i * 8192, R, C); const int Rb = Epi::PERM ? ((R & ~31) + perm32(R & 31)) : R;
        voffA[i] = (unsigned)(R * K + C) * 2u; voffB[i] = (unsigned)(Rb * K + C) * 2u; }
    const size_t kstep = (size_t)(BK * 2);
    const size_t hstep = (size_t)HALF * K * 2;
    const size_t tstep = 2 * hstep;
    const unsigned ldsw = (unsigned)wid * 1024u;
    const int aoff = lds_byte(wr * 64 + fr, fq * 8), boff = lds_byte(wc * 32 + fr, fq * 8);
#define PG8_SA(b, h) (((b) * 2 + (h)) * HTB)
#define PG8_SB(b, h) ((4 + (b) * 2 + (h)) * HTB)
#define PG8_STAGE(bufoff, gbase, voff) do { _Pragma("unroll") for (int _i = 0; _i < 2; ++_i) \
        __builtin_amdgcn_global_load_lds((const unsigned*)((const char*)(gbase) + (voff)[_i]), (LAS unsigned*)(lds + (bufoff) + ldsw + _i * 8192), 16, 0, 0); } while (0)
#define PG8_LDA(dst, b, h) do { _Pragma("unroll") for (int m = 0; m < 4; ++m) _Pragma("unroll") for (int k = 0; k < 2; ++k) dst[m][k] = *(const LAS bf16x8*)(lds + PG8_SA(b, h) + aoff + m * 2048 + k * 1024); } while (0)
#define PG8_LDB(dst, b, h) do { _Pragma("unroll") for (int n = 0; n < 2; ++n) _Pragma("unroll") for (int k = 0; k < 2; ++k) dst[n][k] = *(const LAS bf16x8*)(lds + PG8_SB(b, h) + boff + n * 2048 + k * 1024); } while (0)
#define PG8_MMA(ai, bj, At, Bt) do { __builtin_amdgcn_s_setprio(1); _Pragma("unroll") for (int m = 0; m < 4; ++m) _Pragma("unroll") for (int n = 0; n < 2; ++n) _Pragma("unroll") for (int k = 0; k < 2; ++k) \
        acc[ai][bj][m][n] = __builtin_amdgcn_mfma_f32_16x16x32_bf16(Bt[n][k], At[m][k], acc[ai][bj][m][n], 0, 0, 0); __builtin_amdgcn_s_setprio(0); } while (0)
#define PG8_WAIT_V(n) asm volatile("s_waitcnt vmcnt(" #n ")" ::: "memory")
#define PG8_WAIT_L(n) asm volatile("s_waitcnt lgkmcnt(" #n ")" ::: "memory")
#define PG8_BAR __builtin_amdgcn_s_barrier()
#define PG8_SCHED __builtin_amdgcn_sched_barrier(0)
    Unit cur, nxt; int ui = 0;
    if (!S.next(0, cur)) return;
    f32x4 acc[2][2][4][2];
#pragma unroll
    for (int a = 0; a < 2; ++a)
#pragma unroll
        for (int b = 0; b < 2; ++b)
#pragma unroll
            for (int m = 0; m < 4; ++m)
#pragma unroll
                for (int n = 0; n < 2; ++n) acc[a][b][m][n] = (f32x4){0.f, 0.f, 0.f, 0.f};
    bf16x8 At[4][2], B0[2][2], B1[2][2];
    const char* cA = (const char*)g.A + (size_t)cur.pm * tstep; const char* cB = (const char*)g.Bt + (size_t)cur.pn * tstep;
    PG8_STAGE(PG8_SB(0, 0), cB, voffB); PG8_STAGE(PG8_SA(0, 0), cA, voffA); PG8_STAGE(PG8_SB(0, 1), cB + hstep, voffB); PG8_STAGE(PG8_SA(0, 1), cA + hstep, voffA);
    if (wr == 1) PG8_BAR;
    PG8_WAIT_V(4); PG8_BAR;
    PG8_STAGE(PG8_SB(1, 0), cB + kstep, voffB); PG8_STAGE(PG8_SA(1, 0), cA + kstep, voffA); PG8_STAGE(PG8_SB(1, 1), cB + hstep + kstep, voffB);
    PG8_WAIT_V(6); PG8_BAR;
    for (;;) {
        const bool has_next = S.next(ui + 1, nxt);
        const char* nA = has_next ? (const char*)g.A + (size_t)nxt.pm * tstep : cA; const char* nB = has_next ? (const char*)g.Bt + (size_t)nxt.pn * tstep : cB;
        for (int t = 0; t < nt; t += 2) {
            const bool last = (t == nt - 2);
            const char* a1 = cA + (size_t)(t + 1) * kstep;
            const char* a2 = last ? nA : cA + (size_t)(t + 2) * kstep; const char* b2 = last ? nB : cB + (size_t)(t + 2) * kstep;
            const char* a3 = a2 + kstep; const char* b3 = b2 + kstep;
            PG8_LDB(B0, 0, 0); PG8_SCHED; PG8_LDA(At, 0, 0); PG8_STAGE(PG8_SA(1, 1), a1 + hstep, voffA);
            PG8_WAIT_L(8); PG8_BAR; PG8_WAIT_L(0); PG8_MMA(0, 0, At, B0); PG8_BAR; PG8_SCHED;
            PG8_LDB(B1, 0, 1); PG8_STAGE(PG8_SB(0, 0), b2, voffB);
            PG8_BAR; PG8_WAIT_L(0); PG8_MMA(0, 1, At, B1); PG8_BAR;
            PG8_LDA(At, 0, 1); PG8_STAGE(PG8_SA(0, 0), a2, voffA);
            PG8_BAR; PG8_WAIT_L(0); PG8_MMA(1, 0, At, B0); PG8_BAR; PG8_SCHED;
            PG8_STAGE(PG8_SB(0, 1), b2 + hstep, voffB);
            PG8_WAIT_V(6); PG8_BAR; PG8_MMA(1, 1, At, B1); PG8_BAR;
            PG8_LDB(B0, 1, 0); PG8_SCHED; PG8_LDA(At, 1, 0); PG8_STAGE(PG8_SA(0, 1), a2 + hstep, voffA);
            PG8_WAIT_L(8); PG8_BAR; PG8_WAIT_L(0); PG8_MMA(0, 0, At, B0); PG8_BAR; PG8_SCHED;
            PG8_LDB(B1, 1, 1); PG8_STAGE(PG8_SB(1, 0), b3, voffB);
            PG8_BAR; PG8_WAIT_L(0); PG8_MMA(0, 1, At, B1); PG8_BAR;
            PG8_LDA(At, 1, 1); PG8_STAGE(PG8_SA(1, 0), a3, voffA);
            PG8_BAR; PG8_WAIT_L(0); PG8_MMA(1, 0, At, B0); PG8_BAR; PG8_SCHED;
            PG8_STAGE(PG8_SB(1, 1), b3 + hstep, voffB);
            PG8_WAIT_V(6); PG8_BAR; PG8_MMA(1, 1, At, B1); PG8_BAR;
        }
        E(acc, cur, wr, wc, fr, fq);
        if (!has_next) break;
#pragma unroll
        for (int a = 0; a < 2; ++a)
#pragma unroll
            for (int b = 0; b < 2; ++b)
#pragma unroll
                for (int m = 0; m < 4; ++m)
#pragma unroll
                    for (int n = 0; n < 2; ++n) acc[a][b][m][n] = (f32x4){0.f, 0.f, 0.f, 0.f};
        cur = nxt; cA = nA; cB = nB; ++ui;
    }
    PG8_WAIT_V(0);
    if (wr == 0) PG8_BAR;
    PG8_BAR;
#undef PG8_SA
#undef PG8_SB
#undef PG8_STAGE
#undef PG8_LDA
#undef PG8_LDB
#undef PG8_MMA
#undef PG8_WAIT_V
#undef PG8_WAIT_L
#undef PG8_BAR
#undef PG8_SCHED
}
}

#define KSWZ(row, colB) ((row) * 256 + ((colB) ^ (((row) & 7) << 4)))
#define SBAR() __builtin_amdgcn_sched_barrier(0)
__device__ __forceinline__ int crow(int r, int hi) { return (r & 3) + 8 * (r >> 2) + 4 * hi; }
__device__ __forceinline__ int v_st(int k, int c) { const int kk = (k & ~0xC) | ((k & 4) << 1) | ((k & 8) >> 1); return ((kk >> 3) * 4 + (c >> 5)) * 512 + ((kk & 7) * 32 + (c & 31)) * 2; }
__device__ __forceinline__ int v_rd_base(int lane) { return ((lane & 3) << 3) | (((lane >> 2) & 3) << 6) | (((lane >> 4) & 1) << 5) | (((lane >> 5) & 1) << 8); }
constexpr int v_rd_off(int d0, int ks, int half) { return d0 * 512 + ks * 4096 + half * 2048; }
template <int OFF> __device__ __forceinline__ s16x4 tr_read(int vb) {
    s16x4 r; asm volatile("ds_read_b64_tr_b16 %0, %1 offset:%2" : "=&v"(r) : "v"(vb), "i"(OFF) : "memory"); return r;
}
template <int D0> __device__ __forceinline__ void pv_one(f32x16& od, int vb, bf16x8 pa0, bf16x8 pa1, bf16x8 pa2, bf16x8 pa3) {
    const s16x4 l0 = tr_read<v_rd_off(D0, 0, 0)>(vb), h0 = tr_read<v_rd_off(D0, 0, 1)>(vb), l1 = tr_read<v_rd_off(D0, 1, 0)>(vb), h1 = tr_read<v_rd_off(D0, 1, 1)>(vb);
    const s16x4 l2 = tr_read<v_rd_off(D0, 2, 0)>(vb), h2 = tr_read<v_rd_off(D0, 2, 1)>(vb), l3 = tr_read<v_rd_off(D0, 3, 0)>(vb), h3 = tr_read<v_rd_off(D0, 3, 1)>(vb);
    asm volatile("s_waitcnt lgkmcnt(0)" ::: "memory"); SBAR();
#define PK(L, H) (bf16x8){L[0], L[1], L[2], L[3], H[0], H[1], H[2], H[3]}
    od = __builtin_amdgcn_mfma_f32_32x32x16_bf16(pa0, PK(l0, h0), od, 0, 0, 0);
    od = __builtin_amdgcn_mfma_f32_32x32x16_bf16(pa1, PK(l1, h1), od, 0, 0, 0);
    od = __builtin_amdgcn_mfma_f32_32x32x16_bf16(pa2, PK(l2, h2), od, 0, 0, 0);
    od = __builtin_amdgcn_mfma_f32_32x32x16_bf16(pa3, PK(l3, h3), od, 0, 0, 0);
#undef PK
}
__device__ __forceinline__ void pv_d0(f32x16* o, int vb, bf16x8 pa0, bf16x8 pa1, bf16x8 pa2, bf16x8 pa3) {
    pv_one<0>(o[0], vb, pa0, pa1, pa2, pa3); pv_one<1>(o[1], vb, pa0, pa1, pa2, pa3); pv_one<2>(o[2], vb, pa0, pa1, pa2, pa3); pv_one<3>(o[3], vb, pa0, pa1, pa2, pa3);
}
#define PK4(P, BASE, OUT) do { unsigned a0 = cvtpk(P[BASE + 0], P[BASE + 1]), a1 = cvtpk(P[BASE + 2], P[BASE + 3]);   \
    unsigned b0 = cvtpk(P[BASE + 4], P[BASE + 5]), b1 = cvtpk(P[BASE + 6], P[BASE + 7]);                              \
    auto r0 = __builtin_amdgcn_permlane32_swap(a0, b0, false, false); auto r1 = __builtin_amdgcn_permlane32_swap(a1, b1, false, false); \
    u32x4 w = {r0[0], r1[0], r0[1], r1[1]}; OUT = *reinterpret_cast<bf16x8*>(&w); } while (0)
__device__ __forceinline__ float halfswap_add(float v) {
    auto rr = __builtin_amdgcn_permlane32_swap(__float_as_uint(v), __float_as_uint(v), false, false);
    return __uint_as_float(rr[0]) + __uint_as_float(rr[1]);
}

__device__ __forceinline__ void ada_phase(const Params& p, unsigned char* lds) {
    float* sc = (float*)lds;
    float* red = (float*)(lds + 40960);
    float* mod = (float*)(p.ws + WS_MOD);
    const int tid = threadIdx.x;
    for (int j = blockIdx.x; j < 192; j += gridDim.x) {
        const int l = j / 96, n0 = (j % 96) * 64;
        for (int i = tid; i < 9 * 1024; i += NTHREADS) { const int r = i >> 10, k = i & 1023; const float v = r < 8 ? p.c[r * 1024 + k] : p.c_ctx[k]; sc[i] = v / (1.f + expf(-v)); }
        __syncthreads();
        const int col = tid & 63, ks = tid >> 6;
        float acc[9];
#pragma unroll
        for (int r = 0; r < 9; ++r) acc[r] = 0.f;
        const float* wp = p.ada_w + ((size_t)l * 1024 + ks * 128) * 6144 + n0 + col;
#pragma unroll 8
        for (int kk = 0; kk < 128; ++kk) { const float w = wp[(size_t)kk * 6144];
#pragma unroll
            for (int r = 0; r < 9; ++r) acc[r] += sc[r * 1024 + ks * 128 + kk] * w; }
#pragma unroll
        for (int r = 0; r < 9; ++r) red[(ks * 9 + r) * 64 + col] = acc[r];
        __syncthreads();
        for (int i = tid; i < 576; i += NTHREADS) { const int r = i >> 6, cc = i & 63; float s = p.ada_b[l * 6144 + n0 + cc];
            for (int k2 = 0; k2 < 8; ++k2) s += red[(k2 * 9 + r) * 64 + cc];
            mod[(size_t)(l * 9 + r) * 6144 + n0 + cc] = s; }
        __syncthreads();
    }
}
__device__ __forceinline__ void wconv_phase(const Params& p, unsigned char* lds) {
    float* tl = (float*)lds;
    const int tid = threadIdx.x;
    const int T0 = 16 * 60, T1 = T0 + 16 * 16, T2 = T1 + 16 * 48, T3 = T2 + 16 * 16, T4 = T3 + 16 * 88, T5 = T4 + 16 * 88, T6 = T5 + 44 * 16, T7 = T6 + 44 * 16;
    for (int t = blockIdx.x; t < T7; t += gridDim.x) {
        const float* src; bf16_t* dst; int K, N, NP, mode = 0, tt;
        if (t < T0) { src = p.even_w_in; dst = (bf16_t*)(p.ws + WS_W_EVIN); K = 1024; N = EV_N; NP = EV_NP; tt = t; }
        else if (t < T1) { src = p.even_w_out; dst = (bf16_t*)(p.ws + WS_W_EVOUT); K = 1024; N = 1024; NP = 1024; tt = t - T0; }
        else if (t < T2) { src = p.odd_w_in; dst = (bf16_t*)(p.ws + WS_W_ODIN); K = 1024; N = OD_N; NP = OD_N; tt = t - T1; }
        else if (t < T3) { src = p.odd_w_out; dst = (bf16_t*)(p.ws + WS_W_ODOUT); K = 1024; N = 1024; NP = 1024; tt = t - T2; }
        else if (t < T4) { src = p.ffn_w_in; dst = (bf16_t*)(p.ws + WS_W_FFIN); K = 1024; N = 2 * FF; NP = 2 * FF; mode = 1; tt = t - T3; }
        else if (t < T5) { src = p.ffn_w_in + (size_t)1024 * 2 * FF; dst = (bf16_t*)(p.ws + WS_W_FFIN) + (size_t)2 * FF * 1024; K = 1024; N = 2 * FF; NP = 2 * FF; mode = 1; tt = t - T4; }
        else if (t < T6) { src = p.ffn_w_out; dst = (bf16_t*)(p.ws + WS_W_FFOUT); K = FF; N = 1024; NP = 1024; tt = t - T5; }
        else { src = p.ffn_w_out + (size_t)FF * 1024; dst = (bf16_t*)(p.ws + WS_W_FFOUT) + (size_t)1024 * FF; K = FF; N = 1024; NP = 1024; tt = t - T6; }
        const int nnt = NP / 64; const int k0 = (tt / nnt) * 64, n0 = (tt % nnt) * 64;
        int sn0;
        if (mode == 1) { const int tb = n0 >> 8, bj = (n0 >> 7) & 1, i0 = n0 & 127; sn0 = bj * FF + tb * 128 + i0; } else sn0 = n0;
        for (int e = tid; e < 4096; e += NTHREADS) { const int kk = e >> 6, nn = e & 63; const int sn = sn0 + nn;
            tl[kk * 65 + nn] = (sn < N) ? src[(size_t)(k0 + kk) * N + sn] : 0.f; }
        __syncthreads();
        for (int e = tid; e < 2048; e += NTHREADS) { const int nn = e >> 5, k2 = (e & 31) * 2;
            *(unsigned*)(dst + (size_t)(n0 + nn) * K + k0 + k2) = cvtpk(tl[k2 * 65 + nn], tl[(k2 + 1) * 65 + nn]); }
        __syncthreads();
    }
}

__device__ __forceinline__ void norm_phase(const Params& p, const float* xlat, const float* xctx, int l, int which, int nrows) {
    const int lane = threadIdx.x & 63, wid = threadIdx.x >> 6;
    bf16_t* h = (bf16_t*)(p.ws + WS_H);
    const float* mod = (const float*)(p.ws + WS_MOD) + (size_t)l * 9 * 6144;
    const float* gain = (which ? p.norm_ffn : p.norm_mix) + l * 1024;
    const int shoff = which ? 3072 : 0, scoff = which ? 4096 : 1024;
    const int stride = gridDim.x * 8;
    for (int row = blockIdx.x * 8 + wid; row < nrows; row += 2 * stride) {
        const int rowB = row + stride; const bool hasB = rowB < nrows;
        const float* srcA = row < NLAT ? xlat + (size_t)row * DM : xctx + (size_t)(row - NLAT) * DM;
        const float* srcB = hasB ? (rowB < NLAT ? xlat + (size_t)rowB * DM : xctx + (size_t)(rowB - NLAT) * DM) : srcA;
        f32x4 va[4], vb[4];
#pragma unroll
        for (int i = 0; i < 4; ++i) { va[i] = *(const f32x4*)(srcA + lane * 4 + 256 * i); vb[i] = *(const f32x4*)(srcB + lane * 4 + 256 * i); }
#pragma unroll
        for (int rr = 0; rr < 2; ++rr) {
            if (rr == 1 && !hasB) break;
            const int r = rr ? rowB : row;
            const float* mr = mod + (size_t)(r < NLAT ? (r >> 13) : 8) * 6144;
            float ss = 0.f;
#pragma unroll
            for (int i = 0; i < 4; ++i) { const f32x4 v = rr ? vb[i] : va[i]; ss += v[0] * v[0] + v[1] * v[1] + v[2] * v[2] + v[3] * v[3]; }
#pragma unroll
            for (int o = 1; o < 64; o <<= 1) ss += __shfl_xor(ss, o);
            const float rstd = rsqrtf(ss * (1.f / 1024.f) + 1e-6f);
#pragma unroll
            for (int i = 0; i < 4; ++i) { const int c0 = lane * 4 + 256 * i; const f32x4 v = rr ? vb[i] : va[i];
                const f32x4 g = *(const f32x4*)(gain + c0), s1 = *(const f32x4*)(mr + scoff + c0), sh = *(const f32x4*)(mr + shoff + c0);
                float y[4];
#pragma unroll
                for (int j = 0; j < 4; ++j) y[j] = v[j] * rstd * g[j] * (1.f + s1[j]) + sh[j];
                u32x2 w; w.x = cvtpk(y[0], y[1]); w.y = cvtpk(y[2], y[3]);
                *(u32x2*)(h + (size_t)r * DM + c0) = w; }
        }
    }
}

__device__ __forceinline__ void prep0_phase(const Params& p) {
    const int lane0 = threadIdx.x & 63, wid = threadIdx.x >> 6;
    bf16_t* proj = (bf16_t*)(p.ws + WS_PROJ);
    bf16_t* qkvp = (bf16_t*)p.out;
    float* gbuf = (float*)(p.ws + WS_GATES);
    const float* ropec = (const float*)(p.ws + WS_ROPE); const float* ropes = ropec + SEQ * 32;
    constexpr int RB = 8;
    for (int blk = blockIdx.x * 8 + wid; blk < MTOT / RB; blk += gridDim.x * 8) {
        int lane = lane0; asm volatile("" : "+v"(lane));
        const int row0 = blk * RB; const bool lat = row0 < NLAT; const int t0 = lat ? (row0 & 8191) : ((row0 - NLAT) & 255); const int len = lat ? SEQ : CTXL;
        const int dsub = (lane & 7) * 8;
        {
            float gq[8], gk[8];
#pragma unroll
            for (int i = 0; i < 8; ++i) { gq[i] = p.diff_qk_gain[dsub + i] * (0.125f * 1.4426950408889634f); gk[i] = p.diff_qk_gain[64 + dsub + i]; }
            for (int i = 0; i < RB; ++i) {
                bf16_t* P = proj + (size_t)(row0 + i) * EV_NP;
                f32x4 c4 = {1.f, 1.f, 1.f, 1.f}, s4 = {0.f, 0.f, 0.f, 0.f};
                if (lat) { c4 = *(const f32x4*)(ropec + (t0 + i) * 32 + (lane & 7) * 4); s4 = *(const f32x4*)(ropes + (t0 + i) * 32 + (lane & 7) * 4); }
#pragma unroll
                for (int which = 0; which < 2; ++which) {
                    float v[8]; unpack8(*(const bf16x8*)(P + which * 512 + lane * 8), v);
                    float ss = 0.f;
#pragma unroll
                    for (int e = 0; e < 8; ++e) ss += v[e] * v[e];
                    ss += __shfl_xor(ss, 1); ss += __shfl_xor(ss, 2); ss += __shfl_xor(ss, 4);
                    const float rstd = rsqrtf(ss * (1.f / 64.f) + 1e-6f);
#pragma unroll
                    for (int e = 0; e < 8; ++e) v[e] = v[e] * rstd * (which ? gk[e] : gq[e]);
#pragma unroll
                    for (int e = 0; e < 4; ++e) { const float x0 = v[2 * e], x1 = v[2 * e + 1]; v[2 * e] = x0 * c4[e] - x1 * s4[e]; v[2 * e + 1] = x0 * s4[e] + x1 * c4[e]; }
                    *(bf16x8*)(P + which * 512 + lane * 8) = pack8(v);
                }
            }
        }
#pragma unroll 1
        for (int g = 0; g < 3; ++g) {
            const int c0 = g * 512 + lane * 8;
            float w[5][8];
#pragma unroll
            for (int j = 0; j < 5; ++j) { const f32x4 w0 = *(const f32x4*)(p.gdn_conv + j * 1536 + c0), w1 = *(const f32x4*)(p.gdn_conv + j * 1536 + c0 + 4);
#pragma unroll
                for (int e = 0; e < 4; ++e) { w[j][e] = w0[e]; w[j][4 + e] = w1[e]; } }
            float xm2[8], xm1[8], x0[8], xp1[8], xp2[8];
            const bf16_t* src = proj + (size_t)row0 * EV_NP + 1536 + c0;
#define LDROW(dst, dt) do { if (t0 + (dt) >= 0 && t0 + (dt) < len) unpack8(*(const bf16x8*)(src + (ptrdiff_t)(dt) * EV_NP), dst); else { _Pragma("unroll") for (int e_ = 0; e_ < 8; ++e_) dst[e_] = 0.f; } } while (0)
            LDROW(xm2, -2); LDROW(xm1, -1); LDROW(x0, 0); LDROW(xp1, 1);
            const float nsc = g == 0 ? 0.08838834764831845f : 1.f;
            for (int i = 0; i < RB; ++i) {
                LDROW(xp2, i + 2);
                float y[8];
#pragma unroll
                for (int e = 0; e < 8; ++e) { y[e] = w[0][e] * xm2[e] + w[1][e] * xm1[e] + w[2][e] * x0[e] + w[3][e] * xp1[e] + w[4][e] * xp2[e]; y[e] = y[e] * __builtin_amdgcn_rcpf(1.f + __expf(-y[e])); }
                if (g < 2) { float ss = 0.f;
#pragma unroll
                    for (int e = 0; e < 8; ++e) ss += y[e] * y[e];
                    ss += __shfl_xor(ss, 1); ss += __shfl_xor(ss, 2); ss += __shfl_xor(ss, 4); ss += __shfl_xor(ss, 8);
                    const float sc_ = rsqrtf(ss + 1e-6f) * nsc;
#pragma unroll
                    for (int e = 0; e < 8; ++e) y[e] *= sc_; }
                *(bf16x8*)(qkvp + (size_t)(row0 + i) * 1536 + c0) = pack8(y);
#pragma unroll
                for (int e = 0; e < 8; ++e) { xm2[e] = xm1[e]; xm1[e] = x0[e]; x0[e] = xp1[e]; xp1[e] = xp2[e]; }
            }
#undef LDROW
        }
#pragma unroll
        for (int k = 0; k < RB / 4; ++k) { const int idx = lane + 64 * k, i = idx >> 4, gi = idx & 15;
            const float gvv = bf2f(proj[(size_t)(row0 + i) * EV_NP + 3584 + gi]); float o;
            if (gi < 8) o = 1.f / (1.f + expf(-gvv));
            else { const float z = gvv + p.gdn_dt_bias[gi - 8]; const float sp = z > 20.f ? z : log1pf(expf(z)); o = -expf(p.gdn_a_log[gi - 8]) * sp; }
            gbuf[(size_t)(row0 + i) * 16 + gi] = o; }
    }
}

__device__ __forceinline__ int gdn_row(int b, int pc, int tau, int dir) {
    const int tt = dir ? 63 - tau : tau;
    return pc < 4 ? NLAT + b * CTXL + pc * 64 + tt : b * SEQ + (pc - 4) * 64 + tt;
}
__device__ __forceinline__ void gdn_pre_phase(const Params& p, unsigned char* lds) {
    const int lane = threadIdx.x & 63, wid = threadIdx.x >> 6;
    float* Lw = (float*)(lds + wid * 16896);
    float* gs = Lw + 4096; float* bs = gs + 64;
    const bf16_t* qkvp = (const bf16_t*)p.out;
    const float* gbuf = (const float*)(p.ws + WS_GATES);
    bf16_t* Tb = (bf16_t*)(p.ws + WS_T); bf16_t* Ab = (bf16_t*)(p.ws + WS_AQK);
    float* gv = (float*)(p.ws + WS_GV); float* bv = (float*)(p.ws + WS_BV);
    const int lane0 = lane;
    for (int cp = blockIdx.x * 8 + wid; cp < NCHUNKP; cp += gridDim.x * 8) {
        int lane = lane0; asm volatile("" : "+v"(lane));
        const int r32 = lane & 31, hi = lane >> 5;
        const int pc = cp % 132, ch = cp / 132, dir = ch & 1, h = (ch >> 1) & 3, b = ch >> 3;
        { const int R = gdn_row(b, pc, lane, dir);
          float g = gbuf[(size_t)R * 16 + 8 + dir * 4 + h]; const float be = gbuf[(size_t)R * 16 + dir * 4 + h];
#pragma unroll
          for (int o = 1; o < 64; o <<= 1) { const float t = __shfl_up(g, o); if (lane >= o) g += t; }
          gs[lane] = g; bs[lane] = be; const float gl_ = __shfl(g, 63); gv[(size_t)cp * 64 + lane] = expf(g); bv[(size_t)cp * 64 + lane] = be; ((float*)(p.ws + WS_EL))[(size_t)cp * 64 + lane] = expf(gl_ - g); }
        bf16x8 kf[2][8];
#pragma unroll
        for (int mi = 0; mi < 2; ++mi) { const size_t R = (size_t)gdn_row(b, pc, 32 * mi + r32, dir);
#pragma unroll
            for (int d0 = 0; d0 < 8; ++d0) kf[mi][d0] = *(const bf16x8*)(qkvp + R * 1536 + 512 + h * 128 + d0 * 16 + hi * 8); }
        bf16_t* Ao = Ab + (size_t)cp * 4096;
#pragma unroll
        for (int mi = 0; mi < 2; ++mi) {
            bf16x8 qf[8];
            { const size_t R = (size_t)gdn_row(b, pc, 32 * mi + r32, dir);
#pragma unroll
              for (int d0 = 0; d0 < 8; ++d0) qf[d0] = *(const bf16x8*)(qkvp + R * 1536 + h * 128 + d0 * 16 + hi * 8); }
#pragma unroll
            for (int ni = 0; ni <= mi; ++ni) {
                f32x16 ckk = {}, cqk = {};
#pragma unroll
                for (int d0 = 0; d0 < 8; ++d0) { ckk = __builtin_amdgcn_mfma_f32_32x32x16_bf16(kf[mi][d0], kf[ni][d0], ckk, 0, 0, 0);
                                                 cqk = __builtin_amdgcn_mfma_f32_32x32x16_bf16(qf[d0], kf[ni][d0], cqk, 0, 0, 0); }
                const int sg = 32 * ni + r32; const float gsg = gs[sg];
#pragma unroll
                for (int r = 0; r < 16; ++r) { const int tau = 32 * mi + crow(r, hi);
                    const float dec = tau >= sg ? expf(gs[tau] - gsg) : 0.f;
                    Lw[tau * 64 + sg] = tau > sg ? bs[tau] * dec * ckk[r] : 0.f;
                    Ao[tau * 64 + sg] = f2bf(cqk[r] * dec); }
                asm volatile("" ::: "memory");
            }
        }
#pragma unroll
        for (int r = 0; r < 16; ++r) Ao[crow(r, hi) * 64 + 32 + r32] = 0;
        float Tc[64];
#pragma unroll
        for (int i = 0; i < 64; ++i) { float a = (i == lane) ? 1.f : 0.f;
#pragma unroll
            for (int j = 0; j < i; ++j) a -= Lw[i * 64 + j] * Tc[j];
            Tc[i] = a; asm volatile("" ::: "memory"); }
        bf16_t* To = Tb + (size_t)cp * 4096;
#pragma unroll
        for (int i = 0; i < 64; ++i) To[i * 64 + lane] = f2bf(Tc[i]);
    }
}

constexpr int G_KV = 0, G_QA = 16384, G_TT = 32768, G_AQ = G_TT + 9216, G_RT = G_AQ + 9216, G_UT = G_RT + 4608, G_UP = G_UT + 4608,
              G_ST = G_UP + 4608, G_VS = G_ST + 8704, G_GS = G_VS + 4096, G_BS = G_GS + 256, G_EL = G_BS + 256, G_END = G_EL + 256;
__device__ __forceinline__ void gdn_scan_phase(const Params& p, unsigned char* lds) {
    const int tid = threadIdx.x, lane0 = tid & 63, wid = tid >> 6;
    const bf16_t* qkvp = (const bf16_t*)p.out;
    const bf16_t* Tb = (const bf16_t*)(p.ws + WS_T); const bf16_t* Ab = (const bf16_t*)(p.ws + WS_AQK);
    const float* gv = (const float*)(p.ws + WS_GV); const float* bv = (const float*)(p.ws + WS_BV);
    bf16_t* obuf = (bf16_t*)(p.ws + WS_H);
    const float* gsl = (const float*)(lds + G_GS); const float* bsl = (const float*)(lds + G_BS); const float* esl = (const float*)(lds + G_EL);
    const int sr = tid >> 4, sc = (tid & 15) * 8;
    const int vblk = (gridDim.x % 8 == 0) ? (int)((blockIdx.x & 7) * (gridDim.x >> 3) + (blockIdx.x >> 3)) : (int)blockIdx.x;
    for (int wi = vblk; wi < 256; wi += gridDim.x) {
        const int chain = wi >> 2, cs = wi & 3, b = chain >> 3, h = (chain >> 1) & 3, dir = chain & 1;
        f32x16 Sacc = {};
        for (int i = tid; i < 8704 / 4; i += NTHREADS) ((unsigned*)(lds + G_ST))[i] = 0u;
        bf16x8 sk0, sk1, sq0, sq1, sT, sA, sV; float sg = 0.f;
#define GLOAD(step) do { const int pc_ = dir == 0 ? (step) : ((step) < 4 ? 3 - (step) : 4 + 127 - ((step) - 4)); \
        const size_t cp_ = (size_t)chain * 132 + pc_; \
        const size_t R0_ = (size_t)gdn_row(b, pc_, sr, dir), R1_ = (size_t)gdn_row(b, pc_, 32 + sr, dir); \
        sk0 = *(const bf16x8*)(qkvp + R0_ * 1536 + 512 + h * 128 + sc); sk1 = *(const bf16x8*)(qkvp + R1_ * 1536 + 512 + h * 128 + sc); \
        sq0 = *(const bf16x8*)(qkvp + R0_ * 1536 + h * 128 + sc); sq1 = *(const bf16x8*)(qkvp + R1_ * 1536 + h * 128 + sc); \
        sT = *(const bf16x8*)(Tb + cp_ * 4096 + tid * 8); sA = *(const bf16x8*)(Ab + cp_ * 4096 + tid * 8); \
        if (tid < 256) { const size_t Rv_ = (size_t)gdn_row(b, pc_, tid >> 2, dir); sV = *(const bf16x8*)(qkvp + Rv_ * 1536 + 1024 + h * 128 + cs * 32 + (tid & 3) * 8); } \
        if (tid < 64) sg = gv[cp_ * 64 + tid]; else if (tid < 128) sg = bv[cp_ * 64 + tid - 64]; else if (tid < 192) sg = ((const float*)(p.ws + WS_EL))[cp_ * 64 + tid - 128]; } while (0)
#define GWRITE() do { *(bf16x8*)(lds + G_KV + v_st(sr, sc)) = sk0; *(bf16x8*)(lds + G_KV + v_st(32 + sr, sc)) = sk1; \
        *(bf16x8*)(lds + G_QA + KSWZ(sr, sc * 2)) = sq0; *(bf16x8*)(lds + G_QA + KSWZ(32 + sr, sc * 2)) = sq1; \
        *(bf16x8*)(lds + G_TT + (tid >> 3) * 144 + (tid & 7) * 16) = sT; *(bf16x8*)(lds + G_AQ + (tid >> 3) * 144 + (tid & 7) * 16) = sA; \
        if (tid < 256) *(bf16x8*)(lds + G_VS + (tid >> 2) * 64 + (tid & 3) * 16) = sV; \
        if (tid < 192) ((float*)(lds + G_GS))[tid] = sg; } while (0)
        GLOAD(0);
        for (int step = 0; step < 132; ++step) {
            GWRITE();
            __syncthreads();
            if (step + 1 < 132) GLOAD(step + 1);
            int lane = lane0; asm volatile("" : "+v"(lane));
            const int r32 = lane & 31, hi = lane >> 5;
            const int vb0 = (int)(uintptr_t)(lds + G_KV) + v_rd_base(lane);
            const int pc = dir == 0 ? step : (step < 4 ? 3 - step : 4 + 127 - (step - 4));
            f32x16 acc = {};
            const int mi = wid & 1;
            if (wid < 4) {
                f32x16 acc2 = {};
                if (wid < 2) {
#pragma unroll
                    for (int d0 = 0; d0 < 8; d0 += 2) {
                        const bf16x8 a0 = *(const bf16x8*)(lds + G_KV + v_st(32 * mi + r32, d0 * 16 + hi * 8)), a1 = *(const bf16x8*)(lds + G_KV + v_st(32 * mi + r32, d0 * 16 + 16 + hi * 8));
                        const bf16x8 b0 = *(const bf16x8*)(lds + G_ST + r32 * 272 + (d0 * 16 + hi * 8) * 2), b1 = *(const bf16x8*)(lds + G_ST + r32 * 272 + (d0 * 16 + 16 + hi * 8) * 2);
                        acc = __builtin_amdgcn_mfma_f32_32x32x16_bf16(a0, b0, acc, 0, 0, 0);
                        acc2 = __builtin_amdgcn_mfma_f32_32x32x16_bf16(a1, b1, acc2, 0, 0, 0); }
                } else {
#pragma unroll
                    for (int d0 = 0; d0 < 8; d0 += 2) {
                        const bf16x8 a0 = *(const bf16x8*)(lds + G_QA + KSWZ(32 * mi + r32, (d0 * 16 + hi * 8) * 2)), a1 = *(const bf16x8*)(lds + G_QA + KSWZ(32 * mi + r32, (d0 * 16 + 16 + hi * 8) * 2));
                        const bf16x8 b0 = *(const bf16x8*)(lds + G_ST + r32 * 272 + (d0 * 16 + hi * 8) * 2), b1 = *(const bf16x8*)(lds + G_ST + r32 * 272 + (d0 * 16 + 16 + hi * 8) * 2);
                        acc = __builtin_amdgcn_mfma_f32_32x32x16_bf16(a0, b0, acc, 0, 0, 0);
                        acc2 = __builtin_amdgcn_mfma_f32_32x32x16_bf16(a1, b1, acc2, 0, 0, 0); }
                }
#pragma unroll
                for (int r = 0; r < 16; ++r) acc[r] += acc2[r];
                if (wid < 2) {
#pragma unroll
                    for (int g4 = 0; g4 < 4; ++g4) { float rv[4];
#pragma unroll
                        for (int j = 0; j < 4; ++j) { const int tau = 32 * mi + 8 * g4 + 4 * hi + j;
                            const float vv = bf2f(*(const bf16_t*)(lds + G_VS + tau * 64 + r32 * 2));
                            rv[j] = bsl[tau] * (vv - gsl[tau] * acc[g4 * 4 + j]); }
                        u32x2 w; w.x = cvtpk(rv[0], rv[1]); w.y = cvtpk(rv[2], rv[3]);
                        *(u32x2*)(lds + G_RT + r32 * 144 + (32 * mi + 8 * g4 + 4 * hi) * 2) = w; }
                } else {
#pragma unroll
                    for (int r = 0; r < 16; ++r) acc[r] *= gsl[32 * mi + crow(r, hi)];
                }
            }
            __syncthreads();
            if (wid < 2) {
                f32x16 u = {}, u2 = {};
#pragma unroll
                for (int s = 0; s < 4; s += 2) {
                    const bf16x8 a0 = *(const bf16x8*)(lds + G_TT + (32 * mi + r32) * 144 + (16 * s + hi * 8) * 2), a1 = *(const bf16x8*)(lds + G_TT + (32 * mi + r32) * 144 + (16 * s + 16 + hi * 8) * 2);
                    const bf16x8 b0 = *(const bf16x8*)(lds + G_RT + r32 * 144 + (16 * s + hi * 8) * 2), b1 = *(const bf16x8*)(lds + G_RT + r32 * 144 + (16 * s + 16 + hi * 8) * 2);
                    u = __builtin_amdgcn_mfma_f32_32x32x16_bf16(a0, b0, u, 0, 0, 0);
                    u2 = __builtin_amdgcn_mfma_f32_32x32x16_bf16(a1, b1, u2, 0, 0, 0); }
#pragma unroll
                for (int r = 0; r < 16; ++r) u[r] += u2[r];
#pragma unroll
                for (int g4 = 0; g4 < 4; ++g4) { float uv[4], up[4];
#pragma unroll
                    for (int j = 0; j < 4; ++j) { const int tau = 32 * mi + 8 * g4 + 4 * hi + j; uv[j] = u[g4 * 4 + j]; up[j] = uv[j] * esl[tau]; }
                    u32x2 w; w.x = cvtpk(uv[0], uv[1]); w.y = cvtpk(uv[2], uv[3]);
                    *(u32x2*)(lds + G_UT + r32 * 144 + (32 * mi + 8 * g4 + 4 * hi) * 2) = w;
                    u32x2 w2; w2.x = cvtpk(up[0], up[1]); w2.y = cvtpk(up[2], up[3]);
                    *(u32x2*)(lds + G_UP + r32 * 144 + (32 * mi + 8 * g4 + 4 * hi) * 2) = w2; }
            }
            __syncthreads();
            if (wid == 2 || wid == 3) {
#pragma unroll
                for (int s = 0; s < 4; ++s) {
                    const bf16x8 a = *(const bf16x8*)(lds + G_AQ + (32 * mi + r32) * 144 + (16 * s + hi * 8) * 2);
                    const bf16x8 bb = *(const bf16x8*)(lds + G_UT + r32 * 144 + (16 * s + hi * 8) * 2);
                    acc = __builtin_amdgcn_mfma_f32_32x32x16_bf16(a, bb, acc, 0, 0, 0); }
#pragma unroll
                for (int r = 0; r < 16; ++r) { const size_t R = (size_t)gdn_row(b, pc, 32 * mi + crow(r, hi), dir);
                    obuf[((size_t)dir * MTOT + R) * 512 + h * 128 + cs * 32 + r32] = f2bf(acc[r]); }
            } else if (wid >= 4) {
                const float gl = gsl[63];
#pragma unroll
                for (int r = 0; r < 16; ++r) Sacc[r] *= gl;
                const bf16x8 pa0 = *(const bf16x8*)(lds + G_UP + r32 * 144 + (0 + hi * 8) * 2), pa1 = *(const bf16x8*)(lds + G_UP + r32 * 144 + (16 + hi * 8) * 2),
                             pa2 = *(const bf16x8*)(lds + G_UP + r32 * 144 + (32 + hi * 8) * 2), pa3 = *(const bf16x8*)(lds + G_UP + r32 * 144 + (48 + hi * 8) * 2);
                const int d0 = wid - 4;
                if (d0 == 0) pv_one<0>(Sacc, vb0, pa0, pa1, pa2, pa3); else if (d0 == 1) pv_one<1>(Sacc, vb0, pa0, pa1, pa2, pa3);
                else if (d0 == 2) pv_one<2>(Sacc, vb0, pa0, pa1, pa2, pa3); else pv_one<3>(Sacc, vb0, pa0, pa1, pa2, pa3);
#pragma unroll
                for (int r = 0; r < 16; ++r) *(bf16_t*)(lds + G_ST + crow(r, hi) * 272 + (32 * d0 + r32) * 2) = f2bf(Sacc[r]);
            }
            __syncthreads();
        }
#undef GLOAD
#undef GWRITE
    }
}

__device__ __forceinline__ void gdn_post_phase(const Params& p) {
    const int lane = threadIdx.x & 63, wid = threadIdx.x >> 6;
    const bf16_t* obuf = (const bf16_t*)(p.ws + WS_H);
    const bf16_t* proj = (const bf16_t*)(p.ws + WS_PROJ);
    bf16_t* mix = (bf16_t*)(p.ws + WS_MIX);
    const int d = (lane & 15) * 8;
    for (int row = blockIdx.x * 8 + wid; row < MTOT; row += gridDim.x * 8) {
        float a[8], bb[8], g[8], y[8];
        unpack8(*(const bf16x8*)(obuf + (size_t)row * 512 + lane * 8), a);
        unpack8(*(const bf16x8*)(obuf + ((size_t)MTOT + row) * 512 + lane * 8), bb);
        unpack8(*(const bf16x8*)(proj + (size_t)row * EV_NP + 3072 + lane * 8), g);
        float ss = 0.f;
#pragma unroll
        for (int i = 0; i < 8; ++i) { a[i] += bb[i]; ss += a[i] * a[i]; }
        ss += __shfl_xor(ss, 1); ss += __shfl_xor(ss, 2); ss += __shfl_xor(ss, 4); ss += __shfl_xor(ss, 8);
        const float rstd = rsqrtf(ss * (1.f / 128.f) + 1e-6f);
#pragma unroll
        for (int i = 0; i < 8; ++i) y[i] = a[i] * rstd * p.gdn_norm[d + i] * (g[i] / (1.f + expf(-g[i])));
        *(bf16x8*)(mix + (size_t)row * DM + 512 + lane * 8) = pack8(y);
    }
}

__device__ __forceinline__ void diffattn_phase(const Params& p, unsigned char* lds) {
    const int tid = threadIdx.x, wid = tid >> 6, lane = tid & 63, r32 = lane & 31, hi = lane >> 5;
    const bf16_t* proj = (const bf16_t*)(p.ws + WS_PROJ);
    bf16_t* mix = (bf16_t*)(p.ws + WS_MIX);
    float s01 = 0.f, s23 = 0.f;
    for (int i = 0; i < 64; ++i) { s01 += p.diff_lambda[i] * p.diff_lambda[64 + i]; s23 += p.diff_lambda[128 + i] * p.diff_lambda[192 + i]; }
    const float lam = expf(s01) - expf(s23) + 0.2f;
    float* X = (float*)lds; float* li = (float*)(lds + 131072) + wid * 64;
    LAS unsigned char* ldsl = (LAS unsigned char*)lds;
    int koff[2], voff[2];
#pragma unroll
    for (int i = 0; i < 2; ++i) {
        const int g = i * 512 + tid;
        { const int row = g >> 4, cg = (g & 15) ^ (row & 7); koff[i] = row * EV_NP + cg * 8; }
        { const int o = g * 16, st = o >> 9, w = o & 511, kk = (st >> 2) * 8 + (w >> 6);
          const int k = (kk & ~0xC) | ((kk & 4) << 1) | ((kk & 8) >> 1), cc = (st & 3) * 32 + ((w & 63) >> 4) * 8; voff[i] = k * EV_NP + cc; }
    }
    const int vbase = (int)(uintptr_t)lds + v_rd_base(lane);
    const int map = wid >> 2, wq = wid & 3;
    unsigned char* Qs = lds + 98304 + wid * 4096 + lane * 16;
    const int vblk = (gridDim.x % 8 == 0) ? (int)((blockIdx.x & 7) * (gridDim.x >> 3) + (blockIdx.x >> 3)) : (int)blockIdx.x;
    for (int it = vblk; it < 2112; it += gridDim.x) {
        int b, h, NT, qrow0;
        if (it < 2048) { b = it >> 8; h = (it >> 6) & 3; const int qb = it & 63; NT = 132; qrow0 = b * SEQ + qb * 128; }
        else { const int j = it - 2048; b = j >> 3; h = (j >> 1) & 3; NT = 4; qrow0 = NLAT + b * CTXL + (j & 1) * 128; }
        bf16x8 qr[4];
        { const bf16_t* qp = proj + (size_t)(qrow0 + 32 * wq + r32) * EV_NP + h * 128 + map * 64 + hi * 8;
#pragma unroll
          for (int d0 = 0; d0 < 4; ++d0) qr[d0] = *(const bf16x8*)(qp + d0 * 16); }
        f32x16 o[4] = {}; float lsum = 0.f;
#define DDMA(j, bo) do { const bf16_t* pp_ = proj + (size_t)((j) < 4 ? NLAT + b * CTXL + 64 * (j) : b * SEQ + 64 * ((j) - 4)) * EV_NP + h * 128; \
        _Pragma("unroll") for (int i_ = 0; i_ < 2; ++i_) { \
            __builtin_amdgcn_global_load_lds((const unsigned*)(pp_ + 1024 + voff[i_]), (LAS unsigned*)(ldsl + (bo) + i_ * 8192 + wid * 1024), 16, 0, 0); \
            __builtin_amdgcn_global_load_lds((const unsigned*)(pp_ + 512 + koff[i_]), (LAS unsigned*)(ldsl + (bo) + 16384 + i_ * 8192 + wid * 1024), 16, 0, 0); } } while (0)
#define DQK(P0, P1, bo) do { P0 = (f32x16){}; P1 = (f32x16){}; const unsigned char* Ks_ = lds + (bo) + 16384; \
        _Pragma("unroll") for (int d0 = 0; d0 < 4; ++d0) { const int cb_ = (map * 64 + d0 * 16 + hi * 8) * 2; \
            const bf16x8 b0_ = *(const bf16x8*)(Ks_ + KSWZ(r32, cb_)), b1_ = *(const bf16x8*)(Ks_ + KSWZ(32 + r32, cb_)); \
            P0 = __builtin_amdgcn_mfma_f32_32x32x16_bf16(b0_, qr[d0], P0, 0, 0, 0); \
            P1 = __builtin_amdgcn_mfma_f32_32x32x16_bf16(b1_, qr[d0], P1, 0, 0, 0); } } while (0)
#define DSM(P0, P1) do { _Pragma("unroll") for (int r = 0; r < 16; ++r) { P0[r] = __builtin_amdgcn_exp2f(P0[r]); P1[r] = __builtin_amdgcn_exp2f(P1[r]); lsum += P0[r] + P1[r]; } \
        PK4(P0, 0, pa0); PK4(P0, 8, pa1); PK4(P1, 0, pa2); PK4(P1, 8, pa3); } while (0)
#define DTAIL_() asm volatile("s_waitcnt vmcnt(0)" ::: "memory"); __syncthreads(); { const int t_ = bprev; bprev = bcur; bcur = bnext; bnext = t_; }
#define DSTEP_A(N0, N1, O0, O1, j) do { if ((j) + 1 < NT) DDMA((j) + 1, bnext); \
        DQK(N0, N1, bcur); DSM(O0, O1); pv_d0(o, vbase + bprev, pa0, pa1, pa2, pa3); DTAIL_() } while (0)
#define DSTEP_B(N0, N1, O0, O1, j) do { if ((j) + 1 < NT) DDMA((j) + 1, bnext); \
        DSM(O0, O1); pv_d0(o, vbase + bprev, pa0, pa1, pa2, pa3); SBAR(); DQK(N0, N1, bcur); DTAIL_() } while (0)
        f32x16 pA0, pA1, pB0, pB1; bf16x8 pa0, pa1, pa2, pa3;
        DDMA(0, 0); DDMA(1, 32768); asm volatile("s_waitcnt vmcnt(0)" ::: "memory"); __syncthreads();
        DQK(pA0, pA1, 0);
        int bprev = 0, bcur = 32768, bnext = 65536;
        if (map == 0) {
            for (int j = 1; j + 1 < NT; j += 2) { DSTEP_A(pB0, pB1, pA0, pA1, j); DSTEP_A(pA0, pA1, pB0, pB1, j + 1); }
            DSTEP_A(pB0, pB1, pA0, pA1, NT - 1);
        } else {
            for (int j = 1; j + 1 < NT; j += 2) { DSTEP_B(pB0, pB1, pA0, pA1, j); DSTEP_B(pA0, pA1, pB0, pB1, j + 1); }
            DSTEP_B(pB0, pB1, pA0, pA1, NT - 1);
        }
        DSM(pB0, pB1); pv_d0(o, vbase + bprev, pa0, pa1, pa2, pa3);
        __syncthreads();
#undef DDMA
#undef DQK
#undef DSM
#undef DSTEP_A
#undef DSTEP_B
#undef DTAIL_
        const float lt = halfswap_add(lsum);
        if (hi == 0) li[r32] = lt;
        asm volatile("s_waitcnt lgkmcnt(0)" ::: "memory");
        float rli[16];
#pragma unroll
        for (int r = 0; r < 16; ++r) rli[r] = 1.f / li[crow(r, hi)];
        if (map == 1) {
#pragma unroll
            for (int d0 = 0; d0 < 4; ++d0)
#pragma unroll
                for (int r = 0; r < 16; ++r) X[(wq * 64 + d0 * 16 + r) * 64 + lane] = o[d0][r] * rli[r] * lam;
        }
        __syncthreads();
        if (map == 0) {
#pragma unroll
            for (int d0 = 0; d0 < 4; ++d0)
#pragma unroll
                for (int r = 0; r < 16; ++r) o[d0][r] = o[d0][r] * rli[r] - X[(wq * 64 + d0 * 16 + r) * 64 + lane];
#pragma unroll
            for (int r = 0; r < 16; ++r) {
                float ss = o[0][r] * o[0][r] + o[1][r] * o[1][r] + o[2][r] * o[2][r] + o[3][r] * o[3][r];
                ss += __shfl_xor(ss, 1); ss += __shfl_xor(ss, 2); ss += __shfl_xor(ss, 4); ss += __shfl_xor(ss, 8); ss += __shfl_xor(ss, 16);
                const float rstd = rsqrtf(ss * (1.f / 128.f) + 1e-6f) * 0.8f;
                bf16_t* mp = mix + (size_t)(qrow0 + 32 * wq + crow(r, hi)) * DM + h * 128 + r32;
#pragma unroll
                for (int d0 = 0; d0 < 4; ++d0) mp[32 * d0] = f2bf(o[d0][r] * rstd * p.diff_subln[32 * d0 + r32]);
            }
        }
        __syncthreads();
    }
}

__device__ __forceinline__ void natten_phase(const Params& p, unsigned char* lds) {
    const int tid = threadIdx.x, wid = tid >> 6, lane = tid & 63, r32 = lane & 31, hi = lane >> 5;
    const bf16_t* proj = (const bf16_t*)(p.ws + WS_PROJ);
    bf16_t* mix = (bf16_t*)(p.ws + WS_MIX);
    constexpr float L2E = 1.4426950408889634f;
    unsigned char* Vl = lds; unsigned char* Kl = lds + 32768;
    float* rpbs = (float*)(lds + 65536);
    float* li = (float*)(lds + 133120) + wid * 64;
    unsigned char* Qs = lds + 67584 + wid * 8192 + lane * 16;
    const int sr = tid >> 4, sc = (tid & 15) * 8, vst0 = v_st(sr, sc), vst1 = v_st(32 + sr, sc);
    const int vb0 = (int)(uintptr_t)Vl + v_rd_base(lane);
    const float* gkp = p.na_qk_gain + 128 + sc;
    const int vblk = (gridDim.x % 8 == 0) ? (int)((blockIdx.x & 7) * (gridDim.x >> 3) + (blockIdx.x >> 3)) : (int)blockIdx.x;
    for (int it = vblk; it < 2048; it += gridDim.x) {
        const int b = it >> 8, h = (it >> 5) & 7, rq = it & 31;
        const int grow = 4 * rq + (wid >> 1), qc = (wid & 1) * 32 + r32;
        const size_t qR = (size_t)b * SEQ + grow * 64 + qc;
        for (int i = tid; i < 465; i += NTHREADS) rpbs[i] = p.na_rpb[h * 465 + i] * L2E;
        { float ss = 0.f;
#pragma unroll
          for (int d0 = 0; d0 < 8; ++d0) { float qv[8]; unpack8(*(const bf16x8*)(proj + qR * OD_N + h * 128 + d0 * 16 + hi * 8), qv);
#pragma unroll
              for (int i = 0; i < 8; ++i) ss += qv[i] * qv[i]; }
          ss = halfswap_add(ss);
          const float rs = rsqrtf(ss * (1.f / 128.f) + 1e-6f) * 0.08838834764831845f * L2E;
#pragma unroll
          for (int d0 = 0; d0 < 8; ++d0) { float qv[8]; unpack8(*(const bf16x8*)(proj + qR * OD_N + h * 128 + d0 * 16 + hi * 8), qv);
#pragma unroll
              for (int i = 0; i < 8; ++i) qv[i] *= rs * p.na_qk_gain[d0 * 16 + hi * 8 + i];
              *(bf16x8*)(Qs + d0 * 1024) = pack8(qv); } }
        int lo = 4 * rq - 4; lo = lo < 0 ? 0 : (lo > 120 ? 120 : lo);
        int hi_r = 4 * rq + 3 - 4; hi_r = hi_r < 0 ? 0 : (hi_r > 120 ? 120 : hi_r); hi_r += 7;
        const int nlat = hi_r - lo + 1, NT = nlat + 4;
        int wsr = grow - 4; wsr = wsr < 0 ? 0 : (wsr > 120 ? 120 : wsr);
        int cst = qc - 8; cst = cst < 0 ? 0 : (cst > 48 ? 48 : cst);
        f32x16 o[4] = {}; float lsum = 0.f;
        bf16x8 vs0, vs1, ks0, ks1;
#define NLOAD(j) do { const size_t R0_ = (size_t)((j) < nlat ? b * SEQ + (lo + (j)) * 64 : NLAT + b * CTXL + 64 * ((j) - nlat)) + sr; \
        const bf16_t* pp_ = proj + R0_ * OD_N + h * 128 + sc; \
        vs0 = *(const bf16x8*)(pp_ + 2048); vs1 = *(const bf16x8*)(pp_ + 2048 + (size_t)32 * OD_N); \
        ks0 = *(const bf16x8*)(pp_ + 1024); ks1 = *(const bf16x8*)(pp_ + 1024 + (size_t)32 * OD_N); } while (0)
#define KNORM(kx) do { float f_[8]; unpack8(kx, f_); float ss_ = 0.f; _Pragma("unroll") for (int i_ = 0; i_ < 8; ++i_) ss_ += f_[i_] * f_[i_]; \
        ss_ += __shfl_xor(ss_, 1); ss_ += __shfl_xor(ss_, 2); ss_ += __shfl_xor(ss_, 4); ss_ += __shfl_xor(ss_, 8); \
        const float rs_ = rsqrtf(ss_ * (1.f / 128.f) + 1e-6f); _Pragma("unroll") for (int i_ = 0; i_ < 8; ++i_) f_[i_] *= rs_ * gkp[i_]; kx = pack8(f_); } while (0)
#define NWRITE(bf) do { KNORM(ks0); KNORM(ks1); *(bf16x8*)(Vl + (bf) * 16384 + vst0) = vs0; *(bf16x8*)(Vl + (bf) * 16384 + vst1) = vs1; \
        *(bf16x8*)(Kl + (bf) * 16384 + KSWZ(sr, sc * 2)) = ks0; *(bf16x8*)(Kl + (bf) * 16384 + KSWZ(32 + sr, sc * 2)) = ks1; } while (0)
        NLOAD(0); NWRITE(0); __syncthreads();
        for (int j = 0; j < NT; ++j) {
            if (j + 1 < NT) NLOAD(j + 1);
            const int bf = j & 1;
            const bool islat = j < nlat; const int kr = lo + j;
            const bool active = !islat || (kr >= wsr && kr <= wsr + 7);
            if (active) {
                f32x16 p0 = {}, p1 = {};
                const unsigned char* Ks = Kl + bf * 16384;
#pragma unroll
                for (int d0 = 0; d0 < 8; ++d0) { const int cb = (d0 * 16 + hi * 8) * 2;
                    const bf16x8 b0 = *(const bf16x8*)(Ks + KSWZ(r32, cb)), b1 = *(const bf16x8*)(Ks + KSWZ(32 + r32, cb));
                    const bf16x8 qd = *(const bf16x8*)(Qs + d0 * 1024);
                    p0 = __builtin_amdgcn_mfma_f32_32x32x16_bf16(b0, qd, p0, 0, 0, 0);
                    p1 = __builtin_amdgcn_mfma_f32_32x32x16_bf16(b1, qd, p1, 0, 0, 0); }
                if (islat) {
                    const float* rb = rpbs + (kr - grow + 7) * 31 + 15 - qc + 4 * hi;
                    const int mofs = 4 * hi - cst;
#pragma unroll
                    for (int r = 0; r < 16; ++r) {
                        const int kb = (r & 3) + 8 * (r >> 2);
                        const float e0 = __builtin_amdgcn_exp2f(p0[r] + rb[kb]), e1 = __builtin_amdgcn_exp2f(p1[r] + rb[32 + kb]);
                        p0[r] = ((unsigned)(kb + mofs) < 16u) ? e0 : 0.f; p1[r] = ((unsigned)(32 + kb + mofs) < 16u) ? e1 : 0.f;
                        lsum += p0[r] + p1[r]; }
                } else {
#pragma unroll
                    for (int r = 0; r < 16; ++r) { p0[r] = __builtin_amdgcn_exp2f(p0[r]); p1[r] = __builtin_amdgcn_exp2f(p1[r]); lsum += p0[r] + p1[r]; }
                }
                bf16x8 pa0, pa1, pa2, pa3;
                PK4(p0, 0, pa0); PK4(p0, 8, pa1); PK4(p1, 0, pa2); PK4(p1, 8, pa3);
                pv_d0(o, vb0 + bf * 16384, pa0, pa1, pa2, pa3);
            }
            if (j + 1 < NT) NWRITE((j + 1) & 1);
            __syncthreads();
        }
#undef NLOAD
#undef KNORM
#undef NWRITE
        const float lt = halfswap_add(lsum);
        if (hi == 0) li[r32] = lt;
        asm volatile("s_waitcnt lgkmcnt(0)" ::: "memory");
#pragma unroll
        for (int r = 0; r < 16; ++r) { const float rl = 1.f / li[crow(r, hi)];
            bf16_t* mp = mix + ((size_t)b * SEQ + grow * 64 + (wid & 1) * 32 + crow(r, hi)) * DM + h * 128 + r32;
#pragma unroll
            for (int d0 = 0; d0 < 4; ++d0) mp[32 * d0] = f2bf(o[d0][r] * rl); }
        __syncthreads();
    }
}

#define XB_TMO      128
#define XB_XCNT(j)  (256  + 64 * (j))
#define XB_XSUB(j)  (1280 + 64 * (j))
#define XB_XGEN(j)  (2304 + 64 * (j))
#define XB_TOP      3328
#define XB_TOPGEN   3392
#define XCD_BAR_WORDS 3456
#define XB_SPIN_CAP (1u << 22)
__device__ __forceinline__ unsigned xb_ld(unsigned* p)              { return __hip_atomic_load(p, __ATOMIC_RELAXED, __HIP_MEMORY_SCOPE_AGENT); }
__device__ __forceinline__ unsigned xb_add(unsigned* p, unsigned v) { return __hip_atomic_fetch_add(p, v, __ATOMIC_RELAXED, __HIP_MEMORY_SCOPE_AGENT); }
__device__ __forceinline__ unsigned xb_xcc_id() { return (unsigned)__builtin_amdgcn_s_getreg((3 << 11) | 20) & 0xFu; }
#define XB_SPIN(cond, bar) do { unsigned _sp = 0; while (cond) { __builtin_amdgcn_s_sleep(1); \
    if ((++_sp & 255u) == 0u) { if (xb_ld(&(bar)[XB_TMO])) break; if (_sp > XB_SPIN_CAP) { atomicAdd(&(bar)[XB_TMO], 1u); break; } } } } while (0)
struct XcdBarrier { unsigned* bar; unsigned x; volatile LAS unsigned* st; };
__device__ __forceinline__ XcdBarrier xcd_barrier_post(unsigned* bar, volatile LAS unsigned* st) {
    XcdBarrier b; b.bar = bar; b.x = xb_xcc_id(); b.st = st;
    if (threadIdx.x == 0) (void)xb_add(&bar[XB_XCNT(b.x)], 1u);
    return b;
}
__device__ __forceinline__ void xcd_barrier_complete(unsigned* bar, unsigned x, unsigned& nloc, unsigned& nx) {
    const unsigned G = gridDim.x * gridDim.y * gridDim.z;
    unsigned sum, cnt, mine, sp = 0u;
    for (;;) {
        sum = 0u; cnt = 0u; mine = 0u;
#pragma unroll
        for (unsigned j = 0; j < 16; ++j) { const unsigned c = xb_ld(&bar[XB_XCNT(j)]); sum += c; cnt += (c > 0u) ? 1u : 0u; mine = (j == x) ? c : mine; }
        if (sum == G) break;
        __builtin_amdgcn_s_sleep(1);
        if ((++sp & 255u) == 0u) { if (xb_ld(&bar[XB_TMO])) break; if (sp > XB_SPIN_CAP) { atomicAdd(&bar[XB_TMO], 1u); break; } }
    }
    nloc = mine > 0u ? mine : 1u; nx = cnt > 0u ? cnt : 1u;
}
__device__ __forceinline__ void xcd_barrier(const XcdBarrier& b) {
    asm volatile("s_waitcnt vmcnt(0)" ::: "memory");
    __syncthreads();
    if (threadIdx.x == 0) {
        unsigned* bar = b.bar;
        __builtin_amdgcn_s_waitcnt(0);
        unsigned nloc = b.st[0], nx = b.st[1];
        if (nloc == 0u) { xcd_barrier_complete(bar, b.x, nloc, nx); b.st[0] = nloc; b.st[1] = nx; }
        const unsigned old = xb_add(&bar[XB_XSUB(b.x)], 1u);
        const unsigned gen = old / nloc;
        if (old + 1u == (gen + 1u) * nloc) {
            __builtin_amdgcn_fence(__ATOMIC_RELEASE, "agent");
            asm volatile("s_waitcnt vmcnt(0)" ::: "memory");
            const unsigned og = xb_add(&bar[XB_TOP], 1u);
            const unsigned tg = og / nx;
            if (og + 1u == (tg + 1u) * nx) xb_add(&bar[XB_TOPGEN], 1u);
            else XB_SPIN(xb_ld(&bar[XB_TOPGEN]) == tg, bar);
            __builtin_amdgcn_fence(__ATOMIC_ACQUIRE, "agent");
            xb_add(&bar[XB_XGEN(b.x)], 1u);
            asm volatile("s_waitcnt vmcnt(0)" ::: "memory");
        } else {
            XB_SPIN(xb_ld(&bar[XB_XGEN(b.x)]) == gen, bar);
            __builtin_amdgcn_fence(__ATOMIC_ACQUIRE, "agent");
            asm volatile("s_waitcnt vmcnt(0)" ::: "memory");
        }
    }
    __syncthreads();
}

#ifndef PROBE_REP
#define PROBE_REP 0
#endif
#define REP(k) for (int rep_ = 0; rep_ < (((PROBE_REP >> (k)) & 1) ? 2 : 1); ++rep_)
constexpr int NPH = 18;
__global__ void __launch_bounds__(NTHREADS, 2) fwd_megakernel(Params p) {
    extern __shared__ __attribute__((aligned(16))) unsigned char lds[];
    cg::grid_group grid = cg::this_grid();
    LAS unsigned char* ldsl = (LAS unsigned char*)lds;
    const int lo = p.ph_lo, hi = p.ph_hi;
#ifdef ONLY_PH
#define IN(k) (((ONLY_PH >> (k)) & 1) && lo <= (k) && (k) < hi)
#else
#define IN(k) (lo <= (k) && (k) < hi)
#endif
#define SEAM(k) do { if (IN(k) && IN((k) + 1)) { if ((k) == 0) grid.sync(); else { XcdBarrier xb_; xb_.bar = (unsigned*)(p.ws + WS_BAR); xb_.x = xb_xcc_id(); xb_.st = (volatile LAS unsigned*)(ldsl + 135168); xcd_barrier(xb_); } } } while (0)
    unsigned char* ws = p.ws;
    const bf16_t* H = (const bf16_t*)(ws + WS_H);
    bf16_t* PROJ = (bf16_t*)(ws + WS_PROJ);
    const bf16_t* MIX = (const bf16_t*)(ws + WS_MIX);
    float* CTXRES = (float*)(ws + WS_CTXRES);
    const float* MOD = (const float*)(ws + WS_MOD);
    const int G = gridDim.x, c = blockIdx.x;
    if (threadIdx.x < 4) ((volatile LAS unsigned*)(ldsl + 135168))[threadIdx.x] = 0u;
    __syncthreads();
    (void)xcd_barrier_post((unsigned*)(ws + WS_BAR), (volatile LAS unsigned*)(ldsl + 135168));

    if (IN(0)) REP(0) { ada_phase(p, lds); wconv_phase(p, lds);
        { float* rc = (float*)(ws + WS_ROPE); float* rs = rc + SEQ * 32;
          for (int e = blockIdx.x * NTHREADS + threadIdx.x; e < SEQ * 32; e += gridDim.x * NTHREADS) { const int t = e >> 5, pp = e & 31;
              const float inv = powf(10000.f, -(float)(pp & 15) / 16.f); const float ang = (pp < 16 ? (float)(t >> 6) : (float)(t & 63)) * inv;
              rc[e] = cosf(ang); rs[e] = sinf(ang); } } }
    SEAM(0);
    if (IN(1)) REP(1) norm_phase(p, p.x, p.ctx, 0, 0, MTOT);
    SEAM(1);
    if (IN(2)) REP(2) { pg8::Gemm g{H, (const bf16_t*)(ws + WS_W_EVIN), MTOT, EV_NP, DM}; pg8::StaticOrder S; S.init(MTOT, EV_NP, G, c);
        pg8::EpiBf16 E{PROJ, EV_NP}; pg8::gemm_phase(ldsl, g, S, E); }
    SEAM(2);
    if (IN(3)) prep0_phase(p);
    SEAM(3);
    if (IN(4)) REP(4) gdn_pre_phase(p, lds);
    SEAM(4);
    if (IN(5)) {
#ifndef SKIP_SCAN
        REP(20) { gdn_scan_phase(p, lds); __syncthreads(); }
#endif
#ifndef SKIP_DA
        REP(5) { diffattn_phase(p, lds); __syncthreads(); }
#endif
    }
    SEAM(5);
    if (IN(6)) REP(6) gdn_post_phase(p);
    SEAM(6);
    if (IN(7)) REP(7) { pg8::Gemm g{MIX, (const bf16_t*)(ws + WS_W_EVOUT), MTOT, DM, DM}; pg8::StaticOrder S; S.init(MTOT, DM, G, c);
        pg8::EpiResid E{p.x, p.ctx, p.out, CTXRES, MOD, 2048}; pg8::gemm_phase(ldsl, g, S, E); }
    SEAM(7);
    if (IN(8)) norm_phase(p, p.out, CTXRES, 0, 1, MTOT);
    SEAM(8);
    if (IN(9)) REP(9) { pg8::Gemm g{H, (const bf16_t*)(ws + WS_W_FFIN), MTOT, 2 * FF, DM}; pg8::StaticOrder S; S.init(MTOT, 2 * FF, G, c);
        pg8::EpiSwiglu E{PROJ, FF}; pg8::gemm_phase(ldsl, g, S, E); }
    SEAM(9);
    if (IN(10)) { pg8::Gemm g{PROJ, (const bf16_t*)(ws + WS_W_FFOUT), MTOT, DM, FF}; pg8::StaticOrder S; S.init(MTOT, DM, G, c);
        pg8::EpiResid E{p.out, CTXRES, p.out, CTXRES, MOD, 5120}; pg8::gemm_phase(ldsl, g, S, E); }
    SEAM(10);
    if (IN(11)) norm_phase(p, p.out, CTXRES, 1, 0, MTOT);
    SEAM(11);
    if (IN(12)) { pg8::Gemm g{H, (const bf16_t*)(ws + WS_W_ODIN), MTOT, OD_N, DM}; pg8::StaticOrder S; S.init(MTOT, OD_N, G, c);
        pg8::EpiBf16 E{PROJ, OD_N}; pg8::gemm_phase(ldsl, g, S, E); }
    SEAM(12);
    if (IN(13)) { natten_phase(p, lds); if ((PROBE_REP >> 13) & 1) { __syncthreads(); natten_phase(p, lds); } }
    SEAM(13);
    if (IN(14)) { pg8::Gemm g{MIX, (const bf16_t*)(ws + WS_W_ODOUT), NLAT, DM, DM}; pg8::StaticOrder S; S.init(NLAT, DM, G, c);
        pg8::EpiResid E{p.out, CTXRES, p.out, CTXRES, MOD + 9 * 6144, 2048}; pg8::gemm_phase(ldsl, g, S, E); }
    SEAM(14);
    if (IN(15)) norm_phase(p, p.out, CTXRES, 1, 1, NLAT);
    SEAM(15);
    if (IN(16)) { pg8::Gemm g{H, (const bf16_t*)(ws + WS_W_FFIN) + (size_t)2 * FF * DM, NLAT, 2 * FF, DM}; pg8::StaticOrder S; S.init(NLAT, 2 * FF, G, c);
        pg8::EpiSwiglu E{PROJ, FF}; pg8::gemm_phase(ldsl, g, S, E); }
    SEAM(16);
    if (IN(17)) { pg8::Gemm g{PROJ, (const bf16_t*)(ws + WS_W_FFOUT) + (size_t)DM * FF, NLAT, DM, FF}; pg8::StaticOrder S; S.init(NLAT, DM, G, c);
        pg8::EpiResid E{p.out, CTXRES, p.out, CTXRES, MOD + 9 * 6144, 5120}; pg8::gemm_phase(ldsl, g, S, E); }
#undef IN
#undef SEAM
}

extern "C" void kernel_launch(void* const* d_in, const int* in_sizes, int n_in, void* d_out, int out_size, void* d_ws, size_t ws_size, hipStream_t stream) {
    static int grid = 0;
    if (grid == 0) {
        if (n_in != 23 || ws_size < WS_END) { fprintf(stderr, "kernel_launch: n_in %d ws %zu (need %zu)\n", n_in, ws_size, (size_t)WS_END); grid = -1; return; }
        int dev = 0, cus = 0, per_cu = 0;
        hipGetDevice(&dev); hipDeviceGetAttribute(&cus, hipDeviceAttributeMultiprocessorCount, dev);
        if (hipFuncSetAttribute((const void*)fwd_megakernel, hipFuncAttributeMaxDynamicSharedMemorySize, LDS_BYTES) != hipSuccess) { fprintf(stderr, "hipFuncSetAttribute failed\n"); grid = -1; return; }
        if (hipOccupancyMaxActiveBlocksPerMultiprocessor(&per_cu, (const void*)fwd_megakernel, NTHREADS, LDS_BYTES) != hipSuccess || per_cu < 1) per_cu = 1;
        (void)hipGetLastError();
        grid = cus * 1;
    }
    if (grid < 0) return;
    if (hipMemsetAsync((char*)d_ws + WS_BAR, 0, 16384, stream) != hipSuccess) { fprintf(stderr, "memset failed\n"); return; }
    Params p{};
    const float** pp = (const float**)&p;
    for (int i = 0; i < 23; ++i) pp[i] = (const float*)d_in[i];
    p.out = (float*)d_out; p.ws = (unsigned char*)d_ws;
#if N_LAUNCH_MODE == 1
    p.ph_lo = 0; p.ph_hi = NPH;
    void* args[] = {&p};
    hipError_t e = hipLaunchCooperativeKernel((void*)fwd_megakernel, dim3(grid), dim3(NTHREADS), args, LDS_BYTES, stream);
    if (e != hipSuccess) fprintf(stderr, "cooperative launch failed: %s (grid %d)\n", hipGetErrorString(e), grid);
#else
    for (int k = 0; k < NPH; ++k) { p.ph_lo = k; p.ph_hi = k + 1;
        hipLaunchKernelGGL(fwd_megakernel, dim3(grid), dim3(NTHREADS), LDS_BYTES, stream, p); }
#endif
}
```

```cpp
#include <hip/hip_runtime.h>
#include <hip/hip_cooperative_groups.h>
#include <cstdio>
#include <cstdint>
namespace cg = cooperative_groups;

#define LAS __attribute__((address_space(3)))
typedef unsigned short bf16_t;
typedef short bf16x8 __attribute__((ext_vector_type(8)));
typedef short s16x4 __attribute__((ext_vector_type(4)));
typedef float f32x4 __attribute__((ext_vector_type(4)));
typedef float f32x16 __attribute__((ext_vector_type(16)));
typedef unsigned u32x4 __attribute__((ext_vector_type(4)));
typedef unsigned u32x2 __attribute__((ext_vector_type(2)));

#ifndef N_LAUNCH_MODE
#define N_LAUNCH_MODE 1
#endif

constexpr int DM = 1024, NLAT = 65536, NCTX = 2048, MTOT = NLAT + NCTX, SEQ = 8192, CTXL = 256, FF = 2816;
constexpr int EV_N = 3600, EV_NP = 3840, OD_N = 3072;
constexpr int NCHUNKP = 64 * 132;
constexpr int NTHREADS = 512;
constexpr int LDS_BYTES = 135168 + 16;

constexpr size_t al256(size_t x) { return (x + 255) / 256 * 256; }
constexpr size_t WS_W_EVIN = 0;
constexpr size_t WS_W_EVOUT = WS_W_EVIN + al256((size_t)EV_NP * DM * 2);
constexpr size_t WS_W_ODIN = WS_W_EVOUT + al256((size_t)DM * DM * 2);
constexpr size_t WS_W_ODOUT = WS_W_ODIN + al256((size_t)OD_N * DM * 2);
constexpr size_t WS_W_FFIN = WS_W_ODOUT + al256((size_t)DM * DM * 2);
constexpr size_t WS_W_FFOUT = WS_W_FFIN + al256((size_t)2 * 2 * FF * DM * 2);
constexpr size_t WS_MOD = WS_W_FFOUT + al256((size_t)2 * DM * FF * 2);
constexpr size_t WS_H = WS_MOD + al256((size_t)2 * 9 * 6144 * 4);
constexpr size_t WS_PROJ = WS_H + al256((size_t)MTOT * DM * 2);
constexpr size_t WS_MIX = WS_PROJ + al256((size_t)MTOT * EV_NP * 2);
constexpr size_t WS_T = WS_MIX + al256((size_t)MTOT * DM * 2);
constexpr size_t WS_AQK = WS_T + al256((size_t)NCHUNKP * 4096 * 2);
constexpr size_t WS_GV = WS_AQK + al256((size_t)NCHUNKP * 4096 * 2);
constexpr size_t WS_BV = WS_GV + al256((size_t)NCHUNKP * 64 * 4);
constexpr size_t WS_EL = WS_BV + al256((size_t)NCHUNKP * 64 * 4);
constexpr size_t WS_GATES = WS_EL + al256((size_t)NCHUNKP * 64 * 4);
constexpr size_t WS_CTXRES = WS_GATES + al256((size_t)MTOT * 16 * 4);
constexpr size_t WS_BAR = WS_CTXRES + al256((size_t)NCTX * DM * 4);
constexpr size_t WS_ROPE = WS_BAR + 16384;
constexpr size_t WS_END = WS_ROPE + (size_t)2 * SEQ * 32 * 4;

struct Params {
    const float *x, *c, *ctx, *c_ctx, *ada_w, *ada_b, *norm_mix, *norm_ffn, *ffn_w_in, *ffn_w_out, *even_w_in, *even_w_out,
        *diff_qk_gain, *diff_lambda, *diff_subln, *gdn_conv, *gdn_a_log, *gdn_dt_bias, *gdn_norm, *odd_w_in, *odd_w_out, *na_qk_gain, *na_rpb;
    float* out; unsigned char* ws; int ph_lo, ph_hi;
};

__device__ __forceinline__ float bf2f(bf16_t b) { return __uint_as_float(((unsigned)b) << 16); }
__device__ __forceinline__ bf16_t f2bf(float f) { unsigned u = __float_as_uint(f); u += 0x7FFFu + ((u >> 16) & 1u); return (bf16_t)(u >> 16); }
__device__ __forceinline__ unsigned cvtpk(float lo, float hi) { unsigned r; asm volatile("v_cvt_pk_bf16_f32 %0, %1, %2" : "=v"(r) : "v"(lo), "v"(hi)); return r; }
__device__ __forceinline__ float siluf(float v) { return v / (1.f + __expf(-v)); }
__device__ __forceinline__ void unpack8(bf16x8 v, float* f) {
#pragma unroll
    for (int i = 0; i < 8; ++i) f[i] = bf2f((bf16_t)v[i]);
}
__device__ __forceinline__ bf16x8 pack8(const float* f) {
    u32x4 w = {cvtpk(f[0], f[1]), cvtpk(f[2], f[3]), cvtpk(f[4], f[5]), cvtpk(f[6], f[7])};
    return *reinterpret_cast<bf16x8*>(&w);
}

namespace pg8 {
constexpr int BM = 256, BK = 64, HALF = 128, HTB = HALF * BK * 2, STAGE_BYTES = 8 * HTB, NXCD = 8, WGM = 8;
__host__ __device__ __forceinline__ int lds_byte(int r, int c) { const int st = (r >> 4) * 2 + (c >> 5), rr = r & 15, cc = c & 31, ob = rr * 64 + cc * 2; return st * 1024 + (ob ^ (((ob >> 9) & 1) << 5)); }
__host__ __device__ __forceinline__ void stage_rc(int b, int& R, int& C) { const int st = b / 1024, sb = b % 1024, swz = sb ^ (((sb >> 9) & 1) << 5); R = (st >> 1) * 16 + swz / 64; C = (st & 1) * 32 + (swz % 64) / 2; }
__host__ __device__ __forceinline__ int perm32(int rho) { const int n = rho >> 4, i = rho & 15; return 8 * (i >> 2) + 4 * n + (i & 3); }
struct Unit { int pm, pn; };
struct Gemm { const bf16_t* A; const bf16_t* Bt; int M, N, K; };
struct StaticOrder {
    int nM, nN, nwg, G, c;
    __device__ void init(int M, int N, int G_, int c_) { nM = M / BM; nN = N / BM; nwg = nM * nN; G = G_; c = c_; }
    __device__ bool next(int i, Unit& u) const {
        const long L = (long)i * G + c; if (L >= nwg) return false;
        int wgid = (int)L; { const int q = nwg / NXCD, r = nwg % NXCD, xcd = wgid % NXCD, off = wgid / NXCD; wgid = (xcd < r ? xcd * (q + 1) : r * (q + 1) + (xcd - r) * q) + off; }
        const int nig = WGM * nN, gid = wgid / nig, fm = gid * WGM, gsz = (nM - fm) < WGM ? (nM - fm) : WGM;
        u.pm = fm + ((wgid % nig) % gsz); u.pn = (wgid % nig) / gsz; return true;
    }
};
struct EpiBf16 {
    static constexpr bool PERM = true;
    bf16_t* O; int ldc;
    __device__ __forceinline__ void operator()(const f32x4 (&acc)[2][2][4][2], const Unit& u, int wr, int wc, int fr, int fq) const {
        const int row0 = u.pm * BM + wr * 64 + fr; const int col0 = u.pn * BM + wc * 32 + 8 * fq;
#pragma unroll
        for (int ai = 0; ai < 2; ++ai)
#pragma unroll
            for (int m = 0; m < 4; ++m) { bf16_t* rowp = O + (size_t)(row0 + ai * HALF + m * 16) * ldc + col0;
#pragma unroll
                for (int bj = 0; bj < 2; ++bj) { const f32x4 v0 = acc[ai][bj][m][0], v1 = acc[ai][bj][m][1];
                    u32x4 w; w.x = cvtpk(v0[0], v0[1]); w.y = cvtpk(v0[2], v0[3]); w.z = cvtpk(v1[0], v1[1]); w.w = cvtpk(v1[2], v1[3]);
                    *(u32x4*)(rowp + bj * HALF) = w; } }
    }
};
struct EpiSwiglu {
    static constexpr bool PERM = true;
    bf16_t* O; int ldc;
    __device__ __forceinline__ void operator()(const f32x4 (&acc)[2][2][4][2], const Unit& u, int wr, int wc, int fr, int fq) const {
        const int row0 = u.pm * BM + wr * 64 + fr; const int col0 = u.pn * HALF + wc * 32 + 8 * fq;
#pragma unroll
        for (int ai = 0; ai < 2; ++ai)
#pragma unroll
            for (int m = 0; m < 4; ++m) { bf16_t* rowp = O + (size_t)(row0 + ai * HALF + m * 16) * ldc + col0;
                float o[8];
#pragma unroll
                for (int n = 0; n < 2; ++n)
#pragma unroll
                    for (int j = 0; j < 4; ++j) { const float g = acc[ai][0][m][n][j], up = acc[ai][1][m][n][j]; o[n * 4 + j] = g * __builtin_amdgcn_rcpf(1.f + __expf(-g)) * up; }
                u32x4 w; w.x = cvtpk(o[0], o[1]); w.y = cvtpk(o[2], o[3]); w.z = cvtpk(o[4], o[5]); w.w = cvtpk(o[6], o[7]);
                *(u32x4*)rowp = w; }
    }
};
struct EpiResid {
    static constexpr bool PERM = false;
    const float* resLat; const float* resCtx; float* outLat; float* outCtx; const float* modl; int goff;
    __device__ __forceinline__ void operator()(const f32x4 (&acc)[2][2][4][2], const Unit& u, int wr, int wc, int fr, int fq) const {
        const int rowt = u.pm * BM; const bool lat = rowt < NLAT;
        const float* res = lat ? resLat + (size_t)rowt * DM : resCtx + (size_t)(rowt - NLAT) * DM;
        float* out = lat ? outLat + (size_t)rowt * DM : outCtx + (size_t)(rowt - NLAT) * DM;
        const float* gate = modl + (size_t)(lat ? (rowt >> 13) : 8) * 6144 + goff;
        const int row0 = wr * 64 + fr, col0 = u.pn * BM + wc * 32 + 4 * fq;
        f32x4 gv[2][2];
#pragma unroll
        for (int bj = 0; bj < 2; ++bj)
#pragma unroll
            for (int n = 0; n < 2; ++n) gv[bj][n] = *(const f32x4*)(gate + col0 + bj * HALF + n * 16);
#pragma unroll
        for (int ai = 0; ai < 2; ++ai)
#pragma unroll
            for (int m = 0; m < 4; ++m) { const size_t off = (size_t)(row0 + ai * HALF + m * 16) * DM + col0;
#pragma unroll
                for (int bj = 0; bj < 2; ++bj)
#pragma unroll
                    for (int n = 0; n < 2; ++n) { const f32x4 r = *(const f32x4*)(res + off + bj * HALF + n * 16);
                        *(f32x4*)(out + off + bj * HALF + n * 16) = r + gv[bj][n] * acc[ai][bj][m][n]; } }
    }
};

template <class Epi, class Sched>
__device__ __forceinline__ void gemm_phase(LAS unsigned char* lds, const Gemm g, const Sched& S, const Epi& E) {
    const int tid = threadIdx.x, wid = __builtin_amdgcn_readfirstlane(tid >> 6), lane = tid & 63, wr = wid >> 2, wc = wid & 3, fr = lane & 15, fq = lane >> 4;
    const int K = g.K, nt = K / BK;
    unsigned voffA[2], voffB[2];
#pragma unroll
    for (int i = 0; i < 2; ++i) { int R, C; stage_rc(tid * 16 + i * 8192, R, C); const int Rb = Epi::PERM ? ((R & ~31) + perm32(R & 31)) : R;
        voffA[i] = (unsigned)(R * K + C) * 2u; voffB[i] = (unsigned)(Rb * K + C) * 2u; }
    const size_t kstep = (size_t)(BK * 2);
    const size_t hstep = (size_t)HALF * K * 2;
    const size_t tstep = 2 * hstep;
    const unsigned ldsw = (unsigned)wid * 1024u;
    const int aoff = lds_byte(wr * 64 + fr, fq * 8), boff = lds_byte(wc * 32 + fr, fq * 8);
#define PG8_SA(b, h) (((b) * 2 + (h)) * HTB)
#define PG8_SB(b, h) ((4 + (b) * 2 + (h)) * HTB)
#define PG8_STAGE(bufoff, gbase, voff) do { _Pragma("unroll") for (int _i = 0; _i < 2; ++_i) \
        __builtin_amdgcn_global_load_lds((const unsigned*)((const char*)(gbase) + (voff)[_i]), (LAS unsigned*)(lds + (bufoff) + ldsw + _i * 8192), 16, 0, 0); } while (0)
#define PG8_LDA(dst, b, h) do { _Pragma("unroll") for (int m = 0; m < 4; ++m) _Pragma("unroll") for (int k = 0; k < 2; ++k) dst[m][k] = *(const LAS bf16x8*)(lds + PG8_SA(b, h) + aoff + m * 2048 + k * 1024); } while (0)
#define PG8_LDB(dst, b, h) do { _Pragma("unroll") for (int n = 0; n < 2; ++n) _Pragma("unroll") for (int k = 0; k < 2; ++k) dst[n][k] = *(const LAS bf16x8*)(lds + PG8_SB(b, h) + boff + n * 2048 + k * 1024); } while (0)
#define PG8_MMA(ai, bj, At, Bt) do { __builtin_amdgcn_s_setprio(1); _Pragma("unroll") for (int m = 0; m < 4; ++m) _Pragma("unroll") for (int n = 0; n < 2; ++n) _Pragma("unroll") for (int k = 0; k < 2; ++k) \
        acc[ai][bj][m][n] = __builtin_amdgcn_mfma_f32_16x16x32_bf16(Bt[n][k], At[m][k], acc[ai][bj][m][n], 0, 0, 0); __builtin_amdgcn_s_setprio(0); } while (0)
#define PG8_WAIT_V(n) asm volatile("s_waitcnt vmcnt(" #n ")" ::: "memory")
#define PG8_WAIT_L(n) asm volatile("s_waitcnt lgkmcnt(" #n ")" ::: "memory")
#define PG8_BAR __builtin_amdgcn_s_barrier()
#define PG8_SCHED __builtin_amdgcn_sched_barrier(0)
    Unit cur, nxt; int ui = 0;
    if (!S.next(0, cur)) return;
    f32x4 acc[2][2][4][2];
#pragma unroll
    for (int a = 0; a < 2; ++a)
#pragma unroll
        for (int b = 0; b < 2; ++b)
#pragma unroll
            for (int m = 0; m < 4; ++m)
#pragma unroll
                for (int n = 0; n < 2; ++n) acc[a][b][m][n] = (f32x4){0.f, 0.f, 0.f, 0.f};
    bf16x8 At[4][2], B0[2][2], B1[2][2];
    const char* cA = (const char*)g.A + (size_t)cur.pm * tstep; const char* cB = (const char*)g.Bt + (size_t)cur.pn * tstep;
    PG8_STAGE(PG8_SB(0, 0), cB, voffB); PG8_STAGE(PG8_SA(0, 0), cA, voffA); PG8_STAGE(PG8_SB(0, 1), cB + hstep, voffB); PG8_STAGE(PG8_SA(0, 1), cA + hstep, voffA);
    if (wr == 1) PG8_BAR;
    PG8_WAIT_V(4); PG8_BAR;
    PG8_STAGE(PG8_SB(1, 0), cB + kstep, voffB); PG8_STAGE(PG8_SA(1, 0), cA + kstep, voffA); PG8_STAGE(PG8_SB(1, 1), cB + hstep + kstep, voffB);
    PG8_WAIT_V(6); PG8_BAR;
    for (;;) {
        const bool has_next = S.next(ui + 1, nxt);
        const char* nA = has_next ? (const char*)g.A + (size_t)nxt.pm * tstep : cA; const char* nB = has_next ? (const char*)g.Bt + (size_t)nxt.pn * tstep : cB;
        for (int t = 0; t < nt; t += 2) {
            const bool last = (t == nt - 2);
            const char* a1 = cA + (size_t)(t + 1) * kstep;
            const char* a2 = last ? nA : cA + (size_t)(t + 2) * kstep; const char* b2 = last ? nB : cB + (size_t)(t + 2) * kstep;
            const char* a3 = a2 + kstep; const char* b3 = b2 + kstep;
            PG8_LDB(B0, 0, 0); PG8_SCHED; PG8_LDA(At, 0, 0); PG8_STAGE(PG8_SA(1, 1), a1 + hstep, voffA);
            PG8_WAIT_L(8); PG8_BAR; PG8_WAIT_L(0); PG8_MMA(0, 0, At, B0); PG8_BAR; PG8_SCHED;
            PG8_LDB(B1, 0, 1); PG8_STAGE(PG8_SB(0, 0), b2, voffB);
            PG8_BAR; PG8_WAIT_L(0); PG8_MMA(0, 1, At, B1); PG8_BAR;
            PG8_LDA(At, 0, 1); PG8_STAGE(PG8_SA(0, 0), a2, voffA);
            PG8_BAR; PG8_WAIT_L(0); PG8_MMA(1, 0, At, B0); PG8_BAR; PG8_SCHED;
            PG8_STAGE(PG8_SB(0, 1), b2 + hstep, voffB);
            PG8_WAIT_V(6); PG8_BAR; PG8_MMA(1, 1, At, B1); PG8_BAR;
            PG8_LDB(B0, 1, 0); PG8_SCHED; PG8_LDA(At, 1, 0); PG8_STAGE(PG8_SA(0, 1), a2 + hstep, voffA);
            PG8_WAIT_L(8); PG8_BAR; PG8_WAIT_L(0); PG8_MMA(0, 0, At, B0); PG8_BAR; PG8_SCHED;
            PG8_LDB(B1, 1, 1); PG8_STAGE(PG8_SB(1, 0), b3, voffB);
            PG8_BAR; PG8_WAIT_L(0); PG8_MMA(0, 1, At, B1); PG8_BAR;
            PG8_LDA(At, 1, 1); PG8_STAGE(PG8_SA(1, 0), a3, voffA);
            PG8_BAR; PG8_WAIT_L(0); PG8_MMA(1, 0, At, B0); PG8_BAR; PG8_SCHED;
            PG8_STAGE(PG8_SB(1, 1), b3 + hstep, voffB);
            PG8_WAIT_V(6); PG8_BAR; PG8_MMA(1, 1, At, B1); PG8_BAR;
        }
        E(acc, cur, wr, wc, fr, fq);
        if (!has_next) break;
#pragma unroll
        for (int a = 0; a < 2; ++a)
#pragma unroll
            for (int b = 0; b < 2; ++b)
#pragma unroll
                for (int m = 0; m < 4; ++m)
#pragma unroll
                    for (int n = 0; n < 2; ++n) acc[a][b][m][n] = (f32x4){0.f, 0.f, 0.f, 0.f};
        cur = nxt; cA = nA; cB = nB; ++ui;
    }
    PG8_WAIT_V(0);
    if (wr == 0) PG8_BAR;
    PG8_BAR;
#undef PG8_SA
#undef PG8_SB
#undef PG8_STAGE
#undef PG8_LDA
#undef PG8_LDB
#undef PG8_MMA
#undef PG8_WAIT_V
#undef PG8_WAIT_L
#undef PG8_BAR
#undef PG8_SCHED
}
}

#define KSWZ(row, colB) ((row) * 256 + ((colB) ^ (((row) & 7) << 4)))
#define SBAR() __builtin_amdgcn_sched_barrier(0)
__device__ __forceinline__ int crow(int r, int hi) { return (r & 3) + 8 * (r >> 2) + 4 * hi; }
__device__ __forceinline__ int v_st(int k, int c) { const int kk = (k & ~0xC) | ((k & 4) << 1) | ((k & 8) >> 1); return ((kk >> 3) * 4 + (c >> 5)) * 512 + ((kk & 7) * 32 + (c & 31)) * 2; }
__device__ __forceinline__ int v_rd_base(int lane) { return ((lane & 3) << 3) | (((lane >> 2) & 3) << 6) | (((lane >> 4) & 1) << 5) | (((lane >> 5) & 1) << 8); }
constexpr int v_rd_off(int d0, int ks, int half) { return d0 * 512 + ks * 4096 + half * 2048; }
template <int OFF> __device__ __forceinline__ s16x4 tr_read(int vb) {
    s16x4 r; asm volatile("ds_read_b64_tr_b16 %0, %1 offset:%2" : "=&v"(r) : "v"(vb), "i"(OFF) : "memory"); return r;
}
template <int D0> __device__ __forceinline__ void pv_one(f32x16& od, int vb, bf16x8 pa0, bf16x8 pa1, bf16x8 pa2, bf16x8 pa3) {
    const s16x4 l0 = tr_read<v_rd_off(D0, 0, 0)>(vb), h0 = tr_read<v_rd_off(D0, 0, 1)>(vb), l1 = tr_read<v_rd_off(D0, 1, 0)>(vb), h1 = tr_read<v_rd_off(D0, 1, 1)>(vb);
    const s16x4 l2 = tr_read<v_rd_off(D0, 2, 0)>(vb), h2 = tr_read<v_rd_off(D0, 2, 1)>(vb), l3 = tr_read<v_rd_off(D0, 3, 0)>(vb), h3 = tr_read<v_rd_off(D0, 3, 1)>(vb);
    asm volatile("s_waitcnt lgkmcnt(0)" ::: "memory"); SBAR();
#define PK(L, H) (bf16x8){L[0], L[1], L[2], L[3], H[0], H[1], H[2], H[3]}
    od = __builtin_amdgcn_mfma_f32_32x32x16_bf16(pa0, PK(l0, h0), od, 0, 0, 0);
    od = __builtin_amdgcn_mfma_f32_32x32x16_bf16(pa1, PK(l1, h1), od, 0, 0, 0);
    od = __builtin_amdgcn_mfma_f32_32x32x16_bf16(pa2, PK(l2, h2), od, 0, 0, 0);
    od = __builtin_amdgcn_mfma_f32_32x32x16_bf16(pa3, PK(l3, h3), od, 0, 0, 0);
#undef PK
}
__device__ __forceinline__ void pv_d0(f32x16* o, int vb, bf16x8 pa0, bf16x8 pa1, bf16x8 pa2, bf16x8 pa3) {
    pv_one<0>(o[0], vb, pa0, pa1, pa2, pa3); pv_one<1>(o[1], vb, pa0, pa1, pa2, pa3); pv_one<2>(o[2], vb, pa0, pa1, pa2, pa3); pv_one<3>(o[3], vb, pa0, pa1, pa2, pa3);
}
#define PK4(P, BASE, OUT) do { unsigned a0 = cvtpk(P[BASE + 0], P[BASE + 1]), a1 = cvtpk(P[BASE + 2], P[BASE + 3]);   \
    unsigned b0 = cvtpk(P[BASE + 4], P[BASE + 5]), b1 = cvtpk(P[BASE + 6], P[BASE + 7]);                              \
    auto r0 = __builtin_amdgcn_permlane32_swap(a0, b0, false, false); auto r1 = __builtin_amdgcn_permlane32_swap(a1, b1, false, false); \
    u32x4 w = {r0[0], r1[0], r0[1], r1[1]}; OUT = *reinterpret_cast<bf16x8*>(&w); } while (0)
__device__ __forceinline__ float halfswap_add(float v) {
    auto rr = __builtin_amdgcn_permlane32_swap(__float_as_uint(v), __float_as_uint(v), false, false);
    return __uint_as_float(rr[0]) + __uint_as_float(rr[1]);
}

__device__ __forceinline__ void ada_phase(const Params& p, unsigned char* lds) {
    float* sc = (float*)lds;
    float* red = (float*)(lds + 40960);
    float* mod = (float*)(p.ws + WS_MOD);
    const int tid = threadIdx.x;
    for (int j = blockIdx.x; j < 192; j += gridDim.x) {
        const int l = j / 96, n0 = (j % 96) * 64;
        for (int i = tid; i < 9 * 1024; i += NTHREADS) { const int r = i >> 10, k = i & 1023; const float v = r < 8 ? p.c[r * 1024 + k] : p.c_ctx[k]; sc[i] = v / (1.f + expf(-v)); }
        __syncthreads();
        const int col = tid & 63, ks = tid >> 6;
        float acc[9];
#pragma unroll
        for (int r = 0; r < 9; ++r) acc[r] = 0.f;
        const float* wp = p.ada_w + ((size_t)l * 1024 + ks * 128) * 6144 + n0 + col;
#pragma unroll 8
        for (int kk = 0; kk < 128; ++kk) { const float w = wp[(size_t)kk * 6144];
#pragma unroll
            for (int r = 0; r < 9; ++r) acc[r] += sc[r * 1024 + ks * 128 + kk] * w; }
#pragma unroll
        for (int r = 0; r < 9; ++r) red[(ks * 9 + r) * 64 + col] = acc[r];
        __syncthreads();
        for (int i = tid; i < 576; i += NTHREADS) { const int r = i >> 6, cc = i & 63; float s = p.ada_b[l * 6144 + n0 + cc];
            for (int k2 = 0; k2 < 8; ++k2) s += red[(k2 * 9 + r) * 64 + cc];
            mod[(size_t)(l * 9 + r) * 6144 + n0 + cc] = s; }
        __syncthreads();
    }
}
__device__ __forceinline__ void wconv_phase(const Params& p, unsigned char* lds) {
    float* tl = (float*)lds;
    const int tid = threadIdx.x;
    const int T0 = 16 * 60, T1 = T0 + 16 * 16, T2 = T1 + 16 * 48, T3 = T2 + 16 * 16, T4 = T3 + 16 * 88, T5 = T4 + 16 * 88, T6 = T5 + 44 * 16, T7 = T6 + 44 * 16;
    for (int t = blockIdx.x; t < T7; t += gridDim.x) {
        const float* src; bf16_t* dst; int K, N, NP, mode = 0, tt;
        if (t < T0) { src = p.even_w_in; dst = (bf16_t*)(p.ws + WS_W_EVIN); K = 1024; N = EV_N; NP = EV_NP; tt = t; }
        else if (t < T1) { src = p.even_w_out; dst = (bf16_t*)(p.ws + WS_W_EVOUT); K = 1024; N = 1024; NP = 1024; tt = t - T0; }
        else if (t < T2) { src = p.odd_w_in; dst = (bf16_t*)(p.ws + WS_W_ODIN); K = 1024; N = OD_N; NP = OD_N; tt = t - T1; }
        else if (t < T3) { src = p.odd_w_out; dst = (bf16_t*)(p.ws + WS_W_ODOUT); K = 1024; N = 1024; NP = 1024; tt = t - T2; }
        else if (t < T4) { src = p.ffn_w_in; dst = (bf16_t*)(p.ws + WS_W_FFIN); K = 1024; N = 2 * FF; NP = 2 * FF; mode = 1; tt = t - T3; }
        else if (t < T5) { src = p.ffn_w_in + (size_t)1024 * 2 * FF; dst = (bf16_t*)(p.ws + WS_W_FFIN) + (size_t)2 * FF * 1024; K = 1024; N = 2 * FF; NP = 2 * FF; mode = 1; tt = t - T4; }
        else if (t < T6) { src = p.ffn_w_out; dst = (bf16_t*)(p.ws + WS_W_FFOUT); K = FF; N = 1024; NP = 1024; tt = t - T5; }
        else { src = p.ffn_w_out + (size_t)FF * 1024; dst = (bf16_t*)(p.ws + WS_W_FFOUT) + (size_t)1024 * FF; K = FF; N = 1024; NP = 1024; tt = t - T6; }
        const int nnt = NP / 64; const int k0 = (tt / nnt) * 64, n0 = (tt % nnt) * 64;
        int sn0;
        if (mode == 1) { const int tb = n0 >> 8, bj = (n0 >> 7) & 1, i0 = n0 & 127; sn0 = bj * FF + tb * 128 + i0; } else sn0 = n0;
        for (int e = tid; e < 4096; e += NTHREADS) { const int kk = e >> 6, nn = e & 63; const int sn = sn0 + nn;
            tl[kk * 65 + nn] = (sn < N) ? src[(size_t)(k0 + kk) * N + sn] : 0.f; }
        __syncthreads();
        for (int e = tid; e < 2048; e += NTHREADS) { const int nn = e >> 5, k2 = (e & 31) * 2;
            *(unsigned*)(dst + (size_t)(n0 + nn) * K + k0 + k2) = cvtpk(tl[k2 * 65 + nn], tl[(k2 + 1) * 65 + nn]); }
        __syncthreads();
    }
}

__device__ __forceinline__ void norm_phase(const Params& p, const float* xlat, const float* xctx, int l, int which, int nrows) {
    const int lane = threadIdx.x & 63, wid = threadIdx.x >> 6;
    bf16_t* h = (bf16_t*)(p.ws + WS_H);
    const float* mod = (const float*)(p.ws + WS_MOD) + (size_t)l * 9 * 6144;
    const float* gain = (which ? p.norm_ffn : p.norm_mix) + l * 1024;
    const int shoff = which ? 3072 : 0, scoff = which ? 4096 : 1024;
    const int stride = gridDim.x * 8;
    for (int row = blockIdx.x * 8 + wid; row < nrows; row += 2 * stride) {
        const int rowB = row + stride; const bool hasB = rowB < nrows;
        const float* srcA = row < NLAT ? xlat + (size_t)row * DM : xctx + (size_t)(row - NLAT) * DM;
        const float* srcB = hasB ? (rowB < NLAT ? xlat + (size_t)rowB * DM : xctx + (size_t)(rowB - NLAT) * DM) : srcA;
        f32x4 va[4], vb[4];
#pragma unroll
        for (int i = 0; i < 4; ++i) { va[i] = *(const f32x4*)(srcA + lane * 4 + 256 * i); vb[i] = *(const f32x4*)(srcB + lane * 4 + 256 * i); }
#pragma unroll
        for (int rr = 0; rr < 2; ++rr) {
            if (rr == 1 && !hasB) break;
            const int r = rr ? rowB : row;
            const float* mr = mod + (size_t)(r < NLAT ? (r >> 13) : 8) * 6144;
            float ss = 0.f;
#pragma unroll
            for (int i = 0; i < 4; ++i) { const f32x4 v = rr ? vb[i] : va[i]; ss += v[0] * v[0] + v[1] * v[1] + v[2] * v[2] + v[3] * v[3]; }
#pragma unroll
            for (int o = 1; o < 64; o <<= 1) ss += __shfl_xor(ss, o);
            const float rstd = rsqrtf(ss * (1.f / 1024.f) + 1e-6f);
#pragma unroll
            for (int i = 0; i < 4; ++i) { const int c0 = lane * 4 + 256 * i; const f32x4 v = rr ? vb[i] : va[i];
                const f32x4 g = *(const f32x4*)(gain + c0), s1 = *(const f32x4*)(mr + scoff + c0), sh = *(const f32x4*)(mr + shoff + c0);
                float y[4];
#pragma unroll
                for (int j = 0; j < 4; ++j) y[j] = v[j] * rstd * g[j] * (1.f + s1[j]) + sh[j];
                u32x2 w; w.x = cvtpk(y[0], y[1]); w.y = cvtpk(y[2], y[3]);
                *(u32x2*)(h + (size_t)r * DM + c0) = w; }
        }
    }
}

__device__ __forceinline__ void prep0_phase(const Params& p) {
    const int lane0 = threadIdx.x & 63, wid = threadIdx.x >> 6;
    bf16_t* proj = (bf16_t*)(p.ws + WS_PROJ);
    bf16_t* qkvp = (bf16_t*)p.out;
    float* gbuf = (float*)(p.ws + WS_GATES);
    const float* ropec = (const float*)(p.ws + WS_ROPE); const float* ropes = ropec + SEQ * 32;
    constexpr int RB = 8;
    for (int blk = blockIdx.x * 8 + wid; blk < MTOT / RB; blk += gridDim.x * 8) {
        int lane = lane0; asm volatile("" : "+v"(lane));
        const int row0 = blk * RB; const bool lat = row0 < NLAT; const int t0 = lat ? (row0 & 8191) : ((row0 - NLAT) & 255); const int len = lat ? SEQ : CTXL;
        const int dsub = (lane & 7) * 8;
        {
            float gq[8], gk[8];
#pragma unroll
            for (int i = 0; i < 8; ++i) { gq[i] = p.diff_qk_gain[dsub + i] * (0.125f * 1.4426950408889634f); gk[i] = p.diff_qk_gain[64 + dsub + i]; }
            for (int i = 0; i < RB; ++i) {
                bf16_t* P = proj + (size_t)(row0 + i) * EV_NP;
                f32x4 c4 = {1.f, 1.f, 1.f, 1.f}, s4 = {0.f, 0.f, 0.f, 0.f};
                if (lat) { c4 = *(const f32x4*)(ropec + (t0 + i) * 32 + (lane & 7) * 4); s4 = *(const f32x4*)(ropes + (t0 + i) * 32 + (lane & 7) * 4); }
#pragma unroll
                for (int which = 0; which < 2; ++which) {
                    float v[8]; unpack8(*(const bf16x8*)(P + which * 512 + lane * 8), v);
                    float ss = 0.f;
#pragma unroll
                    for (int e = 0; e < 8; ++e) ss += v[e] * v[e];
                    ss += __shfl_xor(ss, 1); ss += __shfl_xor(ss, 2); ss += __shfl_xor(ss, 4);
                    const float rstd = rsqrtf(ss * (1.f / 64.f) + 1e-6f);
#pragma unroll
                    for (int e = 0; e < 8; ++e) v[e] = v[e] * rstd * (which ? gk[e] : gq[e]);
#pragma unroll
                    for (int e = 0; e < 4; ++e) { const float x0 = v[2 * e], x1 = v[2 * e + 1]; v[2 * e] = x0 * c4[e] - x1 * s4[e]; v[2 * e + 1] = x0 * s4[e] + x1 * c4[e]; }
                    *(bf16x8*)(P + which * 512 + lane * 8) = pack8(v);
                }
            }
        }
#pragma unroll 1
        for (int g = 0; g < 3; ++g) {
            const int c0 = g * 512 + lane * 8;
            float w[5][8];
#pragma unroll
            for (int j = 0; j < 5; ++j) { const f32x4 w0 = *(const f32x4*)(p.gdn_conv + j * 1536 + c0), w1 = *(const f32x4*)(p.gdn_conv + j * 1536 + c0 + 4);
#pragma unroll
                for (int e = 0; e < 4; ++e) { w[j][e] = w0[e]; w[j][4 + e] = w1[e]; } }
            float xm2[8], xm1[8], x0[8], xp1[8], xp2[8];
            const bf16_t* src = proj + (size_t)row0 * EV_NP + 1536 + c0;
#define LDROW(dst, dt) do { if (t0 + (dt) >= 0 && t0 + (dt) < len) unpack8(*(const bf16x8*)(src + (ptrdiff_t)(dt) * EV_NP), dst); else { _Pragma("unroll") for (int e_ = 0; e_ < 8; ++e_) dst[e_] = 0.f; } } while (0)
            LDROW(xm2, -2); LDROW(xm1, -1); LDROW(x0, 0); LDROW(xp1, 1);
            const float nsc = g == 0 ? 0.08838834764831845f : 1.f;
            for (int i = 0; i < RB; ++i) {
                LDROW(xp2, i + 2);
                float y[8];
#pragma unroll
                for (int e = 0; e < 8; ++e) { y[e] = w[0][e] * xm2[e] + w[1][e] * xm1[e] + w[2][e] * x0[e] + w[3][e] * xp1[e] + w[4][e] * xp2[e]; y[e] = y[e] * __builtin_amdgcn_rcpf(1.f + __expf(-y[e])); }
                if (g < 2) { float ss = 0.f;
#pragma unroll
                    for (int e = 0; e < 8; ++e) ss += y[e] * y[e];
                    ss += __shfl_xor(ss, 1); ss += __shfl_xor(ss, 2); ss += __shfl_xor(ss, 4); ss += __shfl_xor(ss, 8);
                    const float sc_ = rsqrtf(ss + 1e-6f) * nsc;
#pragma unroll
                    for (int e = 0; e < 8; ++e) y[e] *= sc_; }
                *(bf16x8*)(qkvp + (size_t)(row0 + i) * 1536 + c0) = pack8(y);
#pragma unroll
                for (int e = 0; e < 8; ++e) { xm2[e] = xm1[e]; xm1[e] = x0[e]; x0[e] = xp1[e]; xp1[e] = xp2[e]; }
            }
#undef LDROW
        }
#pragma unroll
        for (int k = 0; k < RB / 4; ++k) { const int idx = lane + 64 * k, i = idx >> 4, gi = idx & 15;
            const float gvv = bf2f(proj[(size_t)(row0 + i) * EV_NP + 3584 + gi]); float o;
            if (gi < 8) o = 1.f / (1.f + expf(-gvv));
            else { const float z = gvv + p.gdn_dt_bias[gi - 8]; const float sp = z > 20.f ? z : log1pf(expf(z)); o = -expf(p.gdn_a_log[gi - 8]) * sp; }
            gbuf[(size_t)(row0 + i) * 16 + gi] = o; }
    }
}

__device__ __forceinline__ int gdn_row(int b, int pc, int tau, int dir) {
    const int tt = dir ? 63 - tau : tau;
    return pc < 4 ? NLAT + b * CTXL + pc * 64 + tt : b * SEQ + (pc - 4) * 64 + tt;
}
__device__ __forceinline__ void gdn_pre_phase(const Params& p, unsigned char* lds) {
    const int lane = threadIdx.x & 63, wid = threadIdx.x >> 6;
    float* Lw = (float*)(lds + wid * 16896);
    float* gs = Lw + 4096; float* bs = gs + 64;
    const bf16_t* qkvp = (const bf16_t*)p.out;
    const float* gbuf = (const float*)(p.ws + WS_GATES);
    bf16_t* Tb = (bf16_t*)(p.ws + WS_T); bf16_t* Ab = (bf16_t*)(p.ws + WS_AQK);
    float* gv = (float*)(p.ws + WS_GV); float* bv = (float*)(p.ws + WS_BV);
    const int lane0 = lane;
    for (int cp = blockIdx.x * 8 + wid; cp < NCHUNKP; cp += gridDim.x * 8) {
        int lane = lane0; asm volatile("" : "+v"(lane));
        const int r32 = lane & 31, hi = lane >> 5;
        const int pc = cp % 132, ch = cp / 132, dir = ch & 1, h = (ch >> 1) & 3, b = ch >> 3;
        { const int R = gdn_row(b, pc, lane, dir);
          float g = gbuf[(size_t)R * 16 + 8 + dir * 4 + h]; const float be = gbuf[(size_t)R * 16 + dir * 4 + h];
#pragma unroll
          for (int o = 1; o < 64; o <<= 1) { const float t = __shfl_up(g, o); if (lane >= o) g += t; }
          gs[lane] = g; bs[lane] = be; const float gl_ = __shfl(g, 63); gv[(size_t)cp * 64 + lane] = expf(g); bv[(size_t)cp * 64 + lane] = be; ((float*)(p.ws + WS_EL))[(size_t)cp * 64 + lane] = expf(gl_ - g); }
        bf16x8 kf[2][8];
#pragma unroll
        for (int mi = 0; mi < 2; ++mi) { const size_t R = (size_t)gdn_row(b, pc, 32 * mi + r32, dir);
#pragma unroll
            for (int d0 = 0; d0 < 8; ++d0) kf[mi][d0] = *(const bf16x8*)(qkvp + R * 1536 + 512 + h * 128 + d0 * 16 + hi * 8); }
        bf16_t* Ao = Ab + (size_t)cp * 4096;
#pragma unroll
        for (int mi = 0; mi < 2; ++mi) {
            bf16x8 qf[8];
            { const size_t R = (size_t)gdn_row(b, pc, 32 * mi + r32, dir);
#pragma unroll
              for (int d0 = 0; d0 < 8; ++d0) qf[d0] = *(const bf16x8*)(qkvp + R * 1536 + h * 128 + d0 * 16 + hi * 8); }
#pragma unroll
            for (int ni = 0; ni <= mi; ++ni) {
                f32x16 ckk = {}, cqk = {};
#pragma unroll
                for (int d0 = 0; d0 < 8; ++d0) { ckk = __builtin_amdgcn_mfma_f32_32x32x16_bf16(kf[mi][d0], kf[ni][d0], ckk, 0, 0, 0);
                                                 cqk = __builtin_amdgcn_mfma_f32_32x32x16_bf16(qf[d0], kf[ni][d0], cqk, 0, 0, 0); }
                const int sg = 32 * ni + r32; const float gsg = gs[sg];
#pragma unroll
                for (int r = 0; r < 16; ++r) { const int tau = 32 * mi + crow(r, hi);
                    const float dec = tau >= sg ? __expf(gs[tau] - gsg) : 0.f;
                    Lw[tau * 64 + sg] = tau > sg ? bs[tau] * dec * ckk[r] : 0.f;
                    Ao[tau * 64 + sg] = f2bf(cqk[r] * dec); }
                asm volatile("" ::: "memory");
            }
        }
#pragma unroll
        for (int r = 0; r < 16; ++r) Ao[crow(r, hi) * 64 + 32 + r32] = 0;
        float Tc[64];
#pragma unroll
        for (int i = 0; i < 64; ++i) { float a = (i == lane) ? 1.f : 0.f;
#pragma unroll
            for (int j = 0; j < i; ++j) a -= Lw[i * 64 + j] * Tc[j];
            Tc[i] = a; asm volatile("" ::: "memory"); }
        bf16_t* To = Tb + (size_t)cp * 4096;
#pragma unroll
        for (int i = 0; i < 64; ++i) To[i * 64 + lane] = f2bf(Tc[i]);
    }
}

constexpr int G_KV = 0, G_QA = 16384, G_TT = 32768, G_AQ = G_TT + 9216, G_RT = G_AQ + 9216, G_UT = G_RT + 4608, G_UP = G_UT + 4608,
              G_ST = G_UP + 4608, G_VS = G_ST + 8704, G_GS = G_VS + 4096, G_BS = G_GS + 256, G_EL = G_BS + 256, G_END = G_EL + 256;
__device__ __forceinline__ void gdn_scan_phase(const Params& p, unsigned char* lds) {
    const int tid = threadIdx.x, lane0 = tid & 63, wid = tid >> 6;
    const bf16_t* qkvp = (const bf16_t*)p.out;
    const bf16_t* Tb = (const bf16_t*)(p.ws + WS_T); const bf16_t* Ab = (const bf16_t*)(p.ws + WS_AQK);
    const float* gv = (const float*)(p.ws + WS_GV); const float* bv = (const float*)(p.ws + WS_BV);
    bf16_t* obuf = (bf16_t*)(p.ws + WS_H);
    const float* gsl = (const float*)(lds + G_GS); const float* bsl = (const float*)(lds + G_BS); const float* esl = (const float*)(lds + G_EL);
    const int sr = tid >> 4, sc = (tid & 15) * 8;
    const int vblk = (gridDim.x % 8 == 0) ? (int)((blockIdx.x & 7) * (gridDim.x >> 3) + (blockIdx.x >> 3)) : (int)blockIdx.x;
    for (int wi = vblk; wi < 256; wi += gridDim.x) {
        const int chain = wi >> 2, cs = wi & 3, b = chain >> 3, h = (chain >> 1) & 3, dir = chain & 1;
        f32x16 Sacc = {};
        for (int i = tid; i < 8704 / 4; i += NTHREADS) ((unsigned*)(lds + G_ST))[i] = 0u;
        bf16x8 sk0, sk1, sq0, sq1, sT, sA, sV; float sg = 0.f;
#define GLOAD(step) do { const int pc_ = dir == 0 ? (step) : ((step) < 4 ? 3 - (step) : 4 + 127 - ((step) - 4)); \
        const size_t cp_ = (size_t)chain * 132 + pc_; \
        const size_t R0_ = (size_t)gdn_row(b, pc_, sr, dir), R1_ = (size_t)gdn_row(b, pc_, 32 + sr, dir); \
        sk0 = *(const bf16x8*)(qkvp + R0_ * 1536 + 512 + h * 128 + sc); sk1 = *(const bf16x8*)(qkvp + R1_ * 1536 + 512 + h * 128 + sc); \
        sq0 = *(const bf16x8*)(qkvp + R0_ * 1536 + h * 128 + sc); sq1 = *(const bf16x8*)(qkvp + R1_ * 1536 + h * 128 + sc); \
        sT = *(const bf16x8*)(Tb + cp_ * 4096 + tid * 8); sA = *(const bf16x8*)(Ab + cp_ * 4096 + tid * 8); \
        if (tid < 256) { const size_t Rv_ = (size_t)gdn_row(b, pc_, tid >> 2, dir); sV = *(const bf16x8*)(qkvp + Rv_ * 1536 + 1024 + h * 128 + cs * 32 + (tid & 3) * 8); } \
        if (tid < 64) sg = gv[cp_ * 64 + tid]; else if (tid < 128) sg = bv[cp_ * 64 + tid - 64]; else if (tid < 192) sg = ((const float*)(p.ws + WS_EL))[cp_ * 64 + tid - 128]; } while (0)
#define GWRITE() do { *(bf16x8*)(lds + G_KV + v_st(sr, sc)) = sk0; *(bf16x8*)(lds + G_KV + v_st(32 + sr, sc)) = sk1; \
        *(bf16x8*)(lds + G_QA + KSWZ(sr, sc * 2)) = sq0; *(bf16x8*)(lds + G_QA + KSWZ(32 + sr, sc * 2)) = sq1; \
        *(bf16x8*)(lds + G_TT + (tid >> 3) * 144 + (tid & 7) * 16) = sT; *(bf16x8*)(lds + G_AQ + (tid >> 3) * 144 + (tid & 7) * 16) = sA; \
        if (tid < 256) *(bf16x8*)(lds + G_VS + (tid >> 2) * 64 + (tid & 3) * 16) = sV; \
        if (tid < 192) ((float*)(lds + G_GS))[tid] = sg; } while (0)
        GLOAD(0);
        for (int step = 0; step < 132; ++step) {
            GWRITE();
            __syncthreads();
            if (step + 1 < 132) GLOAD(step + 1);
            int lane = lane0; asm volatile("" : "+v"(lane));
            const int r32 = lane & 31, hi = lane >> 5;
            const int vb0 = (int)(uintptr_t)(lds + G_KV) + v_rd_base(lane);
            const int pc = dir == 0 ? step : (step < 4 ? 3 - step : 4 + 127 - (step - 4));
            f32x16 acc = {};
            const int mi = wid & 1;
            if (wid < 4) {
                f32x16 acc2 = {};
                if (wid < 2) {
#pragma unroll
                    for (int d0 = 0; d0 < 8; d0 += 2) {
                        const bf16x8 a0 = *(const bf16x8*)(lds + G_KV + v_st(32 * mi + r32, d0 * 16 + hi * 8)), a1 = *(const bf16x8*)(lds + G_KV + v_st(32 * mi + r32, d0 * 16 + 16 + hi * 8));
                        const bf16x8 b0 = *(const bf16x8*)(lds + G_ST + r32 * 272 + (d0 * 16 + hi * 8) * 2), b1 = *(const bf16x8*)(lds + G_ST + r32 * 272 + (d0 * 16 + 16 + hi * 8) * 2);
                        acc = __builtin_amdgcn_mfma_f32_32x32x16_bf16(a0, b0, acc, 0, 0, 0);
                        acc2 = __builtin_amdgcn_mfma_f32_32x32x16_bf16(a1, b1, acc2, 0, 0, 0); }
                } else {
#pragma unroll
                    for (int d0 = 0; d0 < 8; d0 += 2) {
                        const bf16x8 a0 = *(const bf16x8*)(lds + G_QA + KSWZ(32 * mi + r32, (d0 * 16 + hi * 8) * 2)), a1 = *(const bf16x8*)(lds + G_QA + KSWZ(32 * mi + r32, (d0 * 16 + 16 + hi * 8) * 2));
                        const bf16x8 b0 = *(const bf16x8*)(lds + G_ST + r32 * 272 + (d0 * 16 + hi * 8) * 2), b1 = *(const bf16x8*)(lds + G_ST + r32 * 272 + (d0 * 16 + 16 + hi * 8) * 2);
                        acc = __builtin_amdgcn_mfma_f32_32x32x16_bf16(a0, b0, acc, 0, 0, 0);
                        acc2 = __builtin_amdgcn_mfma_f32_32x32x16_bf16(a1, b1, acc2, 0, 0, 0); }
                }
#pragma unroll
                for (int r = 0; r < 16; ++r) acc[r] += acc2[r];
                if (wid < 2) {
#pragma unroll
                    for (int g4 = 0; g4 < 4; ++g4) { float rv[4];
#pragma unroll
                        for (int j = 0; j < 4; ++j) { const int tau = 32 * mi + 8 * g4 + 4 * hi + j;
                            const float vv = bf2f(*(const bf16_t*)(lds + G_VS + tau * 64 + r32 * 2));
                            rv[j] = bsl[tau] * (vv - gsl[tau] * acc[g4 * 4 + j]); }
                        u32x2 w; w.x = cvtpk(rv[0], rv[1]); w.y = cvtpk(rv[2], rv[3]);
                        *(u32x2*)(lds + G_RT + r32 * 144 + (32 * mi + 8 * g4 + 4 * hi) * 2) = w; }
                } else {
#pragma unroll
                    for (int r = 0; r < 16; ++r) acc[r] *= gsl[32 * mi + crow(r, hi)];
                }
            }
            __syncthreads();
            if (wid < 2) {
                f32x16 u = {}, u2 = {};
#pragma unroll
                for (int s = 0; s < 4; s += 2) {
                    const bf16x8 a0 = *(const bf16x8*)(lds + G_TT + (32 * mi + r32) * 144 + (16 * s + hi * 8) * 2), a1 = *(const bf16x8*)(lds + G_TT + (32 * mi + r32) * 144 + (16 * s + 16 + hi * 8) * 2);
                    const bf16x8 b0 = *(const bf16x8*)(lds + G_RT + r32 * 144 + (16 * s + hi * 8) * 2), b1 = *(const bf16x8*)(lds + G_RT + r32 * 144 + (16 * s + 16 + hi * 8) * 2);
                    u = __builtin_amdgcn_mfma_f32_32x32x16_bf16(a0, b0, u, 0, 0, 0);
                    u2 = __builtin_amdgcn_mfma_f32_32x32x16_bf16(a1, b1, u2, 0, 0, 0); }
#pragma unroll
                for (int r = 0; r < 16; ++r) u[r] += u2[r];
#pragma unroll
                for (int g4 = 0; g4 < 4; ++g4) { float uv[4], up[4];
#pragma unroll
                    for (int j = 0; j < 4; ++j) { const int tau = 32 * mi + 8 * g4 + 4 * hi + j; uv[j] = u[g4 * 4 + j]; up[j] = uv[j] * esl[tau]; }
                    u32x2 w; w.x = cvtpk(uv[0], uv[1]); w.y = cvtpk(uv[2], uv[3]);
                    *(u32x2*)(lds + G_UT + r32 * 144 + (32 * mi + 8 * g4 + 4 * hi) * 2) = w;
                    u32x2 w2; w2.x = cvtpk(up[0], up[1]); w2.y = cvtpk(up[2], up[3]);
                    *(u32x2*)(lds + G_UP + r32 * 144 + (32 * mi + 8 * g4 + 4 * hi) * 2) = w2; }
            }
            __syncthreads();
            if (wid == 2 || wid == 3) {
#pragma unroll
                for (int s = 0; s < 4; ++s) {
                    const bf16x8 a = *(const bf16x8*)(lds + G_AQ + (32 * mi + r32) * 144 + (16 * s + hi * 8) * 2);
                    const bf16x8 bb = *(const bf16x8*)(lds + G_UT + r32 * 144 + (16 * s + hi * 8) * 2);
                    acc = __builtin_amdgcn_mfma_f32_32x32x16_bf16(a, bb, acc, 0, 0, 0); }
#pragma unroll
                for (int r = 0; r < 16; ++r) { const size_t R = (size_t)gdn_row(b, pc, 32 * mi + crow(r, hi), dir);
                    obuf[((size_t)dir * MTOT + R) * 512 + h * 128 + cs * 32 + r32] = f2bf(acc[r]); }
            } else if (wid >= 4) {
                const float gl = gsl[63];
#pragma unroll
                for (int r = 0; r < 16; ++r) Sacc[r] *= gl;
                const bf16x8 pa0 = *(const bf16x8*)(lds + G_UP + r32 * 144 + (0 + hi * 8) * 2), pa1 = *(const bf16x8*)(lds + G_UP + r32 * 144 + (16 + hi * 8) * 2),
                             pa2 = *(const bf16x8*)(lds + G_UP + r32 * 144 + (32 + hi * 8) * 2), pa3 = *(const bf16x8*)(lds + G_UP + r32 * 144 + (48 + hi * 8) * 2);
                const int d0 = wid - 4;
                if (d0 == 0) pv_one<0>(Sacc, vb0, pa0, pa1, pa2, pa3); else if (d0 == 1) pv_one<1>(Sacc, vb0, pa0, pa1, pa2, pa3);
                else if (d0 == 2) pv_one<2>(Sacc, vb0, pa0, pa1, pa2, pa3); else pv_one<3>(Sacc, vb0, pa0, pa1, pa2, pa3);
#pragma unroll
                for (int r = 0; r < 16; ++r) *(bf16_t*)(lds + G_ST + crow(r, hi) * 272 + (32 * d0 + r32) * 2) = f2bf(Sacc[r]);
            }
            __syncthreads();
        }
#undef GLOAD
#undef GWRITE
    }
}

__device__ __forceinline__ void gdn_post_phase(const Params& p) {
    const int lane = threadIdx.x & 63, wid = threadIdx.x >> 6;
    const bf16_t* obuf = (const bf16_t*)(p.ws + WS_H);
    const bf16_t* proj = (const bf16_t*)(p.ws + WS_PROJ);
    bf16_t* mix = (bf16_t*)(p.ws + WS_MIX);
    const int d = (lane & 15) * 8;
    for (int row = blockIdx.x * 8 + wid; row < MTOT; row += gridDim.x * 8) {
        float a[8], bb[8], g[8], y[8];
        unpack8(*(const bf16x8*)(obuf + (size_t)row * 512 + lane * 8), a);
        unpack8(*(const bf16x8*)(obuf + ((size_t)MTOT + row) * 512 + lane * 8), bb);
        unpack8(*(const bf16x8*)(proj + (size_t)row * EV_NP + 3072 + lane * 8), g);
        float ss = 0.f;
#pragma unroll
        for (int i = 0; i < 8; ++i) { a[i] += bb[i]; ss += a[i] * a[i]; }
        ss += __shfl_xor(ss, 1); ss += __shfl_xor(ss, 2); ss += __shfl_xor(ss, 4); ss += __shfl_xor(ss, 8);
        const float rstd = rsqrtf(ss * (1.f / 128.f) + 1e-6f);
#pragma unroll
        for (int i = 0; i < 8; ++i) y[i] = a[i] * rstd * p.gdn_norm[d + i] * (g[i] * __builtin_amdgcn_rcpf(1.f + __expf(-g[i])));
        *(bf16x8*)(mix + (size_t)row * DM + 512 + lane * 8) = pack8(y);
    }
}

__device__ __forceinline__ void diffattn_phase(const Params& p, unsigned char* lds) {
    const int tid = threadIdx.x, wid = tid >> 6, lane = tid & 63, r32 = lane & 31, hi = lane >> 5;
    const bf16_t* proj = (const bf16_t*)(p.ws + WS_PROJ);
    bf16_t* mix = (bf16_t*)(p.ws + WS_MIX);
    float s01 = 0.f, s23 = 0.f;
    for (int i = 0; i < 64; ++i) { s01 += p.diff_lambda[i] * p.diff_lambda[64 + i]; s23 += p.diff_lambda[128 + i] * p.diff_lambda[192 + i]; }
    const float lam = expf(s01) - expf(s23) + 0.2f;
    float* X = (float*)lds; float* li = (float*)(lds + 131072) + wid * 64;
    LAS unsigned char* ldsl = (LAS unsigned char*)lds;
    int koff[2], voff[2];
#pragma unroll
    for (int i = 0; i < 2; ++i) {
        const int g = i * 512 + tid;
        { const int row = g >> 4, cg = (g & 15) ^ (row & 7); koff[i] = row * EV_NP + cg * 8; }
        { const int o = g * 16, st = o >> 9, w = o & 511, kk = (st >> 2) * 8 + (w >> 6);
          const int k = (kk & ~0xC) | ((kk & 4) << 1) | ((kk & 8) >> 1), cc = (st & 3) * 32 + ((w & 63) >> 4) * 8; voff[i] = k * EV_NP + cc; }
    }
    const int vbase = (int)(uintptr_t)lds + v_rd_base(lane);
    const int map = wid >> 2, wq = wid & 3;
    unsigned char* Qs = lds + 98304 + wid * 4096 + lane * 16;
    const int vblk = (gridDim.x % 8 == 0) ? (int)((blockIdx.x & 7) * (gridDim.x >> 3) + (blockIdx.x >> 3)) : (int)blockIdx.x;
    for (int it = vblk; it < 2112; it += gridDim.x) {
        int b, h, NT, qrow0;
        if (it < 2048) { b = it >> 8; h = (it >> 6) & 3; const int qb = it & 63; NT = 132; qrow0 = b * SEQ + qb * 128; }
        else { const int j = it - 2048; b = j >> 3; h = (j >> 1) & 3; NT = 4; qrow0 = NLAT + b * CTXL + (j & 1) * 128; }
        bf16x8 qr[4];
        { const bf16_t* qp = proj + (size_t)(qrow0 + 32 * wq + r32) * EV_NP + h * 128 + map * 64 + hi * 8;
#pragma unroll
          for (int d0 = 0; d0 < 4; ++d0) qr[d0] = *(const bf16x8*)(qp + d0 * 16); }
        f32x16 o[4] = {}; float lsum = 0.f;
#define DDMA(j, bo) do { const bf16_t* pp_ = proj + (size_t)((j) < 4 ? NLAT + b * CTXL + 64 * (j) : b * SEQ + 64 * ((j) - 4)) * EV_NP + h * 128; \
        _Pragma("unroll") for (int i_ = 0; i_ < 2; ++i_) { \
            __builtin_amdgcn_global_load_lds((const unsigned*)(pp_ + 1024 + voff[i_]), (LAS unsigned*)(ldsl + (bo) + i_ * 8192 + wid * 1024), 16, 0, 0); \
            __builtin_amdgcn_global_load_lds((const unsigned*)(pp_ + 512 + koff[i_]), (LAS unsigned*)(ldsl + (bo) + 16384 + i_ * 8192 + wid * 1024), 16, 0, 0); } } while (0)
#define DQK(P0, P1, bo) do { P0 = (f32x16){}; P1 = (f32x16){}; const unsigned char* Ks_ = lds + (bo) + 16384; \
        _Pragma("unroll") for (int d0 = 0; d0 < 4; ++d0) { const int cb_ = (map * 64 + d0 * 16 + hi * 8) * 2; \
            const bf16x8 b0_ = *(const bf16x8*)(Ks_ + KSWZ(r32, cb_)), b1_ = *(const bf16x8*)(Ks_ + KSWZ(32 + r32, cb_)); \
            P0 = __builtin_amdgcn_mfma_f32_32x32x16_bf16(b0_, qr[d0], P0, 0, 0, 0); \
            P1 = __builtin_amdgcn_mfma_f32_32x32x16_bf16(b1_, qr[d0], P1, 0, 0, 0); } } while (0)
#define DSM(P0, P1) do { _Pragma("unroll") for (int r = 0; r < 16; ++r) { P0[r] = __builtin_amdgcn_exp2f(P0[r]); P1[r] = __builtin_amdgcn_exp2f(P1[r]); lsum += P0[r] + P1[r]; } \
        PK4(P0, 0, pa0); PK4(P0, 8, pa1); PK4(P1, 0, pa2); PK4(P1, 8, pa3); } while (0)
#define DTAIL_() asm volatile("s_waitcnt vmcnt(0)" ::: "memory"); __syncthreads(); { const int t_ = bprev; bprev = bcur; bcur = bnext; bnext = t_; }
#define DSTEP_A(N0, N1, O0, O1, j) do { if ((j) + 1 < NT) DDMA((j) + 1, bnext); \
        DQK(N0, N1, bcur); DSM(O0, O1); pv_d0(o, vbase + bprev, pa0, pa1, pa2, pa3); DTAIL_() } while (0)
#define DSTEP_B(N0, N1, O0, O1, j) do { if ((j) + 1 < NT) DDMA((j) + 1, bnext); \
        DSM(O0, O1); pv_d0(o, vbase + bprev, pa0, pa1, pa2, pa3); SBAR(); DQK(N0, N1, bcur); DTAIL_() } while (0)
        f32x16 pA0, pA1, pB0, pB1; bf16x8 pa0, pa1, pa2, pa3;
        DDMA(0, 0); DDMA(1, 32768); asm volatile("s_waitcnt vmcnt(0)" ::: "memory"); __syncthreads();
        DQK(pA0, pA1, 0);
        int bprev = 0, bcur = 32768, bnext = 65536;
        if (map == 0) {
            for (int j = 1; j + 1 < NT; j += 2) { DSTEP_A(pB0, pB1, pA0, pA1, j); DSTEP_A(pA0, pA1, pB0, pB1, j + 1); }
            DSTEP_A(pB0, pB1, pA0, pA1, NT - 1);
        } else {
            for (int j = 1; j + 1 < NT; j += 2) { DSTEP_B(pB0, pB1, pA0, pA1, j); DSTEP_B(pA0, pA1, pB0, pB1, j + 1); }
            DSTEP_B(pB0, pB1, pA0, pA1, NT - 1);
        }
        DSM(pB0, pB1); pv_d0(o, vbase + bprev, pa0, pa1, pa2, pa3);
        __syncthreads();
#undef DDMA
#undef DQK
#undef DSM
#undef DSTEP_A
#undef DSTEP_B
#undef DTAIL_
        const float lt = halfswap_add(lsum);
        if (hi == 0) li[r32] = lt;
        asm volatile("s_waitcnt lgkmcnt(0)" ::: "memory");
        float rli[16];
#pragma unroll
        for (int r = 0; r < 16; ++r) rli[r] = 1.f / li[crow(r, hi)];
        if (map == 1) {
#pragma unroll
            for (int d0 = 0; d0 < 4; ++d0)
#pragma unroll
                for (int r = 0; r < 16; ++r) X[(wq * 64 + d0 * 16 + r) * 64 + lane] = o[d0][r] * rli[r] * lam;
        }
        __syncthreads();
        if (map == 0) {
#pragma unroll
            for (int d0 = 0; d0 < 4; ++d0)
#pragma unroll
                for (int r = 0; r < 16; ++r) o[d0][r] = o[d0][r] * rli[r] - X[(wq * 64 + d0 * 16 + r) * 64 + lane];
#pragma unroll
            for (int r = 0; r < 16; ++r) {
                float ss = o[0][r] * o[0][r] + o[1][r] * o[1][r] + o[2][r] * o[2][r] + o[3][r] * o[3][r];
                ss += __shfl_xor(ss, 1); ss += __shfl_xor(ss, 2); ss += __shfl_xor(ss, 4); ss += __shfl_xor(ss, 8); ss += __shfl_xor(ss, 16);
                const float rstd = rsqrtf(ss * (1.f / 128.f) + 1e-6f) * 0.8f;
                bf16_t* mp = mix + (size_t)(qrow0 + 32 * wq + crow(r, hi)) * DM + h * 128 + r32;
#pragma unroll
                for (int d0 = 0; d0 < 4; ++d0) mp[32 * d0] = f2bf(o[d0][r] * rstd * p.diff_subln[32 * d0 + r32]);
            }
        }
        __syncthreads();
    }
}

__device__ __forceinline__ void natten_phase(const Params& p, unsigned char* lds) {
    const int tid = threadIdx.x, wid = tid >> 6, lane = tid & 63, r32 = lane & 31, hi = lane >> 5;
    const bf16_t* proj = (const bf16_t*)(p.ws + WS_PROJ);
    bf16_t* mix = (bf16_t*)(p.ws + WS_MIX);
    constexpr float L2E = 1.4426950408889634f;
    unsigned char* Vl = lds; unsigned char* Kl = lds + 32768;
    float* rpbs = (float*)(lds + 65536);
    float* li = (float*)(lds + 133120) + wid * 64;
    unsigned char* Qs = lds + 67584 + wid * 8192 + lane * 16;
    const int sr = tid >> 4, sc = (tid & 15) * 8, vst0 = v_st(sr, sc), vst1 = v_st(32 + sr, sc);
    const int vb0 = (int)(uintptr_t)Vl + v_rd_base(lane);
    const float* gkp = p.na_qk_gain + 128 + sc;
    const int vblk = (gridDim.x % 8 == 0) ? (int)((blockIdx.x & 7) * (gridDim.x >> 3) + (blockIdx.x >> 3)) : (int)blockIdx.x;
    for (int it = vblk; it < 2048; it += gridDim.x) {
        const int b = it >> 8, h = (it >> 5) & 7, rq = it & 31;
        const int grow = 4 * rq + (wid >> 1), qc = (wid & 1) * 32 + r32;
        const size_t qR = (size_t)b * SEQ + grow * 64 + qc;
        for (int i = tid; i < 465; i += NTHREADS) rpbs[i] = p.na_rpb[h * 465 + i] * L2E;
        { float ss = 0.f;
#pragma unroll
          for (int d0 = 0; d0 < 8; ++d0) { float qv[8]; unpack8(*(const bf16x8*)(proj + qR * OD_N + h * 128 + d0 * 16 + hi * 8), qv);
#pragma unroll
              for (int i = 0; i < 8; ++i) ss += qv[i] * qv[i]; }
          ss = halfswap_add(ss);
          const float rs = rsqrtf(ss * (1.f / 128.f) + 1e-6f) * 0.08838834764831845f * L2E;
#pragma unroll
          for (int d0 = 0; d0 < 8; ++d0) { float qv[8]; unpack8(*(const bf16x8*)(proj + qR * OD_N + h * 128 + d0 * 16 + hi * 8), qv);
#pragma unroll
              for (int i = 0; i < 8; ++i) qv[i] *= rs * p.na_qk_gain[d0 * 16 + hi * 8 + i];
              *(bf16x8*)(Qs + d0 * 1024) = pack8(qv); } }
        int lo = 4 * rq - 4; lo = lo < 0 ? 0 : (lo > 120 ? 120 : lo);
        int hi_r = 4 * rq + 3 - 4; hi_r = hi_r < 0 ? 0 : (hi_r > 120 ? 120 : hi_r); hi_r += 7;
        const int nlat = hi_r - lo + 1, NT = nlat + 4;
        int wsr = grow - 4; wsr = wsr < 0 ? 0 : (wsr > 120 ? 120 : wsr);
        int cst = qc - 8; cst = cst < 0 ? 0 : (cst > 48 ? 48 : cst);
        f32x16 o[4] = {}; float lsum = 0.f;
        bf16x8 vs0, vs1, ks0, ks1;
#define NLOAD(j) do { const size_t R0_ = (size_t)((j) < nlat ? b * SEQ + (lo + (j)) * 64 : NLAT + b * CTXL + 64 * ((j) - nlat)) + sr; \
        const bf16_t* pp_ = proj + R0_ * OD_N + h * 128 + sc; \
        vs0 = *(const bf16x8*)(pp_ + 2048); vs1 = *(const bf16x8*)(pp_ + 2048 + (size_t)32 * OD_N); \
        ks0 = *(const bf16x8*)(pp_ + 1024); ks1 = *(const bf16x8*)(pp_ + 1024 + (size_t)32 * OD_N); } while (0)
#define KNORM(kx) do { float f_[8]; unpack8(kx, f_); float ss_ = 0.f; _Pragma("unroll") for (int i_ = 0; i_ < 8; ++i_) ss_ += f_[i_] * f_[i_]; \
        ss_ += __shfl_xor(ss_, 1); ss_ += __shfl_xor(ss_, 2); ss_ += __shfl_xor(ss_, 4); ss_ += __shfl_xor(ss_, 8); \
        const float rs_ = rsqrtf(ss_ * (1.f / 128.f) + 1e-6f); _Pragma("unroll") for (int i_ = 0; i_ < 8; ++i_) f_[i_] *= rs_ * gkp[i_]; kx = pack8(f_); } while (0)
#define NWRITE(bf) do { KNORM(ks0); KNORM(ks1); *(bf16x8*)(Vl + (bf) * 16384 + vst0) = vs0; *(bf16x8*)(Vl + (bf) * 16384 + vst1) = vs1; \
        *(bf16x8*)(Kl + (bf) * 16384 + KSWZ(sr, sc * 2)) = ks0; *(bf16x8*)(Kl + (bf) * 16384 + KSWZ(32 + sr, sc * 2)) = ks1; } while (0)
        NLOAD(0); NWRITE(0); __syncthreads();
        for (int j = 0; j < NT; ++j) {
            if (j + 1 < NT) NLOAD(j + 1);
            const int bf = j & 1;
            const bool islat = j < nlat; const int kr = lo + j;
            const bool active = !islat || (kr >= wsr && kr <= wsr + 7);
            if (active) {
                f32x16 p0 = {}, p1 = {};
                const unsigned char* Ks = Kl + bf * 16384;
#pragma unroll
                for (int d0 = 0; d0 < 8; ++d0) { const int cb = (d0 * 16 + hi * 8) * 2;
                    const bf16x8 b0 = *(const bf16x8*)(Ks + KSWZ(r32, cb)), b1 = *(const bf16x8*)(Ks + KSWZ(32 + r32, cb));
                    const bf16x8 qd = *(const bf16x8*)(Qs + d0 * 1024);
                    p0 = __builtin_amdgcn_mfma_f32_32x32x16_bf16(b0, qd, p0, 0, 0, 0);
                    p1 = __builtin_amdgcn_mfma_f32_32x32x16_bf16(b1, qd, p1, 0, 0, 0); }
                if (islat) {
                    const float* rb = rpbs + (kr - grow + 7) * 31 + 15 - qc + 4 * hi;
                    const int mofs = 4 * hi - cst;
#pragma unroll
                    for (int r = 0; r < 16; ++r) {
                        const int kb = (r & 3) + 8 * (r >> 2);
                        const float e0 = __builtin_amdgcn_exp2f(p0[r] + rb[kb]), e1 = __builtin_amdgcn_exp2f(p1[r] + rb[32 + kb]);
                        p0[r] = ((unsigned)(kb + mofs) < 16u) ? e0 : 0.f; p1[r] = ((unsigned)(32 + kb + mofs) < 16u) ? e1 : 0.f;
                        lsum += p0[r] + p1[r]; }
                } else {
#pragma unroll
                    for (int r = 0; r < 16; ++r) { p0[r] = __builtin_amdgcn_exp2f(p0[r]); p1[r] = __builtin_amdgcn_exp2f(p1[r]); lsum += p0[r] + p1[r]; }
                }
                bf16x8 pa0, pa1, pa2, pa3;
                PK4(p0, 0, pa0); PK4(p0, 8, pa1); PK4(p1, 0, pa2); PK4(p1, 8, pa3);
                pv_d0(o, vb0 + bf * 16384, pa0, pa1, pa2, pa3);
            }
            if (j + 1 < NT) NWRITE((j + 1) & 1);
            __syncthreads();
        }
#undef NLOAD
#undef KNORM
#undef NWRITE
        const float lt = halfswap_add(lsum);
        if (hi == 0) li[r32] = lt;
        asm volatile("s_waitcnt lgkmcnt(0)" ::: "memory");
#pragma unroll
        for (int r = 0; r < 16; ++r) { const float rl = 1.f / li[crow(r, hi)];
            bf16_t* mp = mix + ((size_t)b * SEQ + grow * 64 + (wid & 1) * 32 + crow(r, hi)) * DM + h * 128 + r32;
#pragma unroll
            for (int d0 = 0; d0 < 4; ++d0) mp[32 * d0] = f2bf(o[d0][r] * rl); }
        __syncthreads();
    }
}

#define XB_TMO      128
#define XB_XCNT(j)  (256  + 64 * (j))
#define XB_XSUB(j)  (1280 + 64 * (j))
#define XB_XGEN(j)  (2304 + 64 * (j))
#define XB_TOP      3328
#define XB_TOPGEN   3392
#define XCD_BAR_WORDS 3456
#define XB_SPIN_CAP (1u << 22)
__device__ __forceinline__ unsigned xb_ld(unsigned* p)              { return __hip_atomic_load(p, __ATOMIC_RELAXED, __HIP_MEMORY_SCOPE_AGENT); }
__device__ __forceinline__ unsigned xb_add(unsigned* p, unsigned v) { return __hip_atomic_fetch_add(p, v, __ATOMIC_RELAXED, __HIP_MEMORY_SCOPE_AGENT); }
__device__ __forceinline__ unsigned xb_xcc_id() { return (unsigned)__builtin_amdgcn_s_getreg((3 << 11) | 20) & 0xFu; }
#define XB_SPIN(cond, bar) do { unsigned _sp = 0; while (cond) { __builtin_amdgcn_s_sleep(1); \
    if ((++_sp & 255u) == 0u) { if (xb_ld(&(bar)[XB_TMO])) break; if (_sp > XB_SPIN_CAP) { atomicAdd(&(bar)[XB_TMO], 1u); break; } } } } while (0)
struct XcdBarrier { unsigned* bar; unsigned x; volatile LAS unsigned* st; };
__device__ __forceinline__ XcdBarrier xcd_barrier_post(unsigned* bar, volatile LAS unsigned* st) {
    XcdBarrier b; b.bar = bar; b.x = xb_xcc_id(); b.st = st;
    if (threadIdx.x == 0) (void)xb_add(&bar[XB_XCNT(b.x)], 1u);
    return b;
}
__device__ __forceinline__ void xcd_barrier_complete(unsigned* bar, unsigned x, unsigned& nloc, unsigned& nx) {
    const unsigned G = gridDim.x * gridDim.y * gridDim.z;
    unsigned sum, cnt, mine, sp = 0u;
    for (;;) {
        sum = 0u; cnt = 0u; mine = 0u;
#pragma unroll
        for (unsigned j = 0; j < 16; ++j) { const unsigned c = xb_ld(&bar[XB_XCNT(j)]); sum += c; cnt += (c > 0u) ? 1u : 0u; mine = (j == x) ? c : mine; }
        if (sum == G) break;
        __builtin_amdgcn_s_sleep(1);
        if ((++sp & 255u) == 0u) { if (xb_ld(&bar[XB_TMO])) break; if (sp > XB_SPIN_CAP) { atomicAdd(&bar[XB_TMO], 1u); break; } }
    }
    nloc = mine > 0u ? mine : 1u; nx = cnt > 0u ? cnt : 1u;
}
__device__ __forceinline__ void xcd_barrier(const XcdBarrier& b) {
    asm volatile("s_waitcnt vmcnt(0)" ::: "memory");
    __syncthreads();
    if (threadIdx.x == 0) {
        unsigned* bar = b.bar;
        __builtin_amdgcn_s_waitcnt(0);
        unsigned nloc = b.st[0], nx = b.st[1];
        if (nloc == 0u) { xcd_barrier_complete(bar, b.x, nloc, nx); b.st[0] = nloc; b.st[1] = nx; }
        const unsigned old = xb_add(&bar[XB_XSUB(b.x)], 1u);
        const unsigned gen = old / nloc;
        if (old + 1u == (gen + 1u) * nloc) {
            __builtin_amdgcn_fence(__ATOMIC_RELEASE, "agent");
            asm volatile("s_waitcnt vmcnt(0)" ::: "memory");
            const unsigned og = xb_add(&bar[XB_TOP], 1u);
            const unsigned tg = og / nx;
            if (og + 1u == (tg + 1u) * nx) xb_add(&bar[XB_TOPGEN], 1u);
            else XB_SPIN(xb_ld(&bar[XB_TOPGEN]) == tg, bar);
            __builtin_amdgcn_fence(__ATOMIC_ACQUIRE, "agent");
            xb_add(&bar[XB_XGEN(b.x)], 1u);
            asm volatile("s_waitcnt vmcnt(0)" ::: "memory");
        } else {
            XB_SPIN(xb_ld(&bar[XB_XGEN(b.x)]) == gen, bar);
            __builtin_amdgcn_fence(__ATOMIC_ACQUIRE, "agent");
            asm volatile("s_waitcnt vmcnt(0)" ::: "memory");
        }
    }
    __syncthreads();
}

#ifndef PROBE_REP
#define PROBE_REP 0
#endif
#define REP(k) for (int rep_ = 0; rep_ < (((PROBE_REP >> (k)) & 1) ? 2 : 1); ++rep_)
constexpr int NPH = 18;
__global__ void __launch_bounds__(NTHREADS, 2) fwd_megakernel(Params p) {
    extern __shared__ __attribute__((aligned(16))) unsigned char lds[];
    cg::grid_group grid = cg::this_grid();
    LAS unsigned char* ldsl = (LAS unsigned char*)lds;
    const int lo = p.ph_lo, hi = p.ph_hi;
#ifdef ONLY_PH
#define IN(k) (((ONLY_PH >> (k)) & 1) && lo <= (k) && (k) < hi)
#else
#define IN(k) (lo <= (k) && (k) < hi)
#endif
#define SEAM(k) do { if (IN(k) && IN((k) + 1)) { if ((k) == 0) grid.sync(); else { XcdBarrier xb_; xb_.bar = (unsigned*)(p.ws + WS_BAR); xb_.x = xb_xcc_id(); xb_.st = (volatile LAS unsigned*)(ldsl + 135168); xcd_barrier(xb_); } } } while (0)
    unsigned char* ws = p.ws;
    const bf16_t* H = (const bf16_t*)(ws + WS_H);
    bf16_t* PROJ = (bf16_t*)(ws + WS_PROJ);
    const bf16_t* MIX = (const bf16_t*)(ws + WS_MIX);
    float* CTXRES = (float*)(ws + WS_CTXRES);
    const float* MOD = (const float*)(ws + WS_MOD);
    const int G = gridDim.x, c = blockIdx.x;
    if (threadIdx.x < 4) ((volatile LAS unsigned*)(ldsl + 135168))[threadIdx.x] = 0u;
    __syncthreads();
    (void)xcd_barrier_post((unsigned*)(ws + WS_BAR), (volatile LAS unsigned*)(ldsl + 135168));

    if (IN(0)) REP(0) { ada_phase(p, lds); wconv_phase(p, lds);
        { float* rc = (float*)(ws + WS_ROPE); float* rs = rc + SEQ * 32;
          for (int e = blockIdx.x * NTHREADS + threadIdx.x; e < SEQ * 32; e += gridDim.x * NTHREADS) { const int t = e >> 5, pp = e & 31;
              const float inv = powf(10000.f, -(float)(pp & 15) / 16.f); const float ang = (pp < 16 ? (float)(t >> 6) : (float)(t & 63)) * inv;
              rc[e] = cosf(ang); rs[e] = sinf(ang); } } }
    SEAM(0);
    if (IN(1)) REP(1) norm_phase(p, p.x, p.ctx, 0, 0, MTOT);
    SEAM(1);
    if (IN(2)) REP(2) { pg8::Gemm g{H, (const bf16_t*)(ws + WS_W_EVIN), MTOT, EV_NP, DM}; pg8::StaticOrder S; S.init(MTOT, EV_NP, G, c);
        pg8::EpiBf16 E{PROJ, EV_NP}; pg8::gemm_phase(ldsl, g, S, E); }
    SEAM(2);
    if (IN(3)) prep0_phase(p);
    SEAM(3);
    if (IN(4)) REP(4) gdn_pre_phase(p, lds);
    SEAM(4);
    if (IN(5)) {
#ifndef SKIP_SCAN
        REP(20) { gdn_scan_phase(p, lds); __syncthreads(); }
#endif
#ifndef SKIP_DA
        REP(5) { diffattn_phase(p, lds); __syncthreads(); }
#endif
    }
    SEAM(5);
    if (IN(6)) REP(6) gdn_post_phase(p);
    SEAM(6);
    if (IN(7)) REP(7) { pg8::Gemm g{MIX, (const bf16_t*)(ws + WS_W_EVOUT), MTOT, DM, DM}; pg8::StaticOrder S; S.init(MTOT, DM, G, c);
        pg8::EpiResid E{p.x, p.ctx, p.out, CTXRES, MOD, 2048}; pg8::gemm_phase(ldsl, g, S, E); }
    SEAM(7);
    if (IN(8)) norm_phase(p, p.out, CTXRES, 0, 1, MTOT);
    SEAM(8);
    if (IN(9)) REP(9) { pg8::Gemm g{H, (const bf16_t*)(ws + WS_W_FFIN), MTOT, 2 * FF, DM}; pg8::StaticOrder S; S.init(MTOT, 2 * FF, G, c);
        pg8::EpiSwiglu E{PROJ, FF}; pg8::gemm_phase(ldsl, g, S, E); }
    SEAM(9);
    if (IN(10)) { pg8::Gemm g{PROJ, (const bf16_t*)(ws + WS_W_FFOUT), MTOT, DM, FF}; pg8::StaticOrder S; S.init(MTOT, DM, G, c);
        pg8::EpiResid E{p.out, CTXRES, p.out, CTXRES, MOD, 5120}; pg8::gemm_phase(ldsl, g, S, E); }
    SEAM(10);
    if (IN(11)) norm_phase(p, p.out, CTXRES, 1, 0, MTOT);
    SEAM(11);
    if (IN(12)) { pg8::Gemm g{H, (const bf16_t*)(ws + WS_W_ODIN), MTOT, OD_N, DM}; pg8::StaticOrder S; S.init(MTOT, OD_N, G, c);
        pg8::EpiBf16 E{PROJ, OD_N}; pg8::gemm_phase(ldsl, g, S, E); }
    SEAM(12);
    if (IN(13)) { natten_phase(p, lds); if ((PROBE_REP >> 13) & 1) { __syncthreads(); natten_phase(p, lds); } }
    SEAM(13);
    if (IN(14)) { pg8::Gemm g{MIX, (const bf16_t*)(ws + WS_W_ODOUT), NLAT, DM, DM}; pg8::StaticOrder S; S.init(NLAT, DM, G, c);
        pg8::EpiResid E{p.out, CTXRES, p.out, CTXRES, MOD + 9 * 6144, 2048}; pg8::gemm_phase(ldsl, g, S, E); }
    SEAM(14);
    if (IN(15)) norm_phase(p, p.out, CTXRES, 1, 1, NLAT);
    SEAM(15);
    if (IN(16)) { pg8::Gemm g{H, (const bf16_t*)(ws + WS_W_FFIN) + (size_t)2 * FF * DM, NLAT, 2 * FF, DM}; pg8::StaticOrder S; S.init(NLAT, 2 * FF, G, c);
        pg8::EpiSwiglu E{PROJ, FF}; pg8::gemm_phase(ldsl, g, S, E); }
    SEAM(16);
    if (IN(17)) { pg8::Gemm g{PROJ, (const bf16_t*)(ws + WS_W_FFOUT) + (size_t)DM * FF, NLAT, DM, FF}; pg8::StaticOrder S; S.init(NLAT, DM, G, c);
        pg8::EpiResid E{p.out, CTXRES, p.out, CTXRES, MOD + 9 * 6144, 5120}; pg8::gemm_phase(ldsl, g, S, E); }
#undef IN
#undef SEAM
}

extern "C" void kernel_launch(void* const* d_in, const int* in_sizes, int n_in, void* d_out, int out_size, void* d_ws, size_t ws_size, hipStream_t stream) {
    static int grid = 0;
    if (grid == 0) {
        if (n_in != 23 || ws_size < WS_END) { fprintf(stderr, "kernel_launch: n_in %d ws %zu (need %zu)\n", n_in, ws_size, (size_t)WS_END); grid = -1; return; }
        int dev = 0, cus = 0, per_cu = 0;
        hipGetDevice(&dev); hipDeviceGetAttribute(&cus, hipDeviceAttributeMultiprocessorCount, dev);
        if (hipFuncSetAttribute((const void*)fwd_megakernel, hipFuncAttributeMaxDynamicSharedMemorySize, LDS_BYTES) != hipSuccess) { fprintf(stderr, "hipFuncSetAttribute failed\n"); grid = -1; return; }
        if (hipOccupancyMaxActiveBlocksPerMultiprocessor(&per_cu, (const void*)fwd_megakernel, NTHREADS, LDS_BYTES) != hipSuccess || per_cu < 1) per_cu = 1;
        (void)hipGetLastError();
        grid = cus * 1;
    }
    if (grid < 0) return;
    if (hipMemsetAsync((char*)d_ws + WS_BAR, 0, 16384, stream) != hipSuccess) { fprintf(stderr, "memset failed\n"); return; }
    Params p{};
    const float** pp = (const float**)&p;
    for (int i = 0; i < 23; ++i) pp[i] = (const float*)d_in[i];
    p.out = (float*)d_out; p.ws = (unsigned char*)d_ws;
#if N_LAUNCH_MODE == 1
    p.ph_lo = 0; p.ph_hi = NPH;
    void* args[] = {&p};
    hipError_t e = hipLaunchCooperativeKernel((void*)fwd_megakernel, dim3(grid), dim3(NTHREADS), args, LDS_BYTES, stream);
    if (e != hipSuccess) fprintf(stderr, "cooperative launch failed: %s (grid %d)\n", hipGetErrorString(e), grid);
#else
    for (int k = 0; k < NPH; ++k) { p.ph_lo = k; p.ph_hi = k + 1;
        hipLaunchKernelGGL(fwd_megakernel, dim3(grid), dim3(NTHREADS), LDS_BYTES, stream, p); }
#endif
}
```

```cpp
#include <hip/hip_runtime.h>
#include <hip/hip_cooperative_groups.h>
#include <cstdio>
#include <cstdint>
namespace cg = cooperative_groups;

#define LAS __attribute__((address_space(3)))
typedef unsigned short bf16_t;
typedef short bf16x8 __attribute__((ext_vector_type(8)));
typedef short s16x4 __attribute__((ext_vector_type(4)));
typedef float f32x4 __attribute__((ext_vector_type(4)));
typedef float f32x16 __attribute__((ext_vector_type(16)));
typedef unsigned u32x4 __attribute__((ext_vector_type(4)));
typedef unsigned u32x2 __attribute__((ext_vector_type(2)));

#ifndef N_LAUNCH_MODE
#define N_LAUNCH_MODE 1
#endif

constexpr int DM = 1024, NLAT = 65536, NCTX = 2048, MTOT = NLAT + NCTX, SEQ = 8192, CTXL = 256, FF = 2816;
constexpr int EV_N = 3600, EV_NP = 3840, OD_N = 3072;
constexpr int NCHUNKP = 64 * 132;
constexpr int NTHREADS = 512;
constexpr int LDS_BYTES = 135168 + 16;

constexpr size_t al256(size_t x) { return (x + 255) / 256 * 256; }
constexpr size_t WS_W_EVIN = 0;
constexpr size_t WS_W_EVOUT = WS_W_EVIN + al256((size_t)EV_NP * DM * 2);
constexpr size_t WS_W_ODIN = WS_W_EVOUT + al256((size_t)DM * DM * 2);
constexpr size_t WS_W_ODOUT = WS_W_ODIN + al256((size_t)OD_N * DM * 2);
constexpr size_t WS_W_FFIN = WS_W_ODOUT + al256((size_t)DM * DM * 2);
constexpr size_t WS_W_FFOUT = WS_W_FFIN + al256((size_t)2 * 2 * FF * DM * 2);
constexpr size_t WS_MOD = WS_W_FFOUT + al256((size_t)2 * DM * FF * 2);
constexpr size_t WS_H = WS_MOD + al256((size_t)2 * 9 * 6144 * 4);
constexpr size_t WS_PROJ = WS_H + al256((size_t)MTOT * DM * 2);
constexpr size_t WS_MIX = WS_PROJ + al256((size_t)MTOT * EV_NP * 2);
constexpr size_t WS_T = WS_MIX + al256((size_t)MTOT * DM * 2);
constexpr size_t WS_AQK = WS_T + al256((size_t)NCHUNKP * 4096 * 2);
constexpr size_t WS_GV = WS_AQK + al256((size_t)NCHUNKP * 4096 * 2);
constexpr size_t WS_BV = WS_GV + al256((size_t)NCHUNKP * 64 * 4);
constexpr size_t WS_EL = WS_BV + al256((size_t)NCHUNKP * 64 * 4);
constexpr size_t WS_GATES = WS_EL + al256((size_t)NCHUNKP * 64 * 4);
constexpr size_t WS_CTXRES = WS_GATES + al256((size_t)MTOT * 16 * 4);
constexpr size_t WS_BAR = WS_CTXRES + al256((size_t)NCTX * DM * 4);
constexpr size_t WS_ROPE = WS_BAR + 16384;
constexpr size_t WS_END = WS_ROPE + (size_t)2 * SEQ * 32 * 4;

struct Params {
    const float *x, *c, *ctx, *c_ctx, *ada_w, *ada_b, *norm_mix, *norm_ffn, *ffn_w_in, *ffn_w_out, *even_w_in, *even_w_out,
        *diff_qk_gain, *diff_lambda, *diff_subln, *gdn_conv, *gdn_a_log, *gdn_dt_bias, *gdn_norm, *odd_w_in, *odd_w_out, *na_qk_gain, *na_rpb;
    float* out; unsigned char* ws; int ph_lo, ph_hi;
};

__device__ __forceinline__ float bf2f(bf16_t b) { return __uint_as_float(((unsigned)b) << 16); }
__device__ __forceinline__ bf16_t f2bf(float f) { unsigned u = __float_as_uint(f); u += 0x7FFFu + ((u >> 16) & 1u); return (bf16_t)(u >> 16); }
__device__ __forceinline__ unsigned cvtpk(float lo, float hi) { unsigned r; asm volatile("v_cvt_pk_bf16_f32 %0, %1, %2" : "=v"(r) : "v"(lo), "v"(hi)); return r; }
__device__ __forceinline__ float siluf(float v) { return v / (1.f + __expf(-v)); }
__device__ __forceinline__ void unpack8(bf16x8 v, float* f) {
#pragma unroll
    for (int i = 0; i < 8; ++i) f[i] = bf2f((bf16_t)v[i]);
}
__device__ __forceinline__ bf16x8 pack8(const float* f) {
    u32x4 w = {cvtpk(f[0], f[1]), cvtpk(f[2], f[3]), cvtpk(f[4], f[5]), cvtpk(f[6], f[7])};
    return *reinterpret_cast<bf16x8*>(&w);
}

namespace pg8 {
constexpr int BM = 256, BK = 64, HALF = 128, HTB = HALF * BK * 2, STAGE_BYTES = 8 * HTB, NXCD = 8, WGM = 8;
__host__ __device__ __forceinline__ int lds_byte(int r, int c) { const int st = (r >> 4) * 2 + (c >> 5), rr = r & 15, cc = c & 31, ob = rr * 64 + cc * 2; return st * 1024 + (ob ^ (((ob >> 9) & 1) << 5)); }
__host__ __device__ __forceinline__ void stage_rc(int b, int& R, int& C) { const int st = b / 1024, sb = b % 1024, swz = sb ^ (((sb >> 9) & 1) << 5); R = (st >> 1) * 16 + swz / 64; C = (st & 1) * 32 + (swz % 64) / 2; }
__host__ __device__ __forceinline__ int perm32(int rho) { const int n = rho >> 4, i = rho & 15; return 8 * (i >> 2) + 4 * n + (i & 3); }
struct Unit { int pm, pn; };
struct Gemm { const bf16_t* A; const bf16_t* Bt; int M, N, K; };
template <int NM, int NN> struct StaticOrderT {
    static_assert(NM % WGM == 0, "row tiles in whole groups");
    int G, c;
    __device__ void init(int, int, int G_, int c_) { G = G_; c = c_; }
    __device__ bool next(int i, Unit& u) const {
        constexpr int nwg = NM * NN, q = nwg / NXCD, r = nwg % NXCD, nig = WGM * NN;
        const int L = i * G + c; if (L >= nwg) return false;
        const int xcd = L % NXCD, off = L / NXCD;
        const int wgid = (xcd < r ? xcd * (q + 1) : r * (q + 1) + (xcd - r) * q) + off;
        const int gid = wgid / nig, w = wgid % nig;
        u.pm = gid * WGM + (w % WGM); u.pn = w / WGM; return true;
    }
};
struct EpiBf16 {
    static constexpr bool PERM = true;
    bf16_t* O; int ldc;
    __device__ __forceinline__ void operator()(const f32x4 (&acc)[2][2][4][2], const Unit& u, int wr, int wc, int fr, int fq) const {
        const int row0 = u.pm * BM + wr * 64 + fr; const int col0 = u.pn * BM + wc * 32 + 8 * fq;
#pragma unroll
        for (int ai = 0; ai < 2; ++ai)
#pragma unroll
            for (int m = 0; m < 4; ++m) { bf16_t* rowp = O + (size_t)(row0 + ai * HALF + m * 16) * ldc + col0;
#pragma unroll
                for (int bj = 0; bj < 2; ++bj) { const f32x4 v0 = acc[ai][bj][m][0], v1 = acc[ai][bj][m][1];
                    u32x4 w; w.x = cvtpk(v0[0], v0[1]); w.y = cvtpk(v0[2], v0[3]); w.z = cvtpk(v1[0], v1[1]); w.w = cvtpk(v1[2], v1[3]);
                    *(u32x4*)(rowp + bj * HALF) = w; } }
    }
};
struct EpiSwiglu {
    static constexpr bool PERM = true;
    bf16_t* O; int ldc;
    __device__ __forceinline__ void operator()(const f32x4 (&acc)[2][2][4][2], const Unit& u, int wr, int wc, int fr, int fq) const {
        const int row0 = u.pm * BM + wr * 64 + fr; const int col0 = u.pn * HALF + wc * 32 + 8 * fq;
#pragma unroll
        for (int ai = 0; ai < 2; ++ai)
#pragma unroll
            for (int m = 0; m < 4; ++m) { bf16_t* rowp = O + (size_t)(row0 + ai * HALF + m * 16) * ldc + col0;
                float o[8];
#pragma unroll
                for (int n = 0; n < 2; ++n)
#pragma unroll
                    for (int j = 0; j < 4; ++j) { const float g = acc[ai][0][m][n][j], up = acc[ai][1][m][n][j]; o[n * 4 + j] = g * __builtin_amdgcn_rcpf(1.f + __expf(-g)) * up; }
                u32x4 w; w.x = cvtpk(o[0], o[1]); w.y = cvtpk(o[2], o[3]); w.z = cvtpk(o[4], o[5]); w.w = cvtpk(o[6], o[7]);
                *(u32x4*)rowp = w; }
    }
};
struct EpiResid {
    static constexpr bool PERM = false;
    const float* resLat; const float* resCtx; float* outLat; float* outCtx; const float* modl; int goff;
    __device__ __forceinline__ void operator()(const f32x4 (&acc)[2][2][4][2], const Unit& u, int wr, int wc, int fr, int fq) const {
        const int rowt = u.pm * BM; const bool lat = rowt < NLAT;
        const float* res = lat ? resLat + (size_t)rowt * DM : resCtx + (size_t)(rowt - NLAT) * DM;
        float* out = lat ? outLat + (size_t)rowt * DM : outCtx + (size_t)(rowt - NLAT) * DM;
        const float* gate = modl + (size_t)(lat ? (rowt >> 13) : 8) * 6144 + goff;
        const int row0 = wr * 64 + fr, col0 = u.pn * BM + wc * 32 + 4 * fq;
        f32x4 gv[2][2];
#pragma unroll
        for (int bj = 0; bj < 2; ++bj)
#pragma unroll
            for (int n = 0; n < 2; ++n) gv[bj][n] = *(const f32x4*)(gate + col0 + bj * HALF + n * 16);
#pragma unroll
        for (int ai = 0; ai < 2; ++ai)
#pragma unroll
            for (int mp = 0; mp < 4; mp += 2) {
                f32x4 r[2][2][2];
#pragma unroll
                for (int mm = 0; mm < 2; ++mm)
#pragma unroll
                    for (int bj = 0; bj < 2; ++bj)
#pragma unroll
                        for (int n = 0; n < 2; ++n) r[mm][bj][n] = *(const f32x4*)(res + (size_t)(row0 + ai * HALF + (mp + mm) * 16) * DM + col0 + bj * HALF + n * 16);
#pragma unroll
                for (int mm = 0; mm < 2; ++mm)
#pragma unroll
                    for (int bj = 0; bj < 2; ++bj)
#pragma unroll
                        for (int n = 0; n < 2; ++n) *(f32x4*)(out + (size_t)(row0 + ai * HALF + (mp + mm) * 16) * DM + col0 + bj * HALF + n * 16) = r[mm][bj][n] + gv[bj][n] * acc[ai][bj][mp + mm][n];
            }
    }
};

template <class Epi, class Sched>
__device__ __forceinline__ void gemm_phase(LAS unsigned char* lds, const Gemm g, const Sched& S, const Epi& E) {
    const int tid = threadIdx.x, wid = __builtin_amdgcn_readfirstlane(tid >> 6), lane = tid & 63, wr = wid >> 2, wc = wid & 3, fr = lane & 15, fq = lane >> 4;
    const int K = g.K, nt = K / BK;
    unsigned voffA[2], voffB[2];
#pragma unroll
    for (int i = 0; i < 2; ++i) { int R, C; stage_rc(tid * 16 + i * 8192, R, C); const int Rb = Epi::PERM ? ((R & ~31) + perm32(R & 31)) : R;
        voffA[i] = (unsigned)(R * K + C) * 2u; voffB[i] = (unsigned)(Rb * K + C) * 2u; }
    const size_t kstep = (size_t)(BK * 2);
    const size_t hstep = (size_t)HALF * K * 2;
    const size_t tstep = 2 * hstep;
    const unsigned ldsw = (unsigned)wid * 1024u;
    const int aoff = lds_byte(wr * 64 + fr, fq * 8), boff = lds_byte(wc * 32 + fr, fq * 8);
#define PG8_SA(b, h) (((b) * 2 + (h)) * HTB)
#define PG8_SB(b, h) ((4 + (b) * 2 + (h)) * HTB)
#define PG8_STAGE(bufoff, gbase, voff) do { _Pragma("unroll") for (int _i = 0; _i < 2; ++_i) \
        __builtin_amdgcn_global_load_lds((const unsigned*)((const char*)(gbase) + (voff)[_i]), (LAS unsigned*)(lds + (bufoff) + ldsw + _i * 8192), 16, 0, 0); } while (0)
#define PG8_LDA(dst, b, h) do { _Pragma("unroll") for (int m = 0; m < 4; ++m) _Pragma("unroll") for (int k = 0; k < 2; ++k) dst[m][k] = *(const LAS bf16x8*)(lds + PG8_SA(b, h) + aoff + m * 2048 + k * 1024); } while (0)
#define PG8_LDB(dst, b, h) do { _Pragma("unroll") for (int n = 0; n < 2; ++n) _Pragma("unroll") for (int k = 0; k < 2; ++k) dst[n][k] = *(const LAS bf16x8*)(lds + PG8_SB(b, h) + boff + n * 2048 + k * 1024); } while (0)
#define PG8_MMA(ai, bj, At, Bt) do { __builtin_amdgcn_s_setprio(1); _Pragma("unroll") for (int m = 0; m < 4; ++m) _Pragma("unroll") for (int n = 0; n < 2; ++n) _Pragma("unroll") for (int k = 0; k < 2; ++k) \
        acc[ai][bj][m][n] = __builtin_amdgcn_mfma_f32_16x16x32_bf16(Bt[n][k], At[m][k], acc[ai][bj][m][n], 0, 0, 0); __builtin_amdgcn_s_setprio(0); } while (0)
#define PG8_WAIT_V(n) asm volatile("s_waitcnt vmcnt(" #n ")" ::: "memory")
#define PG8_WAIT_L(n) asm volatile("s_waitcnt lgkmcnt(" #n ")" ::: "memory")
#define PG8_BAR __builtin_amdgcn_s_barrier()
#define PG8_SCHED __builtin_amdgcn_sched_barrier(0)
    Unit cur, nxt; int ui = 0;
    if (!S.next(0, cur)) return;
    f32x4 acc[2][2][4][2];
#pragma unroll
    for (int a = 0; a < 2; ++a)
#pragma unroll
        for (int b = 0; b < 2; ++b)
#pragma unroll
            for (int m = 0; m < 4; ++m)
#pragma unroll
                for (int n = 0; n < 2; ++n) acc[a][b][m][n] = (f32x4){0.f, 0.f, 0.f, 0.f};
    bf16x8 At[4][2], B0[2][2], B1[2][2];
    const char* cA = (const char*)g.A + (size_t)cur.pm * tstep; const char* cB = (const char*)g.Bt + (size_t)cur.pn * tstep;
    PG8_STAGE(PG8_SB(0, 0), cB, voffB); PG8_STAGE(PG8_SA(0, 0), cA, voffA); PG8_STAGE(PG8_SB(0, 1), cB + hstep, voffB); PG8_STAGE(PG8_SA(0, 1), cA + hstep, voffA);
    if (wr == 1) PG8_BAR;
    PG8_WAIT_V(4); PG8_BAR;
    PG8_STAGE(PG8_SB(1, 0), cB + kstep, voffB); PG8_STAGE(PG8_SA(1, 0), cA + kstep, voffA); PG8_STAGE(PG8_SB(1, 1), cB + hstep + kstep, voffB);
    PG8_WAIT_V(6); PG8_BAR;
    for (;;) {
        const bool has_next = S.next(ui + 1, nxt);
        const char* nA = has_next ? (const char*)g.A + (size_t)nxt.pm * tstep : cA; const char* nB = has_next ? (const char*)g.Bt + (size_t)nxt.pn * tstep : cB;
        for (int t = 0; t < nt; t += 2) {
            const bool last = (t == nt - 2);
            const char* a1 = cA + (size_t)(t + 1) * kstep;
            const char* a2 = last ? nA : cA + (size_t)(t + 2) * kstep; const char* b2 = last ? nB : cB + (size_t)(t + 2) * kstep;
            const char* a3 = a2 + kstep; const char* b3 = b2 + kstep;
            PG8_LDB(B0, 0, 0); PG8_SCHED; PG8_LDA(At, 0, 0); PG8_STAGE(PG8_SA(1, 1), a1 + hstep, voffA);
            PG8_WAIT_L(8); PG8_BAR; PG8_WAIT_L(0); PG8_MMA(0, 0, At, B0); PG8_BAR; PG8_SCHED;
            PG8_LDB(B1, 0, 1); PG8_STAGE(PG8_SB(0, 0), b2, voffB);
            PG8_BAR; PG8_WAIT_L(0); PG8_MMA(0, 1, At, B1); PG8_BAR;
            PG8_LDA(At, 0, 1); PG8_STAGE(PG8_SA(0, 0), a2, voffA);
            PG8_BAR; PG8_WAIT_L(0); PG8_MMA(1, 0, At, B0); PG8_BAR; PG8_SCHED;
            PG8_STAGE(PG8_SB(0, 1), b2 + hstep, voffB);
            PG8_WAIT_V(6); PG8_BAR; PG8_MMA(1, 1, At, B1); PG8_BAR;
            PG8_LDB(B0, 1, 0); PG8_SCHED; PG8_LDA(At, 1, 0); PG8_STAGE(PG8_SA(0, 1), a2 + hstep, voffA);
            PG8_WAIT_L(8); PG8_BAR; PG8_WAIT_L(0); PG8_MMA(0, 0, At, B0); PG8_BAR; PG8_SCHED;
            PG8_LDB(B1, 1, 1); PG8_STAGE(PG8_SB(1, 0), b3, voffB);
            PG8_BAR; PG8_WAIT_L(0); PG8_MMA(0, 1, At, B1); PG8_BAR;
            PG8_LDA(At, 1, 1); PG8_STAGE(PG8_SA(1, 0), a3, voffA);
            PG8_BAR; PG8_WAIT_L(0); PG8_MMA(1, 0, At, B0); PG8_BAR; PG8_SCHED;
            PG8_STAGE(PG8_SB(1, 1), b3 + hstep, voffB);
            PG8_WAIT_V(6); PG8_BAR; PG8_MMA(1, 1, At, B1); PG8_BAR;
        }
        E(acc, cur, wr, wc, fr, fq);
        if (!has_next) break;
#pragma unroll
        for (int a = 0; a < 2; ++a)
#pragma unroll
            for (int b = 0; b < 2; ++b)
#pragma unroll
                for (int m = 0; m < 4; ++m)
#pragma unroll
                    for (int n = 0; n < 2; ++n) acc[a][b][m][n] = (f32x4){0.f, 0.f, 0.f, 0.f};
        cur = nxt; cA = nA; cB = nB; ++ui;
    }
    PG8_WAIT_V(0);
    if (wr == 0) PG8_BAR;
    PG8_BAR;
#undef PG8_SA
#undef PG8_SB
#undef PG8_STAGE
#undef PG8_LDA
#undef PG8_LDB
#undef PG8_MMA
#undef PG8_WAIT_V
#undef PG8_WAIT_L
#undef PG8_BAR
#undef PG8_SCHED
}
}

#define KSWZ(row, colB) ((row) * 256 + ((colB) ^ (((row) & 7) << 4)))
#define SBAR() __builtin_amdgcn_sched_barrier(0)
__device__ __forceinline__ int crow(int r, int hi) { return (r & 3) + 8 * (r >> 2) + 4 * hi; }
__device__ __forceinline__ int v_st(int k, int c) { const int kk = (k & ~0xC) | ((k & 4) << 1) | ((k & 8) >> 1); return ((kk >> 3) * 4 + (c >> 5)) * 512 + ((kk & 7) * 32 + (c & 31)) * 2; }
__device__ __forceinline__ int v_rd_base(int lane) { return ((lane & 3) << 3) | (((lane >> 2) & 3) << 6) | (((lane >> 4) & 1) << 5) | (((lane >> 5) & 1) << 8); }
constexpr int v_rd_off(int d0, int ks, int half) { return d0 * 512 + ks * 4096 + half * 2048; }
template <int OFF> __device__ __forceinline__ s16x4 tr_read(int vb) {
    s16x4 r; asm volatile("ds_read_b64_tr_b16 %0, %1 offset:%2" : "=&v"(r) : "v"(vb), "i"(OFF) : "memory"); return r;
}
template <int D0> __device__ __forceinline__ void pv_one(f32x16& od, int vb, bf16x8 pa0, bf16x8 pa1, bf16x8 pa2, bf16x8 pa3) {
    const s16x4 l0 = tr_read<v_rd_off(D0, 0, 0)>(vb), h0 = tr_read<v_rd_off(D0, 0, 1)>(vb), l1 = tr_read<v_rd_off(D0, 1, 0)>(vb), h1 = tr_read<v_rd_off(D0, 1, 1)>(vb);
    const s16x4 l2 = tr_read<v_rd_off(D0, 2, 0)>(vb), h2 = tr_read<v_rd_off(D0, 2, 1)>(vb), l3 = tr_read<v_rd_off(D0, 3, 0)>(vb), h3 = tr_read<v_rd_off(D0, 3, 1)>(vb);
    asm volatile("s_waitcnt lgkmcnt(0)" ::: "memory"); SBAR();
#define PK(L, H) (bf16x8){L[0], L[1], L[2], L[3], H[0], H[1], H[2], H[3]}
    od = __builtin_amdgcn_mfma_f32_32x32x16_bf16(pa0, PK(l0, h0), od, 0, 0, 0);
    od = __builtin_amdgcn_mfma_f32_32x32x16_bf16(pa1, PK(l1, h1), od, 0, 0, 0);
    od = __builtin_amdgcn_mfma_f32_32x32x16_bf16(pa2, PK(l2, h2), od, 0, 0, 0);
    od = __builtin_amdgcn_mfma_f32_32x32x16_bf16(pa3, PK(l3, h3), od, 0, 0, 0);
#undef PK
}
__device__ __forceinline__ void pv_d0(f32x16* o, int vb, bf16x8 pa0, bf16x8 pa1, bf16x8 pa2, bf16x8 pa3) {
    pv_one<0>(o[0], vb, pa0, pa1, pa2, pa3); pv_one<1>(o[1], vb, pa0, pa1, pa2, pa3); pv_one<2>(o[2], vb, pa0, pa1, pa2, pa3); pv_one<3>(o[3], vb, pa0, pa1, pa2, pa3);
}
#define PK4(P, BASE, OUT) do { unsigned a0 = cvtpk(P[BASE + 0], P[BASE + 1]), a1 = cvtpk(P[BASE + 2], P[BASE + 3]);   \
    unsigned b0 = cvtpk(P[BASE + 4], P[BASE + 5]), b1 = cvtpk(P[BASE + 6], P[BASE + 7]);                              \
    auto r0 = __builtin_amdgcn_permlane32_swap(a0, b0, false, false); auto r1 = __builtin_amdgcn_permlane32_swap(a1, b1, false, false); \
    u32x4 w = {r0[0], r1[0], r0[1], r1[1]}; OUT = *reinterpret_cast<bf16x8*>(&w); } while (0)
__device__ __forceinline__ float halfswap_add(float v) {
    auto rr = __builtin_amdgcn_permlane32_swap(__float_as_uint(v), __float_as_uint(v), false, false);
    return __uint_as_float(rr[0]) + __uint_as_float(rr[1]);
}

__device__ __forceinline__ void ada_phase(const Params& p, unsigned char* lds) {
    float* sc = (float*)lds;
    float* red = (float*)(lds + 40960);
    float* mod = (float*)(p.ws + WS_MOD);
    const int tid = threadIdx.x;
    for (int j = blockIdx.x; j < 192; j += gridDim.x) {
        const int l = j / 96, n0 = (j % 96) * 64;
        for (int i = tid; i < 9 * 1024; i += NTHREADS) { const int r = i >> 10, k = i & 1023; const float v = r < 8 ? p.c[r * 1024 + k] : p.c_ctx[k]; sc[i] = v / (1.f + expf(-v)); }
        __syncthreads();
        const int col = tid & 63, ks = tid >> 6;
        float acc[9];
#pragma unroll
        for (int r = 0; r < 9; ++r) acc[r] = 0.f;
        const float* wp = p.ada_w + ((size_t)l * 1024 + ks * 128) * 6144 + n0 + col;
#pragma unroll 8
        for (int kk = 0; kk < 128; ++kk) { const float w = wp[(size_t)kk * 6144];
#pragma unroll
            for (int r = 0; r < 9; ++r) acc[r] += sc[r * 1024 + ks * 128 + kk] * w; }
#pragma unroll
        for (int r = 0; r < 9; ++r) red[(ks * 9 + r) * 64 + col] = acc[r];
        __syncthreads();
        for (int i = tid; i < 576; i += NTHREADS) { const int r = i >> 6, cc = i & 63; float s = p.ada_b[l * 6144 + n0 + cc];
            for (int k2 = 0; k2 < 8; ++k2) s += red[(k2 * 9 + r) * 64 + cc];
            mod[(size_t)(l * 9 + r) * 6144 + n0 + cc] = s; }
        __syncthreads();
    }
}
__device__ __forceinline__ void wconv_phase(const Params& p, unsigned char* lds) {
    float* tl = (float*)lds;
    const int tid = threadIdx.x;
    const int T0 = 16 * 60, T1 = T0 + 16 * 16, T2 = T1 + 16 * 48, T3 = T2 + 16 * 16, T4 = T3 + 16 * 88, T5 = T4 + 16 * 88, T6 = T5 + 44 * 16, T7 = T6 + 44 * 16;
    for (int t = blockIdx.x; t < T7; t += gridDim.x) {
        const float* src; bf16_t* dst; int K, N, NP, mode = 0, tt;
        if (t < T0) { src = p.even_w_in; dst = (bf16_t*)(p.ws + WS_W_EVIN); K = 1024; N = EV_N; NP = EV_NP; tt = t; }
        else if (t < T1) { src = p.even_w_out; dst = (bf16_t*)(p.ws + WS_W_EVOUT); K = 1024; N = 1024; NP = 1024; tt = t - T0; }
        else if (t < T2) { src = p.odd_w_in; dst = (bf16_t*)(p.ws + WS_W_ODIN); K = 1024; N = OD_N; NP = OD_N; tt = t - T1; }
        else if (t < T3) { src = p.odd_w_out; dst = (bf16_t*)(p.ws + WS_W_ODOUT); K = 1024; N = 1024; NP = 1024; tt = t - T2; }
        else if (t < T4) { src = p.ffn_w_in; dst = (bf16_t*)(p.ws + WS_W_FFIN); K = 1024; N = 2 * FF; NP = 2 * FF; mode = 1; tt = t - T3; }
        else if (t < T5) { src = p.ffn_w_in + (size_t)1024 * 2 * FF; dst = (bf16_t*)(p.ws + WS_W_FFIN) + (size_t)2 * FF * 1024; K = 1024; N = 2 * FF; NP = 2 * FF; mode = 1; tt = t - T4; }
        else if (t < T6) { src = p.ffn_w_out; dst = (bf16_t*)(p.ws + WS_W_FFOUT); K = FF; N = 1024; NP = 1024; tt = t - T5; }
        else { src = p.ffn_w_out + (size_t)FF * 1024; dst = (bf16_t*)(p.ws + WS_W_FFOUT) + (size_t)1024 * FF; K = FF; N = 1024; NP = 1024; tt = t - T6; }
        const int nnt = NP / 64; const int k0 = (tt / nnt) * 64, n0 = (tt % nnt) * 64;
        int sn0;
        if (mode == 1) { const int tb = n0 >> 8, bj = (n0 >> 7) & 1, i0 = n0 & 127; sn0 = bj * FF + tb * 128 + i0; } else sn0 = n0;
        for (int e = tid; e < 4096; e += NTHREADS) { const int kk = e >> 6, nn = e & 63; const int sn = sn0 + nn;
            tl[kk * 65 + nn] = (sn < N) ? src[(size_t)(k0 + kk) * N + sn] : 0.f; }
        __syncthreads();
        for (int e = tid; e < 2048; e += NTHREADS) { const int nn = e >> 5, k2 = (e & 31) * 2;
            *(unsigned*)(dst + (size_t)(n0 + nn) * K + k0 + k2) = cvtpk(tl[k2 * 65 + nn], tl[(k2 + 1) * 65 + nn]); }
        __syncthreads();
    }
}

__device__ __forceinline__ void norm_phase(const Params& p, const float* xlat, const float* xctx, int l, int which, int nrows) {
    const int lane = threadIdx.x & 63, wid = threadIdx.x >> 6;
    bf16_t* h = (bf16_t*)(p.ws + WS_H);
    const float* mod = (const float*)(p.ws + WS_MOD) + (size_t)l * 9 * 6144;
    const float* gain = (which ? p.norm_ffn : p.norm_mix) + l * 1024;
    const int shoff = which ? 3072 : 0, scoff = which ? 4096 : 1024;
    const int stride = gridDim.x * 8;
    for (int row = blockIdx.x * 8 + wid; row < nrows; row += 2 * stride) {
        const int rowB = row + stride; const bool hasB = rowB < nrows;
        const float* srcA = row < NLAT ? xlat + (size_t)row * DM : xctx + (size_t)(row - NLAT) * DM;
        const float* srcB = hasB ? (rowB < NLAT ? xlat + (size_t)rowB * DM : xctx + (size_t)(rowB - NLAT) * DM) : srcA;
        f32x4 va[4], vb[4];
#pragma unroll
        for (int i = 0; i < 4; ++i) { va[i] = *(const f32x4*)(srcA + lane * 4 + 256 * i); vb[i] = *(const f32x4*)(srcB + lane * 4 + 256 * i); }
#pragma unroll
        for (int rr = 0; rr < 2; ++rr) {
            if (rr == 1 && !hasB) break;
            const int r = rr ? rowB : row;
            const float* mr = mod + (size_t)(r < NLAT ? (r >> 13) : 8) * 6144;
            float ss = 0.f;
#pragma unroll
            for (int i = 0; i < 4; ++i) { const f32x4 v = rr ? vb[i] : va[i]; ss += v[0] * v[0] + v[1] * v[1] + v[2] * v[2] + v[3] * v[3]; }
#pragma unroll
            for (int o = 1; o < 64; o <<= 1) ss += __shfl_xor(ss, o);
            const float rstd = rsqrtf(ss * (1.f / 1024.f) + 1e-6f);
#pragma unroll
            for (int i = 0; i < 4; ++i) { const int c0 = lane * 4 + 256 * i; const f32x4 v = rr ? vb[i] : va[i];
                const f32x4 g = *(const f32x4*)(gain + c0), s1 = *(const f32x4*)(mr + scoff + c0), sh = *(const f32x4*)(mr + shoff + c0);
                float y[4];
#pragma unroll
                for (int j = 0; j < 4; ++j) y[j] = v[j] * rstd * g[j] * (1.f + s1[j]) + sh[j];
                u32x2 w; w.x = cvtpk(y[0], y[1]); w.y = cvtpk(y[2], y[3]);
                *(u32x2*)(h + (size_t)r * DM + c0) = w; }
        }
    }
}

__device__ __forceinline__ void prep0_phase(const Params& p) {
    const int lane0 = threadIdx.x & 63, wid = threadIdx.x >> 6;
    bf16_t* proj = (bf16_t*)(p.ws + WS_PROJ);
    bf16_t* qkvp = (bf16_t*)p.out;
    float* gbuf = (float*)(p.ws + WS_GATES);
    const float* ropec = (const float*)(p.ws + WS_ROPE); const float* ropes = ropec + SEQ * 32;
    constexpr int RB = 8;
    for (int blk = blockIdx.x * 8 + wid; blk < MTOT / RB; blk += gridDim.x * 8) {
        int lane = lane0; asm volatile("" : "+v"(lane));
        const int row0 = blk * RB; const bool lat = row0 < NLAT; const int t0 = lat ? (row0 & 8191) : ((row0 - NLAT) & 255); const int len = lat ? SEQ : CTXL;
        const int dsub = (lane & 7) * 8;
        {
            float gq[8], gk[8];
#pragma unroll
            for (int i = 0; i < 8; ++i) { gq[i] = p.diff_qk_gain[dsub + i] * (0.125f * 1.4426950408889634f); gk[i] = p.diff_qk_gain[64 + dsub + i]; }
#pragma unroll
            for (int i0 = 0; i0 < RB; i0 += 4) {
                bf16x8 raw[4][2]; f32x4 c4[4], s4[4];
#pragma unroll
                for (int i = 0; i < 4; ++i) { const bf16_t* P = proj + (size_t)(row0 + i0 + i) * EV_NP;
                    raw[i][0] = *(const bf16x8*)(P + lane * 8); raw[i][1] = *(const bf16x8*)(P + 512 + lane * 8);
                    c4[i] = (f32x4){1.f, 1.f, 1.f, 1.f}; s4[i] = (f32x4){0.f, 0.f, 0.f, 0.f};
                    if (lat) { c4[i] = *(const f32x4*)(ropec + (t0 + i0 + i) * 32 + (lane & 7) * 4); s4[i] = *(const f32x4*)(ropes + (t0 + i0 + i) * 32 + (lane & 7) * 4); } }
#pragma unroll
                for (int i = 0; i < 4; ++i) { bf16_t* P = proj + (size_t)(row0 + i0 + i) * EV_NP;
#pragma unroll
                    for (int which = 0; which < 2; ++which) {
                        float v[8]; unpack8(raw[i][which], v);
                        float ss = 0.f;
#pragma unroll
                        for (int e = 0; e < 8; ++e) ss += v[e] * v[e];
                        ss += __shfl_xor(ss, 1); ss += __shfl_xor(ss, 2); ss += __shfl_xor(ss, 4);
                        const float rstd = rsqrtf(ss * (1.f / 64.f) + 1e-6f);
#pragma unroll
                        for (int e = 0; e < 8; ++e) v[e] = v[e] * rstd * (which ? gk[e] : gq[e]);
#pragma unroll
                        for (int e = 0; e < 4; ++e) { const float x0 = v[2 * e], x1 = v[2 * e + 1]; v[2 * e] = x0 * c4[i][e] - x1 * s4[i][e]; v[2 * e + 1] = x0 * s4[i][e] + x1 * c4[i][e]; }
                        *(bf16x8*)(P + which * 512 + lane * 8) = pack8(v);
                    } }
            }
        }
#pragma unroll 1
        for (int g = 0; g < 3; ++g) {
            const int c0 = g * 512 + lane * 8;
            float w[5][8];
#pragma unroll
            for (int j = 0; j < 5; ++j) { const f32x4 w0 = *(const f32x4*)(p.gdn_conv + j * 1536 + c0), w1 = *(const f32x4*)(p.gdn_conv + j * 1536 + c0 + 4);
#pragma unroll
                for (int e = 0; e < 4; ++e) { w[j][e] = w0[e]; w[j][4 + e] = w1[e]; } }
            const bf16_t* src = proj + (size_t)row0 * EV_NP + 1536 + c0;
            bf16x8 raw[RB + 4];
#pragma unroll
            for (int k = 0; k < RB + 4; ++k) { const int dt = k - 2; raw[k] = (bf16x8){0, 0, 0, 0, 0, 0, 0, 0};
                if (t0 + dt >= 0 && t0 + dt < len) raw[k] = *(const bf16x8*)(src + (ptrdiff_t)dt * EV_NP); }
            const float nsc = g == 0 ? 0.08838834764831845f : 1.f;
#pragma unroll
            for (int i = 0; i < RB; ++i) {
                float xm2[8], xm1[8], x0[8], xp1[8], xp2[8];
                unpack8(raw[i], xm2); unpack8(raw[i + 1], xm1); unpack8(raw[i + 2], x0); unpack8(raw[i + 3], xp1); unpack8(raw[i + 4], xp2);
                float y[8];
#pragma unroll
                for (int e = 0; e < 8; ++e) { y[e] = w[0][e] * xm2[e] + w[1][e] * xm1[e] + w[2][e] * x0[e] + w[3][e] * xp1[e] + w[4][e] * xp2[e]; y[e] = y[e] * __builtin_amdgcn_rcpf(1.f + __expf(-y[e])); }
                if (g < 2) { float ss = 0.f;
#pragma unroll
                    for (int e = 0; e < 8; ++e) ss += y[e] * y[e];
                    ss += __shfl_xor(ss, 1); ss += __shfl_xor(ss, 2); ss += __shfl_xor(ss, 4); ss += __shfl_xor(ss, 8);
                    const float sc_ = rsqrtf(ss + 1e-6f) * nsc;
#pragma unroll
                    for (int e = 0; e < 8; ++e) y[e] *= sc_; }
                *(bf16x8*)(qkvp + (size_t)(row0 + i) * 1536 + c0) = pack8(y);
            }
        }
#pragma unroll
        for (int k = 0; k < RB / 4; ++k) { const int idx = lane + 64 * k, i = idx >> 4, gi = idx & 15;
            const float gvv = bf2f(proj[(size_t)(row0 + i) * EV_NP + 3584 + gi]); float o;
            if (gi < 8) o = 1.f / (1.f + expf(-gvv));
            else { const float z = gvv + p.gdn_dt_bias[gi - 8]; const float sp = z > 20.f ? z : log1pf(expf(z)); o = -expf(p.gdn_a_log[gi - 8]) * sp; }
            gbuf[(size_t)(row0 + i) * 16 + gi] = o; }
    }
}

__device__ __forceinline__ int gdn_row(int b, int pc, int tau, int dir) {
    const int tt = dir ? 63 - tau : tau;
    return pc < 4 ? NLAT + b * CTXL + pc * 64 + tt : b * SEQ + (pc - 4) * 64 + tt;
}
__device__ __forceinline__ void gdn_pre_phase(const Params& p, unsigned char* lds) {
    const int lane = threadIdx.x & 63, wid = threadIdx.x >> 6;
    float* Lw = (float*)(lds + wid * 16896);
    float* gs = Lw + 4096; float* bs = gs + 64;
    const bf16_t* qkvp = (const bf16_t*)p.out;
    const float* gbuf = (const float*)(p.ws + WS_GATES);
    bf16_t* Tb = (bf16_t*)(p.ws + WS_T); bf16_t* Ab = (bf16_t*)(p.ws + WS_AQK);
    float* gv = (float*)(p.ws + WS_GV); float* bv = (float*)(p.ws + WS_BV);
    const int lane0 = lane;
    for (int cp = blockIdx.x * 8 + wid; cp < NCHUNKP; cp += gridDim.x * 8) {
        int lane = lane0; asm volatile("" : "+v"(lane));
        const int r32 = lane & 31, hi = lane >> 5;
        const int pc = cp % 132, ch = cp / 132, dir = ch & 1, h = (ch >> 1) & 3, b = ch >> 3;
        { const int R = gdn_row(b, pc, lane, dir);
          float g = gbuf[(size_t)R * 16 + 8 + dir * 4 + h]; const float be = gbuf[(size_t)R * 16 + dir * 4 + h];
#pragma unroll
          for (int o = 1; o < 64; o <<= 1) { const float t = __shfl_up(g, o); if (lane >= o) g += t; }
          gs[lane] = g; bs[lane] = be; const float gl_ = __shfl(g, 63); gv[(size_t)cp * 64 + lane] = expf(g); bv[(size_t)cp * 64 + lane] = be; ((float*)(p.ws + WS_EL))[(size_t)cp * 64 + lane] = expf(gl_ - g); }
        bf16x8 kf[2][8];
#pragma unroll
        for (int mi = 0; mi < 2; ++mi) { const size_t R = (size_t)gdn_row(b, pc, 32 * mi + r32, dir);
#pragma unroll
            for (int d0 = 0; d0 < 8; ++d0) kf[mi][d0] = *(const bf16x8*)(qkvp + R * 1536 + 512 + h * 128 + d0 * 16 + hi * 8); }
        bf16_t* Ao = Ab + (size_t)cp * 4096;
#pragma unroll
        for (int mi = 0; mi < 2; ++mi) {
            bf16x8 qf[8];
            { const size_t R = (size_t)gdn_row(b, pc, 32 * mi + r32, dir);
#pragma unroll
              for (int d0 = 0; d0 < 8; ++d0) qf[d0] = *(const bf16x8*)(qkvp + R * 1536 + h * 128 + d0 * 16 + hi * 8); }
#pragma unroll
            for (int ni = 0; ni <= mi; ++ni) {
                f32x16 ckk = {}, cqk = {};
#pragma unroll
                for (int d0 = 0; d0 < 8; ++d0) { ckk = __builtin_amdgcn_mfma_f32_32x32x16_bf16(kf[mi][d0], kf[ni][d0], ckk, 0, 0, 0);
                                                 cqk = __builtin_amdgcn_mfma_f32_32x32x16_bf16(qf[d0], kf[ni][d0], cqk, 0, 0, 0); }
                const int sg = 32 * ni + r32; const float gsg = gs[sg];
#pragma unroll
                for (int r = 0; r < 16; ++r) { const int tau = 32 * mi + crow(r, hi);
                    const float dec = tau >= sg ? __expf(gs[tau] - gsg) : 0.f;
                    Lw[tau * 64 + sg] = tau > sg ? bs[tau] * dec * ckk[r] : 0.f;
                    Ao[tau * 64 + sg] = f2bf(cqk[r] * dec); }
                asm volatile("" ::: "memory");
            }
        }
#pragma unroll
        for (int r = 0; r < 16; ++r) Ao[crow(r, hi) * 64 + 32 + r32] = 0;
        float Tc[64];
#pragma unroll
        for (int i = 0; i < 64; ++i) { float a = (i == lane) ? 1.f : 0.f;
#pragma unroll
            for (int j = 0; j < i; ++j) a -= Lw[i * 64 + j] * Tc[j];
            Tc[i] = a; asm volatile("" ::: "memory"); }
        bf16_t* To = Tb + (size_t)cp * 4096;
#pragma unroll
        for (int i = 0; i < 64; ++i) To[i * 64 + lane] = f2bf(Tc[i]);
    }
}

constexpr int G_KV = 0, G_QA = 16384, G_TT = 32768, G_AQ = G_TT + 9216, G_RT = G_AQ + 9216, G_UT = G_RT + 4608, G_UP = G_UT + 4608,
              G_ST = G_UP + 4608, G_VS = G_ST + 8704, G_GS = G_VS + 4096, G_BS = G_GS + 256, G_EL = G_BS + 256, G_END = G_EL + 256;
__device__ __forceinline__ void gdn_scan_phase(const Params& p, unsigned char* lds) {
    const int tid = threadIdx.x, lane0 = tid & 63, wid = tid >> 6;
    const bf16_t* qkvp = (const bf16_t*)p.out;
    const bf16_t* Tb = (const bf16_t*)(p.ws + WS_T); const bf16_t* Ab = (const bf16_t*)(p.ws + WS_AQK);
    const float* gv = (const float*)(p.ws + WS_GV); const float* bv = (const float*)(p.ws + WS_BV);
    bf16_t* obuf = (bf16_t*)(p.ws + WS_H);
    const float* gsl = (const float*)(lds + G_GS); const float* bsl = (const float*)(lds + G_BS); const float* esl = (const float*)(lds + G_EL);
    const int sr = tid >> 4, sc = (tid & 15) * 8;
    const int vblk = (gridDim.x % 8 == 0) ? (int)((blockIdx.x & 7) * (gridDim.x >> 3) + (blockIdx.x >> 3)) : (int)blockIdx.x;
    for (int wi = vblk; wi < 256; wi += gridDim.x) {
        const int chain = wi >> 2, cs = wi & 3, b = chain >> 3, h = (chain >> 1) & 3, dir = chain & 1;
        f32x16 Sacc = {};
        for (int i = tid; i < 8704 / 4; i += NTHREADS) ((unsigned*)(lds + G_ST))[i] = 0u;
        bf16x8 sk0, sk1, sq0, sq1, sT, sA, sV; float sg = 0.f;
#define GLOAD(step) do { const int pc_ = dir == 0 ? (step) : ((step) < 4 ? 3 - (step) : 4 + 127 - ((step) - 4)); \
        const size_t cp_ = (size_t)chain * 132 + pc_; \
        const size_t R0_ = (size_t)gdn_row(b, pc_, sr, dir), R1_ = (size_t)gdn_row(b, pc_, 32 + sr, dir); \
        sk0 = *(const bf16x8*)(qkvp + R0_ * 1536 + 512 + h * 128 + sc); sk1 = *(const bf16x8*)(qkvp + R1_ * 1536 + 512 + h * 128 + sc); \
        sq0 = *(const bf16x8*)(qkvp + R0_ * 1536 + h * 128 + sc); sq1 = *(const bf16x8*)(qkvp + R1_ * 1536 + h * 128 + sc); \
        sT = *(const bf16x8*)(Tb + cp_ * 4096 + tid * 8); sA = *(const bf16x8*)(Ab + cp_ * 4096 + tid * 8); \
        if (tid < 256) { const size_t Rv_ = (size_t)gdn_row(b, pc_, tid >> 2, dir); sV = *(const bf16x8*)(qkvp + Rv_ * 1536 + 1024 + h * 128 + cs * 32 + (tid & 3) * 8); } \
        if (tid < 64) sg = gv[cp_ * 64 + tid]; else if (tid < 128) sg = bv[cp_ * 64 + tid - 64]; else if (tid < 192) sg = ((const float*)(p.ws + WS_EL))[cp_ * 64 + tid - 128]; } while (0)
#define GWRITE() do { *(bf16x8*)(lds + G_KV + v_st(sr, sc)) = sk0; *(bf16x8*)(lds + G_KV + v_st(32 + sr, sc)) = sk1; \
        *(bf16x8*)(lds + G_QA + KSWZ(sr, sc * 2)) = sq0; *(bf16x8*)(lds + G_QA + KSWZ(32 + sr, sc * 2)) = sq1; \
        *(bf16x8*)(lds + G_TT + (tid >> 3) * 144 + (tid & 7) * 16) = sT; *(bf16x8*)(lds + G_AQ + (tid >> 3) * 144 + (tid & 7) * 16) = sA; \
        if (tid < 256) *(bf16x8*)(lds + G_VS + (tid >> 2) * 64 + (tid & 3) * 16) = sV; \
        if (tid < 192) ((float*)(lds + G_GS))[tid] = sg; } while (0)
        GLOAD(0);
        for (int step = 0; step < 132; ++step) {
            GWRITE();
            __syncthreads();
            if (step + 1 < 132) GLOAD(step + 1);
            int lane = lane0; asm volatile("" : "+v"(lane));
            const int r32 = lane & 31, hi = lane >> 5;
            const int vb0 = (int)(uintptr_t)(lds + G_KV) + v_rd_base(lane);
            const int pc = dir == 0 ? step : (step < 4 ? 3 - step : 4 + 127 - (step - 4));
            f32x16 acc = {};
            const int mi = wid & 1;
            if (wid < 4) {
                f32x16 acc2 = {};
                if (wid < 2) {
#pragma unroll
                    for (int d0 = 0; d0 < 8; d0 += 2) {
                        const bf16x8 a0 = *(const bf16x8*)(lds + G_KV + v_st(32 * mi + r32, d0 * 16 + hi * 8)), a1 = *(const bf16x8*)(lds + G_KV + v_st(32 * mi + r32, d0 * 16 + 16 + hi * 8));
                        const bf16x8 b0 = *(const bf16x8*)(lds + G_ST + r32 * 272 + (d0 * 16 + hi * 8) * 2), b1 = *(const bf16x8*)(lds + G_ST + r32 * 272 + (d0 * 16 + 16 + hi * 8) * 2);
                        acc = __builtin_amdgcn_mfma_f32_32x32x16_bf16(a0, b0, acc, 0, 0, 0);
                        acc2 = __builtin_amdgcn_mfma_f32_32x32x16_bf16(a1, b1, acc2, 0, 0, 0); }
                } else {
#pragma unroll
                    for (int d0 = 0; d0 < 8; d0 += 2) {
                        const bf16x8 a0 = *(const bf16x8*)(lds + G_QA + KSWZ(32 * mi + r32, (d0 * 16 + hi * 8) * 2)), a1 = *(const bf16x8*)(lds + G_QA + KSWZ(32 * mi + r32, (d0 * 16 + 16 + hi * 8) * 2));
                        const bf16x8 b0 = *(const bf16x8*)(lds + G_ST + r32 * 272 + (d0 * 16 + hi * 8) * 2), b1 = *(const bf16x8*)(lds + G_ST + r32 * 272 + (d0 * 16 + 16 + hi * 8) * 2);
                        acc = __builtin_amdgcn_mfma_f32_32x32x16_bf16(a0, b0, acc, 0, 0, 0);
                        acc2 = __builtin_amdgcn_mfma_f32_32x32x16_bf16(a1, b1, acc2, 0, 0, 0); }
                }
#pragma unroll
                for (int r = 0; r < 16; ++r) acc[r] += acc2[r];
                if (wid < 2) {
#pragma unroll
                    for (int g4 = 0; g4 < 4; ++g4) { float rv[4];
#pragma unroll
                        for (int j = 0; j < 4; ++j) { const int tau = 32 * mi + 8 * g4 + 4 * hi + j;
                            const float vv = bf2f(*(const bf16_t*)(lds + G_VS + tau * 64 + r32 * 2));
                            rv[j] = bsl[tau] * (vv - gsl[tau] * acc[g4 * 4 + j]); }
                        u32x2 w; w.x = cvtpk(rv[0], rv[1]); w.y = cvtpk(rv[2], rv[3]);
                        *(u32x2*)(lds + G_RT + r32 * 144 + (32 * mi + 8 * g4 + 4 * hi) * 2) = w; }
                } else {
#pragma unroll
                    for (int r = 0; r < 16; ++r) acc[r] *= gsl[32 * mi + crow(r, hi)];
                }
            }
            __syncthreads();
            if (wid < 2) {
                f32x16 u = {}, u2 = {};
#pragma unroll
                for (int s = 0; s < 4; s += 2) {
                    const bf16x8 a0 = *(const bf16x8*)(lds + G_TT + (32 * mi + r32) * 144 + (16 * s + hi * 8) * 2), a1 = *(const bf16x8*)(lds + G_TT + (32 * mi + r32) * 144 + (16 * s + 16 + hi * 8) * 2);
                    const bf16x8 b0 = *(const bf16x8*)(lds + G_RT + r32 * 144 + (16 * s + hi * 8) * 2), b1 = *(const bf16x8*)(lds + G_RT + r32 * 144 + (16 * s + 16 + hi * 8) * 2);
                    u = __builtin_amdgcn_mfma_f32_32x32x16_bf16(a0, b0, u, 0, 0, 0);
                    u2 = __builtin_amdgcn_mfma_f32_32x32x16_bf16(a1, b1, u2, 0, 0, 0); }
#pragma unroll
                for (int r = 0; r < 16; ++r) u[r] += u2[r];
#pragma unroll
                for (int g4 = 0; g4 < 4; ++g4) { float uv[4], up[4];
#pragma unroll
                    for (int j = 0; j < 4; ++j) { const int tau = 32 * mi + 8 * g4 + 4 * hi + j; uv[j] = u[g4 * 4 + j]; up[j] = uv[j] * esl[tau]; }
                    u32x2 w; w.x = cvtpk(uv[0], uv[1]); w.y = cvtpk(uv[2], uv[3]);
                    *(u32x2*)(lds + G_UT + r32 * 144 + (32 * mi + 8 * g4 + 4 * hi) * 2) = w;
                    u32x2 w2; w2.x = cvtpk(up[0], up[1]); w2.y = cvtpk(up[2], up[3]);
                    *(u32x2*)(lds + G_UP + r32 * 144 + (32 * mi + 8 * g4 + 4 * hi) * 2) = w2; }
            }
            __syncthreads();
            if (wid == 2 || wid == 3) {
#pragma unroll
                for (int s = 0; s < 4; ++s) {
                    const bf16x8 a = *(const bf16x8*)(lds + G_AQ + (32 * mi + r32) * 144 + (16 * s + hi * 8) * 2);
                    const bf16x8 bb = *(const bf16x8*)(lds + G_UT + r32 * 144 + (16 * s + hi * 8) * 2);
                    acc = __builtin_amdgcn_mfma_f32_32x32x16_bf16(a, bb, acc, 0, 0, 0); }
#pragma unroll
                for (int r = 0; r < 16; ++r) { const size_t R = (size_t)gdn_row(b, pc, 32 * mi + crow(r, hi), dir);
                    obuf[((size_t)dir * MTOT + R) * 512 + h * 128 + cs * 32 + r32] = f2bf(acc[r]); }
            } else if (wid >= 4) {
                const float gl = gsl[63];
#pragma unroll
                for (int r = 0; r < 16; ++r) Sacc[r] *= gl;
                const bf16x8 pa0 = *(const bf16x8*)(lds + G_UP + r32 * 144 + (0 + hi * 8) * 2), pa1 = *(const bf16x8*)(lds + G_UP + r32 * 144 + (16 + hi * 8) * 2),
                             pa2 = *(const bf16x8*)(lds + G_UP + r32 * 144 + (32 + hi * 8) * 2), pa3 = *(const bf16x8*)(lds + G_UP + r32 * 144 + (48 + hi * 8) * 2);
                const int d0 = wid - 4;
                if (d0 == 0) pv_one<0>(Sacc, vb0, pa0, pa1, pa2, pa3); else if (d0 == 1) pv_one<1>(Sacc, vb0, pa0, pa1, pa2, pa3);
                else if (d0 == 2) pv_one<2>(Sacc, vb0, pa0, pa1, pa2, pa3); else pv_one<3>(Sacc, vb0, pa0, pa1, pa2, pa3);
#pragma unroll
                for (int r = 0; r < 16; ++r) *(bf16_t*)(lds + G_ST + crow(r, hi) * 272 + (32 * d0 + r32) * 2) = f2bf(Sacc[r]);
            }
            __syncthreads();
        }
#undef GLOAD
#undef GWRITE
    }
}

__device__ __forceinline__ void gdn_post_phase(const Params& p) {
    const int lane = threadIdx.x & 63, wid = threadIdx.x >> 6;
    const bf16_t* obuf = (const bf16_t*)(p.ws + WS_H);
    const bf16_t* proj = (const bf16_t*)(p.ws + WS_PROJ);
    bf16_t* mix = (bf16_t*)(p.ws + WS_MIX);
    const int d = (lane & 15) * 8;
    for (int row = blockIdx.x * 8 + wid; row < MTOT; row += gridDim.x * 8) {
        float a[8], bb[8], g[8], y[8];
        unpack8(*(const bf16x8*)(obuf + (size_t)row * 512 + lane * 8), a);
        unpack8(*(const bf16x8*)(obuf + ((size_t)MTOT + row) * 512 + lane * 8), bb);
        unpack8(*(const bf16x8*)(proj + (size_t)row * EV_NP + 3072 + lane * 8), g);
        float ss = 0.f;
#pragma unroll
        for (int i = 0; i < 8; ++i) { a[i] += bb[i]; ss += a[i] * a[i]; }
        ss += __shfl_xor(ss, 1); ss += __shfl_xor(ss, 2); ss += __shfl_xor(ss, 4); ss += __shfl_xor(ss, 8);
        const float rstd = rsqrtf(ss * (1.f / 128.f) + 1e-6f);
#pragma unroll
        for (int i = 0; i < 8; ++i) y[i] = a[i] * rstd * p.gdn_norm[d + i] * (g[i] * __builtin_amdgcn_rcpf(1.f + __expf(-g[i])));
        *(bf16x8*)(mix + (size_t)row * DM + 512 + lane * 8) = pack8(y);
    }
}

__device__ __forceinline__ void diffattn_phase(const Params& p, unsigned char* lds) {
    const int tid = threadIdx.x, wid = tid >> 6, lane = tid & 63, r32 = lane & 31, hi = lane >> 5;
    const bf16_t* proj = (const bf16_t*)(p.ws + WS_PROJ);
    bf16_t* mix = (bf16_t*)(p.ws + WS_MIX);
    float s01 = 0.f, s23 = 0.f;
    for (int i = 0; i < 64; ++i) { s01 += p.diff_lambda[i] * p.diff_lambda[64 + i]; s23 += p.diff_lambda[128 + i] * p.diff_lambda[192 + i]; }
    const float lam = expf(s01) - expf(s23) + 0.2f;
    float* X = (float*)lds; float* li = (float*)(lds + 131072) + wid * 64;
    LAS unsigned char* ldsl = (LAS unsigned char*)lds;
    int koff[2], voff[2];
#pragma unroll
    for (int i = 0; i < 2; ++i) {
        const int g = i * 512 + tid;
        { const int row = g >> 4, cg = (g & 15) ^ (row & 7); koff[i] = row * EV_NP + cg * 8; }
        { const int o = g * 16, st = o >> 9, w = o & 511, kk = (st >> 2) * 8 + (w >> 6);
          const int k = (kk & ~0xC) | ((kk & 4) << 1) | ((kk & 8) >> 1), cc = (st & 3) * 32 + ((w & 63) >> 4) * 8; voff[i] = k * EV_NP + cc; }
    }
    const int vbase = (int)(uintptr_t)lds + v_rd_base(lane);
    const int map = wid >> 2, wq = wid & 3;
    unsigned char* Qs = lds + 98304 + wid * 4096 + lane * 16;
    const int vblk = (gridDim.x % 8 == 0) ? (int)((blockIdx.x & 7) * (gridDim.x >> 3) + (blockIdx.x >> 3)) : (int)blockIdx.x;
    for (int it = vblk; it < 2112; it += gridDim.x) {
        int b, h, NT, qrow0;
        if (it < 2048) { b = it >> 8; h = (it >> 6) & 3; const int qb = it & 63; NT = 132; qrow0 = b * SEQ + qb * 128; }
        else { const int j = it - 2048; b = j >> 3; h = (j >> 1) & 3; NT = 4; qrow0 = NLAT + b * CTXL + (j & 1) * 128; }
        bf16x8 qr[4];
        { const bf16_t* qp = proj + (size_t)(qrow0 + 32 * wq + r32) * EV_NP + h * 128 + map * 64 + hi * 8;
#pragma unroll
          for (int d0 = 0; d0 < 4; ++d0) qr[d0] = *(const bf16x8*)(qp + d0 * 16); }
        f32x16 o[4] = {}; float lsum = 0.f;
#define DDMA(j, bo) do { const bf16_t* pp_ = proj + (size_t)((j) < 4 ? NLAT + b * CTXL + 64 * (j) : b * SEQ + 64 * ((j) - 4)) * EV_NP + h * 128; \
        _Pragma("unroll") for (int i_ = 0; i_ < 2; ++i_) { \
            __builtin_amdgcn_global_load_lds((const unsigned*)(pp_ + 1024 + voff[i_]), (LAS unsigned*)(ldsl + (bo) + i_ * 8192 + wid * 1024), 16, 0, 0); \
            __builtin_amdgcn_global_load_lds((const unsigned*)(pp_ + 512 + koff[i_]), (LAS unsigned*)(ldsl + (bo) + 16384 + i_ * 8192 + wid * 1024), 16, 0, 0); } } while (0)
#define DQK(P0, P1, bo) do { P0 = (f32x16){}; P1 = (f32x16){}; const unsigned char* Ks_ = lds + (bo) + 16384; \
        _Pragma("unroll") for (int d0 = 0; d0 < 4; ++d0) { const int cb_ = (map * 64 + d0 * 16 + hi * 8) * 2; \
            const bf16x8 b0_ = *(const bf16x8*)(Ks_ + KSWZ(r32, cb_)), b1_ = *(const bf16x8*)(Ks_ + KSWZ(32 + r32, cb_)); \
            P0 = __builtin_amdgcn_mfma_f32_32x32x16_bf16(b0_, qr[d0], P0, 0, 0, 0); \
            P1 = __builtin_amdgcn_mfma_f32_32x32x16_bf16(b1_, qr[d0], P1, 0, 0, 0); } } while (0)
#define DSM(P0, P1) do { _Pragma("unroll") for (int r = 0; r < 16; ++r) { P0[r] = __builtin_amdgcn_exp2f(P0[r]); P1[r] = __builtin_amdgcn_exp2f(P1[r]); lsum += P0[r] + P1[r]; } \
        PK4(P0, 0, pa0); PK4(P0, 8, pa1); PK4(P1, 0, pa2); PK4(P1, 8, pa3); } while (0)
#define DTAIL_() asm volatile("s_waitcnt vmcnt(0)" ::: "memory"); __syncthreads(); { const int t_ = bprev; bprev = bcur; bcur = bnext; bnext = t_; }
#define DSTEP_A(N0, N1, O0, O1, j) do { if ((j) + 1 < NT) DDMA((j) + 1, bnext); \
        DQK(N0, N1, bcur); DSM(O0, O1); pv_d0(o, vbase + bprev, pa0, pa1, pa2, pa3); DTAIL_() } while (0)
#define DSTEP_B(N0, N1, O0, O1, j) do { if ((j) + 1 < NT) DDMA((j) + 1, bnext); \
        DSM(O0, O1); pv_d0(o, vbase + bprev, pa0, pa1, pa2, pa3); SBAR(); DQK(N0, N1, bcur); DTAIL_() } while (0)
        f32x16 pA0, pA1, pB0, pB1; bf16x8 pa0, pa1, pa2, pa3;
        DDMA(0, 0); DDMA(1, 32768); asm volatile("s_waitcnt vmcnt(0)" ::: "memory"); __syncthreads();
        DQK(pA0, pA1, 0);
        int bprev = 0, bcur = 32768, bnext = 65536;
        if (map == 0) {
            for (int j = 1; j + 1 < NT; j += 2) { DSTEP_A(pB0, pB1, pA0, pA1, j); DSTEP_A(pA0, pA1, pB0, pB1, j + 1); }
            DSTEP_A(pB0, pB1, pA0, pA1, NT - 1);
        } else {
            for (int j = 1; j + 1 < NT; j += 2) { DSTEP_B(pB0, pB1, pA0, pA1, j); DSTEP_B(pA0, pA1, pB0, pB1, j + 1); }
            DSTEP_B(pB0, pB1, pA0, pA1, NT - 1);
        }
        DSM(pB0, pB1); pv_d0(o, vbase + bprev, pa0, pa1, pa2, pa3);
        __syncthreads();
#undef DDMA
#undef DQK
#undef DSM
#undef DSTEP_A
#undef DSTEP_B
#undef DTAIL_
        const float lt = halfswap_add(lsum);
        if (hi == 0) li[r32] = lt;
        asm volatile("s_waitcnt lgkmcnt(0)" ::: "memory");
        float rli[16];
#pragma unroll
        for (int r = 0; r < 16; ++r) rli[r] = 1.f / li[crow(r, hi)];
        if (map == 1) {
#pragma unroll
            for (int d0 = 0; d0 < 4; ++d0)
#pragma unroll
                for (int r = 0; r < 16; ++r) X[(wq * 64 + d0 * 16 + r) * 64 + lane] = o[d0][r] * rli[r] * lam;
        }
        __syncthreads();
        if (map == 0) {
#pragma unroll
            for (int d0 = 0; d0 < 4; ++d0)
#pragma unroll
                for (int r = 0; r < 16; ++r) o[d0][r] = o[d0][r] * rli[r] - X[(wq * 64 + d0 * 16 + r) * 64 + lane];
#pragma unroll
            for (int r = 0; r < 16; ++r) {
                float ss = o[0][r] * o[0][r] + o[1][r] * o[1][r] + o[2][r] * o[2][r] + o[3][r] * o[3][r];
                ss += __shfl_xor(ss, 1); ss += __shfl_xor(ss, 2); ss += __shfl_xor(ss, 4); ss += __shfl_xor(ss, 8); ss += __shfl_xor(ss, 16);
                const float rstd = rsqrtf(ss * (1.f / 128.f) + 1e-6f) * 0.8f;
                bf16_t* mp = mix + (size_t)(qrow0 + 32 * wq + crow(r, hi)) * DM + h * 128 + r32;
#pragma unroll
                for (int d0 = 0; d0 < 4; ++d0) mp[32 * d0] = f2bf(o[d0][r] * rstd * p.diff_subln[32 * d0 + r32]);
            }
        }
        __syncthreads();
    }
}

__device__ __forceinline__ void natten_phase(const Params& p, unsigned char* lds) {
    const int tid = threadIdx.x, wid = tid >> 6, lane = tid & 63, r32 = lane & 31, hi = lane >> 5;
    const bf16_t* proj = (const bf16_t*)(p.ws + WS_PROJ);
    bf16_t* mix = (bf16_t*)(p.ws + WS_MIX);
    constexpr float L2E = 1.4426950408889634f;
    unsigned char* Vl = lds; unsigned char* Kl = lds + 32768;
    float* rpbs = (float*)(lds + 65536);
    float* li = (float*)(lds + 133120) + wid * 64;
    unsigned char* Qs = lds + 67584 + wid * 8192 + lane * 16;
    const int sr = tid >> 4, sc = (tid & 15) * 8, vst0 = v_st(sr, sc), vst1 = v_st(32 + sr, sc);
    const int vb0 = (int)(uintptr_t)Vl + v_rd_base(lane);
    const float* gkp = p.na_qk_gain + 128 + sc;
    const int vblk = (gridDim.x % 8 == 0) ? (int)((blockIdx.x & 7) * (gridDim.x >> 3) + (blockIdx.x >> 3)) : (int)blockIdx.x;
    for (int it = vblk; it < 2048; it += gridDim.x) {
        const int b = it >> 8, h = (it >> 5) & 7, rq = it & 31;
        const int grow = 4 * rq + (wid >> 1), qc = (wid & 1) * 32 + r32;
        const size_t qR = (size_t)b * SEQ + grow * 64 + qc;
        for (int i = tid; i < 465; i += NTHREADS) rpbs[i] = p.na_rpb[h * 465 + i] * L2E;
        { float ss = 0.f;
#pragma unroll
          for (int d0 = 0; d0 < 8; ++d0) { float qv[8]; unpack8(*(const bf16x8*)(proj + qR * OD_N + h * 128 + d0 * 16 + hi * 8), qv);
#pragma unroll
              for (int i = 0; i < 8; ++i) ss += qv[i] * qv[i]; }
          ss = halfswap_add(ss);
          const float rs = rsqrtf(ss * (1.f / 128.f) + 1e-6f) * 0.08838834764831845f * L2E;
#pragma unroll
          for (int d0 = 0; d0 < 8; ++d0) { float qv[8]; unpack8(*(const bf16x8*)(proj + qR * OD_N + h * 128 + d0 * 16 + hi * 8), qv);
#pragma unroll
              for (int i = 0; i < 8; ++i) qv[i] *= rs * p.na_qk_gain[d0 * 16 + hi * 8 + i];
              *(bf16x8*)(Qs + d0 * 1024) = pack8(qv); } }
        int lo = 4 * rq - 4; lo = lo < 0 ? 0 : (lo > 120 ? 120 : lo);
        int hi_r = 4 * rq + 3 - 4; hi_r = hi_r < 0 ? 0 : (hi_r > 120 ? 120 : hi_r); hi_r += 7;
        const int nlat = hi_r - lo + 1, NT = nlat + 4;
        int wsr = grow - 4; wsr = wsr < 0 ? 0 : (wsr > 120 ? 120 : wsr);
        int cst = qc - 8; cst = cst < 0 ? 0 : (cst > 48 ? 48 : cst);
        f32x16 o[4] = {}; float lsum = 0.f;
        bf16x8 vs0, vs1, ks0, ks1;
#define NLOAD(j) do { const size_t R0_ = (size_t)((j) < nlat ? b * SEQ + (lo + (j)) * 64 : NLAT + b * CTXL + 64 * ((j) - nlat)) + sr; \
        const bf16_t* pp_ = proj + R0_ * OD_N + h * 128 + sc; \
        vs0 = *(const bf16x8*)(pp_ + 2048); vs1 = *(const bf16x8*)(pp_ + 2048 + (size_t)32 * OD_N); \
        ks0 = *(const bf16x8*)(pp_ + 1024); ks1 = *(const bf16x8*)(pp_ + 1024 + (size_t)32 * OD_N); } while (0)
#define KNORM(kx) do { float f_[8]; unpack8(kx, f_); float ss_ = 0.f; _Pragma("unroll") for (int i_ = 0; i_ < 8; ++i_) ss_ += f_[i_] * f_[i_]; \
        ss_ += __shfl_xor(ss_, 1); ss_ += __shfl_xor(ss_, 2); ss_ += __shfl_xor(ss_, 4); ss_ += __shfl_xor(ss_, 8); \
        const float rs_ = rsqrtf(ss_ * (1.f / 128.f) + 1e-6f); _Pragma("unroll") for (int i_ = 0; i_ < 8; ++i_) f_[i_] *= rs_ * gkp[i_]; kx = pack8(f_); } while (0)
#define NWRITE(bf) do { KNORM(ks0); KNORM(ks1); *(bf16x8*)(Vl + (bf) * 16384 + vst0) = vs0; *(bf16x8*)(Vl + (bf) * 16384 + vst1) = vs1; \
        *(bf16x8*)(Kl + (bf) * 16384 + KSWZ(sr, sc * 2)) = ks0; *(bf16x8*)(Kl + (bf) * 16384 + KSWZ(32 + sr, sc * 2)) = ks1; } while (0)
        NLOAD(0); NWRITE(0); __syncthreads();
        for (int j = 0; j < NT; ++j) {
            if (j + 1 < NT) NLOAD(j + 1);
            const int bf = j & 1;
            const bool islat = j < nlat; const int kr = lo + j;
            const bool active = !islat || (kr >= wsr && kr <= wsr + 7);
            if (active) {
                f32x16 p0 = {}, p1 = {};
                const unsigned char* Ks = Kl + bf * 16384;
#pragma unroll
                for (int d0 = 0; d0 < 8; ++d0) { const int cb = (d0 * 16 + hi * 8) * 2;
                    const bf16x8 b0 = *(const bf16x8*)(Ks + KSWZ(r32, cb)), b1 = *(const bf16x8*)(Ks + KSWZ(32 + r32, cb));
                    const bf16x8 qd = *(const bf16x8*)(Qs + d0 * 1024);
                    p0 = __builtin_amdgcn_mfma_f32_32x32x16_bf16(b0, qd, p0, 0, 0, 0);
                    p1 = __builtin_amdgcn_mfma_f32_32x32x16_bf16(b1, qd, p1, 0, 0, 0); }
                if (islat) {
                    const float* rb = rpbs + (kr - grow + 7) * 31 + 15 - qc + 4 * hi;
                    const int mofs = 4 * hi - cst;
#pragma unroll
                    for (int r = 0; r < 16; ++r) {
                        const int kb = (r & 3) + 8 * (r >> 2);
                        const float e0 = __builtin_amdgcn_exp2f(p0[r] + rb[kb]), e1 = __builtin_amdgcn_exp2f(p1[r] + rb[32 + kb]);
                        p0[r] = ((unsigned)(kb + mofs) < 16u) ? e0 : 0.f; p1[r] = ((unsigned)(32 + kb + mofs) < 16u) ? e1 : 0.f;
                        lsum += p0[r] + p1[r]; }
                } else {
#pragma unroll
                    for (int r = 0; r < 16; ++r) { p0[r] = __builtin_amdgcn_exp2f(p0[r]); p1[r] = __builtin_amdgcn_exp2f(p1[r]); lsum += p0[r] + p1[r]; }
                }
                bf16x8 pa0, pa1, pa2, pa3;
                PK4(p0, 0, pa0); PK4(p0, 8, pa1); PK4(p1, 0, pa2); PK4(p1, 8, pa3);
                pv_d0(o, vb0 + bf * 16384, pa0, pa1, pa2, pa3);
            }
            if (j + 1 < NT) NWRITE((j + 1) & 1);
            __syncthreads();
        }
#undef NLOAD
#undef KNORM
#undef NWRITE
        const float lt = halfswap_add(lsum);
        if (hi == 0) li[r32] = lt;
        asm volatile("s_waitcnt lgkmcnt(0)" ::: "memory");
#pragma unroll
        for (int r = 0; r < 16; ++r) { const float rl = 1.f / li[crow(r, hi)];
            bf16_t* mp = mix + ((size_t)b * SEQ + grow * 64 + (wid & 1) * 32 + crow(r, hi)) * DM + h * 128 + r32;
#pragma unroll
            for (int d0 = 0; d0 < 4; ++d0) mp[32 * d0] = f2bf(o[d0][r] * rl); }
        __syncthreads();
    }
}

#define XB_TMO      128
#define XB_XCNT(j)  (256  + 64 * (j))
#define XB_XSUB(j)  (1280 + 64 * (j))
#define XB_XGEN(j)  (2304 + 64 * (j))
#define XB_TOP      3328
#define XB_TOPGEN   3392
#define XCD_BAR_WORDS 3456
#define XB_SPIN_CAP (1u << 22)
__device__ __forceinline__ unsigned xb_ld(unsigned* p)              { return __hip_atomic_load(p, __ATOMIC_RELAXED, __HIP_MEMORY_SCOPE_AGENT); }
__device__ __forceinline__ unsigned xb_add(unsigned* p, unsigned v) { return __hip_atomic_fetch_add(p, v, __ATOMIC_RELAXED, __HIP_MEMORY_SCOPE_AGENT); }
__device__ __forceinline__ unsigned xb_xcc_id() { return (unsigned)__builtin_amdgcn_s_getreg((3 << 11) | 20) & 0xFu; }
#define XB_SPIN(cond, bar) do { unsigned _sp = 0; while (cond) { __builtin_amdgcn_s_sleep(1); \
    if ((++_sp & 255u) == 0u) { if (xb_ld(&(bar)[XB_TMO])) break; if (_sp > XB_SPIN_CAP) { atomicAdd(&(bar)[XB_TMO], 1u); break; } } } } while (0)
struct XcdBarrier { unsigned* bar; unsigned x; volatile LAS unsigned* st; };
__device__ __forceinline__ XcdBarrier xcd_barrier_post(unsigned* bar, volatile LAS unsigned* st) {
    XcdBarrier b; b.bar = bar; b.x = xb_xcc_id(); b.st = st;
    if (threadIdx.x == 0) (void)xb_add(&bar[XB_XCNT(b.x)], 1u);
    return b;
}
__device__ __forceinline__ void xcd_barrier_complete(unsigned* bar, unsigned x, unsigned& nloc, unsigned& nx) {
    const unsigned G = gridDim.x * gridDim.y * gridDim.z;
    unsigned sum, cnt, mine, sp = 0u;
    for (;;) {
        sum = 0u; cnt = 0u; mine = 0u;
#pragma unroll
        for (unsigned j = 0; j < 16; ++j) { const unsigned c = xb_ld(&bar[XB_XCNT(j)]); sum += c; cnt += (c > 0u) ? 1u : 0u; mine = (j == x) ? c : mine; }
        if (sum == G) break;
        __builtin_amdgcn_s_sleep(1);
        if ((++sp & 255u) == 0u) { if (xb_ld(&bar[XB_TMO])) break; if (sp > XB_SPIN_CAP) { atomicAdd(&bar[XB_TMO], 1u); break; } }
    }
    nloc = mine > 0u ? mine : 1u; nx = cnt > 0u ? cnt : 1u;
}
__device__ __forceinline__ void xcd_barrier(const XcdBarrier& b) {
    asm volatile("s_waitcnt vmcnt(0)" ::: "memory");
    __syncthreads();
    if (threadIdx.x == 0) {
        unsigned* bar = b.bar;
        __builtin_amdgcn_s_waitcnt(0);
        unsigned nloc = b.st[0], nx = b.st[1];
        if (nloc == 0u) { xcd_barrier_complete(bar, b.x, nloc, nx); b.st[0] = nloc; b.st[1] = nx; }
        const unsigned old = xb_add(&bar[XB_XSUB(b.x)], 1u);
        const unsigned gen = old / nloc;
        if (old + 1u == (gen + 1u) * nloc) {
            __builtin_amdgcn_fence(__ATOMIC_RELEASE, "agent");
            asm volatile("s_waitcnt vmcnt(0)" ::: "memory");
            const unsigned og = xb_add(&bar[XB_TOP], 1u);
            const unsigned tg = og / nx;
            if (og + 1u == (tg + 1u) * nx) xb_add(&bar[XB_TOPGEN], 1u);
            else XB_SPIN(xb_ld(&bar[XB_TOPGEN]) == tg, bar);
            __builtin_amdgcn_fence(__ATOMIC_ACQUIRE, "agent");
            xb_add(&bar[XB_XGEN(b.x)], 1u);
            asm volatile("s_waitcnt vmcnt(0)" ::: "memory");
        } else {
            XB_SPIN(xb_ld(&bar[XB_XGEN(b.x)]) == gen, bar);
            __builtin_amdgcn_fence(__ATOMIC_ACQUIRE, "agent");
            asm volatile("s_waitcnt vmcnt(0)" ::: "memory");
        }
    }
    __syncthreads();
}

#ifndef PROBE_REP
#define PROBE_REP 0
#endif
#define REP(k) for (int rep_ = 0; rep_ < (((PROBE_REP >> (k)) & 1) ? 2 : 1); ++rep_)
constexpr int NPH = 18;
__global__ void __launch_bounds__(NTHREADS, 2) fwd_megakernel(Params p) {
    extern __shared__ __attribute__((aligned(16))) unsigned char lds[];
    cg::grid_group grid = cg::this_grid();
    LAS unsigned char* ldsl = (LAS unsigned char*)lds;
    const int lo = p.ph_lo, hi = p.ph_hi;
#ifdef ONLY_PH
#define IN(k) (((ONLY_PH >> (k)) & 1) && lo <= (k) && (k) < hi)
#else
#define IN(k) (lo <= (k) && (k) < hi)
#endif
#define SEAM(k) do { if (IN(k) && IN((k) + 1)) { if ((k) == 0) grid.sync(); else { XcdBarrier xb_; xb_.bar = (unsigned*)(p.ws + WS_BAR); xb_.x = xb_xcc_id(); xb_.st = (volatile LAS unsigned*)(ldsl + 135168); xcd_barrier(xb_); } } } while (0)
    unsigned char* ws = p.ws;
    const bf16_t* H = (const bf16_t*)(ws + WS_H);
    bf16_t* PROJ = (bf16_t*)(ws + WS_PROJ);
    const bf16_t* MIX = (const bf16_t*)(ws + WS_MIX);
    float* CTXRES = (float*)(ws + WS_CTXRES);
    const float* MOD = (const float*)(ws + WS_MOD);
    const int G = gridDim.x, c = blockIdx.x;
    if (threadIdx.x < 4) ((volatile LAS unsigned*)(ldsl + 135168))[threadIdx.x] = 0u;
    __syncthreads();
    (void)xcd_barrier_post((unsigned*)(ws + WS_BAR), (volatile LAS unsigned*)(ldsl + 135168));

    if (IN(0)) REP(0) { ada_phase(p, lds); wconv_phase(p, lds);
        { float* rc = (float*)(ws + WS_ROPE); float* rs = rc + SEQ * 32;
          for (int e = blockIdx.x * NTHREADS + threadIdx.x; e < SEQ * 32; e += gridDim.x * NTHREADS) { const int t = e >> 5, pp = e & 31;
              const float inv = powf(10000.f, -(float)(pp & 15) / 16.f); const float ang = (pp < 16 ? (float)(t >> 6) : (float)(t & 63)) * inv;
              rc[e] = cosf(ang); rs[e] = sinf(ang); } } }
    SEAM(0);
    if (IN(1)) REP(1) norm_phase(p, p.x, p.ctx, 0, 0, MTOT);
    SEAM(1);
    if (IN(2)) REP(2) { pg8::Gemm g{H, (const bf16_t*)(ws + WS_W_EVIN), MTOT, EV_NP, DM}; pg8::StaticOrderT<264, 15> S; S.init(MTOT, EV_NP, G, c);
        pg8::EpiBf16 E{PROJ, EV_NP}; pg8::gemm_phase(ldsl, g, S, E); }
    SEAM(2);
    if (IN(3)) prep0_phase(p);
    SEAM(3);
    if (IN(4)) REP(4) gdn_pre_phase(p, lds);
    SEAM(4);
    if (IN(5)) {
#ifndef SKIP_SCAN
        REP(20) { gdn_scan_phase(p, lds); __syncthreads(); }
#endif
#ifndef SKIP_DA
        REP(5) { diffattn_phase(p, lds); __syncthreads(); }
#endif
    }
    SEAM(5);
    if (IN(6)) REP(6) gdn_post_phase(p);
    SEAM(6);
    if (IN(7)) REP(7) { pg8::Gemm g{MIX, (const bf16_t*)(ws + WS_W_EVOUT), MTOT, DM, DM}; pg8::StaticOrderT<264, 4> S; S.init(MTOT, DM, G, c);
        pg8::EpiResid E{p.x, p.ctx, p.out, CTXRES, MOD, 2048}; pg8::gemm_phase(ldsl, g, S, E); }
    SEAM(7);
    if (IN(8)) norm_phase(p, p.out, CTXRES, 0, 1, MTOT);
    SEAM(8);
    if (IN(9)) REP(9) { pg8::Gemm g{H, (const bf16_t*)(ws + WS_W_FFIN), MTOT, 2 * FF, DM}; pg8::StaticOrderT<264, 22> S; S.init(MTOT, 2 * FF, G, c);
        pg8::EpiSwiglu E{PROJ, FF}; pg8::gemm_phase(ldsl, g, S, E); }
    SEAM(9);
    if (IN(10)) { pg8::Gemm g{PROJ, (const bf16_t*)(ws + WS_W_FFOUT), MTOT, DM, FF}; pg8::StaticOrderT<264, 4> S; S.init(MTOT, DM, G, c);
        pg8::EpiResid E{p.out, CTXRES, p.out, CTXRES, MOD, 5120}; pg8::gemm_phase(ldsl, g, S, E); }
    SEAM(10);
    if (IN(11)) norm_phase(p, p.out, CTXRES, 1, 0, MTOT);
    SEAM(11);
    if (IN(12)) { pg8::Gemm g{H, (const bf16_t*)(ws + WS_W_ODIN), MTOT, OD_N, DM}; pg8::StaticOrderT<264, 12> S; S.init(MTOT, OD_N, G, c);
        pg8::EpiBf16 E{PROJ, OD_N}; pg8::gemm_phase(ldsl, g, S, E); }
    SEAM(12);
    if (IN(13)) { natten_phase(p, lds); if ((PROBE_REP >> 13) & 1) { __syncthreads(); natten_phase(p, lds); } }
    SEAM(13);
    if (IN(14)) { pg8::Gemm g{MIX, (const bf16_t*)(ws + WS_W_ODOUT), NLAT, DM, DM}; pg8::StaticOrderT<256, 4> S; S.init(NLAT, DM, G, c);
        pg8::EpiResid E{p.out, CTXRES, p.out, CTXRES, MOD + 9 * 6144, 2048}; pg8::gemm_phase(ldsl, g, S, E); }
    SEAM(14);
    if (IN(15)) norm_phase(p, p.out, CTXRES, 1, 1, NLAT);
    SEAM(15);
    if (IN(16)) { pg8::Gemm g{H, (const bf16_t*)(ws + WS_W_FFIN) + (size_t)2 * FF * DM, NLAT, 2 * FF, DM}; pg8::StaticOrderT<256, 22> S; S.init(NLAT, 2 * FF, G, c);
        pg8::EpiSwiglu E{PROJ, FF}; pg8::gemm_phase(ldsl, g, S, E); }
    SEAM(16);
    if (IN(17)) { pg8::Gemm g{PROJ, (const bf16_t*)(ws + WS_W_FFOUT) + (size_t)DM * FF, NLAT, DM, FF}; pg8::StaticOrderT<256, 4> S; S.init(NLAT, DM, G, c);
        pg8::EpiResid E{p.out, CTXRES, p.out, CTXRES, MOD + 9 * 6144, 5120}; pg8::gemm_phase(ldsl, g, S, E); }
#undef IN
#undef SEAM
}

extern "C" void kernel_launch(void* const* d_in, const int* in_sizes, int n_in, void* d_out, int out_size, void* d_ws, size_t ws_size, hipStream_t stream) {
    static int grid = 0;
    if (grid == 0) {
        if (n_in != 23 || ws_size < WS_END) { fprintf(stderr, "kernel_launch: n_in %d ws %zu (need %zu)\n", n_in, ws_size, (size_t)WS_END); grid = -1; return; }
        int dev = 0, cus = 0, per_cu = 0;
        hipGetDevice(&dev); hipDeviceGetAttribute(&cus, hipDeviceAttributeMultiprocessorCount, dev);
        if (hipFuncSetAttribute((const void*)fwd_megakernel, hipFuncAttributeMaxDynamicSharedMemorySize, LDS_BYTES) != hipSuccess) { fprintf(stderr, "hipFuncSetAttribute failed\n"); grid = -1; return; }
        if (hipOccupancyMaxActiveBlocksPerMultiprocessor(&per_cu, (const void*)fwd_megakernel, NTHREADS, LDS_BYTES) != hipSuccess || per_cu < 1) per_cu = 1;
        (void)hipGetLastError();
        grid = cus * 1;
    }
    if (grid < 0) return;
    if (hipMemsetAsync((char*)d_ws + WS_BAR, 0, 16384, stream) != hipSuccess) { fprintf(stderr, "memset failed\n"); return; }
    Params p{};
    const float** pp = (const float**)&p;
    for (int i = 0; i < 23; ++i) pp[i] = (const float*)d_in[i];
    p.out = (float*)d_out; p.ws = (unsigned char*)d_ws;
#if N_LAUNCH_MODE == 1
    p.ph_lo = 0; p.ph_hi = NPH;
    void* args[] = {&p};
    hipError_t e = hipLaunchCooperativeKernel((void*)fwd_megakernel, dim3(grid), dim3(NTHREADS), args, LDS_BYTES, stream);
    if (e != hipSuccess) fprintf(stderr, "cooperative launch failed: %s (grid %d)\n", hipGetErrorString(e), grid);
#else
    for (int k = 0; k < NPH; ++k) { p.ph_lo = k; p.ph_hi = k + 1;
        hipLaunchKernelGGL(fwd_megakernel, dim3(grid), dim3(NTHREADS), LDS_BYTES, stream, p); }
#endif
}
```

```cpp
#include <hip/hip_runtime.h>
#include <hip/hip_cooperative_groups.h>
#include <cstdio>
#include <cstdint>
namespace cg = cooperative_groups;

#define LAS __attribute__((address_space(3)))
typedef unsigned short bf16_t;
typedef short bf16x8 __attribute__((ext_vector_type(8)));
typedef short s16x4 __attribute__((ext_vector_type(4)));
typedef float f32x4 __attribute__((ext_vector_type(4)));
typedef float f32x16 __attribute__((ext_vector_type(16)));
typedef unsigned u32x4 __attribute__((ext_vector_type(4)));
typedef unsigned u32x2 __attribute__((ext_vector_type(2)));

#ifndef N_LAUNCH_MODE
#define N_LAUNCH_MODE 1
#endif

constexpr int DM = 1024, NLAT = 65536, NCTX = 2048, MTOT = NLAT + NCTX, SEQ = 8192, CTXL = 256, FF = 2816;
constexpr int EV_N = 3600, EV_NP = 3840, OD_N = 3072;
constexpr int NCHUNKP = 64 * 132;
constexpr int NTHREADS = 512;
constexpr int LDS_BYTES = 135168 + 16;

constexpr size_t al256(size_t x) { return (x + 255) / 256 * 256; }
constexpr size_t WS_W_EVIN = 0;
constexpr size_t WS_W_EVOUT = WS_W_EVIN + al256((size_t)EV_NP * DM * 2);
constexpr size_t WS_W_ODIN = WS_W_EVOUT + al256((size_t)DM * DM * 2);
constexpr size_t WS_W_ODOUT = WS_W_ODIN + al256((size_t)OD_N * DM * 2);
constexpr size_t WS_W_FFIN = WS_W_ODOUT + al256((size_t)DM * DM * 2);
constexpr size_t WS_W_FFOUT = WS_W_FFIN + al256((size_t)2 * 2 * FF * DM * 2);
constexpr size_t WS_MOD = WS_W_FFOUT + al256((size_t)2 * DM * FF * 2);
constexpr size_t WS_H = WS_MOD + al256((size_t)2 * 9 * 6144 * 4);
constexpr size_t WS_PROJ = WS_H + al256((size_t)MTOT * DM * 2);
constexpr size_t WS_MIX = WS_PROJ + al256((size_t)MTOT * EV_NP * 2);
constexpr size_t WS_T = WS_MIX + al256((size_t)MTOT * DM * 2);
constexpr size_t WS_AQK = WS_T + al256((size_t)NCHUNKP * 4096 * 2);
constexpr size_t WS_GV = WS_AQK + al256((size_t)NCHUNKP * 4096 * 2);
constexpr size_t WS_BV = WS_GV + al256((size_t)NCHUNKP * 64 * 4);
constexpr size_t WS_EL = WS_BV + al256((size_t)NCHUNKP * 64 * 4);
constexpr size_t WS_GATES = WS_EL + al256((size_t)NCHUNKP * 64 * 4);
constexpr size_t WS_CTXRES = WS_GATES + al256((size_t)MTOT * 16 * 4);
constexpr size_t WS_BAR = WS_CTXRES + al256((size_t)NCTX * DM * 4);
constexpr size_t WS_ROPE = WS_BAR + 16384;
constexpr size_t WS_END = WS_ROPE + (size_t)2 * SEQ * 32 * 4;

struct Params {
    const float *x, *c, *ctx, *c_ctx, *ada_w, *ada_b, *norm_mix, *norm_ffn, *ffn_w_in, *ffn_w_out, *even_w_in, *even_w_out,
        *diff_qk_gain, *diff_lambda, *diff_subln, *gdn_conv, *gdn_a_log, *gdn_dt_bias, *gdn_norm, *odd_w_in, *odd_w_out, *na_qk_gain, *na_rpb;
    float* out; unsigned char* ws; int ph_lo, ph_hi;
};

__device__ __forceinline__ float bf2f(bf16_t b) { return __uint_as_float(((unsigned)b) << 16); }
__device__ __forceinline__ bf16_t f2bf(float f) { unsigned u = __float_as_uint(f); u += 0x7FFFu + ((u >> 16) & 1u); return (bf16_t)(u >> 16); }
__device__ __forceinline__ unsigned cvtpk(float lo, float hi) { unsigned r; asm volatile("v_cvt_pk_bf16_f32 %0, %1, %2" : "=v"(r) : "v"(lo), "v"(hi)); return r; }
__device__ __forceinline__ float siluf(float v) { return v / (1.f + __expf(-v)); }
__device__ __forceinline__ void unpack8(bf16x8 v, float* f) {
#pragma unroll
    for (int i = 0; i < 8; ++i) f[i] = bf2f((bf16_t)v[i]);
}
__device__ __forceinline__ bf16x8 pack8(const float* f) {
    u32x4 w = {cvtpk(f[0], f[1]), cvtpk(f[2], f[3]), cvtpk(f[4], f[5]), cvtpk(f[6], f[7])};
    return *reinterpret_cast<bf16x8*>(&w);
}

namespace pg8 {
constexpr int BM = 256, BK = 64, HALF = 128, HTB = HALF * BK * 2, STAGE_BYTES = 8 * HTB, NXCD = 8, WGM = 8;
__host__ __device__ __forceinline__ int lds_byte(int r, int c) { const int st = (r >> 4) * 2 + (c >> 5), rr = r & 15, cc = c & 31, ob = rr * 64 + cc * 2; return st * 1024 + (ob ^ (((ob >> 9) & 1) << 5)); }
__host__ __device__ __forceinline__ void stage_rc(int b, int& R, int& C) { const int st = b / 1024, sb = b % 1024, swz = sb ^ (((sb >> 9) & 1) << 5); R = (st >> 1) * 16 + swz / 64; C = (st & 1) * 32 + (swz % 64) / 2; }
__host__ __device__ __forceinline__ int perm32(int rho) { const int n = rho >> 4, i = rho & 15; return 8 * (i >> 2) + 4 * n + (i & 3); }
struct Unit { int pm, pn; };
struct Gemm { const bf16_t* A; const bf16_t* Bt; int M, N, K; };
template <int NM, int NN> struct StaticOrderT {
    static_assert(NM % WGM == 0, "row tiles in whole groups");
    int G, c;
    __device__ void init(int, int, int G_, int c_) { G = G_; c = c_; }
    __device__ bool next(int i, Unit& u) const {
        constexpr int nwg = NM * NN, q = nwg / NXCD, r = nwg % NXCD, nig = WGM * NN;
        const int L = i * G + c; if (L >= nwg) return false;
        const int xcd = L % NXCD, off = L / NXCD;
        const int wgid = (xcd < r ? xcd * (q + 1) : r * (q + 1) + (xcd - r) * q) + off;
        const int gid = wgid / nig, w = wgid % nig;
        u.pm = gid * WGM + (w % WGM); u.pn = w / WGM; return true;
    }
};
struct EpiBf16 {
    static constexpr bool PERM = true;
    bf16_t* O; int ldc;
    __device__ __forceinline__ void operator()(const f32x4 (&acc)[2][2][4][2], const Unit& u, int wr, int wc, int fr, int fq) const {
        const int row0 = u.pm * BM + wr * 64 + fr; const int col0 = u.pn * BM + wc * 32 + 8 * fq;
#pragma unroll
        for (int ai = 0; ai < 2; ++ai)
#pragma unroll
            for (int m = 0; m < 4; ++m) { bf16_t* rowp = O + (size_t)(row0 + ai * HALF + m * 16) * ldc + col0;
#pragma unroll
                for (int bj = 0; bj < 2; ++bj) { const f32x4 v0 = acc[ai][bj][m][0], v1 = acc[ai][bj][m][1];
                    u32x4 w; w.x = cvtpk(v0[0], v0[1]); w.y = cvtpk(v0[2], v0[3]); w.z = cvtpk(v1[0], v1[1]); w.w = cvtpk(v1[2], v1[3]);
                    *(u32x4*)(rowp + bj * HALF) = w; } }
    }
};
struct EpiSwiglu {
    static constexpr bool PERM = true;
    bf16_t* O; int ldc;
    __device__ __forceinline__ void operator()(const f32x4 (&acc)[2][2][4][2], const Unit& u, int wr, int wc, int fr, int fq) const {
        const int row0 = u.pm * BM + wr * 64 + fr; const int col0 = u.pn * HALF + wc * 32 + 8 * fq;
#pragma unroll
        for (int ai = 0; ai < 2; ++ai)
#pragma unroll
            for (int m = 0; m < 4; ++m) { bf16_t* rowp = O + (size_t)(row0 + ai * HALF + m * 16) * ldc + col0;
                float o[8];
#pragma unroll
                for (int n = 0; n < 2; ++n)
#pragma unroll
                    for (int j = 0; j < 4; ++j) { const float g = acc[ai][0][m][n][j], up = acc[ai][1][m][n][j]; o[n * 4 + j] = g * __builtin_amdgcn_rcpf(1.f + __expf(-g)) * up; }
                u32x4 w; w.x = cvtpk(o[0], o[1]); w.y = cvtpk(o[2], o[3]); w.z = cvtpk(o[4], o[5]); w.w = cvtpk(o[6], o[7]);
                *(u32x4*)rowp = w; }
    }
};
struct EpiResid {
    static constexpr bool PERM = false;
    const float* resLat; const float* resCtx; float* outLat; float* outCtx; const float* modl; int goff;
    __device__ __forceinline__ void operator()(const f32x4 (&acc)[2][2][4][2], const Unit& u, int wr, int wc, int fr, int fq) const {
        const int rowt = u.pm * BM; const bool lat = rowt < NLAT;
        const float* res = lat ? resLat + (size_t)rowt * DM : resCtx + (size_t)(rowt - NLAT) * DM;
        float* out = lat ? outLat + (size_t)rowt * DM : outCtx + (size_t)(rowt - NLAT) * DM;
        const float* gate = modl + (size_t)(lat ? (rowt >> 13) : 8) * 6144 + goff;
        const int row0 = wr * 64 + fr, col0 = u.pn * BM + wc * 32 + 4 * fq;
        f32x4 gv[2][2];
#pragma unroll
        for (int bj = 0; bj < 2; ++bj)
#pragma unroll
            for (int n = 0; n < 2; ++n) gv[bj][n] = *(const f32x4*)(gate + col0 + bj * HALF + n * 16);
#pragma unroll
        for (int ai = 0; ai < 2; ++ai)
#pragma unroll
            for (int mp = 0; mp < 4; mp += 2) {
                f32x4 r[2][2][2];
#pragma unroll
                for (int mm = 0; mm < 2; ++mm)
#pragma unroll
                    for (int bj = 0; bj < 2; ++bj)
#pragma unroll
                        for (int n = 0; n < 2; ++n) r[mm][bj][n] = *(const f32x4*)(res + (size_t)(row0 + ai * HALF + (mp + mm) * 16) * DM + col0 + bj * HALF + n * 16);
#pragma unroll
                for (int mm = 0; mm < 2; ++mm)
#pragma unroll
                    for (int bj = 0; bj < 2; ++bj)
#pragma unroll
                        for (int n = 0; n < 2; ++n) *(f32x4*)(out + (size_t)(row0 + ai * HALF + (mp + mm) * 16) * DM + col0 + bj * HALF + n * 16) = r[mm][bj][n] + gv[bj][n] * acc[ai][bj][mp + mm][n];
            }
    }
};

template <class Epi, class Sched>
__device__ __forceinline__ void gemm_phase(LAS unsigned char* lds, const Gemm g, const Sched& S, const Epi& E) {
    const int tid = threadIdx.x, wid = __builtin_amdgcn_readfirstlane(tid >> 6), lane = tid & 63, wr = wid >> 2, wc = wid & 3, fr = lane & 15, fq = lane >> 4;
    const int K = g.K, nt = K / BK;
    unsigned voffA[2], voffB[2];
#pragma unroll
    for (int i = 0; i < 2; ++i) { int R, C; stage_rc(tid * 16 + i * 8192, R, C); const int Rb = Epi::PERM ? ((R & ~31) + perm32(R & 31)) : R;
        voffA[i] = (unsigned)(R * K + C) * 2u; voffB[i] = (unsigned)(Rb * K + C) * 2u; }
    const size_t kstep = (size_t)(BK * 2);
    const size_t hstep = (size_t)HALF * K * 2;
    const size_t tstep = 2 * hstep;
    const unsigned ldsw = (unsigned)wid * 1024u;
    const int aoff = lds_byte(wr * 64 + fr, fq * 8), boff = lds_byte(wc * 32 + fr, fq * 8);
#define PG8_SA(b, h) (((b) * 2 + (h)) * HTB)
#define PG8_SB(b, h) ((4 + (b) * 2 + (h)) * HTB)
#define PG8_STAGE(bufoff, gbase, voff) do { _Pragma("unroll") for (int _i = 0; _i < 2; ++_i) \
        __builtin_amdgcn_global_load_lds((const unsigned*)((const char*)(gbase) + (voff)[_i]), (LAS unsigned*)(lds + (bufoff) + ldsw + _i * 8192), 16, 0, 0); } while (0)
#define PG8_LDA(dst, b, h) do { _Pragma("unroll") for (int m = 0; m < 4; ++m) _Pragma("unroll") for (int k = 0; k < 2; ++k) dst[m][k] = *(const LAS bf16x8*)(lds + PG8_SA(b, h) + aoff + m * 2048 + k * 1024); } while (0)
#define PG8_LDB(dst, b, h) do { _Pragma("unroll") for (int n = 0; n < 2; ++n) _Pragma("unroll") for (int k = 0; k < 2; ++k) dst[n][k] = *(const LAS bf16x8*)(lds + PG8_SB(b, h) + boff + n * 2048 + k * 1024); } while (0)
#define PG8_MMA(ai, bj, At, Bt) do { __builtin_amdgcn_s_setprio(1); _Pragma("unroll") for (int m = 0; m < 4; ++m) _Pragma("unroll") for (int n = 0; n < 2; ++n) _Pragma("unroll") for (int k = 0; k < 2; ++k) \
        acc[ai][bj][m][n] = __builtin_amdgcn_mfma_f32_16x16x32_bf16(Bt[n][k], At[m][k], acc[ai][bj][m][n], 0, 0, 0); __builtin_amdgcn_s_setprio(0); } while (0)
#define PG8_WAIT_V(n) asm volatile("s_waitcnt vmcnt(" #n ")" ::: "memory")
#define PG8_WAIT_L(n) asm volatile("s_waitcnt lgkmcnt(" #n ")" ::: "memory")
#define PG8_BAR __builtin_amdgcn_s_barrier()
#define PG8_SCHED __builtin_amdgcn_sched_barrier(0)
    Unit cur, nxt; int ui = 0;
    if (!S.next(0, cur)) return;
    f32x4 acc[2][2][4][2];
#pragma unroll
    for (int a = 0; a < 2; ++a)
#pragma unroll
        for (int b = 0; b < 2; ++b)
#pragma unroll
            for (int m = 0; m < 4; ++m)
#pragma unroll
                for (int n = 0; n < 2; ++n) acc[a][b][m][n] = (f32x4){0.f, 0.f, 0.f, 0.f};
    bf16x8 At[4][2], B0[2][2], B1[2][2];
    const char* cA = (const char*)g.A + (size_t)cur.pm * tstep; const char* cB = (const char*)g.Bt + (size_t)cur.pn * tstep;
    PG8_STAGE(PG8_SB(0, 0), cB, voffB); PG8_STAGE(PG8_SA(0, 0), cA, voffA); PG8_STAGE(PG8_SB(0, 1), cB + hstep, voffB); PG8_STAGE(PG8_SA(0, 1), cA + hstep, voffA);
    if (wr == 1) PG8_BAR;
    PG8_WAIT_V(4); PG8_BAR;
    PG8_STAGE(PG8_SB(1, 0), cB + kstep, voffB); PG8_STAGE(PG8_SA(1, 0), cA + kstep, voffA); PG8_STAGE(PG8_SB(1, 1), cB + hstep + kstep, voffB);
    PG8_WAIT_V(6); PG8_BAR;
    for (;;) {
        const bool has_next = S.next(ui + 1, nxt);
        const char* nA = has_next ? (const char*)g.A + (size_t)nxt.pm * tstep : cA; const char* nB = has_next ? (const char*)g.Bt + (size_t)nxt.pn * tstep : cB;
        for (int t = 0; t < nt; t += 2) {
            const bool last = (t == nt - 2);
            const char* a1 = cA + (size_t)(t + 1) * kstep;
            const char* a2 = last ? nA : cA + (size_t)(t + 2) * kstep; const char* b2 = last ? nB : cB + (size_t)(t + 2) * kstep;
            const char* a3 = a2 + kstep; const char* b3 = b2 + kstep;
            PG8_LDB(B0, 0, 0); PG8_SCHED; PG8_LDA(At, 0, 0); PG8_STAGE(PG8_SA(1, 1), a1 + hstep, voffA);
            PG8_WAIT_L(8); PG8_BAR; PG8_WAIT_L(0); PG8_MMA(0, 0, At, B0); PG8_BAR; PG8_SCHED;
            PG8_LDB(B1, 0, 1); PG8_STAGE(PG8_SB(0, 0), b2, voffB);
            PG8_BAR; PG8_WAIT_L(0); PG8_MMA(0, 1, At, B1); PG8_BAR;
            PG8_LDA(At, 0, 1); PG8_STAGE(PG8_SA(0, 0), a2, voffA);
            PG8_BAR; PG8_WAIT_L(0); PG8_MMA(1, 0, At, B0); PG8_BAR; PG8_SCHED;
            PG8_STAGE(PG8_SB(0, 1), b2 + hstep, voffB);
            PG8_WAIT_V(6); PG8_BAR; PG8_MMA(1, 1, At, B1); PG8_BAR;
            PG8_LDB(B0, 1, 0); PG8_SCHED; PG8_LDA(At, 1, 0); PG8_STAGE(PG8_SA(0, 1), a2 + hstep, voffA);
            PG8_WAIT_L(8); PG8_BAR; PG8_WAIT_L(0); PG8_MMA(0, 0, At, B0); PG8_BAR; PG8_SCHED;
            PG8_LDB(B1, 1, 1); PG8_STAGE(PG8_SB(1, 0), b3, voffB);
            PG8_BAR; PG8_WAIT_L(0); PG8_MMA(0, 1, At, B1); PG8_BAR;
            PG8_LDA(At, 1, 1); PG8_STAGE(PG8_SA(1, 0), a3, voffA);
            PG8_BAR; PG8_WAIT_L(0); PG8_MMA(1, 0, At, B0); PG8_BAR; PG8_SCHED;
            PG8_STAGE(PG8_SB(1, 1), b3 + hstep, voffB);
            PG8_WAIT_V(6); PG8_BAR; PG8_MMA(1, 1, At, B1); PG8_BAR;
        }
        E(acc, cur, wr, wc, fr, fq);
        if (!has_next) break;
#pragma unroll
        for (int a = 0; a < 2; ++a)
#pragma unroll
            for (int b = 0; b < 2; ++b)
#pragma unroll
                for (int m = 0; m < 4; ++m)
#pragma unroll
                    for (int n = 0; n < 2; ++n) acc[a][b][m][n] = (f32x4){0.f, 0.f, 0.f, 0.f};
        cur = nxt; cA = nA; cB = nB; ++ui;
    }
    PG8_WAIT_V(0);
    if (wr == 0) PG8_BAR;
    PG8_BAR;
#undef PG8_SA
#undef PG8_SB
#undef PG8_STAGE
#undef PG8_LDA
#undef PG8_LDB
#undef PG8_MMA
#undef PG8_WAIT_V
#undef PG8_WAIT_L
#undef PG8_BAR
#undef PG8_SCHED
}
}

#define KSWZ(row, colB) ((row) * 256 + ((colB) ^ (((row) & 7) << 4)))
#define SBAR() __builtin_amdgcn_sched_barrier(0)
__device__ __forceinline__ int crow(int r, int hi) { return (r & 3) + 8 * (r >> 2) + 4 * hi; }
__device__ __forceinline__ int v_st(int k, int c) { const int kk = (k & ~0xC) | ((k & 4) << 1) | ((k & 8) >> 1); return ((kk >> 3) * 4 + (c >> 5)) * 512 + ((kk & 7) * 32 + (c & 31)) * 2; }
__device__ __forceinline__ int v_rd_base(int lane) { return ((lane & 3) << 3) | (((lane >> 2) & 3) << 6) | (((lane >> 4) & 1) << 5) | (((lane >> 5) & 1) << 8); }
constexpr int v_rd_off(int d0, int ks, int half) { return d0 * 512 + ks * 4096 + half * 2048; }
template <int OFF> __device__ __forceinline__ s16x4 tr_read(int vb) {
    s16x4 r; asm volatile("ds_read_b64_tr_b16 %0, %1 offset:%2" : "=&v"(r) : "v"(vb), "i"(OFF) : "memory"); return r;
}
template <int D0> __device__ __forceinline__ void pv_one(f32x16& od, int vb, bf16x8 pa0, bf16x8 pa1, bf16x8 pa2, bf16x8 pa3) {
    const s16x4 l0 = tr_read<v_rd_off(D0, 0, 0)>(vb), h0 = tr_read<v_rd_off(D0, 0, 1)>(vb), l1 = tr_read<v_rd_off(D0, 1, 0)>(vb), h1 = tr_read<v_rd_off(D0, 1, 1)>(vb);
    const s16x4 l2 = tr_read<v_rd_off(D0, 2, 0)>(vb), h2 = tr_read<v_rd_off(D0, 2, 1)>(vb), l3 = tr_read<v_rd_off(D0, 3, 0)>(vb), h3 = tr_read<v_rd_off(D0, 3, 1)>(vb);
    asm volatile("s_waitcnt lgkmcnt(0)" ::: "memory"); SBAR();
#define PK(L, H) (bf16x8){L[0], L[1], L[2], L[3], H[0], H[1], H[2], H[3]}
    od = __builtin_amdgcn_mfma_f32_32x32x16_bf16(pa0, PK(l0, h0), od, 0, 0, 0);
    od = __builtin_amdgcn_mfma_f32_32x32x16_bf16(pa1, PK(l1, h1), od, 0, 0, 0);
    od = __builtin_amdgcn_mfma_f32_32x32x16_bf16(pa2, PK(l2, h2), od, 0, 0, 0);
    od = __builtin_amdgcn_mfma_f32_32x32x16_bf16(pa3, PK(l3, h3), od, 0, 0, 0);
#undef PK
}
__device__ __forceinline__ void pv_d0(f32x16* o, int vb, bf16x8 pa0, bf16x8 pa1, bf16x8 pa2, bf16x8 pa3) {
    pv_one<0>(o[0], vb, pa0, pa1, pa2, pa3); pv_one<1>(o[1], vb, pa0, pa1, pa2, pa3); pv_one<2>(o[2], vb, pa0, pa1, pa2, pa3); pv_one<3>(o[3], vb, pa0, pa1, pa2, pa3);
}
#define PK4(P, BASE, OUT) do { unsigned a0 = cvtpk(P[BASE + 0], P[BASE + 1]), a1 = cvtpk(P[BASE + 2], P[BASE + 3]);   \
    unsigned b0 = cvtpk(P[BASE + 4], P[BASE + 5]), b1 = cvtpk(P[BASE + 6], P[BASE + 7]);                              \
    auto r0 = __builtin_amdgcn_permlane32_swap(a0, b0, false, false); auto r1 = __builtin_amdgcn_permlane32_swap(a1, b1, false, false); \
    u32x4 w = {r0[0], r1[0], r0[1], r1[1]}; OUT = *reinterpret_cast<bf16x8*>(&w); } while (0)
__device__ __forceinline__ float halfswap_add(float v) {
    auto rr = __builtin_amdgcn_permlane32_swap(__float_as_uint(v), __float_as_uint(v), false, false);
    return __uint_as_float(rr[0]) + __uint_as_float(rr[1]);
}

__device__ __forceinline__ void ada_phase(const Params& p, unsigned char* lds) {
    float* sc = (float*)lds;
    float* red = (float*)(lds + 40960);
    float* mod = (float*)(p.ws + WS_MOD);
    const int tid = threadIdx.x;
    for (int j = blockIdx.x; j < 192; j += gridDim.x) {
        const int l = j / 96, n0 = (j % 96) * 64;
        for (int i = tid; i < 9 * 1024; i += NTHREADS) { const int r = i >> 10, k = i & 1023; const float v = r < 8 ? p.c[r * 1024 + k] : p.c_ctx[k]; sc[i] = v / (1.f + expf(-v)); }
        __syncthreads();
        const int col = tid & 63, ks = tid >> 6;
        float acc[9];
#pragma unroll
        for (int r = 0; r < 9; ++r) acc[r] = 0.f;
        const float* wp = p.ada_w + ((size_t)l * 1024 + ks * 128) * 6144 + n0 + col;
#pragma unroll 8
        for (int kk = 0; kk < 128; ++kk) { const float w = wp[(size_t)kk * 6144];
#pragma unroll
            for (int r = 0; r < 9; ++r) acc[r] += sc[r * 1024 + ks * 128 + kk] * w; }
#pragma unroll
        for (int r = 0; r < 9; ++r) red[(ks * 9 + r) * 64 + col] = acc[r];
        __syncthreads();
        for (int i = tid; i < 576; i += NTHREADS) { const int r = i >> 6, cc = i & 63; float s = p.ada_b[l * 6144 + n0 + cc];
            for (int k2 = 0; k2 < 8; ++k2) s += red[(k2 * 9 + r) * 64 + cc];
            mod[(size_t)(l * 9 + r) * 6144 + n0 + cc] = s; }
        __syncthreads();
    }
}
__device__ __forceinline__ void wconv_phase(const Params& p, unsigned char* lds) {
    float* tl = (float*)lds;
    const int tid = threadIdx.x;
    const int T0 = 16 * 60, T1 = T0 + 16 * 16, T2 = T1 + 16 * 48, T3 = T2 + 16 * 16, T4 = T3 + 16 * 88, T5 = T4 + 16 * 88, T6 = T5 + 44 * 16, T7 = T6 + 44 * 16;
#define WC_DECODE(t) \
        const float* src; bf16_t* dst; int K, N, NP, mode = 0, tt; \
        if ((t) < T0) { src = p.even_w_in; dst = (bf16_t*)(p.ws + WS_W_EVIN); K = 1024; N = EV_N; NP = EV_NP; tt = (t); } \
        else if ((t) < T1) { src = p.even_w_out; dst = (bf16_t*)(p.ws + WS_W_EVOUT); K = 1024; N = 1024; NP = 1024; tt = (t) - T0; } \
        else if ((t) < T2) { src = p.odd_w_in; dst = (bf16_t*)(p.ws + WS_W_ODIN); K = 1024; N = OD_N; NP = OD_N; tt = (t) - T1; } \
        else if ((t) < T3) { src = p.odd_w_out; dst = (bf16_t*)(p.ws + WS_W_ODOUT); K = 1024; N = 1024; NP = 1024; tt = (t) - T2; } \
        else if ((t) < T4) { src = p.ffn_w_in; dst = (bf16_t*)(p.ws + WS_W_FFIN); K = 1024; N = 2 * FF; NP = 2 * FF; mode = 1; tt = (t) - T3; } \
        else if ((t) < T5) { src = p.ffn_w_in + (size_t)1024 * 2 * FF; dst = (bf16_t*)(p.ws + WS_W_FFIN) + (size_t)2 * FF * 1024; K = 1024; N = 2 * FF; NP = 2 * FF; mode = 1; tt = (t) - T4; } \
        else if ((t) < T6) { src = p.ffn_w_out; dst = (bf16_t*)(p.ws + WS_W_FFOUT); K = FF; N = 1024; NP = 1024; tt = (t) - T5; } \
        else { src = p.ffn_w_out + (size_t)FF * 1024; dst = (bf16_t*)(p.ws + WS_W_FFOUT) + (size_t)1024 * FF; K = FF; N = 1024; NP = 1024; tt = (t) - T6; } \
        const int nnt = NP / 64; const int k0 = (tt / nnt) * 64, n0 = (tt % nnt) * 64; \
        int sn0; if (mode == 1) { const int tb = n0 >> 8, bj = (n0 >> 7) & 1, i0 = n0 & 127; sn0 = bj * FF + tb * 128 + i0; } else sn0 = n0;
    float rg[8];
#define WC_LOAD(t) do { WC_DECODE(t) (void)dst; _Pragma("unroll") for (int i = 0; i < 8; ++i) { const int e = tid + NTHREADS * i, kk = e >> 6, nn = e & 63; const int sn = sn0 + nn; \
        rg[i] = (sn < N) ? src[(size_t)(k0 + kk) * N + sn] : 0.f; } } while (0)
    int t = blockIdx.x;
    if (t < T7) WC_LOAD(t);
    for (; t < T7; t += gridDim.x) {
#pragma unroll
        for (int i = 0; i < 8; ++i) { const int e = tid + NTHREADS * i; tl[(e >> 6) * 65 + (e & 63)] = rg[i]; }
        __syncthreads();
        { WC_DECODE(t) (void)src; (void)N; (void)sn0;
          if (t + (int)gridDim.x < T7) WC_LOAD(t + (int)gridDim.x);
          for (int e = tid; e < 2048; e += NTHREADS) { const int nn = e >> 5, k2 = (e & 31) * 2;
              *(unsigned*)(dst + (size_t)(n0 + nn) * K + k0 + k2) = cvtpk(tl[k2 * 65 + nn], tl[(k2 + 1) * 65 + nn]); } }
        __syncthreads();
    }
#undef WC_DECODE
#undef WC_LOAD
}

__device__ __forceinline__ void norm_phase(const Params& p, const float* xlat, const float* xctx, int l, int which, int nrows) {
    const int lane = threadIdx.x & 63, wid = threadIdx.x >> 6;
    bf16_t* h = (bf16_t*)(p.ws + WS_H);
    const float* mod = (const float*)(p.ws + WS_MOD) + (size_t)l * 9 * 6144;
    const float* gain = (which ? p.norm_ffn : p.norm_mix) + l * 1024;
    const int shoff = which ? 3072 : 0, scoff = which ? 4096 : 1024;
    const int stride = gridDim.x * 8;
    for (int row = blockIdx.x * 8 + wid; row < nrows; row += 2 * stride) {
        const int rowB = row + stride; const bool hasB = rowB < nrows;
        const float* srcA = row < NLAT ? xlat + (size_t)row * DM : xctx + (size_t)(row - NLAT) * DM;
        const float* srcB = hasB ? (rowB < NLAT ? xlat + (size_t)rowB * DM : xctx + (size_t)(rowB - NLAT) * DM) : srcA;
        f32x4 va[4], vb[4];
#pragma unroll
        for (int i = 0; i < 4; ++i) { va[i] = *(const f32x4*)(srcA + lane * 4 + 256 * i); vb[i] = *(const f32x4*)(srcB + lane * 4 + 256 * i); }
#pragma unroll
        for (int rr = 0; rr < 2; ++rr) {
            if (rr == 1 && !hasB) break;
            const int r = rr ? rowB : row;
            const float* mr = mod + (size_t)(r < NLAT ? (r >> 13) : 8) * 6144;
            float ss = 0.f;
#pragma unroll
            for (int i = 0; i < 4; ++i) { const f32x4 v = rr ? vb[i] : va[i]; ss += v[0] * v[0] + v[1] * v[1] + v[2] * v[2] + v[3] * v[3]; }
#pragma unroll
            for (int o = 1; o < 64; o <<= 1) ss += __shfl_xor(ss, o);
            const float rstd = rsqrtf(ss * (1.f / 1024.f) + 1e-6f);
#pragma unroll
            for (int i = 0; i < 4; ++i) { const int c0 = lane * 4 + 256 * i; const f32x4 v = rr ? vb[i] : va[i];
                const f32x4 g = *(const f32x4*)(gain + c0), s1 = *(const f32x4*)(mr + scoff + c0), sh = *(const f32x4*)(mr + shoff + c0);
                float y[4];
#pragma unroll
                for (int j = 0; j < 4; ++j) y[j] = v[j] * rstd * g[j] * (1.f + s1[j]) + sh[j];
                u32x2 w; w.x = cvtpk(y[0], y[1]); w.y = cvtpk(y[2], y[3]);
                *(u32x2*)(h + (size_t)r * DM + c0) = w; }
        }
    }
}

__device__ __forceinline__ void prep0_phase(const Params& p) {
    const int lane0 = threadIdx.x & 63, wid = threadIdx.x >> 6;
    bf16_t* proj = (bf16_t*)(p.ws + WS_PROJ);
    bf16_t* qkvp = (bf16_t*)p.out;
    float* gbuf = (float*)(p.ws + WS_GATES);
    const float* ropec = (const float*)(p.ws + WS_ROPE); const float* ropes = ropec + SEQ * 32;
    constexpr int RB = 8;
    for (int blk = blockIdx.x * 8 + wid; blk < MTOT / RB; blk += gridDim.x * 8) {
        int lane = lane0; asm volatile("" : "+v"(lane));
        const int row0 = blk * RB; const bool lat = row0 < NLAT; const int t0 = lat ? (row0 & 8191) : ((row0 - NLAT) & 255); const int len = lat ? SEQ : CTXL;
        const int dsub = (lane & 7) * 8;
        {
            float gq[8], gk[8];
#pragma unroll
            for (int i = 0; i < 8; ++i) { gq[i] = p.diff_qk_gain[dsub + i] * (0.125f * 1.4426950408889634f); gk[i] = p.diff_qk_gain[64 + dsub + i]; }
#pragma unroll
            for (int i0 = 0; i0 < RB; i0 += 4) {
                bf16x8 raw[4][2]; f32x4 c4[4], s4[4];
#pragma unroll
                for (int i = 0; i < 4; ++i) { const bf16_t* P = proj + (size_t)(row0 + i0 + i) * EV_NP;
                    raw[i][0] = *(const bf16x8*)(P + lane * 8); raw[i][1] = *(const bf16x8*)(P + 512 + lane * 8);
                    c4[i] = (f32x4){1.f, 1.f, 1.f, 1.f}; s4[i] = (f32x4){0.f, 0.f, 0.f, 0.f};
                    if (lat) { c4[i] = *(const f32x4*)(ropec + (t0 + i0 + i) * 32 + (lane & 7) * 4); s4[i] = *(const f32x4*)(ropes + (t0 + i0 + i) * 32 + (lane & 7) * 4); } }
#pragma unroll
                for (int i = 0; i < 4; ++i) { bf16_t* P = proj + (size_t)(row0 + i0 + i) * EV_NP;
#pragma unroll
                    for (int which = 0; which < 2; ++which) {
                        float v[8]; unpack8(raw[i][which], v);
                        float ss = 0.f;
#pragma unroll
                        for (int e = 0; e < 8; ++e) ss += v[e] * v[e];
                        ss += __shfl_xor(ss, 1); ss += __shfl_xor(ss, 2); ss += __shfl_xor(ss, 4);
                        const float rstd = rsqrtf(ss * (1.f / 64.f) + 1e-6f);
#pragma unroll
                        for (int e = 0; e < 8; ++e) v[e] = v[e] * rstd * (which ? gk[e] : gq[e]);
#pragma unroll
                        for (int e = 0; e < 4; ++e) { const float x0 = v[2 * e], x1 = v[2 * e + 1]; v[2 * e] = x0 * c4[i][e] - x1 * s4[i][e]; v[2 * e + 1] = x0 * s4[i][e] + x1 * c4[i][e]; }
                        *(bf16x8*)(P + which * 512 + lane * 8) = pack8(v);
                    } }
            }
        }
#pragma unroll 1
        for (int g = 0; g < 3; ++g) {
            const int c0 = g * 512 + lane * 8;
            float w[5][8];
#pragma unroll
            for (int j = 0; j < 5; ++j) { const f32x4 w0 = *(const f32x4*)(p.gdn_conv + j * 1536 + c0), w1 = *(const f32x4*)(p.gdn_conv + j * 1536 + c0 + 4);
#pragma unroll
                for (int e = 0; e < 4; ++e) { w[j][e] = w0[e]; w[j][4 + e] = w1[e]; } }
            const bf16_t* src = proj + (size_t)row0 * EV_NP + 1536 + c0;
            bf16x8 raw[RB + 4];
#pragma unroll
            for (int k = 0; k < RB + 4; ++k) { const int dt = k - 2; raw[k] = (bf16x8){0, 0, 0, 0, 0, 0, 0, 0};
                if (t0 + dt >= 0 && t0 + dt < len) raw[k] = *(const bf16x8*)(src + (ptrdiff_t)dt * EV_NP); }
            const float nsc = g == 0 ? 0.08838834764831845f : 1.f;
#pragma unroll
            for (int i = 0; i < RB; ++i) {
                float xm2[8], xm1[8], x0[8], xp1[8], xp2[8];
                unpack8(raw[i], xm2); unpack8(raw[i + 1], xm1); unpack8(raw[i + 2], x0); unpack8(raw[i + 3], xp1); unpack8(raw[i + 4], xp2);
                float y[8];
#pragma unroll
                for (int e = 0; e < 8; ++e) { y[e] = w[0][e] * xm2[e] + w[1][e] * xm1[e] + w[2][e] * x0[e] + w[3][e] * xp1[e] + w[4][e] * xp2[e]; y[e] = y[e] * __builtin_amdgcn_rcpf(1.f + __expf(-y[e])); }
                if (g < 2) { float ss = 0.f;
#pragma unroll
                    for (int e = 0; e < 8; ++e) ss += y[e] * y[e];
                    ss += __shfl_xor(ss, 1); ss += __shfl_xor(ss, 2); ss += __shfl_xor(ss, 4); ss += __shfl_xor(ss, 8);
                    const float sc_ = rsqrtf(ss + 1e-6f) * nsc;
#pragma unroll
                    for (int e = 0; e < 8; ++e) y[e] *= sc_; }
                *(bf16x8*)(qkvp + (size_t)(row0 + i) * 1536 + c0) = pack8(y);
            }
        }
#pragma unroll
        for (int k = 0; k < RB / 4; ++k) { const int idx = lane + 64 * k, i = idx >> 4, gi = idx & 15;
            const float gvv = bf2f(proj[(size_t)(row0 + i) * EV_NP + 3584 + gi]); float o;
            if (gi < 8) o = 1.f / (1.f + expf(-gvv));
            else { const float z = gvv + p.gdn_dt_bias[gi - 8]; const float sp = z > 20.f ? z : log1pf(expf(z)); o = -expf(p.gdn_a_log[gi - 8]) * sp; }
            gbuf[(size_t)(row0 + i) * 16 + gi] = o; }
    }
}

__device__ __forceinline__ int gdn_row(int b, int pc, int tau, int dir) {
    const int tt = dir ? 63 - tau : tau;
    return pc < 4 ? NLAT + b * CTXL + pc * 64 + tt : b * SEQ + (pc - 4) * 64 + tt;
}
__device__ __forceinline__ void gdn_pre_phase(const Params& p, unsigned char* lds) {
    const int lane = threadIdx.x & 63, wid = threadIdx.x >> 6;
    float* Lw = (float*)(lds + wid * 16896);
    float* gs = Lw + 4096; float* bs = gs + 64;
    const bf16_t* qkvp = (const bf16_t*)p.out;
    const float* gbuf = (const float*)(p.ws + WS_GATES);
    bf16_t* Tb = (bf16_t*)(p.ws + WS_T); bf16_t* Ab = (bf16_t*)(p.ws + WS_AQK);
    float* gv = (float*)(p.ws + WS_GV); float* bv = (float*)(p.ws + WS_BV);
    const int lane0 = lane;
    for (int cp = blockIdx.x * 8 + wid; cp < NCHUNKP; cp += gridDim.x * 8) {
        int lane = lane0; asm volatile("" : "+v"(lane));
        const int r32 = lane & 31, hi = lane >> 5;
        const int pc = cp % 132, ch = cp / 132, dir = ch & 1, h = (ch >> 1) & 3, b = ch >> 3;
        { const int R = gdn_row(b, pc, lane, dir);
          float g = gbuf[(size_t)R * 16 + 8 + dir * 4 + h]; const float be = gbuf[(size_t)R * 16 + dir * 4 + h];
#pragma unroll
          for (int o = 1; o < 64; o <<= 1) { const float t = __shfl_up(g, o); if (lane >= o) g += t; }
          gs[lane] = g; bs[lane] = be; const float gl_ = __shfl(g, 63); gv[(size_t)cp * 64 + lane] = expf(g); bv[(size_t)cp * 64 + lane] = be; ((float*)(p.ws + WS_EL))[(size_t)cp * 64 + lane] = expf(gl_ - g); }
        bf16x8 kf[2][8];
#pragma unroll
        for (int mi = 0; mi < 2; ++mi) { const size_t R = (size_t)gdn_row(b, pc, 32 * mi + r32, dir);
#pragma unroll
            for (int d0 = 0; d0 < 8; ++d0) kf[mi][d0] = *(const bf16x8*)(qkvp + R * 1536 + 512 + h * 128 + d0 * 16 + hi * 8); }
        bf16_t* Ao = Ab + (size_t)cp * 4096;
#pragma unroll
        for (int mi = 0; mi < 2; ++mi) {
            bf16x8 qf[8];
            { const size_t R = (size_t)gdn_row(b, pc, 32 * mi + r32, dir);
#pragma unroll
              for (int d0 = 0; d0 < 8; ++d0) qf[d0] = *(const bf16x8*)(qkvp + R * 1536 + h * 128 + d0 * 16 + hi * 8); }
#pragma unroll
            for (int ni = 0; ni <= mi; ++ni) {
                f32x16 ckk = {}, cqk = {};
#pragma unroll
                for (int d0 = 0; d0 < 8; ++d0) { ckk = __builtin_amdgcn_mfma_f32_32x32x16_bf16(kf[mi][d0], kf[ni][d0], ckk, 0, 0, 0);
                                                 cqk = __builtin_amdgcn_mfma_f32_32x32x16_bf16(qf[d0], kf[ni][d0], cqk, 0, 0, 0); }
                const int sg = 32 * ni + r32; const float gsg = gs[sg];
#pragma unroll
                for (int r = 0; r < 16; ++r) { const int tau = 32 * mi + crow(r, hi);
                    const float dec = tau >= sg ? __expf(gs[tau] - gsg) : 0.f;
                    Lw[tau * 64 + sg] = tau > sg ? bs[tau] * dec * ckk[r] : 0.f;
                    Ao[tau * 64 + sg] = f2bf(cqk[r] * dec); }
                asm volatile("" ::: "memory");
            }
        }
#pragma unroll
        for (int r = 0; r < 16; ++r) Ao[crow(r, hi) * 64 + 32 + r32] = 0;
        float Tc[64];
#pragma unroll
        for (int i = 0; i < 64; ++i) { float a = (i == lane) ? 1.f : 0.f;
#pragma unroll
            for (int j = 0; j < i; ++j) a -= Lw[i * 64 + j] * Tc[j];
            Tc[i] = a; asm volatile("" ::: "memory"); }
        bf16_t* To = Tb + (size_t)cp * 4096;
#pragma unroll
        for (int i = 0; i < 64; ++i) To[i * 64 + lane] = f2bf(Tc[i]);
    }
}

constexpr int G_KV = 0, G_QA = 16384, G_TT = 32768, G_AQ = G_TT + 9216, G_RT = G_AQ + 9216, G_UT = G_RT + 4608, G_UP = G_UT + 4608,
              G_ST = G_UP + 4608, G_VS = G_ST + 8704, G_GS = G_VS + 4096, G_BS = G_GS + 256, G_EL = G_BS + 256, G_END = G_EL + 256;
__device__ __forceinline__ void gdn_scan_phase(const Params& p, unsigned char* lds) {
    const int tid = threadIdx.x, lane0 = tid & 63, wid = tid >> 6;
    const bf16_t* qkvp = (const bf16_t*)p.out;
    const bf16_t* Tb = (const bf16_t*)(p.ws + WS_T); const bf16_t* Ab = (const bf16_t*)(p.ws + WS_AQK);
    const float* gv = (const float*)(p.ws + WS_GV); const float* bv = (const float*)(p.ws + WS_BV);
    bf16_t* obuf = (bf16_t*)(p.ws + WS_H);
    const float* gsl = (const float*)(lds + G_GS); const float* bsl = (const float*)(lds + G_BS); const float* esl = (const float*)(lds + G_EL);
    const int sr = tid >> 4, sc = (tid & 15) * 8;
    const int vblk = (gridDim.x % 8 == 0) ? (int)((blockIdx.x & 7) * (gridDim.x >> 3) + (blockIdx.x >> 3)) : (int)blockIdx.x;
    for (int wi = vblk; wi < 256; wi += gridDim.x) {
        const int chain = wi >> 2, cs = wi & 3, b = chain >> 3, h = (chain >> 1) & 3, dir = chain & 1;
        f32x16 Sacc = {};
        for (int i = tid; i < 8704 / 4; i += NTHREADS) ((unsigned*)(lds + G_ST))[i] = 0u;
        bf16x8 sk0, sk1, sq0, sq1, sT, sA, sV; float sg = 0.f;
#define GLOAD(step) do { const int pc_ = dir == 0 ? (step) : ((step) < 4 ? 3 - (step) : 4 + 127 - ((step) - 4)); \
        const size_t cp_ = (size_t)chain * 132 + pc_; \
        const size_t R0_ = (size_t)gdn_row(b, pc_, sr, dir), R1_ = (size_t)gdn_row(b, pc_, 32 + sr, dir); \
        sk0 = *(const bf16x8*)(qkvp + R0_ * 1536 + 512 + h * 128 + sc); sk1 = *(const bf16x8*)(qkvp + R1_ * 1536 + 512 + h * 128 + sc); \
        sq0 = *(const bf16x8*)(qkvp + R0_ * 1536 + h * 128 + sc); sq1 = *(const bf16x8*)(qkvp + R1_ * 1536 + h * 128 + sc); \
        sT = *(const bf16x8*)(Tb + cp_ * 4096 + tid * 8); sA = *(const bf16x8*)(Ab + cp_ * 4096 + tid * 8); \
        if (tid < 256) { const size_t Rv_ = (size_t)gdn_row(b, pc_, tid >> 2, dir); sV = *(const bf16x8*)(qkvp + Rv_ * 1536 + 1024 + h * 128 + cs * 32 + (tid & 3) * 8); } \
        if (tid < 64) sg = gv[cp_ * 64 + tid]; else if (tid < 128) sg = bv[cp_ * 64 + tid - 64]; else if (tid < 192) sg = ((const float*)(p.ws + WS_EL))[cp_ * 64 + tid - 128]; } while (0)
#define GWRITE() do { *(bf16x8*)(lds + G_KV + v_st(sr, sc)) = sk0; *(bf16x8*)(lds + G_KV + v_st(32 + sr, sc)) = sk1; \
        *(bf16x8*)(lds + G_QA + KSWZ(sr, sc * 2)) = sq0; *(bf16x8*)(lds + G_QA + KSWZ(32 + sr, sc * 2)) = sq1; \
        *(bf16x8*)(lds + G_TT + (tid >> 3) * 144 + (tid & 7) * 16) = sT; *(bf16x8*)(lds + G_AQ + (tid >> 3) * 144 + (tid & 7) * 16) = sA; \
        if (tid < 256) *(bf16x8*)(lds + G_VS + (tid >> 2) * 64 + (tid & 3) * 16) = sV; \
        if (tid < 192) ((float*)(lds + G_GS))[tid] = sg; } while (0)
        GLOAD(0);
        for (int step = 0; step < 132; ++step) {
            GWRITE();
            __syncthreads();
            if (step + 1 < 132) GLOAD(step + 1);
            int lane = lane0; asm volatile("" : "+v"(lane));
            const int r32 = lane & 31, hi = lane >> 5;
            const int vb0 = (int)(uintptr_t)(lds + G_KV) + v_rd_base(lane);
            const int pc = dir == 0 ? step : (step < 4 ? 3 - step : 4 + 127 - (step - 4));
            f32x16 acc = {};
            const int mi = wid & 1;
            if (wid < 4) {
                f32x16 acc2 = {};
                if (wid < 2) {
#pragma unroll
                    for (int d0 = 0; d0 < 8; d0 += 2) {
                        const bf16x8 a0 = *(const bf16x8*)(lds + G_KV + v_st(32 * mi + r32, d0 * 16 + hi * 8)), a1 = *(const bf16x8*)(lds + G_KV + v_st(32 * mi + r32, d0 * 16 + 16 + hi * 8));
                        const bf16x8 b0 = *(const bf16x8*)(lds + G_ST + r32 * 272 + (d0 * 16 + hi * 8) * 2), b1 = *(const bf16x8*)(lds + G_ST + r32 * 272 + (d0 * 16 + 16 + hi * 8) * 2);
                        acc = __builtin_amdgcn_mfma_f32_32x32x16_bf16(a0, b0, acc, 0, 0, 0);
                        acc2 = __builtin_amdgcn_mfma_f32_32x32x16_bf16(a1, b1, acc2, 0, 0, 0); }
                } else {
#pragma unroll
                    for (int d0 = 0; d0 < 8; d0 += 2) {
                        const bf16x8 a0 = *(const bf16x8*)(lds + G_QA + KSWZ(32 * mi + r32, (d0 * 16 + hi * 8) * 2)), a1 = *(const bf16x8*)(lds + G_QA + KSWZ(32 * mi + r32, (d0 * 16 + 16 + hi * 8) * 2));
                        const bf16x8 b0 = *(const bf16x8*)(lds + G_ST + r32 * 272 + (d0 * 16 + hi * 8) * 2), b1 = *(const bf16x8*)(lds + G_ST + r32 * 272 + (d0 * 16 + 16 + hi * 8) * 2);
                        acc = __builtin_amdgcn_mfma_f32_32x32x16_bf16(a0, b0, acc, 0, 0, 0);
                        acc2 = __builtin_amdgcn_mfma_f32_32x32x16_bf16(a1, b1, acc2, 0, 0, 0); }
                }
#pragma unroll
                for (int r = 0; r < 16; ++r) acc[r] += acc2[r];
                if (wid < 2) {
#pragma unroll
                    for (int g4 = 0; g4 < 4; ++g4) { float rv[4];
#pragma unroll
                        for (int j = 0; j < 4; ++j) { const int tau = 32 * mi + 8 * g4 + 4 * hi + j;
                            const float vv = bf2f(*(const bf16_t*)(lds + G_VS + tau * 64 + r32 * 2));
                            rv[j] = bsl[tau] * (vv - gsl[tau] * acc[g4 * 4 + j]); }
                        u32x2 w; w.x = cvtpk(rv[0], rv[1]); w.y = cvtpk(rv[2], rv[3]);
                        *(u32x2*)(lds + G_RT + r32 * 144 + (32 * mi + 8 * g4 + 4 * hi) * 2) = w; }
                } else {
#pragma unroll
                    for (int r = 0; r < 16; ++r) acc[r] *= gsl[32 * mi + crow(r, hi)];
                }
            }
            __syncthreads();
            if (wid < 2) {
                f32x16 u = {}, u2 = {};
#pragma unroll
                for (int s = 0; s < 4; s += 2) {
                    const bf16x8 a0 = *(const bf16x8*)(lds + G_TT + (32 * mi + r32) * 144 + (16 * s + hi * 8) * 2), a1 = *(const bf16x8*)(lds + G_TT + (32 * mi + r32) * 144 + (16 * s + 16 + hi * 8) * 2);
                    const bf16x8 b0 = *(const bf16x8*)(lds + G_RT + r32 * 144 + (16 * s + hi * 8) * 2), b1 = *(const bf16x8*)(lds + G_RT + r32 * 144 + (16 * s + 16 + hi * 8) * 2);
                    u = __builtin_amdgcn_mfma_f32_32x32x16_bf16(a0, b0, u, 0, 0, 0);
                    u2 = __builtin_amdgcn_mfma_f32_32x32x16_bf16(a1, b1, u2, 0, 0, 0); }
#pragma unroll
                for (int r = 0; r < 16; ++r) u[r] += u2[r];
#pragma unroll
                for (int g4 = 0; g4 < 4; ++g4) { float uv[4], up[4];
#pragma unroll
                    for (int j = 0; j < 4; ++j) { const int tau = 32 * mi + 8 * g4 + 4 * hi + j; uv[j] = u[g4 * 4 + j]; up[j] = uv[j] * esl[tau]; }
                    u32x2 w; w.x = cvtpk(uv[0], uv[1]); w.y = cvtpk(uv[2], uv[3]);
                    *(u32x2*)(lds + G_UT + r32 * 144 + (32 * mi + 8 * g4 + 4 * hi) * 2) = w;
                    u32x2 w2; w2.x = cvtpk(up[0], up[1]); w2.y = cvtpk(up[2], up[3]);
                    *(u32x2*)(lds + G_UP + r32 * 144 + (32 * mi + 8 * g4 + 4 * hi) * 2) = w2; }
            }
            __syncthreads();
            if (wid == 2 || wid == 3) {
#pragma unroll
                for (int s = 0; s < 4; ++s) {
                    const bf16x8 a = *(const bf16x8*)(lds + G_AQ + (32 * mi + r32) * 144 + (16 * s + hi * 8) * 2);
                    const bf16x8 bb = *(const bf16x8*)(lds + G_UT + r32 * 144 + (16 * s + hi * 8) * 2);
                    acc = __builtin_amdgcn_mfma_f32_32x32x16_bf16(a, bb, acc, 0, 0, 0); }
#pragma unroll
                for (int r = 0; r < 16; ++r) { const size_t R = (size_t)gdn_row(b, pc, 32 * mi + crow(r, hi), dir);
                    obuf[((size_t)dir * MTOT + R) * 512 + h * 128 + cs * 32 + r32] = f2bf(acc[r]); }
            } else if (wid >= 4) {
                const float gl = gsl[63];
#pragma unroll
                for (int r = 0; r < 16; ++r) Sacc[r] *= gl;
                const bf16x8 pa0 = *(const bf16x8*)(lds + G_UP + r32 * 144 + (0 + hi * 8) * 2), pa1 = *(const bf16x8*)(lds + G_UP + r32 * 144 + (16 + hi * 8) * 2),
                             pa2 = *(const bf16x8*)(lds + G_UP + r32 * 144 + (32 + hi * 8) * 2), pa3 = *(const bf16x8*)(lds + G_UP + r32 * 144 + (48 + hi * 8) * 2);
                const int d0 = wid - 4;
                if (d0 == 0) pv_one<0>(Sacc, vb0, pa0, pa1, pa2, pa3); else if (d0 == 1) pv_one<1>(Sacc, vb0, pa0, pa1, pa2, pa3);
                else if (d0 == 2) pv_one<2>(Sacc, vb0, pa0, pa1, pa2, pa3); else pv_one<3>(Sacc, vb0, pa0, pa1, pa2, pa3);
#pragma unroll
                for (int r = 0; r < 16; ++r) *(bf16_t*)(lds + G_ST + crow(r, hi) * 272 + (32 * d0 + r32) * 2) = f2bf(Sacc[r]);
            }
            __syncthreads();
        }
#undef GLOAD
#undef GWRITE
    }
}

__device__ __forceinline__ void gdn_post_phase(const Params& p) {
    const int lane = threadIdx.x & 63, wid = threadIdx.x >> 6;
    const bf16_t* obuf = (const bf16_t*)(p.ws + WS_H);
    const bf16_t* proj = (const bf16_t*)(p.ws + WS_PROJ);
    bf16_t* mix = (bf16_t*)(p.ws + WS_MIX);
    const int d = (lane & 15) * 8;
    for (int row = blockIdx.x * 8 + wid; row < MTOT; row += gridDim.x * 8) {
        float a[8], bb[8], g[8], y[8];
        unpack8(*(const bf16x8*)(obuf + (size_t)row * 512 + lane * 8), a);
        unpack8(*(const bf16x8*)(obuf + ((size_t)MTOT + row) * 512 + lane * 8), bb);
        unpack8(*(const bf16x8*)(proj + (size_t)row * EV_NP + 3072 + lane * 8), g);
        float ss = 0.f;
#pragma unroll
        for (int i = 0; i < 8; ++i) { a[i] += bb[i]; ss += a[i] * a[i]; }
        ss += __shfl_xor(ss, 1); ss += __shfl_xor(ss, 2); ss += __shfl_xor(ss, 4); ss += __shfl_xor(ss, 8);
        const float rstd = rsqrtf(ss * (1.f / 128.f) + 1e-6f);
#pragma unroll
        for (int i = 0; i < 8; ++i) y[i] = a[i] * rstd * p.gdn_norm[d + i] * (g[i] * __builtin_amdgcn_rcpf(1.f + __expf(-g[i])));
        *(bf16x8*)(mix + (size_t)row * DM + 512 + lane * 8) = pack8(y);
    }
}

__device__ __forceinline__ void diffattn_phase(const Params& p, unsigned char* lds) {
    const int tid = threadIdx.x, wid = tid >> 6, lane = tid & 63, r32 = lane & 31, hi = lane >> 5;
    const bf16_t* proj = (const bf16_t*)(p.ws + WS_PROJ);
    bf16_t* mix = (bf16_t*)(p.ws + WS_MIX);
    float s01 = 0.f, s23 = 0.f;
    for (int i = 0; i < 64; ++i) { s01 += p.diff_lambda[i] * p.diff_lambda[64 + i]; s23 += p.diff_lambda[128 + i] * p.diff_lambda[192 + i]; }
    const float lam = expf(s01) - expf(s23) + 0.2f;
    float* X = (float*)lds; float* li = (float*)(lds + 131072) + wid * 64;
    LAS unsigned char* ldsl = (LAS unsigned char*)lds;
    int koff[2], voff[2];
#pragma unroll
    for (int i = 0; i < 2; ++i) {
        const int g = i * 512 + tid;
        { const int row = g >> 4, cg = (g & 15) ^ (row & 7); koff[i] = row * EV_NP + cg * 8; }
        { const int o = g * 16, st = o >> 9, w = o & 511, kk = (st >> 2) * 8 + (w >> 6);
          const int k = (kk & ~0xC) | ((kk & 4) << 1) | ((kk & 8) >> 1), cc = (st & 3) * 32 + ((w & 63) >> 4) * 8; voff[i] = k * EV_NP + cc; }
    }
    const int vbase = (int)(uintptr_t)lds + v_rd_base(lane);
    const int map = wid >> 2, wq = wid & 3;
    unsigned char* Qs = lds + 98304 + wid * 4096 + lane * 16;
    const int vblk = (gridDim.x % 8 == 0) ? (int)((blockIdx.x & 7) * (gridDim.x >> 3) + (blockIdx.x >> 3)) : (int)blockIdx.x;
    for (int it = vblk; it < 2112; it += gridDim.x) {
        int b, h, NT, qrow0;
        if (it < 2048) { b = it >> 8; h = (it >> 6) & 3; const int qb = it & 63; NT = 132; qrow0 = b * SEQ + qb * 128; }
        else { const int j = it - 2048; b = j >> 3; h = (j >> 1) & 3; NT = 4; qrow0 = NLAT + b * CTXL + (j & 1) * 128; }
        bf16x8 qr[4];
        { const bf16_t* qp = proj + (size_t)(qrow0 + 32 * wq + r32) * EV_NP + h * 128 + map * 64 + hi * 8;
#pragma unroll
          for (int d0 = 0; d0 < 4; ++d0) qr[d0] = *(const bf16x8*)(qp + d0 * 16); }
        f32x16 o[4] = {}; float lsum = 0.f;
#define DDMA(j, bo) do { const bf16_t* pp_ = proj + (size_t)((j) < 4 ? NLAT + b * CTXL + 64 * (j) : b * SEQ + 64 * ((j) - 4)) * EV_NP + h * 128; \
        _Pragma("unroll") for (int i_ = 0; i_ < 2; ++i_) { \
            __builtin_amdgcn_global_load_lds((const unsigned*)(pp_ + 1024 + voff[i_]), (LAS unsigned*)(ldsl + (bo) + i_ * 8192 + wid * 1024), 16, 0, 0); \
            __builtin_amdgcn_global_load_lds((const unsigned*)(pp_ + 512 + koff[i_]), (LAS unsigned*)(ldsl + (bo) + 16384 + i_ * 8192 + wid * 1024), 16, 0, 0); } } while (0)
#define DQK(P0, P1, bo) do { P0 = (f32x16){}; P1 = (f32x16){}; const unsigned char* Ks_ = lds + (bo) + 16384; \
        _Pragma("unroll") for (int d0 = 0; d0 < 4; ++d0) { const int cb_ = (map * 64 + d0 * 16 + hi * 8) * 2; \
            const bf16x8 b0_ = *(const bf16x8*)(Ks_ + KSWZ(r32, cb_)), b1_ = *(const bf16x8*)(Ks_ + KSWZ(32 + r32, cb_)); \
            P0 = __builtin_amdgcn_mfma_f32_32x32x16_bf16(b0_, qr[d0], P0, 0, 0, 0); \
            P1 = __builtin_amdgcn_mfma_f32_32x32x16_bf16(b1_, qr[d0], P1, 0, 0, 0); } } while (0)
#define DSM(P0, P1) do { _Pragma("unroll") for (int r = 0; r < 16; ++r) { P0[r] = __builtin_amdgcn_exp2f(P0[r]); P1[r] = __builtin_amdgcn_exp2f(P1[r]); lsum += P0[r] + P1[r]; } \
        PK4(P0, 0, pa0); PK4(P0, 8, pa1); PK4(P1, 0, pa2); PK4(P1, 8, pa3); } while (0)
#define DTAIL_() asm volatile("s_waitcnt vmcnt(0)" ::: "memory"); __syncthreads(); { const int t_ = bprev; bprev = bcur; bcur = bnext; bnext = t_; }
#define DSTEP_A(N0, N1, O0, O1, j) do { if ((j) + 1 < NT) DDMA((j) + 1, bnext); \
        DQK(N0, N1, bcur); DSM(O0, O1); pv_d0(o, vbase + bprev, pa0, pa1, pa2, pa3); DTAIL_() } while (0)
#define DSTEP_B(N0, N1, O0, O1, j) do { if ((j) + 1 < NT) DDMA((j) + 1, bnext); \
        DSM(O0, O1); pv_d0(o, vbase + bprev, pa0, pa1, pa2, pa3); SBAR(); DQK(N0, N1, bcur); DTAIL_() } while (0)
        f32x16 pA0, pA1, pB0, pB1; bf16x8 pa0, pa1, pa2, pa3;
        DDMA(0, 0); DDMA(1, 32768); asm volatile("s_waitcnt vmcnt(0)" ::: "memory"); __syncthreads();
        DQK(pA0, pA1, 0);
        int bprev = 0, bcur = 32768, bnext = 65536;
        if (map == 0) {
            for (int j = 1; j + 1 < NT; j += 2) { DSTEP_A(pB0, pB1, pA0, pA1, j); DSTEP_A(pA0, pA1, pB0, pB1, j + 1); }
            DSTEP_A(pB0, pB1, pA0, pA1, NT - 1);
        } else {
            for (int j = 1; j + 1 < NT; j += 2) { DSTEP_B(pB0, pB1, pA0, pA1, j); DSTEP_B(pA0, pA1, pB0, pB1, j + 1); }
            DSTEP_B(pB0, pB1, pA0, pA1, NT - 1);
        }
        DSM(pB0, pB1); pv_d0(o, vbase + bprev, pa0, pa1, pa2, pa3);
        __syncthreads();
#undef DDMA
#undef DQK
#undef DSM
#undef DSTEP_A
#undef DSTEP_B
#undef DTAIL_
        const float lt = halfswap_add(lsum);
        if (hi == 0) li[r32] = lt;
        asm volatile("s_waitcnt lgkmcnt(0)" ::: "memory");
        float rli[16];
#pragma unroll
        for (int r = 0; r < 16; ++r) rli[r] = __builtin_amdgcn_rcpf(li[crow(r, hi)]);
        if (map == 1) {
#pragma unroll
            for (int d0 = 0; d0 < 4; ++d0)
#pragma unroll
                for (int r = 0; r < 16; ++r) X[(wq * 64 + d0 * 16 + r) * 64 + lane] = o[d0][r] * rli[r] * lam;
        }
        __syncthreads();
        if (map == 0) {
#pragma unroll
            for (int d0 = 0; d0 < 4; ++d0)
#pragma unroll
                for (int r = 0; r < 16; ++r) o[d0][r] = o[d0][r] * rli[r] - X[(wq * 64 + d0 * 16 + r) * 64 + lane];
#pragma unroll
            for (int r = 0; r < 16; ++r) {
                float ss = o[0][r] * o[0][r] + o[1][r] * o[1][r] + o[2][r] * o[2][r] + o[3][r] * o[3][r];
                ss += __shfl_xor(ss, 1); ss += __shfl_xor(ss, 2); ss += __shfl_xor(ss, 4); ss += __shfl_xor(ss, 8); ss += __shfl_xor(ss, 16);
                const float rstd = rsqrtf(ss * (1.f / 128.f) + 1e-6f) * 0.8f;
                bf16_t* mp = mix + (size_t)(qrow0 + 32 * wq + crow(r, hi)) * DM + h * 128 + r32;
#pragma unroll
                for (int d0 = 0; d0 < 4; ++d0) mp[32 * d0] = f2bf(o[d0][r] * rstd * p.diff_subln[32 * d0 + r32]);
            }
        }
        __syncthreads();
    }
}

__device__ __forceinline__ void natten_phase(const Params& p, unsigned char* lds) {
    const int tid = threadIdx.x, wid = tid >> 6, lane = tid & 63, r32 = lane & 31, hi = lane >> 5;
    const bf16_t* proj = (const bf16_t*)(p.ws + WS_PROJ);
    bf16_t* mix = (bf16_t*)(p.ws + WS_MIX);
    constexpr float L2E = 1.4426950408889634f;
    unsigned char* Vl = lds; unsigned char* Kl = lds + 32768;
    float* rpbs = (float*)(lds + 65536);
    float* li = (float*)(lds + 133120) + wid * 64;
    unsigned char* Qs = lds + 67584 + wid * 8192 + lane * 16;
    const int sr = tid >> 4, sc = (tid & 15) * 8, vst0 = v_st(sr, sc), vst1 = v_st(32 + sr, sc);
    const int vb0 = (int)(uintptr_t)Vl + v_rd_base(lane);
    const float* gkp = p.na_qk_gain + 128 + sc;
    const int vblk = (gridDim.x % 8 == 0) ? (int)((blockIdx.x & 7) * (gridDim.x >> 3) + (blockIdx.x >> 3)) : (int)blockIdx.x;
    for (int it = vblk; it < 2048; it += gridDim.x) {
        const int b = it >> 8, h = (it >> 5) & 7, rq = it & 31;
        const int grow = 4 * rq + (wid >> 1), qc = (wid & 1) * 32 + r32;
        const size_t qR = (size_t)b * SEQ + grow * 64 + qc;
        for (int i = tid; i < 465; i += NTHREADS) rpbs[i] = p.na_rpb[h * 465 + i] * L2E;
        { float ss = 0.f;
#pragma unroll
          for (int d0 = 0; d0 < 8; ++d0) { float qv[8]; unpack8(*(const bf16x8*)(proj + qR * OD_N + h * 128 + d0 * 16 + hi * 8), qv);
#pragma unroll
              for (int i = 0; i < 8; ++i) ss += qv[i] * qv[i]; }
          ss = halfswap_add(ss);
          const float rs = rsqrtf(ss * (1.f / 128.f) + 1e-6f) * 0.08838834764831845f * L2E;
#pragma unroll
          for (int d0 = 0; d0 < 8; ++d0) { float qv[8]; unpack8(*(const bf16x8*)(proj + qR * OD_N + h * 128 + d0 * 16 + hi * 8), qv);
#pragma unroll
              for (int i = 0; i < 8; ++i) qv[i] *= rs * p.na_qk_gain[d0 * 16 + hi * 8 + i];
              *(bf16x8*)(Qs + d0 * 1024) = pack8(qv); } }
        int lo = 4 * rq - 4; lo = lo < 0 ? 0 : (lo > 120 ? 120 : lo);
        int hi_r = 4 * rq + 3 - 4; hi_r = hi_r < 0 ? 0 : (hi_r > 120 ? 120 : hi_r); hi_r += 7;
        const int nlat = hi_r - lo + 1, NT = nlat + 4;
        int wsr = grow - 4; wsr = wsr < 0 ? 0 : (wsr > 120 ? 120 : wsr);
        int cst = qc - 8; cst = cst < 0 ? 0 : (cst > 48 ? 48 : cst);
        f32x16 o[4] = {}; float lsum = 0.f;
        bf16x8 vs0, vs1, ks0, ks1;
#define NLOAD(j) do { const size_t R0_ = (size_t)((j) < nlat ? b * SEQ + (lo + (j)) * 64 : NLAT + b * CTXL + 64 * ((j) - nlat)) + sr; \
        const bf16_t* pp_ = proj + R0_ * OD_N + h * 128 + sc; \
        vs0 = *(const bf16x8*)(pp_ + 2048); vs1 = *(const bf16x8*)(pp_ + 2048 + (size_t)32 * OD_N); \
        ks0 = *(const bf16x8*)(pp_ + 1024); ks1 = *(const bf16x8*)(pp_ + 1024 + (size_t)32 * OD_N); } while (0)
#define KNORM(kx) do { float f_[8]; unpack8(kx, f_); float ss_ = 0.f; _Pragma("unroll") for (int i_ = 0; i_ < 8; ++i_) ss_ += f_[i_] * f_[i_]; \
        ss_ += __shfl_xor(ss_, 1); ss_ += __shfl_xor(ss_, 2); ss_ += __shfl_xor(ss_, 4); ss_ += __shfl_xor(ss_, 8); \
        const float rs_ = rsqrtf(ss_ * (1.f / 128.f) + 1e-6f); _Pragma("unroll") for (int i_ = 0; i_ < 8; ++i_) f_[i_] *= rs_ * gkp[i_]; kx = pack8(f_); } while (0)
#define NWRITE(bf) do { KNORM(ks0); KNORM(ks1); *(bf16x8*)(Vl + (bf) * 16384 + vst0) = vs0; *(bf16x8*)(Vl + (bf) * 16384 + vst1) = vs1; \
        *(bf16x8*)(Kl + (bf) * 16384 + KSWZ(sr, sc * 2)) = ks0; *(bf16x8*)(Kl + (bf) * 16384 + KSWZ(32 + sr, sc * 2)) = ks1; } while (0)
        NLOAD(0); NWRITE(0); __syncthreads();
        for (int j = 0; j < NT; ++j) {
            if (j + 1 < NT) NLOAD(j + 1);
            const int bf = j & 1;
            const bool islat = j < nlat; const int kr = lo + j;
            const bool active = !islat || (kr >= wsr && kr <= wsr + 7);
            if (active) {
                f32x16 p0 = {}, p1 = {};
                const unsigned char* Ks = Kl + bf * 16384;
#pragma unroll
                for (int d0 = 0; d0 < 8; ++d0) { const int cb = (d0 * 16 + hi * 8) * 2;
                    const bf16x8 b0 = *(const bf16x8*)(Ks + KSWZ(r32, cb)), b1 = *(const bf16x8*)(Ks + KSWZ(32 + r32, cb));
                    const bf16x8 qd = *(const bf16x8*)(Qs + d0 * 1024);
                    p0 = __builtin_amdgcn_mfma_f32_32x32x16_bf16(b0, qd, p0, 0, 0, 0);
                    p1 = __builtin_amdgcn_mfma_f32_32x32x16_bf16(b1, qd, p1, 0, 0, 0); }
                if (islat) {
                    const float* rb = rpbs + (kr - grow + 7) * 31 + 15 - qc + 4 * hi;
                    const int mofs = 4 * hi - cst;
#pragma unroll
                    for (int r = 0; r < 16; ++r) {
                        const int kb = (r & 3) + 8 * (r >> 2);
                        const float e0 = __builtin_amdgcn_exp2f(p0[r] + rb[kb]), e1 = __builtin_amdgcn_exp2f(p1[r] + rb[32 + kb]);
                        p0[r] = ((unsigned)(kb + mofs) < 16u) ? e0 : 0.f; p1[r] = ((unsigned)(32 + kb + mofs) < 16u) ? e1 : 0.f;
                        lsum += p0[r] + p1[r]; }
                } else {
#pragma unroll
                    for (int r = 0; r < 16; ++r) { p0[r] = __builtin_amdgcn_exp2f(p0[r]); p1[r] = __builtin_amdgcn_exp2f(p1[r]); lsum += p0[r] + p1[r]; }
                }
                bf16x8 pa0, pa1, pa2, pa3;
                PK4(p0, 0, pa0); PK4(p0, 8, pa1); PK4(p1, 0, pa2); PK4(p1, 8, pa3);
                pv_d0(o, vb0 + bf * 16384, pa0, pa1, pa2, pa3);
            }
            if (j + 1 < NT) NWRITE((j + 1) & 1);
            __syncthreads();
        }
#undef NLOAD
#undef KNORM
#undef NWRITE
        const float lt = halfswap_add(lsum);
        if (hi == 0) li[r32] = lt;
        asm volatile("s_waitcnt lgkmcnt(0)" ::: "memory");
#pragma unroll
        for (int r = 0; r < 16; ++r) { const float rl = __builtin_amdgcn_rcpf(li[crow(r, hi)]);
            bf16_t* mp = mix + ((size_t)b * SEQ + grow * 64 + (wid & 1) * 32 + crow(r, hi)) * DM + h * 128 + r32;
#pragma unroll
            for (int d0 = 0; d0 < 4; ++d0) mp[32 * d0] = f2bf(o[d0][r] * rl); }
        __syncthreads();
    }
}

#define XB_TMO      128
#define XB_XCNT(j)  (256  + 64 * (j))
#define XB_XSUB(j)  (1280 + 64 * (j))
#define XB_XGEN(j)  (2304 + 64 * (j))
#define XB_TOP      3328
#define XB_TOPGEN   3392
#define XCD_BAR_WORDS 3456
#define XB_SPIN_CAP (1u << 22)
__device__ __forceinline__ unsigned xb_ld(unsigned* p)              { return __hip_atomic_load(p, __ATOMIC_RELAXED, __HIP_MEMORY_SCOPE_AGENT); }
__device__ __forceinline__ unsigned xb_add(unsigned* p, unsigned v) { return __hip_atomic_fetch_add(p, v, __ATOMIC_RELAXED, __HIP_MEMORY_SCOPE_AGENT); }
__device__ __forceinline__ unsigned xb_xcc_id() { return (unsigned)__builtin_amdgcn_s_getreg((3 << 11) | 20) & 0xFu; }
#define XB_SPIN(cond, bar) do { unsigned _sp = 0; while (cond) { __builtin_amdgcn_s_sleep(1); \
    if ((++_sp & 255u) == 0u) { if (xb_ld(&(bar)[XB_TMO])) break; if (_sp > XB_SPIN_CAP) { atomicAdd(&(bar)[XB_TMO], 1u); break; } } } } while (0)
struct XcdBarrier { unsigned* bar; unsigned x; volatile LAS unsigned* st; };
__device__ __forceinline__ XcdBarrier xcd_barrier_post(unsigned* bar, volatile LAS unsigned* st) {
    XcdBarrier b; b.bar = bar; b.x = xb_xcc_id(); b.st = st;
    if (threadIdx.x == 0) (void)xb_add(&bar[XB_XCNT(b.x)], 1u);
    return b;
}
__device__ __forceinline__ void xcd_barrier_complete(unsigned* bar, unsigned x, unsigned& nloc, unsigned& nx) {
    const unsigned G = gridDim.x * gridDim.y * gridDim.z;
    unsigned sum, cnt, mine, sp = 0u;
    for (;;) {
        sum = 0u; cnt = 0u; mine = 0u;
#pragma unroll
        for (unsigned j = 0; j < 16; ++j) { const unsigned c = xb_ld(&bar[XB_XCNT(j)]); sum += c; cnt += (c > 0u) ? 1u : 0u; mine = (j == x) ? c : mine; }
        if (sum == G) break;
        __builtin_amdgcn_s_sleep(1);
        if ((++sp & 255u) == 0u) { if (xb_ld(&bar[XB_TMO])) break; if (sp > XB_SPIN_CAP) { atomicAdd(&bar[XB_TMO], 1u); break; } }
    }
    nloc = mine > 0u ? mine : 1u; nx = cnt > 0u ? cnt : 1u;
}
__device__ __forceinline__ void xcd_barrier(const XcdBarrier& b) {
    asm volatile("s_waitcnt vmcnt(0)" ::: "memory");
    __syncthreads();
    if (threadIdx.x == 0) {
        unsigned* bar = b.bar;
        __builtin_amdgcn_s_waitcnt(0);
        unsigned nloc = b.st[0], nx = b.st[1];
        if (nloc == 0u) { xcd_barrier_complete(bar, b.x, nloc, nx); b.st[0] = nloc; b.st[1] = nx; }
        const unsigned old = xb_add(&bar[XB_XSUB(b.x)], 1u);
        const unsigned gen = old / nloc;
        if (old + 1u == (gen + 1u) * nloc) {
            __builtin_amdgcn_fence(__ATOMIC_RELEASE, "agent");
            asm volatile("s_waitcnt vmcnt(0)" ::: "memory");
            const unsigned og = xb_add(&bar[XB_TOP], 1u);
            const unsigned tg = og / nx;
            if (og + 1u == (tg + 1u) * nx) xb_add(&bar[XB_TOPGEN], 1u);
            else XB_SPIN(xb_ld(&bar[XB_TOPGEN]) == tg, bar);
            __builtin_amdgcn_fence(__ATOMIC_ACQUIRE, "agent");
            xb_add(&bar[XB_XGEN(b.x)], 1u);
            asm volatile("s_waitcnt vmcnt(0)" ::: "memory");
        } else {
            XB_SPIN(xb_ld(&bar[XB_XGEN(b.x)]) == gen, bar);
            __builtin_amdgcn_fence(__ATOMIC_ACQUIRE, "agent");
            asm volatile("s_waitcnt vmcnt(0)" ::: "memory");
        }
    }
    __syncthreads();
}

#ifndef PROBE_REP
#define PROBE_REP 0
#endif
#define REP(k) for (int rep_ = 0; rep_ < (((PROBE_REP >> (k)) & 1) ? 2 : 1); ++rep_)
constexpr int NPH = 18;
__global__ void __launch_bounds__(NTHREADS, 2) fwd_megakernel(Params p) {
    extern __shared__ __attribute__((aligned(16))) unsigned char lds[];
    cg::grid_group grid = cg::this_grid();
    LAS unsigned char* ldsl = (LAS unsigned char*)lds;
    const int lo = p.ph_lo, hi = p.ph_hi;
#ifdef ONLY_PH
#define IN(k) (((ONLY_PH >> (k)) & 1) && lo <= (k) && (k) < hi)
#else
#define IN(k) (lo <= (k) && (k) < hi)
#endif
#define SEAM(k) do { if (IN(k) && IN((k) + 1)) { if ((k) == 0) grid.sync(); else { XcdBarrier xb_; xb_.bar = (unsigned*)(p.ws + WS_BAR); xb_.x = xb_xcc_id(); xb_.st = (volatile LAS unsigned*)(ldsl + 135168); xcd_barrier(xb_); } } } while (0)
    unsigned char* ws = p.ws;
    const bf16_t* H = (const bf16_t*)(ws + WS_H);
    bf16_t* PROJ = (bf16_t*)(ws + WS_PROJ);
    const bf16_t* MIX = (const bf16_t*)(ws + WS_MIX);
    float* CTXRES = (float*)(ws + WS_CTXRES);
    const float* MOD = (const float*)(ws + WS_MOD);
    const int G = gridDim.x, c = blockIdx.x;
    if (threadIdx.x < 4) ((volatile LAS unsigned*)(ldsl + 135168))[threadIdx.x] = 0u;
    __syncthreads();
    (void)xcd_barrier_post((unsigned*)(ws + WS_BAR), (volatile LAS unsigned*)(ldsl + 135168));

    if (IN(0)) REP(0) { ada_phase(p, lds); wconv_phase(p, lds);
        { float* rc = (float*)(ws + WS_ROPE); float* rs = rc + SEQ * 32;
          for (int e = blockIdx.x * NTHREADS + threadIdx.x; e < SEQ * 32; e += gridDim.x * NTHREADS) { const int t = e >> 5, pp = e & 31;
              const float inv = powf(10000.f, -(float)(pp & 15) / 16.f); const float ang = (pp < 16 ? (float)(t >> 6) : (float)(t & 63)) * inv;
              rc[e] = cosf(ang); rs[e] = sinf(ang); } } }
    SEAM(0);
    if (IN(1)) REP(1) norm_phase(p, p.x, p.ctx, 0, 0, MTOT);
    SEAM(1);
    if (IN(2)) REP(2) { pg8::Gemm g{H, (const bf16_t*)(ws + WS_W_EVIN), MTOT, EV_NP, DM}; pg8::StaticOrderT<264, 15> S; S.init(MTOT, EV_NP, G, c);
        pg8::EpiBf16 E{PROJ, EV_NP}; pg8::gemm_phase(ldsl, g, S, E); }
    SEAM(2);
    if (IN(3)) prep0_phase(p);
    SEAM(3);
    if (IN(4)) REP(4) gdn_pre_phase(p, lds);
    SEAM(4);
    if (IN(5)) {
#ifndef SKIP_SCAN
        REP(20) { gdn_scan_phase(p, lds); __syncthreads(); }
#endif
#ifndef SKIP_DA
        REP(5) { diffattn_phase(p, lds); __syncthreads(); }
#endif
    }
    SEAM(5);
    if (IN(6)) REP(6) gdn_post_phase(p);
    SEAM(6);
    if (IN(7)) REP(7) { pg8::Gemm g{MIX, (const bf16_t*)(ws + WS_W_EVOUT), MTOT, DM, DM}; pg8::StaticOrderT<264, 4> S; S.init(MTOT, DM, G, c);
        pg8::EpiResid E{p.x, p.ctx, p.out, CTXRES, MOD, 2048}; pg8::gemm_phase(ldsl, g, S, E); }
    SEAM(7);
    if (IN(8)) norm_phase(p, p.out, CTXRES, 0, 1, MTOT);
    SEAM(8);
    if (IN(9)) REP(9) { pg8::Gemm g{H, (const bf16_t*)(ws + WS_W_FFIN), MTOT, 2 * FF, DM}; pg8::StaticOrderT<264, 22> S; S.init(MTOT, 2 * FF, G, c);
        pg8::EpiSwiglu E{PROJ, FF}; pg8::gemm_phase(ldsl, g, S, E); }
    SEAM(9);
    if (IN(10)) { pg8::Gemm g{PROJ, (const bf16_t*)(ws + WS_W_FFOUT), MTOT, DM, FF}; pg8::StaticOrderT<264, 4> S; S.init(MTOT, DM, G, c);
        pg8::EpiResid E{p.out, CTXRES, p.out, CTXRES, MOD, 5120}; pg8::gemm_phase(ldsl, g, S, E); }
    SEAM(10);
    if (IN(11)) norm_phase(p, p.out, CTXRES, 1, 0, MTOT);
    SEAM(11);
    if (IN(12)) { pg8::Gemm g{H, (const bf16_t*)(ws + WS_W_ODIN), MTOT, OD_N, DM}; pg8::StaticOrderT<264, 12> S; S.init(MTOT, OD_N, G, c);
        pg8::EpiBf16 E{PROJ, OD_N}; pg8::gemm_phase(ldsl, g, S, E); }
    SEAM(12);
    if (IN(13)) { natten_phase(p, lds); if ((PROBE_REP >> 13) & 1) { __syncthreads(); natten_phase(p, lds); } }
    SEAM(13);
    if (IN(14)) { pg8::Gemm g{MIX, (const bf16_t*)(ws + WS_W_ODOUT), NLAT, DM, DM}; pg8::StaticOrderT<256, 4> S; S.init(NLAT, DM, G, c);
        pg8::EpiResid E{p.out, CTXRES, p.out, CTXRES, MOD + 9 * 6144, 2048}; pg8::gemm_phase(ldsl, g, S, E); }
    SEAM(14);
    if (IN(15)) norm_phase(p, p.out, CTXRES, 1, 1, NLAT);
    SEAM(15);
    if (IN(16)) { pg8::Gemm g{H, (const bf16_t*)(ws + WS_W_FFIN) + (size_t)2 * FF * DM, NLAT, 2 * FF, DM}; pg8::StaticOrderT<256, 22> S; S.init(NLAT, 2 * FF, G, c);
        pg8::EpiSwiglu E{PROJ, FF}; pg8::gemm_phase(ldsl, g, S, E); }
    SEAM(16);
    if (IN(17)) { pg8::Gemm g{PROJ, (const bf16_t*)(ws + WS_W_FFOUT) + (size_t)DM * FF, NLAT, DM, FF}; pg8::StaticOrderT<256, 4> S; S.init(NLAT, DM, G, c);
        pg8::EpiResid E{p.out, CTXRES, p.out, CTXRES, MOD + 9 * 6144, 5120}; pg8::gemm_phase(ldsl, g, S, E); }
#undef IN
#undef SEAM
}

extern "C" void kernel_launch(void* const* d_in, const int* in_sizes, int n_in, void* d_out, int out_size, void* d_ws, size_t ws_size, hipStream_t stream) {
    static int grid = 0;
    if (grid == 0) {
        if (n_in != 23 || ws_size < WS_END) { fprintf(stderr, "kernel_launch: n_in %d ws %zu (need %zu)\n", n_in, ws_size, (size_t)WS_END); grid = -1; return; }
        int dev = 0, cus = 0, per_cu = 0;
        hipGetDevice(&dev); hipDeviceGetAttribute(&cus, hipDeviceAttributeMultiprocessorCount, dev);
        if (hipFuncSetAttribute((const void*)fwd_megakernel, hipFuncAttributeMaxDynamicSharedMemorySize, LDS_BYTES) != hipSuccess) { fprintf(stderr, "hipFuncSetAttribute failed\n"); grid = -1; return; }
        if (hipOccupancyMaxActiveBlocksPerMultiprocessor(&per_cu, (const void*)fwd_megakernel, NTHREADS, LDS_BYTES) != hipSuccess || per_cu < 1) per_cu = 1;
        (void)hipGetLastError();
        grid = cus * 1;
    }
    if (grid < 0) return;
    if (hipMemsetAsync((char*)d_ws + WS_BAR, 0, 16384, stream) != hipSuccess) { fprintf(stderr, "memset failed\n"); return; }
    Params p{};
    const float** pp = (const float**)&p;
    for (int i = 0; i < 23; ++i) pp[i] = (const float*)d_in[i];
    p.out = (float*)d_out; p.ws = (unsigned char*)d_ws;
#if N_LAUNCH_MODE == 1
    p.ph_lo = 0; p.ph_hi = NPH;
    void* args[] = {&p};
    hipError_t e = hipLaunchCooperativeKernel((void*)fwd_megakernel, dim3(grid), dim3(NTHREADS), args, LDS_BYTES, stream);
    if (e != hipSuccess) fprintf(stderr, "cooperative launch failed: %s (grid %d)\n", hipGetErrorString(e), grid);
#else
    for (int k = 0; k < NPH; ++k) { p.ph_lo = k; p.ph_hi = k + 1;
        hipLaunchKernelGGL(fwd_megakernel, dim3(grid), dim3(NTHREADS), LDS_BYTES, stream, p); }
#endif
}
```

```cpp
#include <hip/hip_runtime.h>
#include <hip/hip_cooperative_groups.h>
#include <cstdio>
#include <cstdint>
namespace cg = cooperative_groups;

#define LAS __attribute__((address_space(3)))
typedef unsigned short bf16_t;
typedef short bf16x8 __attribute__((ext_vector_type(8)));
typedef short s16x4 __attribute__((ext_vector_type(4)));
typedef float f32x4 __attribute__((ext_vector_type(4)));
typedef float f32x16 __attribute__((ext_vector_type(16)));
typedef unsigned u32x4 __attribute__((ext_vector_type(4)));
typedef unsigned u32x2 __attribute__((ext_vector_type(2)));

#ifndef N_LAUNCH_MODE
#define N_LAUNCH_MODE 1
#endif

constexpr int DM = 1024, NLAT = 65536, NCTX = 2048, MTOT = NLAT + NCTX, SEQ = 8192, CTXL = 256, FF = 2816;
constexpr int EV_N = 3600, EV_NP = 3840, OD_N = 3072;
constexpr int NCHUNKP = 64 * 132;
constexpr int NTHREADS = 512;
constexpr int LDS_BYTES = 135168 + 16;

constexpr size_t al256(size_t x) { return (x + 255) / 256 * 256; }
constexpr size_t WS_W_EVIN = 0;
constexpr size_t WS_W_EVOUT = WS_W_EVIN + al256((size_t)EV_NP * DM * 2);
constexpr size_t WS_W_ODIN = WS_W_EVOUT + al256((size_t)DM * DM * 2);
constexpr size_t WS_W_ODOUT = WS_W_ODIN + al256((size_t)OD_N * DM * 2);
constexpr size_t WS_W_FFIN = WS_W_ODOUT + al256((size_t)DM * DM * 2);
constexpr size_t WS_W_FFOUT = WS_W_FFIN + al256((size_t)2 * 2 * FF * DM * 2);
constexpr size_t WS_MOD = WS_W_FFOUT + al256((size_t)2 * DM * FF * 2);
constexpr size_t WS_H = WS_MOD + al256((size_t)2 * 9 * 6144 * 4);
constexpr size_t WS_PROJ = WS_H + al256((size_t)MTOT * DM * 2);
constexpr size_t WS_MIX = WS_PROJ + al256((size_t)MTOT * EV_NP * 2);
constexpr size_t WS_T = WS_MIX + al256((size_t)MTOT * DM * 2);
constexpr size_t WS_AQK = WS_T + al256((size_t)NCHUNKP * 4096 * 2);
constexpr size_t WS_GV = WS_AQK + al256((size_t)NCHUNKP * 4096 * 2);
constexpr size_t WS_BV = WS_GV + al256((size_t)NCHUNKP * 64 * 4);
constexpr size_t WS_EL = WS_BV + al256((size_t)NCHUNKP * 64 * 4);
constexpr size_t WS_GATES = WS_EL + al256((size_t)NCHUNKP * 64 * 4);
constexpr size_t WS_CTXRES = WS_GATES + al256((size_t)MTOT * 16 * 4);
constexpr size_t WS_BAR = WS_CTXRES + al256((size_t)NCTX * DM * 4);
constexpr size_t WS_ROPE = WS_BAR + 16384;
constexpr size_t WS_END = WS_ROPE + (size_t)2 * SEQ * 32 * 4;

struct Params {
    const float *x, *c, *ctx, *c_ctx, *ada_w, *ada_b, *norm_mix, *norm_ffn, *ffn_w_in, *ffn_w_out, *even_w_in, *even_w_out,
        *diff_qk_gain, *diff_lambda, *diff_subln, *gdn_conv, *gdn_a_log, *gdn_dt_bias, *gdn_norm, *odd_w_in, *odd_w_out, *na_qk_gain, *na_rpb;
    float* out; unsigned char* ws; int ph_lo, ph_hi;
};

__device__ __forceinline__ float bf2f(bf16_t b) { return __uint_as_float(((unsigned)b) << 16); }
__device__ __forceinline__ bf16_t f2bf(float f) { unsigned u = __float_as_uint(f); u += 0x7FFFu + ((u >> 16) & 1u); return (bf16_t)(u >> 16); }
__device__ __forceinline__ unsigned cvtpk(float lo, float hi) { unsigned r; asm volatile("v_cvt_pk_bf16_f32 %0, %1, %2" : "=v"(r) : "v"(lo), "v"(hi)); return r; }
__device__ __forceinline__ float siluf(float v) { return v / (1.f + __expf(-v)); }
__device__ __forceinline__ void unpack8(bf16x8 v, float* f) {
#pragma unroll
    for (int i = 0; i < 8; ++i) f[i] = bf2f((bf16_t)v[i]);
}
__device__ __forceinline__ bf16x8 pack8(const float* f) {
    u32x4 w = {cvtpk(f[0], f[1]), cvtpk(f[2], f[3]), cvtpk(f[4], f[5]), cvtpk(f[6], f[7])};
    return *reinterpret_cast<bf16x8*>(&w);
}

namespace pg8 {
constexpr int BM = 256, BK = 64, HALF = 128, HTB = HALF * BK * 2, STAGE_BYTES = 8 * HTB, NXCD = 8, WGM = 8;
__host__ __device__ __forceinline__ int lds_byte(int r, int c) { const int st = (r >> 4) * 2 + (c >> 5), rr = r & 15, cc = c & 31, ob = rr * 64 + cc * 2; return st * 1024 + (ob ^ (((ob >> 9) & 1) << 5)); }
__host__ __device__ __forceinline__ void stage_rc(int b, int& R, int& C) { const int st = b / 1024, sb = b % 1024, swz = sb ^ (((sb >> 9) & 1) << 5); R = (st >> 1) * 16 + swz / 64; C = (st & 1) * 32 + (swz % 64) / 2; }
__host__ __device__ __forceinline__ int perm32(int rho) { const int n = rho >> 4, i = rho & 15; return 8 * (i >> 2) + 4 * n + (i & 3); }
struct Unit { int pm, pn; };
struct Gemm { const bf16_t* A; const bf16_t* Bt; int M, N, K; };
template <int NM, int NN> struct StaticOrderT {
    static_assert(NM % WGM == 0, "row tiles in whole groups");
    int G, c;
    __device__ void init(int, int, int G_, int c_) { G = G_; c = c_; }
    __device__ bool next(int i, Unit& u) const {
        constexpr int nwg = NM * NN, q = nwg / NXCD, r = nwg % NXCD, nig = WGM * NN;
        const int L = i * G + c; if (L >= nwg) return false;
        const int xcd = L % NXCD, off = L / NXCD;
        const int wgid = (xcd < r ? xcd * (q + 1) : r * (q + 1) + (xcd - r) * q) + off;
        const int gid = wgid / nig, w = wgid % nig;
        u.pm = gid * WGM + (w % WGM); u.pn = w / WGM; return true;
    }
};
struct EpiBf16 {
    static constexpr bool PERM = true;
    bf16_t* O; int ldc;
    __device__ __forceinline__ void operator()(const f32x4 (&acc)[2][2][4][2], const Unit& u, int wr, int wc, int fr, int fq) const {
        const int row0 = u.pm * BM + wr * 64 + fr; const int col0 = u.pn * BM + wc * 32 + 8 * fq;
#pragma unroll
        for (int ai = 0; ai < 2; ++ai)
#pragma unroll
            for (int m = 0; m < 4; ++m) { bf16_t* rowp = O + (size_t)(row0 + ai * HALF + m * 16) * ldc + col0;
#pragma unroll
                for (int bj = 0; bj < 2; ++bj) { const f32x4 v0 = acc[ai][bj][m][0], v1 = acc[ai][bj][m][1];
                    u32x4 w; w.x = cvtpk(v0[0], v0[1]); w.y = cvtpk(v0[2], v0[3]); w.z = cvtpk(v1[0], v1[1]); w.w = cvtpk(v1[2], v1[3]);
                    *(u32x4*)(rowp + bj * HALF) = w; } }
    }
};
struct EpiSwiglu {
    static constexpr bool PERM = true;
    bf16_t* O; int ldc;
    __device__ __forceinline__ void operator()(const f32x4 (&acc)[2][2][4][2], const Unit& u, int wr, int wc, int fr, int fq) const {
        const int row0 = u.pm * BM + wr * 64 + fr; const int col0 = u.pn * HALF + wc * 32 + 8 * fq;
#pragma unroll
        for (int ai = 0; ai < 2; ++ai)
#pragma unroll
            for (int m = 0; m < 4; ++m) { bf16_t* rowp = O + (size_t)(row0 + ai * HALF + m * 16) * ldc + col0;
                float o[8];
#pragma unroll
                for (int n = 0; n < 2; ++n)
#pragma unroll
                    for (int j = 0; j < 4; ++j) { const float g = acc[ai][0][m][n][j], up = acc[ai][1][m][n][j]; o[n * 4 + j] = g * __builtin_amdgcn_rcpf(1.f + __expf(-g)) * up; }
                u32x4 w; w.x = cvtpk(o[0], o[1]); w.y = cvtpk(o[2], o[3]); w.z = cvtpk(o[4], o[5]); w.w = cvtpk(o[6], o[7]);
                *(u32x4*)rowp = w; }
    }
};
struct EpiResid {
    static constexpr bool PERM = false;
    const float* resLat; const float* resCtx; float* outLat; float* outCtx; const float* modl; int goff;
    __device__ __forceinline__ void operator()(const f32x4 (&acc)[2][2][4][2], const Unit& u, int wr, int wc, int fr, int fq) const {
        const int rowt = u.pm * BM; const bool lat = rowt < NLAT;
        const float* res = lat ? resLat + (size_t)rowt * DM : resCtx + (size_t)(rowt - NLAT) * DM;
        float* out = lat ? outLat + (size_t)rowt * DM : outCtx + (size_t)(rowt - NLAT) * DM;
        const float* gate = modl + (size_t)(lat ? (rowt >> 13) : 8) * 6144 + goff;
        const int row0 = wr * 64 + fr, col0 = u.pn * BM + wc * 32 + 4 * fq;
        f32x4 gv[2][2];
#pragma unroll
        for (int bj = 0; bj < 2; ++bj)
#pragma unroll
            for (int n = 0; n < 2; ++n) gv[bj][n] = *(const f32x4*)(gate + col0 + bj * HALF + n * 16);
#pragma unroll
        for (int ai = 0; ai < 2; ++ai)
#pragma unroll
            for (int mp = 0; mp < 4; mp += 2) {
                f32x4 r[2][2][2];
#pragma unroll
                for (int mm = 0; mm < 2; ++mm)
#pragma unroll
                    for (int bj = 0; bj < 2; ++bj)
#pragma unroll
                        for (int n = 0; n < 2; ++n) r[mm][bj][n] = *(const f32x4*)(res + (size_t)(row0 + ai * HALF + (mp + mm) * 16) * DM + col0 + bj * HALF + n * 16);
#pragma unroll
                for (int mm = 0; mm < 2; ++mm)
#pragma unroll
                    for (int bj = 0; bj < 2; ++bj)
#pragma unroll
                        for (int n = 0; n < 2; ++n) *(f32x4*)(out + (size_t)(row0 + ai * HALF + (mp + mm) * 16) * DM + col0 + bj * HALF + n * 16) = r[mm][bj][n] + gv[bj][n] * acc[ai][bj][mp + mm][n];
            }
    }
};

template <class Epi, class Sched>
__device__ __forceinline__ void gemm_phase(LAS unsigned char* lds, const Gemm g, const Sched& S, const Epi& E) {
    const int tid = threadIdx.x, wid = __builtin_amdgcn_readfirstlane(tid >> 6), lane = tid & 63, wr = wid >> 2, wc = wid & 3, fr = lane & 15, fq = lane >> 4;
    const int K = g.K, nt = K / BK;
    unsigned voffA[2], voffB[2];
#pragma unroll
    for (int i = 0; i < 2; ++i) { int R, C; stage_rc(tid * 16 + i * 8192, R, C); const int Rb = Epi::PERM ? ((R & ~31) + perm32(R & 31)) : R;
        voffA[i] = (unsigned)(R * K + C) * 2u; voffB[i] = (unsigned)(Rb * K + C) * 2u; }
    const size_t kstep = (size_t)(BK * 2);
    const size_t hstep = (size_t)HALF * K * 2;
    const size_t tstep = 2 * hstep;
    const unsigned ldsw = (unsigned)wid * 1024u;
    const int aoff = lds_byte(wr * 64 + fr, fq * 8), boff = lds_byte(wc * 32 + fr, fq * 8);
#define PG8_SA(b, h) (((b) * 2 + (h)) * HTB)
#define PG8_SB(b, h) ((4 + (b) * 2 + (h)) * HTB)
#define PG8_STAGE(bufoff, gbase, voff) do { _Pragma("unroll") for (int _i = 0; _i < 2; ++_i) \
        __builtin_amdgcn_global_load_lds((const unsigned*)((const char*)(gbase) + (voff)[_i]), (LAS unsigned*)(lds + (bufoff) + ldsw + _i * 8192), 16, 0, 0); } while (0)
#define PG8_LDA(dst, b, h) do { _Pragma("unroll") for (int m = 0; m < 4; ++m) _Pragma("unroll") for (int k = 0; k < 2; ++k) dst[m][k] = *(const LAS bf16x8*)(lds + PG8_SA(b, h) + aoff + m * 2048 + k * 1024); } while (0)
#define PG8_LDB(dst, b, h) do { _Pragma("unroll") for (int n = 0; n < 2; ++n) _Pragma("unroll") for (int k = 0; k < 2; ++k) dst[n][k] = *(const LAS bf16x8*)(lds + PG8_SB(b, h) + boff + n * 2048 + k * 1024); } while (0)
#define PG8_MMA(ai, bj, At, Bt) do { __builtin_amdgcn_s_setprio(1); _Pragma("unroll") for (int m = 0; m < 4; ++m) _Pragma("unroll") for (int n = 0; n < 2; ++n) _Pragma("unroll") for (int k = 0; k < 2; ++k) \
        acc[ai][bj][m][n] = __builtin_amdgcn_mfma_f32_16x16x32_bf16(Bt[n][k], At[m][k], acc[ai][bj][m][n], 0, 0, 0); __builtin_amdgcn_s_setprio(0); } while (0)
#define PG8_WAIT_V(n) asm volatile("s_waitcnt vmcnt(" #n ")" ::: "memory")
#define PG8_WAIT_L(n) asm volatile("s_waitcnt lgkmcnt(" #n ")" ::: "memory")
#define PG8_BAR __builtin_amdgcn_s_barrier()
#define PG8_SCHED __builtin_amdgcn_sched_barrier(0)
    Unit cur, nxt; int ui = 0;
    if (!S.next(0, cur)) return;
    f32x4 acc[2][2][4][2];
#pragma unroll
    for (int a = 0; a < 2; ++a)
#pragma unroll
        for (int b = 0; b < 2; ++b)
#pragma unroll
            for (int m = 0; m < 4; ++m)
#pragma unroll
                for (int n = 0; n < 2; ++n) acc[a][b][m][n] = (f32x4){0.f, 0.f, 0.f, 0.f};
    bf16x8 At[4][2], B0[2][2], B1[2][2];
    const char* cA = (const char*)g.A + (size_t)cur.pm * tstep; const char* cB = (const char*)g.Bt + (size_t)cur.pn * tstep;
    PG8_STAGE(PG8_SB(0, 0), cB, voffB); PG8_STAGE(PG8_SA(0, 0), cA, voffA); PG8_STAGE(PG8_SB(0, 1), cB + hstep, voffB); PG8_STAGE(PG8_SA(0, 1), cA + hstep, voffA);
    if (wr == 1) PG8_BAR;
    PG8_WAIT_V(4); PG8_BAR;
    PG8_STAGE(PG8_SB(1, 0), cB + kstep, voffB); PG8_STAGE(PG8_SA(1, 0), cA + kstep, voffA); PG8_STAGE(PG8_SB(1, 1), cB + hstep + kstep, voffB);
    PG8_WAIT_V(6); PG8_BAR;
    for (;;) {
        const bool has_next = S.next(ui + 1, nxt);
        const char* nA = has_next ? (const char*)g.A + (size_t)nxt.pm * tstep : cA; const char* nB = has_next ? (const char*)g.Bt + (size_t)nxt.pn * tstep : cB;
        for (int t = 0; t < nt; t += 2) {
            const bool last = (t == nt - 2);
            const char* a1 = cA + (size_t)(t + 1) * kstep;
            const char* a2 = last ? nA : cA + (size_t)(t + 2) * kstep; const char* b2 = last ? nB : cB + (size_t)(t + 2) * kstep;
            const char* a3 = a2 + kstep; const char* b3 = b2 + kstep;
            PG8_LDB(B0, 0, 0); PG8_SCHED; PG8_LDA(At, 0, 0); PG8_STAGE(PG8_SA(1, 1), a1 + hstep, voffA);
            PG8_WAIT_L(8); PG8_BAR; PG8_WAIT_L(0); PG8_MMA(0, 0, At, B0); PG8_BAR; PG8_SCHED;
            PG8_LDB(B1, 0, 1); PG8_STAGE(PG8_SB(0, 0), b2, voffB);
            PG8_BAR; PG8_WAIT_L(0); PG8_MMA(0, 1, At, B1); PG8_BAR;
            PG8_LDA(At, 0, 1); PG8_STAGE(PG8_SA(0, 0), a2, voffA);
            PG8_BAR; PG8_WAIT_L(0); PG8_MMA(1, 0, At, B0); PG8_BAR; PG8_SCHED;
            PG8_STAGE(PG8_SB(0, 1), b2 + hstep, voffB);
            PG8_WAIT_V(6); PG8_BAR; PG8_MMA(1, 1, At, B1); PG8_BAR;
            PG8_LDB(B0, 1, 0); PG8_SCHED; PG8_LDA(At, 1, 0); PG8_STAGE(PG8_SA(0, 1), a2 + hstep, voffA);
            PG8_WAIT_L(8); PG8_BAR; PG8_WAIT_L(0); PG8_MMA(0, 0, At, B0); PG8_BAR; PG8_SCHED;
            PG8_LDB(B1, 1, 1); PG8_STAGE(PG8_SB(1, 0), b3, voffB);
            PG8_BAR; PG8_WAIT_L(0); PG8_MMA(0, 1, At, B1); PG8_BAR;
            PG8_LDA(At, 1, 1); PG8_STAGE(PG8_SA(1, 0), a3, voffA);
            PG8_BAR; PG8_WAIT_L(0); PG8_MMA(1, 0, At, B0); PG8_BAR; PG8_SCHED;
            PG8_STAGE(PG8_SB(1, 1), b3 + hstep, voffB);
            PG8_WAIT_V(6); PG8_BAR; PG8_MMA(1, 1, At, B1); PG8_BAR;
        }
        E(acc, cur, wr, wc, fr, fq);
        if (!has_next) break;
#pragma unroll
        for (int a = 0; a < 2; ++a)
#pragma unroll
            for (int b = 0; b < 2; ++b)
#pragma unroll
                for (int m = 0; m < 4; ++m)
#pragma unroll
                    for (int n = 0; n < 2; ++n) acc[a][b][m][n] = (f32x4){0.f, 0.f, 0.f, 0.f};
        cur = nxt; cA = nA; cB = nB; ++ui;
    }
    PG8_WAIT_V(0);
    if (wr == 0) PG8_BAR;
    PG8_BAR;
#undef PG8_SA
#undef PG8_SB
#undef PG8_STAGE
#undef PG8_LDA
#undef PG8_LDB
#undef PG8_MMA
#undef PG8_WAIT_V
#undef PG8_WAIT_L
#undef PG8_BAR
#undef PG8_SCHED
}
}

#define KSWZ(row, colB) ((row) * 256 + ((colB) ^ (((row) & 7) << 4)))
#define SBAR() __builtin_amdgcn_sched_barrier(0)
__device__ __forceinline__ int crow(int r, int hi) { return (r & 3) + 8 * (r >> 2) + 4 * hi; }
__device__ __forceinline__ int v_st(int k, int c) { const int kk = (k & ~0xC) | ((k & 4) << 1) | ((k & 8) >> 1); return ((kk >> 3) * 4 + (c >> 5)) * 512 + ((kk & 7) * 32 + (c & 31)) * 2; }
__device__ __forceinline__ int v_rd_base(int lane) { return ((lane & 3) << 3) | (((lane >> 2) & 3) << 6) | (((lane >> 4) & 1) << 5) | (((lane >> 5) & 1) << 8); }
constexpr int v_rd_off(int d0, int ks, int half) { return d0 * 512 + ks * 4096 + half * 2048; }
template <int OFF> __device__ __forceinline__ s16x4 tr_read(int vb) {
    s16x4 r; asm volatile("ds_read_b64_tr_b16 %0, %1 offset:%2" : "=&v"(r) : "v"(vb), "i"(OFF) : "memory"); return r;
}
template <int D0> __device__ __forceinline__ void pv_one(f32x16& od, int vb, bf16x8 pa0, bf16x8 pa1, bf16x8 pa2, bf16x8 pa3) {
    const s16x4 l0 = tr_read<v_rd_off(D0, 0, 0)>(vb), h0 = tr_read<v_rd_off(D0, 0, 1)>(vb), l1 = tr_read<v_rd_off(D0, 1, 0)>(vb), h1 = tr_read<v_rd_off(D0, 1, 1)>(vb);
    const s16x4 l2 = tr_read<v_rd_off(D0, 2, 0)>(vb), h2 = tr_read<v_rd_off(D0, 2, 1)>(vb), l3 = tr_read<v_rd_off(D0, 3, 0)>(vb), h3 = tr_read<v_rd_off(D0, 3, 1)>(vb);
    asm volatile("s_waitcnt lgkmcnt(0)" ::: "memory"); SBAR();
#define PK(L, H) (bf16x8){L[0], L[1], L[2], L[3], H[0], H[1], H[2], H[3]}
    od = __builtin_amdgcn_mfma_f32_32x32x16_bf16(pa0, PK(l0, h0), od, 0, 0, 0);
    od = __builtin_amdgcn_mfma_f32_32x32x16_bf16(pa1, PK(l1, h1), od, 0, 0, 0);
    od = __builtin_amdgcn_mfma_f32_32x32x16_bf16(pa2, PK(l2, h2), od, 0, 0, 0);
    od = __builtin_amdgcn_mfma_f32_32x32x16_bf16(pa3, PK(l3, h3), od, 0, 0, 0);
#undef PK
}
__device__ __forceinline__ void pv_d0(f32x16* o, int vb, bf16x8 pa0, bf16x8 pa1, bf16x8 pa2, bf16x8 pa3) {
    pv_one<0>(o[0], vb, pa0, pa1, pa2, pa3); pv_one<1>(o[1], vb, pa0, pa1, pa2, pa3); pv_one<2>(o[2], vb, pa0, pa1, pa2, pa3); pv_one<3>(o[3], vb, pa0, pa1, pa2, pa3);
}
#define PK4(P, BASE, OUT) do { unsigned a0 = cvtpk(P[BASE + 0], P[BASE + 1]), a1 = cvtpk(P[BASE + 2], P[BASE + 3]);   \
    unsigned b0 = cvtpk(P[BASE + 4], P[BASE + 5]), b1 = cvtpk(P[BASE + 6], P[BASE + 7]);                              \
    auto r0 = __builtin_amdgcn_permlane32_swap(a0, b0, false, false); auto r1 = __builtin_amdgcn_permlane32_swap(a1, b1, false, false); \
    u32x4 w = {r0[0], r1[0], r0[1], r1[1]}; OUT = *reinterpret_cast<bf16x8*>(&w); } while (0)
__device__ __forceinline__ float halfswap_add(float v) {
    auto rr = __builtin_amdgcn_permlane32_swap(__float_as_uint(v), __float_as_uint(v), false, false);
    return __uint_as_float(rr[0]) + __uint_as_float(rr[1]);
}

__device__ __forceinline__ void ada_phase(const Params& p, unsigned char* lds) {
    float* sc = (float*)lds;
    float* red = (float*)(lds + 40960);
    float* mod = (float*)(p.ws + WS_MOD);
    const int tid = threadIdx.x;
    for (int j = blockIdx.x; j < 192; j += gridDim.x) {
        const int l = j / 96, n0 = (j % 96) * 64;
        for (int i = tid; i < 9 * 1024; i += NTHREADS) { const int r = i >> 10, k = i & 1023; const float v = r < 8 ? p.c[r * 1024 + k] : p.c_ctx[k]; sc[i] = v / (1.f + expf(-v)); }
        __syncthreads();
        const int col = tid & 63, ks = tid >> 6;
        float acc[9];
#pragma unroll
        for (int r = 0; r < 9; ++r) acc[r] = 0.f;
        const float* wp = p.ada_w + ((size_t)l * 1024 + ks * 128) * 6144 + n0 + col;
#pragma unroll 8
        for (int kk = 0; kk < 128; ++kk) { const float w = wp[(size_t)kk * 6144];
#pragma unroll
            for (int r = 0; r < 9; ++r) acc[r] += sc[r * 1024 + ks * 128 + kk] * w; }
#pragma unroll
        for (int r = 0; r < 9; ++r) red[(ks * 9 + r) * 64 + col] = acc[r];
        __syncthreads();
        for (int i = tid; i < 576; i += NTHREADS) { const int r = i >> 6, cc = i & 63; float s = p.ada_b[l * 6144 + n0 + cc];
            for (int k2 = 0; k2 < 8; ++k2) s += red[(k2 * 9 + r) * 64 + cc];
            mod[(size_t)(l * 9 + r) * 6144 + n0 + cc] = s; }
        __syncthreads();
    }
}
__device__ __forceinline__ void wconv_phase(const Params& p, unsigned char* lds) {
    float* tl = (float*)lds;
    const int tid = threadIdx.x;
    const int T0 = 16 * 60, T1 = T0 + 16 * 16, T2 = T1 + 16 * 48, T3 = T2 + 16 * 16, T4 = T3 + 16 * 88, T5 = T4 + 16 * 88, T6 = T5 + 44 * 16, T7 = T6 + 44 * 16;
#define WC_DECODE(t) \
        const float* src; bf16_t* dst; int K, N, NP, mode = 0, tt; \
        if ((t) < T0) { src = p.even_w_in; dst = (bf16_t*)(p.ws + WS_W_EVIN); K = 1024; N = EV_N; NP = EV_NP; tt = (t); } \
        else if ((t) < T1) { src = p.even_w_out; dst = (bf16_t*)(p.ws + WS_W_EVOUT); K = 1024; N = 1024; NP = 1024; tt = (t) - T0; } \
        else if ((t) < T2) { src = p.odd_w_in; dst = (bf16_t*)(p.ws + WS_W_ODIN); K = 1024; N = OD_N; NP = OD_N; tt = (t) - T1; } \
        else if ((t) < T3) { src = p.odd_w_out; dst = (bf16_t*)(p.ws + WS_W_ODOUT); K = 1024; N = 1024; NP = 1024; tt = (t) - T2; } \
        else if ((t) < T4) { src = p.ffn_w_in; dst = (bf16_t*)(p.ws + WS_W_FFIN); K = 1024; N = 2 * FF; NP = 2 * FF; mode = 1; tt = (t) - T3; } \
        else if ((t) < T5) { src = p.ffn_w_in + (size_t)1024 * 2 * FF; dst = (bf16_t*)(p.ws + WS_W_FFIN) + (size_t)2 * FF * 1024; K = 1024; N = 2 * FF; NP = 2 * FF; mode = 1; tt = (t) - T4; } \
        else if ((t) < T6) { src = p.ffn_w_out; dst = (bf16_t*)(p.ws + WS_W_FFOUT); K = FF; N = 1024; NP = 1024; tt = (t) - T5; } \
        else { src = p.ffn_w_out + (size_t)FF * 1024; dst = (bf16_t*)(p.ws + WS_W_FFOUT) + (size_t)1024 * FF; K = FF; N = 1024; NP = 1024; tt = (t) - T6; } \
        const int nnt = NP / 64; const int k0 = (tt / nnt) * 64, n0 = (tt % nnt) * 64; \
        int sn0; if (mode == 1) { const int tb = n0 >> 8, bj = (n0 >> 7) & 1, i0 = n0 & 127; sn0 = bj * FF + tb * 128 + i0; } else sn0 = n0;
    float rg[8];
#define WC_LOAD(t) do { WC_DECODE(t) (void)dst; _Pragma("unroll") for (int i = 0; i < 8; ++i) { const int e = tid + NTHREADS * i, kk = e >> 6, nn = e & 63; const int sn = sn0 + nn; \
        rg[i] = (sn < N) ? src[(size_t)(k0 + kk) * N + sn] : 0.f; } } while (0)
    int t = blockIdx.x;
    if (t < T7) WC_LOAD(t);
    for (; t < T7; t += gridDim.x) {
#pragma unroll
        for (int i = 0; i < 8; ++i) { const int e = tid + NTHREADS * i; tl[(e >> 6) * 65 + (e & 63)] = rg[i]; }
        __syncthreads();
        { WC_DECODE(t) (void)src; (void)N; (void)sn0;
          if (t + (int)gridDim.x < T7) WC_LOAD(t + (int)gridDim.x);
          for (int e = tid; e < 2048; e += NTHREADS) { const int nn = e >> 5, k2 = (e & 31) * 2;
              *(unsigned*)(dst + (size_t)(n0 + nn) * K + k0 + k2) = cvtpk(tl[k2 * 65 + nn], tl[(k2 + 1) * 65 + nn]); } }
        __syncthreads();
    }
#undef WC_DECODE
#undef WC_LOAD
}

__device__ __forceinline__ void norm_phase(const Params& p, const float* xlat, const float* xctx, int l, int which, int nrows) {
    const int lane = threadIdx.x & 63, wid = threadIdx.x >> 6;
    bf16_t* h = (bf16_t*)(p.ws + WS_H);
    const float* mod = (const float*)(p.ws + WS_MOD) + (size_t)l * 9 * 6144;
    const float* gain = (which ? p.norm_ffn : p.norm_mix) + l * 1024;
    const int shoff = which ? 3072 : 0, scoff = which ? 4096 : 1024;
    const int stride = gridDim.x * 8;
    f32x4 gn[4];
#pragma unroll
    for (int i = 0; i < 4; ++i) gn[i] = *(const f32x4*)(gain + lane * 4 + 256 * i);
    for (int row = blockIdx.x * 8 + wid; row < nrows; row += 2 * stride) {
        const int rowB = row + stride; const bool hasB = rowB < nrows; const int rB = hasB ? rowB : row;
        const float* srcA = row < NLAT ? xlat + (size_t)row * DM : xctx + (size_t)(row - NLAT) * DM;
        const float* srcB = rB < NLAT ? xlat + (size_t)rB * DM : xctx + (size_t)(rB - NLAT) * DM;
        const float* mrA = mod + (size_t)(row < NLAT ? (row >> 13) : 8) * 6144;
        const float* mrB = mod + (size_t)(rB < NLAT ? (rB >> 13) : 8) * 6144;
        f32x4 va[4], vb[4], sa[4], ha[4], sb[4], hb[4];
#pragma unroll
        for (int i = 0; i < 4; ++i) { const int c0 = lane * 4 + 256 * i;
            va[i] = *(const f32x4*)(srcA + c0); vb[i] = *(const f32x4*)(srcB + c0);
            sa[i] = *(const f32x4*)(mrA + scoff + c0); ha[i] = *(const f32x4*)(mrA + shoff + c0);
            sb[i] = *(const f32x4*)(mrB + scoff + c0); hb[i] = *(const f32x4*)(mrB + shoff + c0); }
#pragma unroll
        for (int rr = 0; rr < 2; ++rr) {
            if (rr == 1 && !hasB) break;
            const int r = rr ? rowB : row;
            float ss = 0.f;
#pragma unroll
            for (int i = 0; i < 4; ++i) { const f32x4 v = rr ? vb[i] : va[i]; ss += v[0] * v[0] + v[1] * v[1] + v[2] * v[2] + v[3] * v[3]; }
#pragma unroll
            for (int o = 1; o < 64; o <<= 1) ss += __shfl_xor(ss, o);
            const float rstd = rsqrtf(ss * (1.f / 1024.f) + 1e-6f);
#pragma unroll
            for (int i = 0; i < 4; ++i) { const int c0 = lane * 4 + 256 * i; const f32x4 v = rr ? vb[i] : va[i], s1 = rr ? sb[i] : sa[i], sh = rr ? hb[i] : ha[i];
                float y[4];
#pragma unroll
                for (int j = 0; j < 4; ++j) y[j] = v[j] * rstd * gn[i][j] * (1.f + s1[j]) + sh[j];
                u32x2 w; w.x = cvtpk(y[0], y[1]); w.y = cvtpk(y[2], y[3]);
                *(u32x2*)(h + (size_t)r * DM + c0) = w; }
        }
    }
}

__device__ __forceinline__ void prep0_phase(const Params& p) {
    const int lane0 = threadIdx.x & 63, wid = threadIdx.x >> 6;
    bf16_t* proj = (bf16_t*)(p.ws + WS_PROJ);
    bf16_t* qkvp = (bf16_t*)p.out;
    float* gbuf = (float*)(p.ws + WS_GATES);
    const float* ropec = (const float*)(p.ws + WS_ROPE); const float* ropes = ropec + SEQ * 32;
    constexpr int RB = 8;
    for (int blk = blockIdx.x * 8 + wid; blk < MTOT / RB; blk += gridDim.x * 8) {
        int lane = lane0; asm volatile("" : "+v"(lane));
        const int row0 = blk * RB; const bool lat = row0 < NLAT; const int t0 = lat ? (row0 & 8191) : ((row0 - NLAT) & 255); const int len = lat ? SEQ : CTXL;
        const int dsub = (lane & 7) * 8;
        {
            float gq[8], gk[8];
#pragma unroll
            for (int i = 0; i < 8; ++i) { gq[i] = p.diff_qk_gain[dsub + i] * (0.125f * 1.4426950408889634f); gk[i] = p.diff_qk_gain[64 + dsub + i]; }
#pragma unroll
            for (int i0 = 0; i0 < RB; i0 += 4) {
                bf16x8 raw[4][2]; f32x4 c4[4], s4[4];
#pragma unroll
                for (int i = 0; i < 4; ++i) { const bf16_t* P = proj + (size_t)(row0 + i0 + i) * EV_NP;
                    raw[i][0] = *(const bf16x8*)(P + lane * 8); raw[i][1] = *(const bf16x8*)(P + 512 + lane * 8);
                    c4[i] = (f32x4){1.f, 1.f, 1.f, 1.f}; s4[i] = (f32x4){0.f, 0.f, 0.f, 0.f};
                    if (lat) { c4[i] = *(const f32x4*)(ropec + (t0 + i0 + i) * 32 + (lane & 7) * 4); s4[i] = *(const f32x4*)(ropes + (t0 + i0 + i) * 32 + (lane & 7) * 4); } }
#pragma unroll
                for (int i = 0; i < 4; ++i) { bf16_t* P = proj + (size_t)(row0 + i0 + i) * EV_NP;
#pragma unroll
                    for (int which = 0; which < 2; ++which) {
                        float v[8]; unpack8(raw[i][which], v);
                        float ss = 0.f;
#pragma unroll
                        for (int e = 0; e < 8; ++e) ss += v[e] * v[e];
                        ss += __shfl_xor(ss, 1); ss += __shfl_xor(ss, 2); ss += __shfl_xor(ss, 4);
                        const float rstd = rsqrtf(ss * (1.f / 64.f) + 1e-6f);
#pragma unroll
                        for (int e = 0; e < 8; ++e) v[e] = v[e] * rstd * (which ? gk[e] : gq[e]);
#pragma unroll
                        for (int e = 0; e < 4; ++e) { const float x0 = v[2 * e], x1 = v[2 * e + 1]; v[2 * e] = x0 * c4[i][e] - x1 * s4[i][e]; v[2 * e + 1] = x0 * s4[i][e] + x1 * c4[i][e]; }
                        *(bf16x8*)(P + which * 512 + lane * 8) = pack8(v);
                    } }
            }
        }
#pragma unroll 1
        for (int g = 0; g < 3; ++g) {
            const int c0 = g * 512 + lane * 8;
            float w[5][8];
#pragma unroll
            for (int j = 0; j < 5; ++j) { const f32x4 w0 = *(const f32x4*)(p.gdn_conv + j * 1536 + c0), w1 = *(const f32x4*)(p.gdn_conv + j * 1536 + c0 + 4);
#pragma unroll
                for (int e = 0; e < 4; ++e) { w[j][e] = w0[e]; w[j][4 + e] = w1[e]; } }
            const bf16_t* src = proj + (size_t)row0 * EV_NP + 1536 + c0;
            bf16x8 raw[RB + 4];
#pragma unroll
            for (int k = 0; k < RB + 4; ++k) { const int dt = k - 2; raw[k] = (bf16x8){0, 0, 0, 0, 0, 0, 0, 0};
                if (t0 + dt >= 0 && t0 + dt < len) raw[k] = *(const bf16x8*)(src + (ptrdiff_t)dt * EV_NP); }
            const float nsc = g == 0 ? 0.08838834764831845f : 1.f;
#pragma unroll
            for (int i = 0; i < RB; ++i) {
                float xm2[8], xm1[8], x0[8], xp1[8], xp2[8];
                unpack8(raw[i], xm2); unpack8(raw[i + 1], xm1); unpack8(raw[i + 2], x0); unpack8(raw[i + 3], xp1); unpack8(raw[i + 4], xp2);
                float y[8];
#pragma unroll
                for (int e = 0; e < 8; ++e) { y[e] = w[0][e] * xm2[e] + w[1][e] * xm1[e] + w[2][e] * x0[e] + w[3][e] * xp1[e] + w[4][e] * xp2[e]; y[e] = y[e] * __builtin_amdgcn_rcpf(1.f + __expf(-y[e])); }
                if (g < 2) { float ss = 0.f;
#pragma unroll
                    for (int e = 0; e < 8; ++e) ss += y[e] * y[e];
                    ss += __shfl_xor(ss, 1); ss += __shfl_xor(ss, 2); ss += __shfl_xor(ss, 4); ss += __shfl_xor(ss, 8);
                    const float sc_ = rsqrtf(ss + 1e-6f) * nsc;
#pragma unroll
                    for (int e = 0; e < 8; ++e) y[e] *= sc_; }
                *(bf16x8*)(qkvp + (size_t)(row0 + i) * 1536 + c0) = pack8(y);
            }
        }
#pragma unroll
        for (int k = 0; k < RB / 4; ++k) { const int idx = lane + 64 * k, i = idx >> 4, gi = idx & 15;
            const float gvv = bf2f(proj[(size_t)(row0 + i) * EV_NP + 3584 + gi]); float o;
            if (gi < 8) o = 1.f / (1.f + expf(-gvv));
            else { const float z = gvv + p.gdn_dt_bias[gi - 8]; const float sp = z > 20.f ? z : log1pf(expf(z)); o = -expf(p.gdn_a_log[gi - 8]) * sp; }
            gbuf[(size_t)(row0 + i) * 16 + gi] = o; }
    }
}

__device__ __forceinline__ int gdn_row(int b, int pc, int tau, int dir) {
    const int tt = dir ? 63 - tau : tau;
    return pc < 4 ? NLAT + b * CTXL + pc * 64 + tt : b * SEQ + (pc - 4) * 64 + tt;
}
__device__ __forceinline__ void gdn_pre_phase(const Params& p, unsigned char* lds) {
    const int lane = threadIdx.x & 63, wid = threadIdx.x >> 6;
    float* Lw = (float*)(lds + wid * 16896);
    float* gs = Lw + 4096; float* bs = gs + 64;
    const bf16_t* qkvp = (const bf16_t*)p.out;
    const float* gbuf = (const float*)(p.ws + WS_GATES);
    bf16_t* Tb = (bf16_t*)(p.ws + WS_T); bf16_t* Ab = (bf16_t*)(p.ws + WS_AQK);
    float* gv = (float*)(p.ws + WS_GV); float* bv = (float*)(p.ws + WS_BV);
    const int lane0 = lane;
    for (int cp = blockIdx.x * 8 + wid; cp < NCHUNKP; cp += gridDim.x * 8) {
        int lane = lane0; asm volatile("" : "+v"(lane));
        const int r32 = lane & 31, hi = lane >> 5;
        const int pc = cp % 132, ch = cp / 132, dir = ch & 1, h = (ch >> 1) & 3, b = ch >> 3;
        { const int R = gdn_row(b, pc, lane, dir);
          float g = gbuf[(size_t)R * 16 + 8 + dir * 4 + h]; const float be = gbuf[(size_t)R * 16 + dir * 4 + h];
#pragma unroll
          for (int o = 1; o < 64; o <<= 1) { const float t = __shfl_up(g, o); if (lane >= o) g += t; }
          gs[lane] = g; bs[lane] = be; const float gl_ = __shfl(g, 63); gv[(size_t)cp * 64 + lane] = expf(g); bv[(size_t)cp * 64 + lane] = be; ((float*)(p.ws + WS_EL))[(size_t)cp * 64 + lane] = expf(gl_ - g); }
        bf16x8 kf[2][8];
#pragma unroll
        for (int mi = 0; mi < 2; ++mi) { const size_t R = (size_t)gdn_row(b, pc, 32 * mi + r32, dir);
#pragma unroll
            for (int d0 = 0; d0 < 8; ++d0) kf[mi][d0] = *(const bf16x8*)(qkvp + R * 1536 + 512 + h * 128 + d0 * 16 + hi * 8); }
        bf16_t* Ao = Ab + (size_t)cp * 4096;
#pragma unroll
        for (int mi = 0; mi < 2; ++mi) {
            bf16x8 qf[8];
            { const size_t R = (size_t)gdn_row(b, pc, 32 * mi + r32, dir);
#pragma unroll
              for (int d0 = 0; d0 < 8; ++d0) qf[d0] = *(const bf16x8*)(qkvp + R * 1536 + h * 128 + d0 * 16 + hi * 8); }
#pragma unroll
            for (int ni = 0; ni <= mi; ++ni) {
                f32x16 ckk = {}, cqk = {};
#pragma unroll
                for (int d0 = 0; d0 < 8; ++d0) { ckk = __builtin_amdgcn_mfma_f32_32x32x16_bf16(kf[mi][d0], kf[ni][d0], ckk, 0, 0, 0);
                                                 cqk = __builtin_amdgcn_mfma_f32_32x32x16_bf16(qf[d0], kf[ni][d0], cqk, 0, 0, 0); }
                const int sg = 32 * ni + r32; const float gsg = gs[sg];
#pragma unroll
                for (int r = 0; r < 16; ++r) { const int tau = 32 * mi + crow(r, hi);
                    const float dec = tau >= sg ? __expf(gs[tau] - gsg) : 0.f;
                    Lw[tau * 64 + sg] = tau > sg ? bs[tau] * dec * ckk[r] : 0.f;
                    Ao[tau * 64 + sg] = f2bf(cqk[r] * dec); }
                asm volatile("" ::: "memory");
            }
        }
#pragma unroll
        for (int r = 0; r < 16; ++r) Ao[crow(r, hi) * 64 + 32 + r32] = 0;
        float Tc[64];
#pragma unroll
        for (int i = 0; i < 64; ++i) { float a = (i == lane) ? 1.f : 0.f;
#pragma unroll
            for (int j = 0; j < i; ++j) a -= Lw[i * 64 + j] * Tc[j];
            Tc[i] = a; asm volatile("" ::: "memory"); }
        bf16_t* To = Tb + (size_t)cp * 4096;
#pragma unroll
        for (int i = 0; i < 64; ++i) To[i * 64 + lane] = f2bf(Tc[i]);
    }
}

constexpr int G_KV = 0, G_QA = 16384, G_TT = 32768, G_AQ = G_TT + 9216, G_RT = G_AQ + 9216, G_UT = G_RT + 4608, G_UP = G_UT + 4608,
              G_ST = G_UP + 4608, G_VS = G_ST + 8704, G_GS = G_VS + 4096, G_BS = G_GS + 256, G_EL = G_BS + 256, G_END = G_EL + 256;
__device__ __forceinline__ void gdn_scan_phase(const Params& p, unsigned char* lds) {
    const int tid = threadIdx.x, lane0 = tid & 63, wid = tid >> 6;
    const bf16_t* qkvp = (const bf16_t*)p.out;
    const bf16_t* Tb = (const bf16_t*)(p.ws + WS_T); const bf16_t* Ab = (const bf16_t*)(p.ws + WS_AQK);
    const float* gv = (const float*)(p.ws + WS_GV); const float* bv = (const float*)(p.ws + WS_BV);
    bf16_t* obuf = (bf16_t*)(p.ws + WS_H);
    const float* gsl = (const float*)(lds + G_GS); const float* bsl = (const float*)(lds + G_BS); const float* esl = (const float*)(lds + G_EL);
    const int sr = tid >> 4, sc = (tid & 15) * 8;
    const int vblk = (gridDim.x % 8 == 0) ? (int)((blockIdx.x & 7) * (gridDim.x >> 3) + (blockIdx.x >> 3)) : (int)blockIdx.x;
    for (int wi = vblk; wi < 256; wi += gridDim.x) {
        const int chain = wi >> 2, cs = wi & 3, b = chain >> 3, h = (chain >> 1) & 3, dir = chain & 1;
        f32x16 Sacc = {};
        for (int i = tid; i < 8704 / 4; i += NTHREADS) ((unsigned*)(lds + G_ST))[i] = 0u;
        bf16x8 sk0, sk1, sq0, sq1, sT, sA, sV; float sg = 0.f;
#define GLOAD(step) do { const int pc_ = dir == 0 ? (step) : ((step) < 4 ? 3 - (step) : 4 + 127 - ((step) - 4)); \
        const size_t cp_ = (size_t)chain * 132 + pc_; \
        const size_t R0_ = (size_t)gdn_row(b, pc_, sr, dir), R1_ = (size_t)gdn_row(b, pc_, 32 + sr, dir); \
        sk0 = *(const bf16x8*)(qkvp + R0_ * 1536 + 512 + h * 128 + sc); sk1 = *(const bf16x8*)(qkvp + R1_ * 1536 + 512 + h * 128 + sc); \
        sq0 = *(const bf16x8*)(qkvp + R0_ * 1536 + h * 128 + sc); sq1 = *(const bf16x8*)(qkvp + R1_ * 1536 + h * 128 + sc); \
        sT = *(const bf16x8*)(Tb + cp_ * 4096 + tid * 8); sA = *(const bf16x8*)(Ab + cp_ * 4096 + tid * 8); \
        if (tid < 256) { const size_t Rv_ = (size_t)gdn_row(b, pc_, tid >> 2, dir); sV = *(const bf16x8*)(qkvp + Rv_ * 1536 + 1024 + h * 128 + cs * 32 + (tid & 3) * 8); } \
        if (tid < 64) sg = gv[cp_ * 64 + tid]; else if (tid < 128) sg = bv[cp_ * 64 + tid - 64]; else if (tid < 192) sg = ((const float*)(p.ws + WS_EL))[cp_ * 64 + tid - 128]; } while (0)
#define GWRITE() do { *(bf16x8*)(lds + G_KV + v_st(sr, sc)) = sk0; *(bf16x8*)(lds + G_KV + v_st(32 + sr, sc)) = sk1; \
        *(bf16x8*)(lds + G_QA + KSWZ(sr, sc * 2)) = sq0; *(bf16x8*)(lds + G_QA + KSWZ(32 + sr, sc * 2)) = sq1; \
        *(bf16x8*)(lds + G_TT + (tid >> 3) * 144 + (tid & 7) * 16) = sT; *(bf16x8*)(lds + G_AQ + (tid >> 3) * 144 + (tid & 7) * 16) = sA; \
        if (tid < 256) *(bf16x8*)(lds + G_VS + (tid >> 2) * 64 + (tid & 3) * 16) = sV; \
        if (tid < 192) ((float*)(lds + G_GS))[tid] = sg; } while (0)
        GLOAD(0);
        for (int step = 0; step < 132; ++step) {
            GWRITE();
            __syncthreads();
            if (step + 1 < 132) GLOAD(step + 1);
            int lane = lane0; asm volatile("" : "+v"(lane));
            const int r32 = lane & 31, hi = lane >> 5;
            const int vb0 = (int)(uintptr_t)(lds + G_KV) + v_rd_base(lane);
            const int pc = dir == 0 ? step : (step < 4 ? 3 - step : 4 + 127 - (step - 4));
            f32x16 acc = {};
            const int mi = wid & 1;
            if (wid < 4) {
                f32x16 acc2 = {};
                if (wid < 2) {
#pragma unroll
                    for (int d0 = 0; d0 < 8; d0 += 2) {
                        const bf16x8 a0 = *(const bf16x8*)(lds + G_KV + v_st(32 * mi + r32, d0 * 16 + hi * 8)), a1 = *(const bf16x8*)(lds + G_KV + v_st(32 * mi + r32, d0 * 16 + 16 + hi * 8));
                        const bf16x8 b0 = *(const bf16x8*)(lds + G_ST + r32 * 272 + (d0 * 16 + hi * 8) * 2), b1 = *(const bf16x8*)(lds + G_ST + r32 * 272 + (d0 * 16 + 16 + hi * 8) * 2);
                        acc = __builtin_amdgcn_mfma_f32_32x32x16_bf16(a0, b0, acc, 0, 0, 0);
                        acc2 = __builtin_amdgcn_mfma_f32_32x32x16_bf16(a1, b1, acc2, 0, 0, 0); }
                } else {
#pragma unroll
                    for (int d0 = 0; d0 < 8; d0 += 2) {
                        const bf16x8 a0 = *(const bf16x8*)(lds + G_QA + KSWZ(32 * mi + r32, (d0 * 16 + hi * 8) * 2)), a1 = *(const bf16x8*)(lds + G_QA + KSWZ(32 * mi + r32, (d0 * 16 + 16 + hi * 8) * 2));
                        const bf16x8 b0 = *(const bf16x8*)(lds + G_ST + r32 * 272 + (d0 * 16 + hi * 8) * 2), b1 = *(const bf16x8*)(lds + G_ST + r32 * 272 + (d0 * 16 + 16 + hi * 8) * 2);
                        acc = __builtin_amdgcn_mfma_f32_32x32x16_bf16(a0, b0, acc, 0, 0, 0);
                        acc2 = __builtin_amdgcn_mfma_f32_32x32x16_bf16(a1, b1, acc2, 0, 0, 0); }
                }
#pragma unroll
                for (int r = 0; r < 16; ++r) acc[r] += acc2[r];
                if (wid < 2) {
#pragma unroll
                    for (int g4 = 0; g4 < 4; ++g4) { float rv[4];
#pragma unroll
                        for (int j = 0; j < 4; ++j) { const int tau = 32 * mi + 8 * g4 + 4 * hi + j;
                            const float vv = bf2f(*(const bf16_t*)(lds + G_VS + tau * 64 + r32 * 2));
                            rv[j] = bsl[tau] * (vv - gsl[tau] * acc[g4 * 4 + j]); }
                        u32x2 w; w.x = cvtpk(rv[0], rv[1]); w.y = cvtpk(rv[2], rv[3]);
                        *(u32x2*)(lds + G_RT + r32 * 144 + (32 * mi + 8 * g4 + 4 * hi) * 2) = w; }
                } else {
#pragma unroll
                    for (int r = 0; r < 16; ++r) acc[r] *= gsl[32 * mi + crow(r, hi)];
                }
            }
            __syncthreads();
            if (wid < 2) {
                f32x16 u = {}, u2 = {};
#pragma unroll
                for (int s = 0; s < 4; s += 2) {
                    const bf16x8 a0 = *(const bf16x8*)(lds + G_TT + (32 * mi + r32) * 144 + (16 * s + hi * 8) * 2), a1 = *(const bf16x8*)(lds + G_TT + (32 * mi + r32) * 144 + (16 * s + 16 + hi * 8) * 2);
                    const bf16x8 b0 = *(const bf16x8*)(lds + G_RT + r32 * 144 + (16 * s + hi * 8) * 2), b1 = *(const bf16x8*)(lds + G_RT + r32 * 144 + (16 * s + 16 + hi * 8) * 2);
                    u = __builtin_amdgcn_mfma_f32_32x32x16_bf16(a0, b0, u, 0, 0, 0);
                    u2 = __builtin_amdgcn_mfma_f32_32x32x16_bf16(a1, b1, u2, 0, 0, 0); }
#pragma unroll
                for (int r = 0; r < 16; ++r) u[r] += u2[r];
#pragma unroll
                for (int g4 = 0; g4 < 4; ++g4) { float uv[4], up[4];
#pragma unroll
                    for (int j = 0; j < 4; ++j) { const int tau = 32 * mi + 8 * g4 + 4 * hi + j; uv[j] = u[g4 * 4 + j]; up[j] = uv[j] * esl[tau]; }
                    u32x2 w; w.x = cvtpk(uv[0], uv[1]); w.y = cvtpk(uv[2], uv[3]);
                    *(u32x2*)(lds + G_UT + r32 * 144 + (32 * mi + 8 * g4 + 4 * hi) * 2) = w;
                    u32x2 w2; w2.x = cvtpk(up[0], up[1]); w2.y = cvtpk(up[2], up[3]);
                    *(u32x2*)(lds + G_UP + r32 * 144 + (32 * mi + 8 * g4 + 4 * hi) * 2) = w2; }
            }
            __syncthreads();
            if (wid == 2 || wid == 3) {
#pragma unroll
                for (int s = 0; s < 4; ++s) {
                    const bf16x8 a = *(const bf16x8*)(lds + G_AQ + (32 * mi + r32) * 144 + (16 * s + hi * 8) * 2);
                    const bf16x8 bb = *(const bf16x8*)(lds + G_UT + r32 * 144 + (16 * s + hi * 8) * 2);
                    acc = __builtin_amdgcn_mfma_f32_32x32x16_bf16(a, bb, acc, 0, 0, 0); }
#pragma unroll
                for (int r = 0; r < 16; ++r) { const size_t R = (size_t)gdn_row(b, pc, 32 * mi + crow(r, hi), dir);
                    obuf[((size_t)dir * MTOT + R) * 512 + h * 128 + cs * 32 + r32] = f2bf(acc[r]); }
            } else if (wid >= 4) {
                const float gl = gsl[63];
#pragma unroll
                for (int r = 0; r < 16; ++r) Sacc[r] *= gl;
                const bf16x8 pa0 = *(const bf16x8*)(lds + G_UP + r32 * 144 + (0 + hi * 8) * 2), pa1 = *(const bf16x8*)(lds + G_UP + r32 * 144 + (16 + hi * 8) * 2),
                             pa2 = *(const bf16x8*)(lds + G_UP + r32 * 144 + (32 + hi * 8) * 2), pa3 = *(const bf16x8*)(lds + G_UP + r32 * 144 + (48 + hi * 8) * 2);
                const int d0 = wid - 4;
                if (d0 == 0) pv_one<0>(Sacc, vb0, pa0, pa1, pa2, pa3); else if (d0 == 1) pv_one<1>(Sacc, vb0, pa0, pa1, pa2, pa3);
                else if (d0 == 2) pv_one<2>(Sacc, vb0, pa0, pa1, pa2, pa3); else pv_one<3>(Sacc, vb0, pa0, pa1, pa2, pa3);
#pragma unroll
                for (int r = 0; r < 16; ++r) *(bf16_t*)(lds + G_ST + crow(r, hi) * 272 + (32 * d0 + r32) * 2) = f2bf(Sacc[r]);
            }
            __syncthreads();
        }
#undef GLOAD
#undef GWRITE
    }
}

__device__ __forceinline__ void gdn_post_phase(const Params& p) {
    const int lane = threadIdx.x & 63, wid = threadIdx.x >> 6;
    const bf16_t* obuf = (const bf16_t*)(p.ws + WS_H);
    const bf16_t* proj = (const bf16_t*)(p.ws + WS_PROJ);
    bf16_t* mix = (bf16_t*)(p.ws + WS_MIX);
    const int d = (lane & 15) * 8;
    for (int row = blockIdx.x * 8 + wid; row < MTOT; row += gridDim.x * 8) {
        float a[8], bb[8], g[8], y[8];
        unpack8(*(const bf16x8*)(obuf + (size_t)row * 512 + lane * 8), a);
        unpack8(*(const bf16x8*)(obuf + ((size_t)MTOT + row) * 512 + lane * 8), bb);
        unpack8(*(const bf16x8*)(proj + (size_t)row * EV_NP + 3072 + lane * 8), g);
        float ss = 0.f;
#pragma unroll
        for (int i = 0; i < 8; ++i) { a[i] += bb[i]; ss += a[i] * a[i]; }
        ss += __shfl_xor(ss, 1); ss += __shfl_xor(ss, 2); ss += __shfl_xor(ss, 4); ss += __shfl_xor(ss, 8);
        const float rstd = rsqrtf(ss * (1.f / 128.f) + 1e-6f);
#pragma unroll
        for (int i = 0; i < 8; ++i) y[i] = a[i] * rstd * p.gdn_norm[d + i] * (g[i] * __builtin_amdgcn_rcpf(1.f + __expf(-g[i])));
        *(bf16x8*)(mix + (size_t)row * DM + 512 + lane * 8) = pack8(y);
    }
}

__device__ __forceinline__ void diffattn_phase(const Params& p, unsigned char* lds) {
    const int tid = threadIdx.x, wid = tid >> 6, lane = tid & 63, r32 = lane & 31, hi = lane >> 5;
    const bf16_t* proj = (const bf16_t*)(p.ws + WS_PROJ);
    bf16_t* mix = (bf16_t*)(p.ws + WS_MIX);
    float s01 = 0.f, s23 = 0.f;
    for (int i = 0; i < 64; ++i) { s01 += p.diff_lambda[i] * p.diff_lambda[64 + i]; s23 += p.diff_lambda[128 + i] * p.diff_lambda[192 + i]; }
    const float lam = expf(s01) - expf(s23) + 0.2f;
    float* X = (float*)lds; float* li = (float*)(lds + 131072) + wid * 64;
    LAS unsigned char* ldsl = (LAS unsigned char*)lds;
    int koff[2], voff[2];
#pragma unroll
    for (int i = 0; i < 2; ++i) {
        const int g = i * 512 + tid;
        { const int row = g >> 4, cg = (g & 15) ^ (row & 7); koff[i] = row * EV_NP + cg * 8; }
        { const int o = g * 16, st = o >> 9, w = o & 511, kk = (st >> 2) * 8 + (w >> 6);
          const int k = (kk & ~0xC) | ((kk & 4) << 1) | ((kk & 8) >> 1), cc = (st & 3) * 32 + ((w & 63) >> 4) * 8; voff[i] = k * EV_NP + cc; }
    }
    const int vbase = (int)(uintptr_t)lds + v_rd_base(lane);
    const int map = wid >> 2, wq = wid & 3;
    unsigned char* Qs = lds + 98304 + wid * 4096 + lane * 16;
    const int vblk = (gridDim.x % 8 == 0) ? (int)((blockIdx.x & 7) * (gridDim.x >> 3) + (blockIdx.x >> 3)) : (int)blockIdx.x;
    for (int it = vblk; it < 2112; it += gridDim.x) {
        int b, h, NT, qrow0;
        if (it < 2048) { b = it >> 8; h = (it >> 6) & 3; const int qb = it & 63; NT = 132; qrow0 = b * SEQ + qb * 128; }
        else { const int j = it - 2048; b = j >> 3; h = (j >> 1) & 3; NT = 4; qrow0 = NLAT + b * CTXL + (j & 1) * 128; }
        bf16x8 qr[4];
        { const bf16_t* qp = proj + (size_t)(qrow0 + 32 * wq + r32) * EV_NP + h * 128 + map * 64 + hi * 8;
#pragma unroll
          for (int d0 = 0; d0 < 4; ++d0) qr[d0] = *(const bf16x8*)(qp + d0 * 16); }
        f32x16 o[4] = {}; float lsum = 0.f;
#define DDMA(j, bo) do { const bf16_t* pp_ = proj + (size_t)((j) < 4 ? NLAT + b * CTXL + 64 * (j) : b * SEQ + 64 * ((j) - 4)) * EV_NP + h * 128; \
        _Pragma("unroll") for (int i_ = 0; i_ < 2; ++i_) { \
            __builtin_amdgcn_global_load_lds((const unsigned*)(pp_ + 1024 + voff[i_]), (LAS unsigned*)(ldsl + (bo) + i_ * 8192 + wid * 1024), 16, 0, 0); \
            __builtin_amdgcn_global_load_lds((const unsigned*)(pp_ + 512 + koff[i_]), (LAS unsigned*)(ldsl + (bo) + 16384 + i_ * 8192 + wid * 1024), 16, 0, 0); } } while (0)
#define DQK(P0, P1, bo) do { P0 = (f32x16){}; P1 = (f32x16){}; const unsigned char* Ks_ = lds + (bo) + 16384; \
        _Pragma("unroll") for (int d0 = 0; d0 < 4; ++d0) { const int cb_ = (map * 64 + d0 * 16 + hi * 8) * 2; \
            const bf16x8 b0_ = *(const bf16x8*)(Ks_ + KSWZ(r32, cb_)), b1_ = *(const bf16x8*)(Ks_ + KSWZ(32 + r32, cb_)); \
            P0 = __builtin_amdgcn_mfma_f32_32x32x16_bf16(b0_, qr[d0], P0, 0, 0, 0); \
            P1 = __builtin_amdgcn_mfma_f32_32x32x16_bf16(b1_, qr[d0], P1, 0, 0, 0); } } while (0)
#define DSM(P0, P1) do { _Pragma("unroll") for (int r = 0; r < 16; ++r) { P0[r] = __builtin_amdgcn_exp2f(P0[r]); P1[r] = __builtin_amdgcn_exp2f(P1[r]); lsum += P0[r] + P1[r]; } \
        PK4(P0, 0, pa0); PK4(P0, 8, pa1); PK4(P1, 0, pa2); PK4(P1, 8, pa3); } while (0)
#define DTAIL_() asm volatile("s_waitcnt vmcnt(0)" ::: "memory"); __syncthreads(); { const int t_ = bprev; bprev = bcur; bcur = bnext; bnext = t_; }
#define DSTEP_A(N0, N1, O0, O1, j) do { if ((j) + 1 < NT) DDMA((j) + 1, bnext); \
        DQK(N0, N1, bcur); DSM(O0, O1); pv_d0(o, vbase + bprev, pa0, pa1, pa2, pa3); DTAIL_() } while (0)
#define DSTEP_B(N0, N1, O0, O1, j) do { if ((j) + 1 < NT) DDMA((j) + 1, bnext); \
        DSM(O0, O1); pv_d0(o, vbase + bprev, pa0, pa1, pa2, pa3); SBAR(); DQK(N0, N1, bcur); DTAIL_() } while (0)
        f32x16 pA0, pA1, pB0, pB1; bf16x8 pa0, pa1, pa2, pa3;
        DDMA(0, 0); DDMA(1, 32768); asm volatile("s_waitcnt vmcnt(0)" ::: "memory"); __syncthreads();
        DQK(pA0, pA1, 0);
        int bprev = 0, bcur = 32768, bnext = 65536;
        if (map == 0) {
            for (int j = 1; j + 1 < NT; j += 2) { DSTEP_A(pB0, pB1, pA0, pA1, j); DSTEP_A(pA0, pA1, pB0, pB1, j + 1); }
            DSTEP_A(pB0, pB1, pA0, pA1, NT - 1);
        } else {
            for (int j = 1; j + 1 < NT; j += 2) { DSTEP_B(pB0, pB1, pA0, pA1, j); DSTEP_B(pA0, pA1, pB0, pB1, j + 1); }
            DSTEP_B(pB0, pB1, pA0, pA1, NT - 1);
        }
        DSM(pB0, pB1); pv_d0(o, vbase + bprev, pa0, pa1, pa2, pa3);
        __syncthreads();
#undef DDMA
#undef DQK
#undef DSM
#undef DSTEP_A
#undef DSTEP_B
#undef DTAIL_
        const float lt = halfswap_add(lsum);
        if (hi == 0) li[r32] = lt;
        asm volatile("s_waitcnt lgkmcnt(0)" ::: "memory");
        float rli[16];
#pragma unroll
        for (int r = 0; r < 16; ++r) rli[r] = __builtin_amdgcn_rcpf(li[crow(r, hi)]);
        if (map == 1) {
#pragma unroll
            for (int d0 = 0; d0 < 4; ++d0)
#pragma unroll
                for (int r = 0; r < 16; ++r) X[(wq * 64 + d0 * 16 + r) * 64 + lane] = o[d0][r] * rli[r] * lam;
        }
        __syncthreads();
        if (map == 0) {
#pragma unroll
            for (int d0 = 0; d0 < 4; ++d0)
#pragma unroll
                for (int r = 0; r < 16; ++r) o[d0][r] = o[d0][r] * rli[r] - X[(wq * 64 + d0 * 16 + r) * 64 + lane];
#pragma unroll
            for (int r = 0; r < 16; ++r) {
                float ss = o[0][r] * o[0][r] + o[1][r] * o[1][r] + o[2][r] * o[2][r] + o[3][r] * o[3][r];
                ss += __shfl_xor(ss, 1); ss += __shfl_xor(ss, 2); ss += __shfl_xor(ss, 4); ss += __shfl_xor(ss, 8); ss += __shfl_xor(ss, 16);
                const float rstd = rsqrtf(ss * (1.f / 128.f) + 1e-6f) * 0.8f;
                bf16_t* mp = mix + (size_t)(qrow0 + 32 * wq + crow(r, hi)) * DM + h * 128 + r32;
#pragma unroll
                for (int d0 = 0; d0 < 4; ++d0) mp[32 * d0] = f2bf(o[d0][r] * rstd * p.diff_subln[32 * d0 + r32]);
            }
        }
        __syncthreads();
    }
}

__device__ __forceinline__ void natten_phase(const Params& p, unsigned char* lds) {
    const int tid = threadIdx.x, wid = tid >> 6, lane = tid & 63, r32 = lane & 31, hi = lane >> 5;
    const bf16_t* proj = (const bf16_t*)(p.ws + WS_PROJ);
    bf16_t* mix = (bf16_t*)(p.ws + WS_MIX);
    constexpr float L2E = 1.4426950408889634f;
    unsigned char* Vl = lds; unsigned char* Kl = lds + 32768;
    float* rpbs = (float*)(lds + 65536);
    float* li = (float*)(lds + 133120) + wid * 64;
    unsigned char* Qs = lds + 67584 + wid * 8192 + lane * 16;
    const int sr = tid >> 4, sc = (tid & 15) * 8, vst0 = v_st(sr, sc), vst1 = v_st(32 + sr, sc);
    const int vb0 = (int)(uintptr_t)Vl + v_rd_base(lane);
    const float* gkp = p.na_qk_gain + 128 + sc;
    const int vblk = (gridDim.x % 8 == 0) ? (int)((blockIdx.x & 7) * (gridDim.x >> 3) + (blockIdx.x >> 3)) : (int)blockIdx.x;
    for (int it = vblk; it < 2048; it += gridDim.x) {
        const int b = it >> 8, h = (it >> 5) & 7, rq = it & 31;
        const int grow = 4 * rq + (wid >> 1), qc = (wid & 1) * 32 + r32;
        const size_t qR = (size_t)b * SEQ + grow * 64 + qc;
        for (int i = tid; i < 465; i += NTHREADS) rpbs[i] = p.na_rpb[h * 465 + i] * L2E;
        { float ss = 0.f;
#pragma unroll
          for (int d0 = 0; d0 < 8; ++d0) { float qv[8]; unpack8(*(const bf16x8*)(proj + qR * OD_N + h * 128 + d0 * 16 + hi * 8), qv);
#pragma unroll
              for (int i = 0; i < 8; ++i) ss += qv[i] * qv[i]; }
          ss = halfswap_add(ss);
          const float rs = rsqrtf(ss * (1.f / 128.f) + 1e-6f) * 0.08838834764831845f * L2E;
#pragma unroll
          for (int d0 = 0; d0 < 8; ++d0) { float qv[8]; unpack8(*(const bf16x8*)(proj + qR * OD_N + h * 128 + d0 * 16 + hi * 8), qv);
#pragma unroll
              for (int i = 0; i < 8; ++i) qv[i] *= rs * p.na_qk_gain[d0 * 16 + hi * 8 + i];
              *(bf16x8*)(Qs + d0 * 1024) = pack8(qv); } }
        int lo = 4 * rq - 4; lo = lo < 0 ? 0 : (lo > 120 ? 120 : lo);
        int hi_r = 4 * rq + 3 - 4; hi_r = hi_r < 0 ? 0 : (hi_r > 120 ? 120 : hi_r); hi_r += 7;
        const int nlat = hi_r - lo + 1, NT = nlat + 4;
        int wsr = grow - 4; wsr = wsr < 0 ? 0 : (wsr > 120 ? 120 : wsr);
        int cst = qc - 8; cst = cst < 0 ? 0 : (cst > 48 ? 48 : cst);
        f32x16 o[4] = {}; float lsum = 0.f;
        bf16x8 vs0, vs1, ks0, ks1;
#define NLOAD(j) do { const size_t R0_ = (size_t)((j) < nlat ? b * SEQ + (lo + (j)) * 64 : NLAT + b * CTXL + 64 * ((j) - nlat)) + sr; \
        const bf16_t* pp_ = proj + R0_ * OD_N + h * 128 + sc; \
        vs0 = *(const bf16x8*)(pp_ + 2048); vs1 = *(const bf16x8*)(pp_ + 2048 + (size_t)32 * OD_N); \
        ks0 = *(const bf16x8*)(pp_ + 1024); ks1 = *(const bf16x8*)(pp_ + 1024 + (size_t)32 * OD_N); } while (0)
#define KNORM(kx) do { float f_[8]; unpack8(kx, f_); float ss_ = 0.f; _Pragma("unroll") for (int i_ = 0; i_ < 8; ++i_) ss_ += f_[i_] * f_[i_]; \
        ss_ += __shfl_xor(ss_, 1); ss_ += __shfl_xor(ss_, 2); ss_ += __shfl_xor(ss_, 4); ss_ += __shfl_xor(ss_, 8); \
        const float rs_ = rsqrtf(ss_ * (1.f / 128.f) + 1e-6f); _Pragma("unroll") for (int i_ = 0; i_ < 8; ++i_) f_[i_] *= rs_ * gkp[i_]; kx = pack8(f_); } while (0)
#define NWRITE(bf) do { KNORM(ks0); KNORM(ks1); *(bf16x8*)(Vl + (bf) * 16384 + vst0) = vs0; *(bf16x8*)(Vl + (bf) * 16384 + vst1) = vs1; \
        *(bf16x8*)(Kl + (bf) * 16384 + KSWZ(sr, sc * 2)) = ks0; *(bf16x8*)(Kl + (bf) * 16384 + KSWZ(32 + sr, sc * 2)) = ks1; } while (0)
        NLOAD(0); NWRITE(0); __syncthreads();
        for (int j = 0; j < NT; ++j) {
            if (j + 1 < NT) NLOAD(j + 1);
            const int bf = j & 1;
            const bool islat = j < nlat; const int kr = lo + j;
            const bool active = !islat || (kr >= wsr && kr <= wsr + 7);
            if (active) {
                f32x16 p0 = {}, p1 = {};
                const unsigned char* Ks = Kl + bf * 16384;
#pragma unroll
                for (int d0 = 0; d0 < 8; ++d0) { const int cb = (d0 * 16 + hi * 8) * 2;
                    const bf16x8 b0 = *(const bf16x8*)(Ks + KSWZ(r32, cb)), b1 = *(const bf16x8*)(Ks + KSWZ(32 + r32, cb));
                    const bf16x8 qd = *(const bf16x8*)(Qs + d0 * 1024);
                    p0 = __builtin_amdgcn_mfma_f32_32x32x16_bf16(b0, qd, p0, 0, 0, 0);
                    p1 = __builtin_amdgcn_mfma_f32_32x32x16_bf16(b1, qd, p1, 0, 0, 0); }
                if (islat) {
                    const float* rb = rpbs + (kr - grow + 7) * 31 + 15 - qc + 4 * hi;
                    const int mofs = 4 * hi - cst;
#pragma unroll
                    for (int r = 0; r < 16; ++r) {
                        const int kb = (r & 3) + 8 * (r >> 2);
                        const float e0 = __builtin_amdgcn_exp2f(p0[r] + rb[kb]), e1 = __builtin_amdgcn_exp2f(p1[r] + rb[32 + kb]);
                        p0[r] = ((unsigned)(kb + mofs) < 16u) ? e0 : 0.f; p1[r] = ((unsigned)(32 + kb + mofs) < 16u) ? e1 : 0.f;
                        lsum += p0[r] + p1[r]; }
                } else {
#pragma unroll
                    for (int r = 0; r < 16; ++r) { p0[r] = __builtin_amdgcn_exp2f(p0[r]); p1[r] = __builtin_amdgcn_exp2f(p1[r]); lsum += p0[r] + p1[r]; }
                }
                bf16x8 pa0, pa1, pa2, pa3;
                PK4(p0, 0, pa0); PK4(p0, 8, pa1); PK4(p1, 0, pa2); PK4(p1, 8, pa3);
                pv_d0(o, vb0 + bf * 16384, pa0, pa1, pa2, pa3);
            }
            if (j + 1 < NT) NWRITE((j + 1) & 1);
            __syncthreads();
        }
#undef NLOAD
#undef KNORM
#undef NWRITE
        const float lt = halfswap_add(lsum);
        if (hi == 0) li[r32] = lt;
        asm volatile("s_waitcnt lgkmcnt(0)" ::: "memory");
#pragma unroll
        for (int r = 0; r < 16; ++r) { const float rl = __builtin_amdgcn_rcpf(li[crow(r, hi)]);
            bf16_t* mp = mix + ((size_t)b * SEQ + grow * 64 + (wid & 1) * 32 + crow(r, hi)) * DM + h * 128 + r32;
#pragma unroll
            for (int d0 = 0; d0 < 4; ++d0) mp[32 * d0] = f2bf(o[d0][r] * rl); }
        __syncthreads();
    }
}

#define XB_TMO      128
#define XB_XCNT(j)  (256  + 64 * (j))
#define XB_XSUB(j)  (1280 + 64 * (j))
#define XB_XGEN(j)  (2304 + 64 * (j))
#define XB_TOP      3328
#define XB_TOPGEN   3392
#define XCD_BAR_WORDS 3456
#define XB_SPIN_CAP (1u << 22)
__device__ __forceinline__ unsigned xb_ld(unsigned* p)              { return __hip_atomic_load(p, __ATOMIC_RELAXED, __HIP_MEMORY_SCOPE_AGENT); }
__device__ __forceinline__ unsigned xb_add(unsigned* p, unsigned v) { return __hip_atomic_fetch_add(p, v, __ATOMIC_RELAXED, __HIP_MEMORY_SCOPE_AGENT); }
__device__ __forceinline__ unsigned xb_xcc_id() { return (unsigned)__builtin_amdgcn_s_getreg((3 << 11) | 20) & 0xFu; }
#define XB_SPIN(cond, bar) do { unsigned _sp = 0; while (cond) { __builtin_amdgcn_s_sleep(1); \
    if ((++_sp & 255u) == 0u) { if (xb_ld(&(bar)[XB_TMO])) break; if (_sp > XB_SPIN_CAP) { atomicAdd(&(bar)[XB_TMO], 1u); break; } } } } while (0)
struct XcdBarrier { unsigned* bar; unsigned x; volatile LAS unsigned* st; };
__device__ __forceinline__ XcdBarrier xcd_barrier_post(unsigned* bar, volatile LAS unsigned* st) {
    XcdBarrier b; b.bar = bar; b.x = xb_xcc_id(); b.st = st;
    if (threadIdx.x == 0) (void)xb_add(&bar[XB_XCNT(b.x)], 1u);
    return b;
}
__device__ __forceinline__ void xcd_barrier_complete(unsigned* bar, unsigned x, unsigned& nloc, unsigned& nx) {
    const unsigned G = gridDim.x * gridDim.y * gridDim.z;
    unsigned sum, cnt, mine, sp = 0u;
    for (;;) {
        sum = 0u; cnt = 0u; mine = 0u;
#pragma unroll
        for (unsigned j = 0; j < 16; ++j) { const unsigned c = xb_ld(&bar[XB_XCNT(j)]); sum += c; cnt += (c > 0u) ? 1u : 0u; mine = (j == x) ? c : mine; }
        if (sum == G) break;
        __builtin_amdgcn_s_sleep(1);
        if ((++sp & 255u) == 0u) { if (xb_ld(&bar[XB_TMO])) break; if (sp > XB_SPIN_CAP) { atomicAdd(&bar[XB_TMO], 1u); break; } }
    }
    nloc = mine > 0u ? mine : 1u; nx = cnt > 0u ? cnt : 1u;
}
__device__ __forceinline__ void xcd_barrier(const XcdBarrier& b) {
    asm volatile("s_waitcnt vmcnt(0)" ::: "memory");
    __syncthreads();
    if (threadIdx.x == 0) {
        unsigned* bar = b.bar;
        __builtin_amdgcn_s_waitcnt(0);
        unsigned nloc = b.st[0], nx = b.st[1];
        if (nloc == 0u) { xcd_barrier_complete(bar, b.x, nloc, nx); b.st[0] = nloc; b.st[1] = nx; }
        const unsigned old = xb_add(&bar[XB_XSUB(b.x)], 1u);
        const unsigned gen = old / nloc;
        if (old + 1u == (gen + 1u) * nloc) {
            __builtin_amdgcn_fence(__ATOMIC_RELEASE, "agent");
            asm volatile("s_waitcnt vmcnt(0)" ::: "memory");
            const unsigned og = xb_add(&bar[XB_TOP], 1u);
            const unsigned tg = og / nx;
            if (og + 1u == (tg + 1u) * nx) xb_add(&bar[XB_TOPGEN], 1u);
            else XB_SPIN(xb_ld(&bar[XB_TOPGEN]) == tg, bar);
            __builtin_amdgcn_fence(__ATOMIC_ACQUIRE, "agent");
            xb_add(&bar[XB_XGEN(b.x)], 1u);
            asm volatile("s_waitcnt vmcnt(0)" ::: "memory");
        } else {
            XB_SPIN(xb_ld(&bar[XB_XGEN(b.x)]) == gen, bar);
            __builtin_amdgcn_fence(__ATOMIC_ACQUIRE, "agent");
            asm volatile("s_waitcnt vmcnt(0)" ::: "memory");
        }
    }
    __syncthreads();
}

#ifndef PROBE_REP
#define PROBE_REP 0
#endif
#define REP(k) for (int rep_ = 0; rep_ < (((PROBE_REP >> (k)) & 1) ? 2 : 1); ++rep_)
constexpr int NPH = 18;
__global__ void __launch_bounds__(NTHREADS, 2) fwd_megakernel(Params p) {
    extern __shared__ __attribute__((aligned(16))) unsigned char lds[];
    cg::grid_group grid = cg::this_grid();
    LAS unsigned char* ldsl = (LAS unsigned char*)lds;
    const int lo = p.ph_lo, hi = p.ph_hi;
#ifdef ONLY_PH
#define IN(k) (((ONLY_PH >> (k)) & 1) && lo <= (k) && (k) < hi)
#else
#define IN(k) (lo <= (k) && (k) < hi)
#endif
#define SEAM(k) do { if (IN(k) && IN((k) + 1)) { if ((k) == 0) grid.sync(); else { XcdBarrier xb_; xb_.bar = (unsigned*)(p.ws + WS_BAR); xb_.x = xb_xcc_id(); xb_.st = (volatile LAS unsigned*)(ldsl + 135168); xcd_barrier(xb_); } } } while (0)
    unsigned char* ws = p.ws;
    const bf16_t* H = (const bf16_t*)(ws + WS_H);
    bf16_t* PROJ = (bf16_t*)(ws + WS_PROJ);
    const bf16_t* MIX = (const bf16_t*)(ws + WS_MIX);
    float* CTXRES = (float*)(ws + WS_CTXRES);
    const float* MOD = (const float*)(ws + WS_MOD);
    const int G = gridDim.x, c = blockIdx.x;
    if (threadIdx.x < 4) ((volatile LAS unsigned*)(ldsl + 135168))[threadIdx.x] = 0u;
    __syncthreads();
    (void)xcd_barrier_post((unsigned*)(ws + WS_BAR), (volatile LAS unsigned*)(ldsl + 135168));

    if (IN(0)) REP(0) { ada_phase(p, lds); wconv_phase(p, lds);
        { float* rc = (float*)(ws + WS_ROPE); float* rs = rc + SEQ * 32;
          for (int e = blockIdx.x * NTHREADS + threadIdx.x; e < SEQ * 32; e += gridDim.x * NTHREADS) { const int t = e >> 5, pp = e & 31;
              const float inv = powf(10000.f, -(float)(pp & 15) / 16.f); const float ang = (pp < 16 ? (float)(t >> 6) : (float)(t & 63)) * inv;
              rc[e] = cosf(ang); rs[e] = sinf(ang); } } }
    SEAM(0);
    if (IN(1)) REP(1) norm_phase(p, p.x, p.ctx, 0, 0, MTOT);
    SEAM(1);
    if (IN(2)) REP(2) { pg8::Gemm g{H, (const bf16_t*)(ws + WS_W_EVIN), MTOT, EV_NP, DM}; pg8::StaticOrderT<264, 15> S; S.init(MTOT, EV_NP, G, c);
        pg8::EpiBf16 E{PROJ, EV_NP}; pg8::gemm_phase(ldsl, g, S, E); }
    SEAM(2);
    if (IN(3)) prep0_phase(p);
    SEAM(3);
    if (IN(4)) REP(4) gdn_pre_phase(p, lds);
    SEAM(4);
    if (IN(5)) {
#ifndef SKIP_SCAN
        REP(20) { gdn_scan_phase(p, lds); __syncthreads(); }
#endif
#ifndef SKIP_DA
        REP(5) { diffattn_phase(p, lds); __syncthreads(); }
#endif
    }
    SEAM(5);
    if (IN(6)) REP(6) gdn_post_phase(p);
    SEAM(6);
    if (IN(7)) REP(7) { pg8::Gemm g{MIX, (const bf16_t*)(ws + WS_W_EVOUT), MTOT, DM, DM}; pg8::StaticOrderT<264, 4> S; S.init(MTOT, DM, G, c);
        pg8::EpiResid E{p.x, p.ctx, p.out, CTXRES, MOD, 2048}; pg8::gemm_phase(ldsl, g, S, E); }
    SEAM(7);
    if (IN(8)) norm_phase(p, p.out, CTXRES, 0, 1, MTOT);
    SEAM(8);
    if (IN(9)) REP(9) { pg8::Gemm g{H, (const bf16_t*)(ws + WS_W_FFIN), MTOT, 2 * FF, DM}; pg8::StaticOrderT<264, 22> S; S.init(MTOT, 2 * FF, G, c);
        pg8::EpiSwiglu E{PROJ, FF}; pg8::gemm_phase(ldsl, g, S, E); }
    SEAM(9);
    if (IN(10)) { pg8::Gemm g{PROJ, (const bf16_t*)(ws + WS_W_FFOUT), MTOT, DM, FF}; pg8::StaticOrderT<264, 4> S; S.init(MTOT, DM, G, c);
        pg8::EpiResid E{p.out, CTXRES, p.out, CTXRES, MOD, 5120}; pg8::gemm_phase(ldsl, g, S, E); }
    SEAM(10);
    if (IN(11)) norm_phase(p, p.out, CTXRES, 1, 0, MTOT);
    SEAM(11);
    if (IN(12)) { pg8::Gemm g{H, (const bf16_t*)(ws + WS_W_ODIN), MTOT, OD_N, DM}; pg8::StaticOrderT<264, 12> S; S.init(MTOT, OD_N, G, c);
        pg8::EpiBf16 E{PROJ, OD_N}; pg8::gemm_phase(ldsl, g, S, E); }
    SEAM(12);
    if (IN(13)) { natten_phase(p, lds); if ((PROBE_REP >> 13) & 1) { __syncthreads(); natten_phase(p, lds); } }
    SEAM(13);
    if (IN(14)) { pg8::Gemm g{MIX, (const bf16_t*)(ws + WS_W_ODOUT), NLAT, DM, DM}; pg8::StaticOrderT<256, 4> S; S.init(NLAT, DM, G, c);
        pg8::EpiResid E{p.out, CTXRES, p.out, CTXRES, MOD + 9 * 6144, 2048}; pg8::gemm_phase(ldsl, g, S, E); }
    SEAM(14);
    if (IN(15)) norm_phase(p, p.out, CTXRES, 1, 1, NLAT);
    SEAM(15);
    if (IN(16)) { pg8::Gemm g{H, (const bf16_t*)(ws + WS_W_FFIN) + (size_t)2 * FF * DM, NLAT, 2 * FF, DM}; pg8::StaticOrderT<256, 22> S; S.init(NLAT, 2 * FF, G, c);
        pg8::EpiSwiglu E{PROJ, FF}; pg8::gemm_phase(ldsl, g, S, E); }
    SEAM(16);
    if (IN(17)) { pg8::Gemm g{PROJ, (const bf16_t*)(ws + WS_W_FFOUT) + (size_t)DM * FF, NLAT, DM, FF}; pg8::StaticOrderT<256, 4> S; S.init(NLAT, DM, G, c);
        pg8::EpiResid E{p.out, CTXRES, p.out, CTXRES, MOD + 9 * 6144, 5120}; pg8::gemm_phase(ldsl, g, S, E); }
#undef IN
#undef SEAM
}

extern "C" void kernel_launch(void* const* d_in, const int* in_sizes, int n_in, void* d_out, int out_size, void* d_ws, size_t ws_size, hipStream_t stream) {
    static int grid = 0;
    if (grid == 0) {
        if (n_in != 23 || ws_size < WS_END) { fprintf(stderr, "kernel_launch: n_in %d ws %zu (need %zu)\n", n_in, ws_size, (size_t)WS_END); grid = -1; return; }
        int dev = 0, cus = 0, per_cu = 0;
        hipGetDevice(&dev); hipDeviceGetAttribute(&cus, hipDeviceAttributeMultiprocessorCount, dev);
        if (hipFuncSetAttribute((const void*)fwd_megakernel, hipFuncAttributeMaxDynamicSharedMemorySize, LDS_BYTES) != hipSuccess) { fprintf(stderr, "hipFuncSetAttribute failed\n"); grid = -1; return; }
        if (hipOccupancyMaxActiveBlocksPerMultiprocessor(&per_cu, (const void*)fwd_megakernel, NTHREADS, LDS_BYTES) != hipSuccess || per_cu < 1) per_cu = 1;
        (void)hipGetLastError();
        grid = cus * 1;
    }
    if (grid < 0) return;
    if (hipMemsetAsync((char*)d_ws + WS_BAR, 0, 16384, stream) != hipSuccess) { fprintf(stderr, "memset failed\n"); return; }
    Params p{};
    const float** pp = (const float**)&p;
    for (int i = 0; i < 23; ++i) pp[i] = (const float*)d_in[i];
    p.out = (float*)d_out; p.ws = (unsigned char*)d_ws;
#if N_LAUNCH_MODE == 1
    p.ph_lo = 0; p.ph_hi = NPH;
    void* args[] = {&p};
    hipError_t e = hipLaunchCooperativeKernel((void*)fwd_megakernel, dim3(grid), dim3(NTHREADS), args, LDS_BYTES, stream);
    if (e != hipSuccess) fprintf(stderr, "cooperative launch failed: %s (grid %d)\n", hipGetErrorString(e), grid);
#else
    for (int k = 0; k < NPH; ++k) { p.ph_lo = k; p.ph_hi = k + 1;
        hipLaunchKernelGGL(fwd_megakernel, dim3(grid), dim3(NTHREADS), LDS_BYTES, stream, p); }
#endif
}
```

```cpp
#include <hip/hip_runtime.h>
#include <hip/hip_cooperative_groups.h>
#include <cstdio>
#include <cstdint>
namespace cg = cooperative_groups;

#define LAS __attribute__((address_space(3)))
typedef unsigned short bf16_t;
typedef short bf16x8 __attribute__((ext_vector_type(8)));
typedef short s16x4 __attribute__((ext_vector_type(4)));
typedef float f32x4 __attribute__((ext_vector_type(4)));
typedef float f32x16 __attribute__((ext_vector_type(16)));
typedef unsigned u32x4 __attribute__((ext_vector_type(4)));
typedef unsigned u32x2 __attribute__((ext_vector_type(2)));

#ifndef N_LAUNCH_MODE
#define N_LAUNCH_MODE 1
#endif

constexpr int DM = 1024, NLAT = 65536, NCTX = 2048, MTOT = NLAT + NCTX, SEQ = 8192, CTXL = 256, FF = 2816;
constexpr int EV_N = 3600, EV_NP = 3840, OD_N = 3072;
constexpr int NCHUNKP = 64 * 132;
constexpr int NTHREADS = 512;
constexpr int LDS_BYTES = 135168 + 16;

constexpr size_t al256(size_t x) { return (x + 255) / 256 * 256; }
constexpr size_t WS_W_EVIN = 0;
constexpr size_t WS_W_EVOUT = WS_W_EVIN + al256((size_t)EV_NP * DM * 2);
constexpr size_t WS_W_ODIN = WS_W_EVOUT + al256((size_t)DM * DM * 2);
constexpr size_t WS_W_ODOUT = WS_W_ODIN + al256((size_t)OD_N * DM * 2);
constexpr size_t WS_W_FFIN = WS_W_ODOUT + al256((size_t)DM * DM * 2);
constexpr size_t WS_W_FFOUT = WS_W_FFIN + al256((size_t)2 * 2 * FF * DM * 2);
constexpr size_t WS_MOD = WS_W_FFOUT + al256((size_t)2 * DM * FF * 2);
constexpr size_t WS_H = WS_MOD + al256((size_t)2 * 9 * 6144 * 4);
constexpr size_t WS_PROJ = WS_H + al256((size_t)MTOT * DM * 2);
constexpr size_t WS_MIX = WS_PROJ + al256((size_t)MTOT * EV_NP * 2);
constexpr size_t WS_T = WS_MIX + al256((size_t)MTOT * DM * 2);
constexpr size_t WS_AQK = WS_T + al256((size_t)NCHUNKP * 4096 * 2);
constexpr size_t WS_GV = WS_AQK + al256((size_t)NCHUNKP * 4096 * 2);
constexpr size_t WS_BV = WS_GV + al256((size_t)NCHUNKP * 64 * 4);
constexpr size_t WS_EL = WS_BV + al256((size_t)NCHUNKP * 64 * 4);
constexpr size_t WS_GATES = WS_EL + al256((size_t)NCHUNKP * 64 * 4);
constexpr size_t WS_CTXRES = WS_GATES + al256((size_t)MTOT * 16 * 4);
constexpr size_t WS_BAR = WS_CTXRES + al256((size_t)NCTX * DM * 4);
constexpr size_t WS_ROPE = WS_BAR + 16384;
constexpr size_t WS_END = WS_ROPE + (size_t)2 * SEQ * 32 * 4;

struct Params {
    const float *x, *c, *ctx, *c_ctx, *ada_w, *ada_b, *norm_mix, *norm_ffn, *ffn_w_in, *ffn_w_out, *even_w_in, *even_w_out,
        *diff_qk_gain, *diff_lambda, *diff_subln, *gdn_conv, *gdn_a_log, *gdn_dt_bias, *gdn_norm, *odd_w_in, *odd_w_out, *na_qk_gain, *na_rpb;
    float* out; unsigned char* ws; int ph_lo, ph_hi;
};

__device__ __forceinline__ float bf2f(bf16_t b) { return __uint_as_float(((unsigned)b) << 16); }
__device__ __forceinline__ bf16_t f2bf(float f) { unsigned u = __float_as_uint(f); u += 0x7FFFu + ((u >> 16) & 1u); return (bf16_t)(u >> 16); }
__device__ __forceinline__ unsigned cvtpk(float lo, float hi) { unsigned r; asm volatile("v_cvt_pk_bf16_f32 %0, %1, %2" : "=v"(r) : "v"(lo), "v"(hi)); return r; }
__device__ __forceinline__ float siluf(float v) { return v / (1.f + __expf(-v)); }
__device__ __forceinline__ void unpack8(bf16x8 v, float* f) {
#pragma unroll
    for (int i = 0; i < 8; ++i) f[i] = bf2f((bf16_t)v[i]);
}
__device__ __forceinline__ bf16x8 pack8(const float* f) {
    u32x4 w = {cvtpk(f[0], f[1]), cvtpk(f[2], f[3]), cvtpk(f[4], f[5]), cvtpk(f[6], f[7])};
    return *reinterpret_cast<bf16x8*>(&w);
}

namespace pg8 {
constexpr int BM = 256, BK = 64, HALF = 128, HTB = HALF * BK * 2, STAGE_BYTES = 8 * HTB, NXCD = 8, WGM = 8;
__host__ __device__ __forceinline__ int lds_byte(int r, int c) { const int st = (r >> 4) * 2 + (c >> 5), rr = r & 15, cc = c & 31, ob = rr * 64 + cc * 2; return st * 1024 + (ob ^ (((ob >> 9) & 1) << 5)); }
__host__ __device__ __forceinline__ void stage_rc(int b, int& R, int& C) { const int st = b / 1024, sb = b % 1024, swz = sb ^ (((sb >> 9) & 1) << 5); R = (st >> 1) * 16 + swz / 64; C = (st & 1) * 32 + (swz % 64) / 2; }
__host__ __device__ __forceinline__ int perm32(int rho) { const int n = rho >> 4, i = rho & 15; return 8 * (i >> 2) + 4 * n + (i & 3); }
struct Unit { int pm, pn; };
struct Gemm { const bf16_t* A; const bf16_t* Bt; int M, N, K; };
template <int NM, int NN> struct StaticOrderT {
    static_assert(NM % WGM == 0, "row tiles in whole groups");
    int G, c;
    __device__ void init(int, int, int G_, int c_) { G = G_; c = c_; }
    __device__ bool next(int i, Unit& u) const {
        constexpr int nwg = NM * NN, q = nwg / NXCD, r = nwg % NXCD, nig = WGM * NN;
        const int L = i * G + c; if (L >= nwg) return false;
        const int xcd = L % NXCD, off = L / NXCD;
        const int wgid = (xcd < r ? xcd * (q + 1) : r * (q + 1) + (xcd - r) * q) + off;
        const int gid = wgid / nig, w = wgid % nig;
        u.pm = gid * WGM + (w % WGM); u.pn = w / WGM; return true;
    }
};
struct EpiBf16 {
    static constexpr bool PERM = true;
    bf16_t* O; int ldc;
    __device__ __forceinline__ void operator()(const f32x4 (&acc)[2][2][4][2], const Unit& u, int wr, int wc, int fr, int fq) const {
        const int row0 = u.pm * BM + wr * 64 + fr; const int col0 = u.pn * BM + wc * 32 + 8 * fq;
#pragma unroll
        for (int ai = 0; ai < 2; ++ai)
#pragma unroll
            for (int m = 0; m < 4; ++m) { bf16_t* rowp = O + (size_t)(row0 + ai * HALF + m * 16) * ldc + col0;
#pragma unroll
                for (int bj = 0; bj < 2; ++bj) { const f32x4 v0 = acc[ai][bj][m][0], v1 = acc[ai][bj][m][1];
                    u32x4 w; w.x = cvtpk(v0[0], v0[1]); w.y = cvtpk(v0[2], v0[3]); w.z = cvtpk(v1[0], v1[1]); w.w = cvtpk(v1[2], v1[3]);
                    *(u32x4*)(rowp + bj * HALF) = w; } }
    }
};
struct EpiSwiglu {
    static constexpr bool PERM = true;
    bf16_t* O; int ldc;
    __device__ __forceinline__ void operator()(const f32x4 (&acc)[2][2][4][2], const Unit& u, int wr, int wc, int fr, int fq) const {
        const int row0 = u.pm * BM + wr * 64 + fr; const int col0 = u.pn * HALF + wc * 32 + 8 * fq;
#pragma unroll
        for (int ai = 0; ai < 2; ++ai)
#pragma unroll
            for (int m = 0; m < 4; ++m) { bf16_t* rowp = O + (size_t)(row0 + ai * HALF + m * 16) * ldc + col0;
                float o[8];
#pragma unroll
                for (int n = 0; n < 2; ++n)
#pragma unroll
                    for (int j = 0; j < 4; ++j) { const float g = acc[ai][0][m][n][j], up = acc[ai][1][m][n][j]; o[n * 4 + j] = g * __builtin_amdgcn_rcpf(1.f + __expf(-g)) * up; }
                u32x4 w; w.x = cvtpk(o[0], o[1]); w.y = cvtpk(o[2], o[3]); w.z = cvtpk(o[4], o[5]); w.w = cvtpk(o[6], o[7]);
                *(u32x4*)rowp = w; }
    }
};
struct EpiResid {
    static constexpr bool PERM = false;
    const float* resLat; const float* resCtx; float* outLat; float* outCtx; const float* modl; int goff;
    __device__ __forceinline__ void operator()(const f32x4 (&acc)[2][2][4][2], const Unit& u, int wr, int wc, int fr, int fq) const {
        const int rowt = u.pm * BM; const bool lat = rowt < NLAT;
        const float* res = lat ? resLat + (size_t)rowt * DM : resCtx + (size_t)(rowt - NLAT) * DM;
        float* out = lat ? outLat + (size_t)rowt * DM : outCtx + (size_t)(rowt - NLAT) * DM;
        const float* gate = modl + (size_t)(lat ? (rowt >> 13) : 8) * 6144 + goff;
        const int row0 = wr * 64 + fr, col0 = u.pn * BM + wc * 32 + 4 * fq;
        f32x4 gv[2][2];
#pragma unroll
        for (int bj = 0; bj < 2; ++bj)
#pragma unroll
            for (int n = 0; n < 2; ++n) gv[bj][n] = *(const f32x4*)(gate + col0 + bj * HALF + n * 16);
#pragma unroll
        for (int ai = 0; ai < 2; ++ai)
#pragma unroll
            for (int mp = 0; mp < 4; mp += 2) {
                f32x4 r[2][2][2];
#pragma unroll
                for (int mm = 0; mm < 2; ++mm)
#pragma unroll
                    for (int bj = 0; bj < 2; ++bj)
#pragma unroll
                        for (int n = 0; n < 2; ++n) r[mm][bj][n] = *(const f32x4*)(res + (size_t)(row0 + ai * HALF + (mp + mm) * 16) * DM + col0 + bj * HALF + n * 16);
#pragma unroll
                for (int mm = 0; mm < 2; ++mm)
#pragma unroll
                    for (int bj = 0; bj < 2; ++bj)
#pragma unroll
                        for (int n = 0; n < 2; ++n) *(f32x4*)(out + (size_t)(row0 + ai * HALF + (mp + mm) * 16) * DM + col0 + bj * HALF + n * 16) = r[mm][bj][n] + gv[bj][n] * acc[ai][bj][mp + mm][n];
            }
    }
};

template <class Epi, class Sched>
__device__ __forceinline__ void gemm_phase(LAS unsigned char* lds, const Gemm g, const Sched& S, const Epi& E) {
    const int tid = threadIdx.x, wid = __builtin_amdgcn_readfirstlane(tid >> 6), lane = tid & 63, wr = wid >> 2, wc = wid & 3, fr = lane & 15, fq = lane >> 4;
    const int K = g.K, nt = K / BK;
    unsigned voffA[2], voffB[2];
#pragma unroll
    for (int i = 0; i < 2; ++i) { int R, C; stage_rc(tid * 16 + i * 8192, R, C); const int Rb = Epi::PERM ? ((R & ~31) + perm32(R & 31)) : R;
        voffA[i] = (unsigned)(R * K + C) * 2u; voffB[i] = (unsigned)(Rb * K + C) * 2u; }
    const size_t kstep = (size_t)(BK * 2);
    const size_t hstep = (size_t)HALF * K * 2;
    const size_t tstep = 2 * hstep;
    const unsigned ldsw = (unsigned)wid * 1024u;
    const int aoff = lds_byte(wr * 64 + fr, fq * 8), boff = lds_byte(wc * 32 + fr, fq * 8);
#define PG8_SA(b, h) (((b) * 2 + (h)) * HTB)
#define PG8_SB(b, h) ((4 + (b) * 2 + (h)) * HTB)
#define PG8_STAGE(bufoff, gbase, voff) do { _Pragma("unroll") for (int _i = 0; _i < 2; ++_i) \
        __builtin_amdgcn_global_load_lds((const unsigned*)((const char*)(gbase) + (voff)[_i]), (LAS unsigned*)(lds + (bufoff) + ldsw + _i * 8192), 16, 0, 0); } while (0)
#define PG8_LDA(dst, b, h) do { _Pragma("unroll") for (int m = 0; m < 4; ++m) _Pragma("unroll") for (int k = 0; k < 2; ++k) dst[m][k] = *(const LAS bf16x8*)(lds + PG8_SA(b, h) + aoff + m * 2048 + k * 1024); } while (0)
#define PG8_LDB(dst, b, h) do { _Pragma("unroll") for (int n = 0; n < 2; ++n) _Pragma("unroll") for (int k = 0; k < 2; ++k) dst[n][k] = *(const LAS bf16x8*)(lds + PG8_SB(b, h) + boff + n * 2048 + k * 1024); } while (0)
#define PG8_MMA(ai, bj, At, Bt) do { __builtin_amdgcn_s_setprio(1); _Pragma("unroll") for (int m = 0; m < 4; ++m) _Pragma("unroll") for (int n = 0; n < 2; ++n) _Pragma("unroll") for (int k = 0; k < 2; ++k) \
        acc[ai][bj][m][n] = __builtin_amdgcn_mfma_f32_16x16x32_bf16(Bt[n][k], At[m][k], acc[ai][bj][m][n], 0, 0, 0); __builtin_amdgcn_s_setprio(0); } while (0)
#define PG8_WAIT_V(n) asm volatile("s_waitcnt vmcnt(" #n ")" ::: "memory")
#define PG8_WAIT_L(n) asm volatile("s_waitcnt lgkmcnt(" #n ")" ::: "memory")
#define PG8_BAR __builtin_amdgcn_s_barrier()
#define PG8_SCHED __builtin_amdgcn_sched_barrier(0)
    Unit cur, nxt; int ui = 0;
    if (!S.next(0, cur)) return;
    f32x4 acc[2][2][4][2];
#pragma unroll
    for (int a = 0; a < 2; ++a)
#pragma unroll
        for (int b = 0; b < 2; ++b)
#pragma unroll
            for (int m = 0; m < 4; ++m)
#pragma unroll
                for (int n = 0; n < 2; ++n) acc[a][b][m][n] = (f32x4){0.f, 0.f, 0.f, 0.f};
    bf16x8 At[4][2], B0[2][2], B1[2][2];
    const char* cA = (const char*)g.A + (size_t)cur.pm * tstep; const char* cB = (const char*)g.Bt + (size_t)cur.pn * tstep;
    PG8_STAGE(PG8_SB(0, 0), cB, voffB); PG8_STAGE(PG8_SA(0, 0), cA, voffA); PG8_STAGE(PG8_SB(0, 1), cB + hstep, voffB); PG8_STAGE(PG8_SA(0, 1), cA + hstep, voffA);
    if (wr == 1) PG8_BAR;
    PG8_WAIT_V(4); PG8_BAR;
    PG8_STAGE(PG8_SB(1, 0), cB + kstep, voffB); PG8_STAGE(PG8_SA(1, 0), cA + kstep, voffA); PG8_STAGE(PG8_SB(1, 1), cB + hstep + kstep, voffB);
    PG8_WAIT_V(6); PG8_BAR;
    for (;;) {
        const bool has_next = S.next(ui + 1, nxt);
        const char* nA = has_next ? (const char*)g.A + (size_t)nxt.pm * tstep : cA; const char* nB = has_next ? (const char*)g.Bt + (size_t)nxt.pn * tstep : cB;
        for (int t = 0; t < nt; t += 2) {
            const bool last = (t == nt - 2);
            const char* a1 = cA + (size_t)(t + 1) * kstep;
            const char* a2 = last ? nA : cA + (size_t)(t + 2) * kstep; const char* b2 = last ? nB : cB + (size_t)(t + 2) * kstep;
            const char* a3 = a2 + kstep; const char* b3 = b2 + kstep;
            PG8_LDB(B0, 0, 0); PG8_SCHED; PG8_LDA(At, 0, 0); PG8_STAGE(PG8_SA(1, 1), a1 + hstep, voffA);
            PG8_WAIT_L(8); PG8_BAR; PG8_WAIT_L(0); PG8_MMA(0, 0, At, B0); PG8_BAR; PG8_SCHED;
            PG8_LDB(B1, 0, 1); PG8_STAGE(PG8_SB(0, 0), b2, voffB);
            PG8_BAR; PG8_WAIT_L(0); PG8_MMA(0, 1, At, B1); PG8_BAR;
            PG8_LDA(At, 0, 1); PG8_STAGE(PG8_SA(0, 0), a2, voffA);
            PG8_BAR; PG8_WAIT_L(0); PG8_MMA(1, 0, At, B0); PG8_BAR; PG8_SCHED;
            PG8_STAGE(PG8_SB(0, 1), b2 + hstep, voffB);
            PG8_WAIT_V(6); PG8_BAR; PG8_MMA(1, 1, At, B1); PG8_BAR;
            PG8_LDB(B0, 1, 0); PG8_SCHED; PG8_LDA(At, 1, 0); PG8_STAGE(PG8_SA(0, 1), a2 + hstep, voffA);
            PG8_WAIT_L(8); PG8_BAR; PG8_WAIT_L(0); PG8_MMA(0, 0, At, B0); PG8_BAR; PG8_SCHED;
            PG8_LDB(B1, 1, 1); PG8_STAGE(PG8_SB(1, 0), b3, voffB);
            PG8_BAR; PG8_WAIT_L(0); PG8_MMA(0, 1, At, B1); PG8_BAR;
            PG8_LDA(At, 1, 1); PG8_STAGE(PG8_SA(1, 0), a3, voffA);
            PG8_BAR; PG8_WAIT_L(0); PG8_MMA(1, 0, At, B0); PG8_BAR; PG8_SCHED;
            PG8_STAGE(PG8_SB(1, 1), b3 + hstep, voffB);
            PG8_WAIT_V(6); PG8_BAR; PG8_MMA(1, 1, At, B1); PG8_BAR;
        }
        E(acc, cur, wr, wc, fr, fq);
        if (!has_next) break;
#pragma unroll
        for (int a = 0; a < 2; ++a)
#pragma unroll
            for (int b = 0; b < 2; ++b)
#pragma unroll
                for (int m = 0; m < 4; ++m)
#pragma unroll
                    for (int n = 0; n < 2; ++n) acc[a][b][m][n] = (f32x4){0.f, 0.f, 0.f, 0.f};
        cur = nxt; cA = nA; cB = nB; ++ui;
    }
    PG8_WAIT_V(0);
    if (wr == 0) PG8_BAR;
    PG8_BAR;
#undef PG8_SA
#undef PG8_SB
#undef PG8_STAGE
#undef PG8_LDA
#undef PG8_LDB
#undef PG8_MMA
#undef PG8_WAIT_V
#undef PG8_WAIT_L
#undef PG8_BAR
#undef PG8_SCHED
}
}

#define KSWZ(row, colB) ((row) * 256 + ((colB) ^ (((row) & 7) << 4)))
#define SBAR() __builtin_amdgcn_sched_barrier(0)
__device__ __forceinline__ int crow(int r, int hi) { return (r & 3) + 8 * (r >> 2) + 4 * hi; }
__device__ __forceinline__ int v_st(int k, int c) { const int kk = (k & ~0xC) | ((k & 4) << 1) | ((k & 8) >> 1); return ((kk >> 3) * 4 + (c >> 5)) * 512 + ((kk & 7) * 32 + (c & 31)) * 2; }
__device__ __forceinline__ int v_rd_base(int lane) { return ((lane & 3) << 3) | (((lane >> 2) & 3) << 6) | (((lane >> 4) & 1) << 5) | (((lane >> 5) & 1) << 8); }
constexpr int v_rd_off(int d0, int ks, int half) { return d0 * 512 + ks * 4096 + half * 2048; }
template <int OFF> __device__ __forceinline__ s16x4 tr_read(int vb) {
    s16x4 r; asm volatile("ds_read_b64_tr_b16 %0, %1 offset:%2" : "=&v"(r) : "v"(vb), "i"(OFF) : "memory"); return r;
}
template <int D0> __device__ __forceinline__ void pv_one(f32x16& od, int vb, bf16x8 pa0, bf16x8 pa1, bf16x8 pa2, bf16x8 pa3) {
    const s16x4 l0 = tr_read<v_rd_off(D0, 0, 0)>(vb), h0 = tr_read<v_rd_off(D0, 0, 1)>(vb), l1 = tr_read<v_rd_off(D0, 1, 0)>(vb), h1 = tr_read<v_rd_off(D0, 1, 1)>(vb);
    const s16x4 l2 = tr_read<v_rd_off(D0, 2, 0)>(vb), h2 = tr_read<v_rd_off(D0, 2, 1)>(vb), l3 = tr_read<v_rd_off(D0, 3, 0)>(vb), h3 = tr_read<v_rd_off(D0, 3, 1)>(vb);
    asm volatile("s_waitcnt lgkmcnt(0)" ::: "memory"); SBAR();
#define PK(L, H) (bf16x8){L[0], L[1], L[2], L[3], H[0], H[1], H[2], H[3]}
    od = __builtin_amdgcn_mfma_f32_32x32x16_bf16(pa0, PK(l0, h0), od, 0, 0, 0);
    od = __builtin_amdgcn_mfma_f32_32x32x16_bf16(pa1, PK(l1, h1), od, 0, 0, 0);
    od = __builtin_amdgcn_mfma_f32_32x32x16_bf16(pa2, PK(l2, h2), od, 0, 0, 0);
    od = __builtin_amdgcn_mfma_f32_32x32x16_bf16(pa3, PK(l3, h3), od, 0, 0, 0);
#undef PK
}
__device__ __forceinline__ void pv_d0(f32x16* o, int vb, bf16x8 pa0, bf16x8 pa1, bf16x8 pa2, bf16x8 pa3) {
    pv_one<0>(o[0], vb, pa0, pa1, pa2, pa3); pv_one<1>(o[1], vb, pa0, pa1, pa2, pa3); pv_one<2>(o[2], vb, pa0, pa1, pa2, pa3); pv_one<3>(o[3], vb, pa0, pa1, pa2, pa3);
}
#define PK4(P, BASE, OUT) do { unsigned a0 = cvtpk(P[BASE + 0], P[BASE + 1]), a1 = cvtpk(P[BASE + 2], P[BASE + 3]);   \
    unsigned b0 = cvtpk(P[BASE + 4], P[BASE + 5]), b1 = cvtpk(P[BASE + 6], P[BASE + 7]);                              \
    auto r0 = __builtin_amdgcn_permlane32_swap(a0, b0, false, false); auto r1 = __builtin_amdgcn_permlane32_swap(a1, b1, false, false); \
    u32x4 w = {r0[0], r1[0], r0[1], r1[1]}; OUT = *reinterpret_cast<bf16x8*>(&w); } while (0)
__device__ __forceinline__ float halfswap_add(float v) {
    auto rr = __builtin_amdgcn_permlane32_swap(__float_as_uint(v), __float_as_uint(v), false, false);
    return __uint_as_float(rr[0]) + __uint_as_float(rr[1]);
}

__device__ __forceinline__ void ada_phase(const Params& p, unsigned char* lds) {
    float* sc = (float*)lds;
    float* red = (float*)(lds + 40960);
    float* mod = (float*)(p.ws + WS_MOD);
    const int tid = threadIdx.x;
    for (int j = blockIdx.x; j < 192; j += gridDim.x) {
        const int l = j / 96, n0 = (j % 96) * 64;
        for (int i = tid; i < 9 * 1024; i += NTHREADS) { const int r = i >> 10, k = i & 1023; const float v = r < 8 ? p.c[r * 1024 + k] : p.c_ctx[k]; sc[i] = v / (1.f + expf(-v)); }
        __syncthreads();
        const int col = tid & 63, ks = tid >> 6;
        float acc[9];
#pragma unroll
        for (int r = 0; r < 9; ++r) acc[r] = 0.f;
        const float* wp = p.ada_w + ((size_t)l * 1024 + ks * 128) * 6144 + n0 + col;
#pragma unroll 8
        for (int kk = 0; kk < 128; ++kk) { const float w = wp[(size_t)kk * 6144];
#pragma unroll
            for (int r = 0; r < 9; ++r) acc[r] += sc[r * 1024 + ks * 128 + kk] * w; }
#pragma unroll
        for (int r = 0; r < 9; ++r) red[(ks * 9 + r) * 64 + col] = acc[r];
        __syncthreads();
        for (int i = tid; i < 576; i += NTHREADS) { const int r = i >> 6, cc = i & 63; float s = p.ada_b[l * 6144 + n0 + cc];
            for (int k2 = 0; k2 < 8; ++k2) s += red[(k2 * 9 + r) * 64 + cc];
            mod[(size_t)(l * 9 + r) * 6144 + n0 + cc] = s; }
        __syncthreads();
    }
}
__device__ __forceinline__ void wconv_phase(const Params& p, unsigned char* lds) {
    float* tl = (float*)lds;
    const int tid = threadIdx.x;
    const int T0 = 16 * 60, T1 = T0 + 16 * 16, T2 = T1 + 16 * 48, T3 = T2 + 16 * 16, T4 = T3 + 16 * 88, T5 = T4 + 16 * 88, T6 = T5 + 44 * 16, T7 = T6 + 44 * 16;
#define WC_DECODE(t) \
        const float* src; bf16_t* dst; int K, N, NP, mode = 0, tt; \
        if ((t) < T0) { src = p.even_w_in; dst = (bf16_t*)(p.ws + WS_W_EVIN); K = 1024; N = EV_N; NP = EV_NP; tt = (t); } \
        else if ((t) < T1) { src = p.even_w_out; dst = (bf16_t*)(p.ws + WS_W_EVOUT); K = 1024; N = 1024; NP = 1024; tt = (t) - T0; } \
        else if ((t) < T2) { src = p.odd_w_in; dst = (bf16_t*)(p.ws + WS_W_ODIN); K = 1024; N = OD_N; NP = OD_N; tt = (t) - T1; } \
        else if ((t) < T3) { src = p.odd_w_out; dst = (bf16_t*)(p.ws + WS_W_ODOUT); K = 1024; N = 1024; NP = 1024; tt = (t) - T2; } \
        else if ((t) < T4) { src = p.ffn_w_in; dst = (bf16_t*)(p.ws + WS_W_FFIN); K = 1024; N = 2 * FF; NP = 2 * FF; mode = 1; tt = (t) - T3; } \
        else if ((t) < T5) { src = p.ffn_w_in + (size_t)1024 * 2 * FF; dst = (bf16_t*)(p.ws + WS_W_FFIN) + (size_t)2 * FF * 1024; K = 1024; N = 2 * FF; NP = 2 * FF; mode = 1; tt = (t) - T4; } \
        else if ((t) < T6) { src = p.ffn_w_out; dst = (bf16_t*)(p.ws + WS_W_FFOUT); K = FF; N = 1024; NP = 1024; tt = (t) - T5; } \
        else { src = p.ffn_w_out + (size_t)FF * 1024; dst = (bf16_t*)(p.ws + WS_W_FFOUT) + (size_t)1024 * FF; K = FF; N = 1024; NP = 1024; tt = (t) - T6; } \
        const int nnt = NP / 64; const int k0 = (tt / nnt) * 64, n0 = (tt % nnt) * 64; \
        int sn0; if (mode == 1) { const int tb = n0 >> 8, bj = (n0 >> 7) & 1, i0 = n0 & 127; sn0 = bj * FF + tb * 128 + i0; } else sn0 = n0;
    float rg[8];
#define WC_LOAD(t) do { WC_DECODE(t) (void)dst; _Pragma("unroll") for (int i = 0; i < 8; ++i) { const int e = tid + NTHREADS * i, kk = e >> 6, nn = e & 63; const int sn = sn0 + nn; \
        rg[i] = (sn < N) ? src[(size_t)(k0 + kk) * N + sn] : 0.f; } } while (0)
    int t = blockIdx.x;
    if (t < T7) WC_LOAD(t);
    for (; t < T7; t += gridDim.x) {
#pragma unroll
        for (int i = 0; i < 8; ++i) { const int e = tid + NTHREADS * i; tl[(e >> 6) * 65 + (e & 63)] = rg[i]; }
        __syncthreads();
        { WC_DECODE(t) (void)src; (void)N; (void)sn0;
          if (t + (int)gridDim.x < T7) WC_LOAD(t + (int)gridDim.x);
          for (int e = tid; e < 2048; e += NTHREADS) { const int nn = e >> 5, k2 = (e & 31) * 2;
              *(unsigned*)(dst + (size_t)(n0 + nn) * K + k0 + k2) = cvtpk(tl[k2 * 65 + nn], tl[(k2 + 1) * 65 + nn]); } }
        __syncthreads();
    }
#undef WC_DECODE
#undef WC_LOAD
}

__device__ __forceinline__ void norm_phase(const Params& p, const float* xlat, const float* xctx, int l, int which, int nrows) {
    const int lane = threadIdx.x & 63, wid = threadIdx.x >> 6;
    bf16_t* h = (bf16_t*)(p.ws + WS_H);
    const float* mod = (const float*)(p.ws + WS_MOD) + (size_t)l * 9 * 6144;
    const float* gain = (which ? p.norm_ffn : p.norm_mix) + l * 1024;
    const int shoff = which ? 3072 : 0, scoff = which ? 4096 : 1024;
    const int stride = gridDim.x * 8;
    f32x4 gn[4];
#pragma unroll
    for (int i = 0; i < 4; ++i) gn[i] = *(const f32x4*)(gain + lane * 4 + 256 * i);
    for (int row = blockIdx.x * 8 + wid; row < nrows; row += 2 * stride) {
        const int rowB = row + stride; const bool hasB = rowB < nrows; const int rB = hasB ? rowB : row;
        const float* srcA = row < NLAT ? xlat + (size_t)row * DM : xctx + (size_t)(row - NLAT) * DM;
        const float* srcB = rB < NLAT ? xlat + (size_t)rB * DM : xctx + (size_t)(rB - NLAT) * DM;
        const float* mrA = mod + (size_t)(row < NLAT ? (row >> 13) : 8) * 6144;
        const float* mrB = mod + (size_t)(rB < NLAT ? (rB >> 13) : 8) * 6144;
        f32x4 va[4], vb[4], sa[4], ha[4], sb[4], hb[4];
#pragma unroll
        for (int i = 0; i < 4; ++i) { const int c0 = lane * 4 + 256 * i;
            va[i] = *(const f32x4*)(srcA + c0); vb[i] = *(const f32x4*)(srcB + c0);
            sa[i] = *(const f32x4*)(mrA + scoff + c0); ha[i] = *(const f32x4*)(mrA + shoff + c0);
            sb[i] = *(const f32x4*)(mrB + scoff + c0); hb[i] = *(const f32x4*)(mrB + shoff + c0); }
#pragma unroll
        for (int rr = 0; rr < 2; ++rr) {
            if (rr == 1 && !hasB) break;
            const int r = rr ? rowB : row;
            float ss = 0.f;
#pragma unroll
            for (int i = 0; i < 4; ++i) { const f32x4 v = rr ? vb[i] : va[i]; ss += v[0] * v[0] + v[1] * v[1] + v[2] * v[2] + v[3] * v[3]; }
#pragma unroll
            for (int o = 1; o < 64; o <<= 1) ss += __shfl_xor(ss, o);
            const float rstd = rsqrtf(ss * (1.f / 1024.f) + 1e-6f);
#pragma unroll
            for (int i = 0; i < 4; ++i) { const int c0 = lane * 4 + 256 * i; const f32x4 v = rr ? vb[i] : va[i], s1 = rr ? sb[i] : sa[i], sh = rr ? hb[i] : ha[i];
                float y[4];
#pragma unroll
                for (int j = 0; j < 4; ++j) y[j] = v[j] * rstd * gn[i][j] * (1.f + s1[j]) + sh[j];
                u32x2 w; w.x = cvtpk(y[0], y[1]); w.y = cvtpk(y[2], y[3]);
                *(u32x2*)(h + (size_t)r * DM + c0) = w; }
        }
    }
}

__device__ __forceinline__ void prep0_phase(const Params& p) {
    const int lane0 = threadIdx.x & 63, wid = threadIdx.x >> 6;
    bf16_t* proj = (bf16_t*)(p.ws + WS_PROJ);
    bf16_t* qkvp = (bf16_t*)p.out;
    float* gbuf = (float*)(p.ws + WS_GATES);
    const float* ropec = (const float*)(p.ws + WS_ROPE); const float* ropes = ropec + SEQ * 32;
    constexpr int RB = 8;
    for (int blk = blockIdx.x * 8 + wid; blk < MTOT / RB; blk += gridDim.x * 8) {
        int lane = lane0; asm volatile("" : "+v"(lane));
        const int row0 = blk * RB; const bool lat = row0 < NLAT; const int t0 = lat ? (row0 & 8191) : ((row0 - NLAT) & 255); const int len = lat ? SEQ : CTXL;
        const int dsub = (lane & 7) * 8;
        {
            float gq[8], gk[8];
#pragma unroll
            for (int i = 0; i < 8; ++i) { gq[i] = p.diff_qk_gain[dsub + i] * (0.125f * 1.4426950408889634f); gk[i] = p.diff_qk_gain[64 + dsub + i]; }
#pragma unroll
            for (int i0 = 0; i0 < RB; i0 += 4) {
                bf16x8 raw[4][2]; f32x4 c4[4], s4[4];
#pragma unroll
                for (int i = 0; i < 4; ++i) { const bf16_t* P = proj + (size_t)(row0 + i0 + i) * EV_NP;
                    raw[i][0] = *(const bf16x8*)(P + lane * 8); raw[i][1] = *(const bf16x8*)(P + 512 + lane * 8);
                    c4[i] = (f32x4){1.f, 1.f, 1.f, 1.f}; s4[i] = (f32x4){0.f, 0.f, 0.f, 0.f};
                    if (lat) { c4[i] = *(const f32x4*)(ropec + (t0 + i0 + i) * 32 + (lane & 7) * 4); s4[i] = *(const f32x4*)(ropes + (t0 + i0 + i) * 32 + (lane & 7) * 4); } }
#pragma unroll
                for (int i = 0; i < 4; ++i) { bf16_t* P = proj + (size_t)(row0 + i0 + i) * EV_NP;
#pragma unroll
                    for (int which = 0; which < 2; ++which) {
                        float v[8]; unpack8(raw[i][which], v);
                        float ss = 0.f;
#pragma unroll
                        for (int e = 0; e < 8; ++e) ss += v[e] * v[e];
                        ss += __shfl_xor(ss, 1); ss += __shfl_xor(ss, 2); ss += __shfl_xor(ss, 4);
                        const float rstd = rsqrtf(ss * (1.f / 64.f) + 1e-6f);
#pragma unroll
                        for (int e = 0; e < 8; ++e) v[e] = v[e] * rstd * (which ? gk[e] : gq[e]);
#pragma unroll
                        for (int e = 0; e < 4; ++e) { const float x0 = v[2 * e], x1 = v[2 * e + 1]; v[2 * e] = x0 * c4[i][e] - x1 * s4[i][e]; v[2 * e + 1] = x0 * s4[i][e] + x1 * c4[i][e]; }
                        *(bf16x8*)(P + which * 512 + lane * 8) = pack8(v);
                    } }
            }
        }
#pragma unroll 1
        for (int g = 0; g < 3; ++g) {
            const int c0 = g * 512 + lane * 8;
            float w[5][8];
#pragma unroll
            for (int j = 0; j < 5; ++j) { const f32x4 w0 = *(const f32x4*)(p.gdn_conv + j * 1536 + c0), w1 = *(const f32x4*)(p.gdn_conv + j * 1536 + c0 + 4);
#pragma unroll
                for (int e = 0; e < 4; ++e) { w[j][e] = w0[e]; w[j][4 + e] = w1[e]; } }
            const bf16_t* src = proj + (size_t)row0 * EV_NP + 1536 + c0;
            bf16x8 raw[RB + 4];
#pragma unroll
            for (int k = 0; k < RB + 4; ++k) { const int dt = k - 2; raw[k] = (bf16x8){0, 0, 0, 0, 0, 0, 0, 0};
                if (t0 + dt >= 0 && t0 + dt < len) raw[k] = *(const bf16x8*)(src + (ptrdiff_t)dt * EV_NP); }
            const float nsc = g == 0 ? 0.08838834764831845f : 1.f;
#pragma unroll
            for (int i = 0; i < RB; ++i) {
                float xm2[8], xm1[8], x0[8], xp1[8], xp2[8];
                unpack8(raw[i], xm2); unpack8(raw[i + 1], xm1); unpack8(raw[i + 2], x0); unpack8(raw[i + 3], xp1); unpack8(raw[i + 4], xp2);
                float y[8];
#pragma unroll
                for (int e = 0; e < 8; ++e) { y[e] = w[0][e] * xm2[e] + w[1][e] * xm1[e] + w[2][e] * x0[e] + w[3][e] * xp1[e] + w[4][e] * xp2[e]; y[e] = y[e] * __builtin_amdgcn_rcpf(1.f + __expf(-y[e])); }
                if (g < 2) { float ss = 0.f;
#pragma unroll
                    for (int e = 0; e < 8; ++e) ss += y[e] * y[e];
                    ss += __shfl_xor(ss, 1); ss += __shfl_xor(ss, 2); ss += __shfl_xor(ss, 4); ss += __shfl_xor(ss, 8);
                    const float sc_ = rsqrtf(ss + 1e-6f) * nsc;
#pragma unroll
                    for (int e = 0; e < 8; ++e) y[e] *= sc_; }
                *(bf16x8*)(qkvp + (size_t)(row0 + i) * 1536 + c0) = pack8(y);
            }
        }
#pragma unroll
        for (int k = 0; k < RB / 4; ++k) { const int idx = lane + 64 * k, i = idx >> 4, gi = idx & 15;
            const float gvv = bf2f(proj[(size_t)(row0 + i) * EV_NP + 3584 + gi]); float o;
            if (gi < 8) o = 1.f / (1.f + expf(-gvv));
            else { const float z = gvv + p.gdn_dt_bias[gi - 8]; const float sp = z > 20.f ? z : log1pf(expf(z)); o = -expf(p.gdn_a_log[gi - 8]) * sp; }
            gbuf[(size_t)(row0 + i) * 16 + gi] = o; }
    }
}

__device__ __forceinline__ int gdn_row(int b, int pc, int tau, int dir) {
    const int tt = dir ? 63 - tau : tau;
    return pc < 4 ? NLAT + b * CTXL + pc * 64 + tt : b * SEQ + (pc - 4) * 64 + tt;
}
__device__ __forceinline__ void gdn_pre_phase(const Params& p, unsigned char* lds) {
    const int lane = threadIdx.x & 63, wid = threadIdx.x >> 6;
    float* Lw = (float*)(lds + wid * 16896);
    float* gs = Lw + 4096; float* bs = gs + 64;
    const bf16_t* qkvp = (const bf16_t*)p.out;
    const float* gbuf = (const float*)(p.ws + WS_GATES);
    bf16_t* Tb = (bf16_t*)(p.ws + WS_T); bf16_t* Ab = (bf16_t*)(p.ws + WS_AQK);
    float* gv = (float*)(p.ws + WS_GV); float* bv = (float*)(p.ws + WS_BV);
    const int lane0 = lane;
    for (int cp = blockIdx.x * 8 + wid; cp < NCHUNKP; cp += gridDim.x * 8) {
        int lane = lane0; asm volatile("" : "+v"(lane));
        const int r32 = lane & 31, hi = lane >> 5;
        const int pc = cp % 132, ch = cp / 132, dir = ch & 1, h = (ch >> 1) & 3, b = ch >> 3;
        float g_keep, be_keep;
        { const int R = gdn_row(b, pc, lane, dir);
          float g = gbuf[(size_t)R * 16 + 8 + dir * 4 + h]; const float be = gbuf[(size_t)R * 16 + dir * 4 + h];
#pragma unroll
          for (int o = 1; o < 64; o <<= 1) { const float t = __shfl_up(g, o); if (lane >= o) g += t; }
          gs[lane] = g; bs[lane] = be; g_keep = g; be_keep = be; }
        bf16x8 kf[2][8], qf[2][8];
#pragma unroll
        for (int mi = 0; mi < 2; ++mi) { const size_t R = (size_t)gdn_row(b, pc, 32 * mi + r32, dir);
#pragma unroll
            for (int d0 = 0; d0 < 8; ++d0) { kf[mi][d0] = *(const bf16x8*)(qkvp + R * 1536 + 512 + h * 128 + d0 * 16 + hi * 8);
                                             qf[mi][d0] = *(const bf16x8*)(qkvp + R * 1536 + h * 128 + d0 * 16 + hi * 8); } }
        { const float gl_ = __shfl(g_keep, 63); gv[(size_t)cp * 64 + lane] = expf(g_keep); bv[(size_t)cp * 64 + lane] = be_keep; ((float*)(p.ws + WS_EL))[(size_t)cp * 64 + lane] = expf(gl_ - g_keep); }
        bf16_t* Ao = Ab + (size_t)cp * 4096;
#pragma unroll
        for (int mi = 0; mi < 2; ++mi) {
#pragma unroll
            for (int ni = 0; ni <= mi; ++ni) {
                f32x16 ckk = {}, cqk = {};
#pragma unroll
                for (int d0 = 0; d0 < 8; ++d0) { ckk = __builtin_amdgcn_mfma_f32_32x32x16_bf16(kf[mi][d0], kf[ni][d0], ckk, 0, 0, 0);
                                                 cqk = __builtin_amdgcn_mfma_f32_32x32x16_bf16(qf[mi][d0], kf[ni][d0], cqk, 0, 0, 0); }
                const int sg = 32 * ni + r32; const float gsg = gs[sg];
#pragma unroll
                for (int r = 0; r < 16; ++r) { const int tau = 32 * mi + crow(r, hi);
                    const float dec = tau >= sg ? __expf(gs[tau] - gsg) : 0.f;
                    Lw[tau * 64 + sg] = tau > sg ? bs[tau] * dec * ckk[r] : 0.f;
                    Ao[tau * 64 + sg] = f2bf(cqk[r] * dec); }
                asm volatile("" ::: "memory");
            }
        }
#pragma unroll
        for (int r = 0; r < 16; ++r) Ao[crow(r, hi) * 64 + 32 + r32] = 0;
        float Tc[64];
#pragma unroll
        for (int i = 0; i < 64; ++i) { float a = (i == lane) ? 1.f : 0.f;
#pragma unroll
            for (int j = 0; j < i; ++j) a -= Lw[i * 64 + j] * Tc[j];
            Tc[i] = a; asm volatile("" ::: "memory"); }
        bf16_t* To = Tb + (size_t)cp * 4096;
#pragma unroll
        for (int i = 0; i < 64; ++i) To[i * 64 + lane] = f2bf(Tc[i]);
    }
}

constexpr int G_KV = 0, G_QA = 16384, G_TT = 32768, G_AQ = G_TT + 9216, G_RT = G_AQ + 9216, G_UT = G_RT + 4608, G_UP = G_UT + 4608,
              G_ST = G_UP + 4608, G_VS = G_ST + 8704, G_GS = G_VS + 4096, G_BS = G_GS + 256, G_EL = G_BS + 256, G_END = G_EL + 256;
__device__ __forceinline__ void gdn_scan_phase(const Params& p, unsigned char* lds) {
    const int tid = threadIdx.x, lane0 = tid & 63, wid = tid >> 6;
    const bf16_t* qkvp = (const bf16_t*)p.out;
    const bf16_t* Tb = (const bf16_t*)(p.ws + WS_T); const bf16_t* Ab = (const bf16_t*)(p.ws + WS_AQK);
    const float* gv = (const float*)(p.ws + WS_GV); const float* bv = (const float*)(p.ws + WS_BV);
    bf16_t* obuf = (bf16_t*)(p.ws + WS_H);
    const float* gsl = (const float*)(lds + G_GS); const float* bsl = (const float*)(lds + G_BS); const float* esl = (const float*)(lds + G_EL);
    const int sr = tid >> 4, sc = (tid & 15) * 8;
    const int vblk = (gridDim.x % 8 == 0) ? (int)((blockIdx.x & 7) * (gridDim.x >> 3) + (blockIdx.x >> 3)) : (int)blockIdx.x;
    for (int wi = vblk; wi < 256; wi += gridDim.x) {
        const int chain = wi >> 2, cs = wi & 3, b = chain >> 3, h = (chain >> 1) & 3, dir = chain & 1;
        f32x16 Sacc = {};
        for (int i = tid; i < 8704 / 4; i += NTHREADS) ((unsigned*)(lds + G_ST))[i] = 0u;
        bf16x8 sk0, sk1, sq0, sq1, sT, sA, sV; float sg = 0.f;
#define GLOAD(step) do { const int pc_ = dir == 0 ? (step) : ((step) < 4 ? 3 - (step) : 4 + 127 - ((step) - 4)); \
        const size_t cp_ = (size_t)chain * 132 + pc_; \
        const size_t R0_ = (size_t)gdn_row(b, pc_, sr, dir), R1_ = (size_t)gdn_row(b, pc_, 32 + sr, dir); \
        sk0 = *(const bf16x8*)(qkvp + R0_ * 1536 + 512 + h * 128 + sc); sk1 = *(const bf16x8*)(qkvp + R1_ * 1536 + 512 + h * 128 + sc); \
        sq0 = *(const bf16x8*)(qkvp + R0_ * 1536 + h * 128 + sc); sq1 = *(const bf16x8*)(qkvp + R1_ * 1536 + h * 128 + sc); \
        sT = *(const bf16x8*)(Tb + cp_ * 4096 + tid * 8); sA = *(const bf16x8*)(Ab + cp_ * 4096 + tid * 8); \
        if (tid < 256) { const size_t Rv_ = (size_t)gdn_row(b, pc_, tid >> 2, dir); sV = *(const bf16x8*)(qkvp + Rv_ * 1536 + 1024 + h * 128 + cs * 32 + (tid & 3) * 8); } \
        if (tid < 64) sg = gv[cp_ * 64 + tid]; else if (tid < 128) sg = bv[cp_ * 64 + tid - 64]; else if (tid < 192) sg = ((const float*)(p.ws + WS_EL))[cp_ * 64 + tid - 128]; } while (0)
#define GWRITE() do { *(bf16x8*)(lds + G_KV + v_st(sr, sc)) = sk0; *(bf16x8*)(lds + G_KV + v_st(32 + sr, sc)) = sk1; \
        *(bf16x8*)(lds + G_QA + KSWZ(sr, sc * 2)) = sq0; *(bf16x8*)(lds + G_QA + KSWZ(32 + sr, sc * 2)) = sq1; \
        *(bf16x8*)(lds + G_TT + (tid >> 3) * 144 + (tid & 7) * 16) = sT; *(bf16x8*)(lds + G_AQ + (tid >> 3) * 144 + (tid & 7) * 16) = sA; \
        if (tid < 256) *(bf16x8*)(lds + G_VS + (tid >> 2) * 64 + (tid & 3) * 16) = sV; \
        if (tid < 192) ((float*)(lds + G_GS))[tid] = sg; } while (0)
        GLOAD(0);
        for (int step = 0; step < 132; ++step) {
            GWRITE();
            __syncthreads();
            if (step + 1 < 132) GLOAD(step + 1);
            int lane = lane0; asm volatile("" : "+v"(lane));
            const int r32 = lane & 31, hi = lane >> 5;
            const int vb0 = (int)(uintptr_t)(lds + G_KV) + v_rd_base(lane);
            const int pc = dir == 0 ? step : (step < 4 ? 3 - step : 4 + 127 - (step - 4));
            f32x16 acc = {};
            const int mi = wid & 1;
            if (wid < 4) {
                f32x16 acc2 = {};
                if (wid < 2) {
#pragma unroll
                    for (int d0 = 0; d0 < 8; d0 += 2) {
                        const bf16x8 a0 = *(const bf16x8*)(lds + G_KV + v_st(32 * mi + r32, d0 * 16 + hi * 8)), a1 = *(const bf16x8*)(lds + G_KV + v_st(32 * mi + r32, d0 * 16 + 16 + hi * 8));
                        const bf16x8 b0 = *(const bf16x8*)(lds + G_ST + r32 * 272 + (d0 * 16 + hi * 8) * 2), b1 = *(const bf16x8*)(lds + G_ST + r32 * 272 + (d0 * 16 + 16 + hi * 8) * 2);
                        acc = __builtin_amdgcn_mfma_f32_32x32x16_bf16(a0, b0, acc, 0, 0, 0);
                        acc2 = __builtin_amdgcn_mfma_f32_32x32x16_bf16(a1, b1, acc2, 0, 0, 0); }
                } else {
#pragma unroll
                    for (int d0 = 0; d0 < 8; d0 += 2) {
                        const bf16x8 a0 = *(const bf16x8*)(lds + G_QA + KSWZ(32 * mi + r32, (d0 * 16 + hi * 8) * 2)), a1 = *(const bf16x8*)(lds + G_QA + KSWZ(32 * mi + r32, (d0 * 16 + 16 + hi * 8) * 2));
                        const bf16x8 b0 = *(const bf16x8*)(lds + G_ST + r32 * 272 + (d0 * 16 + hi * 8) * 2), b1 = *(const bf16x8*)(lds + G_ST + r32 * 272 + (d0 * 16 + 16 + hi * 8) * 2);
                        acc = __builtin_amdgcn_mfma_f32_32x32x16_bf16(a0, b0, acc, 0, 0, 0);
                        acc2 = __builtin_amdgcn_mfma_f32_32x32x16_bf16(a1, b1, acc2, 0, 0, 0); }
                }
#pragma unroll
                for (int r = 0; r < 16; ++r) acc[r] += acc2[r];
                if (wid < 2) {
#pragma unroll
                    for (int g4 = 0; g4 < 4; ++g4) { float rv[4];
#pragma unroll
                        for (int j = 0; j < 4; ++j) { const int tau = 32 * mi + 8 * g4 + 4 * hi + j;
                            const float vv = bf2f(*(const bf16_t*)(lds + G_VS + tau * 64 + r32 * 2));
                            rv[j] = bsl[tau] * (vv - gsl[tau] * acc[g4 * 4 + j]); }
                        u32x2 w; w.x = cvtpk(rv[0], rv[1]); w.y = cvtpk(rv[2], rv[3]);
                        *(u32x2*)(lds + G_RT + r32 * 144 + (32 * mi + 8 * g4 + 4 * hi) * 2) = w; }
                } else {
#pragma unroll
                    for (int r = 0; r < 16; ++r) acc[r] *= gsl[32 * mi + crow(r, hi)];
                }
            }
            __syncthreads();
            if (wid < 2) {
                f32x16 u = {}, u2 = {};
#pragma unroll
                for (int s = 0; s < 4; s += 2) {
                    const bf16x8 a0 = *(const bf16x8*)(lds + G_TT + (32 * mi + r32) * 144 + (16 * s + hi * 8) * 2), a1 = *(const bf16x8*)(lds + G_TT + (32 * mi + r32) * 144 + (16 * s + 16 + hi * 8) * 2);
                    const bf16x8 b0 = *(const bf16x8*)(lds + G_RT + r32 * 144 + (16 * s + hi * 8) * 2), b1 = *(const bf16x8*)(lds + G_RT + r32 * 144 + (16 * s + 16 + hi * 8) * 2);
                    u = __builtin_amdgcn_mfma_f32_32x32x16_bf16(a0, b0, u, 0, 0, 0);
                    u2 = __builtin_amdgcn_mfma_f32_32x32x16_bf16(a1, b1, u2, 0, 0, 0); }
#pragma unroll
                for (int r = 0; r < 16; ++r) u[r] += u2[r];
#pragma unroll
                for (int g4 = 0; g4 < 4; ++g4) { float uv[4], up[4];
#pragma unroll
                    for (int j = 0; j < 4; ++j) { const int tau = 32 * mi + 8 * g4 + 4 * hi + j; uv[j] = u[g4 * 4 + j]; up[j] = uv[j] * esl[tau]; }
                    u32x2 w; w.x = cvtpk(uv[0], uv[1]); w.y = cvtpk(uv[2], uv[3]);
                    *(u32x2*)(lds + G_UT + r32 * 144 + (32 * mi + 8 * g4 + 4 * hi) * 2) = w;
                    u32x2 w2; w2.x = cvtpk(up[0], up[1]); w2.y = cvtpk(up[2], up[3]);
                    *(u32x2*)(lds + G_UP + r32 * 144 + (32 * mi + 8 * g4 + 4 * hi) * 2) = w2; }
            }
            __syncthreads();
            if (wid == 2 || wid == 3) {
#pragma unroll
                for (int s = 0; s < 4; ++s) {
                    const bf16x8 a = *(const bf16x8*)(lds + G_AQ + (32 * mi + r32) * 144 + (16 * s + hi * 8) * 2);
                    const bf16x8 bb = *(const bf16x8*)(lds + G_UT + r32 * 144 + (16 * s + hi * 8) * 2);
                    acc = __builtin_amdgcn_mfma_f32_32x32x16_bf16(a, bb, acc, 0, 0, 0); }
#pragma unroll
                for (int r = 0; r < 16; ++r) { const size_t R = (size_t)gdn_row(b, pc, 32 * mi + crow(r, hi), dir);
                    obuf[((size_t)dir * MTOT + R) * 512 + h * 128 + cs * 32 + r32] = f2bf(acc[r]); }
            } else if (wid >= 4) {
                const float gl = gsl[63];
#pragma unroll
                for (int r = 0; r < 16; ++r) Sacc[r] *= gl;
                const bf16x8 pa0 = *(const bf16x8*)(lds + G_UP + r32 * 144 + (0 + hi * 8) * 2), pa1 = *(const bf16x8*)(lds + G_UP + r32 * 144 + (16 + hi * 8) * 2),
                             pa2 = *(const bf16x8*)(lds + G_UP + r32 * 144 + (32 + hi * 8) * 2), pa3 = *(const bf16x8*)(lds + G_UP + r32 * 144 + (48 + hi * 8) * 2);
                const int d0 = wid - 4;
                if (d0 == 0) pv_one<0>(Sacc, vb0, pa0, pa1, pa2, pa3); else if (d0 == 1) pv_one<1>(Sacc, vb0, pa0, pa1, pa2, pa3);
                else if (d0 == 2) pv_one<2>(Sacc, vb0, pa0, pa1, pa2, pa3); else pv_one<3>(Sacc, vb0, pa0, pa1, pa2, pa3);
#pragma unroll
                for (int r = 0; r < 16; ++r) *(bf16_t*)(lds + G_ST + crow(r, hi) * 272 + (32 * d0 + r32) * 2) = f2bf(Sacc[r]);
            }
            __syncthreads();
        }
#undef GLOAD
#undef GWRITE
    }
}

__device__ __forceinline__ void gdn_post_phase(const Params& p) {
    const int lane = threadIdx.x & 63, wid = threadIdx.x >> 6;
    const bf16_t* obuf = (const bf16_t*)(p.ws + WS_H);
    const bf16_t* proj = (const bf16_t*)(p.ws + WS_PROJ);
    bf16_t* mix = (bf16_t*)(p.ws + WS_MIX);
    const int d = (lane & 15) * 8;
    for (int row = blockIdx.x * 8 + wid; row < MTOT; row += gridDim.x * 8) {
        float a[8], bb[8], g[8], y[8];
        unpack8(*(const bf16x8*)(obuf + (size_t)row * 512 + lane * 8), a);
        unpack8(*(const bf16x8*)(obuf + ((size_t)MTOT + row) * 512 + lane * 8), bb);
        unpack8(*(const bf16x8*)(proj + (size_t)row * EV_NP + 3072 + lane * 8), g);
        float ss = 0.f;
#pragma unroll
        for (int i = 0; i < 8; ++i) { a[i] += bb[i]; ss += a[i] * a[i]; }
        ss += __shfl_xor(ss, 1); ss += __shfl_xor(ss, 2); ss += __shfl_xor(ss, 4); ss += __shfl_xor(ss, 8);
        const float rstd = rsqrtf(ss * (1.f / 128.f) + 1e-6f);
#pragma unroll
        for (int i = 0; i < 8; ++i) y[i] = a[i] * rstd * p.gdn_norm[d + i] * (g[i] * __builtin_amdgcn_rcpf(1.f + __expf(-g[i])));
        *(bf16x8*)(mix + (size_t)row * DM + 512 + lane * 8) = pack8(y);
    }
}

__device__ __forceinline__ void diffattn_phase(const Params& p, unsigned char* lds) {
    const int tid = threadIdx.x, wid = tid >> 6, lane = tid & 63, r32 = lane & 31, hi = lane >> 5;
    const bf16_t* proj = (const bf16_t*)(p.ws + WS_PROJ);
    bf16_t* mix = (bf16_t*)(p.ws + WS_MIX);
    float s01 = 0.f, s23 = 0.f;
    for (int i = 0; i < 64; ++i) { s01 += p.diff_lambda[i] * p.diff_lambda[64 + i]; s23 += p.diff_lambda[128 + i] * p.diff_lambda[192 + i]; }
    const float lam = expf(s01) - expf(s23) + 0.2f;
    float* X = (float*)lds; float* li = (float*)(lds + 131072) + wid * 64;
    LAS unsigned char* ldsl = (LAS unsigned char*)lds;
    int koff[2], voff[2];
#pragma unroll
    for (int i = 0; i < 2; ++i) {
        const int g = i * 512 + tid;
        { const int row = g >> 4, cg = (g & 15) ^ (row & 7); koff[i] = row * EV_NP + cg * 8; }
        { const int o = g * 16, st = o >> 9, w = o & 511, kk = (st >> 2) * 8 + (w >> 6);
          const int k = (kk & ~0xC) | ((kk & 4) << 1) | ((kk & 8) >> 1), cc = (st & 3) * 32 + ((w & 63) >> 4) * 8; voff[i] = k * EV_NP + cc; }
    }
    const int vbase = (int)(uintptr_t)lds + v_rd_base(lane);
    const int map = wid >> 2, wq = wid & 3;
    unsigned char* Qs = lds + 98304 + wid * 4096 + lane * 16;
    const int vblk = (gridDim.x % 8 == 0) ? (int)((blockIdx.x & 7) * (gridDim.x >> 3) + (blockIdx.x >> 3)) : (int)blockIdx.x;
    for (int it = vblk; it < 2112; it += gridDim.x) {
        int b, h, NT, qrow0;
        if (it < 2048) { b = it >> 8; h = (it >> 6) & 3; const int qb = it & 63; NT = 132; qrow0 = b * SEQ + qb * 128; }
        else { const int j = it - 2048; b = j >> 3; h = (j >> 1) & 3; NT = 4; qrow0 = NLAT + b * CTXL + (j & 1) * 128; }
        bf16x8 qr[4];
        { const bf16_t* qp = proj + (size_t)(qrow0 + 32 * wq + r32) * EV_NP + h * 128 + map * 64 + hi * 8;
#pragma unroll
          for (int d0 = 0; d0 < 4; ++d0) qr[d0] = *(const bf16x8*)(qp + d0 * 16); }
        f32x16 o[4] = {}; float lsum = 0.f;
#define DDMA(j, bo) do { const bf16_t* pp_ = proj + (size_t)((j) < 4 ? NLAT + b * CTXL + 64 * (j) : b * SEQ + 64 * ((j) - 4)) * EV_NP + h * 128; \
        _Pragma("unroll") for (int i_ = 0; i_ < 2; ++i_) { \
            __builtin_amdgcn_global_load_lds((const unsigned*)(pp_ + 1024 + voff[i_]), (LAS unsigned*)(ldsl + (bo) + i_ * 8192 + wid * 1024), 16, 0, 0); \
            __builtin_amdgcn_global_load_lds((const unsigned*)(pp_ + 512 + koff[i_]), (LAS unsigned*)(ldsl + (bo) + 16384 + i_ * 8192 + wid * 1024), 16, 0, 0); } } while (0)
#define DQK(P0, P1, bo) do { P0 = (f32x16){}; P1 = (f32x16){}; const unsigned char* Ks_ = lds + (bo) + 16384; \
        _Pragma("unroll") for (int d0 = 0; d0 < 4; ++d0) { const int cb_ = (map * 64 + d0 * 16 + hi * 8) * 2; \
            const bf16x8 b0_ = *(const bf16x8*)(Ks_ + KSWZ(r32, cb_)), b1_ = *(const bf16x8*)(Ks_ + KSWZ(32 + r32, cb_)); \
            P0 = __builtin_amdgcn_mfma_f32_32x32x16_bf16(b0_, qr[d0], P0, 0, 0, 0); \
            P1 = __builtin_amdgcn_mfma_f32_32x32x16_bf16(b1_, qr[d0], P1, 0, 0, 0); } } while (0)
#define DSM(P0, P1) do { _Pragma("unroll") for (int r = 0; r < 16; ++r) { P0[r] = __builtin_amdgcn_exp2f(P0[r]); P1[r] = __builtin_amdgcn_exp2f(P1[r]); lsum += P0[r] + P1[r]; } \
        PK4(P0, 0, pa0); PK4(P0, 8, pa1); PK4(P1, 0, pa2); PK4(P1, 8, pa3); } while (0)
#define DTAIL_() asm volatile("s_waitcnt vmcnt(0)" ::: "memory"); __syncthreads(); { const int t_ = bprev; bprev = bcur; bcur = bnext; bnext = t_; }
#define DSTEP_A(N0, N1, O0, O1, j) do { if ((j) + 1 < NT) DDMA((j) + 1, bnext); \
        DQK(N0, N1, bcur); DSM(O0, O1); pv_d0(o, vbase + bprev, pa0, pa1, pa2, pa3); DTAIL_() } while (0)
#define DSTEP_B(N0, N1, O0, O1, j) do { if ((j) + 1 < NT) DDMA((j) + 1, bnext); \
        DSM(O0, O1); pv_d0(o, vbase + bprev, pa0, pa1, pa2, pa3); SBAR(); DQK(N0, N1, bcur); DTAIL_() } while (0)
        f32x16 pA0, pA1, pB0, pB1; bf16x8 pa0, pa1, pa2, pa3;
        DDMA(0, 0); DDMA(1, 32768); asm volatile("s_waitcnt vmcnt(0)" ::: "memory"); __syncthreads();
        DQK(pA0, pA1, 0);
        int bprev = 0, bcur = 32768, bnext = 65536;
        if (map == 0) {
            for (int j = 1; j + 1 < NT; j += 2) { DSTEP_A(pB0, pB1, pA0, pA1, j); DSTEP_A(pA0, pA1, pB0, pB1, j + 1); }
            DSTEP_A(pB0, pB1, pA0, pA1, NT - 1);
        } else {
            for (int j = 1; j + 1 < NT; j += 2) { DSTEP_B(pB0, pB1, pA0, pA1, j); DSTEP_B(pA0, pA1, pB0, pB1, j + 1); }
            DSTEP_B(pB0, pB1, pA0, pA1, NT - 1);
        }
        DSM(pB0, pB1); pv_d0(o, vbase + bprev, pa0, pa1, pa2, pa3);
        __syncthreads();
#undef DDMA
#undef DQK
#undef DSM
#undef DSTEP_A
#undef DSTEP_B
#undef DTAIL_
        const float lt = halfswap_add(lsum);
        if (hi == 0) li[r32] = lt;
        asm volatile("s_waitcnt lgkmcnt(0)" ::: "memory");
        float rli[16];
#pragma unroll
        for (int r = 0; r < 16; ++r) rli[r] = __builtin_amdgcn_rcpf(li[crow(r, hi)]);
        if (map == 1) {
#pragma unroll
            for (int d0 = 0; d0 < 4; ++d0)
#pragma unroll
                for (int r = 0; r < 16; ++r) X[(wq * 64 + d0 * 16 + r) * 64 + lane] = o[d0][r] * rli[r] * lam;
        }
        __syncthreads();
        if (map == 0) {
#pragma unroll
            for (int d0 = 0; d0 < 4; ++d0)
#pragma unroll
                for (int r = 0; r < 16; ++r) o[d0][r] = o[d0][r] * rli[r] - X[(wq * 64 + d0 * 16 + r) * 64 + lane];
#pragma unroll
            for (int r = 0; r < 16; ++r) {
                float ss = o[0][r] * o[0][r] + o[1][r] * o[1][r] + o[2][r] * o[2][r] + o[3][r] * o[3][r];
                ss += __shfl_xor(ss, 1); ss += __shfl_xor(ss, 2); ss += __shfl_xor(ss, 4); ss += __shfl_xor(ss, 8); ss += __shfl_xor(ss, 16);
                const float rstd = rsqrtf(ss * (1.f / 128.f) + 1e-6f) * 0.8f;
                bf16_t* mp = mix + (size_t)(qrow0 + 32 * wq + crow(r, hi)) * DM + h * 128 + r32;
#pragma unroll
                for (int d0 = 0; d0 < 4; ++d0) mp[32 * d0] = f2bf(o[d0][r] * rstd * p.diff_subln[32 * d0 + r32]);
            }
        }
        __syncthreads();
    }
}

__device__ __forceinline__ void natten_phase(const Params& p, unsigned char* lds) {
    const int tid = threadIdx.x, wid = tid >> 6, lane = tid & 63, r32 = lane & 31, hi = lane >> 5;
    const bf16_t* proj = (const bf16_t*)(p.ws + WS_PROJ);
    bf16_t* mix = (bf16_t*)(p.ws + WS_MIX);
    constexpr float L2E = 1.4426950408889634f;
    unsigned char* Vl = lds; unsigned char* Kl = lds + 32768;
    float* rpbs = (float*)(lds + 65536);
    float* li = (float*)(lds + 133120) + wid * 64;
    unsigned char* Qs = lds + 67584 + wid * 8192 + lane * 16;
    const int sr = tid >> 4, sc = (tid & 15) * 8, vst0 = v_st(sr, sc), vst1 = v_st(32 + sr, sc);
    const int vb0 = (int)(uintptr_t)Vl + v_rd_base(lane);
    const float* gkp = p.na_qk_gain + 128 + sc;
    const int vblk = (gridDim.x % 8 == 0) ? (int)((blockIdx.x & 7) * (gridDim.x >> 3) + (blockIdx.x >> 3)) : (int)blockIdx.x;
    for (int it = vblk; it < 2048; it += gridDim.x) {
        const int b = it >> 8, h = (it >> 5) & 7, rq = it & 31;
        const int grow = 4 * rq + (wid >> 1), qc = (wid & 1) * 32 + r32;
        const size_t qR = (size_t)b * SEQ + grow * 64 + qc;
        for (int i = tid; i < 465; i += NTHREADS) rpbs[i] = p.na_rpb[h * 465 + i] * L2E;
        { float ss = 0.f;
#pragma unroll
          for (int d0 = 0; d0 < 8; ++d0) { float qv[8]; unpack8(*(const bf16x8*)(proj + qR * OD_N + h * 128 + d0 * 16 + hi * 8), qv);
#pragma unroll
              for (int i = 0; i < 8; ++i) ss += qv[i] * qv[i]; }
          ss = halfswap_add(ss);
          const float rs = rsqrtf(ss * (1.f / 128.f) + 1e-6f) * 0.08838834764831845f * L2E;
#pragma unroll
          for (int d0 = 0; d0 < 8; ++d0) { float qv[8]; unpack8(*(const bf16x8*)(proj + qR * OD_N + h * 128 + d0 * 16 + hi * 8), qv);
#pragma unroll
              for (int i = 0; i < 8; ++i) qv[i] *= rs * p.na_qk_gain[d0 * 16 + hi * 8 + i];
              *(bf16x8*)(Qs + d0 * 1024) = pack8(qv); } }
        int lo = 4 * rq - 4; lo = lo < 0 ? 0 : (lo > 120 ? 120 : lo);
        int hi_r = 4 * rq + 3 - 4; hi_r = hi_r < 0 ? 0 : (hi_r > 120 ? 120 : hi_r); hi_r += 7;
        const int nlat = hi_r - lo + 1, NT = nlat + 4;
        int wsr = grow - 4; wsr = wsr < 0 ? 0 : (wsr > 120 ? 120 : wsr);
        int cst = qc - 8; cst = cst < 0 ? 0 : (cst > 48 ? 48 : cst);
        f32x16 o[4] = {}; float lsum = 0.f;
        bf16x8 vs0, vs1, ks0, ks1;
#define NLOAD(j) do { const size_t R0_ = (size_t)((j) < nlat ? b * SEQ + (lo + (j)) * 64 : NLAT + b * CTXL + 64 * ((j) - nlat)) + sr; \
        const bf16_t* pp_ = proj + R0_ * OD_N + h * 128 + sc; \
        vs0 = *(const bf16x8*)(pp_ + 2048); vs1 = *(const bf16x8*)(pp_ + 2048 + (size_t)32 * OD_N); \
        ks0 = *(const bf16x8*)(pp_ + 1024); ks1 = *(const bf16x8*)(pp_ + 1024 + (size_t)32 * OD_N); } while (0)
#define KNORM(kx) do { float f_[8]; unpack8(kx, f_); float ss_ = 0.f; _Pragma("unroll") for (int i_ = 0; i_ < 8; ++i_) ss_ += f_[i_] * f_[i_]; \
        ss_ += __shfl_xor(ss_, 1); ss_ += __shfl_xor(ss_, 2); ss_ += __shfl_xor(ss_, 4); ss_ += __shfl_xor(ss_, 8); \
        const float rs_ = rsqrtf(ss_ * (1.f / 128.f) + 1e-6f); _Pragma("unroll") for (int i_ = 0; i_ < 8; ++i_) f_[i_] *= rs_ * gkp[i_]; kx = pack8(f_); } while (0)
#define NWRITE(bf) do { KNORM(ks0); KNORM(ks1); *(bf16x8*)(Vl + (bf) * 16384 + vst0) = vs0; *(bf16x8*)(Vl + (bf) * 16384 + vst1) = vs1; \
        *(bf16x8*)(Kl + (bf) * 16384 + KSWZ(sr, sc * 2)) = ks0; *(bf16x8*)(Kl + (bf) * 16384 + KSWZ(32 + sr, sc * 2)) = ks1; } while (0)
        NLOAD(0); NWRITE(0); __syncthreads();
        for (int j = 0; j < NT; ++j) {
            if (j + 1 < NT) NLOAD(j + 1);
            const int bf = j & 1;
            const bool islat = j < nlat; const int kr = lo + j;
            const bool active = !islat || (kr >= wsr && kr <= wsr + 7);
            if (active) {
                f32x16 p0 = {}, p1 = {};
                const unsigned char* Ks = Kl + bf * 16384;
#pragma unroll
                for (int d0 = 0; d0 < 8; ++d0) { const int cb = (d0 * 16 + hi * 8) * 2;
                    const bf16x8 b0 = *(const bf16x8*)(Ks + KSWZ(r32, cb)), b1 = *(const bf16x8*)(Ks + KSWZ(32 + r32, cb));
                    const bf16x8 qd = *(const bf16x8*)(Qs + d0 * 1024);
                    p0 = __builtin_amdgcn_mfma_f32_32x32x16_bf16(b0, qd, p0, 0, 0, 0);
                    p1 = __builtin_amdgcn_mfma_f32_32x32x16_bf16(b1, qd, p1, 0, 0, 0); }
                if (islat) {
                    const float* rb = rpbs + (kr - grow + 7) * 31 + 15 - qc + 4 * hi;
                    const int mofs = 4 * hi - cst;
#pragma unroll
                    for (int r = 0; r < 16; ++r) {
                        const int kb = (r & 3) + 8 * (r >> 2);
                        const float e0 = __builtin_amdgcn_exp2f(p0[r] + rb[kb]), e1 = __builtin_amdgcn_exp2f(p1[r] + rb[32 + kb]);
                        p0[r] = ((unsigned)(kb + mofs) < 16u) ? e0 : 0.f; p1[r] = ((unsigned)(32 + kb + mofs) < 16u) ? e1 : 0.f;
                        lsum += p0[r] + p1[r]; }
                } else {
#pragma unroll
                    for (int r = 0; r < 16; ++r) { p0[r] = __builtin_amdgcn_exp2f(p0[r]); p1[r] = __builtin_amdgcn_exp2f(p1[r]); lsum += p0[r] + p1[r]; }
                }
                bf16x8 pa0, pa1, pa2, pa3;
                PK4(p0, 0, pa0); PK4(p0, 8, pa1); PK4(p1, 0, pa2); PK4(p1, 8, pa3);
                pv_d0(o, vb0 + bf * 16384, pa0, pa1, pa2, pa3);
            }
            if (j + 1 < NT) NWRITE((j + 1) & 1);
            __syncthreads();
        }
#undef NLOAD
#undef KNORM
#undef NWRITE
        const float lt = halfswap_add(lsum);
        if (hi == 0) li[r32] = lt;
        asm volatile("s_waitcnt lgkmcnt(0)" ::: "memory");
#pragma unroll
        for (int r = 0; r < 16; ++r) { const float rl = __builtin_amdgcn_rcpf(li[crow(r, hi)]);
            bf16_t* mp = mix + ((size_t)b * SEQ + grow * 64 + (wid & 1) * 32 + crow(r, hi)) * DM + h * 128 + r32;
#pragma unroll
            for (int d0 = 0; d0 < 4; ++d0) mp[32 * d0] = f2bf(o[d0][r] * rl); }
        __syncthreads();
    }
}

#define XB_TMO      128
#define XB_XCNT(j)  (256  + 64 * (j))
#define XB_XSUB(j)  (1280 + 64 * (j))
#define XB_XGEN(j)  (2304 + 64 * (j))
#define XB_TOP      3328
#define XB_TOPGEN   3392
#define XCD_BAR_WORDS 3456
#define XB_SPIN_CAP (1u << 22)
__device__ __forceinline__ unsigned xb_ld(unsigned* p)              { return __hip_atomic_load(p, __ATOMIC_RELAXED, __HIP_MEMORY_SCOPE_AGENT); }
__device__ __forceinline__ unsigned xb_add(unsigned* p, unsigned v) { return __hip_atomic_fetch_add(p, v, __ATOMIC_RELAXED, __HIP_MEMORY_SCOPE_AGENT); }
__device__ __forceinline__ unsigned xb_xcc_id() { return (unsigned)__builtin_amdgcn_s_getreg((3 << 11) | 20) & 0xFu; }
#define XB_SPIN(cond, bar) do { unsigned _sp = 0; while (cond) { __builtin_amdgcn_s_sleep(1); \
    if ((++_sp & 255u) == 0u) { if (xb_ld(&(bar)[XB_TMO])) break; if (_sp > XB_SPIN_CAP) { atomicAdd(&(bar)[XB_TMO], 1u); break; } } } } while (0)
struct XcdBarrier { unsigned* bar; unsigned x; volatile LAS unsigned* st; };
__device__ __forceinline__ XcdBarrier xcd_barrier_post(unsigned* bar, volatile LAS unsigned* st) {
    XcdBarrier b; b.bar = bar; b.x = xb_xcc_id(); b.st = st;
    if (threadIdx.x == 0) (void)xb_add(&bar[XB_XCNT(b.x)], 1u);
    return b;
}
__device__ __forceinline__ void xcd_barrier_complete(unsigned* bar, unsigned x, unsigned& nloc, unsigned& nx) {
    const unsigned G = gridDim.x * gridDim.y * gridDim.z;
    unsigned sum, cnt, mine, sp = 0u;
    for (;;) {
        sum = 0u; cnt = 0u; mine = 0u;
#pragma unroll
        for (unsigned j = 0; j < 16; ++j) { const unsigned c = xb_ld(&bar[XB_XCNT(j)]); sum += c; cnt += (c > 0u) ? 1u : 0u; mine = (j == x) ? c : mine; }
        if (sum == G) break;
        __builtin_amdgcn_s_sleep(1);
        if ((++sp & 255u) == 0u) { if (xb_ld(&bar[XB_TMO])) break; if (sp > XB_SPIN_CAP) { atomicAdd(&bar[XB_TMO], 1u); break; } }
    }
    nloc = mine > 0u ? mine : 1u; nx = cnt > 0u ? cnt : 1u;
}
__device__ __forceinline__ void xcd_barrier(const XcdBarrier& b) {
    asm volatile("s_waitcnt vmcnt(0)" ::: "memory");
    __syncthreads();
    if (threadIdx.x == 0) {
        unsigned* bar = b.bar;
        __builtin_amdgcn_s_waitcnt(0);
        unsigned nloc = b.st[0], nx = b.st[1];
        if (nloc == 0u) { xcd_barrier_complete(bar, b.x, nloc, nx); b.st[0] = nloc; b.st[1] = nx; }
        const unsigned old = xb_add(&bar[XB_XSUB(b.x)], 1u);
        const unsigned gen = old / nloc;
        if (old + 1u == (gen + 1u) * nloc) {
            __builtin_amdgcn_fence(__ATOMIC_RELEASE, "agent");
            asm volatile("s_waitcnt vmcnt(0)" ::: "memory");
            const unsigned og = xb_add(&bar[XB_TOP], 1u);
            const unsigned tg = og / nx;
            if (og + 1u == (tg + 1u) * nx) xb_add(&bar[XB_TOPGEN], 1u);
            else XB_SPIN(xb_ld(&bar[XB_TOPGEN]) == tg, bar);
            __builtin_amdgcn_fence(__ATOMIC_ACQUIRE, "agent");
            xb_add(&bar[XB_XGEN(b.x)], 1u);
            asm volatile("s_waitcnt vmcnt(0)" ::: "memory");
        } else {
            XB_SPIN(xb_ld(&bar[XB_XGEN(b.x)]) == gen, bar);
            __builtin_amdgcn_fence(__ATOMIC_ACQUIRE, "agent");
            asm volatile("s_waitcnt vmcnt(0)" ::: "memory");
        }
    }
    __syncthreads();
}

#ifndef PROBE_REP
#define PROBE_REP 0
#endif
#define REP(k) for (int rep_ = 0; rep_ < (((PROBE_REP >> (k)) & 1) ? 2 : 1); ++rep_)
constexpr int NPH = 18;
__global__ void __launch_bounds__(NTHREADS, 2) fwd_megakernel(Params p) {
    extern __shared__ __attribute__((aligned(16))) unsigned char lds[];
    cg::grid_group grid = cg::this_grid();
    LAS unsigned char* ldsl = (LAS unsigned char*)lds;
    const int lo = p.ph_lo, hi = p.ph_hi;
#ifdef ONLY_PH
#define IN(k) (((ONLY_PH >> (k)) & 1) && lo <= (k) && (k) < hi)
#else
#define IN(k) (lo <= (k) && (k) < hi)
#endif
#define SEAM(k) do { if (IN(k) && IN((k) + 1)) { if ((k) == 0) grid.sync(); else { XcdBarrier xb_; xb_.bar = (unsigned*)(p.ws + WS_BAR); xb_.x = xb_xcc_id(); xb_.st = (volatile LAS unsigned*)(ldsl + 135168); xcd_barrier(xb_); } } } while (0)
    unsigned char* ws = p.ws;
    const bf16_t* H = (const bf16_t*)(ws + WS_H);
    bf16_t* PROJ = (bf16_t*)(ws + WS_PROJ);
    const bf16_t* MIX = (const bf16_t*)(ws + WS_MIX);
    float* CTXRES = (float*)(ws + WS_CTXRES);
    const float* MOD = (const float*)(ws + WS_MOD);
    const int G = gridDim.x, c = blockIdx.x;
    if (threadIdx.x < 4) ((volatile LAS unsigned*)(ldsl + 135168))[threadIdx.x] = 0u;
    __syncthreads();
    (void)xcd_barrier_post((unsigned*)(ws + WS_BAR), (volatile LAS unsigned*)(ldsl + 135168));

    if (IN(0)) REP(0) { ada_phase(p, lds); wconv_phase(p, lds);
        { float* rc = (float*)(ws + WS_ROPE); float* rs = rc + SEQ * 32;
          for (int e = blockIdx.x * NTHREADS + threadIdx.x; e < SEQ * 32; e += gridDim.x * NTHREADS) { const int t = e >> 5, pp = e & 31;
              const float inv = powf(10000.f, -(float)(pp & 15) / 16.f); const float ang = (pp < 16 ? (float)(t >> 6) : (float)(t & 63)) * inv;
              rc[e] = cosf(ang); rs[e] = sinf(ang); } } }
    SEAM(0);
    if (IN(1)) REP(1) norm_phase(p, p.x, p.ctx, 0, 0, MTOT);
    SEAM(1);
    if (IN(2)) REP(2) { pg8::Gemm g{H, (const bf16_t*)(ws + WS_W_EVIN), MTOT, EV_NP, DM}; pg8::StaticOrderT<264, 15> S; S.init(MTOT, EV_NP, G, c);
        pg8::EpiBf16 E{PROJ, EV_NP}; pg8::gemm_phase(ldsl, g, S, E); }
    SEAM(2);
    if (IN(3)) prep0_phase(p);
    SEAM(3);
    if (IN(4)) REP(4) gdn_pre_phase(p, lds);
    SEAM(4);
    if (IN(5)) {
#ifndef SKIP_SCAN
        REP(20) { gdn_scan_phase(p, lds); __syncthreads(); }
#endif
#ifndef SKIP_DA
        REP(5) { diffattn_phase(p, lds); __syncthreads(); }
#endif
    }
    SEAM(5);
    if (IN(6)) REP(6) gdn_post_phase(p);
    SEAM(6);
    if (IN(7)) REP(7) { pg8::Gemm g{MIX, (const bf16_t*)(ws + WS_W_EVOUT), MTOT, DM, DM}; pg8::StaticOrderT<264, 4> S; S.init(MTOT, DM, G, c);
        pg8::EpiResid E{p.x, p.ctx, p.out, CTXRES, MOD, 2048}; pg8::gemm_phase(ldsl, g, S, E); }
    SEAM(7);
    if (IN(8)) norm_phase(p, p.out, CTXRES, 0, 1, MTOT);
    SEAM(8);
    if (IN(9)) REP(9) { pg8::Gemm g{H, (const bf16_t*)(ws + WS_W_FFIN), MTOT, 2 * FF, DM}; pg8::StaticOrderT<264, 22> S; S.init(MTOT, 2 * FF, G, c);
        pg8::EpiSwiglu E{PROJ, FF}; pg8::gemm_phase(ldsl, g, S, E); }
    SEAM(9);
    if (IN(10)) { pg8::Gemm g{PROJ, (const bf16_t*)(ws + WS_W_FFOUT), MTOT, DM, FF}; pg8::StaticOrderT<264, 4> S; S.init(MTOT, DM, G, c);
        pg8::EpiResid E{p.out, CTXRES, p.out, CTXRES, MOD, 5120}; pg8::gemm_phase(ldsl, g, S, E); }
    SEAM(10);
    if (IN(11)) norm_phase(p, p.out, CTXRES, 1, 0, MTOT);
    SEAM(11);
    if (IN(12)) { pg8::Gemm g{H, (const bf16_t*)(ws + WS_W_ODIN), MTOT, OD_N, DM}; pg8::StaticOrderT<264, 12> S; S.init(MTOT, OD_N, G, c);
        pg8::EpiBf16 E{PROJ, OD_N}; pg8::gemm_phase(ldsl, g, S, E); }
    SEAM(12);
    if (IN(13)) { natten_phase(p, lds); if ((PROBE_REP >> 13) & 1) { __syncthreads(); natten_phase(p, lds); } }
    SEAM(13);
    if (IN(14)) { pg8::Gemm g{MIX, (const bf16_t*)(ws + WS_W_ODOUT), NLAT, DM, DM}; pg8::StaticOrderT<256, 4> S; S.init(NLAT, DM, G, c);
        pg8::EpiResid E{p.out, CTXRES, p.out, CTXRES, MOD + 9 * 6144, 2048}; pg8::gemm_phase(ldsl, g, S, E); }
    SEAM(14);
    if (IN(15)) norm_phase(p, p.out, CTXRES, 1, 1, NLAT);
    SEAM(15);
    if (IN(16)) { pg8::Gemm g{H, (const bf16_t*)(ws + WS_W_FFIN) + (size_t)2 * FF * DM, NLAT, 2 * FF, DM}; pg8::StaticOrderT<256, 22> S; S.init(NLAT, 2 * FF, G, c);
        pg8::EpiSwiglu E{PROJ, FF}; pg8::gemm_phase(ldsl, g, S, E); }
    SEAM(16);
    if (IN(17)) { pg8::Gemm g{PROJ, (const bf16_t*)(ws + WS_W_FFOUT) + (size_t)DM * FF, NLAT, DM, FF}; pg8::StaticOrderT<256, 4> S; S.init(NLAT, DM, G, c);
        pg8::EpiResid E{p.out, CTXRES, p.out, CTXRES, MOD + 9 * 6144, 5120}; pg8::gemm_phase(ldsl, g, S, E); }
#undef IN
#undef SEAM
}

extern "C" void kernel_launch(void* const* d_in, const int* in_sizes, int n_in, void* d_out, int out_size, void* d_ws, size_t ws_size, hipStream_t stream) {
    static int grid = 0;
    if (grid == 0) {
        if (n_in != 23 || ws_size < WS_END) { fprintf(stderr, "kernel_launch: n_in %d ws %zu (need %zu)\n", n_in, ws_size, (size_t)WS_END); grid = -1; return; }
        int dev = 0, cus = 0, per_cu = 0;
        hipGetDevice(&dev); hipDeviceGetAttribute(&cus, hipDeviceAttributeMultiprocessorCount, dev);
        if (hipFuncSetAttribute((const void*)fwd_megakernel, hipFuncAttributeMaxDynamicSharedMemorySize, LDS_BYTES) != hipSuccess) { fprintf(stderr, "hipFuncSetAttribute failed\n"); grid = -1; return; }
        if (hipOccupancyMaxActiveBlocksPerMultiprocessor(&per_cu, (const void*)fwd_megakernel, NTHREADS, LDS_BYTES) != hipSuccess || per_cu < 1) per_cu = 1;
        (void)hipGetLastError();
        grid = cus * 1;
    }
    if (grid < 0) return;
    if (hipMemsetAsync((char*)d_ws + WS_BAR, 0, 16384, stream) != hipSuccess) { fprintf(stderr, "memset failed\n"); return; }
    Params p{};
    const float** pp = (const float**)&p;
    for (int i = 0; i < 23; ++i) pp[i] = (const float*)d_in[i];
    p.out = (float*)d_out; p.ws = (unsigned char*)d_ws;
#if N_LAUNCH_MODE == 1
    p.ph_lo = 0; p.ph_hi = NPH;
    void* args[] = {&p};
    hipError_t e = hipLaunchCooperativeKernel((void*)fwd_megakernel, dim3(grid), dim3(NTHREADS), args, LDS_BYTES, stream);
    if (e != hipSuccess) fprintf(stderr, "cooperative launch failed: %s (grid %d)\n", hipGetErrorString(e), grid);
#else
    for (int k = 0; k < NPH; ++k) { p.ph_lo = k; p.ph_hi = k + 1;
        hipLaunchKernelGGL(fwd_megakernel, dim3(grid), dim3(NTHREADS), LDS_BYTES, stream, p); }
#endif
}
```

```cpp
#include <hip/hip_runtime.h>
#include <hip/hip_cooperative_groups.h>
#include <cstdio>
#include <cstdint>
namespace cg = cooperative_groups;

#define LAS __attribute__((address_space(3)))
typedef unsigned short bf16_t;
typedef short bf16x8 __attribute__((ext_vector_type(8)));
typedef short s16x4 __attribute__((ext_vector_type(4)));
typedef float f32x4 __attribute__((ext_vector_type(4)));
typedef float f32x16 __attribute__((ext_vector_type(16)));
typedef unsigned u32x4 __attribute__((ext_vector_type(4)));
typedef unsigned u32x2 __attribute__((ext_vector_type(2)));

#ifndef N_LAUNCH_MODE
#define N_LAUNCH_MODE 1
#endif

constexpr int DM = 1024, NLAT = 65536, NCTX = 2048, MTOT = NLAT + NCTX, SEQ = 8192, CTXL = 256, FF = 2816;
constexpr int EV_N = 3600, EV_NP = 3840, OD_N = 3072;
constexpr int NCHUNKP = 64 * 132;
constexpr int NTHREADS = 512;
constexpr int LDS_BYTES = 135168 + 16;

constexpr size_t al256(size_t x) { return (x + 255) / 256 * 256; }
constexpr size_t WS_W_EVIN = 0;
constexpr size_t WS_W_EVOUT = WS_W_EVIN + al256((size_t)EV_NP * DM * 2);
constexpr size_t WS_W_ODIN = WS_W_EVOUT + al256((size_t)DM * DM * 2);
constexpr size_t WS_W_ODOUT = WS_W_ODIN + al256((size_t)OD_N * DM * 2);
constexpr size_t WS_W_FFIN = WS_W_ODOUT + al256((size_t)DM * DM * 2);
constexpr size_t WS_W_FFOUT = WS_W_FFIN + al256((size_t)2 * 2 * FF * DM * 2);
constexpr size_t WS_MOD = WS_W_FFOUT + al256((size_t)2 * DM * FF * 2);
constexpr size_t WS_H = WS_MOD + al256((size_t)2 * 9 * 6144 * 4);
constexpr size_t WS_PROJ = WS_H + al256((size_t)MTOT * DM * 2);
constexpr size_t WS_MIX = WS_PROJ + al256((size_t)MTOT * EV_NP * 2);
constexpr size_t WS_T = WS_MIX + al256((size_t)MTOT * DM * 2);
constexpr size_t WS_AQK = WS_T + al256((size_t)NCHUNKP * 4096 * 2);
constexpr size_t WS_GV = WS_AQK + al256((size_t)NCHUNKP * 4096 * 2);
constexpr size_t WS_BV = WS_GV + al256((size_t)NCHUNKP * 64 * 4);
constexpr size_t WS_EL = WS_BV + al256((size_t)NCHUNKP * 64 * 4);
constexpr size_t WS_GATES = WS_EL + al256((size_t)NCHUNKP * 64 * 4);
constexpr size_t WS_CTXRES = WS_GATES + al256((size_t)MTOT * 16 * 4);
constexpr size_t WS_BAR = WS_CTXRES + al256((size_t)NCTX * DM * 4);
constexpr size_t WS_ROPE = WS_BAR + 16384;
constexpr size_t WS_END = WS_ROPE + (size_t)2 * SEQ * 32 * 4;

struct Params {
    const float *x, *c, *ctx, *c_ctx, *ada_w, *ada_b, *norm_mix, *norm_ffn, *ffn_w_in, *ffn_w_out, *even_w_in, *even_w_out,
        *diff_qk_gain, *diff_lambda, *diff_subln, *gdn_conv, *gdn_a_log, *gdn_dt_bias, *gdn_norm, *odd_w_in, *odd_w_out, *na_qk_gain, *na_rpb;
    float* out; unsigned char* ws; int ph_lo, ph_hi;
};

__device__ __forceinline__ float bf2f(bf16_t b) { return __uint_as_float(((unsigned)b) << 16); }
__device__ __forceinline__ bf16_t f2bf(float f) { unsigned u = __float_as_uint(f); u += 0x7FFFu + ((u >> 16) & 1u); return (bf16_t)(u >> 16); }
__device__ __forceinline__ unsigned cvtpk(float lo, float hi) { unsigned r; asm volatile("v_cvt_pk_bf16_f32 %0, %1, %2" : "=v"(r) : "v"(lo), "v"(hi)); return r; }
__device__ __forceinline__ float siluf(float v) { return v / (1.f + __expf(-v)); }
__device__ __forceinline__ void unpack8(bf16x8 v, float* f) {
#pragma unroll
    for (int i = 0; i < 8; ++i) f[i] = bf2f((bf16_t)v[i]);
}
__device__ __forceinline__ bf16x8 pack8(const float* f) {
    u32x4 w = {cvtpk(f[0], f[1]), cvtpk(f[2], f[3]), cvtpk(f[4], f[5]), cvtpk(f[6], f[7])};
    return *reinterpret_cast<bf16x8*>(&w);
}

namespace pg8 {
constexpr int BM = 256, BK = 64, HALF = 128, HTB = HALF * BK * 2, STAGE_BYTES = 8 * HTB, NXCD = 8, WGM = 8;
__host__ __device__ __forceinline__ int lds_byte(int r, int c) { const int st = (r >> 4) * 2 + (c >> 5), rr = r & 15, cc = c & 31, ob = rr * 64 + cc * 2; return st * 1024 + (ob ^ (((ob >> 9) & 1) << 5)); }
__host__ __device__ __forceinline__ void stage_rc(int b, int& R, int& C) { const int st = b / 1024, sb = b % 1024, swz = sb ^ (((sb >> 9) & 1) << 5); R = (st >> 1) * 16 + swz / 64; C = (st & 1) * 32 + (swz % 64) / 2; }
__host__ __device__ __forceinline__ int perm32(int rho) { const int n = rho >> 4, i = rho & 15; return 8 * (i >> 2) + 4 * n + (i & 3); }
struct Unit { int pm, pn; };
struct Gemm { const bf16_t* A; const bf16_t* Bt; int M, N, K; };
template <int NM, int NN> struct StaticOrderT {
    static_assert(NM % WGM == 0, "row tiles in whole groups");
    int G, c;
    __device__ void init(int, int, int G_, int c_) { G = G_; c = c_; }
    __device__ bool next(int i, Unit& u) const {
        constexpr int nwg = NM * NN, q = nwg / NXCD, r = nwg % NXCD, nig = WGM * NN;
        const int L = i * G + c; if (L >= nwg) return false;
        const int xcd = L % NXCD, off = L / NXCD;
        const int wgid = (xcd < r ? xcd * (q + 1) : r * (q + 1) + (xcd - r) * q) + off;
        const int gid = wgid / nig, w = wgid % nig;
        u.pm = gid * WGM + (w % WGM); u.pn = w / WGM; return true;
    }
};
struct EpiBf16 {
    static constexpr bool PERM = true;
    bf16_t* O; int ldc;
    __device__ __forceinline__ void operator()(const f32x4 (&acc)[2][2][4][2], const Unit& u, int wr, int wc, int fr, int fq) const {
        const int row0 = u.pm * BM + wr * 64 + fr; const int col0 = u.pn * BM + wc * 32 + 8 * fq;
#pragma unroll
        for (int ai = 0; ai < 2; ++ai)
#pragma unroll
            for (int m = 0; m < 4; ++m) { bf16_t* rowp = O + (size_t)(row0 + ai * HALF + m * 16) * ldc + col0;
#pragma unroll
                for (int bj = 0; bj < 2; ++bj) { const f32x4 v0 = acc[ai][bj][m][0], v1 = acc[ai][bj][m][1];
                    u32x4 w; w.x = cvtpk(v0[0], v0[1]); w.y = cvtpk(v0[2], v0[3]); w.z = cvtpk(v1[0], v1[1]); w.w = cvtpk(v1[2], v1[3]);
                    *(u32x4*)(rowp + bj * HALF) = w; } }
    }
};
struct EpiSwiglu {
    static constexpr bool PERM = true;
    bf16_t* O; int ldc;
    __device__ __forceinline__ void operator()(const f32x4 (&acc)[2][2][4][2], const Unit& u, int wr, int wc, int fr, int fq) const {
        const int row0 = u.pm * BM + wr * 64 + fr; const int col0 = u.pn * HALF + wc * 32 + 8 * fq;
#pragma unroll
        for (int ai = 0; ai < 2; ++ai)
#pragma unroll
            for (int m = 0; m < 4; ++m) { bf16_t* rowp = O + (size_t)(row0 + ai * HALF + m * 16) * ldc + col0;
                typedef float f32x2v __attribute__((ext_vector_type(2)));
                unsigned wv[4];
#pragma unroll
                for (int n = 0; n < 2; ++n)
#pragma unroll
                    for (int j = 0; j < 4; j += 2) { const f32x2v g = {acc[ai][0][m][n][j], acc[ai][0][m][n][j + 1]}, up = {acc[ai][1][m][n][j], acc[ai][1][m][n][j + 1]};
                        const f32x2v t = g * (-1.4426950408889634f); f32x2v e; e.x = __builtin_amdgcn_exp2f(t.x); e.y = __builtin_amdgcn_exp2f(t.y);
                        const f32x2v d = e + 1.0f; f32x2v r; r.x = __builtin_amdgcn_rcpf(d.x); r.y = __builtin_amdgcn_rcpf(d.y);
                        const f32x2v o = (g * up) * r; wv[n * 2 + (j >> 1)] = cvtpk(o.x, o.y); }
                u32x4 w; w.x = wv[0]; w.y = wv[1]; w.z = wv[2]; w.w = wv[3];
                *(u32x4*)rowp = w; }
    }
};
struct EpiResid {
    static constexpr bool PERM = false;
    const float* resLat; const float* resCtx; float* outLat; float* outCtx; const float* modl; int goff;
    __device__ __forceinline__ void operator()(const f32x4 (&acc)[2][2][4][2], const Unit& u, int wr, int wc, int fr, int fq) const {
        const int rowt = u.pm * BM; const bool lat = rowt < NLAT;
        const float* res = lat ? resLat + (size_t)rowt * DM : resCtx + (size_t)(rowt - NLAT) * DM;
        float* out = lat ? outLat + (size_t)rowt * DM : outCtx + (size_t)(rowt - NLAT) * DM;
        const float* gate = modl + (size_t)(lat ? (rowt >> 13) : 8) * 6144 + goff;
        const int row0 = wr * 64 + fr, col0 = u.pn * BM + wc * 32 + 4 * fq;
        f32x4 gv[2][2];
#pragma unroll
        for (int bj = 0; bj < 2; ++bj)
#pragma unroll
            for (int n = 0; n < 2; ++n) gv[bj][n] = *(const f32x4*)(gate + col0 + bj * HALF + n * 16);
#pragma unroll
        for (int ai = 0; ai < 2; ++ai)
#pragma unroll
            for (int mp = 0; mp < 4; mp += 2) {
                f32x4 r[2][2][2];
#pragma unroll
                for (int mm = 0; mm < 2; ++mm)
#pragma unroll
                    for (int bj = 0; bj < 2; ++bj)
#pragma unroll
                        for (int n = 0; n < 2; ++n) r[mm][bj][n] = *(const f32x4*)(res + (size_t)(row0 + ai * HALF + (mp + mm) * 16) * DM + col0 + bj * HALF + n * 16);
#pragma unroll
                for (int mm = 0; mm < 2; ++mm)
#pragma unroll
                    for (int bj = 0; bj < 2; ++bj)
#pragma unroll
                        for (int n = 0; n < 2; ++n) *(f32x4*)(out + (size_t)(row0 + ai * HALF + (mp + mm) * 16) * DM + col0 + bj * HALF + n * 16) = r[mm][bj][n] + gv[bj][n] * acc[ai][bj][mp + mm][n];
            }
    }
};

template <class Epi, class Sched>
__device__ __forceinline__ void gemm_phase(LAS unsigned char* lds, const Gemm g, const Sched& S, const Epi& E) {
    const int tid = threadIdx.x, wid = __builtin_amdgcn_readfirstlane(tid >> 6), lane = tid & 63, wr = wid >> 2, wc = wid & 3, fr = lane & 15, fq = lane >> 4;
    const int K = g.K, nt = K / BK;
    unsigned voffA[2], voffB[2];
#pragma unroll
    for (int i = 0; i < 2; ++i) { int R, C; stage_rc(tid * 16 + i * 8192, R, C); const int Rb = Epi::PERM ? ((R & ~31) + perm32(R & 31)) : R;
        voffA[i] = (unsigned)(R * K + C) * 2u; voffB[i] = (unsigned)(Rb * K + C) * 2u; }
    const size_t kstep = (size_t)(BK * 2);
    const size_t hstep = (size_t)HALF * K * 2;
    const size_t tstep = 2 * hstep;
    const unsigned ldsw = (unsigned)wid * 1024u;
    const int aoff = lds_byte(wr * 64 + fr, fq * 8), boff = lds_byte(wc * 32 + fr, fq * 8);
#define PG8_SA(b, h) (((b) * 2 + (h)) * HTB)
#define PG8_SB(b, h) ((4 + (b) * 2 + (h)) * HTB)
#define PG8_STAGE(bufoff, gbase, voff) do { _Pragma("unroll") for (int _i = 0; _i < 2; ++_i) \
        __builtin_amdgcn_global_load_lds((const unsigned*)((const char*)(gbase) + (voff)[_i]), (LAS unsigned*)(lds + (bufoff) + ldsw + _i * 8192), 16, 0, 0); } while (0)
#define PG8_LDA(dst, b, h) do { _Pragma("unroll") for (int m = 0; m < 4; ++m) _Pragma("unroll") for (int k = 0; k < 2; ++k) dst[m][k] = *(const LAS bf16x8*)(lds + PG8_SA(b, h) + aoff + m * 2048 + k * 1024); } while (0)
#define PG8_LDB(dst, b, h) do { _Pragma("unroll") for (int n = 0; n < 2; ++n) _Pragma("unroll") for (int k = 0; k < 2; ++k) dst[n][k] = *(const LAS bf16x8*)(lds + PG8_SB(b, h) + boff + n * 2048 + k * 1024); } while (0)
#define PG8_MMA(ai, bj, At, Bt) do { __builtin_amdgcn_s_setprio(1); _Pragma("unroll") for (int m = 0; m < 4; ++m) _Pragma("unroll") for (int n = 0; n < 2; ++n) _Pragma("unroll") for (int k = 0; k < 2; ++k) \
        acc[ai][bj][m][n] = __builtin_amdgcn_mfma_f32_16x16x32_bf16(Bt[n][k], At[m][k], acc[ai][bj][m][n], 0, 0, 0); __builtin_amdgcn_s_setprio(0); } while (0)
#define PG8_WAIT_V(n) asm volatile("s_waitcnt vmcnt(" #n ")" ::: "memory")
#define PG8_WAIT_L(n) asm volatile("s_waitcnt lgkmcnt(" #n ")" ::: "memory")
#define PG8_BAR __builtin_amdgcn_s_barrier()
#define PG8_SCHED __builtin_amdgcn_sched_barrier(0)
    Unit cur, nxt; int ui = 0;
    if (!S.next(0, cur)) return;
    f32x4 acc[2][2][4][2];
#pragma unroll
    for (int a = 0; a < 2; ++a)
#pragma unroll
        for (int b = 0; b < 2; ++b)
#pragma unroll
            for (int m = 0; m < 4; ++m)
#pragma unroll
                for (int n = 0; n < 2; ++n) acc[a][b][m][n] = (f32x4){0.f, 0.f, 0.f, 0.f};
    bf16x8 At[4][2], B0[2][2], B1[2][2];
    const char* cA = (const char*)g.A + (size_t)cur.pm * tstep; const char* cB = (const char*)g.Bt + (size_t)cur.pn * tstep;
    PG8_STAGE(PG8_SB(0, 0), cB, voffB); PG8_STAGE(PG8_SA(0, 0), cA, voffA); PG8_STAGE(PG8_SB(0, 1), cB + hstep, voffB); PG8_STAGE(PG8_SA(0, 1), cA + hstep, voffA);
    if (wr == 1) PG8_BAR;
    PG8_WAIT_V(4); PG8_BAR;
    PG8_STAGE(PG8_SB(1, 0), cB + kstep, voffB); PG8_STAGE(PG8_SA(1, 0), cA + kstep, voffA); PG8_STAGE(PG8_SB(1, 1), cB + hstep + kstep, voffB);
    PG8_WAIT_V(6); PG8_BAR;
    for (;;) {
        const bool has_next = S.next(ui + 1, nxt);
        const char* nA = has_next ? (const char*)g.A + (size_t)nxt.pm * tstep : cA; const char* nB = has_next ? (const char*)g.Bt + (size_t)nxt.pn * tstep : cB;
        for (int t = 0; t < nt; t += 2) {
            const bool last = (t == nt - 2);
            const char* a1 = cA + (size_t)(t + 1) * kstep;
            const char* a2 = last ? nA : cA + (size_t)(t + 2) * kstep; const char* b2 = last ? nB : cB + (size_t)(t + 2) * kstep;
            const char* a3 = a2 + kstep; const char* b3 = b2 + kstep;
            PG8_LDB(B0, 0, 0); PG8_SCHED; PG8_LDA(At, 0, 0); PG8_STAGE(PG8_SA(1, 1), a1 + hstep, voffA);
            PG8_WAIT_L(8); PG8_BAR; PG8_WAIT_L(0); PG8_MMA(0, 0, At, B0); PG8_BAR; PG8_SCHED;
            PG8_LDB(B1, 0, 1); PG8_STAGE(PG8_SB(0, 0), b2, voffB);
            PG8_BAR; PG8_WAIT_L(0); PG8_MMA(0, 1, At, B1); PG8_BAR;
            PG8_LDA(At, 0, 1); PG8_STAGE(PG8_SA(0, 0), a2, voffA);
            PG8_BAR; PG8_WAIT_L(0); PG8_MMA(1, 0, At, B0); PG8_BAR; PG8_SCHED;
            PG8_STAGE(PG8_SB(0, 1), b2 + hstep, voffB);
            PG8_WAIT_V(6); PG8_BAR; PG8_MMA(1, 1, At, B1); PG8_BAR;
            PG8_LDB(B0, 1, 0); PG8_SCHED; PG8_LDA(At, 1, 0); PG8_STAGE(PG8_SA(0, 1), a2 + hstep, voffA);
            PG8_WAIT_L(8); PG8_BAR; PG8_WAIT_L(0); PG8_MMA(0, 0, At, B0); PG8_BAR; PG8_SCHED;
            PG8_LDB(B1, 1, 1); PG8_STAGE(PG8_SB(1, 0), b3, voffB);
            PG8_BAR; PG8_WAIT_L(0); PG8_MMA(0, 1, At, B1); PG8_BAR;
            PG8_LDA(At, 1, 1); PG8_STAGE(PG8_SA(1, 0), a3, voffA);
            PG8_BAR; PG8_WAIT_L(0); PG8_MMA(1, 0, At, B0); PG8_BAR; PG8_SCHED;
            PG8_STAGE(PG8_SB(1, 1), b3 + hstep, voffB);
            PG8_WAIT_V(6); PG8_BAR; PG8_MMA(1, 1, At, B1); PG8_BAR;
        }
        E(acc, cur, wr, wc, fr, fq);
        if (!has_next) break;
#pragma unroll
        for (int a = 0; a < 2; ++a)
#pragma unroll
            for (int b = 0; b < 2; ++b)
#pragma unroll
                for (int m = 0; m < 4; ++m)
#pragma unroll
                    for (int n = 0; n < 2; ++n) acc[a][b][m][n] = (f32x4){0.f, 0.f, 0.f, 0.f};
        cur = nxt; cA = nA; cB = nB; ++ui;
    }
    PG8_WAIT_V(0);
    if (wr == 0) PG8_BAR;
    PG8_BAR;
#undef PG8_SA
#undef PG8_SB
#undef PG8_STAGE
#undef PG8_LDA
#undef PG8_LDB
#undef PG8_MMA
#undef PG8_WAIT_V
#undef PG8_WAIT_L
#undef PG8_BAR
#undef PG8_SCHED
}
}

#define KSWZ(row, colB) ((row) * 256 + ((colB) ^ (((row) & 7) << 4)))
#define SBAR() __builtin_amdgcn_sched_barrier(0)
__device__ __forceinline__ int crow(int r, int hi) { return (r & 3) + 8 * (r >> 2) + 4 * hi; }
__device__ __forceinline__ int v_st(int k, int c) { const int kk = (k & ~0xC) | ((k & 4) << 1) | ((k & 8) >> 1); return ((kk >> 3) * 4 + (c >> 5)) * 512 + ((kk & 7) * 32 + (c & 31)) * 2; }
__device__ __forceinline__ int v_rd_base(int lane) { return ((lane & 3) << 3) | (((lane >> 2) & 3) << 6) | (((lane >> 4) & 1) << 5) | (((lane >> 5) & 1) << 8); }
constexpr int v_rd_off(int d0, int ks, int half) { return d0 * 512 + ks * 4096 + half * 2048; }
template <int OFF> __device__ __forceinline__ s16x4 tr_read(int vb) {
    s16x4 r; asm volatile("ds_read_b64_tr_b16 %0, %1 offset:%2" : "=&v"(r) : "v"(vb), "i"(OFF) : "memory"); return r;
}
template <int D0> __device__ __forceinline__ void pv_one(f32x16& od, int vb, bf16x8 pa0, bf16x8 pa1, bf16x8 pa2, bf16x8 pa3) {
    const s16x4 l0 = tr_read<v_rd_off(D0, 0, 0)>(vb), h0 = tr_read<v_rd_off(D0, 0, 1)>(vb), l1 = tr_read<v_rd_off(D0, 1, 0)>(vb), h1 = tr_read<v_rd_off(D0, 1, 1)>(vb);
    const s16x4 l2 = tr_read<v_rd_off(D0, 2, 0)>(vb), h2 = tr_read<v_rd_off(D0, 2, 1)>(vb), l3 = tr_read<v_rd_off(D0, 3, 0)>(vb), h3 = tr_read<v_rd_off(D0, 3, 1)>(vb);
    asm volatile("s_waitcnt lgkmcnt(0)" ::: "memory"); SBAR();
#define PK(L, H) (bf16x8){L[0], L[1], L[2], L[3], H[0], H[1], H[2], H[3]}
    od = __builtin_amdgcn_mfma_f32_32x32x16_bf16(pa0, PK(l0, h0), od, 0, 0, 0);
    od = __builtin_amdgcn_mfma_f32_32x32x16_bf16(pa1, PK(l1, h1), od, 0, 0, 0);
    od = __builtin_amdgcn_mfma_f32_32x32x16_bf16(pa2, PK(l2, h2), od, 0, 0, 0);
    od = __builtin_amdgcn_mfma_f32_32x32x16_bf16(pa3, PK(l3, h3), od, 0, 0, 0);
#undef PK
}
__device__ __forceinline__ void pv_d0(f32x16* o, int vb, bf16x8 pa0, bf16x8 pa1, bf16x8 pa2, bf16x8 pa3) {
    pv_one<0>(o[0], vb, pa0, pa1, pa2, pa3); pv_one<1>(o[1], vb, pa0, pa1, pa2, pa3); pv_one<2>(o[2], vb, pa0, pa1, pa2, pa3); pv_one<3>(o[3], vb, pa0, pa1, pa2, pa3);
}
#define PK4(P, BASE, OUT) do { unsigned a0 = cvtpk(P[BASE + 0], P[BASE + 1]), a1 = cvtpk(P[BASE + 2], P[BASE + 3]);   \
    unsigned b0 = cvtpk(P[BASE + 4], P[BASE + 5]), b1 = cvtpk(P[BASE + 6], P[BASE + 7]);                              \
    auto r0 = __builtin_amdgcn_permlane32_swap(a0, b0, false, false); auto r1 = __builtin_amdgcn_permlane32_swap(a1, b1, false, false); \
    u32x4 w = {r0[0], r1[0], r0[1], r1[1]}; OUT = *reinterpret_cast<bf16x8*>(&w); } while (0)
__device__ __forceinline__ float halfswap_add(float v) {
    auto rr = __builtin_amdgcn_permlane32_swap(__float_as_uint(v), __float_as_uint(v), false, false);
    return __uint_as_float(rr[0]) + __uint_as_float(rr[1]);
}

__device__ __forceinline__ void ada_phase(const Params& p, unsigned char* lds) {
    float* sc = (float*)lds;
    float* red = (float*)(lds + 40960);
    float* mod = (float*)(p.ws + WS_MOD);
    const int tid = threadIdx.x;
    for (int j = blockIdx.x; j < 192; j += gridDim.x) {
        const int l = j / 96, n0 = (j % 96) * 64;
        for (int i = tid; i < 9 * 1024; i += NTHREADS) { const int r = i >> 10, k = i & 1023; const float v = r < 8 ? p.c[r * 1024 + k] : p.c_ctx[k]; sc[i] = v / (1.f + expf(-v)); }
        __syncthreads();
        const int col = tid & 63, ks = tid >> 6;
        float acc[9];
#pragma unroll
        for (int r = 0; r < 9; ++r) acc[r] = 0.f;
        const float* wp = p.ada_w + ((size_t)l * 1024 + ks * 128) * 6144 + n0 + col;
#pragma unroll 8
        for (int kk = 0; kk < 128; ++kk) { const float w = wp[(size_t)kk * 6144];
#pragma unroll
            for (int r = 0; r < 9; ++r) acc[r] += sc[r * 1024 + ks * 128 + kk] * w; }
#pragma unroll
        for (int r = 0; r < 9; ++r) red[(ks * 9 + r) * 64 + col] = acc[r];
        __syncthreads();
        for (int i = tid; i < 576; i += NTHREADS) { const int r = i >> 6, cc = i & 63; float s = p.ada_b[l * 6144 + n0 + cc];
            for (int k2 = 0; k2 < 8; ++k2) s += red[(k2 * 9 + r) * 64 + cc];
            mod[(size_t)(l * 9 + r) * 6144 + n0 + cc] = s; }
        __syncthreads();
    }
}
__device__ __forceinline__ void wconv_phase(const Params& p, unsigned char* lds) {
    float* tl = (float*)lds;
    const int tid = threadIdx.x;
    const int T0 = 16 * 60, T1 = T0 + 16 * 16, T2 = T1 + 16 * 48, T3 = T2 + 16 * 16, T4 = T3 + 16 * 88, T5 = T4 + 16 * 88, T6 = T5 + 44 * 16, T7 = T6 + 44 * 16;
#define WC_DECODE(t) \
        const float* src; bf16_t* dst; int K, N, NP, mode = 0, tt; \
        if ((t) < T0) { src = p.even_w_in; dst = (bf16_t*)(p.ws + WS_W_EVIN); K = 1024; N = EV_N; NP = EV_NP; tt = (t); } \
        else if ((t) < T1) { src = p.even_w_out; dst = (bf16_t*)(p.ws + WS_W_EVOUT); K = 1024; N = 1024; NP = 1024; tt = (t) - T0; } \
        else if ((t) < T2) { src = p.odd_w_in; dst = (bf16_t*)(p.ws + WS_W_ODIN); K = 1024; N = OD_N; NP = OD_N; tt = (t) - T1; } \
        else if ((t) < T3) { src = p.odd_w_out; dst = (bf16_t*)(p.ws + WS_W_ODOUT); K = 1024; N = 1024; NP = 1024; tt = (t) - T2; } \
        else if ((t) < T4) { src = p.ffn_w_in; dst = (bf16_t*)(p.ws + WS_W_FFIN); K = 1024; N = 2 * FF; NP = 2 * FF; mode = 1; tt = (t) - T3; } \
        else if ((t) < T5) { src = p.ffn_w_in + (size_t)1024 * 2 * FF; dst = (bf16_t*)(p.ws + WS_W_FFIN) + (size_t)2 * FF * 1024; K = 1024; N = 2 * FF; NP = 2 * FF; mode = 1; tt = (t) - T4; } \
        else if ((t) < T6) { src = p.ffn_w_out; dst = (bf16_t*)(p.ws + WS_W_FFOUT); K = FF; N = 1024; NP = 1024; tt = (t) - T5; } \
        else { src = p.ffn_w_out + (size_t)FF * 1024; dst = (bf16_t*)(p.ws + WS_W_FFOUT) + (size_t)1024 * FF; K = FF; N = 1024; NP = 1024; tt = (t) - T6; } \
        const int nnt = NP / 64; const int k0 = (tt / nnt) * 64, n0 = (tt % nnt) * 64; \
        int sn0; if (mode == 1) { const int tb = n0 >> 8, bj = (n0 >> 7) & 1, i0 = n0 & 127; sn0 = bj * FF + tb * 128 + i0; } else sn0 = n0;
    float rg[8];
#define WC_LOAD(t) do { WC_DECODE(t) (void)dst; _Pragma("unroll") for (int i = 0; i < 8; ++i) { const int e = tid + NTHREADS * i, kk = e >> 6, nn = e & 63; const int sn = sn0 + nn; \
        rg[i] = (sn < N) ? src[(size_t)(k0 + kk) * N + sn] : 0.f; } } while (0)
    int t = blockIdx.x;
    if (t < T7) WC_LOAD(t);
    for (; t < T7; t += gridDim.x) {
#pragma unroll
        for (int i = 0; i < 8; ++i) { const int e = tid + NTHREADS * i; tl[(e >> 6) * 65 + (e & 63)] = rg[i]; }
        __syncthreads();
        { WC_DECODE(t) (void)src; (void)N; (void)sn0;
          if (t + (int)gridDim.x < T7) WC_LOAD(t + (int)gridDim.x);
          for (int e = tid; e < 2048; e += NTHREADS) { const int nn = e >> 5, k2 = (e & 31) * 2;
              *(unsigned*)(dst + (size_t)(n0 + nn) * K + k0 + k2) = cvtpk(tl[k2 * 65 + nn], tl[(k2 + 1) * 65 + nn]); } }
        __syncthreads();
    }
#undef WC_DECODE
#undef WC_LOAD
}

__device__ __forceinline__ void norm_phase(const Params& p, const float* xlat, const float* xctx, int l, int which, int nrows) {
    const int lane = threadIdx.x & 63, wid = threadIdx.x >> 6;
    bf16_t* h = (bf16_t*)(p.ws + WS_H);
    const float* mod = (const float*)(p.ws + WS_MOD) + (size_t)l * 9 * 6144;
    const float* gain = (which ? p.norm_ffn : p.norm_mix) + l * 1024;
    const int shoff = which ? 3072 : 0, scoff = which ? 4096 : 1024;
    const int stride = gridDim.x * 8;
    f32x4 gn[4];
#pragma unroll
    for (int i = 0; i < 4; ++i) gn[i] = *(const f32x4*)(gain + lane * 4 + 256 * i);
    for (int row = blockIdx.x * 8 + wid; row < nrows; row += 2 * stride) {
        const int rowB = row + stride; const bool hasB = rowB < nrows; const int rB = hasB ? rowB : row;
        const float* srcA = row < NLAT ? xlat + (size_t)row * DM : xctx + (size_t)(row - NLAT) * DM;
        const float* srcB = rB < NLAT ? xlat + (size_t)rB * DM : xctx + (size_t)(rB - NLAT) * DM;
        const float* mrA = mod + (size_t)(row < NLAT ? (row >> 13) : 8) * 6144;
        const float* mrB = mod + (size_t)(rB < NLAT ? (rB >> 13) : 8) * 6144;
        f32x4 va[4], vb[4], sa[4], ha[4], sb[4], hb[4];
#pragma unroll
        for (int i = 0; i < 4; ++i) { const int c0 = lane * 4 + 256 * i;
            va[i] = *(const f32x4*)(srcA + c0); vb[i] = *(const f32x4*)(srcB + c0);
            sa[i] = *(const f32x4*)(mrA + scoff + c0); ha[i] = *(const f32x4*)(mrA + shoff + c0);
            sb[i] = *(const f32x4*)(mrB + scoff + c0); hb[i] = *(const f32x4*)(mrB + shoff + c0); }
#pragma unroll
        for (int rr = 0; rr < 2; ++rr) {
            if (rr == 1 && !hasB) break;
            const int r = rr ? rowB : row;
            float ss = 0.f;
#pragma unroll
            for (int i = 0; i < 4; ++i) { const f32x4 v = rr ? vb[i] : va[i]; ss += v[0] * v[0] + v[1] * v[1] + v[2] * v[2] + v[3] * v[3]; }
#pragma unroll
            for (int o = 1; o < 64; o <<= 1) ss += __shfl_xor(ss, o);
            const float rstd = rsqrtf(ss * (1.f / 1024.f) + 1e-6f);
#pragma unroll
            for (int i = 0; i < 4; ++i) { const int c0 = lane * 4 + 256 * i; const f32x4 v = rr ? vb[i] : va[i], s1 = rr ? sb[i] : sa[i], sh = rr ? hb[i] : ha[i];
                float y[4];
#pragma unroll
                for (int j = 0; j < 4; ++j) y[j] = v[j] * rstd * gn[i][j] * (1.f + s1[j]) + sh[j];
                u32x2 w; w.x = cvtpk(y[0], y[1]); w.y = cvtpk(y[2], y[3]);
                *(u32x2*)(h + (size_t)r * DM + c0) = w; }
        }
    }
}

__device__ __forceinline__ void prep0_phase(const Params& p) {
    const int lane0 = threadIdx.x & 63, wid = threadIdx.x >> 6;
    bf16_t* proj = (bf16_t*)(p.ws + WS_PROJ);
    bf16_t* qkvp = (bf16_t*)p.out;
    float* gbuf = (float*)(p.ws + WS_GATES);
    const float* ropec = (const float*)(p.ws + WS_ROPE); const float* ropes = ropec + SEQ * 32;
    constexpr int RB = 8;
    for (int blk = blockIdx.x * 8 + wid; blk < MTOT / RB; blk += gridDim.x * 8) {
        int lane = lane0; asm volatile("" : "+v"(lane));
        const int row0 = blk * RB; const bool lat = row0 < NLAT; const int t0 = lat ? (row0 & 8191) : ((row0 - NLAT) & 255); const int len = lat ? SEQ : CTXL;
        const int dsub = (lane & 7) * 8;
        {
            float gq[8], gk[8];
#pragma unroll
            for (int i = 0; i < 8; ++i) { gq[i] = p.diff_qk_gain[dsub + i] * (0.125f * 1.4426950408889634f); gk[i] = p.diff_qk_gain[64 + dsub + i]; }
#pragma unroll
            for (int i0 = 0; i0 < RB; i0 += 4) {
                bf16x8 raw[4][2]; f32x4 c4[4], s4[4];
#pragma unroll
                for (int i = 0; i < 4; ++i) { const bf16_t* P = proj + (size_t)(row0 + i0 + i) * EV_NP;
                    raw[i][0] = *(const bf16x8*)(P + lane * 8); raw[i][1] = *(const bf16x8*)(P + 512 + lane * 8);
                    c4[i] = (f32x4){1.f, 1.f, 1.f, 1.f}; s4[i] = (f32x4){0.f, 0.f, 0.f, 0.f};
                    if (lat) { c4[i] = *(const f32x4*)(ropec + (t0 + i0 + i) * 32 + (lane & 7) * 4); s4[i] = *(const f32x4*)(ropes + (t0 + i0 + i) * 32 + (lane & 7) * 4); } }
#pragma unroll
                for (int i = 0; i < 4; ++i) { bf16_t* P = proj + (size_t)(row0 + i0 + i) * EV_NP;
#pragma unroll
                    for (int which = 0; which < 2; ++which) {
                        float v[8]; unpack8(raw[i][which], v);
                        float ss = 0.f;
#pragma unroll
                        for (int e = 0; e < 8; ++e) ss += v[e] * v[e];
                        ss += __shfl_xor(ss, 1); ss += __shfl_xor(ss, 2); ss += __shfl_xor(ss, 4);
                        const float rstd = rsqrtf(ss * (1.f / 64.f) + 1e-6f);
#pragma unroll
                        for (int e = 0; e < 8; ++e) v[e] = v[e] * rstd * (which ? gk[e] : gq[e]);
#pragma unroll
                        for (int e = 0; e < 4; ++e) { const float x0 = v[2 * e], x1 = v[2 * e + 1]; v[2 * e] = x0 * c4[i][e] - x1 * s4[i][e]; v[2 * e + 1] = x0 * s4[i][e] + x1 * c4[i][e]; }
                        *(bf16x8*)(P + which * 512 + lane * 8) = pack8(v);
                    } }
            }
        }
#pragma unroll 1
        for (int g = 0; g < 3; ++g) {
            const int c0 = g * 512 + lane * 8;
            float w[5][8];
#pragma unroll
            for (int j = 0; j < 5; ++j) { const f32x4 w0 = *(const f32x4*)(p.gdn_conv + j * 1536 + c0), w1 = *(const f32x4*)(p.gdn_conv + j * 1536 + c0 + 4);
#pragma unroll
                for (int e = 0; e < 4; ++e) { w[j][e] = w0[e]; w[j][4 + e] = w1[e]; } }
            const bf16_t* src = proj + (size_t)row0 * EV_NP + 1536 + c0;
            bf16x8 raw[RB + 4];
#pragma unroll
            for (int k = 0; k < RB + 4; ++k) { const int dt = k - 2; raw[k] = (bf16x8){0, 0, 0, 0, 0, 0, 0, 0};
                if (t0 + dt >= 0 && t0 + dt < len) raw[k] = *(const bf16x8*)(src + (ptrdiff_t)dt * EV_NP); }
            const float nsc = g == 0 ? 0.08838834764831845f : 1.f;
#pragma unroll
            for (int i = 0; i < RB; ++i) {
                float xm2[8], xm1[8], x0[8], xp1[8], xp2[8];
                unpack8(raw[i], xm2); unpack8(raw[i + 1], xm1); unpack8(raw[i + 2], x0); unpack8(raw[i + 3], xp1); unpack8(raw[i + 4], xp2);
                float y[8];
#pragma unroll
                for (int e = 0; e < 8; ++e) { y[e] = w[0][e] * xm2[e] + w[1][e] * xm1[e] + w[2][e] * x0[e] + w[3][e] * xp1[e] + w[4][e] * xp2[e]; y[e] = y[e] * __builtin_amdgcn_rcpf(1.f + __expf(-y[e])); }
                if (g < 2) { float ss = 0.f;
#pragma unroll
                    for (int e = 0; e < 8; ++e) ss += y[e] * y[e];
                    ss += __shfl_xor(ss, 1); ss += __shfl_xor(ss, 2); ss += __shfl_xor(ss, 4); ss += __shfl_xor(ss, 8);
                    const float sc_ = rsqrtf(ss + 1e-6f) * nsc;
#pragma unroll
                    for (int e = 0; e < 8; ++e) y[e] *= sc_; }
                *(bf16x8*)(qkvp + (size_t)(row0 + i) * 1536 + c0) = pack8(y);
            }
        }
#pragma unroll
        for (int k = 0; k < RB / 4; ++k) { const int idx = lane + 64 * k, i = idx >> 4, gi = idx & 15;
            const float gvv = bf2f(proj[(size_t)(row0 + i) * EV_NP + 3584 + gi]); float o;
            if (gi < 8) o = 1.f / (1.f + expf(-gvv));
            else { const float z = gvv + p.gdn_dt_bias[gi - 8]; const float sp = z > 20.f ? z : log1pf(expf(z)); o = -expf(p.gdn_a_log[gi - 8]) * sp; }
            gbuf[(size_t)(row0 + i) * 16 + gi] = o; }
    }
}

__device__ __forceinline__ int gdn_row(int b, int pc, int tau, int dir) {
    const int tt = dir ? 63 - tau : tau;
    return pc < 4 ? NLAT + b * CTXL + pc * 64 + tt : b * SEQ + (pc - 4) * 64 + tt;
}
__device__ __forceinline__ void gdn_pre_phase(const Params& p, unsigned char* lds) {
    const int lane = threadIdx.x & 63, wid = threadIdx.x >> 6;
    float* Lw = (float*)(lds + wid * 16896);
    float* gs = Lw + 4096; float* bs = gs + 64;
    const bf16_t* qkvp = (const bf16_t*)p.out;
    const float* gbuf = (const float*)(p.ws + WS_GATES);
    bf16_t* Tb = (bf16_t*)(p.ws + WS_T); bf16_t* Ab = (bf16_t*)(p.ws + WS_AQK);
    float* gv = (float*)(p.ws + WS_GV); float* bv = (float*)(p.ws + WS_BV);
    const int lane0 = lane;
    for (int cp = blockIdx.x * 8 + wid; cp < NCHUNKP; cp += gridDim.x * 8) {
        int lane = lane0; asm volatile("" : "+v"(lane));
        const int r32 = lane & 31, hi = lane >> 5;
        const int pc = cp % 132, ch = cp / 132, dir = ch & 1, h = (ch >> 1) & 3, b = ch >> 3;
        float g_keep, be_keep;
        { const int R = gdn_row(b, pc, lane, dir);
          float g = gbuf[(size_t)R * 16 + 8 + dir * 4 + h]; const float be = gbuf[(size_t)R * 16 + dir * 4 + h];
#pragma unroll
          for (int o = 1; o < 64; o <<= 1) { const float t = __shfl_up(g, o); if (lane >= o) g += t; }
          gs[lane] = g; bs[lane] = be; g_keep = g; be_keep = be; }
        bf16x8 kf[2][8], qf[2][8];
#pragma unroll
        for (int mi = 0; mi < 2; ++mi) { const size_t R = (size_t)gdn_row(b, pc, 32 * mi + r32, dir);
#pragma unroll
            for (int d0 = 0; d0 < 8; ++d0) { kf[mi][d0] = *(const bf16x8*)(qkvp + R * 1536 + 512 + h * 128 + d0 * 16 + hi * 8);
                                             qf[mi][d0] = *(const bf16x8*)(qkvp + R * 1536 + h * 128 + d0 * 16 + hi * 8); } }
        { const float gl_ = __shfl(g_keep, 63); gv[(size_t)cp * 64 + lane] = expf(g_keep); bv[(size_t)cp * 64 + lane] = be_keep; ((float*)(p.ws + WS_EL))[(size_t)cp * 64 + lane] = expf(gl_ - g_keep); }
        bf16_t* Ao = Ab + (size_t)cp * 4096;
#pragma unroll
        for (int mi = 0; mi < 2; ++mi) {
#pragma unroll
            for (int ni = 0; ni <= mi; ++ni) {
                f32x16 ckk = {}, cqk = {};
#pragma unroll
                for (int d0 = 0; d0 < 8; ++d0) { ckk = __builtin_amdgcn_mfma_f32_32x32x16_bf16(kf[mi][d0], kf[ni][d0], ckk, 0, 0, 0);
                                                 cqk = __builtin_amdgcn_mfma_f32_32x32x16_bf16(qf[mi][d0], kf[ni][d0], cqk, 0, 0, 0); }
                const int sg = 32 * ni + r32; const float gsg = gs[sg];
#pragma unroll
                for (int r = 0; r < 16; ++r) { const int tau = 32 * mi + crow(r, hi);
                    const float dec = tau >= sg ? __expf(gs[tau] - gsg) : 0.f;
                    Lw[tau * 64 + sg] = tau > sg ? bs[tau] * dec * ckk[r] : 0.f;
                    Ao[tau * 64 + sg] = f2bf(cqk[r] * dec); }
                asm volatile("" ::: "memory");
            }
        }
#pragma unroll
        for (int r = 0; r < 16; ++r) Ao[crow(r, hi) * 64 + 32 + r32] = 0;
        float Tc[64];
#pragma unroll
        for (int i = 0; i < 64; ++i) { float a = (i == lane) ? 1.f : 0.f;
#pragma unroll
            for (int j = 0; j < i; ++j) a -= Lw[i * 64 + j] * Tc[j];
            Tc[i] = a; asm volatile("" ::: "memory"); }
        bf16_t* To = Tb + (size_t)cp * 4096;
#pragma unroll
        for (int i = 0; i < 64; ++i) To[i * 64 + lane] = f2bf(Tc[i]);
    }
}

constexpr int G_KV = 0, G_QA = 16384, G_TT = 32768, G_AQ = G_TT + 9216, G_RT = G_AQ + 9216, G_UT = G_RT + 4608, G_UP = G_UT + 4608,
              G_ST = G_UP + 4608, G_VS = G_ST + 8704, G_GS = G_VS + 4096, G_BS = G_GS + 256, G_EL = G_BS + 256, G_END = G_EL + 256;
__device__ __forceinline__ void gdn_scan_phase(const Params& p, unsigned char* lds) {
    const int tid = threadIdx.x, lane0 = tid & 63, wid = tid >> 6;
    const bf16_t* qkvp = (const bf16_t*)p.out;
    const bf16_t* Tb = (const bf16_t*)(p.ws + WS_T); const bf16_t* Ab = (const bf16_t*)(p.ws + WS_AQK);
    const float* gv = (const float*)(p.ws + WS_GV); const float* bv = (const float*)(p.ws + WS_BV);
    bf16_t* obuf = (bf16_t*)(p.ws + WS_H);
    const float* gsl = (const float*)(lds + G_GS); const float* bsl = (const float*)(lds + G_BS); const float* esl = (const float*)(lds + G_EL);
    const int sr = tid >> 4, sc = (tid & 15) * 8;
    const int vblk = (gridDim.x % 8 == 0) ? (int)((blockIdx.x & 7) * (gridDim.x >> 3) + (blockIdx.x >> 3)) : (int)blockIdx.x;
    for (int wi = vblk; wi < 256; wi += gridDim.x) {
        const int chain = wi >> 2, cs = wi & 3, b = chain >> 3, h = (chain >> 1) & 3, dir = chain & 1;
        f32x16 Sacc = {};
        for (int i = tid; i < 8704 / 4; i += NTHREADS) ((unsigned*)(lds + G_ST))[i] = 0u;
        bf16x8 sk0, sk1, sq0, sq1, sT, sA, sV; float sg = 0.f;
#define GLOAD(step) do { const int pc_ = dir == 0 ? (step) : ((step) < 4 ? 3 - (step) : 4 + 127 - ((step) - 4)); \
        const size_t cp_ = (size_t)chain * 132 + pc_; \
        const size_t R0_ = (size_t)gdn_row(b, pc_, sr, dir), R1_ = (size_t)gdn_row(b, pc_, 32 + sr, dir); \
        sk0 = *(const bf16x8*)(qkvp + R0_ * 1536 + 512 + h * 128 + sc); sk1 = *(const bf16x8*)(qkvp + R1_ * 1536 + 512 + h * 128 + sc); \
        sq0 = *(const bf16x8*)(qkvp + R0_ * 1536 + h * 128 + sc); sq1 = *(const bf16x8*)(qkvp + R1_ * 1536 + h * 128 + sc); \
        sT = *(const bf16x8*)(Tb + cp_ * 4096 + tid * 8); sA = *(const bf16x8*)(Ab + cp_ * 4096 + tid * 8); \
        if (tid < 256) { const size_t Rv_ = (size_t)gdn_row(b, pc_, tid >> 2, dir); sV = *(const bf16x8*)(qkvp + Rv_ * 1536 + 1024 + h * 128 + cs * 32 + (tid & 3) * 8); } \
        if (tid < 64) sg = gv[cp_ * 64 + tid]; else if (tid < 128) sg = bv[cp_ * 64 + tid - 64]; else if (tid < 192) sg = ((const float*)(p.ws + WS_EL))[cp_ * 64 + tid - 128]; } while (0)
#define GWRITE() do { *(bf16x8*)(lds + G_KV + v_st(sr, sc)) = sk0; *(bf16x8*)(lds + G_KV + v_st(32 + sr, sc)) = sk1; \
        *(bf16x8*)(lds + G_QA + KSWZ(sr, sc * 2)) = sq0; *(bf16x8*)(lds + G_QA + KSWZ(32 + sr, sc * 2)) = sq1; \
        *(bf16x8*)(lds + G_TT + (tid >> 3) * 144 + (tid & 7) * 16) = sT; *(bf16x8*)(lds + G_AQ + (tid >> 3) * 144 + (tid & 7) * 16) = sA; \
        if (tid < 256) *(bf16x8*)(lds + G_VS + (tid >> 2) * 64 + (tid & 3) * 16) = sV; \
        if (tid < 192) ((float*)(lds + G_GS))[tid] = sg; } while (0)
        GLOAD(0);
        for (int step = 0; step < 132; ++step) {
            GWRITE();
            __syncthreads();
            if (step + 1 < 132) GLOAD(step + 1);
            int lane = lane0; asm volatile("" : "+v"(lane));
            const int r32 = lane & 31, hi = lane >> 5;
            const int vb0 = (int)(uintptr_t)(lds + G_KV) + v_rd_base(lane);
            const int pc = dir == 0 ? step : (step < 4 ? 3 - step : 4 + 127 - (step - 4));
            f32x16 acc = {};
            const int mi = wid & 1;
            if (wid < 4) {
                f32x16 acc2 = {};
                if (wid < 2) {
#pragma unroll
                    for (int d0 = 0; d0 < 8; d0 += 2) {
                        const bf16x8 a0 = *(const bf16x8*)(lds + G_KV + v_st(32 * mi + r32, d0 * 16 + hi * 8)), a1 = *(const bf16x8*)(lds + G_KV + v_st(32 * mi + r32, d0 * 16 + 16 + hi * 8));
                        const bf16x8 b0 = *(const bf16x8*)(lds + G_ST + r32 * 272 + (d0 * 16 + hi * 8) * 2), b1 = *(const bf16x8*)(lds + G_ST + r32 * 272 + (d0 * 16 + 16 + hi * 8) * 2);
                        acc = __builtin_amdgcn_mfma_f32_32x32x16_bf16(a0, b0, acc, 0, 0, 0);
                        acc2 = __builtin_amdgcn_mfma_f32_32x32x16_bf16(a1, b1, acc2, 0, 0, 0); }
                } else {
#pragma unroll
                    for (int d0 = 0; d0 < 8; d0 += 2) {
                        const bf16x8 a0 = *(const bf16x8*)(lds + G_QA + KSWZ(32 * mi + r32, (d0 * 16 + hi * 8) * 2)), a1 = *(const bf16x8*)(lds + G_QA + KSWZ(32 * mi + r32, (d0 * 16 + 16 + hi * 8) * 2));
                        const bf16x8 b0 = *(const bf16x8*)(lds + G_ST + r32 * 272 + (d0 * 16 + hi * 8) * 2), b1 = *(const bf16x8*)(lds + G_ST + r32 * 272 + (d0 * 16 + 16 + hi * 8) * 2);
                        acc = __builtin_amdgcn_mfma_f32_32x32x16_bf16(a0, b0, acc, 0, 0, 0);
                        acc2 = __builtin_amdgcn_mfma_f32_32x32x16_bf16(a1, b1, acc2, 0, 0, 0); }
                }
#pragma unroll
                for (int r = 0; r < 16; ++r) acc[r] += acc2[r];
                if (wid < 2) {
#pragma unroll
                    for (int g4 = 0; g4 < 4; ++g4) { float rv[4];
#pragma unroll
                        for (int j = 0; j < 4; ++j) { const int tau = 32 * mi + 8 * g4 + 4 * hi + j;
                            const float vv = bf2f(*(const bf16_t*)(lds + G_VS + tau * 64 + r32 * 2));
                            rv[j] = bsl[tau] * (vv - gsl[tau] * acc[g4 * 4 + j]); }
                        u32x2 w; w.x = cvtpk(rv[0], rv[1]); w.y = cvtpk(rv[2], rv[3]);
                        *(u32x2*)(lds + G_RT + r32 * 144 + (32 * mi + 8 * g4 + 4 * hi) * 2) = w; }
                } else {
#pragma unroll
                    for (int r = 0; r < 16; ++r) acc[r] *= gsl[32 * mi + crow(r, hi)];
                }
            }
            __syncthreads();
            if (wid < 2) {
                f32x16 u = {}, u2 = {};
#pragma unroll
                for (int s = 0; s < 4; s += 2) {
                    const bf16x8 a0 = *(const bf16x8*)(lds + G_TT + (32 * mi + r32) * 144 + (16 * s + hi * 8) * 2), a1 = *(const bf16x8*)(lds + G_TT + (32 * mi + r32) * 144 + (16 * s + 16 + hi * 8) * 2);
                    const bf16x8 b0 = *(const bf16x8*)(lds + G_RT + r32 * 144 + (16 * s + hi * 8) * 2), b1 = *(const bf16x8*)(lds + G_RT + r32 * 144 + (16 * s + 16 + hi * 8) * 2);
                    u = __builtin_amdgcn_mfma_f32_32x32x16_bf16(a0, b0, u, 0, 0, 0);
                    u2 = __builtin_amdgcn_mfma_f32_32x32x16_bf16(a1, b1, u2, 0, 0, 0); }
#pragma unroll
                for (int r = 0; r < 16; ++r) u[r] += u2[r];
#pragma unroll
                for (int g4 = 0; g4 < 4; ++g4) { float uv[4], up[4];
#pragma unroll
                    for (int j = 0; j < 4; ++j) { const int tau = 32 * mi + 8 * g4 + 4 * hi + j; uv[j] = u[g4 * 4 + j]; up[j] = uv[j] * esl[tau]; }
                    u32x2 w; w.x = cvtpk(uv[0], uv[1]); w.y = cvtpk(uv[2], uv[3]);
                    *(u32x2*)(lds + G_UT + r32 * 144 + (32 * mi + 8 * g4 + 4 * hi) * 2) = w;
                    u32x2 w2; w2.x = cvtpk(up[0], up[1]); w2.y = cvtpk(up[2], up[3]);
                    *(u32x2*)(lds + G_UP + r32 * 144 + (32 * mi + 8 * g4 + 4 * hi) * 2) = w2; }
            }
            __syncthreads();
            if (wid == 2 || wid == 3) {
#pragma unroll
                for (int s = 0; s < 4; ++s) {
                    const bf16x8 a = *(const bf16x8*)(lds + G_AQ + (32 * mi + r32) * 144 + (16 * s + hi * 8) * 2);
                    const bf16x8 bb = *(const bf16x8*)(lds + G_UT + r32 * 144 + (16 * s + hi * 8) * 2);
                    acc = __builtin_amdgcn_mfma_f32_32x32x16_bf16(a, bb, acc, 0, 0, 0); }
#pragma unroll
                for (int r = 0; r < 16; ++r) { const size_t R = (size_t)gdn_row(b, pc, 32 * mi + crow(r, hi), dir);
                    obuf[((size_t)dir * MTOT + R) * 512 + h * 128 + cs * 32 + r32] = f2bf(acc[r]); }
            } else if (wid >= 4) {
                const float gl = gsl[63];
#pragma unroll
                for (int r = 0; r < 16; ++r) Sacc[r] *= gl;
                const bf16x8 pa0 = *(const bf16x8*)(lds + G_UP + r32 * 144 + (0 + hi * 8) * 2), pa1 = *(const bf16x8*)(lds + G_UP + r32 * 144 + (16 + hi * 8) * 2),
                             pa2 = *(const bf16x8*)(lds + G_UP + r32 * 144 + (32 + hi * 8) * 2), pa3 = *(const bf16x8*)(lds + G_UP + r32 * 144 + (48 + hi * 8) * 2);
                const int d0 = wid - 4;
                if (d0 == 0) pv_one<0>(Sacc, vb0, pa0, pa1, pa2, pa3); else if (d0 == 1) pv_one<1>(Sacc, vb0, pa0, pa1, pa2, pa3);
                else if (d0 == 2) pv_one<2>(Sacc, vb0, pa0, pa1, pa2, pa3); else pv_one<3>(Sacc, vb0, pa0, pa1, pa2, pa3);
#pragma unroll
                for (int r = 0; r < 16; ++r) *(bf16_t*)(lds + G_ST + crow(r, hi) * 272 + (32 * d0 + r32) * 2) = f2bf(Sacc[r]);
            }
            __syncthreads();
        }
#undef GLOAD
#undef GWRITE
    }
}

__device__ __forceinline__ void gdn_post_phase(const Params& p) {
    const int lane = threadIdx.x & 63, wid = threadIdx.x >> 6;
    const bf16_t* obuf = (const bf16_t*)(p.ws + WS_H);
    const bf16_t* proj = (const bf16_t*)(p.ws + WS_PROJ);
    bf16_t* mix = (bf16_t*)(p.ws + WS_MIX);
    const int d = (lane & 15) * 8;
    for (int row = blockIdx.x * 8 + wid; row < MTOT; row += gridDim.x * 8) {
        float a[8], bb[8], g[8], y[8];
        unpack8(*(const bf16x8*)(obuf + (size_t)row * 512 + lane * 8), a);
        unpack8(*(const bf16x8*)(obuf + ((size_t)MTOT + row) * 512 + lane * 8), bb);
        unpack8(*(const bf16x8*)(proj + (size_t)row * EV_NP + 3072 + lane * 8), g);
        float ss = 0.f;
#pragma unroll
        for (int i = 0; i < 8; ++i) { a[i] += bb[i]; ss += a[i] * a[i]; }
        ss += __shfl_xor(ss, 1); ss += __shfl_xor(ss, 2); ss += __shfl_xor(ss, 4); ss += __shfl_xor(ss, 8);
        const float rstd = rsqrtf(ss * (1.f / 128.f) + 1e-6f);
#pragma unroll
        for (int i = 0; i < 8; ++i) y[i] = a[i] * rstd * p.gdn_norm[d + i] * (g[i] * __builtin_amdgcn_rcpf(1.f + __expf(-g[i])));
        *(bf16x8*)(mix + (size_t)row * DM + 512 + lane * 8) = pack8(y);
    }
}

__device__ __forceinline__ void diffattn_phase(const Params& p, unsigned char* lds) {
    const int tid = threadIdx.x, wid = tid >> 6, lane = tid & 63, r32 = lane & 31, hi = lane >> 5;
    const bf16_t* proj = (const bf16_t*)(p.ws + WS_PROJ);
    bf16_t* mix = (bf16_t*)(p.ws + WS_MIX);
    float s01 = 0.f, s23 = 0.f;
    for (int i = 0; i < 64; ++i) { s01 += p.diff_lambda[i] * p.diff_lambda[64 + i]; s23 += p.diff_lambda[128 + i] * p.diff_lambda[192 + i]; }
    const float lam = expf(s01) - expf(s23) + 0.2f;
    float* X = (float*)lds; float* li = (float*)(lds + 131072) + wid * 64;
    LAS unsigned char* ldsl = (LAS unsigned char*)lds;
    int koff[2], voff[2];
#pragma unroll
    for (int i = 0; i < 2; ++i) {
        const int g = i * 512 + tid;
        { const int row = g >> 4, cg = (g & 15) ^ (row & 7); koff[i] = row * EV_NP + cg * 8; }
        { const int o = g * 16, st = o >> 9, w = o & 511, kk = (st >> 2) * 8 + (w >> 6);
          const int k = (kk & ~0xC) | ((kk & 4) << 1) | ((kk & 8) >> 1), cc = (st & 3) * 32 + ((w & 63) >> 4) * 8; voff[i] = k * EV_NP + cc; }
    }
    const int vbase = (int)(uintptr_t)lds + v_rd_base(lane);
    const int map = wid >> 2, wq = wid & 3;
    unsigned char* Qs = lds + 98304 + wid * 4096 + lane * 16;
    const int vblk = (gridDim.x % 8 == 0) ? (int)((blockIdx.x & 7) * (gridDim.x >> 3) + (blockIdx.x >> 3)) : (int)blockIdx.x;
    for (int it = vblk; it < 2112; it += gridDim.x) {
        int b, h, NT, qrow0;
        if (it < 2048) { b = it >> 8; h = (it >> 6) & 3; const int qb = it & 63; NT = 132; qrow0 = b * SEQ + qb * 128; }
        else { const int j = it - 2048; b = j >> 3; h = (j >> 1) & 3; NT = 4; qrow0 = NLAT + b * CTXL + (j & 1) * 128; }
        bf16x8 qr[4];
        { const bf16_t* qp = proj + (size_t)(qrow0 + 32 * wq + r32) * EV_NP + h * 128 + map * 64 + hi * 8;
#pragma unroll
          for (int d0 = 0; d0 < 4; ++d0) qr[d0] = *(const bf16x8*)(qp + d0 * 16); }
        f32x16 o[4] = {}; float lsum = 0.f;
#define DDMA(j, bo) do { const bf16_t* pp_ = proj + (size_t)((j) < 4 ? NLAT + b * CTXL + 64 * (j) : b * SEQ + 64 * ((j) - 4)) * EV_NP + h * 128; \
        _Pragma("unroll") for (int i_ = 0; i_ < 2; ++i_) { \
            __builtin_amdgcn_global_load_lds((const unsigned*)(pp_ + 1024 + voff[i_]), (LAS unsigned*)(ldsl + (bo) + i_ * 8192 + wid * 1024), 16, 0, 0); \
            __builtin_amdgcn_global_load_lds((const unsigned*)(pp_ + 512 + koff[i_]), (LAS unsigned*)(ldsl + (bo) + 16384 + i_ * 8192 + wid * 1024), 16, 0, 0); } } while (0)
#define DQK(P0, P1, bo) do { P0 = (f32x16){}; P1 = (f32x16){}; const unsigned char* Ks_ = lds + (bo) + 16384; \
        _Pragma("unroll") for (int d0 = 0; d0 < 4; ++d0) { const int cb_ = (map * 64 + d0 * 16 + hi * 8) * 2; \
            const bf16x8 b0_ = *(const bf16x8*)(Ks_ + KSWZ(r32, cb_)), b1_ = *(const bf16x8*)(Ks_ + KSWZ(32 + r32, cb_)); \
            P0 = __builtin_amdgcn_mfma_f32_32x32x16_bf16(b0_, qr[d0], P0, 0, 0, 0); \
            P1 = __builtin_amdgcn_mfma_f32_32x32x16_bf16(b1_, qr[d0], P1, 0, 0, 0); } } while (0)
#define DSM(P0, P1) do { _Pragma("unroll") for (int r = 0; r < 16; ++r) { P0[r] = __builtin_amdgcn_exp2f(P0[r]); P1[r] = __builtin_amdgcn_exp2f(P1[r]); lsum += P0[r] + P1[r]; } \
        PK4(P0, 0, pa0); PK4(P0, 8, pa1); PK4(P1, 0, pa2); PK4(P1, 8, pa3); } while (0)
#define DTAIL_() asm volatile("s_waitcnt vmcnt(0)" ::: "memory"); __syncthreads(); { const int t_ = bprev; bprev = bcur; bcur = bnext; bnext = t_; }
#define DSTEP_A(N0, N1, O0, O1, j) do { if ((j) + 1 < NT) DDMA((j) + 1, bnext); \
        DQK(N0, N1, bcur); DSM(O0, O1); pv_d0(o, vbase + bprev, pa0, pa1, pa2, pa3); DTAIL_() } while (0)
#define DSTEP_B(N0, N1, O0, O1, j) do { if ((j) + 1 < NT) DDMA((j) + 1, bnext); \
        DSM(O0, O1); pv_d0(o, vbase + bprev, pa0, pa1, pa2, pa3); SBAR(); DQK(N0, N1, bcur); DTAIL_() } while (0)
        f32x16 pA0, pA1, pB0, pB1; bf16x8 pa0, pa1, pa2, pa3;
        DDMA(0, 0); DDMA(1, 32768); asm volatile("s_waitcnt vmcnt(0)" ::: "memory"); __syncthreads();
        DQK(pA0, pA1, 0);
        int bprev = 0, bcur = 32768, bnext = 65536;
        if (map == 0) {
            for (int j = 1; j + 1 < NT; j += 2) { DSTEP_A(pB0, pB1, pA0, pA1, j); DSTEP_A(pA0, pA1, pB0, pB1, j + 1); }
            DSTEP_A(pB0, pB1, pA0, pA1, NT - 1);
        } else {
            for (int j = 1; j + 1 < NT; j += 2) { DSTEP_B(pB0, pB1, pA0, pA1, j); DSTEP_B(pA0, pA1, pB0, pB1, j + 1); }
            DSTEP_B(pB0, pB1, pA0, pA1, NT - 1);
        }
        DSM(pB0, pB1); pv_d0(o, vbase + bprev, pa0, pa1, pa2, pa3);
        __syncthreads();
#undef DDMA
#undef DQK
#undef DSM
#undef DSTEP_A
#undef DSTEP_B
#undef DTAIL_
        const float lt = halfswap_add(lsum);
        if (hi == 0) li[r32] = lt;
        asm volatile("s_waitcnt lgkmcnt(0)" ::: "memory");
        float rli[16];
#pragma unroll
        for (int r = 0; r < 16; ++r) rli[r] = __builtin_amdgcn_rcpf(li[crow(r, hi)]);
        if (map == 1) {
#pragma unroll
            for (int d0 = 0; d0 < 4; ++d0)
#pragma unroll
                for (int r = 0; r < 16; ++r) X[(wq * 64 + d0 * 16 + r) * 64 + lane] = o[d0][r] * rli[r] * lam;
        }
        __syncthreads();
        if (map == 0) {
#pragma unroll
            for (int d0 = 0; d0 < 4; ++d0)
#pragma unroll
                for (int r = 0; r < 16; ++r) o[d0][r] = o[d0][r] * rli[r] - X[(wq * 64 + d0 * 16 + r) * 64 + lane];
#pragma unroll
            for (int r = 0; r < 16; ++r) {
                float ss = o[0][r] * o[0][r] + o[1][r] * o[1][r] + o[2][r] * o[2][r] + o[3][r] * o[3][r];
                ss += __shfl_xor(ss, 1); ss += __shfl_xor(ss, 2); ss += __shfl_xor(ss, 4); ss += __shfl_xor(ss, 8); ss += __shfl_xor(ss, 16);
                const float rstd = rsqrtf(ss * (1.f / 128.f) + 1e-6f) * 0.8f;
                bf16_t* mp = mix + (size_t)(qrow0 + 32 * wq + crow(r, hi)) * DM + h * 128 + r32;
#pragma unroll
                for (int d0 = 0; d0 < 4; ++d0) mp[32 * d0] = f2bf(o[d0][r] * rstd * p.diff_subln[32 * d0 + r32]);
            }
        }
        __syncthreads();
    }
}

__device__ __forceinline__ void natten_phase(const Params& p, unsigned char* lds) {
    const int tid = threadIdx.x, wid = tid >> 6, lane = tid & 63, r32 = lane & 31, hi = lane >> 5;
    const bf16_t* proj = (const bf16_t*)(p.ws + WS_PROJ);
    bf16_t* mix = (bf16_t*)(p.ws + WS_MIX);
    constexpr float L2E = 1.4426950408889634f;
    unsigned char* Vl = lds; unsigned char* Kl = lds + 32768;
    float* rpbs = (float*)(lds + 65536);
    float* li = (float*)(lds + 133120) + wid * 64;
    unsigned char* Qs = lds + 67584 + wid * 8192 + lane * 16;
    const int sr = tid >> 4, sc = (tid & 15) * 8, vst0 = v_st(sr, sc), vst1 = v_st(32 + sr, sc);
    const int vb0 = (int)(uintptr_t)Vl + v_rd_base(lane);
    const float* gkp = p.na_qk_gain + 128 + sc;
    const int vblk = (gridDim.x % 8 == 0) ? (int)((blockIdx.x & 7) * (gridDim.x >> 3) + (blockIdx.x >> 3)) : (int)blockIdx.x;
    for (int it = vblk; it < 2048; it += gridDim.x) {
        const int b = it >> 8, h = (it >> 5) & 7, rq = it & 31;
        const int grow = 4 * rq + (wid >> 1), qc = (wid & 1) * 32 + r32;
        const size_t qR = (size_t)b * SEQ + grow * 64 + qc;
        for (int i = tid; i < 465; i += NTHREADS) rpbs[i] = p.na_rpb[h * 465 + i] * L2E;
        { float ss = 0.f;
#pragma unroll
          for (int d0 = 0; d0 < 8; ++d0) { float qv[8]; unpack8(*(const bf16x8*)(proj + qR * OD_N + h * 128 + d0 * 16 + hi * 8), qv);
#pragma unroll
              for (int i = 0; i < 8; ++i) ss += qv[i] * qv[i]; }
          ss = halfswap_add(ss);
          const float rs = rsqrtf(ss * (1.f / 128.f) + 1e-6f) * 0.08838834764831845f * L2E;
#pragma unroll
          for (int d0 = 0; d0 < 8; ++d0) { float qv[8]; unpack8(*(const bf16x8*)(proj + qR * OD_N + h * 128 + d0 * 16 + hi * 8), qv);
#pragma unroll
              for (int i = 0; i < 8; ++i) qv[i] *= rs * p.na_qk_gain[d0 * 16 + hi * 8 + i];
              *(bf16x8*)(Qs + d0 * 1024) = pack8(qv); } }
        int lo = 4 * rq - 4; lo = lo < 0 ? 0 : (lo > 120 ? 120 : lo);
        int hi_r = 4 * rq + 3 - 4; hi_r = hi_r < 0 ? 0 : (hi_r > 120 ? 120 : hi_r); hi_r += 7;
        const int nlat = hi_r - lo + 1, NT = nlat + 4;
        int wsr = grow - 4; wsr = wsr < 0 ? 0 : (wsr > 120 ? 120 : wsr);
        int cst = qc - 8; cst = cst < 0 ? 0 : (cst > 48 ? 48 : cst);
        f32x16 o[4] = {}; float lsum = 0.f;
        bf16x8 vs0, vs1, ks0, ks1;
#define NLOAD(j) do { const size_t R0_ = (size_t)((j) < nlat ? b * SEQ + (lo + (j)) * 64 : NLAT + b * CTXL + 64 * ((j) - nlat)) + sr; \
        const bf16_t* pp_ = proj + R0_ * OD_N + h * 128 + sc; \
        vs0 = *(const bf16x8*)(pp_ + 2048); vs1 = *(const bf16x8*)(pp_ + 2048 + (size_t)32 * OD_N); \
        ks0 = *(const bf16x8*)(pp_ + 1024); ks1 = *(const bf16x8*)(pp_ + 1024 + (size_t)32 * OD_N); } while (0)
#define KNORM(kx) do { float f_[8]; unpack8(kx, f_); float ss_ = 0.f; _Pragma("unroll") for (int i_ = 0; i_ < 8; ++i_) ss_ += f_[i_] * f_[i_]; \
        ss_ += __shfl_xor(ss_, 1); ss_ += __shfl_xor(ss_, 2); ss_ += __shfl_xor(ss_, 4); ss_ += __shfl_xor(ss_, 8); \
        const float rs_ = rsqrtf(ss_ * (1.f / 128.f) + 1e-6f); _Pragma("unroll") for (int i_ = 0; i_ < 8; ++i_) f_[i_] *= rs_ * gkp[i_]; kx = pack8(f_); } while (0)
#define NWRITE(bf) do { KNORM(ks0); KNORM(ks1); *(bf16x8*)(Vl + (bf) * 16384 + vst0) = vs0; *(bf16x8*)(Vl + (bf) * 16384 + vst1) = vs1; \
        *(bf16x8*)(Kl + (bf) * 16384 + KSWZ(sr, sc * 2)) = ks0; *(bf16x8*)(Kl + (bf) * 16384 + KSWZ(32 + sr, sc * 2)) = ks1; } while (0)
        NLOAD(0); NWRITE(0); __syncthreads();
        for (int j = 0; j < NT; ++j) {
            if (j + 1 < NT) NLOAD(j + 1);
            const int bf = j & 1;
            const bool islat = j < nlat; const int kr = lo + j;
            const bool active = !islat || (kr >= wsr && kr <= wsr + 7);
            if (active) {
                f32x16 p0 = {}, p1 = {};
                const unsigned char* Ks = Kl + bf * 16384;
#pragma unroll
                for (int d0 = 0; d0 < 8; ++d0) { const int cb = (d0 * 16 + hi * 8) * 2;
                    const bf16x8 b0 = *(const bf16x8*)(Ks + KSWZ(r32, cb)), b1 = *(const bf16x8*)(Ks + KSWZ(32 + r32, cb));
                    const bf16x8 qd = *(const bf16x8*)(Qs + d0 * 1024);
                    p0 = __builtin_amdgcn_mfma_f32_32x32x16_bf16(b0, qd, p0, 0, 0, 0);
                    p1 = __builtin_amdgcn_mfma_f32_32x32x16_bf16(b1, qd, p1, 0, 0, 0); }
                if (islat) {
                    const float* rb = rpbs + (kr - grow + 7) * 31 + 15 - qc + 4 * hi;
                    const int mofs = 4 * hi - cst;
#pragma unroll
                    for (int r = 0; r < 16; ++r) {
                        const int kb = (r & 3) + 8 * (r >> 2);
                        const float e0 = __builtin_amdgcn_exp2f(p0[r] + rb[kb]), e1 = __builtin_amdgcn_exp2f(p1[r] + rb[32 + kb]);
                        p0[r] = ((unsigned)(kb + mofs) < 16u) ? e0 : 0.f; p1[r] = ((unsigned)(32 + kb + mofs) < 16u) ? e1 : 0.f;
                        lsum += p0[r] + p1[r]; }
                } else {
#pragma unroll
                    for (int r = 0; r < 16; ++r) { p0[r] = __builtin_amdgcn_exp2f(p0[r]); p1[r] = __builtin_amdgcn_exp2f(p1[r]); lsum += p0[r] + p1[r]; }
                }
                bf16x8 pa0, pa1, pa2, pa3;
                PK4(p0, 0, pa0); PK4(p0, 8, pa1); PK4(p1, 0, pa2); PK4(p1, 8, pa3);
                pv_d0(o, vb0 + bf * 16384, pa0, pa1, pa2, pa3);
            }
            if (j + 1 < NT) NWRITE((j + 1) & 1);
            __syncthreads();
        }
#undef NLOAD
#undef KNORM
#undef NWRITE
        const float lt = halfswap_add(lsum);
        if (hi == 0) li[r32] = lt;
        asm volatile("s_waitcnt lgkmcnt(0)" ::: "memory");
#pragma unroll
        for (int r = 0; r < 16; ++r) { const float rl = __builtin_amdgcn_rcpf(li[crow(r, hi)]);
            bf16_t* mp = mix + ((size_t)b * SEQ + grow * 64 + (wid & 1) * 32 + crow(r, hi)) * DM + h * 128 + r32;
#pragma unroll
            for (int d0 = 0; d0 < 4; ++d0) mp[32 * d0] = f2bf(o[d0][r] * rl); }
        __syncthreads();
    }
}

#define XB_TMO      128
#define XB_XCNT(j)  (256  + 64 * (j))
#define XB_XSUB(j)  (1280 + 64 * (j))
#define XB_XGEN(j)  (2304 + 64 * (j))
#define XB_TOP      3328
#define XB_TOPGEN   3392
#define XCD_BAR_WORDS 3456
#define XB_SPIN_CAP (1u << 22)
__device__ __forceinline__ unsigned xb_ld(unsigned* p)              { return __hip_atomic_load(p, __ATOMIC_RELAXED, __HIP_MEMORY_SCOPE_AGENT); }
__device__ __forceinline__ unsigned xb_add(unsigned* p, unsigned v) { return __hip_atomic_fetch_add(p, v, __ATOMIC_RELAXED, __HIP_MEMORY_SCOPE_AGENT); }
__device__ __forceinline__ unsigned xb_xcc_id() { return (unsigned)__builtin_amdgcn_s_getreg((3 << 11) | 20) & 0xFu; }
#define XB_SPIN(cond, bar) do { unsigned _sp = 0; while (cond) { __builtin_amdgcn_s_sleep(1); \
    if ((++_sp & 255u) == 0u) { if (xb_ld(&(bar)[XB_TMO])) break; if (_sp > XB_SPIN_CAP) { atomicAdd(&(bar)[XB_TMO], 1u); break; } } } } while (0)
struct XcdBarrier { unsigned* bar; unsigned x; volatile LAS unsigned* st; };
__device__ __forceinline__ XcdBarrier xcd_barrier_post(unsigned* bar, volatile LAS unsigned* st) {
    XcdBarrier b; b.bar = bar; b.x = xb_xcc_id(); b.st = st;
    if (threadIdx.x == 0) (void)xb_add(&bar[XB_XCNT(b.x)], 1u);
    return b;
}
__device__ __forceinline__ void xcd_barrier_complete(unsigned* bar, unsigned x, unsigned& nloc, unsigned& nx) {
    const unsigned G = gridDim.x * gridDim.y * gridDim.z;
    unsigned sum, cnt, mine, sp = 0u;
    for (;;) {
        sum = 0u; cnt = 0u; mine = 0u;
#pragma unroll
        for (unsigned j = 0; j < 16; ++j) { const unsigned c = xb_ld(&bar[XB_XCNT(j)]); sum += c; cnt += (c > 0u) ? 1u : 0u; mine = (j == x) ? c : mine; }
        if (sum == G) break;
        __builtin_amdgcn_s_sleep(1);
        if ((++sp & 255u) == 0u) { if (xb_ld(&bar[XB_TMO])) break; if (sp > XB_SPIN_CAP) { atomicAdd(&bar[XB_TMO], 1u); break; } }
    }
    nloc = mine > 0u ? mine : 1u; nx = cnt > 0u ? cnt : 1u;
}
__device__ __forceinline__ void xcd_barrier(const XcdBarrier& b) {
    asm volatile("s_waitcnt vmcnt(0)" ::: "memory");
    __syncthreads();
    if (threadIdx.x == 0) {
        unsigned* bar = b.bar;
        __builtin_amdgcn_s_waitcnt(0);
        unsigned nloc = b.st[0], nx = b.st[1];
        if (nloc == 0u) { xcd_barrier_complete(bar, b.x, nloc, nx); b.st[0] = nloc; b.st[1] = nx; }
        const unsigned old = xb_add(&bar[XB_XSUB(b.x)], 1u);
        const unsigned gen = old / nloc;
        if (old + 1u == (gen + 1u) * nloc) {
            __builtin_amdgcn_fence(__ATOMIC_RELEASE, "agent");
            asm volatile("s_waitcnt vmcnt(0)" ::: "memory");
            const unsigned og = xb_add(&bar[XB_TOP], 1u);
            const unsigned tg = og / nx;
            if (og + 1u == (tg + 1u) * nx) xb_add(&bar[XB_TOPGEN], 1u);
            else XB_SPIN(xb_ld(&bar[XB_TOPGEN]) == tg, bar);
            __builtin_amdgcn_fence(__ATOMIC_ACQUIRE, "agent");
            xb_add(&bar[XB_XGEN(b.x)], 1u);
            asm volatile("s_waitcnt vmcnt(0)" ::: "memory");
        } else {
            XB_SPIN(xb_ld(&bar[XB_XGEN(b.x)]) == gen, bar);
            __builtin_amdgcn_fence(__ATOMIC_ACQUIRE, "agent");
            asm volatile("s_waitcnt vmcnt(0)" ::: "memory");
        }
    }
    __syncthreads();
}

#ifndef PROBE_REP
#define PROBE_REP 0
#endif
#define REP(k) for (int rep_ = 0; rep_ < (((PROBE_REP >> (k)) & 1) ? 2 : 1); ++rep_)
constexpr int NPH = 18;
__global__ void __launch_bounds__(NTHREADS, 2) fwd_megakernel(Params p) {
    extern __shared__ __attribute__((aligned(16))) unsigned char lds[];
    cg::grid_group grid = cg::this_grid();
    LAS unsigned char* ldsl = (LAS unsigned char*)lds;
    const int lo = p.ph_lo, hi = p.ph_hi;
#ifdef ONLY_PH
#define IN(k) (((ONLY_PH >> (k)) & 1) && lo <= (k) && (k) < hi)
#else
#define IN(k) (lo <= (k) && (k) < hi)
#endif
#define SEAM(k) do { if (IN(k) && IN((k) + 1)) { if ((k) == 0) grid.sync(); else { XcdBarrier xb_; xb_.bar = (unsigned*)(p.ws + WS_BAR); xb_.x = xb_xcc_id(); xb_.st = (volatile LAS unsigned*)(ldsl + 135168); xcd_barrier(xb_); } } } while (0)
    unsigned char* ws = p.ws;
    const bf16_t* H = (const bf16_t*)(ws + WS_H);
    bf16_t* PROJ = (bf16_t*)(ws + WS_PROJ);
    const bf16_t* MIX = (const bf16_t*)(ws + WS_MIX);
    float* CTXRES = (float*)(ws + WS_CTXRES);
    const float* MOD = (const float*)(ws + WS_MOD);
    const int G = gridDim.x, c = blockIdx.x;
    if (threadIdx.x < 4) ((volatile LAS unsigned*)(ldsl + 135168))[threadIdx.x] = 0u;
    __syncthreads();
    (void)xcd_barrier_post((unsigned*)(ws + WS_BAR), (volatile LAS unsigned*)(ldsl + 135168));

    if (IN(0)) REP(0) { ada_phase(p, lds); wconv_phase(p, lds);
        { float* rc = (float*)(ws + WS_ROPE); float* rs = rc + SEQ * 32;
          for (int e = blockIdx.x * NTHREADS + threadIdx.x; e < SEQ * 32; e += gridDim.x * NTHREADS) { const int t = e >> 5, pp = e & 31;
              const float inv = powf(10000.f, -(float)(pp & 15) / 16.f); const float ang = (pp < 16 ? (float)(t >> 6) : (float)(t & 63)) * inv;
              rc[e] = cosf(ang); rs[e] = sinf(ang); } } }
    SEAM(0);
    if (IN(1)) REP(1) norm_phase(p, p.x, p.ctx, 0, 0, MTOT);
    SEAM(1);
    if (IN(2)) REP(2) { pg8::Gemm g{H, (const bf16_t*)(ws + WS_W_EVIN), MTOT, EV_NP, DM}; pg8::StaticOrderT<264, 15> S; S.init(MTOT, EV_NP, G, c);
        pg8::EpiBf16 E{PROJ, EV_NP}; pg8::gemm_phase(ldsl, g, S, E); }
    SEAM(2);
    if (IN(3)) prep0_phase(p);
    SEAM(3);
    if (IN(4)) REP(4) gdn_pre_phase(p, lds);
    SEAM(4);
    if (IN(5)) {
#ifndef SKIP_SCAN
        REP(20) { gdn_scan_phase(p, lds); __syncthreads(); }
#endif
#ifndef SKIP_DA
        REP(5) { diffattn_phase(p, lds); __syncthreads(); }
#endif
    }
    SEAM(5);
    if (IN(6)) REP(6) gdn_post_phase(p);
    SEAM(6);
    if (IN(7)) REP(7) { pg8::Gemm g{MIX, (const bf16_t*)(ws + WS_W_EVOUT), MTOT, DM, DM}; pg8::StaticOrderT<264, 4> S; S.init(MTOT, DM, G, c);
        pg8::EpiResid E{p.x, p.ctx, p.out, CTXRES, MOD, 2048}; pg8::gemm_phase(ldsl, g, S, E); }
    SEAM(7);
    if (IN(8)) norm_phase(p, p.out, CTXRES, 0, 1, MTOT);
    SEAM(8);
    if (IN(9)) REP(9) { pg8::Gemm g{H, (const bf16_t*)(ws + WS_W_FFIN), MTOT, 2 * FF, DM}; pg8::StaticOrderT<264, 22> S; S.init(MTOT, 2 * FF, G, c);
        pg8::EpiSwiglu E{PROJ, FF}; pg8::gemm_phase(ldsl, g, S, E); }
    SEAM(9);
    if (IN(10)) { pg8::Gemm g{PROJ, (const bf16_t*)(ws + WS_W_FFOUT), MTOT, DM, FF}; pg8::StaticOrderT<264, 4> S; S.init(MTOT, DM, G, c);
        pg8::EpiResid E{p.out, CTXRES, p.out, CTXRES, MOD, 5120}; pg8::gemm_phase(ldsl, g, S, E); }
    SEAM(10);
    if (IN(11)) norm_phase(p, p.out, CTXRES, 1, 0, MTOT);
    SEAM(11);
    if (IN(12)) { pg8::Gemm g{H, (const bf16_t*)(ws + WS_W_ODIN), MTOT, OD_N, DM}; pg8::StaticOrderT<264, 12> S; S.init(MTOT, OD_N, G, c);
        pg8::EpiBf16 E{PROJ, OD_N}; pg8::gemm_phase(ldsl, g, S, E); }
    SEAM(12);
    if (IN(13)) { natten_phase(p, lds); if ((PROBE_REP >> 13) & 1) { __syncthreads(); natten_phase(p, lds); } }
    SEAM(13);
    if (IN(14)) { pg8::Gemm g{MIX, (const bf16_t*)(ws + WS_W_ODOUT), NLAT, DM, DM}; pg8::StaticOrderT<256, 4> S; S.init(NLAT, DM, G, c);
        pg8::EpiResid E{p.out, CTXRES, p.out, CTXRES, MOD + 9 * 6144, 2048}; pg8::gemm_phase(ldsl, g, S, E); }
    SEAM(14);
    if (IN(15)) norm_phase(p, p.out, CTXRES, 1, 1, NLAT);
    SEAM(15);
    if (IN(16)) { pg8::Gemm g{H, (const bf16_t*)(ws + WS_W_FFIN) + (size_t)2 * FF * DM, NLAT, 2 * FF, DM}; pg8::StaticOrderT<256, 22> S; S.init(NLAT, 2 * FF, G, c);
        pg8::EpiSwiglu E{PROJ, FF}; pg8::gemm_phase(ldsl, g, S, E); }
    SEAM(16);
    if (IN(17)) { pg8::Gemm g{PROJ, (const bf16_t*)(ws + WS_W_FFOUT) + (size_t)DM * FF, NLAT, DM, FF}; pg8::StaticOrderT<256, 4> S; S.init(NLAT, DM, G, c);
        pg8::EpiResid E{p.out, CTXRES, p.out, CTXRES, MOD + 9 * 6144, 5120}; pg8::gemm_phase(ldsl, g, S, E); }
#undef IN
#undef SEAM
}

extern "C" void kernel_launch(void* const* d_in, const int* in_sizes, int n_in, void* d_out, int out_size, void* d_ws, size_t ws_size, hipStream_t stream) {
    static int grid = 0;
    if (grid == 0) {
        if (n_in != 23 || ws_size < WS_END) { fprintf(stderr, "kernel_launch: n_in %d ws %zu (need %zu)\n", n_in, ws_size, (size_t)WS_END); grid = -1; return; }
        int dev = 0, cus = 0, per_cu = 0;
        hipGetDevice(&dev); hipDeviceGetAttribute(&cus, hipDeviceAttributeMultiprocessorCount, dev);
        if (hipFuncSetAttribute((const void*)fwd_megakernel, hipFuncAttributeMaxDynamicSharedMemorySize, LDS_BYTES) != hipSuccess) { fprintf(stderr, "hipFuncSetAttribute failed\n"); grid = -1; return; }
        if (hipOccupancyMaxActiveBlocksPerMultiprocessor(&per_cu, (const void*)fwd_megakernel, NTHREADS, LDS_BYTES) != hipSuccess || per_cu < 1) per_cu = 1;
        (void)hipGetLastError();
        grid = cus * 1;
    }
    if (grid < 0) return;
    if (hipMemsetAsync((char*)d_ws + WS_BAR, 0, 16384, stream) != hipSuccess) { fprintf(stderr, "memset failed\n"); return; }
    Params p{};
    const float** pp = (const float**)&p;
    for (int i = 0; i < 23; ++i) pp[i] = (const float*)d_in[i];
    p.out = (float*)d_out; p.ws = (unsigned char*)d_ws;
#if N_LAUNCH_MODE == 1
    p.ph_lo = 0; p.ph_hi = NPH;
    void* args[] = {&p};
    hipError_t e = hipLaunchCooperativeKernel((void*)fwd_megakernel, dim3(grid), dim3(NTHREADS), args, LDS_BYTES, stream);
    if (e != hipSuccess) fprintf(stderr, "cooperative launch failed: %s (grid %d)\n", hipGetErrorString(e), grid);
#else
    for (int k = 0; k < NPH; ++k) { p.ph_lo = k; p.ph_hi = k + 1;
        hipLaunchKernelGGL(fwd_megakernel, dim3(grid), dim3(NTHREADS), LDS_BYTES, stream, p); }
#endif
}
```

```cpp
#include <hip/hip_runtime.h>
#include <hip/hip_cooperative_groups.h>
#include <cstdio>
#include <cstdint>
namespace cg = cooperative_groups;

#define LAS __attribute__((address_space(3)))
typedef unsigned short bf16_t;
typedef short bf16x8 __attribute__((ext_vector_type(8)));
typedef short s16x4 __attribute__((ext_vector_type(4)));
typedef float f32x4 __attribute__((ext_vector_type(4)));
typedef float f32x16 __attribute__((ext_vector_type(16)));
typedef unsigned u32x4 __attribute__((ext_vector_type(4)));
typedef unsigned u32x2 __attribute__((ext_vector_type(2)));

#ifndef N_LAUNCH_MODE
#define N_LAUNCH_MODE 1
#endif

constexpr int DM = 1024, NLAT = 65536, NCTX = 2048, MTOT = NLAT + NCTX, SEQ = 8192, CTXL = 256, FF = 2816;
constexpr int EV_N = 3600, EV_NP = 3840, OD_N = 3072;
constexpr int NCHUNKP = 64 * 132;
constexpr int NTHREADS = 512;
constexpr int LDS_BYTES = 135168 + 16;

constexpr size_t al256(size_t x) { return (x + 255) / 256 * 256; }
constexpr size_t WS_W_EVIN = 0;
constexpr size_t WS_W_EVOUT = WS_W_EVIN + al256((size_t)EV_NP * DM * 2);
constexpr size_t WS_W_ODIN = WS_W_EVOUT + al256((size_t)DM * DM * 2);
constexpr size_t WS_W_ODOUT = WS_W_ODIN + al256((size_t)OD_N * DM * 2);
constexpr size_t WS_W_FFIN = WS_W_ODOUT + al256((size_t)DM * DM * 2);
constexpr size_t WS_W_FFOUT = WS_W_FFIN + al256((size_t)2 * 2 * FF * DM * 2);
constexpr size_t WS_MOD = WS_W_FFOUT + al256((size_t)2 * DM * FF * 2);
constexpr size_t WS_H = WS_MOD + al256((size_t)2 * 9 * 6144 * 4);
constexpr size_t WS_PROJ = WS_H + al256((size_t)MTOT * DM * 2);
constexpr size_t WS_MIX = WS_PROJ + al256((size_t)MTOT * EV_NP * 2);
constexpr size_t WS_T = WS_MIX + al256((size_t)MTOT * DM * 2);
constexpr size_t WS_AQK = WS_T + al256((size_t)NCHUNKP * 4096 * 2);
constexpr size_t WS_GV = WS_AQK + al256((size_t)NCHUNKP * 4096 * 2);
constexpr size_t WS_BV = WS_GV + al256((size_t)NCHUNKP * 64 * 4);
constexpr size_t WS_EL = WS_BV + al256((size_t)NCHUNKP * 64 * 4);
constexpr size_t WS_GATES = WS_EL + al256((size_t)NCHUNKP * 64 * 4);
constexpr size_t WS_CTXRES = WS_GATES + al256((size_t)MTOT * 16 * 4);
constexpr size_t WS_BAR = WS_CTXRES + al256((size_t)NCTX * DM * 4);
constexpr size_t WS_ROPE = WS_BAR + 16384;
constexpr size_t WS_END = WS_ROPE + (size_t)2 * SEQ * 32 * 4;

struct Params {
    const float *x, *c, *ctx, *c_ctx, *ada_w, *ada_b, *norm_mix, *norm_ffn, *ffn_w_in, *ffn_w_out, *even_w_in, *even_w_out,
        *diff_qk_gain, *diff_lambda, *diff_subln, *gdn_conv, *gdn_a_log, *gdn_dt_bias, *gdn_norm, *odd_w_in, *odd_w_out, *na_qk_gain, *na_rpb;
    float* out; unsigned char* ws; int ph_lo, ph_hi;
};

__device__ __forceinline__ float bf2f(bf16_t b) { return __uint_as_float(((unsigned)b) << 16); }
__device__ __forceinline__ bf16_t f2bf(float f) { unsigned u = __float_as_uint(f); u += 0x7FFFu + ((u >> 16) & 1u); return (bf16_t)(u >> 16); }
__device__ __forceinline__ unsigned cvtpk(float lo, float hi) { unsigned r; asm volatile("v_cvt_pk_bf16_f32 %0, %1, %2" : "=v"(r) : "v"(lo), "v"(hi)); return r; }
__device__ __forceinline__ float siluf(float v) { return v / (1.f + __expf(-v)); }
__device__ __forceinline__ void unpack8(bf16x8 v, float* f) {
#pragma unroll
    for (int i = 0; i < 8; ++i) f[i] = bf2f((bf16_t)v[i]);
}
__device__ __forceinline__ bf16x8 pack8(const float* f) {
    u32x4 w = {cvtpk(f[0], f[1]), cvtpk(f[2], f[3]), cvtpk(f[4], f[5]), cvtpk(f[6], f[7])};
    return *reinterpret_cast<bf16x8*>(&w);
}

namespace pg8 {
constexpr int BM = 256, BK = 64, HALF = 128, HTB = HALF * BK * 2, STAGE_BYTES = 8 * HTB, NXCD = 8, WGM = 8;
__host__ __device__ __forceinline__ int lds_byte(int r, int c) { const int st = (r >> 4) * 2 + (c >> 5), rr = r & 15, cc = c & 31, ob = rr * 64 + cc * 2; return st * 1024 + (ob ^ (((ob >> 9) & 1) << 5)); }
__host__ __device__ __forceinline__ void stage_rc(int b, int& R, int& C) { const int st = b / 1024, sb = b % 1024, swz = sb ^ (((sb >> 9) & 1) << 5); R = (st >> 1) * 16 + swz / 64; C = (st & 1) * 32 + (swz % 64) / 2; }
__host__ __device__ __forceinline__ int perm32(int rho) { const int n = rho >> 4, i = rho & 15; return 8 * (i >> 2) + 4 * n + (i & 3); }
struct Unit { int pm, pn; };
struct Gemm { const bf16_t* A; const bf16_t* Bt; int M, N, K; };
template <int NM, int NN> struct StaticOrderT {
    static_assert(NM % WGM == 0, "row tiles in whole groups");
    int G, c;
    __device__ void init(int, int, int G_, int c_) { G = G_; c = c_; }
    __device__ bool next(int i, Unit& u) const {
        constexpr int nwg = NM * NN, q = nwg / NXCD, r = nwg % NXCD, nig = WGM * NN;
        const int L = i * G + c; if (L >= nwg) return false;
        const int xcd = L % NXCD, off = L / NXCD;
        const int wgid = (xcd < r ? xcd * (q + 1) : r * (q + 1) + (xcd - r) * q) + off;
        const int gid = wgid / nig, w = wgid % nig;
        u.pm = gid * WGM + (w % WGM); u.pn = w / WGM; return true;
    }
};
struct EpiBf16 {
    static constexpr bool PERM = true;
    bf16_t* O; int ldc;
    __device__ __forceinline__ void operator()(const f32x4 (&acc)[2][2][4][2], const Unit& u, int wr, int wc, int fr, int fq) const {
        const int row0 = u.pm * BM + wr * 64 + fr; const int col0 = u.pn * BM + wc * 32 + 8 * fq;
#pragma unroll
        for (int ai = 0; ai < 2; ++ai)
#pragma unroll
            for (int m = 0; m < 4; ++m) { bf16_t* rowp = O + (size_t)(row0 + ai * HALF + m * 16) * ldc + col0;
#pragma unroll
                for (int bj = 0; bj < 2; ++bj) { const f32x4 v0 = acc[ai][bj][m][0], v1 = acc[ai][bj][m][1];
                    u32x4 w; w.x = cvtpk(v0[0], v0[1]); w.y = cvtpk(v0[2], v0[3]); w.z = cvtpk(v1[0], v1[1]); w.w = cvtpk(v1[2], v1[3]);
                    *(u32x4*)(rowp + bj * HALF) = w; } }
    }
};
struct EpiSwiglu {
    static constexpr bool PERM = true;
    bf16_t* O; int ldc;
    __device__ __forceinline__ void operator()(const f32x4 (&acc)[2][2][4][2], const Unit& u, int wr, int wc, int fr, int fq) const {
        const int row0 = u.pm * BM + wr * 64 + fr; const int col0 = u.pn * HALF + wc * 32 + 8 * fq;
#pragma unroll
        for (int ai = 0; ai < 2; ++ai)
#pragma unroll
            for (int m = 0; m < 4; ++m) { bf16_t* rowp = O + (size_t)(row0 + ai * HALF + m * 16) * ldc + col0;
                typedef float f32x2v __attribute__((ext_vector_type(2)));
                unsigned wv[4];
#pragma unroll
                for (int n = 0; n < 2; ++n)
#pragma unroll
                    for (int j = 0; j < 4; j += 2) { const f32x2v g = {acc[ai][0][m][n][j], acc[ai][0][m][n][j + 1]}, up = {acc[ai][1][m][n][j], acc[ai][1][m][n][j + 1]};
                        const f32x2v t = g * (-1.4426950408889634f); f32x2v e; e.x = __builtin_amdgcn_exp2f(t.x); e.y = __builtin_amdgcn_exp2f(t.y);
                        const f32x2v d = e + 1.0f; f32x2v r; r.x = __builtin_amdgcn_rcpf(d.x); r.y = __builtin_amdgcn_rcpf(d.y);
                        const f32x2v o = (g * up) * r; wv[n * 2 + (j >> 1)] = cvtpk(o.x, o.y); }
                u32x4 w; w.x = wv[0]; w.y = wv[1]; w.z = wv[2]; w.w = wv[3];
                *(u32x4*)rowp = w; }
    }
};
struct EpiResid {
    static constexpr bool PERM = false;
    const float* resLat; const float* resCtx; float* outLat; float* outCtx; const float* modl; int goff;
    __device__ __forceinline__ void operator()(const f32x4 (&acc)[2][2][4][2], const Unit& u, int wr, int wc, int fr, int fq) const {
        const int rowt = u.pm * BM; const bool lat = rowt < NLAT;
        const float* res = lat ? resLat + (size_t)rowt * DM : resCtx + (size_t)(rowt - NLAT) * DM;
        float* out = lat ? outLat + (size_t)rowt * DM : outCtx + (size_t)(rowt - NLAT) * DM;
        const float* gate = modl + (size_t)(lat ? (rowt >> 13) : 8) * 6144 + goff;
        const int row0 = wr * 64 + fr, col0 = u.pn * BM + wc * 32 + 4 * fq;
        f32x4 gv[2][2];
#pragma unroll
        for (int bj = 0; bj < 2; ++bj)
#pragma unroll
            for (int n = 0; n < 2; ++n) gv[bj][n] = *(const f32x4*)(gate + col0 + bj * HALF + n * 16);
#pragma unroll
        for (int ai = 0; ai < 2; ++ai)
#pragma unroll
            for (int mp = 0; mp < 4; mp += 2) {
                f32x4 r[2][2][2];
#pragma unroll
                for (int mm = 0; mm < 2; ++mm)
#pragma unroll
                    for (int bj = 0; bj < 2; ++bj)
#pragma unroll
                        for (int n = 0; n < 2; ++n) r[mm][bj][n] = *(const f32x4*)(res + (size_t)(row0 + ai * HALF + (mp + mm) * 16) * DM + col0 + bj * HALF + n * 16);
#pragma unroll
                for (int mm = 0; mm < 2; ++mm)
#pragma unroll
                    for (int bj = 0; bj < 2; ++bj)
#pragma unroll
                        for (int n = 0; n < 2; ++n) *(f32x4*)(out + (size_t)(row0 + ai * HALF + (mp + mm) * 16) * DM + col0 + bj * HALF + n * 16) = r[mm][bj][n] + gv[bj][n] * acc[ai][bj][mp + mm][n];
            }
    }
};

template <class Epi, class Sched>
__device__ __forceinline__ void gemm_phase(LAS unsigned char* lds, const Gemm g, const Sched& S, const Epi& E) {
    const int tid = threadIdx.x, wid = __builtin_amdgcn_readfirstlane(tid >> 6), lane = tid & 63, wr = wid >> 2, wc = wid & 3, fr = lane & 15, fq = lane >> 4;
    const int K = g.K, nt = K / BK;
    unsigned voffA[2], voffB[2];
#pragma unroll
    for (int i = 0; i < 2; ++i) { int R, C; stage_rc(tid * 16 + i * 8192, R, C); const int Rb = Epi::PERM ? ((R & ~31) + perm32(R & 31)) : R;
        voffA[i] = (unsigned)(R * K + C) * 2u; voffB[i] = (unsigned)(Rb * K + C) * 2u; }
    const size_t kstep = (size_t)(BK * 2);
    const size_t hstep = (size_t)HALF * K * 2;
    const size_t tstep = 2 * hstep;
    const unsigned ldsw = (unsigned)wid * 1024u;
    const int aoff = lds_byte(wr * 64 + fr, fq * 8), boff = lds_byte(wc * 32 + fr, fq * 8);
#define PG8_SA(b, h) (((b) * 2 + (h)) * HTB)
#define PG8_SB(b, h) ((4 + (b) * 2 + (h)) * HTB)
#define PG8_STAGE(bufoff, gbase, voff) do { _Pragma("unroll") for (int _i = 0; _i < 2; ++_i) \
        __builtin_amdgcn_global_load_lds((const unsigned*)((const char*)(gbase) + (voff)[_i]), (LAS unsigned*)(lds + (bufoff) + ldsw + _i * 8192), 16, 0, 0); } while (0)
#define PG8_LDA(dst, b, h) do { _Pragma("unroll") for (int m = 0; m < 4; ++m) _Pragma("unroll") for (int k = 0; k < 2; ++k) dst[m][k] = *(const LAS bf16x8*)(lds + PG8_SA(b, h) + aoff + m * 2048 + k * 1024); } while (0)
#define PG8_LDB(dst, b, h) do { _Pragma("unroll") for (int n = 0; n < 2; ++n) _Pragma("unroll") for (int k = 0; k < 2; ++k) dst[n][k] = *(const LAS bf16x8*)(lds + PG8_SB(b, h) + boff + n * 2048 + k * 1024); } while (0)
#define PG8_MMA(ai, bj, At, Bt) do { __builtin_amdgcn_s_setprio(1); _Pragma("unroll") for (int m = 0; m < 4; ++m) _Pragma("unroll") for (int n = 0; n < 2; ++n) _Pragma("unroll") for (int k = 0; k < 2; ++k) \
        acc[ai][bj][m][n] = __builtin_amdgcn_mfma_f32_16x16x32_bf16(Bt[n][k], At[m][k], acc[ai][bj][m][n], 0, 0, 0); __builtin_amdgcn_s_setprio(0); } while (0)
#define PG8_WAIT_V(n) asm volatile("s_waitcnt vmcnt(" #n ")" ::: "memory")
#define PG8_WAIT_L(n) asm volatile("s_waitcnt lgkmcnt(" #n ")" ::: "memory")
#define PG8_BAR __builtin_amdgcn_s_barrier()
#define PG8_SCHED __builtin_amdgcn_sched_barrier(0)
    Unit cur, nxt; int ui = 0;
    if (!S.next(0, cur)) return;
    f32x4 acc[2][2][4][2];
#pragma unroll
    for (int a = 0; a < 2; ++a)
#pragma unroll
        for (int b = 0; b < 2; ++b)
#pragma unroll
            for (int m = 0; m < 4; ++m)
#pragma unroll
                for (int n = 0; n < 2; ++n) acc[a][b][m][n] = (f32x4){0.f, 0.f, 0.f, 0.f};
    bf16x8 At[4][2], B0[2][2], B1[2][2];
    const char* cA = (const char*)g.A + (size_t)cur.pm * tstep; const char* cB = (const char*)g.Bt + (size_t)cur.pn * tstep;
    PG8_STAGE(PG8_SB(0, 0), cB, voffB); PG8_STAGE(PG8_SA(0, 0), cA, voffA); PG8_STAGE(PG8_SB(0, 1), cB + hstep, voffB); PG8_STAGE(PG8_SA(0, 1), cA + hstep, voffA);
    if (wr == 1) PG8_BAR;
    PG8_WAIT_V(4); PG8_BAR;
    PG8_STAGE(PG8_SB(1, 0), cB + kstep, voffB); PG8_STAGE(PG8_SA(1, 0), cA + kstep, voffA); PG8_STAGE(PG8_SB(1, 1), cB + hstep + kstep, voffB);
    PG8_WAIT_V(6); PG8_BAR;
    for (;;) {
        const bool has_next = S.next(ui + 1, nxt);
        const char* nA = has_next ? (const char*)g.A + (size_t)nxt.pm * tstep : cA; const char* nB = has_next ? (const char*)g.Bt + (size_t)nxt.pn * tstep : cB;
        for (int t = 0; t < nt; t += 2) {
            const bool last = (t == nt - 2);
            const char* a1 = cA + (size_t)(t + 1) * kstep;
            const char* a2 = last ? nA : cA + (size_t)(t + 2) * kstep; const char* b2 = last ? nB : cB + (size_t)(t + 2) * kstep;
            const char* a3 = a2 + kstep; const char* b3 = b2 + kstep;
            PG8_LDB(B0, 0, 0); PG8_SCHED; PG8_LDA(At, 0, 0); PG8_STAGE(PG8_SA(1, 1), a1 + hstep, voffA);
            PG8_WAIT_L(8); PG8_BAR; PG8_WAIT_L(0); PG8_MMA(0, 0, At, B0); PG8_BAR; PG8_SCHED;
            PG8_LDB(B1, 0, 1); PG8_STAGE(PG8_SB(0, 0), b2, voffB);
            PG8_BAR; PG8_WAIT_L(0); PG8_MMA(0, 1, At, B1); PG8_BAR;
            PG8_LDA(At, 0, 1); PG8_STAGE(PG8_SA(0, 0), a2, voffA);
            PG8_BAR; PG8_WAIT_L(0); PG8_MMA(1, 0, At, B0); PG8_BAR; PG8_SCHED;
            PG8_STAGE(PG8_SB(0, 1), b2 + hstep, voffB);
            PG8_WAIT_V(6); PG8_BAR; PG8_MMA(1, 1, At, B1); PG8_BAR;
            PG8_LDB(B0, 1, 0); PG8_SCHED; PG8_LDA(At, 1, 0); PG8_STAGE(PG8_SA(0, 1), a2 + hstep, voffA);
            PG8_WAIT_L(8); PG8_BAR; PG8_WAIT_L(0); PG8_MMA(0, 0, At, B0); PG8_BAR; PG8_SCHED;
            PG8_LDB(B1, 1, 1); PG8_STAGE(PG8_SB(1, 0), b3, voffB);
            PG8_BAR; PG8_WAIT_L(0); PG8_MMA(0, 1, At, B1); PG8_BAR;
            PG8_LDA(At, 1, 1); PG8_STAGE(PG8_SA(1, 0), a3, voffA);
            PG8_BAR; PG8_WAIT_L(0); PG8_MMA(1, 0, At, B0); PG8_BAR; PG8_SCHED;
            PG8_STAGE(PG8_SB(1, 1), b3 + hstep, voffB);
            PG8_WAIT_V(6); PG8_BAR; PG8_MMA(1, 1, At, B1); PG8_BAR;
        }
        E(acc, cur, wr, wc, fr, fq);
        if (!has_next) break;
#pragma unroll
        for (int a = 0; a < 2; ++a)
#pragma unroll
            for (int b = 0; b < 2; ++b)
#pragma unroll
                for (int m = 0; m < 4; ++m)
#pragma unroll
                    for (int n = 0; n < 2; ++n) acc[a][b][m][n] = (f32x4){0.f, 0.f, 0.f, 0.f};
        cur = nxt; cA = nA; cB = nB; ++ui;
    }
    PG8_WAIT_V(0);
    if (wr == 0) PG8_BAR;
    PG8_BAR;
#undef PG8_SA
#undef PG8_SB
#undef PG8_STAGE
#undef PG8_LDA
#undef PG8_LDB
#undef PG8_MMA
#undef PG8_WAIT_V
#undef PG8_WAIT_L
#undef PG8_BAR
#undef PG8_SCHED
}
}

#define KSWZ(row, colB) ((row) * 256 + ((colB) ^ (((row) & 7) << 4)))
#define SBAR() __builtin_amdgcn_sched_barrier(0)
__device__ __forceinline__ int crow(int r, int hi) { return (r & 3) + 8 * (r >> 2) + 4 * hi; }
__device__ __forceinline__ int v_st(int k, int c) { const int kk = (k & ~0xC) | ((k & 4) << 1) | ((k & 8) >> 1); return ((kk >> 3) * 4 + (c >> 5)) * 512 + ((kk & 7) * 32 + (c & 31)) * 2; }
__device__ __forceinline__ int v_rd_base(int lane) { return ((lane & 3) << 3) | (((lane >> 2) & 3) << 6) | (((lane >> 4) & 1) << 5) | (((lane >> 5) & 1) << 8); }
constexpr int v_rd_off(int d0, int ks, int half) { return d0 * 512 + ks * 4096 + half * 2048; }
template <int OFF> __device__ __forceinline__ s16x4 tr_read(int vb) {
    s16x4 r; asm volatile("ds_read_b64_tr_b16 %0, %1 offset:%2" : "=&v"(r) : "v"(vb), "i"(OFF) : "memory"); return r;
}
template <int D0> __device__ __forceinline__ void pv_one(f32x16& od, int vb, bf16x8 pa0, bf16x8 pa1, bf16x8 pa2, bf16x8 pa3) {
    const s16x4 l0 = tr_read<v_rd_off(D0, 0, 0)>(vb), h0 = tr_read<v_rd_off(D0, 0, 1)>(vb), l1 = tr_read<v_rd_off(D0, 1, 0)>(vb), h1 = tr_read<v_rd_off(D0, 1, 1)>(vb);
    const s16x4 l2 = tr_read<v_rd_off(D0, 2, 0)>(vb), h2 = tr_read<v_rd_off(D0, 2, 1)>(vb), l3 = tr_read<v_rd_off(D0, 3, 0)>(vb), h3 = tr_read<v_rd_off(D0, 3, 1)>(vb);
    asm volatile("s_waitcnt lgkmcnt(0)" ::: "memory"); SBAR();
#define PK(L, H) (bf16x8){L[0], L[1], L[2], L[3], H[0], H[1], H[2], H[3]}
    od = __builtin_amdgcn_mfma_f32_32x32x16_bf16(pa0, PK(l0, h0), od, 0, 0, 0);
    od = __builtin_amdgcn_mfma_f32_32x32x16_bf16(pa1, PK(l1, h1), od, 0, 0, 0);
    od = __builtin_amdgcn_mfma_f32_32x32x16_bf16(pa2, PK(l2, h2), od, 0, 0, 0);
    od = __builtin_amdgcn_mfma_f32_32x32x16_bf16(pa3, PK(l3, h3), od, 0, 0, 0);
#undef PK
}
__device__ __forceinline__ void pv_d0(f32x16* o, int vb, bf16x8 pa0, bf16x8 pa1, bf16x8 pa2, bf16x8 pa3) {
    pv_one<0>(o[0], vb, pa0, pa1, pa2, pa3); pv_one<1>(o[1], vb, pa0, pa1, pa2, pa3); pv_one<2>(o[2], vb, pa0, pa1, pa2, pa3); pv_one<3>(o[3], vb, pa0, pa1, pa2, pa3);
}
#define PK4(P, BASE, OUT) do { unsigned a0 = cvtpk(P[BASE + 0], P[BASE + 1]), a1 = cvtpk(P[BASE + 2], P[BASE + 3]);   \
    unsigned b0 = cvtpk(P[BASE + 4], P[BASE + 5]), b1 = cvtpk(P[BASE + 6], P[BASE + 7]);                              \
    auto r0 = __builtin_amdgcn_permlane32_swap(a0, b0, false, false); auto r1 = __builtin_amdgcn_permlane32_swap(a1, b1, false, false); \
    u32x4 w = {r0[0], r1[0], r0[1], r1[1]}; OUT = *reinterpret_cast<bf16x8*>(&w); } while (0)
__device__ __forceinline__ float halfswap_add(float v) {
    auto rr = __builtin_amdgcn_permlane32_swap(__float_as_uint(v), __float_as_uint(v), false, false);
    return __uint_as_float(rr[0]) + __uint_as_float(rr[1]);
}

__device__ __forceinline__ void ada_phase(const Params& p, unsigned char* lds) {
    float* sc = (float*)lds;
    float* red = (float*)(lds + 40960);
    float* mod = (float*)(p.ws + WS_MOD);
    const int tid = threadIdx.x;
    for (int j = blockIdx.x; j < 192; j += gridDim.x) {
        const int l = j / 96, n0 = (j % 96) * 64;
        for (int i = tid; i < 9 * 1024; i += NTHREADS) { const int r = i >> 10, k = i & 1023; const float v = r < 8 ? p.c[r * 1024 + k] : p.c_ctx[k]; sc[i] = v / (1.f + expf(-v)); }
        __syncthreads();
        const int col = tid & 63, ks = tid >> 6;
        float acc[9];
#pragma unroll
        for (int r = 0; r < 9; ++r) acc[r] = 0.f;
        const float* wp = p.ada_w + ((size_t)l * 1024 + ks * 128) * 6144 + n0 + col;
#pragma unroll 8
        for (int kk = 0; kk < 128; ++kk) { const float w = wp[(size_t)kk * 6144];
#pragma unroll
            for (int r = 0; r < 9; ++r) acc[r] += sc[r * 1024 + ks * 128 + kk] * w; }
#pragma unroll
        for (int r = 0; r < 9; ++r) red[(ks * 9 + r) * 64 + col] = acc[r];
        __syncthreads();
        for (int i = tid; i < 576; i += NTHREADS) { const int r = i >> 6, cc = i & 63; float s = p.ada_b[l * 6144 + n0 + cc];
            for (int k2 = 0; k2 < 8; ++k2) s += red[(k2 * 9 + r) * 64 + cc];
            mod[(size_t)(l * 9 + r) * 6144 + n0 + cc] = s; }
        __syncthreads();
    }
}
__device__ __forceinline__ void wconv_phase(const Params& p, unsigned char* lds) {
    float* tl = (float*)lds;
    const int tid = threadIdx.x;
    const int T0 = 16 * 60, T1 = T0 + 16 * 16, T2 = T1 + 16 * 48, T3 = T2 + 16 * 16, T4 = T3 + 16 * 88, T5 = T4 + 16 * 88, T6 = T5 + 44 * 16, T7 = T6 + 44 * 16;
#define WC_DECODE(t) \
        const float* src; bf16_t* dst; int K, N, NP, mode = 0, tt; \
        if ((t) < T0) { src = p.even_w_in; dst = (bf16_t*)(p.ws + WS_W_EVIN); K = 1024; N = EV_N; NP = EV_NP; tt = (t); } \
        else if ((t) < T1) { src = p.even_w_out; dst = (bf16_t*)(p.ws + WS_W_EVOUT); K = 1024; N = 1024; NP = 1024; tt = (t) - T0; } \
        else if ((t) < T2) { src = p.odd_w_in; dst = (bf16_t*)(p.ws + WS_W_ODIN); K = 1024; N = OD_N; NP = OD_N; tt = (t) - T1; } \
        else if ((t) < T3) { src = p.odd_w_out; dst = (bf16_t*)(p.ws + WS_W_ODOUT); K = 1024; N = 1024; NP = 1024; tt = (t) - T2; } \
        else if ((t) < T4) { src = p.ffn_w_in; dst = (bf16_t*)(p.ws + WS_W_FFIN); K = 1024; N = 2 * FF; NP = 2 * FF; mode = 1; tt = (t) - T3; } \
        else if ((t) < T5) { src = p.ffn_w_in + (size_t)1024 * 2 * FF; dst = (bf16_t*)(p.ws + WS_W_FFIN) + (size_t)2 * FF * 1024; K = 1024; N = 2 * FF; NP = 2 * FF; mode = 1; tt = (t) - T4; } \
        else if ((t) < T6) { src = p.ffn_w_out; dst = (bf16_t*)(p.ws + WS_W_FFOUT); K = FF; N = 1024; NP = 1024; tt = (t) - T5; } \
        else { src = p.ffn_w_out + (size_t)FF * 1024; dst = (bf16_t*)(p.ws + WS_W_FFOUT) + (size_t)1024 * FF; K = FF; N = 1024; NP = 1024; tt = (t) - T6; } \
        const int nnt = NP / 64; const int k0 = (tt / nnt) * 64, n0 = (tt % nnt) * 64; \
        int sn0; if (mode == 1) { const int tb = n0 >> 8, bj = (n0 >> 7) & 1, i0 = n0 & 127; sn0 = bj * FF + tb * 128 + i0; } else sn0 = n0;
    float rg[8];
#define WC_LOAD(t) do { WC_DECODE(t) (void)dst; _Pragma("unroll") for (int i = 0; i < 8; ++i) { const int e = tid + NTHREADS * i, kk = e >> 6, nn = e & 63; const int sn = sn0 + nn; \
        rg[i] = (sn < N) ? src[(size_t)(k0 + kk) * N + sn] : 0.f; } } while (0)
    int t = blockIdx.x;
    if (t < T7) WC_LOAD(t);
    for (; t < T7; t += gridDim.x) {
#pragma unroll
        for (int i = 0; i < 8; ++i) { const int e = tid + NTHREADS * i; tl[(e >> 6) * 65 + (e & 63)] = rg[i]; }
        __syncthreads();
        { WC_DECODE(t) (void)src; (void)N; (void)sn0;
          if (t + (int)gridDim.x < T7) WC_LOAD(t + (int)gridDim.x);
          for (int e = tid; e < 2048; e += NTHREADS) { const int nn = e >> 5, k2 = (e & 31) * 2;
              *(unsigned*)(dst + (size_t)(n0 + nn) * K + k0 + k2) = cvtpk(tl[k2 * 65 + nn], tl[(k2 + 1) * 65 + nn]); } }
        __syncthreads();
    }
#undef WC_DECODE
#undef WC_LOAD
}

__device__ __forceinline__ void norm_phase(const Params& p, const float* xlat, const float* xctx, int l, int which, int nrows) {
    const int lane = threadIdx.x & 63, wid = threadIdx.x >> 6;
    bf16_t* h = (bf16_t*)(p.ws + WS_H);
    const float* mod = (const float*)(p.ws + WS_MOD) + (size_t)l * 9 * 6144;
    const float* gain = (which ? p.norm_ffn : p.norm_mix) + l * 1024;
    const int shoff = which ? 3072 : 0, scoff = which ? 4096 : 1024;
    const int stride = gridDim.x * 8;
    f32x4 gn[4];
#pragma unroll
    for (int i = 0; i < 4; ++i) gn[i] = *(const f32x4*)(gain + lane * 4 + 256 * i);
    for (int row = blockIdx.x * 8 + wid; row < nrows; row += 2 * stride) {
        const int rowB = row + stride; const bool hasB = rowB < nrows; const int rB = hasB ? rowB : row;
        const float* srcA = row < NLAT ? xlat + (size_t)row * DM : xctx + (size_t)(row - NLAT) * DM;
        const float* srcB = rB < NLAT ? xlat + (size_t)rB * DM : xctx + (size_t)(rB - NLAT) * DM;
        const float* mrA = mod + (size_t)(row < NLAT ? (row >> 13) : 8) * 6144;
        const float* mrB = mod + (size_t)(rB < NLAT ? (rB >> 13) : 8) * 6144;
        f32x4 va[4], vb[4], sa[4], ha[4], sb[4], hb[4];
#pragma unroll
        for (int i = 0; i < 4; ++i) { const int c0 = lane * 4 + 256 * i;
            va[i] = *(const f32x4*)(srcA + c0); vb[i] = *(const f32x4*)(srcB + c0);
            sa[i] = *(const f32x4*)(mrA + scoff + c0); ha[i] = *(const f32x4*)(mrA + shoff + c0);
            sb[i] = *(const f32x4*)(mrB + scoff + c0); hb[i] = *(const f32x4*)(mrB + shoff + c0); }
#pragma unroll
        for (int rr = 0; rr < 2; ++rr) {
            if (rr == 1 && !hasB) break;
            const int r = rr ? rowB : row;
            float ss = 0.f;
#pragma unroll
            for (int i = 0; i < 4; ++i) { const f32x4 v = rr ? vb[i] : va[i]; ss += v[0] * v[0] + v[1] * v[1] + v[2] * v[2] + v[3] * v[3]; }
#pragma unroll
            for (int o = 1; o < 64; o <<= 1) ss += __shfl_xor(ss, o);
            const float rstd = rsqrtf(ss * (1.f / 1024.f) + 1e-6f);
#pragma unroll
            for (int i = 0; i < 4; ++i) { const int c0 = lane * 4 + 256 * i; const f32x4 v = rr ? vb[i] : va[i], s1 = rr ? sb[i] : sa[i], sh = rr ? hb[i] : ha[i];
                float y[4];
#pragma unroll
                for (int j = 0; j < 4; ++j) y[j] = v[j] * rstd * gn[i][j] * (1.f + s1[j]) + sh[j];
                u32x2 w; w.x = cvtpk(y[0], y[1]); w.y = cvtpk(y[2], y[3]);
                *(u32x2*)(h + (size_t)r * DM + c0) = w; }
        }
    }
}

template <int RB>
__device__ __forceinline__ void prep0_block(const Params& p, const int row0, const int lane0) {
    bf16_t* proj = (bf16_t*)(p.ws + WS_PROJ);
    bf16_t* qkvp = (bf16_t*)p.out;
    float* gbuf = (float*)(p.ws + WS_GATES);
    const float* ropec = (const float*)(p.ws + WS_ROPE); const float* ropes = ropec + SEQ * 32;
    {
        int lane = lane0; asm volatile("" : "+v"(lane));
        const bool lat = row0 < NLAT; const int t0 = lat ? (row0 & 8191) : ((row0 - NLAT) & 255); const int len = lat ? SEQ : CTXL;
        const int dsub = (lane & 7) * 8;
        {
            float gq[8], gk[8];
#pragma unroll
            for (int i = 0; i < 8; ++i) { gq[i] = p.diff_qk_gain[dsub + i] * (0.125f * 1.4426950408889634f); gk[i] = p.diff_qk_gain[64 + dsub + i]; }
            constexpr int DB = RB < 4 ? RB : 4;
#pragma unroll
            for (int i0 = 0; i0 < RB; i0 += DB) {
                bf16x8 raw[DB][2]; f32x4 c4[DB], s4[DB];
#pragma unroll
                for (int i = 0; i < DB; ++i) { const bf16_t* P = proj + (size_t)(row0 + i0 + i) * EV_NP;
                    raw[i][0] = *(const bf16x8*)(P + lane * 8); raw[i][1] = *(const bf16x8*)(P + 512 + lane * 8);
                    c4[i] = (f32x4){1.f, 1.f, 1.f, 1.f}; s4[i] = (f32x4){0.f, 0.f, 0.f, 0.f};
                    if (lat) { c4[i] = *(const f32x4*)(ropec + (t0 + i0 + i) * 32 + (lane & 7) * 4); s4[i] = *(const f32x4*)(ropes + (t0 + i0 + i) * 32 + (lane & 7) * 4); } }
#pragma unroll
                for (int i = 0; i < DB; ++i) { bf16_t* P = proj + (size_t)(row0 + i0 + i) * EV_NP;
#pragma unroll
                    for (int which = 0; which < 2; ++which) {
                        float v[8]; unpack8(raw[i][which], v);
                        float ss = 0.f;
#pragma unroll
                        for (int e = 0; e < 8; ++e) ss += v[e] * v[e];
                        ss += __shfl_xor(ss, 1); ss += __shfl_xor(ss, 2); ss += __shfl_xor(ss, 4);
                        const float rstd = rsqrtf(ss * (1.f / 64.f) + 1e-6f);
#pragma unroll
                        for (int e = 0; e < 8; ++e) v[e] = v[e] * rstd * (which ? gk[e] : gq[e]);
#pragma unroll
                        for (int e = 0; e < 4; ++e) { const float x0 = v[2 * e], x1 = v[2 * e + 1]; v[2 * e] = x0 * c4[i][e] - x1 * s4[i][e]; v[2 * e + 1] = x0 * s4[i][e] + x1 * c4[i][e]; }
                        *(bf16x8*)(P + which * 512 + lane * 8) = pack8(v);
                    } }
            }
        }
#pragma unroll 1
        for (int g = 0; g < 3; ++g) {
            const int c0 = g * 512 + lane * 8;
            float w[5][8];
#pragma unroll
            for (int j = 0; j < 5; ++j) { const f32x4 w0 = *(const f32x4*)(p.gdn_conv + j * 1536 + c0), w1 = *(const f32x4*)(p.gdn_conv + j * 1536 + c0 + 4);
#pragma unroll
                for (int e = 0; e < 4; ++e) { w[j][e] = w0[e]; w[j][4 + e] = w1[e]; } }
            const bf16_t* src = proj + (size_t)row0 * EV_NP + 1536 + c0;
            bf16x8 raw[RB + 4];
#pragma unroll
            for (int k = 0; k < RB + 4; ++k) { const int dt = k - 2; raw[k] = (bf16x8){0, 0, 0, 0, 0, 0, 0, 0};
                if (t0 + dt >= 0 && t0 + dt < len) raw[k] = *(const bf16x8*)(src + (ptrdiff_t)dt * EV_NP); }
            const float nsc = g == 0 ? 0.08838834764831845f : 1.f;
#pragma unroll
            for (int i = 0; i < RB; ++i) {
                float xm2[8], xm1[8], x0[8], xp1[8], xp2[8];
                unpack8(raw[i], xm2); unpack8(raw[i + 1], xm1); unpack8(raw[i + 2], x0); unpack8(raw[i + 3], xp1); unpack8(raw[i + 4], xp2);
                float y[8];
#pragma unroll
                for (int e = 0; e < 8; ++e) { y[e] = w[0][e] * xm2[e] + w[1][e] * xm1[e] + w[2][e] * x0[e] + w[3][e] * xp1[e] + w[4][e] * xp2[e]; y[e] = y[e] * __builtin_amdgcn_rcpf(1.f + __expf(-y[e])); }
                if (g < 2) { float ss = 0.f;
#pragma unroll
                    for (int e = 0; e < 8; ++e) ss += y[e] * y[e];
                    ss += __shfl_xor(ss, 1); ss += __shfl_xor(ss, 2); ss += __shfl_xor(ss, 4); ss += __shfl_xor(ss, 8);
                    const float sc_ = rsqrtf(ss + 1e-6f) * nsc;
#pragma unroll
                    for (int e = 0; e < 8; ++e) y[e] *= sc_; }
                *(bf16x8*)(qkvp + (size_t)(row0 + i) * 1536 + c0) = pack8(y);
            }
        }
#pragma unroll
        for (int k = 0; k < (RB * 16 + 63) / 64; ++k) { const int idx = lane + 64 * k, i = idx >> 4, gi = idx & 15; if (idx >= RB * 16) break;
            const float gvv = bf2f(proj[(size_t)(row0 + i) * EV_NP + 3584 + gi]); float o;
            if (gi < 8) o = 1.f / (1.f + expf(-gvv));
            else { const float z = gvv + p.gdn_dt_bias[gi - 8]; const float sp = z > 20.f ? z : log1pf(expf(z)); o = -expf(p.gdn_a_log[gi - 8]) * sp; }
            gbuf[(size_t)(row0 + i) * 16 + gi] = o; }
    }
}
__device__ __forceinline__ void prep0_phase(const Params& p) {
    const int lane0 = threadIdx.x & 63, wid = threadIdx.x >> 6;
    for (int blk = blockIdx.x * 8 + wid; blk < NLAT / 8; blk += gridDim.x * 8) prep0_block<8>(p, blk * 8, lane0);
    for (int r = blockIdx.x * 8 + wid; r < NCTX; r += gridDim.x * 8) prep0_block<1>(p, NLAT + r, lane0);
}

__device__ __forceinline__ int gdn_row(int b, int pc, int tau, int dir) {
    const int tt = dir ? 63 - tau : tau;
    return pc < 4 ? NLAT + b * CTXL + pc * 64 + tt : b * SEQ + (pc - 4) * 64 + tt;
}
__device__ __forceinline__ void gdn_pre_phase(const Params& p, unsigned char* lds) {
    const int lane = threadIdx.x & 63, wid = threadIdx.x >> 6;
    float* Lw = (float*)(lds + wid * 16896);
    float* gs = Lw + 4096; float* bs = gs + 64;
    const bf16_t* qkvp = (const bf16_t*)p.out;
    const float* gbuf = (const float*)(p.ws + WS_GATES);
    bf16_t* Tb = (bf16_t*)(p.ws + WS_T); bf16_t* Ab = (bf16_t*)(p.ws + WS_AQK);
    float* gv = (float*)(p.ws + WS_GV); float* bv = (float*)(p.ws + WS_BV);
    const int lane0 = lane;
    for (int cp = blockIdx.x * 8 + wid; cp < NCHUNKP; cp += gridDim.x * 8) {
        int lane = lane0; asm volatile("" : "+v"(lane));
        const int r32 = lane & 31, hi = lane >> 5;
        const int pc = cp % 132, ch = cp / 132, dir = ch & 1, h = (ch >> 1) & 3, b = ch >> 3;
        float g_keep, be_keep;
        { const int R = gdn_row(b, pc, lane, dir);
          float g = gbuf[(size_t)R * 16 + 8 + dir * 4 + h]; const float be = gbuf[(size_t)R * 16 + dir * 4 + h];
#pragma unroll
          for (int o = 1; o < 64; o <<= 1) { const float t = __shfl_up(g, o); if (lane >= o) g += t; }
          gs[lane] = g; bs[lane] = be; g_keep = g; be_keep = be; }
        bf16x8 kf[2][8], qf[2][8];
#pragma unroll
        for (int mi = 0; mi < 2; ++mi) { const size_t R = (size_t)gdn_row(b, pc, 32 * mi + r32, dir);
#pragma unroll
            for (int d0 = 0; d0 < 8; ++d0) { kf[mi][d0] = *(const bf16x8*)(qkvp + R * 1536 + 512 + h * 128 + d0 * 16 + hi * 8);
                                             qf[mi][d0] = *(const bf16x8*)(qkvp + R * 1536 + h * 128 + d0 * 16 + hi * 8); } }
        { const float gl_ = __shfl(g_keep, 63); gv[(size_t)cp * 64 + lane] = expf(g_keep); bv[(size_t)cp * 64 + lane] = be_keep; ((float*)(p.ws + WS_EL))[(size_t)cp * 64 + lane] = expf(gl_ - g_keep); }
        bf16_t* Ao = Ab + (size_t)cp * 4096;
#pragma unroll
        for (int mi = 0; mi < 2; ++mi) {
#pragma unroll
            for (int ni = 0; ni <= mi; ++ni) {
                f32x16 ckk = {}, cqk = {};
#pragma unroll
                for (int d0 = 0; d0 < 8; ++d0) { ckk = __builtin_amdgcn_mfma_f32_32x32x16_bf16(kf[mi][d0], kf[ni][d0], ckk, 0, 0, 0);
                                                 cqk = __builtin_amdgcn_mfma_f32_32x32x16_bf16(qf[mi][d0], kf[ni][d0], cqk, 0, 0, 0); }
                const int sg = 32 * ni + r32; const float gsg = gs[sg];
#pragma unroll
                for (int r = 0; r < 16; ++r) { const int tau = 32 * mi + crow(r, hi);
                    const float dec = tau >= sg ? __expf(gs[tau] - gsg) : 0.f;
                    Lw[tau * 64 + sg] = tau > sg ? bs[tau] * dec * ckk[r] : 0.f;
                    Ao[tau * 64 + sg] = f2bf(cqk[r] * dec); }
                asm volatile("" ::: "memory");
            }
        }
#pragma unroll
        for (int r = 0; r < 16; ++r) Ao[crow(r, hi) * 64 + 32 + r32] = 0;
        float Tc[64];
#pragma unroll
        for (int i = 0; i < 64; ++i) { float a = (i == lane) ? 1.f : 0.f;
#pragma unroll
            for (int j = 0; j < i; ++j) a -= Lw[i * 64 + j] * Tc[j];
            Tc[i] = a; asm volatile("" ::: "memory"); }
        bf16_t* To = Tb + (size_t)cp * 4096;
#pragma unroll
        for (int i = 0; i < 64; ++i) To[i * 64 + lane] = f2bf(Tc[i]);
    }
}

constexpr int G_KV = 0, G_QA = 16384, G_TT = 32768, G_AQ = G_TT + 9216, G_RT = G_AQ + 9216, G_UT = G_RT + 4608, G_UP = G_UT + 4608,
              G_ST = G_UP + 4608, G_VS = G_ST + 8704, G_GS = G_VS + 4096, G_BS = G_GS + 256, G_EL = G_BS + 256, G_END = G_EL + 256;
__device__ __forceinline__ void gdn_scan_phase(const Params& p, unsigned char* lds) {
    const int tid = threadIdx.x, lane0 = tid & 63, wid = tid >> 6;
    const bf16_t* qkvp = (const bf16_t*)p.out;
    const bf16_t* Tb = (const bf16_t*)(p.ws + WS_T); const bf16_t* Ab = (const bf16_t*)(p.ws + WS_AQK);
    const float* gv = (const float*)(p.ws + WS_GV); const float* bv = (const float*)(p.ws + WS_BV);
    bf16_t* obuf = (bf16_t*)(p.ws + WS_H);
    const float* gsl = (const float*)(lds + G_GS); const float* bsl = (const float*)(lds + G_BS); const float* esl = (const float*)(lds + G_EL);
    const int sr = tid >> 4, sc = (tid & 15) * 8;
    const int vblk = (gridDim.x % 8 == 0) ? (int)((blockIdx.x & 7) * (gridDim.x >> 3) + (blockIdx.x >> 3)) : (int)blockIdx.x;
    for (int wi = vblk; wi < 256; wi += gridDim.x) {
        const int chain = wi >> 2, cs = wi & 3, b = chain >> 3, h = (chain >> 1) & 3, dir = chain & 1;
        f32x16 Sacc = {};
        for (int i = tid; i < 8704 / 4; i += NTHREADS) ((unsigned*)(lds + G_ST))[i] = 0u;
        bf16x8 sk0, sk1, sq0, sq1, sT, sA, sV; float sg = 0.f;
#define GLOAD(step) do { const int pc_ = dir == 0 ? (step) : ((step) < 4 ? 3 - (step) : 4 + 127 - ((step) - 4)); \
        const size_t cp_ = (size_t)chain * 132 + pc_; \
        const size_t R0_ = (size_t)gdn_row(b, pc_, sr, dir), R1_ = (size_t)gdn_row(b, pc_, 32 + sr, dir); \
        sk0 = *(const bf16x8*)(qkvp + R0_ * 1536 + 512 + h * 128 + sc); sk1 = *(const bf16x8*)(qkvp + R1_ * 1536 + 512 + h * 128 + sc); \
        sq0 = *(const bf16x8*)(qkvp + R0_ * 1536 + h * 128 + sc); sq1 = *(const bf16x8*)(qkvp + R1_ * 1536 + h * 128 + sc); \
        sT = *(const bf16x8*)(Tb + cp_ * 4096 + tid * 8); sA = *(const bf16x8*)(Ab + cp_ * 4096 + tid * 8); \
        if (tid < 256) { const size_t Rv_ = (size_t)gdn_row(b, pc_, tid >> 2, dir); sV = *(const bf16x8*)(qkvp + Rv_ * 1536 + 1024 + h * 128 + cs * 32 + (tid & 3) * 8); } \
        if (tid < 64) sg = gv[cp_ * 64 + tid]; else if (tid < 128) sg = bv[cp_ * 64 + tid - 64]; else if (tid < 192) sg = ((const float*)(p.ws + WS_EL))[cp_ * 64 + tid - 128]; } while (0)
#define GWRITE() do { *(bf16x8*)(lds + G_KV + v_st(sr, sc)) = sk0; *(bf16x8*)(lds + G_KV + v_st(32 + sr, sc)) = sk1; \
        *(bf16x8*)(lds + G_QA + KSWZ(sr, sc * 2)) = sq0; *(bf16x8*)(lds + G_QA + KSWZ(32 + sr, sc * 2)) = sq1; \
        *(bf16x8*)(lds + G_TT + (tid >> 3) * 144 + (tid & 7) * 16) = sT; *(bf16x8*)(lds + G_AQ + (tid >> 3) * 144 + (tid & 7) * 16) = sA; \
        if (tid < 256) *(bf16x8*)(lds + G_VS + (tid >> 2) * 64 + (tid & 3) * 16) = sV; \
        if (tid < 192) ((float*)(lds + G_GS))[tid] = sg; } while (0)
        GLOAD(0);
        for (int step = 0; step < 132; ++step) {
            GWRITE();
            __syncthreads();
            if (step + 1 < 132) GLOAD(step + 1);
            int lane = lane0; asm volatile("" : "+v"(lane));
            const int r32 = lane & 31, hi = lane >> 5;
            const int vb0 = (int)(uintptr_t)(lds + G_KV) + v_rd_base(lane);
            const int pc = dir == 0 ? step : (step < 4 ? 3 - step : 4 + 127 - (step - 4));
            f32x16 acc = {};
            const int mi = wid & 1;
            if (wid < 4) {
                f32x16 acc2 = {};
                if (wid < 2) {
#pragma unroll
                    for (int d0 = 0; d0 < 8; d0 += 2) {
                        const bf16x8 a0 = *(const bf16x8*)(lds + G_KV + v_st(32 * mi + r32, d0 * 16 + hi * 8)), a1 = *(const bf16x8*)(lds + G_KV + v_st(32 * mi + r32, d0 * 16 + 16 + hi * 8));
                        const bf16x8 b0 = *(const bf16x8*)(lds + G_ST + r32 * 272 + (d0 * 16 + hi * 8) * 2), b1 = *(const bf16x8*)(lds + G_ST + r32 * 272 + (d0 * 16 + 16 + hi * 8) * 2);
                        acc = __builtin_amdgcn_mfma_f32_32x32x16_bf16(a0, b0, acc, 0, 0, 0);
                        acc2 = __builtin_amdgcn_mfma_f32_32x32x16_bf16(a1, b1, acc2, 0, 0, 0); }
                } else {
#pragma unroll
                    for (int d0 = 0; d0 < 8; d0 += 2) {
                        const bf16x8 a0 = *(const bf16x8*)(lds + G_QA + KSWZ(32 * mi + r32, (d0 * 16 + hi * 8) * 2)), a1 = *(const bf16x8*)(lds + G_QA + KSWZ(32 * mi + r32, (d0 * 16 + 16 + hi * 8) * 2));
                        const bf16x8 b0 = *(const bf16x8*)(lds + G_ST + r32 * 272 + (d0 * 16 + hi * 8) * 2), b1 = *(const bf16x8*)(lds + G_ST + r32 * 272 + (d0 * 16 + 16 + hi * 8) * 2);
                        acc = __builtin_amdgcn_mfma_f32_32x32x16_bf16(a0, b0, acc, 0, 0, 0);
                        acc2 = __builtin_amdgcn_mfma_f32_32x32x16_bf16(a1, b1, acc2, 0, 0, 0); }
                }
#pragma unroll
                for (int r = 0; r < 16; ++r) acc[r] += acc2[r];
                if (wid < 2) {
#pragma unroll
                    for (int g4 = 0; g4 < 4; ++g4) { float rv[4];
#pragma unroll
                        for (int j = 0; j < 4; ++j) { const int tau = 32 * mi + 8 * g4 + 4 * hi + j;
                            const float vv = bf2f(*(const bf16_t*)(lds + G_VS + tau * 64 + r32 * 2));
                            rv[j] = bsl[tau] * (vv - gsl[tau] * acc[g4 * 4 + j]); }
                        u32x2 w; w.x = cvtpk(rv[0], rv[1]); w.y = cvtpk(rv[2], rv[3]);
                        *(u32x2*)(lds + G_RT + r32 * 144 + (32 * mi + 8 * g4 + 4 * hi) * 2) = w; }
                } else {
#pragma unroll
                    for (int r = 0; r < 16; ++r) acc[r] *= gsl[32 * mi + crow(r, hi)];
                }
            }
            __syncthreads();
            if (wid < 2) {
                f32x16 u = {}, u2 = {};
#pragma unroll
                for (int s = 0; s < 4; s += 2) {
                    const bf16x8 a0 = *(const bf16x8*)(lds + G_TT + (32 * mi + r32) * 144 + (16 * s + hi * 8) * 2), a1 = *(const bf16x8*)(lds + G_TT + (32 * mi + r32) * 144 + (16 * s + 16 + hi * 8) * 2);
                    const bf16x8 b0 = *(const bf16x8*)(lds + G_RT + r32 * 144 + (16 * s + hi * 8) * 2), b1 = *(const bf16x8*)(lds + G_RT + r32 * 144 + (16 * s + 16 + hi * 8) * 2);
                    u = __builtin_amdgcn_mfma_f32_32x32x16_bf16(a0, b0, u, 0, 0, 0);
                    u2 = __builtin_amdgcn_mfma_f32_32x32x16_bf16(a1, b1, u2, 0, 0, 0); }
#pragma unroll
                for (int r = 0; r < 16; ++r) u[r] += u2[r];
#pragma unroll
                for (int g4 = 0; g4 < 4; ++g4) { float uv[4], up[4];
#pragma unroll
                    for (int j = 0; j < 4; ++j) { const int tau = 32 * mi + 8 * g4 + 4 * hi + j; uv[j] = u[g4 * 4 + j]; up[j] = uv[j] * esl[tau]; }
                    u32x2 w; w.x = cvtpk(uv[0], uv[1]); w.y = cvtpk(uv[2], uv[3]);
                    *(u32x2*)(lds + G_UT + r32 * 144 + (32 * mi + 8 * g4 + 4 * hi) * 2) = w;
                    u32x2 w2; w2.x = cvtpk(up[0], up[1]); w2.y = cvtpk(up[2], up[3]);
                    *(u32x2*)(lds + G_UP + r32 * 144 + (32 * mi + 8 * g4 + 4 * hi) * 2) = w2; }
            }
            __syncthreads();
            if (wid == 2 || wid == 3) {
#pragma unroll
                for (int s = 0; s < 4; ++s) {
                    const bf16x8 a = *(const bf16x8*)(lds + G_AQ + (32 * mi + r32) * 144 + (16 * s + hi * 8) * 2);
                    const bf16x8 bb = *(const bf16x8*)(lds + G_UT + r32 * 144 + (16 * s + hi * 8) * 2);
                    acc = __builtin_amdgcn_mfma_f32_32x32x16_bf16(a, bb, acc, 0, 0, 0); }
#pragma unroll
                for (int r = 0; r < 16; ++r) { const size_t R = (size_t)gdn_row(b, pc, 32 * mi + crow(r, hi), dir);
                    obuf[((size_t)dir * MTOT + R) * 512 + h * 128 + cs * 32 + r32] = f2bf(acc[r]); }
            } else if (wid >= 4) {
                const float gl = gsl[63];
#pragma unroll
                for (int r = 0; r < 16; ++r) Sacc[r] *= gl;
                const bf16x8 pa0 = *(const bf16x8*)(lds + G_UP + r32 * 144 + (0 + hi * 8) * 2), pa1 = *(const bf16x8*)(lds + G_UP + r32 * 144 + (16 + hi * 8) * 2),
                             pa2 = *(const bf16x8*)(lds + G_UP + r32 * 144 + (32 + hi * 8) * 2), pa3 = *(const bf16x8*)(lds + G_UP + r32 * 144 + (48 + hi * 8) * 2);
                const int d0 = wid - 4;
                if (d0 == 0) pv_one<0>(Sacc, vb0, pa0, pa1, pa2, pa3); else if (d0 == 1) pv_one<1>(Sacc, vb0, pa0, pa1, pa2, pa3);
                else if (d0 == 2) pv_one<2>(Sacc, vb0, pa0, pa1, pa2, pa3); else pv_one<3>(Sacc, vb0, pa0, pa1, pa2, pa3);
#pragma unroll
                for (int r = 0; r < 16; ++r) *(bf16_t*)(lds + G_ST + crow(r, hi) * 272 + (32 * d0 + r32) * 2) = f2bf(Sacc[r]);
            }
            __syncthreads();
        }
#undef GLOAD
#undef GWRITE
    }
}

__device__ __forceinline__ void gdn_post_phase(const Params& p) {
    const int lane = threadIdx.x & 63, wid = threadIdx.x >> 6;
    const bf16_t* obuf = (const bf16_t*)(p.ws + WS_H);
    const bf16_t* proj = (const bf16_t*)(p.ws + WS_PROJ);
    bf16_t* mix = (bf16_t*)(p.ws + WS_MIX);
    const int d = (lane & 15) * 8;
    for (int row = blockIdx.x * 8 + wid; row < MTOT; row += gridDim.x * 8) {
        float a[8], bb[8], g[8], y[8];
        unpack8(*(const bf16x8*)(obuf + (size_t)row * 512 + lane * 8), a);
        unpack8(*(const bf16x8*)(obuf + ((size_t)MTOT + row) * 512 + lane * 8), bb);
        unpack8(*(const bf16x8*)(proj + (size_t)row * EV_NP + 3072 + lane * 8), g);
        float ss = 0.f;
#pragma unroll
        for (int i = 0; i < 8; ++i) { a[i] += bb[i]; ss += a[i] * a[i]; }
        ss += __shfl_xor(ss, 1); ss += __shfl_xor(ss, 2); ss += __shfl_xor(ss, 4); ss += __shfl_xor(ss, 8);
        const float rstd = rsqrtf(ss * (1.f / 128.f) + 1e-6f);
#pragma unroll
        for (int i = 0; i < 8; ++i) y[i] = a[i] * rstd * p.gdn_norm[d + i] * (g[i] * __builtin_amdgcn_rcpf(1.f + __expf(-g[i])));
        *(bf16x8*)(mix + (size_t)row * DM + 512 + lane * 8) = pack8(y);
    }
}

__device__ __forceinline__ void diffattn_phase(const Params& p, unsigned char* lds) {
    const int tid = threadIdx.x, wid = tid >> 6, lane = tid & 63, r32 = lane & 31, hi = lane >> 5;
    const bf16_t* proj = (const bf16_t*)(p.ws + WS_PROJ);
    bf16_t* mix = (bf16_t*)(p.ws + WS_MIX);
    float s01 = 0.f, s23 = 0.f;
    for (int i = 0; i < 64; ++i) { s01 += p.diff_lambda[i] * p.diff_lambda[64 + i]; s23 += p.diff_lambda[128 + i] * p.diff_lambda[192 + i]; }
    const float lam = expf(s01) - expf(s23) + 0.2f;
    float* X = (float*)lds; float* li = (float*)(lds + 131072) + wid * 64;
    LAS unsigned char* ldsl = (LAS unsigned char*)lds;
    int koff[2], voff[2];
#pragma unroll
    for (int i = 0; i < 2; ++i) {
        const int g = i * 512 + tid;
        { const int row = g >> 4, cg = (g & 15) ^ (row & 7); koff[i] = row * EV_NP + cg * 8; }
        { const int o = g * 16, st = o >> 9, w = o & 511, kk = (st >> 2) * 8 + (w >> 6);
          const int k = (kk & ~0xC) | ((kk & 4) << 1) | ((kk & 8) >> 1), cc = (st & 3) * 32 + ((w & 63) >> 4) * 8; voff[i] = k * EV_NP + cc; }
    }
    const int vbase = (int)(uintptr_t)lds + v_rd_base(lane);
    const int map = wid >> 2, wq = wid & 3;
    unsigned char* Qs = lds + 98304 + wid * 4096 + lane * 16;
    const int vblk = (gridDim.x % 8 == 0) ? (int)((blockIdx.x & 7) * (gridDim.x >> 3) + (blockIdx.x >> 3)) : (int)blockIdx.x;
    for (int it = vblk; it < 2112; it += gridDim.x) {
        int b, h, NT, qrow0;
        if (it < 2048) { b = it >> 8; h = (it >> 6) & 3; const int qb = it & 63; NT = 132; qrow0 = b * SEQ + qb * 128; }
        else { const int j = it - 2048; b = j >> 3; h = (j >> 1) & 3; NT = 4; qrow0 = NLAT + b * CTXL + (j & 1) * 128; }
        bf16x8 qr[4];
        { const bf16_t* qp = proj + (size_t)(qrow0 + 32 * wq + r32) * EV_NP + h * 128 + map * 64 + hi * 8;
#pragma unroll
          for (int d0 = 0; d0 < 4; ++d0) qr[d0] = *(const bf16x8*)(qp + d0 * 16); }
        f32x16 o[4] = {}; float lsum = 0.f;
#define DDMA(j, bo) do { const bf16_t* pp_ = proj + (size_t)((j) < 4 ? NLAT + b * CTXL + 64 * (j) : b * SEQ + 64 * ((j) - 4)) * EV_NP + h * 128; \
        _Pragma("unroll") for (int i_ = 0; i_ < 2; ++i_) { \
            __builtin_amdgcn_global_load_lds((const unsigned*)(pp_ + 1024 + voff[i_]), (LAS unsigned*)(ldsl + (bo) + i_ * 8192 + wid * 1024), 16, 0, 0); \
            __builtin_amdgcn_global_load_lds((const unsigned*)(pp_ + 512 + koff[i_]), (LAS unsigned*)(ldsl + (bo) + 16384 + i_ * 8192 + wid * 1024), 16, 0, 0); } } while (0)
#define DQK(P0, P1, bo) do { P0 = (f32x16){}; P1 = (f32x16){}; const unsigned char* Ks_ = lds + (bo) + 16384; \
        _Pragma("unroll") for (int d0 = 0; d0 < 4; ++d0) { const int cb_ = (map * 64 + d0 * 16 + hi * 8) * 2; \
            const bf16x8 b0_ = *(const bf16x8*)(Ks_ + KSWZ(r32, cb_)), b1_ = *(const bf16x8*)(Ks_ + KSWZ(32 + r32, cb_)); \
            P0 = __builtin_amdgcn_mfma_f32_32x32x16_bf16(b0_, qr[d0], P0, 0, 0, 0); \
            P1 = __builtin_amdgcn_mfma_f32_32x32x16_bf16(b1_, qr[d0], P1, 0, 0, 0); } } while (0)
#define DSM(P0, P1) do { _Pragma("unroll") for (int r = 0; r < 16; ++r) { P0[r] = __builtin_amdgcn_exp2f(P0[r]); P1[r] = __builtin_amdgcn_exp2f(P1[r]); lsum += P0[r] + P1[r]; } \
        PK4(P0, 0, pa0); PK4(P0, 8, pa1); PK4(P1, 0, pa2); PK4(P1, 8, pa3); } while (0)
#define DTAIL_() asm volatile("s_waitcnt vmcnt(0)" ::: "memory"); __syncthreads(); { const int t_ = bprev; bprev = bcur; bcur = bnext; bnext = t_; }
#define DSTEP_A(N0, N1, O0, O1, j) do { if ((j) + 1 < NT) DDMA((j) + 1, bnext); \
        DQK(N0, N1, bcur); DSM(O0, O1); pv_d0(o, vbase + bprev, pa0, pa1, pa2, pa3); DTAIL_() } while (0)
#define DSTEP_B(N0, N1, O0, O1, j) do { if ((j) + 1 < NT) DDMA((j) + 1, bnext); \
        DSM(O0, O1); pv_d0(o, vbase + bprev, pa0, pa1, pa2, pa3); SBAR(); DQK(N0, N1, bcur); DTAIL_() } while (0)
        f32x16 pA0, pA1, pB0, pB1; bf16x8 pa0, pa1, pa2, pa3;
        DDMA(0, 0); DDMA(1, 32768); asm volatile("s_waitcnt vmcnt(0)" ::: "memory"); __syncthreads();
        DQK(pA0, pA1, 0);
        int bprev = 0, bcur = 32768, bnext = 65536;
        if (map == 0) {
            for (int j = 1; j + 1 < NT; j += 2) { DSTEP_A(pB0, pB1, pA0, pA1, j); DSTEP_A(pA0, pA1, pB0, pB1, j + 1); }
            DSTEP_A(pB0, pB1, pA0, pA1, NT - 1);
        } else {
            for (int j = 1; j + 1 < NT; j += 2) { DSTEP_B(pB0, pB1, pA0, pA1, j); DSTEP_B(pA0, pA1, pB0, pB1, j + 1); }
            DSTEP_B(pB0, pB1, pA0, pA1, NT - 1);
        }
        DSM(pB0, pB1); pv_d0(o, vbase + bprev, pa0, pa1, pa2, pa3);
        __syncthreads();
#undef DDMA
#undef DQK
#undef DSM
#undef DSTEP_A
#undef DSTEP_B
#undef DTAIL_
        const float lt = halfswap_add(lsum);
        if (hi == 0) li[r32] = lt;
        asm volatile("s_waitcnt lgkmcnt(0)" ::: "memory");
        float rli[16];
#pragma unroll
        for (int r = 0; r < 16; ++r) rli[r] = __builtin_amdgcn_rcpf(li[crow(r, hi)]);
        if (map == 1) {
#pragma unroll
            for (int d0 = 0; d0 < 4; ++d0)
#pragma unroll
                for (int r = 0; r < 16; ++r) X[(wq * 64 + d0 * 16 + r) * 64 + lane] = o[d0][r] * rli[r] * lam;
        }
        __syncthreads();
        if (map == 0) {
#pragma unroll
            for (int d0 = 0; d0 < 4; ++d0)
#pragma unroll
                for (int r = 0; r < 16; ++r) o[d0][r] = o[d0][r] * rli[r] - X[(wq * 64 + d0 * 16 + r) * 64 + lane];
#pragma unroll
            for (int r = 0; r < 16; ++r) {
                float ss = o[0][r] * o[0][r] + o[1][r] * o[1][r] + o[2][r] * o[2][r] + o[3][r] * o[3][r];
                ss += __shfl_xor(ss, 1); ss += __shfl_xor(ss, 2); ss += __shfl_xor(ss, 4); ss += __shfl_xor(ss, 8); ss += __shfl_xor(ss, 16);
                const float rstd = rsqrtf(ss * (1.f / 128.f) + 1e-6f) * 0.8f;
                bf16_t* mp = mix + (size_t)(qrow0 + 32 * wq + crow(r, hi)) * DM + h * 128 + r32;
#pragma unroll
                for (int d0 = 0; d0 < 4; ++d0) mp[32 * d0] = f2bf(o[d0][r] * rstd * p.diff_subln[32 * d0 + r32]);
            }
        }
        __syncthreads();
    }
}

__device__ __forceinline__ void natten_phase(const Params& p, unsigned char* lds) {
    const int tid = threadIdx.x, wid = tid >> 6, lane = tid & 63, r32 = lane & 31, hi = lane >> 5;
    const bf16_t* proj = (const bf16_t*)(p.ws + WS_PROJ);
    bf16_t* mix = (bf16_t*)(p.ws + WS_MIX);
    constexpr float L2E = 1.4426950408889634f;
    unsigned char* Vl = lds; unsigned char* Kl = lds + 32768;
    float* rpbs = (float*)(lds + 65536);
    float* li = (float*)(lds + 133120) + wid * 64;
    unsigned char* Qs = lds + 67584 + wid * 8192 + lane * 16;
    const int sr = tid >> 4, sc = (tid & 15) * 8, vst0 = v_st(sr, sc), vst1 = v_st(32 + sr, sc);
    const int vb0 = (int)(uintptr_t)Vl + v_rd_base(lane);
    const float* gkp = p.na_qk_gain + 128 + sc;
    const int vblk = (gridDim.x % 8 == 0) ? (int)((blockIdx.x & 7) * (gridDim.x >> 3) + (blockIdx.x >> 3)) : (int)blockIdx.x;
    for (int it = vblk; it < 2048; it += gridDim.x) {
        const int b = it >> 8, h = (it >> 5) & 7, rq = it & 31;
        const int grow = 4 * rq + (wid >> 1), qc = (wid & 1) * 32 + r32;
        const size_t qR = (size_t)b * SEQ + grow * 64 + qc;
        for (int i = tid; i < 465; i += NTHREADS) rpbs[i] = p.na_rpb[h * 465 + i] * L2E;
        { float ss = 0.f;
#pragma unroll
          for (int d0 = 0; d0 < 8; ++d0) { float qv[8]; unpack8(*(const bf16x8*)(proj + qR * OD_N + h * 128 + d0 * 16 + hi * 8), qv);
#pragma unroll
              for (int i = 0; i < 8; ++i) ss += qv[i] * qv[i]; }
          ss = halfswap_add(ss);
          const float rs = rsqrtf(ss * (1.f / 128.f) + 1e-6f) * 0.08838834764831845f * L2E;
#pragma unroll
          for (int d0 = 0; d0 < 8; ++d0) { float qv[8]; unpack8(*(const bf16x8*)(proj + qR * OD_N + h * 128 + d0 * 16 + hi * 8), qv);
#pragma unroll
              for (int i = 0; i < 8; ++i) qv[i] *= rs * p.na_qk_gain[d0 * 16 + hi * 8 + i];
              *(bf16x8*)(Qs + d0 * 1024) = pack8(qv); } }
        int lo = 4 * rq - 4; lo = lo < 0 ? 0 : (lo > 120 ? 120 : lo);
        int hi_r = 4 * rq + 3 - 4; hi_r = hi_r < 0 ? 0 : (hi_r > 120 ? 120 : hi_r); hi_r += 7;
        const int nlat = hi_r - lo + 1, NT = nlat + 4;
        int wsr = grow - 4; wsr = wsr < 0 ? 0 : (wsr > 120 ? 120 : wsr);
        int cst = qc - 8; cst = cst < 0 ? 0 : (cst > 48 ? 48 : cst);
        f32x16 o[4] = {}; float lsum = 0.f;
        bf16x8 vs0, vs1, ks0, ks1;
#define NLOAD(j) do { const size_t R0_ = (size_t)((j) < nlat ? b * SEQ + (lo + (j)) * 64 : NLAT + b * CTXL + 64 * ((j) - nlat)) + sr; \
        const bf16_t* pp_ = proj + R0_ * OD_N + h * 128 + sc; \
        vs0 = *(const bf16x8*)(pp_ + 2048); vs1 = *(const bf16x8*)(pp_ + 2048 + (size_t)32 * OD_N); \
        ks0 = *(const bf16x8*)(pp_ + 1024); ks1 = *(const bf16x8*)(pp_ + 1024 + (size_t)32 * OD_N); } while (0)
#define KNORM(kx) do { float f_[8]; unpack8(kx, f_); float ss_ = 0.f; _Pragma("unroll") for (int i_ = 0; i_ < 8; ++i_) ss_ += f_[i_] * f_[i_]; \
        ss_ += __shfl_xor(ss_, 1); ss_ += __shfl_xor(ss_, 2); ss_ += __shfl_xor(ss_, 4); ss_ += __shfl_xor(ss_, 8); \
        const float rs_ = rsqrtf(ss_ * (1.f / 128.f) + 1e-6f); _Pragma("unroll") for (int i_ = 0; i_ < 8; ++i_) f_[i_] *= rs_ * gkp[i_]; kx = pack8(f_); } while (0)
#define NWRITE(bf) do { KNORM(ks0); KNORM(ks1); *(bf16x8*)(Vl + (bf) * 16384 + vst0) = vs0; *(bf16x8*)(Vl + (bf) * 16384 + vst1) = vs1; \
        *(bf16x8*)(Kl + (bf) * 16384 + KSWZ(sr, sc * 2)) = ks0; *(bf16x8*)(Kl + (bf) * 16384 + KSWZ(32 + sr, sc * 2)) = ks1; } while (0)
        NLOAD(0); NWRITE(0); __syncthreads();
        for (int j = 0; j < NT; ++j) {
            if (j + 1 < NT) NLOAD(j + 1);
            const int bf = j & 1;
            const bool islat = j < nlat; const int kr = lo + j;
            const bool active = !islat || (kr >= wsr && kr <= wsr + 7);
            if (active) {
                f32x16 p0 = {}, p1 = {};
                const unsigned char* Ks = Kl + bf * 16384;
#pragma unroll
                for (int d0 = 0; d0 < 8; ++d0) { const int cb = (d0 * 16 + hi * 8) * 2;
                    const bf16x8 b0 = *(const bf16x8*)(Ks + KSWZ(r32, cb)), b1 = *(const bf16x8*)(Ks + KSWZ(32 + r32, cb));
                    const bf16x8 qd = *(const bf16x8*)(Qs + d0 * 1024);
                    p0 = __builtin_amdgcn_mfma_f32_32x32x16_bf16(b0, qd, p0, 0, 0, 0);
                    p1 = __builtin_amdgcn_mfma_f32_32x32x16_bf16(b1, qd, p1, 0, 0, 0); }
                if (islat) {
                    const float* rb = rpbs + (kr - grow + 7) * 31 + 15 - qc + 4 * hi;
                    const int mofs = 4 * hi - cst;
#pragma unroll
                    for (int r = 0; r < 16; ++r) {
                        const int kb = (r & 3) + 8 * (r >> 2);
                        const float e0 = __builtin_amdgcn_exp2f(p0[r] + rb[kb]), e1 = __builtin_amdgcn_exp2f(p1[r] + rb[32 + kb]);
                        p0[r] = ((unsigned)(kb + mofs) < 16u) ? e0 : 0.f; p1[r] = ((unsigned)(32 + kb + mofs) < 16u) ? e1 : 0.f;
                        lsum += p0[r] + p1[r]; }
                } else {
#pragma unroll
                    for (int r = 0; r < 16; ++r) { p0[r] = __builtin_amdgcn_exp2f(p0[r]); p1[r] = __builtin_amdgcn_exp2f(p1[r]); lsum += p0[r] + p1[r]; }
                }
                bf16x8 pa0, pa1, pa2, pa3;
                PK4(p0, 0, pa0); PK4(p0, 8, pa1); PK4(p1, 0, pa2); PK4(p1, 8, pa3);
                pv_d0(o, vb0 + bf * 16384, pa0, pa1, pa2, pa3);
            }
            if (j + 1 < NT) NWRITE((j + 1) & 1);
            __syncthreads();
        }
#undef NLOAD
#undef KNORM
#undef NWRITE
        const float lt = halfswap_add(lsum);
        if (hi == 0) li[r32] = lt;
        asm volatile("s_waitcnt lgkmcnt(0)" ::: "memory");
#pragma unroll
        for (int r = 0; r < 16; ++r) { const float rl = __builtin_amdgcn_rcpf(li[crow(r, hi)]);
            bf16_t* mp = mix + ((size_t)b * SEQ + grow * 64 + (wid & 1) * 32 + crow(r, hi)) * DM + h * 128 + r32;
#pragma unroll
            for (int d0 = 0; d0 < 4; ++d0) mp[32 * d0] = f2bf(o[d0][r] * rl); }
        __syncthreads();
    }
}

#define XB_TMO      128
#define XB_XCNT(j)  (256  + 64 * (j))
#define XB_XSUB(j)  (1280 + 64 * (j))
#define XB_XGEN(j)  (2304 + 64 * (j))
#define XB_TOP      3328
#define XB_TOPGEN   3392
#define XCD_BAR_WORDS 3456
#define XB_SPIN_CAP (1u << 22)
__device__ __forceinline__ unsigned xb_ld(unsigned* p)              { return __hip_atomic_load(p, __ATOMIC_RELAXED, __HIP_MEMORY_SCOPE_AGENT); }
__device__ __forceinline__ unsigned xb_add(unsigned* p, unsigned v) { return __hip_atomic_fetch_add(p, v, __ATOMIC_RELAXED, __HIP_MEMORY_SCOPE_AGENT); }
__device__ __forceinline__ unsigned xb_xcc_id() { return (unsigned)__builtin_amdgcn_s_getreg((3 << 11) | 20) & 0xFu; }
#define XB_SPIN(cond, bar) do { unsigned _sp = 0; while (cond) { __builtin_amdgcn_s_sleep(1); \
    if ((++_sp & 255u) == 0u) { if (xb_ld(&(bar)[XB_TMO])) break; if (_sp > XB_SPIN_CAP) { atomicAdd(&(bar)[XB_TMO], 1u); break; } } } } while (0)
struct XcdBarrier { unsigned* bar; unsigned x; volatile LAS unsigned* st; };
__device__ __forceinline__ XcdBarrier xcd_barrier_post(unsigned* bar, volatile LAS unsigned* st) {
    XcdBarrier b; b.bar = bar; b.x = xb_xcc_id(); b.st = st;
    if (threadIdx.x == 0) (void)xb_add(&bar[XB_XCNT(b.x)], 1u);
    return b;
}
__device__ __forceinline__ void xcd_barrier_complete(unsigned* bar, unsigned x, unsigned& nloc, unsigned& nx) {
    const unsigned G = gridDim.x * gridDim.y * gridDim.z;
    unsigned sum, cnt, mine, sp = 0u;
    for (;;) {
        sum = 0u; cnt = 0u; mine = 0u;
#pragma unroll
        for (unsigned j = 0; j < 16; ++j) { const unsigned c = xb_ld(&bar[XB_XCNT(j)]); sum += c; cnt += (c > 0u) ? 1u : 0u; mine = (j == x) ? c : mine; }
        if (sum == G) break;
        __builtin_amdgcn_s_sleep(1);
        if ((++sp & 255u) == 0u) { if (xb_ld(&bar[XB_TMO])) break; if (sp > XB_SPIN_CAP) { atomicAdd(&bar[XB_TMO], 1u); break; } }
    }
    nloc = mine > 0u ? mine : 1u; nx = cnt > 0u ? cnt : 1u;
}
__device__ __forceinline__ void xcd_barrier(const XcdBarrier& b) {
    asm volatile("s_waitcnt vmcnt(0)" ::: "memory");
    __syncthreads();
    if (threadIdx.x == 0) {
        unsigned* bar = b.bar;
        __builtin_amdgcn_s_waitcnt(0);
        unsigned nloc = b.st[0], nx = b.st[1];
        if (nloc == 0u) { xcd_barrier_complete(bar, b.x, nloc, nx); b.st[0] = nloc; b.st[1] = nx; }
        const unsigned old = xb_add(&bar[XB_XSUB(b.x)], 1u);
        const unsigned gen = old / nloc;
        if (old + 1u == (gen + 1u) * nloc) {
            __builtin_amdgcn_fence(__ATOMIC_RELEASE, "agent");
            asm volatile("s_waitcnt vmcnt(0)" ::: "memory");
            const unsigned og = xb_add(&bar[XB_TOP], 1u);
            const unsigned tg = og / nx;
            if (og + 1u == (tg + 1u) * nx) xb_add(&bar[XB_TOPGEN], 1u);
            else XB_SPIN(xb_ld(&bar[XB_TOPGEN]) == tg, bar);
            __builtin_amdgcn_fence(__ATOMIC_ACQUIRE, "agent");
            xb_add(&bar[XB_XGEN(b.x)], 1u);
            asm volatile("s_waitcnt vmcnt(0)" ::: "memory");
        } else {
            XB_SPIN(xb_ld(&bar[XB_XGEN(b.x)]) == gen, bar);
            __builtin_amdgcn_fence(__ATOMIC_ACQUIRE, "agent");
            asm volatile("s_waitcnt vmcnt(0)" ::: "memory");
        }
    }
    __syncthreads();
}

#ifndef PROBE_REP
#define PROBE_REP 0
#endif
#define REP(k) for (int rep_ = 0; rep_ < (((PROBE_REP >> (k)) & 1) ? 2 : 1); ++rep_)
constexpr int NPH = 18;
__global__ void __launch_bounds__(NTHREADS, 2) fwd_megakernel(Params p) {
    extern __shared__ __attribute__((aligned(16))) unsigned char lds[];
    cg::grid_group grid = cg::this_grid();
    LAS unsigned char* ldsl = (LAS unsigned char*)lds;
    const int lo = p.ph_lo, hi = p.ph_hi;
#ifdef ONLY_PH
#define IN(k) (((ONLY_PH >> (k)) & 1) && lo <= (k) && (k) < hi)
#else
#define IN(k) (lo <= (k) && (k) < hi)
#endif
#define SEAM(k) do { if (IN(k) && IN((k) + 1)) { if ((k) == 0) grid.sync(); else { XcdBarrier xb_; xb_.bar = (unsigned*)(p.ws + WS_BAR); xb_.x = xb_xcc_id(); xb_.st = (volatile LAS unsigned*)(ldsl + 135168); xcd_barrier(xb_); } } } while (0)
    unsigned char* ws = p.ws;
    const bf16_t* H = (const bf16_t*)(ws + WS_H);
    bf16_t* PROJ = (bf16_t*)(ws + WS_PROJ);
    const bf16_t* MIX = (const bf16_t*)(ws + WS_MIX);
    float* CTXRES = (float*)(ws + WS_CTXRES);
    const float* MOD = (const float*)(ws + WS_MOD);
    const int G = gridDim.x, c = blockIdx.x;
    if (threadIdx.x < 4) ((volatile LAS unsigned*)(ldsl + 135168))[threadIdx.x] = 0u;
    __syncthreads();
    (void)xcd_barrier_post((unsigned*)(ws + WS_BAR), (volatile LAS unsigned*)(ldsl + 135168));

    if (IN(0)) REP(0) { ada_phase(p, lds); wconv_phase(p, lds);
        { float* rc = (float*)(ws + WS_ROPE); float* rs = rc + SEQ * 32;
          for (int e = blockIdx.x * NTHREADS + threadIdx.x; e < SEQ * 32; e += gridDim.x * NTHREADS) { const int t = e >> 5, pp = e & 31;
              const float inv = powf(10000.f, -(float)(pp & 15) / 16.f); const float ang = (pp < 16 ? (float)(t >> 6) : (float)(t & 63)) * inv;
              rc[e] = cosf(ang); rs[e] = sinf(ang); } } }
    SEAM(0);
    if (IN(1)) REP(1) norm_phase(p, p.x, p.ctx, 0, 0, MTOT);
    SEAM(1);
    if (IN(2)) REP(2) { pg8::Gemm g{H, (const bf16_t*)(ws + WS_W_EVIN), MTOT, EV_NP, DM}; pg8::StaticOrderT<264, 15> S; S.init(MTOT, EV_NP, G, c);
        pg8::EpiBf16 E{PROJ, EV_NP}; pg8::gemm_phase(ldsl, g, S, E); }
    SEAM(2);
    if (IN(3)) prep0_phase(p);
    SEAM(3);
    if (IN(4)) REP(4) gdn_pre_phase(p, lds);
    SEAM(4);
    if (IN(5)) {
#ifndef SKIP_SCAN
        REP(20) { gdn_scan_phase(p, lds); __syncthreads(); }
#endif
#ifndef SKIP_DA
        REP(5) { diffattn_phase(p, lds); __syncthreads(); }
#endif
    }
    SEAM(5);
    if (IN(6)) REP(6) gdn_post_phase(p);
    SEAM(6);
    if (IN(7)) REP(7) { pg8::Gemm g{MIX, (const bf16_t*)(ws + WS_W_EVOUT), MTOT, DM, DM}; pg8::StaticOrderT<264, 4> S; S.init(MTOT, DM, G, c);
        pg8::EpiResid E{p.x, p.ctx, p.out, CTXRES, MOD, 2048}; pg8::gemm_phase(ldsl, g, S, E); }
    SEAM(7);
    if (IN(8)) norm_phase(p, p.out, CTXRES, 0, 1, MTOT);
    SEAM(8);
    if (IN(9)) REP(9) { pg8::Gemm g{H, (const bf16_t*)(ws + WS_W_FFIN), MTOT, 2 * FF, DM}; pg8::StaticOrderT<264, 22> S; S.init(MTOT, 2 * FF, G, c);
        pg8::EpiSwiglu E{PROJ, FF}; pg8::gemm_phase(ldsl, g, S, E); }
    SEAM(9);
    if (IN(10)) { pg8::Gemm g{PROJ, (const bf16_t*)(ws + WS_W_FFOUT), MTOT, DM, FF}; pg8::StaticOrderT<264, 4> S; S.init(MTOT, DM, G, c);
        pg8::EpiResid E{p.out, CTXRES, p.out, CTXRES, MOD, 5120}; pg8::gemm_phase(ldsl, g, S, E); }
    SEAM(10);
    if (IN(11)) norm_phase(p, p.out, CTXRES, 1, 0, MTOT);
    SEAM(11);
    if (IN(12)) { pg8::Gemm g{H, (const bf16_t*)(ws + WS_W_ODIN), MTOT, OD_N, DM}; pg8::StaticOrderT<264, 12> S; S.init(MTOT, OD_N, G, c);
        pg8::EpiBf16 E{PROJ, OD_N}; pg8::gemm_phase(ldsl, g, S, E); }
    SEAM(12);
    if (IN(13)) { natten_phase(p, lds); if ((PROBE_REP >> 13) & 1) { __syncthreads(); natten_phase(p, lds); } }
    SEAM(13);
    if (IN(14)) { pg8::Gemm g{MIX, (const bf16_t*)(ws + WS_W_ODOUT), NLAT, DM, DM}; pg8::StaticOrderT<256, 4> S; S.init(NLAT, DM, G, c);
        pg8::EpiResid E{p.out, CTXRES, p.out, CTXRES, MOD + 9 * 6144, 2048}; pg8::gemm_phase(ldsl, g, S, E); }
    SEAM(14);
    if (IN(15)) norm_phase(p, p.out, CTXRES, 1, 1, NLAT);
    SEAM(15);
    if (IN(16)) { pg8::Gemm g{H, (const bf16_t*)(ws + WS_W_FFIN) + (size_t)2 * FF * DM, NLAT, 2 * FF, DM}; pg8::StaticOrderT<256, 22> S; S.init(NLAT, 2 * FF, G, c);
        pg8::EpiSwiglu E{PROJ, FF}; pg8::gemm_phase(ldsl, g, S, E); }
    SEAM(16);
    if (IN(17)) { pg8::Gemm g{PROJ, (const bf16_t*)(ws + WS_W_FFOUT) + (size_t)DM * FF, NLAT, DM, FF}; pg8::StaticOrderT<256, 4> S; S.init(NLAT, DM, G, c);
        pg8::EpiResid E{p.out, CTXRES, p.out, CTXRES, MOD + 9 * 6144, 5120}; pg8::gemm_phase(ldsl, g, S, E); }
#undef IN
#undef SEAM
}

extern "C" void kernel_launch(void* const* d_in, const int* in_sizes, int n_in, void* d_out, int out_size, void* d_ws, size_t ws_size, hipStream_t stream) {
    static int grid = 0;
    if (grid == 0) {
        if (n_in != 23 || ws_size < WS_END) { fprintf(stderr, "kernel_launch: n_in %d ws %zu (need %zu)\n", n_in, ws_size, (size_t)WS_END); grid = -1; return; }
        int dev = 0, cus = 0, per_cu = 0;
        hipGetDevice(&dev); hipDeviceGetAttribute(&cus, hipDeviceAttributeMultiprocessorCount, dev);
        if (hipFuncSetAttribute((const void*)fwd_megakernel, hipFuncAttributeMaxDynamicSharedMemorySize, LDS_BYTES) != hipSuccess) { fprintf(stderr, "hipFuncSetAttribute failed\n"); grid = -1; return; }
        if (hipOccupancyMaxActiveBlocksPerMultiprocessor(&per_cu, (const void*)fwd_megakernel, NTHREADS, LDS_BYTES) != hipSuccess || per_cu < 1) per_cu = 1;
        (void)hipGetLastError();
        grid = cus * 1;
    }
    if (grid < 0) return;
    if (hipMemsetAsync((char*)d_ws + WS_BAR, 0, 16384, stream) != hipSuccess) { fprintf(stderr, "memset failed\n"); return; }
    Params p{};
    const float** pp = (const float**)&p;
    for (int i = 0; i < 23; ++i) pp[i] = (const float*)d_in[i];
    p.out = (float*)d_out; p.ws = (unsigned char*)d_ws;
#if N_LAUNCH_MODE == 1
    p.ph_lo = 0; p.ph_hi = NPH;
    void* args[] = {&p};
    hipError_t e = hipLaunchCooperativeKernel((void*)fwd_megakernel, dim3(grid), dim3(NTHREADS), args, LDS_BYTES, stream);
    if (e != hipSuccess) fprintf(stderr, "cooperative launch failed: %s (grid %d)\n", hipGetErrorString(e), grid);
#else
    for (int k = 0; k < NPH; ++k) { p.ph_lo = k; p.ph_hi = k + 1;
        hipLaunchKernelGGL(fwd_megakernel, dim3(grid), dim3(NTHREADS), LDS_BYTES, stream, p); }
#endif
}
```

```cpp
#include <hip/hip_runtime.h>
#include <hip/hip_cooperative_groups.h>
#include <cstdio>
#include <cstdint>
namespace cg = cooperative_groups;

#define LAS __attribute__((address_space(3)))
typedef unsigned short bf16_t;
typedef short bf16x8 __attribute__((ext_vector_type(8)));
typedef short s16x4 __attribute__((ext_vector_type(4)));
typedef float f32x4 __attribute__((ext_vector_type(4)));
typedef float f32x16 __attribute__((ext_vector_type(16)));
typedef unsigned u32x4 __attribute__((ext_vector_type(4)));
typedef unsigned u32x2 __attribute__((ext_vector_type(2)));

#ifndef N_LAUNCH_MODE
#define N_LAUNCH_MODE 1
#endif

constexpr int DM = 1024, NLAT = 65536, NCTX = 2048, MTOT = NLAT + NCTX, SEQ = 8192, CTXL = 256, FF = 2816;
constexpr int EV_N = 3600, EV_NP = 3840, OD_N = 3072;
constexpr int NCHUNKP = 64 * 132;
constexpr int NTHREADS = 512;
constexpr int LDS_BYTES = 135168 + 16;

constexpr size_t al256(size_t x) { return (x + 255) / 256 * 256; }
constexpr size_t WS_W_EVIN = 0;
constexpr size_t WS_W_EVOUT = WS_W_EVIN + al256((size_t)EV_NP * DM * 2);
constexpr size_t WS_W_ODIN = WS_W_EVOUT + al256((size_t)DM * DM * 2);
constexpr size_t WS_W_ODOUT = WS_W_ODIN + al256((size_t)OD_N * DM * 2);
constexpr size_t WS_W_FFIN = WS_W_ODOUT + al256((size_t)DM * DM * 2);
constexpr size_t WS_W_FFOUT = WS_W_FFIN + al256((size_t)2 * 2 * FF * DM * 2);
constexpr size_t WS_MOD = WS_W_FFOUT + al256((size_t)2 * DM * FF * 2);
constexpr size_t WS_H = WS_MOD + al256((size_t)2 * 9 * 6144 * 4);
constexpr size_t WS_PROJ = WS_H + al256((size_t)MTOT * DM * 2);
constexpr size_t WS_MIX = WS_PROJ + al256((size_t)MTOT * EV_NP * 2);
constexpr size_t WS_T = WS_MIX + al256((size_t)MTOT * DM * 2);
constexpr size_t WS_AQK = WS_T + al256((size_t)NCHUNKP * 4096 * 2);
constexpr size_t WS_GV = WS_AQK + al256((size_t)NCHUNKP * 4096 * 2);
constexpr size_t WS_BV = WS_GV + al256((size_t)NCHUNKP * 64 * 4);
constexpr size_t WS_EL = WS_BV + al256((size_t)NCHUNKP * 64 * 4);
constexpr size_t WS_GATES = WS_EL + al256((size_t)NCHUNKP * 64 * 4);
constexpr size_t WS_CTXRES = WS_GATES + al256((size_t)MTOT * 16 * 4);
constexpr size_t WS_BAR = WS_CTXRES + al256((size_t)NCTX * DM * 4);
constexpr size_t WS_ROPE = WS_BAR + 16384;
constexpr size_t WS_END = WS_ROPE + (size_t)2 * SEQ * 32 * 4;

struct Params {
    const float *x, *c, *ctx, *c_ctx, *ada_w, *ada_b, *norm_mix, *norm_ffn, *ffn_w_in, *ffn_w_out, *even_w_in, *even_w_out,
        *diff_qk_gain, *diff_lambda, *diff_subln, *gdn_conv, *gdn_a_log, *gdn_dt_bias, *gdn_norm, *odd_w_in, *odd_w_out, *na_qk_gain, *na_rpb;
    float* out; unsigned char* ws; int ph_lo, ph_hi;
};

__device__ __forceinline__ float bf2f(bf16_t b) { return __uint_as_float(((unsigned)b) << 16); }
__device__ __forceinline__ bf16_t f2bf(float f) { unsigned u = __float_as_uint(f); u += 0x7FFFu + ((u >> 16) & 1u); return (bf16_t)(u >> 16); }
__device__ __forceinline__ unsigned cvtpk(float lo, float hi) { unsigned r; asm volatile("v_cvt_pk_bf16_f32 %0, %1, %2" : "=v"(r) : "v"(lo), "v"(hi)); return r; }
__device__ __forceinline__ float siluf(float v) { return v / (1.f + __expf(-v)); }
__device__ __forceinline__ void unpack8(bf16x8 v, float* f) {
#pragma unroll
    for (int i = 0; i < 8; ++i) f[i] = bf2f((bf16_t)v[i]);
}
__device__ __forceinline__ bf16x8 pack8(const float* f) {
    u32x4 w = {cvtpk(f[0], f[1]), cvtpk(f[2], f[3]), cvtpk(f[4], f[5]), cvtpk(f[6], f[7])};
    return *reinterpret_cast<bf16x8*>(&w);
}

namespace pg8 {
constexpr int BM = 256, BK = 64, HALF = 128, HTB = HALF * BK * 2, STAGE_BYTES = 8 * HTB, NXCD = 8, WGM = 8;
__host__ __device__ __forceinline__ int lds_byte(int r, int c) { const int st = (r >> 4) * 2 + (c >> 5), rr = r & 15, cc = c & 31, ob = rr * 64 + cc * 2; return st * 1024 + (ob ^ (((ob >> 9) & 1) << 5)); }
__host__ __device__ __forceinline__ void stage_rc(int b, int& R, int& C) { const int st = b / 1024, sb = b % 1024, swz = sb ^ (((sb >> 9) & 1) << 5); R = (st >> 1) * 16 + swz / 64; C = (st & 1) * 32 + (swz % 64) / 2; }
__host__ __device__ __forceinline__ int perm32(int rho) { const int n = rho >> 4, i = rho & 15; return 8 * (i >> 2) + 4 * n + (i & 3); }
struct Unit { int pm, pn; };
struct Gemm { const bf16_t* A; const bf16_t* Bt; int M, N, K; };
template <int NM, int NN> struct StaticOrderT {
    static_assert(NM % WGM == 0, "row tiles in whole groups");
    int G, c;
    __device__ void init(int, int, int G_, int c_) { G = G_; c = c_; }
    __device__ bool next(int i, Unit& u) const {
        constexpr int nwg = NM * NN, q = nwg / NXCD, r = nwg % NXCD, nig = WGM * NN;
        const int L = i * G + c; if (L >= nwg) return false;
        const int xcd = L % NXCD, off = L / NXCD;
        const int wgid = (xcd < r ? xcd * (q + 1) : r * (q + 1) + (xcd - r) * q) + off;
        const int gid = wgid / nig, w = wgid % nig;
        u.pm = gid * WGM + (w % WGM); u.pn = w / WGM; return true;
    }
};
struct EpiBf16 {
    static constexpr bool PERM = true;
    bf16_t* O; int ldc;
    __device__ __forceinline__ void operator()(const f32x4 (&acc)[2][2][4][2], const Unit& u, int wr, int wc, int fr, int fq) const {
        const int row0 = u.pm * BM + wr * 64 + fr; const int col0 = u.pn * BM + wc * 32 + 8 * fq;
#pragma unroll
        for (int ai = 0; ai < 2; ++ai)
#pragma unroll
            for (int m = 0; m < 4; ++m) { bf16_t* rowp = O + (size_t)(row0 + ai * HALF + m * 16) * ldc + col0;
#pragma unroll
                for (int bj = 0; bj < 2; ++bj) { const f32x4 v0 = acc[ai][bj][m][0], v1 = acc[ai][bj][m][1];
                    u32x4 w; w.x = cvtpk(v0[0], v0[1]); w.y = cvtpk(v0[2], v0[3]); w.z = cvtpk(v1[0], v1[1]); w.w = cvtpk(v1[2], v1[3]);
                    *(u32x4*)(rowp + bj * HALF) = w; } }
    }
};
struct EpiSwiglu {
    static constexpr bool PERM = true;
    bf16_t* O; int ldc;
    __device__ __forceinline__ void operator()(const f32x4 (&acc)[2][2][4][2], const Unit& u, int wr, int wc, int fr, int fq) const {
        const int row0 = u.pm * BM + wr * 64 + fr; const int col0 = u.pn * HALF + wc * 32 + 8 * fq;
#pragma unroll
        for (int ai = 0; ai < 2; ++ai)
#pragma unroll
            for (int m = 0; m < 4; ++m) { bf16_t* rowp = O + (size_t)(row0 + ai * HALF + m * 16) * ldc + col0;
                typedef float f32x2v __attribute__((ext_vector_type(2)));
                unsigned wv[4];
#pragma unroll
                for (int n = 0; n < 2; ++n)
#pragma unroll
                    for (int j = 0; j < 4; j += 2) { const f32x2v g = {acc[ai][0][m][n][j], acc[ai][0][m][n][j + 1]}, up = {acc[ai][1][m][n][j], acc[ai][1][m][n][j + 1]};
                        const f32x2v t = g * (-1.4426950408889634f); f32x2v e; e.x = __builtin_amdgcn_exp2f(t.x); e.y = __builtin_amdgcn_exp2f(t.y);
                        const f32x2v d = e + 1.0f; f32x2v r; r.x = __builtin_amdgcn_rcpf(d.x); r.y = __builtin_amdgcn_rcpf(d.y);
                        const f32x2v o = (g * up) * r; wv[n * 2 + (j >> 1)] = cvtpk(o.x, o.y); }
                u32x4 w; w.x = wv[0]; w.y = wv[1]; w.z = wv[2]; w.w = wv[3];
                *(u32x4*)rowp = w; }
    }
};
struct EpiResid {
    static constexpr bool PERM = false;
    const float* resLat; const float* resCtx; float* outLat; float* outCtx; const float* modl; int goff;
    __device__ __forceinline__ void operator()(const f32x4 (&acc)[2][2][4][2], const Unit& u, int wr, int wc, int fr, int fq) const {
        const int rowt = u.pm * BM; const bool lat = rowt < NLAT;
        const float* res = lat ? resLat + (size_t)rowt * DM : resCtx + (size_t)(rowt - NLAT) * DM;
        float* out = lat ? outLat + (size_t)rowt * DM : outCtx + (size_t)(rowt - NLAT) * DM;
        const float* gate = modl + (size_t)(lat ? (rowt >> 13) : 8) * 6144 + goff;
        const int row0 = wr * 64 + fr, col0 = u.pn * BM + wc * 32 + 4 * fq;
        f32x4 gv[2][2];
#pragma unroll
        for (int bj = 0; bj < 2; ++bj)
#pragma unroll
            for (int n = 0; n < 2; ++n) gv[bj][n] = *(const f32x4*)(gate + col0 + bj * HALF + n * 16);
#pragma unroll
        for (int ai = 0; ai < 2; ++ai)
#pragma unroll
            for (int mp = 0; mp < 4; mp += 2) {
                f32x4 r[2][2][2];
#pragma unroll
                for (int mm = 0; mm < 2; ++mm)
#pragma unroll
                    for (int bj = 0; bj < 2; ++bj)
#pragma unroll
                        for (int n = 0; n < 2; ++n) r[mm][bj][n] = *(const f32x4*)(res + (size_t)(row0 + ai * HALF + (mp + mm) * 16) * DM + col0 + bj * HALF + n * 16);
#pragma unroll
                for (int mm = 0; mm < 2; ++mm)
#pragma unroll
                    for (int bj = 0; bj < 2; ++bj)
#pragma unroll
                        for (int n = 0; n < 2; ++n) *(f32x4*)(out + (size_t)(row0 + ai * HALF + (mp + mm) * 16) * DM + col0 + bj * HALF + n * 16) = r[mm][bj][n] + gv[bj][n] * acc[ai][bj][mp + mm][n];
            }
    }
};

template <class Epi, class Sched>
__device__ __forceinline__ void gemm_phase(LAS unsigned char* lds, const Gemm g, const Sched& S, const Epi& E) {
    const int tid = threadIdx.x, wid = __builtin_amdgcn_readfirstlane(tid >> 6), lane = tid & 63, wr = wid >> 2, wc = wid & 3, fr = lane & 15, fq = lane >> 4;
    const int K = g.K, nt = K / BK;
    unsigned voffA[2], voffB[2];
#pragma unroll
    for (int i = 0; i < 2; ++i) { int R, C; stage_rc(tid * 16 + i * 8192, R, C); const int Rb = Epi::PERM ? ((R & ~31) + perm32(R & 31)) : R;
        voffA[i] = (unsigned)(R * K + C) * 2u; voffB[i] = (unsigned)(Rb * K + C) * 2u; }
    const size_t kstep = (size_t)(BK * 2);
    const size_t hstep = (size_t)HALF * K * 2;
    const size_t tstep = 2 * hstep;
    const unsigned ldsw = (unsigned)wid * 1024u;
    const int aoff = lds_byte(wr * 64 + fr, fq * 8), boff = lds_byte(wc * 32 + fr, fq * 8);
#define PG8_SA(b, h) (((b) * 2 + (h)) * HTB)
#define PG8_SB(b, h) ((4 + (b) * 2 + (h)) * HTB)
#define PG8_STAGE(bufoff, gbase, voff) do { _Pragma("unroll") for (int _i = 0; _i < 2; ++_i) \
        __builtin_amdgcn_global_load_lds((const unsigned*)((const char*)(gbase) + (voff)[_i]), (LAS unsigned*)(lds + (bufoff) + ldsw + _i * 8192), 16, 0, 0); } while (0)
#define PG8_LDA(dst, b, h) do { _Pragma("unroll") for (int m = 0; m < 4; ++m) _Pragma("unroll") for (int k = 0; k < 2; ++k) dst[m][k] = *(const LAS bf16x8*)(lds + PG8_SA(b, h) + aoff + m * 2048 + k * 1024); } while (0)
#define PG8_LDB(dst, b, h) do { _Pragma("unroll") for (int n = 0; n < 2; ++n) _Pragma("unroll") for (int k = 0; k < 2; ++k) dst[n][k] = *(const LAS bf16x8*)(lds + PG8_SB(b, h) + boff + n * 2048 + k * 1024); } while (0)
#define PG8_MMA(ai, bj, At, Bt) do { __builtin_amdgcn_s_setprio(1); _Pragma("unroll") for (int m = 0; m < 4; ++m) _Pragma("unroll") for (int n = 0; n < 2; ++n) _Pragma("unroll") for (int k = 0; k < 2; ++k) \
        acc[ai][bj][m][n] = __builtin_amdgcn_mfma_f32_16x16x32_bf16(Bt[n][k], At[m][k], acc[ai][bj][m][n], 0, 0, 0); __builtin_amdgcn_s_setprio(0); } while (0)
#define PG8_WAIT_V(n) asm volatile("s_waitcnt vmcnt(" #n ")" ::: "memory")
#define PG8_WAIT_L(n) asm volatile("s_waitcnt lgkmcnt(" #n ")" ::: "memory")
#define PG8_BAR __builtin_amdgcn_s_barrier()
#define PG8_SCHED __builtin_amdgcn_sched_barrier(0)
    Unit cur, nxt; int ui = 0;
    if (!S.next(0, cur)) return;
    f32x4 acc[2][2][4][2];
#pragma unroll
    for (int a = 0; a < 2; ++a)
#pragma unroll
        for (int b = 0; b < 2; ++b)
#pragma unroll
            for (int m = 0; m < 4; ++m)
#pragma unroll
                for (int n = 0; n < 2; ++n) acc[a][b][m][n] = (f32x4){0.f, 0.f, 0.f, 0.f};
    bf16x8 At[4][2], B0[2][2], B1[2][2];
    const char* cA = (const char*)g.A + (size_t)cur.pm * tstep; const char* cB = (const char*)g.Bt + (size_t)cur.pn * tstep;
    PG8_STAGE(PG8_SB(0, 0), cB, voffB); PG8_STAGE(PG8_SA(0, 0), cA, voffA); PG8_STAGE(PG8_SB(0, 1), cB + hstep, voffB); PG8_STAGE(PG8_SA(0, 1), cA + hstep, voffA);
    if (wr == 1) PG8_BAR;
    PG8_WAIT_V(4); PG8_BAR;
    PG8_STAGE(PG8_SB(1, 0), cB + kstep, voffB); PG8_STAGE(PG8_SA(1, 0), cA + kstep, voffA); PG8_STAGE(PG8_SB(1, 1), cB + hstep + kstep, voffB);
    PG8_WAIT_V(6); PG8_BAR;
    for (;;) {
        const bool has_next = S.next(ui + 1, nxt);
        const char* nA = has_next ? (const char*)g.A + (size_t)nxt.pm * tstep : cA; const char* nB = has_next ? (const char*)g.Bt + (size_t)nxt.pn * tstep : cB;
        for (int t = 0; t < nt; t += 2) {
            const bool last = (t == nt - 2);
            const char* a1 = cA + (size_t)(t + 1) * kstep;
            const char* a2 = last ? nA : cA + (size_t)(t + 2) * kstep; const char* b2 = last ? nB : cB + (size_t)(t + 2) * kstep;
            const char* a3 = a2 + kstep; const char* b3 = b2 + kstep;
            PG8_LDB(B0, 0, 0); PG8_SCHED; PG8_LDA(At, 0, 0); PG8_STAGE(PG8_SA(1, 1), a1 + hstep, voffA);
            PG8_WAIT_L(8); PG8_BAR; PG8_WAIT_L(0); PG8_MMA(0, 0, At, B0); PG8_BAR; PG8_SCHED;
            PG8_LDB(B1, 0, 1); PG8_STAGE(PG8_SB(0, 0), b2, voffB);
            PG8_BAR; PG8_WAIT_L(0); PG8_MMA(0, 1, At, B1); PG8_BAR;
            PG8_LDA(At, 0, 1); PG8_STAGE(PG8_SA(0, 0), a2, voffA);
            PG8_BAR; PG8_WAIT_L(0); PG8_MMA(1, 0, At, B0); PG8_BAR; PG8_SCHED;
            PG8_STAGE(PG8_SB(0, 1), b2 + hstep, voffB);
            PG8_WAIT_V(6); PG8_BAR; PG8_MMA(1, 1, At, B1); PG8_BAR;
            PG8_LDB(B0, 1, 0); PG8_SCHED; PG8_LDA(At, 1, 0); PG8_STAGE(PG8_SA(0, 1), a2 + hstep, voffA);
            PG8_WAIT_L(8); PG8_BAR; PG8_WAIT_L(0); PG8_MMA(0, 0, At, B0); PG8_BAR; PG8_SCHED;
            PG8_LDB(B1, 1, 1); PG8_STAGE(PG8_SB(1, 0), b3, voffB);
            PG8_BAR; PG8_WAIT_L(0); PG8_MMA(0, 1, At, B1); PG8_BAR;
            PG8_LDA(At, 1, 1); PG8_STAGE(PG8_SA(1, 0), a3, voffA);
            PG8_BAR; PG8_WAIT_L(0); PG8_MMA(1, 0, At, B0); PG8_BAR; PG8_SCHED;
            PG8_STAGE(PG8_SB(1, 1), b3 + hstep, voffB);
            PG8_WAIT_V(6); PG8_BAR; PG8_MMA(1, 1, At, B1); PG8_BAR;
        }
        E(acc, cur, wr, wc, fr, fq);
        if (!has_next) break;
#pragma unroll
        for (int a = 0; a < 2; ++a)
#pragma unroll
            for (int b = 0; b < 2; ++b)
#pragma unroll
                for (int m = 0; m < 4; ++m)
#pragma unroll
                    for (int n = 0; n < 2; ++n) acc[a][b][m][n] = (f32x4){0.f, 0.f, 0.f, 0.f};
        cur = nxt; cA = nA; cB = nB; ++ui;
    }
    PG8_WAIT_V(0);
    if (wr == 0) PG8_BAR;
    PG8_BAR;
#undef PG8_SA
#undef PG8_SB
#undef PG8_STAGE
#undef PG8_LDA
#undef PG8_LDB
#undef PG8_MMA
#undef PG8_WAIT_V
#undef PG8_WAIT_L
#undef PG8_BAR
#undef PG8_SCHED
}
}

#define KSWZ(row, colB) ((row) * 256 + ((colB) ^ (((row) & 7) << 4)))
#define SBAR() __builtin_amdgcn_sched_barrier(0)
__device__ __forceinline__ int crow(int r, int hi) { return (r & 3) + 8 * (r >> 2) + 4 * hi; }
__device__ __forceinline__ int v_st(int k, int c) { const int kk = (k & ~0xC) | ((k & 4) << 1) | ((k & 8) >> 1); return ((kk >> 3) * 4 + (c >> 5)) * 512 + ((kk & 7) * 32 + (c & 31)) * 2; }
__device__ __forceinline__ int v_rd_base(int lane) { return ((lane & 3) << 3) | (((lane >> 2) & 3) << 6) | (((lane >> 4) & 1) << 5) | (((lane >> 5) & 1) << 8); }
constexpr int v_rd_off(int d0, int ks, int half) { return d0 * 512 + ks * 4096 + half * 2048; }
template <int OFF> __device__ __forceinline__ s16x4 tr_read(int vb) {
    s16x4 r; asm volatile("ds_read_b64_tr_b16 %0, %1 offset:%2" : "=&v"(r) : "v"(vb), "i"(OFF) : "memory"); return r;
}
template <int D0> __device__ __forceinline__ void pv_one(f32x16& od, int vb, bf16x8 pa0, bf16x8 pa1, bf16x8 pa2, bf16x8 pa3) {
    const s16x4 l0 = tr_read<v_rd_off(D0, 0, 0)>(vb), h0 = tr_read<v_rd_off(D0, 0, 1)>(vb), l1 = tr_read<v_rd_off(D0, 1, 0)>(vb), h1 = tr_read<v_rd_off(D0, 1, 1)>(vb);
    const s16x4 l2 = tr_read<v_rd_off(D0, 2, 0)>(vb), h2 = tr_read<v_rd_off(D0, 2, 1)>(vb), l3 = tr_read<v_rd_off(D0, 3, 0)>(vb), h3 = tr_read<v_rd_off(D0, 3, 1)>(vb);
    asm volatile("s_waitcnt lgkmcnt(0)" ::: "memory"); SBAR();
#define PK(L, H) (bf16x8){L[0], L[1], L[2], L[3], H[0], H[1], H[2], H[3]}
    od = __builtin_amdgcn_mfma_f32_32x32x16_bf16(pa0, PK(l0, h0), od, 0, 0, 0);
    od = __builtin_amdgcn_mfma_f32_32x32x16_bf16(pa1, PK(l1, h1), od, 0, 0, 0);
    od = __builtin_amdgcn_mfma_f32_32x32x16_bf16(pa2, PK(l2, h2), od, 0, 0, 0);
    od = __builtin_amdgcn_mfma_f32_32x32x16_bf16(pa3, PK(l3, h3), od, 0, 0, 0);
#undef PK
}
__device__ __forceinline__ void pv_d0(f32x16* o, int vb, bf16x8 pa0, bf16x8 pa1, bf16x8 pa2, bf16x8 pa3) {
    pv_one<0>(o[0], vb, pa0, pa1, pa2, pa3); pv_one<1>(o[1], vb, pa0, pa1, pa2, pa3); pv_one<2>(o[2], vb, pa0, pa1, pa2, pa3); pv_one<3>(o[3], vb, pa0, pa1, pa2, pa3);
}
#define PK4(P, BASE, OUT) do { unsigned a0 = cvtpk(P[BASE + 0], P[BASE + 1]), a1 = cvtpk(P[BASE + 2], P[BASE + 3]);   \
    unsigned b0 = cvtpk(P[BASE + 4], P[BASE + 5]), b1 = cvtpk(P[BASE + 6], P[BASE + 7]);                              \
    auto r0 = __builtin_amdgcn_permlane32_swap(a0, b0, false, false); auto r1 = __builtin_amdgcn_permlane32_swap(a1, b1, false, false); \
    u32x4 w = {r0[0], r1[0], r0[1], r1[1]}; OUT = *reinterpret_cast<bf16x8*>(&w); } while (0)
__device__ __forceinline__ float halfswap_add(float v) {
    auto rr = __builtin_amdgcn_permlane32_swap(__float_as_uint(v), __float_as_uint(v), false, false);
    return __uint_as_float(rr[0]) + __uint_as_float(rr[1]);
}

__device__ __forceinline__ void ada_phase(const Params& p, unsigned char* lds) {
    float* sc = (float*)lds;
    float* red = (float*)(lds + 40960);
    float* mod = (float*)(p.ws + WS_MOD);
    const int tid = threadIdx.x;
    for (int j = blockIdx.x; j < 192; j += gridDim.x) {
        const int l = j / 96, n0 = (j % 96) * 64;
        for (int i = tid; i < 9 * 1024; i += NTHREADS) { const int r = i >> 10, k = i & 1023; const float v = r < 8 ? p.c[r * 1024 + k] : p.c_ctx[k]; sc[i] = v / (1.f + expf(-v)); }
        __syncthreads();
        const int col = tid & 63, ks = tid >> 6;
        float acc[9];
#pragma unroll
        for (int r = 0; r < 9; ++r) acc[r] = 0.f;
        const float* wp = p.ada_w + ((size_t)l * 1024 + ks * 128) * 6144 + n0 + col;
#pragma unroll 8
        for (int kk = 0; kk < 128; ++kk) { const float w = wp[(size_t)kk * 6144];
#pragma unroll
            for (int r = 0; r < 9; ++r) acc[r] += sc[r * 1024 + ks * 128 + kk] * w; }
#pragma unroll
        for (int r = 0; r < 9; ++r) red[(ks * 9 + r) * 64 + col] = acc[r];
        __syncthreads();
        for (int i = tid; i < 576; i += NTHREADS) { const int r = i >> 6, cc = i & 63; float s = p.ada_b[l * 6144 + n0 + cc];
            for (int k2 = 0; k2 < 8; ++k2) s += red[(k2 * 9 + r) * 64 + cc];
            mod[(size_t)(l * 9 + r) * 6144 + n0 + cc] = s; }
        __syncthreads();
    }
}
__device__ __forceinline__ void wconv_phase(const Params& p, unsigned char* lds) {
    float* tl = (float*)lds;
    const int tid = threadIdx.x;
    const int T0 = 16 * 60, T1 = T0 + 16 * 16, T2 = T1 + 16 * 48, T3 = T2 + 16 * 16, T4 = T3 + 16 * 88, T5 = T4 + 16 * 88, T6 = T5 + 44 * 16, T7 = T6 + 44 * 16;
#define WC_DECODE(t) \
        const float* src; bf16_t* dst; int K, N, NP, mode = 0, tt; \
        if ((t) < T0) { src = p.even_w_in; dst = (bf16_t*)(p.ws + WS_W_EVIN); K = 1024; N = EV_N; NP = EV_NP; tt = (t); } \
        else if ((t) < T1) { src = p.even_w_out; dst = (bf16_t*)(p.ws + WS_W_EVOUT); K = 1024; N = 1024; NP = 1024; tt = (t) - T0; } \
        else if ((t) < T2) { src = p.odd_w_in; dst = (bf16_t*)(p.ws + WS_W_ODIN); K = 1024; N = OD_N; NP = OD_N; tt = (t) - T1; } \
        else if ((t) < T3) { src = p.odd_w_out; dst = (bf16_t*)(p.ws + WS_W_ODOUT); K = 1024; N = 1024; NP = 1024; tt = (t) - T2; } \
        else if ((t) < T4) { src = p.ffn_w_in; dst = (bf16_t*)(p.ws + WS_W_FFIN); K = 1024; N = 2 * FF; NP = 2 * FF; mode = 1; tt = (t) - T3; } \
        else if ((t) < T5) { src = p.ffn_w_in + (size_t)1024 * 2 * FF; dst = (bf16_t*)(p.ws + WS_W_FFIN) + (size_t)2 * FF * 1024; K = 1024; N = 2 * FF; NP = 2 * FF; mode = 1; tt = (t) - T4; } \
        else if ((t) < T6) { src = p.ffn_w_out; dst = (bf16_t*)(p.ws + WS_W_FFOUT); K = FF; N = 1024; NP = 1024; tt = (t) - T5; } \
        else { src = p.ffn_w_out + (size_t)FF * 1024; dst = (bf16_t*)(p.ws + WS_W_FFOUT) + (size_t)1024 * FF; K = FF; N = 1024; NP = 1024; tt = (t) - T6; } \
        const int nnt = NP / 64; const int k0 = (tt / nnt) * 64, n0 = (tt % nnt) * 64; \
        int sn0; if (mode == 1) { const int tb = n0 >> 8, bj = (n0 >> 7) & 1, i0 = n0 & 127; sn0 = bj * FF + tb * 128 + i0; } else sn0 = n0;
    float rg[8];
#define WC_LOAD(t) do { WC_DECODE(t) (void)dst; _Pragma("unroll") for (int i = 0; i < 8; ++i) { const int e = tid + NTHREADS * i, kk = e >> 6, nn = e & 63; const int sn = sn0 + nn; \
        rg[i] = (sn < N) ? src[(size_t)(k0 + kk) * N + sn] : 0.f; } } while (0)
    int t = blockIdx.x;
    if (t < T7) WC_LOAD(t);
    for (; t < T7; t += gridDim.x) {
#pragma unroll
        for (int i = 0; i < 8; ++i) { const int e = tid + NTHREADS * i; tl[(e >> 6) * 65 + (e & 63)] = rg[i]; }
        __syncthreads();
        { WC_DECODE(t) (void)src; (void)N; (void)sn0;
          if (t + (int)gridDim.x < T7) WC_LOAD(t + (int)gridDim.x);
          for (int e = tid; e < 2048; e += NTHREADS) { const int nn = e >> 5, k2 = (e & 31) * 2;
              *(unsigned*)(dst + (size_t)(n0 + nn) * K + k0 + k2) = cvtpk(tl[k2 * 65 + nn], tl[(k2 + 1) * 65 + nn]); } }
        __syncthreads();
    }
#undef WC_DECODE
#undef WC_LOAD
}

__device__ __forceinline__ void norm_phase(const Params& p, const float* xlat, const float* xctx, int l, int which, int nrows) {
    const int lane = threadIdx.x & 63, wid = threadIdx.x >> 6;
    bf16_t* h = (bf16_t*)(p.ws + WS_H);
    const float* mod = (const float*)(p.ws + WS_MOD) + (size_t)l * 9 * 6144;
    const float* gain = (which ? p.norm_ffn : p.norm_mix) + l * 1024;
    const int shoff = which ? 3072 : 0, scoff = which ? 4096 : 1024;
    const int stride = gridDim.x * 8;
    f32x4 gn[4];
#pragma unroll
    for (int i = 0; i < 4; ++i) gn[i] = *(const f32x4*)(gain + lane * 4 + 256 * i);
    for (int row = blockIdx.x * 8 + wid; row < nrows; row += 2 * stride) {
        const int rowB = row + stride; const bool hasB = rowB < nrows; const int rB = hasB ? rowB : row;
        const float* srcA = row < NLAT ? xlat + (size_t)row * DM : xctx + (size_t)(row - NLAT) * DM;
        const float* srcB = rB < NLAT ? xlat + (size_t)rB * DM : xctx + (size_t)(rB - NLAT) * DM;
        const float* mrA = mod + (size_t)(row < NLAT ? (row >> 13) : 8) * 6144;
        const float* mrB = mod + (size_t)(rB < NLAT ? (rB >> 13) : 8) * 6144;
        f32x4 va[4], vb[4], sa[4], ha[4], sb[4], hb[4];
#pragma unroll
        for (int i = 0; i < 4; ++i) { const int c0 = lane * 4 + 256 * i;
            va[i] = *(const f32x4*)(srcA + c0); vb[i] = *(const f32x4*)(srcB + c0);
            sa[i] = *(const f32x4*)(mrA + scoff + c0); ha[i] = *(const f32x4*)(mrA + shoff + c0);
            sb[i] = *(const f32x4*)(mrB + scoff + c0); hb[i] = *(const f32x4*)(mrB + shoff + c0); }
#pragma unroll
        for (int rr = 0; rr < 2; ++rr) {
            if (rr == 1 && !hasB) break;
            const int r = rr ? rowB : row;
            float ss = 0.f;
#pragma unroll
            for (int i = 0; i < 4; ++i) { const f32x4 v = rr ? vb[i] : va[i]; ss += v[0] * v[0] + v[1] * v[1] + v[2] * v[2] + v[3] * v[3]; }
#pragma unroll
            for (int o = 1; o < 64; o <<= 1) ss += __shfl_xor(ss, o);
            const float rstd = rsqrtf(ss * (1.f / 1024.f) + 1e-6f);
#pragma unroll
            for (int i = 0; i < 4; ++i) { const int c0 = lane * 4 + 256 * i; const f32x4 v = rr ? vb[i] : va[i], s1 = rr ? sb[i] : sa[i], sh = rr ? hb[i] : ha[i];
                float y[4];
#pragma unroll
                for (int j = 0; j < 4; ++j) y[j] = v[j] * rstd * gn[i][j] * (1.f + s1[j]) + sh[j];
                u32x2 w; w.x = cvtpk(y[0], y[1]); w.y = cvtpk(y[2], y[3]);
                *(u32x2*)(h + (size_t)r * DM + c0) = w; }
        }
    }
}

template <int RB>
__device__ __forceinline__ void prep0_block(const Params& p, const int row0, const int lane0) {
    bf16_t* proj = (bf16_t*)(p.ws + WS_PROJ);
    bf16_t* qkvp = (bf16_t*)p.out;
    float* gbuf = (float*)(p.ws + WS_GATES);
    const float* ropec = (const float*)(p.ws + WS_ROPE); const float* ropes = ropec + SEQ * 32;
    {
        int lane = lane0; asm volatile("" : "+v"(lane));
        const bool lat = row0 < NLAT; const int t0 = lat ? (row0 & 8191) : ((row0 - NLAT) & 255); const int len = lat ? SEQ : CTXL;
        const int dsub = (lane & 7) * 8;
        {
            float gq[8], gk[8];
#pragma unroll
            for (int i = 0; i < 8; ++i) { gq[i] = p.diff_qk_gain[dsub + i] * (0.125f * 1.4426950408889634f); gk[i] = p.diff_qk_gain[64 + dsub + i]; }
            constexpr int DB = RB < 4 ? RB : 4;
#pragma unroll
            for (int i0 = 0; i0 < RB; i0 += DB) {
                bf16x8 raw[DB][2]; f32x4 c4[DB], s4[DB];
#pragma unroll
                for (int i = 0; i < DB; ++i) { const bf16_t* P = proj + (size_t)(row0 + i0 + i) * EV_NP;
                    raw[i][0] = *(const bf16x8*)(P + lane * 8); raw[i][1] = *(const bf16x8*)(P + 512 + lane * 8);
                    c4[i] = (f32x4){1.f, 1.f, 1.f, 1.f}; s4[i] = (f32x4){0.f, 0.f, 0.f, 0.f};
                    if (lat) { c4[i] = *(const f32x4*)(ropec + (t0 + i0 + i) * 32 + (lane & 7) * 4); s4[i] = *(const f32x4*)(ropes + (t0 + i0 + i) * 32 + (lane & 7) * 4); } }
#pragma unroll
                for (int i = 0; i < DB; ++i) { bf16_t* P = proj + (size_t)(row0 + i0 + i) * EV_NP;
#pragma unroll
                    for (int which = 0; which < 2; ++which) {
                        float v[8]; unpack8(raw[i][which], v);
                        float ss = 0.f;
#pragma unroll
                        for (int e = 0; e < 8; ++e) ss += v[e] * v[e];
                        ss += __shfl_xor(ss, 1); ss += __shfl_xor(ss, 2); ss += __shfl_xor(ss, 4);
                        const float rstd = rsqrtf(ss * (1.f / 64.f) + 1e-6f);
#pragma unroll
                        for (int e = 0; e < 8; ++e) v[e] = v[e] * rstd * (which ? gk[e] : gq[e]);
#pragma unroll
                        for (int e = 0; e < 4; ++e) { const float x0 = v[2 * e], x1 = v[2 * e + 1]; v[2 * e] = x0 * c4[i][e] - x1 * s4[i][e]; v[2 * e + 1] = x0 * s4[i][e] + x1 * c4[i][e]; }
                        *(bf16x8*)(P + which * 512 + lane * 8) = pack8(v);
                    } }
            }
        }
#pragma unroll 1
        for (int g = 0; g < 3; ++g) {
            const int c0 = g * 512 + lane * 8;
            float w[5][8];
#pragma unroll
            for (int j = 0; j < 5; ++j) { const f32x4 w0 = *(const f32x4*)(p.gdn_conv + j * 1536 + c0), w1 = *(const f32x4*)(p.gdn_conv + j * 1536 + c0 + 4);
#pragma unroll
                for (int e = 0; e < 4; ++e) { w[j][e] = w0[e]; w[j][4 + e] = w1[e]; } }
            const bf16_t* src = proj + (size_t)row0 * EV_NP + 1536 + c0;
            bf16x8 raw[RB + 4];
#pragma unroll
            for (int k = 0; k < RB + 4; ++k) { const int dt = k - 2; raw[k] = (bf16x8){0, 0, 0, 0, 0, 0, 0, 0};
                if (t0 + dt >= 0 && t0 + dt < len) raw[k] = *(const bf16x8*)(src + (ptrdiff_t)dt * EV_NP); }
            const float nsc = g == 0 ? 0.08838834764831845f : 1.f;
#pragma unroll
            for (int i = 0; i < RB; ++i) {
                float xm2[8], xm1[8], x0[8], xp1[8], xp2[8];
                unpack8(raw[i], xm2); unpack8(raw[i + 1], xm1); unpack8(raw[i + 2], x0); unpack8(raw[i + 3], xp1); unpack8(raw[i + 4], xp2);
                float y[8];
#pragma unroll
                for (int e = 0; e < 8; ++e) { y[e] = w[0][e] * xm2[e] + w[1][e] * xm1[e] + w[2][e] * x0[e] + w[3][e] * xp1[e] + w[4][e] * xp2[e]; y[e] = y[e] * __builtin_amdgcn_rcpf(1.f + __expf(-y[e])); }
                if (g < 2) { float ss = 0.f;
#pragma unroll
                    for (int e = 0; e < 8; ++e) ss += y[e] * y[e];
                    ss += __shfl_xor(ss, 1); ss += __shfl_xor(ss, 2); ss += __shfl_xor(ss, 4); ss += __shfl_xor(ss, 8);
                    const float sc_ = rsqrtf(ss + 1e-6f) * nsc;
#pragma unroll
                    for (int e = 0; e < 8; ++e) y[e] *= sc_; }
                *(bf16x8*)(qkvp + (size_t)(row0 + i) * 1536 + c0) = pack8(y);
            }
        }
#pragma unroll
        for (int k = 0; k < (RB * 16 + 63) / 64; ++k) { const int idx = lane + 64 * k, i = idx >> 4, gi = idx & 15; if (idx >= RB * 16) break;
            const float gvv = bf2f(proj[(size_t)(row0 + i) * EV_NP + 3584 + gi]); float o;
            if (gi < 8) o = 1.f / (1.f + expf(-gvv));
            else { const float z = gvv + p.gdn_dt_bias[gi - 8]; const float sp = z > 20.f ? z : log1pf(expf(z)); o = -expf(p.gdn_a_log[gi - 8]) * sp; }
            gbuf[(size_t)(row0 + i) * 16 + gi] = o; }
    }
}
__device__ __forceinline__ void prep0_phase(const Params& p) {
    const int lane0 = threadIdx.x & 63, wid = threadIdx.x >> 6;
    for (int blk = blockIdx.x * 8 + wid; blk < NLAT / 8; blk += gridDim.x * 8) prep0_block<8>(p, blk * 8, lane0);
    for (int r = blockIdx.x * 8 + wid; r < NCTX; r += gridDim.x * 8) prep0_block<1>(p, NLAT + r, lane0);
}

__device__ __forceinline__ int gdn_row(int b, int pc, int tau, int dir) {
    const int tt = dir ? 63 - tau : tau;
    return pc < 4 ? NLAT + b * CTXL + pc * 64 + tt : b * SEQ + (pc - 4) * 64 + tt;
}
__device__ __forceinline__ void gdn_pre_phase(const Params& p, unsigned char* lds) {
    const int lane = threadIdx.x & 63, wid = threadIdx.x >> 6;
    float* Lw = (float*)(lds + wid * 16896);
    float* gs = Lw + 4096; float* bs = gs + 64;
    const bf16_t* qkvp = (const bf16_t*)p.out;
    const float* gbuf = (const float*)(p.ws + WS_GATES);
    bf16_t* Tb = (bf16_t*)(p.ws + WS_T); bf16_t* Ab = (bf16_t*)(p.ws + WS_AQK);
    float* gv = (float*)(p.ws + WS_GV); float* bv = (float*)(p.ws + WS_BV);
    const int lane0 = lane;
    for (int cp = blockIdx.x * 8 + wid; cp < NCHUNKP; cp += gridDim.x * 8) {
        int lane = lane0; asm volatile("" : "+v"(lane));
        const int r32 = lane & 31, hi = lane >> 5;
        const int pc = cp % 132, ch = cp / 132, dir = ch & 1, h = (ch >> 1) & 3, b = ch >> 3;
        float g_keep, be_keep;
        { const int R = gdn_row(b, pc, lane, dir);
          float g = gbuf[(size_t)R * 16 + 8 + dir * 4 + h]; const float be = gbuf[(size_t)R * 16 + dir * 4 + h];
#pragma unroll
          for (int o = 1; o < 64; o <<= 1) { const float t = __shfl_up(g, o); if (lane >= o) g += t; }
          gs[lane] = g; bs[lane] = be; g_keep = g; be_keep = be; }
        bf16x8 kf[2][8], qf[2][8];
#pragma unroll
        for (int mi = 0; mi < 2; ++mi) { const size_t R = (size_t)gdn_row(b, pc, 32 * mi + r32, dir);
#pragma unroll
            for (int d0 = 0; d0 < 8; ++d0) { kf[mi][d0] = *(const bf16x8*)(qkvp + R * 1536 + 512 + h * 128 + d0 * 16 + hi * 8);
                                             qf[mi][d0] = *(const bf16x8*)(qkvp + R * 1536 + h * 128 + d0 * 16 + hi * 8); } }
        { const float gl_ = __shfl(g_keep, 63); gv[(size_t)cp * 64 + lane] = expf(g_keep); bv[(size_t)cp * 64 + lane] = be_keep; ((float*)(p.ws + WS_EL))[(size_t)cp * 64 + lane] = expf(gl_ - g_keep); }
        bf16_t* Ao = Ab + (size_t)cp * 4096;
#pragma unroll
        for (int mi = 0; mi < 2; ++mi) {
#pragma unroll
            for (int ni = 0; ni <= mi; ++ni) {
                f32x16 ckk = {}, cqk = {};
#pragma unroll
                for (int d0 = 0; d0 < 8; ++d0) { ckk = __builtin_amdgcn_mfma_f32_32x32x16_bf16(kf[mi][d0], kf[ni][d0], ckk, 0, 0, 0);
                                                 cqk = __builtin_amdgcn_mfma_f32_32x32x16_bf16(qf[mi][d0], kf[ni][d0], cqk, 0, 0, 0); }
                const int sg = 32 * ni + r32; const float gsg = gs[sg];
#pragma unroll
                for (int r = 0; r < 16; ++r) { const int tau = 32 * mi + crow(r, hi);
                    const float dec = tau >= sg ? __expf(gs[tau] - gsg) : 0.f;
                    Lw[tau * 64 + sg] = tau > sg ? bs[tau] * dec * ckk[r] : 0.f;
                    Ao[tau * 64 + sg] = f2bf(cqk[r] * dec); }
                asm volatile("" ::: "memory");
            }
        }
#pragma unroll
        for (int r = 0; r < 16; ++r) Ao[crow(r, hi) * 64 + 32 + r32] = 0;
        float Tc[64];
#pragma unroll
        for (int i = 0; i < 64; ++i) { float a = (i == lane) ? 1.f : 0.f;
#pragma unroll
            for (int j = 0; j < i; ++j) a -= Lw[i * 64 + j] * Tc[j];
            Tc[i] = a; asm volatile("" ::: "memory"); }
        bf16_t* To = Tb + (size_t)cp * 4096;
#pragma unroll
        for (int i = 0; i < 64; ++i) To[i * 64 + lane] = f2bf(Tc[i]);
    }
}

constexpr int G_KV = 0, G_QA = 16384, G_TT = 32768, G_AQ = G_TT + 9216, G_RT = G_AQ + 9216, G_UT = G_RT + 4608, G_UP = G_UT + 4608,
              G_ST = G_UP + 4608, G_VS = G_ST + 8704, G_GS = G_VS + 4096, G_BS = G_GS + 256, G_EL = G_BS + 256, G_END = G_EL + 256;
__device__ __forceinline__ void gdn_scan_phase(const Params& p, unsigned char* lds) {
    const int tid = threadIdx.x, lane0 = tid & 63, wid = tid >> 6;
    const bf16_t* qkvp = (const bf16_t*)p.out;
    const bf16_t* Tb = (const bf16_t*)(p.ws + WS_T); const bf16_t* Ab = (const bf16_t*)(p.ws + WS_AQK);
    const float* gv = (const float*)(p.ws + WS_GV); const float* bv = (const float*)(p.ws + WS_BV);
    bf16_t* obuf = (bf16_t*)(p.ws + WS_H);
    const float* gsl = (const float*)(lds + G_GS); const float* bsl = (const float*)(lds + G_BS); const float* esl = (const float*)(lds + G_EL);
    const int sr = tid >> 4, sc = (tid & 15) * 8;
    const int vblk = (gridDim.x % 8 == 0) ? (int)((blockIdx.x & 7) * (gridDim.x >> 3) + (blockIdx.x >> 3)) : (int)blockIdx.x;
    for (int wi = vblk; wi < 256; wi += gridDim.x) {
        const int chain = wi >> 2, cs = wi & 3, b = chain >> 3, h = (chain >> 1) & 3, dir = chain & 1;
        f32x16 Sacc = {};
        for (int i = tid; i < 8704 / 4; i += NTHREADS) ((unsigned*)(lds + G_ST))[i] = 0u;
        bf16x8 sk0, sk1, sq0, sq1, sT, sA, sV; float sg = 0.f;
#define GLOAD(step) do { const int pc_ = dir == 0 ? (step) : ((step) < 4 ? 3 - (step) : 4 + 127 - ((step) - 4)); \
        const size_t cp_ = (size_t)chain * 132 + pc_; \
        const size_t R0_ = (size_t)gdn_row(b, pc_, sr, dir), R1_ = (size_t)gdn_row(b, pc_, 32 + sr, dir); \
        sk0 = *(const bf16x8*)(qkvp + R0_ * 1536 + 512 + h * 128 + sc); sk1 = *(const bf16x8*)(qkvp + R1_ * 1536 + 512 + h * 128 + sc); \
        sq0 = *(const bf16x8*)(qkvp + R0_ * 1536 + h * 128 + sc); sq1 = *(const bf16x8*)(qkvp + R1_ * 1536 + h * 128 + sc); \
        sT = *(const bf16x8*)(Tb + cp_ * 4096 + tid * 8); sA = *(const bf16x8*)(Ab + cp_ * 4096 + tid * 8); \
        if (tid < 256) { const size_t Rv_ = (size_t)gdn_row(b, pc_, tid >> 2, dir); sV = *(const bf16x8*)(qkvp + Rv_ * 1536 + 1024 + h * 128 + cs * 32 + (tid & 3) * 8); } \
        if (tid < 64) sg = gv[cp_ * 64 + tid]; else if (tid < 128) sg = bv[cp_ * 64 + tid - 64]; else if (tid < 192) sg = ((const float*)(p.ws + WS_EL))[cp_ * 64 + tid - 128]; } while (0)
#define GWRITE() do { *(bf16x8*)(lds + G_KV + v_st(sr, sc)) = sk0; *(bf16x8*)(lds + G_KV + v_st(32 + sr, sc)) = sk1; \
        *(bf16x8*)(lds + G_QA + KSWZ(sr, sc * 2)) = sq0; *(bf16x8*)(lds + G_QA + KSWZ(32 + sr, sc * 2)) = sq1; \
        *(bf16x8*)(lds + G_TT + (tid >> 3) * 144 + (tid & 7) * 16) = sT; *(bf16x8*)(lds + G_AQ + (tid >> 3) * 144 + (tid & 7) * 16) = sA; \
        if (tid < 256) *(bf16x8*)(lds + G_VS + (tid >> 2) * 64 + (tid & 3) * 16) = sV; \
        if (tid < 192) ((float*)(lds + G_GS))[tid] = sg; } while (0)
        GLOAD(0);
        for (int step = 0; step < 132; ++step) {
            GWRITE();
            __syncthreads();
            if (step + 1 < 132) GLOAD(step + 1);
            int lane = lane0; asm volatile("" : "+v"(lane));
            const int r32 = lane & 31, hi = lane >> 5;
            const int vb0 = (int)(uintptr_t)(lds + G_KV) + v_rd_base(lane);
            const int pc = dir == 0 ? step : (step < 4 ? 3 - step : 4 + 127 - (step - 4));
            f32x16 acc = {};
            const int mi = wid & 1;
            if (wid < 4) {
                f32x16 acc2 = {};
                if (wid < 2) {
#pragma unroll
                    for (int d0 = 0; d0 < 8; d0 += 2) {
                        const bf16x8 a0 = *(const bf16x8*)(lds + G_KV + v_st(32 * mi + r32, d0 * 16 + hi * 8)), a1 = *(const bf16x8*)(lds + G_KV + v_st(32 * mi + r32, d0 * 16 + 16 + hi * 8));
                        const bf16x8 b0 = *(const bf16x8*)(lds + G_ST + r32 * 272 + (d0 * 16 + hi * 8) * 2), b1 = *(const bf16x8*)(lds + G_ST + r32 * 272 + (d0 * 16 + 16 + hi * 8) * 2);
                        acc = __builtin_amdgcn_mfma_f32_32x32x16_bf16(a0, b0, acc, 0, 0, 0);
                        acc2 = __builtin_amdgcn_mfma_f32_32x32x16_bf16(a1, b1, acc2, 0, 0, 0); }
                } else {
#pragma unroll
                    for (int d0 = 0; d0 < 8; d0 += 2) {
                        const bf16x8 a0 = *(const bf16x8*)(lds + G_QA + KSWZ(32 * mi + r32, (d0 * 16 + hi * 8) * 2)), a1 = *(const bf16x8*)(lds + G_QA + KSWZ(32 * mi + r32, (d0 * 16 + 16 + hi * 8) * 2));
                        const bf16x8 b0 = *(const bf16x8*)(lds + G_ST + r32 * 272 + (d0 * 16 + hi * 8) * 2), b1 = *(const bf16x8*)(lds + G_ST + r32 * 272 + (d0 * 16 + 16 + hi * 8) * 2);
                        acc = __builtin_amdgcn_mfma_f32_32x32x16_bf16(a0, b0, acc, 0, 0, 0);
                        acc2 = __builtin_amdgcn_mfma_f32_32x32x16_bf16(a1, b1, acc2, 0, 0, 0); }
                }
#pragma unroll
                for (int r = 0; r < 16; ++r) acc[r] += acc2[r];
                if (wid < 2) {
#pragma unroll
                    for (int g4 = 0; g4 < 4; ++g4) { float rv[4];
#pragma unroll
                        for (int j = 0; j < 4; ++j) { const int tau = 32 * mi + 8 * g4 + 4 * hi + j;
                            const float vv = bf2f(*(const bf16_t*)(lds + G_VS + tau * 64 + r32 * 2));
                            rv[j] = bsl[tau] * (vv - gsl[tau] * acc[g4 * 4 + j]); }
                        u32x2 w; w.x = cvtpk(rv[0], rv[1]); w.y = cvtpk(rv[2], rv[3]);
                        *(u32x2*)(lds + G_RT + r32 * 144 + (32 * mi + 8 * g4 + 4 * hi) * 2) = w; }
                } else {
#pragma unroll
                    for (int r = 0; r < 16; ++r) acc[r] *= gsl[32 * mi + crow(r, hi)];
                }
            }
            __syncthreads();
            if (wid < 2) {
                f32x16 u = {}, u2 = {};
#pragma unroll
                for (int s = 0; s < 4; s += 2) {
                    const bf16x8 a0 = *(const bf16x8*)(lds + G_TT + (32 * mi + r32) * 144 + (16 * s + hi * 8) * 2), a1 = *(const bf16x8*)(lds + G_TT + (32 * mi + r32) * 144 + (16 * s + 16 + hi * 8) * 2);
                    const bf16x8 b0 = *(const bf16x8*)(lds + G_RT + r32 * 144 + (16 * s + hi * 8) * 2), b1 = *(const bf16x8*)(lds + G_RT + r32 * 144 + (16 * s + 16 + hi * 8) * 2);
                    u = __builtin_amdgcn_mfma_f32_32x32x16_bf16(a0, b0, u, 0, 0, 0);
                    u2 = __builtin_amdgcn_mfma_f32_32x32x16_bf16(a1, b1, u2, 0, 0, 0); }
#pragma unroll
                for (int r = 0; r < 16; ++r) u[r] += u2[r];
#pragma unroll
                for (int g4 = 0; g4 < 4; ++g4) { float uv[4], up[4];
#pragma unroll
                    for (int j = 0; j < 4; ++j) { const int tau = 32 * mi + 8 * g4 + 4 * hi + j; uv[j] = u[g4 * 4 + j]; up[j] = uv[j] * esl[tau]; }
                    u32x2 w; w.x = cvtpk(uv[0], uv[1]); w.y = cvtpk(uv[2], uv[3]);
                    *(u32x2*)(lds + G_UT + r32 * 144 + (32 * mi + 8 * g4 + 4 * hi) * 2) = w;
                    u32x2 w2; w2.x = cvtpk(up[0], up[1]); w2.y = cvtpk(up[2], up[3]);
                    *(u32x2*)(lds + G_UP + r32 * 144 + (32 * mi + 8 * g4 + 4 * hi) * 2) = w2; }
            }
            __syncthreads();
            if (wid == 2 || wid == 3) {
#pragma unroll
                for (int s = 0; s < 4; ++s) {
                    const bf16x8 a = *(const bf16x8*)(lds + G_AQ + (32 * mi + r32) * 144 + (16 * s + hi * 8) * 2);
                    const bf16x8 bb = *(const bf16x8*)(lds + G_UT + r32 * 144 + (16 * s + hi * 8) * 2);
                    acc = __builtin_amdgcn_mfma_f32_32x32x16_bf16(a, bb, acc, 0, 0, 0); }
#pragma unroll
                for (int r = 0; r < 16; ++r) { const size_t R = (size_t)gdn_row(b, pc, 32 * mi + crow(r, hi), dir);
                    obuf[((size_t)dir * MTOT + R) * 512 + h * 128 + cs * 32 + r32] = f2bf(acc[r]); }
            } else if (wid >= 4) {
                const float gl = gsl[63];
#pragma unroll
                for (int r = 0; r < 16; ++r) Sacc[r] *= gl;
                const bf16x8 pa0 = *(const bf16x8*)(lds + G_UP + r32 * 144 + (0 + hi * 8) * 2), pa1 = *(const bf16x8*)(lds + G_UP + r32 * 144 + (16 + hi * 8) * 2),
                             pa2 = *(const bf16x8*)(lds + G_UP + r32 * 144 + (32 + hi * 8) * 2), pa3 = *(const bf16x8*)(lds + G_UP + r32 * 144 + (48 + hi * 8) * 2);
                const int d0 = wid - 4;
                if (d0 == 0) pv_one<0>(Sacc, vb0, pa0, pa1, pa2, pa3); else if (d0 == 1) pv_one<1>(Sacc, vb0, pa0, pa1, pa2, pa3);
                else if (d0 == 2) pv_one<2>(Sacc, vb0, pa0, pa1, pa2, pa3); else pv_one<3>(Sacc, vb0, pa0, pa1, pa2, pa3);
#pragma unroll
                for (int r = 0; r < 16; ++r) *(bf16_t*)(lds + G_ST + crow(r, hi) * 272 + (32 * d0 + r32) * 2) = f2bf(Sacc[r]);
            }
            __syncthreads();
        }
#undef GLOAD
#undef GWRITE
    }
}

__device__ __forceinline__ void gdn_post_phase(const Params& p) {
    const int lane = threadIdx.x & 63, wid = threadIdx.x >> 6;
    const bf16_t* obuf = (const bf16_t*)(p.ws + WS_H);
    const bf16_t* proj = (const bf16_t*)(p.ws + WS_PROJ);
    bf16_t* mix = (bf16_t*)(p.ws + WS_MIX);
    const int d = (lane & 15) * 8;
    for (int row = blockIdx.x * 8 + wid; row < MTOT; row += gridDim.x * 8) {
        float a[8], bb[8], g[8], y[8];
        unpack8(*(const bf16x8*)(obuf + (size_t)row * 512 + lane * 8), a);
        unpack8(*(const bf16x8*)(obuf + ((size_t)MTOT + row) * 512 + lane * 8), bb);
        unpack8(*(const bf16x8*)(proj + (size_t)row * EV_NP + 3072 + lane * 8), g);
        float ss = 0.f;
#pragma unroll
        for (int i = 0; i < 8; ++i) { a[i] += bb[i]; ss += a[i] * a[i]; }
        ss += __shfl_xor(ss, 1); ss += __shfl_xor(ss, 2); ss += __shfl_xor(ss, 4); ss += __shfl_xor(ss, 8);
        const float rstd = rsqrtf(ss * (1.f / 128.f) + 1e-6f);
#pragma unroll
        for (int i = 0; i < 8; ++i) y[i] = a[i] * rstd * p.gdn_norm[d + i] * (g[i] * __builtin_amdgcn_rcpf(1.f + __expf(-g[i])));
        *(bf16x8*)(mix + (size_t)row * DM + 512 + lane * 8) = pack8(y);
    }
}

__device__ __forceinline__ void diffattn_phase(const Params& p, unsigned char* lds) {
    const int tid = threadIdx.x, wid = tid >> 6, lane = tid & 63, r32 = lane & 31, hi = lane >> 5;
    const bf16_t* proj = (const bf16_t*)(p.ws + WS_PROJ);
    bf16_t* mix = (bf16_t*)(p.ws + WS_MIX);
    float s01 = 0.f, s23 = 0.f;
    for (int i = 0; i < 64; ++i) { s01 += p.diff_lambda[i] * p.diff_lambda[64 + i]; s23 += p.diff_lambda[128 + i] * p.diff_lambda[192 + i]; }
    const float lam = expf(s01) - expf(s23) + 0.2f;
    float* X = (float*)lds; float* li = (float*)(lds + 131072) + wid * 64;
    LAS unsigned char* ldsl = (LAS unsigned char*)lds;
    int koff[2], voff[2];
#pragma unroll
    for (int i = 0; i < 2; ++i) {
        const int g = i * 512 + tid;
        { const int row = g >> 4, cg = (g & 15) ^ (row & 7); koff[i] = row * EV_NP + cg * 8; }
        { const int o = g * 16, st = o >> 9, w = o & 511, kk = (st >> 2) * 8 + (w >> 6);
          const int k = (kk & ~0xC) | ((kk & 4) << 1) | ((kk & 8) >> 1), cc = (st & 3) * 32 + ((w & 63) >> 4) * 8; voff[i] = k * EV_NP + cc; }
    }
    const int vbase = (int)(uintptr_t)lds + v_rd_base(lane);
    const int map = wid >> 2, wq = wid & 3;
    unsigned char* Qs = lds + 98304 + wid * 4096 + lane * 16;
    const int vblk = (gridDim.x % 8 == 0) ? (int)((blockIdx.x & 7) * (gridDim.x >> 3) + (blockIdx.x >> 3)) : (int)blockIdx.x;
    for (int it = vblk; it < 2112; it += gridDim.x) {
        int b, h, NT, qrow0;
        if (it < 2048) { b = it >> 8; h = (it >> 6) & 3; const int qb = it & 63; NT = 132; qrow0 = b * SEQ + qb * 128; }
        else { const int j = it - 2048; b = j >> 3; h = (j >> 1) & 3; NT = 4; qrow0 = NLAT + b * CTXL + (j & 1) * 128; }
        bf16x8 qr[4];
        { const bf16_t* qp = proj + (size_t)(qrow0 + 32 * wq + r32) * EV_NP + h * 128 + map * 64 + hi * 8;
#pragma unroll
          for (int d0 = 0; d0 < 4; ++d0) qr[d0] = *(const bf16x8*)(qp + d0 * 16); }
        f32x16 o[4] = {}; float lsum = 0.f;
#define DDMA(j, bo) do { const bf16_t* pp_ = proj + (size_t)((j) < 4 ? NLAT + b * CTXL + 64 * (j) : b * SEQ + 64 * ((j) - 4)) * EV_NP + h * 128; \
        _Pragma("unroll") for (int i_ = 0; i_ < 2; ++i_) { \
            __builtin_amdgcn_global_load_lds((const unsigned*)(pp_ + 1024 + voff[i_]), (LAS unsigned*)(ldsl + (bo) + i_ * 8192 + wid * 1024), 16, 0, 0); \
            __builtin_amdgcn_global_load_lds((const unsigned*)(pp_ + 512 + koff[i_]), (LAS unsigned*)(ldsl + (bo) + 16384 + i_ * 8192 + wid * 1024), 16, 0, 0); } } while (0)
#define DQK(P0, P1, bo) do { P0 = (f32x16){}; P1 = (f32x16){}; const unsigned char* Ks_ = lds + (bo) + 16384; \
        _Pragma("unroll") for (int d0 = 0; d0 < 4; ++d0) { const int cb_ = (map * 64 + d0 * 16 + hi * 8) * 2; \
            const bf16x8 b0_ = *(const bf16x8*)(Ks_ + KSWZ(r32, cb_)), b1_ = *(const bf16x8*)(Ks_ + KSWZ(32 + r32, cb_)); \
            P0 = __builtin_amdgcn_mfma_f32_32x32x16_bf16(b0_, qr[d0], P0, 0, 0, 0); \
            P1 = __builtin_amdgcn_mfma_f32_32x32x16_bf16(b1_, qr[d0], P1, 0, 0, 0); } } while (0)
#define DSM(P0, P1) do { _Pragma("unroll") for (int r = 0; r < 16; ++r) { P0[r] = __builtin_amdgcn_exp2f(P0[r]); P1[r] = __builtin_amdgcn_exp2f(P1[r]); lsum += P0[r] + P1[r]; } \
        PK4(P0, 0, pa0); PK4(P0, 8, pa1); PK4(P1, 0, pa2); PK4(P1, 8, pa3); } while (0)
#define DTAIL_() asm volatile("s_waitcnt vmcnt(0)" ::: "memory"); __syncthreads(); { const int t_ = bprev; bprev = bcur; bcur = bnext; bnext = t_; }
#define DSTEP_A(N0, N1, O0, O1, j) do { if ((j) + 1 < NT) DDMA((j) + 1, bnext); \
        DQK(N0, N1, bcur); DSM(O0, O1); pv_d0(o, vbase + bprev, pa0, pa1, pa2, pa3); DTAIL_() } while (0)
#define DSTEP_B(N0, N1, O0, O1, j) do { if ((j) + 1 < NT) DDMA((j) + 1, bnext); \
        DSM(O0, O1); pv_d0(o, vbase + bprev, pa0, pa1, pa2, pa3); SBAR(); DQK(N0, N1, bcur); DTAIL_() } while (0)
        f32x16 pA0, pA1, pB0, pB1; bf16x8 pa0, pa1, pa2, pa3;
        DDMA(0, 0); DDMA(1, 32768); asm volatile("s_waitcnt vmcnt(0)" ::: "memory"); __syncthreads();
        DQK(pA0, pA1, 0);
        int bprev = 0, bcur = 32768, bnext = 65536;
        if (map == 0) {
            for (int j = 1; j + 1 < NT; j += 2) { DSTEP_A(pB0, pB1, pA0, pA1, j); DSTEP_A(pA0, pA1, pB0, pB1, j + 1); }
            DSTEP_A(pB0, pB1, pA0, pA1, NT - 1);
        } else {
            for (int j = 1; j + 1 < NT; j += 2) { DSTEP_B(pB0, pB1, pA0, pA1, j); DSTEP_B(pA0, pA1, pB0, pB1, j + 1); }
            DSTEP_B(pB0, pB1, pA0, pA1, NT - 1);
        }
        DSM(pB0, pB1); pv_d0(o, vbase + bprev, pa0, pa1, pa2, pa3);
        __syncthreads();
#undef DDMA
#undef DQK
#undef DSM
#undef DSTEP_A
#undef DSTEP_B
#undef DTAIL_
        const float lt = halfswap_add(lsum);
        if (hi == 0) li[r32] = lt;
        asm volatile("s_waitcnt lgkmcnt(0)" ::: "memory");
        float rli[16];
#pragma unroll
        for (int r = 0; r < 16; ++r) rli[r] = __builtin_amdgcn_rcpf(li[crow(r, hi)]);
        if (map == 1) {
#pragma unroll
            for (int d0 = 0; d0 < 4; ++d0)
#pragma unroll
                for (int r = 0; r < 16; ++r) X[(wq * 64 + d0 * 16 + r) * 64 + lane] = o[d0][r] * rli[r] * lam;
        }
        __syncthreads();
        if (map == 0) {
#pragma unroll
            for (int d0 = 0; d0 < 4; ++d0)
#pragma unroll
                for (int r = 0; r < 16; ++r) o[d0][r] = o[d0][r] * rli[r] - X[(wq * 64 + d0 * 16 + r) * 64 + lane];
#pragma unroll
            for (int r = 0; r < 16; ++r) {
                float ss = o[0][r] * o[0][r] + o[1][r] * o[1][r] + o[2][r] * o[2][r] + o[3][r] * o[3][r];
                ss += __shfl_xor(ss, 1); ss += __shfl_xor(ss, 2); ss += __shfl_xor(ss, 4); ss += __shfl_xor(ss, 8); ss += __shfl_xor(ss, 16);
                const float rstd = rsqrtf(ss * (1.f / 128.f) + 1e-6f) * 0.8f;
                bf16_t* mp = mix + (size_t)(qrow0 + 32 * wq + crow(r, hi)) * DM + h * 128 + r32;
#pragma unroll
                for (int d0 = 0; d0 < 4; ++d0) mp[32 * d0] = f2bf(o[d0][r] * rstd * p.diff_subln[32 * d0 + r32]);
            }
        }
        __syncthreads();
    }
}

__device__ __forceinline__ void natten_phase(const Params& p, unsigned char* lds) {
    const int tid = threadIdx.x, wid = tid >> 6, lane = tid & 63, r32 = lane & 31, hi = lane >> 5;
    const bf16_t* proj = (const bf16_t*)(p.ws + WS_PROJ);
    bf16_t* mix = (bf16_t*)(p.ws + WS_MIX);
    constexpr float L2E = 1.4426950408889634f;
    unsigned char* Vl = lds; unsigned char* Kl = lds + 32768;
    float* rpbs = (float*)(lds + 65536);
    float* li = (float*)(lds + 133120) + wid * 64;
    unsigned char* Qs = lds + 67584 + wid * 8192 + lane * 16;
    const int sr = tid >> 4, sc = (tid & 15) * 8, vst0 = v_st(sr, sc), vst1 = v_st(32 + sr, sc);
    const int vb0 = (int)(uintptr_t)Vl + v_rd_base(lane);
    const float* gkp = p.na_qk_gain + 128 + sc;
    const int vblk = (gridDim.x % 8 == 0) ? (int)((blockIdx.x & 7) * (gridDim.x >> 3) + (blockIdx.x >> 3)) : (int)blockIdx.x;
    for (int it = vblk; it < 2048; it += gridDim.x) {
        const int b = it >> 8, h = (it >> 5) & 7, rq = it & 31;
        const int grow = 4 * rq + (wid >> 1), qc = (wid & 1) * 32 + r32;
        const size_t qR = (size_t)b * SEQ + grow * 64 + qc;
        for (int i = tid; i < 465; i += NTHREADS) rpbs[i] = p.na_rpb[h * 465 + i] * L2E;
        { float ss = 0.f;
#pragma unroll
          for (int d0 = 0; d0 < 8; ++d0) { float qv[8]; unpack8(*(const bf16x8*)(proj + qR * OD_N + h * 128 + d0 * 16 + hi * 8), qv);
#pragma unroll
              for (int i = 0; i < 8; ++i) ss += qv[i] * qv[i]; }
          ss = halfswap_add(ss);
          const float rs = rsqrtf(ss * (1.f / 128.f) + 1e-6f) * 0.08838834764831845f * L2E;
#pragma unroll
          for (int d0 = 0; d0 < 8; ++d0) { float qv[8]; unpack8(*(const bf16x8*)(proj + qR * OD_N + h * 128 + d0 * 16 + hi * 8), qv);
#pragma unroll
              for (int i = 0; i < 8; ++i) qv[i] *= rs * p.na_qk_gain[d0 * 16 + hi * 8 + i];
              *(bf16x8*)(Qs + d0 * 1024) = pack8(qv); } }
        int lo = 4 * rq - 4; lo = lo < 0 ? 0 : (lo > 120 ? 120 : lo);
        int hi_r = 4 * rq + 3 - 4; hi_r = hi_r < 0 ? 0 : (hi_r > 120 ? 120 : hi_r); hi_r += 7;
        const int nlat = hi_r - lo + 1, NT = nlat + 4;
        int wsr = grow - 4; wsr = wsr < 0 ? 0 : (wsr > 120 ? 120 : wsr);
        int cst = qc - 8; cst = cst < 0 ? 0 : (cst > 48 ? 48 : cst);
        f32x16 o[4] = {}; float lsum = 0.f;
        bf16x8 vs0, vs1, ks0, ks1;
#define NLOAD(j) do { const size_t R0_ = (size_t)((j) < nlat ? b * SEQ + (lo + (j)) * 64 : NLAT + b * CTXL + 64 * ((j) - nlat)) + sr; \
        const bf16_t* pp_ = proj + R0_ * OD_N + h * 128 + sc; \
        vs0 = *(const bf16x8*)(pp_ + 2048); vs1 = *(const bf16x8*)(pp_ + 2048 + (size_t)32 * OD_N); \
        ks0 = *(const bf16x8*)(pp_ + 1024); ks1 = *(const bf16x8*)(pp_ + 1024 + (size_t)32 * OD_N); } while (0)
#define KNORM(kx) do { float f_[8]; unpack8(kx, f_); float ss_ = 0.f; _Pragma("unroll") for (int i_ = 0; i_ < 8; ++i_) ss_ += f_[i_] * f_[i_]; \
        ss_ += __shfl_xor(ss_, 1); ss_ += __shfl_xor(ss_, 2); ss_ += __shfl_xor(ss_, 4); ss_ += __shfl_xor(ss_, 8); \
        const float rs_ = rsqrtf(ss_ * (1.f / 128.f) + 1e-6f); _Pragma("unroll") for (int i_ = 0; i_ < 8; ++i_) f_[i_] *= rs_ * gkp[i_]; kx = pack8(f_); } while (0)
#define NWRITE(bf) do { KNORM(ks0); KNORM(ks1); *(bf16x8*)(Vl + (bf) * 16384 + vst0) = vs0; *(bf16x8*)(Vl + (bf) * 16384 + vst1) = vs1; \
        *(bf16x8*)(Kl + (bf) * 16384 + KSWZ(sr, sc * 2)) = ks0; *(bf16x8*)(Kl + (bf) * 16384 + KSWZ(32 + sr, sc * 2)) = ks1; } while (0)
        NLOAD(0); NWRITE(0); __syncthreads();
        for (int j = 0; j < NT; ++j) {
            if (j + 1 < NT) NLOAD(j + 1);
            const int bf = j & 1;
            const bool islat = j < nlat; const int kr = lo + j;
            const bool active = !islat || (kr >= wsr && kr <= wsr + 7);
            if (active) {
                f32x16 p0 = {}, p1 = {};
                const unsigned char* Ks = Kl + bf * 16384;
#pragma unroll
                for (int d0 = 0; d0 < 8; ++d0) { const int cb = (d0 * 16 + hi * 8) * 2;
                    const bf16x8 b0 = *(const bf16x8*)(Ks + KSWZ(r32, cb)), b1 = *(const bf16x8*)(Ks + KSWZ(32 + r32, cb));
                    const bf16x8 qd = *(const bf16x8*)(Qs + d0 * 1024);
                    p0 = __builtin_amdgcn_mfma_f32_32x32x16_bf16(b0, qd, p0, 0, 0, 0);
                    p1 = __builtin_amdgcn_mfma_f32_32x32x16_bf16(b1, qd, p1, 0, 0, 0); }
                if (islat) {
                    const float* rb = rpbs + (kr - grow + 7) * 31 + 15 - qc + 4 * hi;
                    const int mofs = 4 * hi - cst;
#pragma unroll
                    for (int r = 0; r < 16; ++r) {
                        const int kb = (r & 3) + 8 * (r >> 2);
                        const float e0 = __builtin_amdgcn_exp2f(p0[r] + rb[kb]), e1 = __builtin_amdgcn_exp2f(p1[r] + rb[32 + kb]);
                        p0[r] = ((unsigned)(kb + mofs) < 16u) ? e0 : 0.f; p1[r] = ((unsigned)(32 + kb + mofs) < 16u) ? e1 : 0.f;
                        lsum += p0[r] + p1[r]; }
                } else {
#pragma unroll
                    for (int r = 0; r < 16; ++r) { p0[r] = __builtin_amdgcn_exp2f(p0[r]); p1[r] = __builtin_amdgcn_exp2f(p1[r]); lsum += p0[r] + p1[r]; }
                }
                bf16x8 pa0, pa1, pa2, pa3;
                PK4(p0, 0, pa0); PK4(p0, 8, pa1); PK4(p1, 0, pa2); PK4(p1, 8, pa3);
                pv_d0(o, vb0 + bf * 16384, pa0, pa1, pa2, pa3);
            }
            if (j + 1 < NT) NWRITE((j + 1) & 1);
            __syncthreads();
        }
#undef NLOAD
#undef KNORM
#undef NWRITE
        const float lt = halfswap_add(lsum);
        if (hi == 0) li[r32] = lt;
        asm volatile("s_waitcnt lgkmcnt(0)" ::: "memory");
#pragma unroll
        for (int r = 0; r < 16; ++r) { const float rl = __builtin_amdgcn_rcpf(li[crow(r, hi)]);
            bf16_t* mp = mix + ((size_t)b * SEQ + grow * 64 + (wid & 1) * 32 + crow(r, hi)) * DM + h * 128 + r32;
#pragma unroll
            for (int d0 = 0; d0 < 4; ++d0) mp[32 * d0] = f2bf(o[d0][r] * rl); }
        __syncthreads();
    }
}

#define XB_TMO      128
#define XB_XCNT(j)  (256  + 64 * (j))
#define XB_XSUB(j)  (1280 + 64 * (j))
#define XB_XGEN(j)  (2304 + 64 * (j))
#define XB_TOP      3328
#define XB_TOPGEN   3392
#define XCD_BAR_WORDS 3456
#define XB_SPIN_CAP (1u << 22)
__device__ __forceinline__ unsigned xb_ld(unsigned* p)              { return __hip_atomic_load(p, __ATOMIC_RELAXED, __HIP_MEMORY_SCOPE_AGENT); }
__device__ __forceinline__ unsigned xb_add(unsigned* p, unsigned v) { return __hip_atomic_fetch_add(p, v, __ATOMIC_RELAXED, __HIP_MEMORY_SCOPE_AGENT); }
__device__ __forceinline__ unsigned xb_xcc_id() { return (unsigned)__builtin_amdgcn_s_getreg((3 << 11) | 20) & 0xFu; }
#define XB_SPIN(cond, bar) do { unsigned _sp = 0; while (cond) { __builtin_amdgcn_s_sleep(1); \
    if ((++_sp & 255u) == 0u) { if (xb_ld(&(bar)[XB_TMO])) break; if (_sp > XB_SPIN_CAP) { atomicAdd(&(bar)[XB_TMO], 1u); break; } } } } while (0)
struct XcdBarrier { unsigned* bar; unsigned x; volatile LAS unsigned* st; };
__device__ __forceinline__ XcdBarrier xcd_barrier_post(unsigned* bar, volatile LAS unsigned* st) {
    XcdBarrier b; b.bar = bar; b.x = xb_xcc_id(); b.st = st;
    if (threadIdx.x == 0) (void)xb_add(&bar[XB_XCNT(b.x)], 1u);
    return b;
}
__device__ __forceinline__ void xcd_barrier_complete(unsigned* bar, unsigned x, unsigned& nloc, unsigned& nx) {
    const unsigned G = gridDim.x * gridDim.y * gridDim.z;
    unsigned sum, cnt, mine, sp = 0u;
    for (;;) {
        sum = 0u; cnt = 0u; mine = 0u;
#pragma unroll
        for (unsigned j = 0; j < 16; ++j) { const unsigned c = xb_ld(&bar[XB_XCNT(j)]); sum += c; cnt += (c > 0u) ? 1u : 0u; mine = (j == x) ? c : mine; }
        if (sum == G) break;
        __builtin_amdgcn_s_sleep(1);
        if ((++sp & 255u) == 0u) { if (xb_ld(&bar[XB_TMO])) break; if (sp > XB_SPIN_CAP) { atomicAdd(&bar[XB_TMO], 1u); break; } }
    }
    nloc = mine > 0u ? mine : 1u; nx = cnt > 0u ? cnt : 1u;
}
__device__ __forceinline__ void xcd_barrier(const XcdBarrier& b) {
    asm volatile("s_waitcnt vmcnt(0)" ::: "memory");
    __syncthreads();
    if (threadIdx.x == 0) {
        unsigned* bar = b.bar;
        __builtin_amdgcn_s_waitcnt(0);
        unsigned nloc = b.st[0], nx = b.st[1];
        if (nloc == 0u) { xcd_barrier_complete(bar, b.x, nloc, nx); b.st[0] = nloc; b.st[1] = nx; }
        const unsigned old = xb_add(&bar[XB_XSUB(b.x)], 1u);
        const unsigned gen = old / nloc;
        if (old + 1u == (gen + 1u) * nloc) {
            __builtin_amdgcn_fence(__ATOMIC_RELEASE, "agent");
            asm volatile("s_waitcnt vmcnt(0)" ::: "memory");
            const unsigned og = xb_add(&bar[XB_TOP], 1u);
            const unsigned tg = og / nx;
            if (og + 1u == (tg + 1u) * nx) xb_add(&bar[XB_TOPGEN], 1u);
            else XB_SPIN(xb_ld(&bar[XB_TOPGEN]) == tg, bar);
            __builtin_amdgcn_fence(__ATOMIC_ACQUIRE, "agent");
            xb_add(&bar[XB_XGEN(b.x)], 1u);
            asm volatile("s_waitcnt vmcnt(0)" ::: "memory");
        } else {
            XB_SPIN(xb_ld(&bar[XB_XGEN(b.x)]) == gen, bar);
            __builtin_amdgcn_fence(__ATOMIC_ACQUIRE, "agent");
            asm volatile("s_waitcnt vmcnt(0)" ::: "memory");
        }
    }
    __syncthreads();
}

#ifndef PROBE_REP
#define PROBE_REP 0
#endif
#define REP(k) for (int rep_ = 0; rep_ < (((PROBE_REP >> (k)) & 1) ? 2 : 1); ++rep_)
constexpr int NPH = 18;
__global__ void __launch_bounds__(NTHREADS, 2) fwd_megakernel(Params p) {
    extern __shared__ __attribute__((aligned(16))) unsigned char lds[];
    cg::grid_group grid = cg::this_grid();
    LAS unsigned char* ldsl = (LAS unsigned char*)lds;
    const int lo = p.ph_lo, hi = p.ph_hi;
#ifdef ONLY_PH
#define IN(k) (((ONLY_PH >> (k)) & 1) && lo <= (k) && (k) < hi)
#else
#define IN(k) (lo <= (k) && (k) < hi)
#endif
#define SEAM(k) do { if (IN(k) && IN((k) + 1)) { if (p.ph_lo < 0) grid.sync();   { XcdBarrier xb_; xb_.bar = (unsigned*)(p.ws + WS_BAR); xb_.x = xb_xcc_id(); xb_.st = (volatile LAS unsigned*)(ldsl + 135168); xcd_barrier(xb_); } } } while (0)
    unsigned char* ws = p.ws;
    const bf16_t* H = (const bf16_t*)(ws + WS_H);
    bf16_t* PROJ = (bf16_t*)(ws + WS_PROJ);
    const bf16_t* MIX = (const bf16_t*)(ws + WS_MIX);
    float* CTXRES = (float*)(ws + WS_CTXRES);
    const float* MOD = (const float*)(ws + WS_MOD);
    const int G = gridDim.x, c = blockIdx.x;
    if (threadIdx.x < 4) ((volatile LAS unsigned*)(ldsl + 135168))[threadIdx.x] = 0u;
    __syncthreads();
    (void)xcd_barrier_post((unsigned*)(ws + WS_BAR), (volatile LAS unsigned*)(ldsl + 135168));

    if (IN(0)) REP(0) { ada_phase(p, lds); wconv_phase(p, lds);
        { float* rc = (float*)(ws + WS_ROPE); float* rs = rc + SEQ * 32;
          for (int e = blockIdx.x * NTHREADS + threadIdx.x; e < SEQ * 32; e += gridDim.x * NTHREADS) { const int t = e >> 5, pp = e & 31;
              const float inv = powf(10000.f, -(float)(pp & 15) / 16.f); const float ang = (pp < 16 ? (float)(t >> 6) : (float)(t & 63)) * inv;
              rc[e] = cosf(ang); rs[e] = sinf(ang); } } }
    SEAM(0);
    if (IN(1)) REP(1) norm_phase(p, p.x, p.ctx, 0, 0, MTOT);
    SEAM(1);
    if (IN(2)) REP(2) { pg8::Gemm g{H, (const bf16_t*)(ws + WS_W_EVIN), MTOT, EV_NP, DM}; pg8::StaticOrderT<264, 15> S; S.init(MTOT, EV_NP, G, c);
        pg8::EpiBf16 E{PROJ, EV_NP}; pg8::gemm_phase(ldsl, g, S, E); }
    SEAM(2);
    if (IN(3)) prep0_phase(p);
    SEAM(3);
    if (IN(4)) REP(4) gdn_pre_phase(p, lds);
    SEAM(4);
    if (IN(5)) {
#ifndef SKIP_SCAN
        REP(20) { gdn_scan_phase(p, lds); __syncthreads(); }
#endif
#ifndef SKIP_DA
        REP(5) { diffattn_phase(p, lds); __syncthreads(); }
#endif
    }
    SEAM(5);
    if (IN(6)) REP(6) gdn_post_phase(p);
    SEAM(6);
    if (IN(7)) REP(7) { pg8::Gemm g{MIX, (const bf16_t*)(ws + WS_W_EVOUT), MTOT, DM, DM}; pg8::StaticOrderT<264, 4> S; S.init(MTOT, DM, G, c);
        pg8::EpiResid E{p.x, p.ctx, p.out, CTXRES, MOD, 2048}; pg8::gemm_phase(ldsl, g, S, E); }
    SEAM(7);
    if (IN(8)) norm_phase(p, p.out, CTXRES, 0, 1, MTOT);
    SEAM(8);
    if (IN(9)) REP(9) { pg8::Gemm g{H, (const bf16_t*)(ws + WS_W_FFIN), MTOT, 2 * FF, DM}; pg8::StaticOrderT<264, 22> S; S.init(MTOT, 2 * FF, G, c);
        pg8::EpiSwiglu E{PROJ, FF}; pg8::gemm_phase(ldsl, g, S, E); }
    SEAM(9);
    if (IN(10)) { pg8::Gemm g{PROJ, (const bf16_t*)(ws + WS_W_FFOUT), MTOT, DM, FF}; pg8::StaticOrderT<264, 4> S; S.init(MTOT, DM, G, c);
        pg8::EpiResid E{p.out, CTXRES, p.out, CTXRES, MOD, 5120}; pg8::gemm_phase(ldsl, g, S, E); }
    SEAM(10);
    if (IN(11)) norm_phase(p, p.out, CTXRES, 1, 0, MTOT);
    SEAM(11);
    if (IN(12)) { pg8::Gemm g{H, (const bf16_t*)(ws + WS_W_ODIN), MTOT, OD_N, DM}; pg8::StaticOrderT<264, 12> S; S.init(MTOT, OD_N, G, c);
        pg8::EpiBf16 E{PROJ, OD_N}; pg8::gemm_phase(ldsl, g, S, E); }
    SEAM(12);
    if (IN(13)) { natten_phase(p, lds); if ((PROBE_REP >> 13) & 1) { __syncthreads(); natten_phase(p, lds); } }
    SEAM(13);
    if (IN(14)) { pg8::Gemm g{MIX, (const bf16_t*)(ws + WS_W_ODOUT), NLAT, DM, DM}; pg8::StaticOrderT<256, 4> S; S.init(NLAT, DM, G, c);
        pg8::EpiResid E{p.out, CTXRES, p.out, CTXRES, MOD + 9 * 6144, 2048}; pg8::gemm_phase(ldsl, g, S, E); }
    SEAM(14);
    if (IN(15)) norm_phase(p, p.out, CTXRES, 1, 1, NLAT);
    SEAM(15);
    if (IN(16)) { pg8::Gemm g{H, (const bf16_t*)(ws + WS_W_FFIN) + (size_t)2 * FF * DM, NLAT, 2 * FF, DM}; pg8::StaticOrderT<256, 22> S; S.init(NLAT, 2 * FF, G, c);
        pg8::EpiSwiglu E{PROJ, FF}; pg8::gemm_phase(ldsl, g, S, E); }
    SEAM(16);
    if (IN(17)) { pg8::Gemm g{PROJ, (const bf16_t*)(ws + WS_W_FFOUT) + (size_t)DM * FF, NLAT, DM, FF}; pg8::StaticOrderT<256, 4> S; S.init(NLAT, DM, G, c);
        pg8::EpiResid E{p.out, CTXRES, p.out, CTXRES, MOD + 9 * 6144, 5120}; pg8::gemm_phase(ldsl, g, S, E); }
#undef IN
#undef SEAM
}

extern "C" void kernel_launch(void* const* d_in, const int* in_sizes, int n_in, void* d_out, int out_size, void* d_ws, size_t ws_size, hipStream_t stream) {
    static int grid = 0;
    if (grid == 0) {
        if (n_in != 23 || ws_size < WS_END) { fprintf(stderr, "kernel_launch: n_in %d ws %zu (need %zu)\n", n_in, ws_size, (size_t)WS_END); grid = -1; return; }
        int dev = 0, cus = 0, per_cu = 0;
        hipGetDevice(&dev); hipDeviceGetAttribute(&cus, hipDeviceAttributeMultiprocessorCount, dev);
        if (hipFuncSetAttribute((const void*)fwd_megakernel, hipFuncAttributeMaxDynamicSharedMemorySize, LDS_BYTES) != hipSuccess) { fprintf(stderr, "hipFuncSetAttribute failed\n"); grid = -1; return; }
        if (hipOccupancyMaxActiveBlocksPerMultiprocessor(&per_cu, (const void*)fwd_megakernel, NTHREADS, LDS_BYTES) != hipSuccess || per_cu < 1) per_cu = 1;
        (void)hipGetLastError();
        grid = cus * 1;
    }
    if (grid < 0) return;
    if (hipMemsetAsync((char*)d_ws + WS_BAR, 0, 16384, stream) != hipSuccess) { fprintf(stderr, "memset failed\n"); return; }
    Params p{};
    const float** pp = (const float**)&p;
    for (int i = 0; i < 23; ++i) pp[i] = (const float*)d_in[i];
    p.out = (float*)d_out; p.ws = (unsigned char*)d_ws;
#if N_LAUNCH_MODE == 1
    p.ph_lo = 0; p.ph_hi = NPH;
    void* args[] = {&p};
    hipError_t e = hipLaunchCooperativeKernel((void*)fwd_megakernel, dim3(grid), dim3(NTHREADS), args, LDS_BYTES, stream);
    if (e != hipSuccess) fprintf(stderr, "cooperative launch failed: %s (grid %d)\n", hipGetErrorString(e), grid);
#else
    for (int k = 0; k < NPH; ++k) { p.ph_lo = k; p.ph_hi = k + 1;
        hipLaunchKernelGGL(fwd_megakernel, dim3(grid), dim3(NTHREADS), LDS_BYTES, stream, p); }
#endif
}
```

```cpp
#include <hip/hip_runtime.h>
#include <hip/hip_cooperative_groups.h>
#include <cstdio>
#include <cstdint>
namespace cg = cooperative_groups;

#define LAS __attribute__((address_space(3)))
typedef unsigned short bf16_t;
typedef short bf16x8 __attribute__((ext_vector_type(8)));
typedef short s16x4 __attribute__((ext_vector_type(4)));
typedef float f32x4 __attribute__((ext_vector_type(4)));
typedef float f32x16 __attribute__((ext_vector_type(16)));
typedef unsigned u32x4 __attribute__((ext_vector_type(4)));
typedef unsigned u32x2 __attribute__((ext_vector_type(2)));

#ifndef N_LAUNCH_MODE
#define N_LAUNCH_MODE 1
#endif

constexpr int DM = 1024, NLAT = 65536, NCTX = 2048, MTOT = NLAT + NCTX, SEQ = 8192, CTXL = 256, FF = 2816;
constexpr int EV_N = 3600, EV_NP = 3840, OD_N = 3072;
constexpr int NCHUNKP = 64 * 132;
constexpr int NTHREADS = 512;
constexpr int LDS_BYTES = 135168 + 16;

constexpr size_t al256(size_t x) { return (x + 255) / 256 * 256; }
constexpr size_t WS_W_EVIN = 0;
constexpr size_t WS_W_EVOUT = WS_W_EVIN + al256((size_t)EV_NP * DM * 2);
constexpr size_t WS_W_ODIN = WS_W_EVOUT + al256((size_t)DM * DM * 2);
constexpr size_t WS_W_ODOUT = WS_W_ODIN + al256((size_t)OD_N * DM * 2);
constexpr size_t WS_W_FFIN = WS_W_ODOUT + al256((size_t)DM * DM * 2);
constexpr size_t WS_W_FFOUT = WS_W_FFIN + al256((size_t)2 * 2 * FF * DM * 2);
constexpr size_t WS_MOD = WS_W_FFOUT + al256((size_t)2 * DM * FF * 2);
constexpr size_t WS_H = WS_MOD + al256((size_t)2 * 9 * 6144 * 4);
constexpr size_t WS_PROJ = WS_H + al256((size_t)MTOT * DM * 2);
constexpr size_t WS_MIX = WS_PROJ + al256((size_t)MTOT * EV_NP * 2);
constexpr size_t WS_T = WS_MIX + al256((size_t)MTOT * DM * 2);
constexpr size_t WS_AQK = WS_T + al256((size_t)NCHUNKP * 4096 * 2);
constexpr size_t WS_GV = WS_AQK + al256((size_t)NCHUNKP * 4096 * 2);
constexpr size_t WS_BV = WS_GV + al256((size_t)NCHUNKP * 64 * 4);
constexpr size_t WS_EL = WS_BV + al256((size_t)NCHUNKP * 64 * 4);
constexpr size_t WS_GATES = WS_EL + al256((size_t)NCHUNKP * 64 * 4);
constexpr size_t WS_CTXRES = WS_GATES + al256((size_t)MTOT * 16 * 4);
constexpr size_t WS_BAR = WS_CTXRES + al256((size_t)NCTX * DM * 4);
constexpr size_t WS_ROPE = WS_BAR + 16384;
constexpr size_t WS_END = WS_ROPE + (size_t)2 * SEQ * 32 * 4;

struct Params {
    const float *x, *c, *ctx, *c_ctx, *ada_w, *ada_b, *norm_mix, *norm_ffn, *ffn_w_in, *ffn_w_out, *even_w_in, *even_w_out,
        *diff_qk_gain, *diff_lambda, *diff_subln, *gdn_conv, *gdn_a_log, *gdn_dt_bias, *gdn_norm, *odd_w_in, *odd_w_out, *na_qk_gain, *na_rpb;
    float* out; unsigned char* ws; int ph_lo, ph_hi;
};

__device__ __forceinline__ float bf2f(bf16_t b) { return __uint_as_float(((unsigned)b) << 16); }
__device__ __forceinline__ bf16_t f2bf(float f) { unsigned u = __float_as_uint(f); u += 0x7FFFu + ((u >> 16) & 1u); return (bf16_t)(u >> 16); }
__device__ __forceinline__ unsigned cvtpk(float lo, float hi) { unsigned r; asm volatile("v_cvt_pk_bf16_f32 %0, %1, %2" : "=v"(r) : "v"(lo), "v"(hi)); return r; }
__device__ __forceinline__ float siluf(float v) { return v / (1.f + __expf(-v)); }
__device__ __forceinline__ void unpack8(bf16x8 v, float* f) {
#pragma unroll
    for (int i = 0; i < 8; ++i) f[i] = bf2f((bf16_t)v[i]);
}
__device__ __forceinline__ bf16x8 pack8(const float* f) {
    u32x4 w = {cvtpk(f[0], f[1]), cvtpk(f[2], f[3]), cvtpk(f[4], f[5]), cvtpk(f[6], f[7])};
    return *reinterpret_cast<bf16x8*>(&w);
}

namespace pg8 {
constexpr int BM = 256, BK = 64, HALF = 128, HTB = HALF * BK * 2, STAGE_BYTES = 8 * HTB, NXCD = 8, WGM = 4;
__host__ __device__ __forceinline__ int lds_byte(int r, int c) { const int st = (r >> 4) * 2 + (c >> 5), rr = r & 15, cc = c & 31, ob = rr * 64 + cc * 2; return st * 1024 + (ob ^ (((ob >> 9) & 1) << 5)); }
__host__ __device__ __forceinline__ void stage_rc(int b, int& R, int& C) { const int st = b / 1024, sb = b % 1024, swz = sb ^ (((sb >> 9) & 1) << 5); R = (st >> 1) * 16 + swz / 64; C = (st & 1) * 32 + (swz % 64) / 2; }
__host__ __device__ __forceinline__ int perm32(int rho) { const int n = rho >> 4, i = rho & 15; return 8 * (i >> 2) + 4 * n + (i & 3); }
struct Unit { int pm, pn; };
struct Gemm { const bf16_t* A; const bf16_t* Bt; int M, N, K; };
template <int NM, int NN> struct StaticOrderT {
    static_assert(NM % WGM == 0, "row tiles in whole groups");
    int G, c;
    __device__ void init(int, int, int G_, int c_) { G = G_; c = c_; }
    __device__ bool next(int i, Unit& u) const {
        constexpr int nwg = NM * NN, q = nwg / NXCD, r = nwg % NXCD, nig = WGM * NN;
        const int L = i * G + c; if (L >= nwg) return false;
        const int xcd = L % NXCD, off = L / NXCD;
        const int wgid = (xcd < r ? xcd * (q + 1) : r * (q + 1) + (xcd - r) * q) + off;
        const int gid = wgid / nig, w = wgid % nig;
        u.pm = gid * WGM + (w % WGM); u.pn = w / WGM; return true;
    }
};
struct EpiBf16 {
    static constexpr bool PERM = true;
    bf16_t* O; int ldc; int nvalid;
    __device__ __forceinline__ void operator()(const f32x4 (&acc)[2][2][4][2], const Unit& u, int wr, int wc, int fr, int fq) const {
        const int row0 = u.pm * BM + wr * 64 + fr; const int col0 = u.pn * BM + wc * 32 + 8 * fq;
#pragma unroll
        for (int ai = 0; ai < 2; ++ai)
#pragma unroll
            for (int m = 0; m < 4; ++m) { bf16_t* rowp = O + (size_t)(row0 + ai * HALF + m * 16) * ldc + col0;
#pragma unroll
                for (int bj = 0; bj < 2; ++bj) { const f32x4 v0 = acc[ai][bj][m][0], v1 = acc[ai][bj][m][1];
                    u32x4 w; w.x = cvtpk(v0[0], v0[1]); w.y = cvtpk(v0[2], v0[3]); w.z = cvtpk(v1[0], v1[1]); w.w = cvtpk(v1[2], v1[3]);
                    if (col0 + bj * HALF < nvalid) *(u32x4*)(rowp + bj * HALF) = w; } }
    }
};
struct EpiSwiglu {
    static constexpr bool PERM = true;
    bf16_t* O; int ldc;
    __device__ __forceinline__ void operator()(const f32x4 (&acc)[2][2][4][2], const Unit& u, int wr, int wc, int fr, int fq) const {
        const int row0 = u.pm * BM + wr * 64 + fr; const int col0 = u.pn * HALF + wc * 32 + 8 * fq;
#pragma unroll
        for (int ai = 0; ai < 2; ++ai)
#pragma unroll
            for (int m = 0; m < 4; ++m) { bf16_t* rowp = O + (size_t)(row0 + ai * HALF + m * 16) * ldc + col0;
                typedef float f32x2v __attribute__((ext_vector_type(2)));
                unsigned wv[4];
#pragma unroll
                for (int n = 0; n < 2; ++n)
#pragma unroll
                    for (int j = 0; j < 4; j += 2) { const f32x2v g = {acc[ai][0][m][n][j], acc[ai][0][m][n][j + 1]}, up = {acc[ai][1][m][n][j], acc[ai][1][m][n][j + 1]};
                        const f32x2v t = g * (-1.4426950408889634f); f32x2v e; e.x = __builtin_amdgcn_exp2f(t.x); e.y = __builtin_amdgcn_exp2f(t.y);
                        const f32x2v d = e + 1.0f; f32x2v r; r.x = __builtin_amdgcn_rcpf(d.x); r.y = __builtin_amdgcn_rcpf(d.y);
                        const f32x2v o = (g * up) * r; wv[n * 2 + (j >> 1)] = cvtpk(o.x, o.y); }
                u32x4 w; w.x = wv[0]; w.y = wv[1]; w.z = wv[2]; w.w = wv[3];
                *(u32x4*)rowp = w; }
    }
};
struct EpiResid {
    static constexpr bool PERM = false;
    const float* resLat; const float* resCtx; float* outLat; float* outCtx; const float* modl; int goff;
    __device__ __forceinline__ void operator()(const f32x4 (&acc)[2][2][4][2], const Unit& u, int wr, int wc, int fr, int fq) const {
        const int rowt = u.pm * BM; const bool lat = rowt < NLAT;
        const float* res = lat ? resLat + (size_t)rowt * DM : resCtx + (size_t)(rowt - NLAT) * DM;
        float* out = lat ? outLat + (size_t)rowt * DM : outCtx + (size_t)(rowt - NLAT) * DM;
        const float* gate = modl + (size_t)(lat ? (rowt >> 13) : 8) * 6144 + goff;
        const int row0 = wr * 64 + fr, col0 = u.pn * BM + wc * 32 + 4 * fq;
        f32x4 gv[2][2];
#pragma unroll
        for (int bj = 0; bj < 2; ++bj)
#pragma unroll
            for (int n = 0; n < 2; ++n) gv[bj][n] = *(const f32x4*)(gate + col0 + bj * HALF + n * 16);
#pragma unroll
        for (int ai = 0; ai < 2; ++ai) {
            f32x4 r[4][2][2];
#pragma unroll
            for (int m = 0; m < 4; ++m)
#pragma unroll
                for (int bj = 0; bj < 2; ++bj)
#pragma unroll
                    for (int n = 0; n < 2; ++n) r[m][bj][n] = *(const f32x4*)(res + (size_t)(row0 + ai * HALF + m * 16) * DM + col0 + bj * HALF + n * 16);
#pragma unroll
            for (int m = 0; m < 4; ++m)
#pragma unroll
                for (int bj = 0; bj < 2; ++bj)
#pragma unroll
                    for (int n = 0; n < 2; ++n) *(f32x4*)(out + (size_t)(row0 + ai * HALF + m * 16) * DM + col0 + bj * HALF + n * 16) = r[m][bj][n] + gv[bj][n] * acc[ai][bj][m][n];
        }
    }
};

template <class Epi, class Sched>
__device__ __forceinline__ void gemm_phase(LAS unsigned char* lds, const Gemm g, const Sched& S, const Epi& E) {
    const int tid = threadIdx.x, wid = __builtin_amdgcn_readfirstlane(tid >> 6), lane = tid & 63, wr = wid >> 2, wc = wid & 3, fr = lane & 15, fq = lane >> 4;
    const int K = g.K, nt = K / BK;
    unsigned voffA[2], voffB[2];
#pragma unroll
    for (int i = 0; i < 2; ++i) { int R, C; stage_rc(tid * 16 + i * 8192, R, C); const int Rb = Epi::PERM ? ((R & ~31) + perm32(R & 31)) : R;
        voffA[i] = (unsigned)(R * K + C) * 2u; voffB[i] = (unsigned)(Rb * K + C) * 2u; }
    const size_t kstep = (size_t)(BK * 2);
    const size_t hstep = (size_t)HALF * K * 2;
    const size_t tstep = 2 * hstep;
    const unsigned ldsw = (unsigned)wid * 1024u;
    const int aoff = lds_byte(wr * 64 + fr, fq * 8), boff = lds_byte(wc * 32 + fr, fq * 8);
#define PG8_SA(b, h) (((b) * 2 + (h)) * HTB)
#define PG8_SB(b, h) ((4 + (b) * 2 + (h)) * HTB)
#define PG8_STAGE(bufoff, gbase, voff) do { _Pragma("unroll") for (int _i = 0; _i < 2; ++_i) \
        __builtin_amdgcn_global_load_lds((const unsigned*)((const char*)(gbase) + (voff)[_i]), (LAS unsigned*)(lds + (bufoff) + ldsw + _i * 8192), 16, 0, 0); } while (0)
#define PG8_LDA(dst, b, h) do { _Pragma("unroll") for (int m = 0; m < 4; ++m) _Pragma("unroll") for (int k = 0; k < 2; ++k) dst[m][k] = *(const LAS bf16x8*)(lds + PG8_SA(b, h) + aoff + m * 2048 + k * 1024); } while (0)
#define PG8_LDB(dst, b, h) do { _Pragma("unroll") for (int n = 0; n < 2; ++n) _Pragma("unroll") for (int k = 0; k < 2; ++k) dst[n][k] = *(const LAS bf16x8*)(lds + PG8_SB(b, h) + boff + n * 2048 + k * 1024); } while (0)
#define PG8_MMA(ai, bj, At, Bt) do { __builtin_amdgcn_s_setprio(1); _Pragma("unroll") for (int m = 0; m < 4; ++m) _Pragma("unroll") for (int n = 0; n < 2; ++n) _Pragma("unroll") for (int k = 0; k < 2; ++k) \
        acc[ai][bj][m][n] = __builtin_amdgcn_mfma_f32_16x16x32_bf16(Bt[n][k], At[m][k], acc[ai][bj][m][n], 0, 0, 0); __builtin_amdgcn_s_setprio(0); } while (0)
#define PG8_WAIT_V(n) asm volatile("s_waitcnt vmcnt(" #n ")" ::: "memory")
#define PG8_WAIT_L(n) asm volatile("s_waitcnt lgkmcnt(" #n ")" ::: "memory")
#define PG8_BAR __builtin_amdgcn_s_barrier()
#define PG8_SCHED __builtin_amdgcn_sched_barrier(0)
    Unit cur, nxt; int ui = 0;
    if (!S.next(0, cur)) return;
    f32x4 acc[2][2][4][2];
#pragma unroll
    for (int a = 0; a < 2; ++a)
#pragma unroll
        for (int b = 0; b < 2; ++b)
#pragma unroll
            for (int m = 0; m < 4; ++m)
#pragma unroll
                for (int n = 0; n < 2; ++n) acc[a][b][m][n] = (f32x4){0.f, 0.f, 0.f, 0.f};
    bf16x8 At[4][2], B0[2][2], B1[2][2];
    const char* cA = (const char*)g.A + (size_t)cur.pm * tstep; const char* cB = (const char*)g.Bt + (size_t)cur.pn * tstep;
    PG8_STAGE(PG8_SB(0, 0), cB, voffB); PG8_STAGE(PG8_SA(0, 0), cA, voffA); PG8_STAGE(PG8_SB(0, 1), cB + hstep, voffB); PG8_STAGE(PG8_SA(0, 1), cA + hstep, voffA);
    if (wr == 1) PG8_BAR;
    PG8_WAIT_V(4); PG8_BAR;
    PG8_STAGE(PG8_SB(1, 0), cB + kstep, voffB); PG8_STAGE(PG8_SA(1, 0), cA + kstep, voffA); PG8_STAGE(PG8_SB(1, 1), cB + hstep + kstep, voffB);
    PG8_WAIT_V(6); PG8_BAR;
    for (;;) {
        const bool has_next = S.next(ui + 1, nxt);
        const char* nA = has_next ? (const char*)g.A + (size_t)nxt.pm * tstep : cA; const char* nB = has_next ? (const char*)g.Bt + (size_t)nxt.pn * tstep : cB;
        for (int t = 0; t < nt; t += 2) {
            const bool last = (t == nt - 2);
            const char* a1 = cA + (size_t)(t + 1) * kstep;
            const char* a2 = last ? nA : cA + (size_t)(t + 2) * kstep; const char* b2 = last ? nB : cB + (size_t)(t + 2) * kstep;
            const char* a3 = a2 + kstep; const char* b3 = b2 + kstep;
            PG8_LDB(B0, 0, 0); PG8_SCHED; PG8_LDA(At, 0, 0); PG8_STAGE(PG8_SA(1, 1), a1 + hstep, voffA);
            PG8_WAIT_L(8); PG8_BAR; PG8_WAIT_L(0); PG8_MMA(0, 0, At, B0); PG8_BAR; PG8_SCHED;
            PG8_LDB(B1, 0, 1); PG8_STAGE(PG8_SB(0, 0), b2, voffB);
            PG8_BAR; PG8_WAIT_L(0); PG8_MMA(0, 1, At, B1); PG8_BAR;
            PG8_LDA(At, 0, 1); PG8_STAGE(PG8_SA(0, 0), a2, voffA);
            PG8_BAR; PG8_WAIT_L(0); PG8_MMA(1, 0, At, B0); PG8_BAR; PG8_SCHED;
            PG8_STAGE(PG8_SB(0, 1), b2 + hstep, voffB);
            PG8_WAIT_V(6); PG8_BAR; PG8_MMA(1, 1, At, B1); PG8_BAR;
            PG8_LDB(B0, 1, 0); PG8_SCHED; PG8_LDA(At, 1, 0); PG8_STAGE(PG8_SA(0, 1), a2 + hstep, voffA);
            PG8_WAIT_L(8); PG8_BAR; PG8_WAIT_L(0); PG8_MMA(0, 0, At, B0); PG8_BAR; PG8_SCHED;
            PG8_LDB(B1, 1, 1); PG8_STAGE(PG8_SB(1, 0), b3, voffB);
            PG8_BAR; PG8_WAIT_L(0); PG8_MMA(0, 1, At, B1); PG8_BAR;
            PG8_LDA(At, 1, 1); PG8_STAGE(PG8_SA(1, 0), a3, voffA);
            PG8_BAR; PG8_WAIT_L(0); PG8_MMA(1, 0, At, B0); PG8_BAR; PG8_SCHED;
            PG8_STAGE(PG8_SB(1, 1), b3 + hstep, voffB);
            PG8_WAIT_V(6); PG8_BAR; PG8_MMA(1, 1, At, B1); PG8_BAR;
        }
        E(acc, cur, wr, wc, fr, fq);
        if (!has_next) break;
#pragma unroll
        for (int a = 0; a < 2; ++a)
#pragma unroll
            for (int b = 0; b < 2; ++b)
#pragma unroll
                for (int m = 0; m < 4; ++m)
#pragma unroll
                    for (int n = 0; n < 2; ++n) acc[a][b][m][n] = (f32x4){0.f, 0.f, 0.f, 0.f};
        cur = nxt; cA = nA; cB = nB; ++ui;
    }
    PG8_WAIT_V(0);
    if (wr == 0) PG8_BAR;
    PG8_BAR;
#undef PG8_SA
#undef PG8_SB
#undef PG8_STAGE
#undef PG8_LDA
#undef PG8_LDB
#undef PG8_MMA
#undef PG8_WAIT_V
#undef PG8_WAIT_L
#undef PG8_BAR
#undef PG8_SCHED
}
}

#define KSWZ(row, colB) ((row) * 256 + ((colB) ^ (((row) & 7) << 4)))
#define SBAR() __builtin_amdgcn_sched_barrier(0)
__device__ __forceinline__ int crow(int r, int hi) { return (r & 3) + 8 * (r >> 2) + 4 * hi; }
__device__ __forceinline__ int v_st(int k, int c) { const int kk = (k & ~0xC) | ((k & 4) << 1) | ((k & 8) >> 1); return ((kk >> 3) * 4 + (c >> 5)) * 512 + ((kk & 7) * 32 + (c & 31)) * 2; }
__device__ __forceinline__ int v_rd_base(int lane) { return ((lane & 3) << 3) | (((lane >> 2) & 3) << 6) | (((lane >> 4) & 1) << 5) | (((lane >> 5) & 1) << 8); }
constexpr int v_rd_off(int d0, int ks, int half) { return d0 * 512 + ks * 4096 + half * 2048; }
template <int OFF> __device__ __forceinline__ s16x4 tr_read(int vb) {
    s16x4 r; asm volatile("ds_read_b64_tr_b16 %0, %1 offset:%2" : "=&v"(r) : "v"(vb), "i"(OFF) : "memory"); return r;
}
template <int D0> __device__ __forceinline__ void pv_one(f32x16& od, int vb, bf16x8 pa0, bf16x8 pa1, bf16x8 pa2, bf16x8 pa3) {
    const s16x4 l0 = tr_read<v_rd_off(D0, 0, 0)>(vb), h0 = tr_read<v_rd_off(D0, 0, 1)>(vb), l1 = tr_read<v_rd_off(D0, 1, 0)>(vb), h1 = tr_read<v_rd_off(D0, 1, 1)>(vb);
    const s16x4 l2 = tr_read<v_rd_off(D0, 2, 0)>(vb), h2 = tr_read<v_rd_off(D0, 2, 1)>(vb), l3 = tr_read<v_rd_off(D0, 3, 0)>(vb), h3 = tr_read<v_rd_off(D0, 3, 1)>(vb);
    asm volatile("s_waitcnt lgkmcnt(0)" ::: "memory"); SBAR();
#define PK(L, H) (bf16x8){L[0], L[1], L[2], L[3], H[0], H[1], H[2], H[3]}
    od = __builtin_amdgcn_mfma_f32_32x32x16_bf16(pa0, PK(l0, h0), od, 0, 0, 0);
    od = __builtin_amdgcn_mfma_f32_32x32x16_bf16(pa1, PK(l1, h1), od, 0, 0, 0);
    od = __builtin_amdgcn_mfma_f32_32x32x16_bf16(pa2, PK(l2, h2), od, 0, 0, 0);
    od = __builtin_amdgcn_mfma_f32_32x32x16_bf16(pa3, PK(l3, h3), od, 0, 0, 0);
#undef PK
}
__device__ __forceinline__ void pv_d0(f32x16* o, int vb, bf16x8 pa0, bf16x8 pa1, bf16x8 pa2, bf16x8 pa3) {
    pv_one<0>(o[0], vb, pa0, pa1, pa2, pa3); pv_one<1>(o[1], vb, pa0, pa1, pa2, pa3); pv_one<2>(o[2], vb, pa0, pa1, pa2, pa3); pv_one<3>(o[3], vb, pa0, pa1, pa2, pa3);
}
#define PK4(P, BASE, OUT) do { unsigned a0 = cvtpk(P[BASE + 0], P[BASE + 1]), a1 = cvtpk(P[BASE + 2], P[BASE + 3]);   \
    unsigned b0 = cvtpk(P[BASE + 4], P[BASE + 5]), b1 = cvtpk(P[BASE + 6], P[BASE + 7]);                              \
    auto r0 = __builtin_amdgcn_permlane32_swap(a0, b0, false, false); auto r1 = __builtin_amdgcn_permlane32_swap(a1, b1, false, false); \
    u32x4 w = {r0[0], r1[0], r0[1], r1[1]}; OUT = *reinterpret_cast<bf16x8*>(&w); } while (0)
__device__ __forceinline__ float halfswap_add(float v) {
    auto rr = __builtin_amdgcn_permlane32_swap(__float_as_uint(v), __float_as_uint(v), false, false);
    return __uint_as_float(rr[0]) + __uint_as_float(rr[1]);
}

__device__ __forceinline__ void ada_phase(const Params& p, unsigned char* lds) {
    float* sc = (float*)lds;
    float* red = (float*)(lds + 40960);
    float* mod = (float*)(p.ws + WS_MOD);
    const int tid = threadIdx.x;
    for (int j = blockIdx.x; j < 192; j += gridDim.x) {
        const int l = j / 96, n0 = (j % 96) * 64;
        for (int i = tid; i < 9 * 1024; i += NTHREADS) { const int r = i >> 10, k = i & 1023; const float v = r < 8 ? p.c[r * 1024 + k] : p.c_ctx[k]; sc[i] = v / (1.f + expf(-v)); }
        __syncthreads();
        const int col = tid & 63, ks = tid >> 6;
        float acc[9];
#pragma unroll
        for (int r = 0; r < 9; ++r) acc[r] = 0.f;
        const float* wp = p.ada_w + ((size_t)l * 1024 + ks * 128) * 6144 + n0 + col;
#pragma unroll 8
        for (int kk = 0; kk < 128; ++kk) { const float w = wp[(size_t)kk * 6144];
#pragma unroll
            for (int r = 0; r < 9; ++r) acc[r] += sc[r * 1024 + ks * 128 + kk] * w; }
#pragma unroll
        for (int r = 0; r < 9; ++r) red[(ks * 9 + r) * 64 + col] = acc[r];
        __syncthreads();
        for (int i = tid; i < 576; i += NTHREADS) { const int r = i >> 6, cc = i & 63; float s = p.ada_b[l * 6144 + n0 + cc];
            for (int k2 = 0; k2 < 8; ++k2) s += red[(k2 * 9 + r) * 64 + cc];
            mod[(size_t)(l * 9 + r) * 6144 + n0 + cc] = s; }
        __syncthreads();
    }
}
__device__ __forceinline__ void wconv_phase(const Params& p, unsigned char* lds) {
    float* tl = (float*)lds;
    const int tid = threadIdx.x;
    const int T0 = 16 * 60, T1 = T0 + 16 * 16, T2 = T1 + 16 * 48, T3 = T2 + 16 * 16, T4 = T3 + 16 * 88, T5 = T4 + 16 * 88, T6 = T5 + 44 * 16, T7 = T6 + 44 * 16;
#define WC_DECODE(t) \
        const float* src; bf16_t* dst; int K, N, NP, mode = 0, tt; \
        if ((t) < T0) { src = p.even_w_in; dst = (bf16_t*)(p.ws + WS_W_EVIN); K = 1024; N = EV_N; NP = EV_NP; tt = (t); } \
        else if ((t) < T1) { src = p.even_w_out; dst = (bf16_t*)(p.ws + WS_W_EVOUT); K = 1024; N = 1024; NP = 1024; tt = (t) - T0; } \
        else if ((t) < T2) { src = p.odd_w_in; dst = (bf16_t*)(p.ws + WS_W_ODIN); K = 1024; N = OD_N; NP = OD_N; tt = (t) - T1; } \
        else if ((t) < T3) { src = p.odd_w_out; dst = (bf16_t*)(p.ws + WS_W_ODOUT); K = 1024; N = 1024; NP = 1024; tt = (t) - T2; } \
        else if ((t) < T4) { src = p.ffn_w_in; dst = (bf16_t*)(p.ws + WS_W_FFIN); K = 1024; N = 2 * FF; NP = 2 * FF; mode = 1; tt = (t) - T3; } \
        else if ((t) < T5) { src = p.ffn_w_in + (size_t)1024 * 2 * FF; dst = (bf16_t*)(p.ws + WS_W_FFIN) + (size_t)2 * FF * 1024; K = 1024; N = 2 * FF; NP = 2 * FF; mode = 1; tt = (t) - T4; } \
        else if ((t) < T6) { src = p.ffn_w_out; dst = (bf16_t*)(p.ws + WS_W_FFOUT); K = FF; N = 1024; NP = 1024; tt = (t) - T5; } \
        else { src = p.ffn_w_out + (size_t)FF * 1024; dst = (bf16_t*)(p.ws + WS_W_FFOUT) + (size_t)1024 * FF; K = FF; N = 1024; NP = 1024; tt = (t) - T6; } \
        const int nnt = NP / 64; const int k0 = (tt / nnt) * 64, n0 = (tt % nnt) * 64; \
        int sn0; if (mode == 1) { const int tb = n0 >> 8, bj = (n0 >> 7) & 1, i0 = n0 & 127; sn0 = bj * FF + tb * 128 + i0; } else sn0 = n0;
    float rg[8];
#define WC_LOAD(t) do { WC_DECODE(t) (void)dst; _Pragma("unroll") for (int i = 0; i < 8; ++i) { const int e = tid + NTHREADS * i, kk = e >> 6, nn = e & 63; const int sn = sn0 + nn; \
        rg[i] = (sn < N) ? src[(size_t)(k0 + kk) * N + sn] : 0.f; } } while (0)
    int t = blockIdx.x;
    if (t < T7) WC_LOAD(t);
    for (; t < T7; t += gridDim.x) {
#pragma unroll
        for (int i = 0; i < 8; ++i) { const int e = tid + NTHREADS * i; tl[(e >> 6) * 65 + (e & 63)] = rg[i]; }
        __syncthreads();
        { WC_DECODE(t) (void)src; (void)N; (void)sn0;
          if (t + (int)gridDim.x < T7) WC_LOAD(t + (int)gridDim.x);
          for (int e = tid; e < 2048; e += NTHREADS) { const int nn = e >> 5, k2 = (e & 31) * 2;
              *(unsigned*)(dst + (size_t)(n0 + nn) * K + k0 + k2) = cvtpk(tl[k2 * 65 + nn], tl[(k2 + 1) * 65 + nn]); } }
        __syncthreads();
    }
#undef WC_DECODE
#undef WC_LOAD
}

__device__ __forceinline__ void norm_phase(const Params& p, const float* xlat, const float* xctx, int l, int which, int nrows) {
    const int lane = threadIdx.x & 63, wid = threadIdx.x >> 6;
    bf16_t* h = (bf16_t*)(p.ws + WS_H);
    const float* mod = (const float*)(p.ws + WS_MOD) + (size_t)l * 9 * 6144;
    const float* gain = (which ? p.norm_ffn : p.norm_mix) + l * 1024;
    const int shoff = which ? 3072 : 0, scoff = which ? 4096 : 1024;
    const int stride = gridDim.x * 8;
    f32x4 gn[4];
#pragma unroll
    for (int i = 0; i < 4; ++i) gn[i] = *(const f32x4*)(gain + lane * 4 + 256 * i);
    for (int row = blockIdx.x * 8 + wid; row < nrows; row += 2 * stride) {
        const int rowB = row + stride; const bool hasB = rowB < nrows; const int rB = hasB ? rowB : row;
        const float* srcA = row < NLAT ? xlat + (size_t)row * DM : xctx + (size_t)(row - NLAT) * DM;
        const float* srcB = rB < NLAT ? xlat + (size_t)rB * DM : xctx + (size_t)(rB - NLAT) * DM;
        const float* mrA = mod + (size_t)(row < NLAT ? (row >> 13) : 8) * 6144;
        const float* mrB = mod + (size_t)(rB < NLAT ? (rB >> 13) : 8) * 6144;
        f32x4 va[4], vb[4], sa[4], ha[4], sb[4], hb[4];
#pragma unroll
        for (int i = 0; i < 4; ++i) { const int c0 = lane * 4 + 256 * i;
            va[i] = *(const f32x4*)(srcA + c0); vb[i] = *(const f32x4*)(srcB + c0);
            sa[i] = *(const f32x4*)(mrA + scoff + c0); ha[i] = *(const f32x4*)(mrA + shoff + c0);
            sb[i] = *(const f32x4*)(mrB + scoff + c0); hb[i] = *(const f32x4*)(mrB + shoff + c0); }
#pragma unroll
        for (int rr = 0; rr < 2; ++rr) {
            if (rr == 1 && !hasB) break;
            const int r = rr ? rowB : row;
            float ss = 0.f;
#pragma unroll
            for (int i = 0; i < 4; ++i) { const f32x4 v = rr ? vb[i] : va[i]; ss += v[0] * v[0] + v[1] * v[1] + v[2] * v[2] + v[3] * v[3]; }
#pragma unroll
            for (int o = 1; o < 64; o <<= 1) ss += __shfl_xor(ss, o);
            const float rstd = rsqrtf(ss * (1.f / 1024.f) + 1e-6f);
#pragma unroll
            for (int i = 0; i < 4; ++i) { const int c0 = lane * 4 + 256 * i; const f32x4 v = rr ? vb[i] : va[i], s1 = rr ? sb[i] : sa[i], sh = rr ? hb[i] : ha[i];
                float y[4];
#pragma unroll
                for (int j = 0; j < 4; ++j) y[j] = v[j] * rstd * gn[i][j] * (1.f + s1[j]) + sh[j];
                u32x2 w; w.x = cvtpk(y[0], y[1]); w.y = cvtpk(y[2], y[3]);
                *(u32x2*)(h + (size_t)r * DM + c0) = w; }
        }
    }
}

template <int RB>
__device__ __forceinline__ void prep0_block(const Params& p, const int row0, const int lane0) {
    bf16_t* proj = (bf16_t*)(p.ws + WS_PROJ);
    bf16_t* qkvp = (bf16_t*)p.out;
    float* gbuf = (float*)(p.ws + WS_GATES);
    const float* ropec = (const float*)(p.ws + WS_ROPE); const float* ropes = ropec + SEQ * 32;
    {
        int lane = lane0; asm volatile("" : "+v"(lane));
        const bool lat = row0 < NLAT; const int t0 = lat ? (row0 & 8191) : ((row0 - NLAT) & 255); const int len = lat ? SEQ : CTXL;
        const int dsub = (lane & 7) * 8;
        {
            float gq[8], gk[8];
#pragma unroll
            for (int i = 0; i < 8; ++i) { gq[i] = p.diff_qk_gain[dsub + i] * (0.125f * 1.4426950408889634f); gk[i] = p.diff_qk_gain[64 + dsub + i]; }
            constexpr int DB = RB < 4 ? RB : 4;
#pragma unroll
            for (int i0 = 0; i0 < RB; i0 += DB) {
                bf16x8 raw[DB][2]; f32x4 c4[DB], s4[DB];
#pragma unroll
                for (int i = 0; i < DB; ++i) { const bf16_t* P = proj + (size_t)(row0 + i0 + i) * EV_NP;
                    raw[i][0] = *(const bf16x8*)(P + lane * 8); raw[i][1] = *(const bf16x8*)(P + 512 + lane * 8);
                    c4[i] = (f32x4){1.f, 1.f, 1.f, 1.f}; s4[i] = (f32x4){0.f, 0.f, 0.f, 0.f};
                    if (lat) { c4[i] = *(const f32x4*)(ropec + (t0 + i0 + i) * 32 + (lane & 7) * 4); s4[i] = *(const f32x4*)(ropes + (t0 + i0 + i) * 32 + (lane & 7) * 4); } }
#pragma unroll
                for (int i = 0; i < DB; ++i) { bf16_t* P = proj + (size_t)(row0 + i0 + i) * EV_NP;
#pragma unroll
                    for (int which = 0; which < 2; ++which) {
                        float v[8]; unpack8(raw[i][which], v);
                        float ss = 0.f;
#pragma unroll
                        for (int e = 0; e < 8; ++e) ss += v[e] * v[e];
                        ss += __shfl_xor(ss, 1); ss += __shfl_xor(ss, 2); ss += __shfl_xor(ss, 4);
                        const float rstd = rsqrtf(ss * (1.f / 64.f) + 1e-6f);
#pragma unroll
                        for (int e = 0; e < 8; ++e) v[e] = v[e] * rstd * (which ? gk[e] : gq[e]);
#pragma unroll
                        for (int e = 0; e < 4; ++e) { const float x0 = v[2 * e], x1 = v[2 * e + 1]; v[2 * e] = x0 * c4[i][e] - x1 * s4[i][e]; v[2 * e + 1] = x0 * s4[i][e] + x1 * c4[i][e]; }
                        *(bf16x8*)(P + which * 512 + lane * 8) = pack8(v);
                    } }
            }
        }
#pragma unroll 1
        for (int g = 0; g < 3; ++g) {
            const int c0 = g * 512 + lane * 8;
            float w[5][8];
#pragma unroll
            for (int j = 0; j < 5; ++j) { const f32x4 w0 = *(const f32x4*)(p.gdn_conv + j * 1536 + c0), w1 = *(const f32x4*)(p.gdn_conv + j * 1536 + c0 + 4);
#pragma unroll
                for (int e = 0; e < 4; ++e) { w[j][e] = w0[e]; w[j][4 + e] = w1[e]; } }
            const bf16_t* src = proj + (size_t)row0 * EV_NP + 1536 + c0;
            bf16x8 raw[RB + 4];
#pragma unroll
            for (int k = 0; k < RB + 4; ++k) { const int dt = k - 2; raw[k] = (bf16x8){0, 0, 0, 0, 0, 0, 0, 0};
                if (t0 + dt >= 0 && t0 + dt < len) raw[k] = *(const bf16x8*)(src + (ptrdiff_t)dt * EV_NP); }
            const float nsc = g == 0 ? 0.08838834764831845f : 1.f;
#pragma unroll
            for (int i = 0; i < RB; ++i) {
                float xm2[8], xm1[8], x0[8], xp1[8], xp2[8];
                unpack8(raw[i], xm2); unpack8(raw[i + 1], xm1); unpack8(raw[i + 2], x0); unpack8(raw[i + 3], xp1); unpack8(raw[i + 4], xp2);
                float y[8];
#pragma unroll
                for (int e = 0; e < 8; ++e) { y[e] = w[0][e] * xm2[e] + w[1][e] * xm1[e] + w[2][e] * x0[e] + w[3][e] * xp1[e] + w[4][e] * xp2[e]; y[e] = y[e] * __builtin_amdgcn_rcpf(1.f + __expf(-y[e])); }
                if (g < 2) { float ss = 0.f;
#pragma unroll
                    for (int e = 0; e < 8; ++e) ss += y[e] * y[e];
                    ss += __shfl_xor(ss, 1); ss += __shfl_xor(ss, 2); ss += __shfl_xor(ss, 4); ss += __shfl_xor(ss, 8);
                    const float sc_ = rsqrtf(ss + 1e-6f) * nsc;
#pragma unroll
                    for (int e = 0; e < 8; ++e) y[e] *= sc_; }
                *(bf16x8*)(qkvp + (size_t)(row0 + i) * 1536 + c0) = pack8(y);
            }
        }
#pragma unroll
        for (int k = 0; k < (RB * 16 + 63) / 64; ++k) { const int idx = lane + 64 * k, i = idx >> 4, gi = idx & 15; if (idx >= RB * 16) break;
            const float gvv = bf2f(proj[(size_t)(row0 + i) * EV_NP + 3584 + gi]); float o;
            if (gi < 8) o = 1.f / (1.f + expf(-gvv));
            else { const float z = gvv + p.gdn_dt_bias[gi - 8]; const float sp = z > 20.f ? z : log1pf(expf(z)); o = -expf(p.gdn_a_log[gi - 8]) * sp; }
            gbuf[(size_t)(row0 + i) * 16 + gi] = o; }
    }
}
__device__ __forceinline__ void prep0_phase(const Params& p) {
    const int lane0 = threadIdx.x & 63, wid = threadIdx.x >> 6;
    for (int blk = blockIdx.x * 8 + wid; blk < NLAT / 8; blk += gridDim.x * 8) prep0_block<8>(p, blk * 8, lane0);
    for (int r = blockIdx.x * 8 + wid; r < NCTX; r += gridDim.x * 8) prep0_block<1>(p, NLAT + r, lane0);
}

__device__ __forceinline__ int gdn_row(int b, int pc, int tau, int dir) {
    const int tt = dir ? 63 - tau : tau;
    return pc < 4 ? NLAT + b * CTXL + pc * 64 + tt : b * SEQ + (pc - 4) * 64 + tt;
}
__device__ __forceinline__ void gdn_pre_phase(const Params& p, unsigned char* lds) {
    const int lane = threadIdx.x & 63, wid = threadIdx.x >> 6;
    float* Lw = (float*)(lds + wid * 16896);
    float* gs = Lw + 4096; float* bs = gs + 64;
    const bf16_t* qkvp = (const bf16_t*)p.out;
    const float* gbuf = (const float*)(p.ws + WS_GATES);
    bf16_t* Tb = (bf16_t*)(p.ws + WS_T); bf16_t* Ab = (bf16_t*)(p.ws + WS_AQK);
    float* gv = (float*)(p.ws + WS_GV); float* bv = (float*)(p.ws + WS_BV);
    const int lane0 = lane;
    for (int cp = blockIdx.x * 8 + wid; cp < NCHUNKP; cp += gridDim.x * 8) {
        int lane = lane0; asm volatile("" : "+v"(lane));
        const int r32 = lane & 31, hi = lane >> 5;
        const int pc = cp % 132, ch = cp / 132, dir = ch & 1, h = (ch >> 1) & 3, b = ch >> 3;
        float g_keep, be_keep;
        { const int R = gdn_row(b, pc, lane, dir);
          float g = gbuf[(size_t)R * 16 + 8 + dir * 4 + h]; const float be = gbuf[(size_t)R * 16 + dir * 4 + h];
#pragma unroll
          for (int o = 1; o < 64; o <<= 1) { const float t = __shfl_up(g, o); if (lane >= o) g += t; }
          gs[lane] = g; bs[lane] = be; g_keep = g; be_keep = be; }
        bf16x8 kf[2][8], qf[2][8];
#pragma unroll
        for (int mi = 0; mi < 2; ++mi) { const size_t R = (size_t)gdn_row(b, pc, 32 * mi + r32, dir);
#pragma unroll
            for (int d0 = 0; d0 < 8; ++d0) { kf[mi][d0] = *(const bf16x8*)(qkvp + R * 1536 + 512 + h * 128 + d0 * 16 + hi * 8);
                                             qf[mi][d0] = *(const bf16x8*)(qkvp + R * 1536 + h * 128 + d0 * 16 + hi * 8); } }
        { const float gl_ = __shfl(g_keep, 63); gv[(size_t)cp * 64 + lane] = expf(g_keep); bv[(size_t)cp * 64 + lane] = be_keep; ((float*)(p.ws + WS_EL))[(size_t)cp * 64 + lane] = expf(gl_ - g_keep); }
        bf16_t* Ao = Ab + (size_t)cp * 4096;
#pragma unroll
        for (int mi = 0; mi < 2; ++mi) {
#pragma unroll
            for (int ni = 0; ni <= mi; ++ni) {
                f32x16 ckk = {}, cqk = {};
#pragma unroll
                for (int d0 = 0; d0 < 8; ++d0) { ckk = __builtin_amdgcn_mfma_f32_32x32x16_bf16(kf[mi][d0], kf[ni][d0], ckk, 0, 0, 0);
                                                 cqk = __builtin_amdgcn_mfma_f32_32x32x16_bf16(qf[mi][d0], kf[ni][d0], cqk, 0, 0, 0); }
                const int sg = 32 * ni + r32; const float gsg = gs[sg];
#pragma unroll
                for (int r = 0; r < 16; ++r) { const int tau = 32 * mi + crow(r, hi);
                    const float dec = tau >= sg ? __expf(gs[tau] - gsg) : 0.f;
                    Lw[tau * 64 + sg] = tau > sg ? bs[tau] * dec * ckk[r] : 0.f;
                    Ao[tau * 64 + sg] = f2bf(cqk[r] * dec); }
                asm volatile("" ::: "memory");
            }
        }
#pragma unroll
        for (int r = 0; r < 16; ++r) Ao[crow(r, hi) * 64 + 32 + r32] = 0;
        float Tc[64];
#pragma unroll
        for (int i = 0; i < 64; ++i) { float a = (i == lane) ? 1.f : 0.f;
#pragma unroll
            for (int j = 0; j < i; ++j) a -= Lw[i * 64 + j] * Tc[j];
            Tc[i] = a; asm volatile("" ::: "memory"); }
        bf16_t* To = Tb + (size_t)cp * 4096;
#pragma unroll
        for (int i = 0; i < 64; ++i) To[i * 64 + lane] = f2bf(Tc[i]);
    }
}

constexpr int G_KV = 0, G_QA = 16384, G_TT = 32768, G_AQ = G_TT + 9216, G_RT = G_AQ + 9216, G_UT = G_RT + 4608, G_UP = G_UT + 4608,
              G_ST = G_UP + 4608, G_VS = G_ST + 8704, G_GS = G_VS + 4096, G_BS = G_GS + 256, G_EL = G_BS + 256, G_END = G_EL + 256;
__device__ __forceinline__ void gdn_scan_phase(const Params& p, unsigned char* lds) {
    const int tid = threadIdx.x, lane0 = tid & 63, wid = tid >> 6;
    const bf16_t* qkvp = (const bf16_t*)p.out;
    const bf16_t* Tb = (const bf16_t*)(p.ws + WS_T); const bf16_t* Ab = (const bf16_t*)(p.ws + WS_AQK);
    const float* gv = (const float*)(p.ws + WS_GV); const float* bv = (const float*)(p.ws + WS_BV);
    bf16_t* obuf = (bf16_t*)(p.ws + WS_H);
    const float* gsl = (const float*)(lds + G_GS); const float* bsl = (const float*)(lds + G_BS); const float* esl = (const float*)(lds + G_EL);
    const int sr = tid >> 4, sc = (tid & 15) * 8;
    const int vblk = (gridDim.x % 8 == 0) ? (int)((blockIdx.x & 7) * (gridDim.x >> 3) + (blockIdx.x >> 3)) : (int)blockIdx.x;
    for (int wi = vblk; wi < 256; wi += gridDim.x) {
        const int chain = wi >> 2, cs = wi & 3, b = chain >> 3, h = (chain >> 1) & 3, dir = chain & 1;
        f32x16 Sacc = {};
        for (int i = tid; i < 8704 / 4; i += NTHREADS) ((unsigned*)(lds + G_ST))[i] = 0u;
        bf16x8 sk0, sk1, sq0, sq1, sT, sA, sV; float sg = 0.f;
#define GLOAD(step) do { const int pc_ = dir == 0 ? (step) : ((step) < 4 ? 3 - (step) : 4 + 127 - ((step) - 4)); \
        const size_t cp_ = (size_t)chain * 132 + pc_; \
        const size_t R0_ = (size_t)gdn_row(b, pc_, sr, dir), R1_ = (size_t)gdn_row(b, pc_, 32 + sr, dir); \
        sk0 = *(const bf16x8*)(qkvp + R0_ * 1536 + 512 + h * 128 + sc); sk1 = *(const bf16x8*)(qkvp + R1_ * 1536 + 512 + h * 128 + sc); \
        sq0 = *(const bf16x8*)(qkvp + R0_ * 1536 + h * 128 + sc); sq1 = *(const bf16x8*)(qkvp + R1_ * 1536 + h * 128 + sc); \
        sT = *(const bf16x8*)(Tb + cp_ * 4096 + tid * 8); sA = *(const bf16x8*)(Ab + cp_ * 4096 + tid * 8); \
        if (tid < 256) { const size_t Rv_ = (size_t)gdn_row(b, pc_, tid >> 2, dir); sV = *(const bf16x8*)(qkvp + Rv_ * 1536 + 1024 + h * 128 + cs * 32 + (tid & 3) * 8); } \
        if (tid < 64) sg = gv[cp_ * 64 + tid]; else if (tid < 128) sg = bv[cp_ * 64 + tid - 64]; else if (tid < 192) sg = ((const float*)(p.ws + WS_EL))[cp_ * 64 + tid - 128]; } while (0)
#define GWRITE() do { *(bf16x8*)(lds + G_KV + v_st(sr, sc)) = sk0; *(bf16x8*)(lds + G_KV + v_st(32 + sr, sc)) = sk1; \
        *(bf16x8*)(lds + G_QA + KSWZ(sr, sc * 2)) = sq0; *(bf16x8*)(lds + G_QA + KSWZ(32 + sr, sc * 2)) = sq1; \
        *(bf16x8*)(lds + G_TT + (tid >> 3) * 144 + (tid & 7) * 16) = sT; *(bf16x8*)(lds + G_AQ + (tid >> 3) * 144 + (tid & 7) * 16) = sA; \
        if (tid < 256) *(bf16x8*)(lds + G_VS + (tid >> 2) * 64 + (tid & 3) * 16) = sV; \
        if (tid < 192) ((float*)(lds + G_GS))[tid] = sg; } while (0)
        GLOAD(0);
        for (int step = 0; step < 132; ++step) {
            GWRITE();
            __syncthreads();
            if (step + 1 < 132) GLOAD(step + 1);
            int lane = lane0; asm volatile("" : "+v"(lane));
            const int r32 = lane & 31, hi = lane >> 5;
            const int vb0 = (int)(uintptr_t)(lds + G_KV) + v_rd_base(lane);
            const int pc = dir == 0 ? step : (step < 4 ? 3 - step : 4 + 127 - (step - 4));
            f32x16 acc = {};
            const int mi = wid & 1;
            if (wid < 4) {
                f32x16 acc2 = {};
                if (wid < 2) {
#pragma unroll
                    for (int d0 = 0; d0 < 8; d0 += 2) {
                        const bf16x8 a0 = *(const bf16x8*)(lds + G_KV + v_st(32 * mi + r32, d0 * 16 + hi * 8)), a1 = *(const bf16x8*)(lds + G_KV + v_st(32 * mi + r32, d0 * 16 + 16 + hi * 8));
                        const bf16x8 b0 = *(const bf16x8*)(lds + G_ST + r32 * 272 + (d0 * 16 + hi * 8) * 2), b1 = *(const bf16x8*)(lds + G_ST + r32 * 272 + (d0 * 16 + 16 + hi * 8) * 2);
                        acc = __builtin_amdgcn_mfma_f32_32x32x16_bf16(a0, b0, acc, 0, 0, 0);
                        acc2 = __builtin_amdgcn_mfma_f32_32x32x16_bf16(a1, b1, acc2, 0, 0, 0); }
                } else {
#pragma unroll
                    for (int d0 = 0; d0 < 8; d0 += 2) {
                        const bf16x8 a0 = *(const bf16x8*)(lds + G_QA + KSWZ(32 * mi + r32, (d0 * 16 + hi * 8) * 2)), a1 = *(const bf16x8*)(lds + G_QA + KSWZ(32 * mi + r32, (d0 * 16 + 16 + hi * 8) * 2));
                        const bf16x8 b0 = *(const bf16x8*)(lds + G_ST + r32 * 272 + (d0 * 16 + hi * 8) * 2), b1 = *(const bf16x8*)(lds + G_ST + r32 * 272 + (d0 * 16 + 16 + hi * 8) * 2);
                        acc = __builtin_amdgcn_mfma_f32_32x32x16_bf16(a0, b0, acc, 0, 0, 0);
                        acc2 = __builtin_amdgcn_mfma_f32_32x32x16_bf16(a1, b1, acc2, 0, 0, 0); }
                }
#pragma unroll
                for (int r = 0; r < 16; ++r) acc[r] += acc2[r];
                if (wid < 2) {
#pragma unroll
                    for (int g4 = 0; g4 < 4; ++g4) { float rv[4];
#pragma unroll
                        for (int j = 0; j < 4; ++j) { const int tau = 32 * mi + 8 * g4 + 4 * hi + j;
                            const float vv = bf2f(*(const bf16_t*)(lds + G_VS + tau * 64 + r32 * 2));
                            rv[j] = bsl[tau] * (vv - gsl[tau] * acc[g4 * 4 + j]); }
                        u32x2 w; w.x = cvtpk(rv[0], rv[1]); w.y = cvtpk(rv[2], rv[3]);
                        *(u32x2*)(lds + G_RT + r32 * 144 + (32 * mi + 8 * g4 + 4 * hi) * 2) = w; }
                } else {
#pragma unroll
                    for (int r = 0; r < 16; ++r) acc[r] *= gsl[32 * mi + crow(r, hi)];
                }
            }
            __syncthreads();
            if (wid < 2) {
                f32x16 u = {}, u2 = {};
#pragma unroll
                for (int s = 0; s < 4; s += 2) {
                    const bf16x8 a0 = *(const bf16x8*)(lds + G_TT + (32 * mi + r32) * 144 + (16 * s + hi * 8) * 2), a1 = *(const bf16x8*)(lds + G_TT + (32 * mi + r32) * 144 + (16 * s + 16 + hi * 8) * 2);
                    const bf16x8 b0 = *(const bf16x8*)(lds + G_RT + r32 * 144 + (16 * s + hi * 8) * 2), b1 = *(const bf16x8*)(lds + G_RT + r32 * 144 + (16 * s + 16 + hi * 8) * 2);
                    u = __builtin_amdgcn_mfma_f32_32x32x16_bf16(a0, b0, u, 0, 0, 0);
                    u2 = __builtin_amdgcn_mfma_f32_32x32x16_bf16(a1, b1, u2, 0, 0, 0); }
#pragma unroll
                for (int r = 0; r < 16; ++r) u[r] += u2[r];
#pragma unroll
                for (int g4 = 0; g4 < 4; ++g4) { float uv[4], up[4];
#pragma unroll
                    for (int j = 0; j < 4; ++j) { const int tau = 32 * mi + 8 * g4 + 4 * hi + j; uv[j] = u[g4 * 4 + j]; up[j] = uv[j] * esl[tau]; }
                    u32x2 w; w.x = cvtpk(uv[0], uv[1]); w.y = cvtpk(uv[2], uv[3]);
                    *(u32x2*)(lds + G_UT + r32 * 144 + (32 * mi + 8 * g4 + 4 * hi) * 2) = w;
                    u32x2 w2; w2.x = cvtpk(up[0], up[1]); w2.y = cvtpk(up[2], up[3]);
                    *(u32x2*)(lds + G_UP + r32 * 144 + (32 * mi + 8 * g4 + 4 * hi) * 2) = w2; }
            }
            __syncthreads();
            if (wid == 2 || wid == 3) {
#pragma unroll
                for (int s = 0; s < 4; ++s) {
                    const bf16x8 a = *(const bf16x8*)(lds + G_AQ + (32 * mi + r32) * 144 + (16 * s + hi * 8) * 2);
                    const bf16x8 bb = *(const bf16x8*)(lds + G_UT + r32 * 144 + (16 * s + hi * 8) * 2);
                    acc = __builtin_amdgcn_mfma_f32_32x32x16_bf16(a, bb, acc, 0, 0, 0); }
#pragma unroll
                for (int r = 0; r < 16; ++r) { const size_t R = (size_t)gdn_row(b, pc, 32 * mi + crow(r, hi), dir);
                    obuf[((size_t)dir * MTOT + R) * 512 + h * 128 + cs * 32 + r32] = f2bf(acc[r]); }
            } else if (wid >= 4) {
                const float gl = gsl[63];
#pragma unroll
                for (int r = 0; r < 16; ++r) Sacc[r] *= gl;
                const bf16x8 pa0 = *(const bf16x8*)(lds + G_UP + r32 * 144 + (0 + hi * 8) * 2), pa1 = *(const bf16x8*)(lds + G_UP + r32 * 144 + (16 + hi * 8) * 2),
                             pa2 = *(const bf16x8*)(lds + G_UP + r32 * 144 + (32 + hi * 8) * 2), pa3 = *(const bf16x8*)(lds + G_UP + r32 * 144 + (48 + hi * 8) * 2);
                const int d0 = wid - 4;
                if (d0 == 0) pv_one<0>(Sacc, vb0, pa0, pa1, pa2, pa3); else if (d0 == 1) pv_one<1>(Sacc, vb0, pa0, pa1, pa2, pa3);
                else if (d0 == 2) pv_one<2>(Sacc, vb0, pa0, pa1, pa2, pa3); else pv_one<3>(Sacc, vb0, pa0, pa1, pa2, pa3);
#pragma unroll
                for (int r = 0; r < 16; ++r) *(bf16_t*)(lds + G_ST + crow(r, hi) * 272 + (32 * d0 + r32) * 2) = f2bf(Sacc[r]);
            }
            __syncthreads();
        }
#undef GLOAD
#undef GWRITE
    }
}

__device__ __forceinline__ void gdn_post_phase(const Params& p) {
    const int lane = threadIdx.x & 63, wid = threadIdx.x >> 6;
    const bf16_t* obuf = (const bf16_t*)(p.ws + WS_H);
    const bf16_t* proj = (const bf16_t*)(p.ws + WS_PROJ);
    bf16_t* mix = (bf16_t*)(p.ws + WS_MIX);
    const int d = (lane & 15) * 8;
    for (int row = blockIdx.x * 8 + wid; row < MTOT; row += gridDim.x * 8) {
        float a[8], bb[8], g[8], y[8];
        unpack8(*(const bf16x8*)(obuf + (size_t)row * 512 + lane * 8), a);
        unpack8(*(const bf16x8*)(obuf + ((size_t)MTOT + row) * 512 + lane * 8), bb);
        unpack8(*(const bf16x8*)(proj + (size_t)row * EV_NP + 3072 + lane * 8), g);
        float ss = 0.f;
#pragma unroll
        for (int i = 0; i < 8; ++i) { a[i] += bb[i]; ss += a[i] * a[i]; }
        ss += __shfl_xor(ss, 1); ss += __shfl_xor(ss, 2); ss += __shfl_xor(ss, 4); ss += __shfl_xor(ss, 8);
        const float rstd = rsqrtf(ss * (1.f / 128.f) + 1e-6f);
#pragma unroll
        for (int i = 0; i < 8; ++i) y[i] = a[i] * rstd * p.gdn_norm[d + i] * (g[i] * __builtin_amdgcn_rcpf(1.f + __expf(-g[i])));
        *(bf16x8*)(mix + (size_t)row * DM + 512 + lane * 8) = pack8(y);
    }
}

__device__ __forceinline__ void diffattn_phase(const Params& p, unsigned char* lds) {
    const int tid = threadIdx.x, wid = tid >> 6, lane = tid & 63, r32 = lane & 31, hi = lane >> 5;
    const bf16_t* proj = (const bf16_t*)(p.ws + WS_PROJ);
    bf16_t* mix = (bf16_t*)(p.ws + WS_MIX);
    float s01 = 0.f, s23 = 0.f;
    for (int i = 0; i < 64; ++i) { s01 += p.diff_lambda[i] * p.diff_lambda[64 + i]; s23 += p.diff_lambda[128 + i] * p.diff_lambda[192 + i]; }
    const float lam = expf(s01) - expf(s23) + 0.2f;
    float* X = (float*)lds; float* li = (float*)(lds + 131072) + wid * 64;
    LAS unsigned char* ldsl = (LAS unsigned char*)lds;
    int koff[2], voff[2];
#pragma unroll
    for (int i = 0; i < 2; ++i) {
        const int g = i * 512 + tid;
        { const int row = g >> 4, cg = (g & 15) ^ (row & 7); koff[i] = row * EV_NP + cg * 8; }
        { const int o = g * 16, st = o >> 9, w = o & 511, kk = (st >> 2) * 8 + (w >> 6);
          const int k = (kk & ~0xC) | ((kk & 4) << 1) | ((kk & 8) >> 1), cc = (st & 3) * 32 + ((w & 63) >> 4) * 8; voff[i] = k * EV_NP + cc; }
    }
    const int vbase = (int)(uintptr_t)lds + v_rd_base(lane);
    const int map = wid >> 2, wq = wid & 3;
    unsigned char* Qs = lds + 98304 + wid * 4096 + lane * 16;
    const int vblk = (gridDim.x % 8 == 0) ? (int)((blockIdx.x & 7) * (gridDim.x >> 3) + (blockIdx.x >> 3)) : (int)blockIdx.x;
    for (int it = vblk; it < 2112; it += gridDim.x) {
        int b, h, NT, qrow0;
        if (it < 2048) { b = it >> 8; h = (it >> 6) & 3; const int qb = it & 63; NT = 132; qrow0 = b * SEQ + qb * 128; }
        else { const int j = it - 2048; b = j >> 3; h = (j >> 1) & 3; NT = 4; qrow0 = NLAT + b * CTXL + (j & 1) * 128; }
        bf16x8 qr[4];
        { const bf16_t* qp = proj + (size_t)(qrow0 + 32 * wq + r32) * EV_NP + h * 128 + map * 64 + hi * 8;
#pragma unroll
          for (int d0 = 0; d0 < 4; ++d0) qr[d0] = *(const bf16x8*)(qp + d0 * 16); }
        f32x16 o[4] = {}; float lsum = 0.f;
#define DDMA(j, bo) do { const bf16_t* pp_ = proj + (size_t)((j) < 4 ? NLAT + b * CTXL + 64 * (j) : b * SEQ + 64 * ((j) - 4)) * EV_NP + h * 128; \
        _Pragma("unroll") for (int i_ = 0; i_ < 2; ++i_) { \
            __builtin_amdgcn_global_load_lds((const unsigned*)(pp_ + 1024 + voff[i_]), (LAS unsigned*)(ldsl + (bo) + i_ * 8192 + wid * 1024), 16, 0, 0); \
            __builtin_amdgcn_global_load_lds((const unsigned*)(pp_ + 512 + koff[i_]), (LAS unsigned*)(ldsl + (bo) + 16384 + i_ * 8192 + wid * 1024), 16, 0, 0); } } while (0)
#define DQK(P0, P1, bo) do { P0 = (f32x16){}; P1 = (f32x16){}; const unsigned char* Ks_ = lds + (bo) + 16384; \
        _Pragma("unroll") for (int d0 = 0; d0 < 4; ++d0) { const int cb_ = (map * 64 + d0 * 16 + hi * 8) * 2; \
            const bf16x8 b0_ = *(const bf16x8*)(Ks_ + KSWZ(r32, cb_)), b1_ = *(const bf16x8*)(Ks_ + KSWZ(32 + r32, cb_)); \
            P0 = __builtin_amdgcn_mfma_f32_32x32x16_bf16(b0_, qr[d0], P0, 0, 0, 0); \
            P1 = __builtin_amdgcn_mfma_f32_32x32x16_bf16(b1_, qr[d0], P1, 0, 0, 0); } } while (0)
#define DSM(P0, P1) do { _Pragma("unroll") for (int r = 0; r < 16; ++r) { P0[r] = __builtin_amdgcn_exp2f(P0[r]); P1[r] = __builtin_amdgcn_exp2f(P1[r]); lsum += P0[r] + P1[r]; } \
        PK4(P0, 0, pa0); PK4(P0, 8, pa1); PK4(P1, 0, pa2); PK4(P1, 8, pa3); } while (0)
#define DTAIL_() asm volatile("s_waitcnt vmcnt(0)" ::: "memory"); __syncthreads(); { const int t_ = bprev; bprev = bcur; bcur = bnext; bnext = t_; }
#define DSTEP_A(N0, N1, O0, O1, j) do { if ((j) + 1 < NT) DDMA((j) + 1, bnext); \
        DQK(N0, N1, bcur); DSM(O0, O1); pv_d0(o, vbase + bprev, pa0, pa1, pa2, pa3); DTAIL_() } while (0)
#define DSTEP_B(N0, N1, O0, O1, j) do { if ((j) + 1 < NT) DDMA((j) + 1, bnext); \
        DSM(O0, O1); pv_d0(o, vbase + bprev, pa0, pa1, pa2, pa3); SBAR(); DQK(N0, N1, bcur); DTAIL_() } while (0)
        f32x16 pA0, pA1, pB0, pB1; bf16x8 pa0, pa1, pa2, pa3;
        DDMA(0, 0); DDMA(1, 32768); asm volatile("s_waitcnt vmcnt(0)" ::: "memory"); __syncthreads();
        DQK(pA0, pA1, 0);
        int bprev = 0, bcur = 32768, bnext = 65536;
        if (map == 0) {
            for (int j = 1; j + 1 < NT; j += 2) { DSTEP_A(pB0, pB1, pA0, pA1, j); DSTEP_A(pA0, pA1, pB0, pB1, j + 1); }
            DSTEP_A(pB0, pB1, pA0, pA1, NT - 1);
        } else {
            for (int j = 1; j + 1 < NT; j += 2) { DSTEP_B(pB0, pB1, pA0, pA1, j); DSTEP_B(pA0, pA1, pB0, pB1, j + 1); }
            DSTEP_B(pB0, pB1, pA0, pA1, NT - 1);
        }
        DSM(pB0, pB1); pv_d0(o, vbase + bprev, pa0, pa1, pa2, pa3);
        __syncthreads();
#undef DDMA
#undef DQK
#undef DSM
#undef DSTEP_A
#undef DSTEP_B
#undef DTAIL_
        const float lt = halfswap_add(lsum);
        if (hi == 0) li[r32] = lt;
        asm volatile("s_waitcnt lgkmcnt(0)" ::: "memory");
        float rli[16];
#pragma unroll
        for (int r = 0; r < 16; ++r) rli[r] = __builtin_amdgcn_rcpf(li[crow(r, hi)]);
        if (map == 1) {
#pragma unroll
            for (int d0 = 0; d0 < 4; ++d0)
#pragma unroll
                for (int r = 0; r < 16; ++r) X[(wq * 64 + d0 * 16 + r) * 64 + lane] = o[d0][r] * rli[r] * lam;
        }
        __syncthreads();
        if (map == 0) {
#pragma unroll
            for (int d0 = 0; d0 < 4; ++d0)
#pragma unroll
                for (int r = 0; r < 16; ++r) o[d0][r] = o[d0][r] * rli[r] - X[(wq * 64 + d0 * 16 + r) * 64 + lane];
#pragma unroll
            for (int r = 0; r < 16; ++r) {
                float ss = o[0][r] * o[0][r] + o[1][r] * o[1][r] + o[2][r] * o[2][r] + o[3][r] * o[3][r];
                ss += __shfl_xor(ss, 1); ss += __shfl_xor(ss, 2); ss += __shfl_xor(ss, 4); ss += __shfl_xor(ss, 8); ss += __shfl_xor(ss, 16);
                const float rstd = rsqrtf(ss * (1.f / 128.f) + 1e-6f) * 0.8f;
                bf16_t* mp = mix + (size_t)(qrow0 + 32 * wq + crow(r, hi)) * DM + h * 128 + r32;
#pragma unroll
                for (int d0 = 0; d0 < 4; ++d0) mp[32 * d0] = f2bf(o[d0][r] * rstd * p.diff_subln[32 * d0 + r32]);
            }
        }
        __syncthreads();
    }
}

__device__ __forceinline__ void natten_phase(const Params& p, unsigned char* lds) {
    const int tid = threadIdx.x, wid = tid >> 6, lane = tid & 63, r32 = lane & 31, hi = lane >> 5;
    const bf16_t* proj = (const bf16_t*)(p.ws + WS_PROJ);
    bf16_t* mix = (bf16_t*)(p.ws + WS_MIX);
    constexpr float L2E = 1.4426950408889634f;
    unsigned char* Vl = lds; unsigned char* Kl = lds + 32768;
    float* rpbs = (float*)(lds + 65536);
    float* li = (float*)(lds + 133120) + wid * 64;
    unsigned char* Qs = lds + 67584 + wid * 8192 + lane * 16;
    const int sr = tid >> 4, sc = (tid & 15) * 8, vst0 = v_st(sr, sc), vst1 = v_st(32 + sr, sc);
    const int vb0 = (int)(uintptr_t)Vl + v_rd_base(lane);
    const float* gkp = p.na_qk_gain + 128 + sc;
    const int vblk = (gridDim.x % 8 == 0) ? (int)((blockIdx.x & 7) * (gridDim.x >> 3) + (blockIdx.x >> 3)) : (int)blockIdx.x;
    for (int it = vblk; it < 2048; it += gridDim.x) {
        const int b = it >> 8, h = (it >> 5) & 7, rq = it & 31;
        const int grow = 4 * rq + (wid >> 1), qc = (wid & 1) * 32 + r32;
        const size_t qR = (size_t)b * SEQ + grow * 64 + qc;
        for (int i = tid; i < 465; i += NTHREADS) rpbs[i] = p.na_rpb[h * 465 + i] * L2E;
        { float ss = 0.f;
#pragma unroll
          for (int d0 = 0; d0 < 8; ++d0) { float qv[8]; unpack8(*(const bf16x8*)(proj + qR * OD_N + h * 128 + d0 * 16 + hi * 8), qv);
#pragma unroll
              for (int i = 0; i < 8; ++i) ss += qv[i] * qv[i]; }
          ss = halfswap_add(ss);
          const float rs = rsqrtf(ss * (1.f / 128.f) + 1e-6f) * 0.08838834764831845f * L2E;
#pragma unroll
          for (int d0 = 0; d0 < 8; ++d0) { float qv[8]; unpack8(*(const bf16x8*)(proj + qR * OD_N + h * 128 + d0 * 16 + hi * 8), qv);
#pragma unroll
              for (int i = 0; i < 8; ++i) qv[i] *= rs * p.na_qk_gain[d0 * 16 + hi * 8 + i];
              *(bf16x8*)(Qs + d0 * 1024) = pack8(qv); } }
        int lo = 4 * rq - 4; lo = lo < 0 ? 0 : (lo > 120 ? 120 : lo);
        int hi_r = 4 * rq + 3 - 4; hi_r = hi_r < 0 ? 0 : (hi_r > 120 ? 120 : hi_r); hi_r += 7;
        const int nlat = hi_r - lo + 1, NT = nlat + 4;
        int wsr = grow - 4; wsr = wsr < 0 ? 0 : (wsr > 120 ? 120 : wsr);
        int cst = qc - 8; cst = cst < 0 ? 0 : (cst > 48 ? 48 : cst);
        f32x16 o[4] = {}; float lsum = 0.f;
        bf16x8 vs0, vs1, ks0, ks1;
#define NLOAD(j) do { const size_t R0_ = (size_t)((j) < nlat ? b * SEQ + (lo + (j)) * 64 : NLAT + b * CTXL + 64 * ((j) - nlat)) + sr; \
        const bf16_t* pp_ = proj + R0_ * OD_N + h * 128 + sc; \
        vs0 = *(const bf16x8*)(pp_ + 2048); vs1 = *(const bf16x8*)(pp_ + 2048 + (size_t)32 * OD_N); \
        ks0 = *(const bf16x8*)(pp_ + 1024); ks1 = *(const bf16x8*)(pp_ + 1024 + (size_t)32 * OD_N); } while (0)
#define KNORM(kx) do { float f_[8]; unpack8(kx, f_); float ss_ = 0.f; _Pragma("unroll") for (int i_ = 0; i_ < 8; ++i_) ss_ += f_[i_] * f_[i_]; \
        ss_ += __shfl_xor(ss_, 1); ss_ += __shfl_xor(ss_, 2); ss_ += __shfl_xor(ss_, 4); ss_ += __shfl_xor(ss_, 8); \
        const float rs_ = rsqrtf(ss_ * (1.f / 128.f) + 1e-6f); _Pragma("unroll") for (int i_ = 0; i_ < 8; ++i_) f_[i_] *= rs_ * gkp[i_]; kx = pack8(f_); } while (0)
#define NWRITE(bf) do { KNORM(ks0); KNORM(ks1); *(bf16x8*)(Vl + (bf) * 16384 + vst0) = vs0; *(bf16x8*)(Vl + (bf) * 16384 + vst1) = vs1; \
        *(bf16x8*)(Kl + (bf) * 16384 + KSWZ(sr, sc * 2)) = ks0; *(bf16x8*)(Kl + (bf) * 16384 + KSWZ(32 + sr, sc * 2)) = ks1; } while (0)
        NLOAD(0); NWRITE(0); __syncthreads();
        for (int j = 0; j < NT; ++j) {
            if (j + 1 < NT) NLOAD(j + 1);
            const int bf = j & 1;
            const bool islat = j < nlat; const int kr = lo + j;
            const bool active = !islat || (kr >= wsr && kr <= wsr + 7);
            if (active) {
                f32x16 p0 = {}, p1 = {};
                const unsigned char* Ks = Kl + bf * 16384;
#pragma unroll
                for (int d0 = 0; d0 < 8; ++d0) { const int cb = (d0 * 16 + hi * 8) * 2;
                    const bf16x8 b0 = *(const bf16x8*)(Ks + KSWZ(r32, cb)), b1 = *(const bf16x8*)(Ks + KSWZ(32 + r32, cb));
                    const bf16x8 qd = *(const bf16x8*)(Qs + d0 * 1024);
                    p0 = __builtin_amdgcn_mfma_f32_32x32x16_bf16(b0, qd, p0, 0, 0, 0);
                    p1 = __builtin_amdgcn_mfma_f32_32x32x16_bf16(b1, qd, p1, 0, 0, 0); }
                if (islat) {
                    const float* rb = rpbs + (kr - grow + 7) * 31 + 15 - qc + 4 * hi;
                    const int mofs = 4 * hi - cst;
#pragma unroll
                    for (int r = 0; r < 16; ++r) {
                        const int kb = (r & 3) + 8 * (r >> 2);
                        const float e0 = __builtin_amdgcn_exp2f(p0[r] + rb[kb]), e1 = __builtin_amdgcn_exp2f(p1[r] + rb[32 + kb]);
                        p0[r] = ((unsigned)(kb + mofs) < 16u) ? e0 : 0.f; p1[r] = ((unsigned)(32 + kb + mofs) < 16u) ? e1 : 0.f;
                        lsum += p0[r] + p1[r]; }
                } else {
#pragma unroll
                    for (int r = 0; r < 16; ++r) { p0[r] = __builtin_amdgcn_exp2f(p0[r]); p1[r] = __builtin_amdgcn_exp2f(p1[r]); lsum += p0[r] + p1[r]; }
                }
                bf16x8 pa0, pa1, pa2, pa3;
                PK4(p0, 0, pa0); PK4(p0, 8, pa1); PK4(p1, 0, pa2); PK4(p1, 8, pa3);
                pv_d0(o, vb0 + bf * 16384, pa0, pa1, pa2, pa3);
            }
            if (j + 1 < NT) NWRITE((j + 1) & 1);
            __syncthreads();
        }
#undef NLOAD
#undef KNORM
#undef NWRITE
        const float lt = halfswap_add(lsum);
        if (hi == 0) li[r32] = lt;
        asm volatile("s_waitcnt lgkmcnt(0)" ::: "memory");
#pragma unroll
        for (int r = 0; r < 16; ++r) { const float rl = __builtin_amdgcn_rcpf(li[crow(r, hi)]);
            bf16_t* mp = mix + ((size_t)b * SEQ + grow * 64 + (wid & 1) * 32 + crow(r, hi)) * DM + h * 128 + r32;
#pragma unroll
            for (int d0 = 0; d0 < 4; ++d0) mp[32 * d0] = f2bf(o[d0][r] * rl); }
        __syncthreads();
    }
}

#define XB_TMO      128
#define XB_XCNT(j)  (256  + 64 * (j))
#define XB_XSUB(j)  (1280 + 64 * (j))
#define XB_XGEN(j)  (2304 + 64 * (j))
#define XB_TOP      3328
#define XB_TOPGEN   3392
#define XCD_BAR_WORDS 3456
#define XB_SPIN_CAP (1u << 22)
__device__ __forceinline__ unsigned xb_ld(unsigned* p)              { return __hip_atomic_load(p, __ATOMIC_RELAXED, __HIP_MEMORY_SCOPE_AGENT); }
__device__ __forceinline__ unsigned xb_add(unsigned* p, unsigned v) { return __hip_atomic_fetch_add(p, v, __ATOMIC_RELAXED, __HIP_MEMORY_SCOPE_AGENT); }
__device__ __forceinline__ unsigned xb_xcc_id() { return (unsigned)__builtin_amdgcn_s_getreg((3 << 11) | 20) & 0xFu; }
#define XB_SPIN(cond, bar) do { unsigned _sp = 0; while (cond) { __builtin_amdgcn_s_sleep(1); \
    if ((++_sp & 255u) == 0u) { if (xb_ld(&(bar)[XB_TMO])) break; if (_sp > XB_SPIN_CAP) { atomicAdd(&(bar)[XB_TMO], 1u); break; } } } } while (0)
struct XcdBarrier { unsigned* bar; unsigned x; volatile LAS unsigned* st; };
__device__ __forceinline__ XcdBarrier xcd_barrier_post(unsigned* bar, volatile LAS unsigned* st) {
    XcdBarrier b; b.bar = bar; b.x = xb_xcc_id(); b.st = st;
    if (threadIdx.x == 0) (void)xb_add(&bar[XB_XCNT(b.x)], 1u);
    return b;
}
__device__ __forceinline__ void xcd_barrier_complete(unsigned* bar, unsigned x, unsigned& nloc, unsigned& nx) {
    const unsigned G = gridDim.x * gridDim.y * gridDim.z;
    unsigned sum, cnt, mine, sp = 0u;
    for (;;) {
        sum = 0u; cnt = 0u; mine = 0u;
#pragma unroll
        for (unsigned j = 0; j < 16; ++j) { const unsigned c = xb_ld(&bar[XB_XCNT(j)]); sum += c; cnt += (c > 0u) ? 1u : 0u; mine = (j == x) ? c : mine; }
        if (sum == G) break;
        __builtin_amdgcn_s_sleep(1);
        if ((++sp & 255u) == 0u) { if (xb_ld(&bar[XB_TMO])) break; if (sp > XB_SPIN_CAP) { atomicAdd(&bar[XB_TMO], 1u); break; } }
    }
    nloc = mine > 0u ? mine : 1u; nx = cnt > 0u ? cnt : 1u;
}
__device__ __forceinline__ void xcd_barrier(const XcdBarrier& b) {
    asm volatile("s_waitcnt vmcnt(0)" ::: "memory");
    __syncthreads();
    if (threadIdx.x == 0) {
        unsigned* bar = b.bar;
        __builtin_amdgcn_s_waitcnt(0);
        unsigned nloc = b.st[0], nx = b.st[1];
        if (nloc == 0u) { xcd_barrier_complete(bar, b.x, nloc, nx); b.st[0] = nloc; b.st[1] = nx; }
        const unsigned old = xb_add(&bar[XB_XSUB(b.x)], 1u);
        const unsigned gen = old / nloc;
        if (old + 1u == (gen + 1u) * nloc) {
            __builtin_amdgcn_fence(__ATOMIC_RELEASE, "agent");
            asm volatile("s_waitcnt vmcnt(0)" ::: "memory");
            const unsigned og = xb_add(&bar[XB_TOP], 1u);
            const unsigned tg = og / nx;
            if (og + 1u == (tg + 1u) * nx) xb_add(&bar[XB_TOPGEN], 1u);
            else XB_SPIN(xb_ld(&bar[XB_TOPGEN]) == tg, bar);
            __builtin_amdgcn_fence(__ATOMIC_ACQUIRE, "agent");
            xb_add(&bar[XB_XGEN(b.x)], 1u);
            asm volatile("s_waitcnt vmcnt(0)" ::: "memory");
        } else {
            XB_SPIN(xb_ld(&bar[XB_XGEN(b.x)]) == gen, bar);
            __builtin_amdgcn_fence(__ATOMIC_ACQUIRE, "agent");
            asm volatile("s_waitcnt vmcnt(0)" ::: "memory");
        }
    }
    __syncthreads();
}

#ifndef PROBE_REP
#define PROBE_REP 0
#endif
#define REP(k) for (int rep_ = 0; rep_ < (((PROBE_REP >> (k)) & 1) ? 2 : 1); ++rep_)
constexpr int NPH = 18;
__global__ void __launch_bounds__(NTHREADS, 2) fwd_megakernel(Params p) {
    extern __shared__ __attribute__((aligned(16))) unsigned char lds[];
    cg::grid_group grid = cg::this_grid();
    LAS unsigned char* ldsl = (LAS unsigned char*)lds;
    const int lo = p.ph_lo, hi = p.ph_hi;
#ifdef ONLY_PH
#define IN(k) (((ONLY_PH >> (k)) & 1) && lo <= (k) && (k) < hi)
#else
#define IN(k) (lo <= (k) && (k) < hi)
#endif
#define SEAM(k) do { if (IN(k) && IN((k) + 1)) { if (p.ph_lo < 0) grid.sync();   { XcdBarrier xb_; xb_.bar = (unsigned*)(p.ws + WS_BAR); xb_.x = xb_xcc_id(); xb_.st = (volatile LAS unsigned*)(ldsl + 135168); xcd_barrier(xb_); } } } while (0)
    unsigned char* ws = p.ws;
    const bf16_t* H = (const bf16_t*)(ws + WS_H);
    bf16_t* PROJ = (bf16_t*)(ws + WS_PROJ);
    const bf16_t* MIX = (const bf16_t*)(ws + WS_MIX);
    float* CTXRES = (float*)(ws + WS_CTXRES);
    const float* MOD = (const float*)(ws + WS_MOD);
    const int G = gridDim.x, c = blockIdx.x;
    if (threadIdx.x < 4) ((volatile LAS unsigned*)(ldsl + 135168))[threadIdx.x] = 0u;
    __syncthreads();
    (void)xcd_barrier_post((unsigned*)(ws + WS_BAR), (volatile LAS unsigned*)(ldsl + 135168));

    if (IN(0)) REP(0) { ada_phase(p, lds); wconv_phase(p, lds);
        { float* rc = (float*)(ws + WS_ROPE); float* rs = rc + SEQ * 32;
          for (int e = blockIdx.x * NTHREADS + threadIdx.x; e < SEQ * 32; e += gridDim.x * NTHREADS) { const int t = e >> 5, pp = e & 31;
              const float inv = powf(10000.f, -(float)(pp & 15) / 16.f); const float ang = (pp < 16 ? (float)(t >> 6) : (float)(t & 63)) * inv;
              rc[e] = cosf(ang); rs[e] = sinf(ang); } } }
    SEAM(0);
    if (IN(1)) REP(1) norm_phase(p, p.x, p.ctx, 0, 0, MTOT);
    SEAM(1);
    if (IN(2)) REP(2) { pg8::Gemm g{H, (const bf16_t*)(ws + WS_W_EVIN), MTOT, EV_NP, DM}; pg8::StaticOrderT<264, 15> S; S.init(MTOT, EV_NP, G, c);
        pg8::EpiBf16 E{PROJ, EV_NP, EV_N}; pg8::gemm_phase(ldsl, g, S, E); }
    SEAM(2);
    if (IN(3)) prep0_phase(p);
    SEAM(3);
    if (IN(4)) REP(4) gdn_pre_phase(p, lds);
    SEAM(4);
    if (IN(5)) {
#ifndef SKIP_SCAN
        REP(20) { gdn_scan_phase(p, lds); __syncthreads(); }
#endif
#ifndef SKIP_DA
        REP(5) { diffattn_phase(p, lds); __syncthreads(); }
#endif
    }
    SEAM(5);
    if (IN(6)) REP(6) gdn_post_phase(p);
    SEAM(6);
    if (IN(7)) REP(7) { pg8::Gemm g{MIX, (const bf16_t*)(ws + WS_W_EVOUT), MTOT, DM, DM}; pg8::StaticOrderT<264, 4> S; S.init(MTOT, DM, G, c);
        pg8::EpiResid E{p.x, p.ctx, p.out, CTXRES, MOD, 2048}; pg8::gemm_phase(ldsl, g, S, E); }
    SEAM(7);
    if (IN(8)) norm_phase(p, p.out, CTXRES, 0, 1, MTOT);
    SEAM(8);
    if (IN(9)) REP(9) { pg8::Gemm g{H, (const bf16_t*)(ws + WS_W_FFIN), MTOT, 2 * FF, DM}; pg8::StaticOrderT<264, 22> S; S.init(MTOT, 2 * FF, G, c);
        pg8::EpiSwiglu E{PROJ, FF}; pg8::gemm_phase(ldsl, g, S, E); }
    SEAM(9);
    if (IN(10)) { pg8::Gemm g{PROJ, (const bf16_t*)(ws + WS_W_FFOUT), MTOT, DM, FF}; pg8::StaticOrderT<264, 4> S; S.init(MTOT, DM, G, c);
        pg8::EpiResid E{p.out, CTXRES, p.out, CTXRES, MOD, 5120}; pg8::gemm_phase(ldsl, g, S, E); }
    SEAM(10);
    if (IN(11)) norm_phase(p, p.out, CTXRES, 1, 0, MTOT);
    SEAM(11);
    if (IN(12)) { pg8::Gemm g{H, (const bf16_t*)(ws + WS_W_ODIN), MTOT, OD_N, DM}; pg8::StaticOrderT<264, 12> S; S.init(MTOT, OD_N, G, c);
        pg8::EpiBf16 E{PROJ, OD_N, OD_N}; pg8::gemm_phase(ldsl, g, S, E); }
    SEAM(12);
    if (IN(13)) { natten_phase(p, lds); if ((PROBE_REP >> 13) & 1) { __syncthreads(); natten_phase(p, lds); } }
    SEAM(13);
    if (IN(14)) { pg8::Gemm g{MIX, (const bf16_t*)(ws + WS_W_ODOUT), NLAT, DM, DM}; pg8::StaticOrderT<256, 4> S; S.init(NLAT, DM, G, c);
        pg8::EpiResid E{p.out, CTXRES, p.out, CTXRES, MOD + 9 * 6144, 2048}; pg8::gemm_phase(ldsl, g, S, E); }
    SEAM(14);
    if (IN(15)) norm_phase(p, p.out, CTXRES, 1, 1, NLAT);
    SEAM(15);
    if (IN(16)) { pg8::Gemm g{H, (const bf16_t*)(ws + WS_W_FFIN) + (size_t)2 * FF * DM, NLAT, 2 * FF, DM}; pg8::StaticOrderT<256, 22> S; S.init(NLAT, 2 * FF, G, c);
        pg8::EpiSwiglu E{PROJ, FF}; pg8::gemm_phase(ldsl, g, S, E); }
    SEAM(16);
    if (IN(17)) { pg8::Gemm g{PROJ, (const bf16_t*)(ws + WS_W_FFOUT) + (size_t)DM * FF, NLAT, DM, FF}; pg8::StaticOrderT<256, 4> S; S.init(NLAT, DM, G, c);
        pg8::EpiResid E{p.out, CTXRES, p.out, CTXRES, MOD + 9 * 6144, 5120}; pg8::gemm_phase(ldsl, g, S, E); }
#undef IN
#undef SEAM
}

extern "C" void kernel_launch(void* const* d_in, const int* in_sizes, int n_in, void* d_out, int out_size, void* d_ws, size_t ws_size, hipStream_t stream) {
    static int grid = 0;
    if (grid == 0) {
        if (n_in != 23 || ws_size < WS_END) { fprintf(stderr, "kernel_launch: n_in %d ws %zu (need %zu)\n", n_in, ws_size, (size_t)WS_END); grid = -1; return; }
        int dev = 0, cus = 0, per_cu = 0;
        hipGetDevice(&dev); hipDeviceGetAttribute(&cus, hipDeviceAttributeMultiprocessorCount, dev);
        if (hipFuncSetAttribute((const void*)fwd_megakernel, hipFuncAttributeMaxDynamicSharedMemorySize, LDS_BYTES) != hipSuccess) { fprintf(stderr, "hipFuncSetAttribute failed\n"); grid = -1; return; }
        if (hipOccupancyMaxActiveBlocksPerMultiprocessor(&per_cu, (const void*)fwd_megakernel, NTHREADS, LDS_BYTES) != hipSuccess || per_cu < 1) per_cu = 1;
        (void)hipGetLastError();
        grid = cus * 1;
    }
    if (grid < 0) return;
    if (hipMemsetAsync((char*)d_ws + WS_BAR, 0, 16384, stream) != hipSuccess) { fprintf(stderr, "memset failed\n"); return; }
    Params p{};
    const float** pp = (const float**)&p;
    for (int i = 0; i < 23; ++i) pp[i] = (const float*)d_in[i];
    p.out = (float*)d_out; p.ws = (unsigned char*)d_ws;
#if N_LAUNCH_MODE == 1
    p.ph_lo = 0; p.ph_hi = NPH;
    void* args[] = {&p};
    hipError_t e = hipLaunchCooperativeKernel((void*)fwd_megakernel, dim3(grid), dim3(NTHREADS), args, LDS_BYTES, stream);
    if (e != hipSuccess) fprintf(stderr, "cooperative launch failed: %s (grid %d)\n", hipGetErrorString(e), grid);
#else
    for (int k = 0; k < NPH; ++k) { p.ph_lo = k; p.ph_hi = k + 1;
        hipLaunchKernelGGL(fwd_megakernel, dim3(grid), dim3(NTHREADS), LDS_BYTES, stream, p); }
#endif
}
```

```cpp
#include <hip/hip_runtime.h>
#include <hip/hip_cooperative_groups.h>
#include <cstdio>
#include <cstdint>
namespace cg = cooperative_groups;

#define LAS __attribute__((address_space(3)))
typedef unsigned short bf16_t;
typedef short bf16x8 __attribute__((ext_vector_type(8)));
typedef short s16x4 __attribute__((ext_vector_type(4)));
typedef float f32x4 __attribute__((ext_vector_type(4)));
typedef float f32x16 __attribute__((ext_vector_type(16)));
typedef unsigned u32x4 __attribute__((ext_vector_type(4)));
typedef unsigned u32x2 __attribute__((ext_vector_type(2)));

#ifndef N_LAUNCH_MODE
#define N_LAUNCH_MODE 1
#endif

constexpr int DM = 1024, NLAT = 65536, NCTX = 2048, MTOT = NLAT + NCTX, SEQ = 8192, CTXL = 256, FF = 2816;
constexpr int EV_N = 3600, EV_NP = 3840, OD_N = 3072;
constexpr int NCHUNKP = 64 * 132;
constexpr int NTHREADS = 512;
constexpr int LDS_BYTES = 135168 + 16;

constexpr size_t al256(size_t x) { return (x + 255) / 256 * 256; }
constexpr size_t WS_W_EVIN = 0;
constexpr size_t WS_W_EVOUT = WS_W_EVIN + al256((size_t)EV_NP * DM * 2);
constexpr size_t WS_W_ODIN = WS_W_EVOUT + al256((size_t)DM * DM * 2);
constexpr size_t WS_W_ODOUT = WS_W_ODIN + al256((size_t)OD_N * DM * 2);
constexpr size_t WS_W_FFIN = WS_W_ODOUT + al256((size_t)DM * DM * 2);
constexpr size_t WS_W_FFOUT = WS_W_FFIN + al256((size_t)2 * 2 * FF * DM * 2);
constexpr size_t WS_MOD = WS_W_FFOUT + al256((size_t)2 * DM * FF * 2);
constexpr size_t WS_H = WS_MOD + al256((size_t)2 * 9 * 6144 * 4);
constexpr size_t WS_PROJ = WS_H + al256((size_t)MTOT * DM * 2);
constexpr size_t WS_MIX = WS_PROJ + al256((size_t)MTOT * EV_NP * 2);
constexpr size_t WS_T = WS_MIX + al256((size_t)MTOT * DM * 2);
constexpr size_t WS_AQK = WS_T + al256((size_t)NCHUNKP * 4096 * 2);
constexpr size_t WS_GV = WS_AQK + al256((size_t)NCHUNKP * 4096 * 2);
constexpr size_t WS_BV = WS_GV + al256((size_t)NCHUNKP * 64 * 4);
constexpr size_t WS_EL = WS_BV + al256((size_t)NCHUNKP * 64 * 4);
constexpr size_t WS_GATES = WS_EL + al256((size_t)NCHUNKP * 64 * 4);
constexpr size_t WS_CTXRES = WS_GATES + al256((size_t)MTOT * 16 * 4);
constexpr size_t WS_BAR = WS_CTXRES + al256((size_t)NCTX * DM * 4);
constexpr size_t WS_ROPE = WS_BAR + 16384;
constexpr size_t WS_END = WS_ROPE + (size_t)2 * SEQ * 32 * 4;

struct Params {
    const float *x, *c, *ctx, *c_ctx, *ada_w, *ada_b, *norm_mix, *norm_ffn, *ffn_w_in, *ffn_w_out, *even_w_in, *even_w_out,
        *diff_qk_gain, *diff_lambda, *diff_subln, *gdn_conv, *gdn_a_log, *gdn_dt_bias, *gdn_norm, *odd_w_in, *odd_w_out, *na_qk_gain, *na_rpb;
    float* out; unsigned char* ws; int ph_lo, ph_hi;
};

__device__ __forceinline__ float bf2f(bf16_t b) { return __uint_as_float(((unsigned)b) << 16); }
__device__ __forceinline__ bf16_t f2bf(float f) { unsigned u = __float_as_uint(f); u += 0x7FFFu + ((u >> 16) & 1u); return (bf16_t)(u >> 16); }
__device__ __forceinline__ unsigned cvtpk(float lo, float hi) { unsigned r; asm volatile("v_cvt_pk_bf16_f32 %0, %1, %2" : "=v"(r) : "v"(lo), "v"(hi)); return r; }
__device__ __forceinline__ float siluf(float v) { return v / (1.f + __expf(-v)); }
__device__ __forceinline__ void unpack8(bf16x8 v, float* f) {
#pragma unroll
    for (int i = 0; i < 8; ++i) f[i] = bf2f((bf16_t)v[i]);
}
__device__ __forceinline__ bf16x8 pack8(const float* f) {
    u32x4 w = {cvtpk(f[0], f[1]), cvtpk(f[2], f[3]), cvtpk(f[4], f[5]), cvtpk(f[6], f[7])};
    return *reinterpret_cast<bf16x8*>(&w);
}

namespace pg8 {
constexpr int BM = 256, BK = 64, HALF = 128, HTB = HALF * BK * 2, STAGE_BYTES = 8 * HTB, NXCD = 8, WGM = 4;
__host__ __device__ __forceinline__ int lds_byte(int r, int c) { const int st = (r >> 4) * 2 + (c >> 5), rr = r & 15, cc = c & 31, ob = rr * 64 + cc * 2; return st * 1024 + (ob ^ (((ob >> 9) & 1) << 5)); }
__host__ __device__ __forceinline__ void stage_rc(int b, int& R, int& C) { const int st = b / 1024, sb = b % 1024, swz = sb ^ (((sb >> 9) & 1) << 5); R = (st >> 1) * 16 + swz / 64; C = (st & 1) * 32 + (swz % 64) / 2; }
__host__ __device__ __forceinline__ int perm32(int rho) { const int n = rho >> 4, i = rho & 15; return 8 * (i >> 2) + 4 * n + (i & 3); }
struct Unit { int pm, pn; };
struct Gemm { const bf16_t* A; const bf16_t* Bt; int M, N, K; };
template <int NM, int NN> struct StaticOrderT {
    static_assert(NM % WGM == 0, "row tiles in whole groups");
    int G, c;
    __device__ void init(int, int, int G_, int c_) { G = G_; c = c_; }
    __device__ bool next(int i, Unit& u) const {
        constexpr int nwg = NM * NN, q = nwg / NXCD, r = nwg % NXCD, nig = WGM * NN;
        const int L = i * G + c; if (L >= nwg) return false;
        const int xcd = L % NXCD, off = L / NXCD;
        const int wgid = (xcd < r ? xcd * (q + 1) : r * (q + 1) + (xcd - r) * q) + off;
        const int gid = wgid / nig, w = wgid % nig;
        u.pm = gid * WGM + (w % WGM); u.pn = w / WGM; return true;
    }
};
struct EpiBf16 {
    static constexpr bool PERM = true;
    bf16_t* O; int ldc; int nvalid;
    __device__ __forceinline__ void operator()(const f32x4 (&acc)[2][2][4][2], const Unit& u, int wr, int wc, int fr, int fq) const {
        const int row0 = u.pm * BM + wr * 64 + fr; const int col0 = u.pn * BM + wc * 32 + 8 * fq;
#pragma unroll
        for (int ai = 0; ai < 2; ++ai)
#pragma unroll
            for (int m = 0; m < 4; ++m) { bf16_t* rowp = O + (size_t)(row0 + ai * HALF + m * 16) * ldc + col0;
#pragma unroll
                for (int bj = 0; bj < 2; ++bj) { const f32x4 v0 = acc[ai][bj][m][0], v1 = acc[ai][bj][m][1];
                    u32x4 w; w.x = cvtpk(v0[0], v0[1]); w.y = cvtpk(v0[2], v0[3]); w.z = cvtpk(v1[0], v1[1]); w.w = cvtpk(v1[2], v1[3]);
                    if (col0 + bj * HALF < nvalid) *(u32x4*)(rowp + bj * HALF) = w; } }
    }
};
struct EpiSwiglu {
    static constexpr bool PERM = true;
    bf16_t* O; int ldc;
    __device__ __forceinline__ void operator()(const f32x4 (&acc)[2][2][4][2], const Unit& u, int wr, int wc, int fr, int fq) const {
        const int row0 = u.pm * BM + wr * 64 + fr; const int col0 = u.pn * HALF + wc * 32 + 8 * fq;
#pragma unroll
        for (int ai = 0; ai < 2; ++ai)
#pragma unroll
            for (int m = 0; m < 4; ++m) { bf16_t* rowp = O + (size_t)(row0 + ai * HALF + m * 16) * ldc + col0;
                typedef float f32x2v __attribute__((ext_vector_type(2)));
                unsigned wv[4];
#pragma unroll
                for (int n = 0; n < 2; ++n)
#pragma unroll
                    for (int j = 0; j < 4; j += 2) { const f32x2v g = {acc[ai][0][m][n][j], acc[ai][0][m][n][j + 1]}, up = {acc[ai][1][m][n][j], acc[ai][1][m][n][j + 1]};
                        const f32x2v t = g * (-1.4426950408889634f); f32x2v e; e.x = __builtin_amdgcn_exp2f(t.x); e.y = __builtin_amdgcn_exp2f(t.y);
                        const f32x2v d = e + 1.0f; f32x2v r; r.x = __builtin_amdgcn_rcpf(d.x); r.y = __builtin_amdgcn_rcpf(d.y);
                        const f32x2v o = (g * up) * r; wv[n * 2 + (j >> 1)] = cvtpk(o.x, o.y); }
                u32x4 w; w.x = wv[0]; w.y = wv[1]; w.z = wv[2]; w.w = wv[3];
                *(u32x4*)rowp = w; }
    }
};
struct EpiResid {
    static constexpr bool PERM = false;
    const float* resLat; const float* resCtx; float* outLat; float* outCtx; const float* modl; int goff;
    __device__ __forceinline__ void operator()(const f32x4 (&acc)[2][2][4][2], const Unit& u, int wr, int wc, int fr, int fq) const {
        const int rowt = u.pm * BM; const bool lat = rowt < NLAT;
        const float* res = lat ? resLat + (size_t)rowt * DM : resCtx + (size_t)(rowt - NLAT) * DM;
        float* out = lat ? outLat + (size_t)rowt * DM : outCtx + (size_t)(rowt - NLAT) * DM;
        const float* gate = modl + (size_t)(lat ? (rowt >> 13) : 8) * 6144 + goff;
        const int row0 = wr * 64 + fr, col0 = u.pn * BM + wc * 32 + 4 * fq;
        f32x4 gv[2][2];
#pragma unroll
        for (int bj = 0; bj < 2; ++bj)
#pragma unroll
            for (int n = 0; n < 2; ++n) gv[bj][n] = *(const f32x4*)(gate + col0 + bj * HALF + n * 16);
#pragma unroll
        for (int ai = 0; ai < 2; ++ai) {
            f32x4 r[4][2][2];
#pragma unroll
            for (int m = 0; m < 4; ++m)
#pragma unroll
                for (int bj = 0; bj < 2; ++bj)
#pragma unroll
                    for (int n = 0; n < 2; ++n) r[m][bj][n] = *(const f32x4*)(res + (size_t)(row0 + ai * HALF + m * 16) * DM + col0 + bj * HALF + n * 16);
#pragma unroll
            for (int m = 0; m < 4; ++m)
#pragma unroll
                for (int bj = 0; bj < 2; ++bj)
#pragma unroll
                    for (int n = 0; n < 2; ++n) *(f32x4*)(out + (size_t)(row0 + ai * HALF + m * 16) * DM + col0 + bj * HALF + n * 16) = r[m][bj][n] + gv[bj][n] * acc[ai][bj][m][n];
        }
    }
};

template <class Epi, class Sched>
__device__ __forceinline__ void gemm_phase(LAS unsigned char* lds, const Gemm g, const Sched& S, const Epi& E) {
    const int tid = threadIdx.x, wid = __builtin_amdgcn_readfirstlane(tid >> 6), lane = tid & 63, wr = wid >> 2, wc = wid & 3, fr = lane & 15, fq = lane >> 4;
    const int K = g.K, nt = K / BK;
    unsigned voffA[2], voffB[2];
#pragma unroll
    for (int i = 0; i < 2; ++i) { int R, C; stage_rc(tid * 16 + i * 8192, R, C); const int Rb = Epi::PERM ? ((R & ~31) + perm32(R & 31)) : R;
        voffA[i] = (unsigned)(R * K + C) * 2u; voffB[i] = (unsigned)(Rb * K + C) * 2u; }
    const size_t kstep = (size_t)(BK * 2);
    const size_t hstep = (size_t)HALF * K * 2;
    const size_t tstep = 2 * hstep;
    const unsigned ldsw = (unsigned)wid * 1024u;
    const int aoff = lds_byte(wr * 64 + fr, fq * 8), boff = lds_byte(wc * 32 + fr, fq * 8);
#define PG8_SA(b, h) (((b) * 2 + (h)) * HTB)
#define PG8_SB(b, h) ((4 + (b) * 2 + (h)) * HTB)
#define PG8_STAGE(bufoff, gbase, voff) do { _Pragma("unroll") for (int _i = 0; _i < 2; ++_i) \
        __builtin_amdgcn_global_load_lds((const unsigned*)((const char*)(gbase) + (voff)[_i]), (LAS unsigned*)(lds + (bufoff) + ldsw + _i * 8192), 16, 0, 0); } while (0)
#define PG8_LDA(dst, b, h) do { _Pragma("unroll") for (int m = 0; m < 4; ++m) _Pragma("unroll") for (int k = 0; k < 2; ++k) dst[m][k] = *(const LAS bf16x8*)(lds + PG8_SA(b, h) + aoff + m * 2048 + k * 1024); } while (0)
#define PG8_LDB(dst, b, h) do { _Pragma("unroll") for (int n = 0; n < 2; ++n) _Pragma("unroll") for (int k = 0; k < 2; ++k) dst[n][k] = *(const LAS bf16x8*)(lds + PG8_SB(b, h) + boff + n * 2048 + k * 1024); } while (0)
#define PG8_MMA(ai, bj, At, Bt) do { __builtin_amdgcn_s_setprio(1); _Pragma("unroll") for (int m = 0; m < 4; ++m) _Pragma("unroll") for (int n = 0; n < 2; ++n) _Pragma("unroll") for (int k = 0; k < 2; ++k) \
        acc[ai][bj][m][n] = __builtin_amdgcn_mfma_f32_16x16x32_bf16(Bt[n][k], At[m][k], acc[ai][bj][m][n], 0, 0, 0); __builtin_amdgcn_s_setprio(0); } while (0)
#define PG8_WAIT_V(n) asm volatile("s_waitcnt vmcnt(" #n ")" ::: "memory")
#define PG8_WAIT_L(n) asm volatile("s_waitcnt lgkmcnt(" #n ")" ::: "memory")
#define PG8_BAR __builtin_amdgcn_s_barrier()
#define PG8_SCHED __builtin_amdgcn_sched_barrier(0)
    Unit cur, nxt; int ui = 0;
    if (!S.next(0, cur)) return;
    f32x4 acc[2][2][4][2];
#pragma unroll
    for (int a = 0; a < 2; ++a)
#pragma unroll
        for (int b = 0; b < 2; ++b)
#pragma unroll
            for (int m = 0; m < 4; ++m)
#pragma unroll
                for (int n = 0; n < 2; ++n) acc[a][b][m][n] = (f32x4){0.f, 0.f, 0.f, 0.f};
    bf16x8 At[4][2], B0[2][2], B1[2][2];
    const char* cA = (const char*)g.A + (size_t)cur.pm * tstep; const char* cB = (const char*)g.Bt + (size_t)cur.pn * tstep;
    PG8_STAGE(PG8_SB(0, 0), cB, voffB); PG8_STAGE(PG8_SA(0, 0), cA, voffA); PG8_STAGE(PG8_SB(0, 1), cB + hstep, voffB); PG8_STAGE(PG8_SA(0, 1), cA + hstep, voffA);
    if (wr == 1) PG8_BAR;
    PG8_WAIT_V(4); PG8_BAR;
    PG8_STAGE(PG8_SB(1, 0), cB + kstep, voffB); PG8_STAGE(PG8_SA(1, 0), cA + kstep, voffA); PG8_STAGE(PG8_SB(1, 1), cB + hstep + kstep, voffB);
    PG8_WAIT_V(6); PG8_BAR;
    for (;;) {
        const bool has_next = S.next(ui + 1, nxt);
        const char* nA = has_next ? (const char*)g.A + (size_t)nxt.pm * tstep : cA; const char* nB = has_next ? (const char*)g.Bt + (size_t)nxt.pn * tstep : cB;
        for (int t = 0; t < nt; t += 2) {
            const bool last = (t == nt - 2);
            const char* a1 = cA + (size_t)(t + 1) * kstep;
            const char* a2 = last ? nA : cA + (size_t)(t + 2) * kstep; const char* b2 = last ? nB : cB + (size_t)(t + 2) * kstep;
            const char* a3 = a2 + kstep; const char* b3 = b2 + kstep;
            PG8_LDB(B0, 0, 0); PG8_SCHED; PG8_LDA(At, 0, 0); PG8_STAGE(PG8_SA(1, 1), a1 + hstep, voffA);
            PG8_WAIT_L(8); PG8_BAR; PG8_WAIT_L(0); PG8_MMA(0, 0, At, B0); PG8_BAR; PG8_SCHED;
            PG8_LDB(B1, 0, 1); PG8_STAGE(PG8_SB(0, 0), b2, voffB);
            PG8_BAR; PG8_WAIT_L(0); PG8_MMA(0, 1, At, B1); PG8_BAR;
            PG8_LDA(At, 0, 1); PG8_STAGE(PG8_SA(0, 0), a2, voffA);
            PG8_BAR; PG8_WAIT_L(0); PG8_MMA(1, 0, At, B0); PG8_BAR; PG8_SCHED;
            PG8_STAGE(PG8_SB(0, 1), b2 + hstep, voffB);
            PG8_WAIT_V(6); PG8_BAR; PG8_MMA(1, 1, At, B1); PG8_BAR;
            PG8_LDB(B0, 1, 0); PG8_SCHED; PG8_LDA(At, 1, 0); PG8_STAGE(PG8_SA(0, 1), a2 + hstep, voffA);
            PG8_WAIT_L(8); PG8_BAR; PG8_WAIT_L(0); PG8_MMA(0, 0, At, B0); PG8_BAR; PG8_SCHED;
            PG8_LDB(B1, 1, 1); PG8_STAGE(PG8_SB(1, 0), b3, voffB);
            PG8_BAR; PG8_WAIT_L(0); PG8_MMA(0, 1, At, B1); PG8_BAR;
            PG8_LDA(At, 1, 1); PG8_STAGE(PG8_SA(1, 0), a3, voffA);
            PG8_BAR; PG8_WAIT_L(0); PG8_MMA(1, 0, At, B0); PG8_BAR; PG8_SCHED;
            PG8_STAGE(PG8_SB(1, 1), b3 + hstep, voffB);
            PG8_WAIT_V(6); PG8_BAR; PG8_MMA(1, 1, At, B1); PG8_BAR;
        }
        E(acc, cur, wr, wc, fr, fq);
        if (!has_next) break;
#pragma unroll
        for (int a = 0; a < 2; ++a)
#pragma unroll
            for (int b = 0; b < 2; ++b)
#pragma unroll
                for (int m = 0; m < 4; ++m)
#pragma unroll
                    for (int n = 0; n < 2; ++n) acc[a][b][m][n] = (f32x4){0.f, 0.f, 0.f, 0.f};
        cur = nxt; cA = nA; cB = nB; ++ui;
    }
    PG8_WAIT_V(0);
    if (wr == 0) PG8_BAR;
    PG8_BAR;
#undef PG8_SA
#undef PG8_SB
#undef PG8_STAGE
#undef PG8_LDA
#undef PG8_LDB
#undef PG8_MMA
#undef PG8_WAIT_V
#undef PG8_WAIT_L
#undef PG8_BAR
#undef PG8_SCHED
}
}

#define KSWZ(row, colB) ((row) * 256 + ((colB) ^ (((row) & 7) << 4)))
#define SBAR() __builtin_amdgcn_sched_barrier(0)
__device__ __forceinline__ int crow(int r, int hi) { return (r & 3) + 8 * (r >> 2) + 4 * hi; }
__device__ __forceinline__ int v_st(int k, int c) { const int kk = (k & ~0xC) | ((k & 4) << 1) | ((k & 8) >> 1); return ((kk >> 3) * 4 + (c >> 5)) * 512 + ((kk & 7) * 32 + (c & 31)) * 2; }
__device__ __forceinline__ int v_rd_base(int lane) { return ((lane & 3) << 3) | (((lane >> 2) & 3) << 6) | (((lane >> 4) & 1) << 5) | (((lane >> 5) & 1) << 8); }
constexpr int v_rd_off(int d0, int ks, int half) { return d0 * 512 + ks * 4096 + half * 2048; }
template <int OFF> __device__ __forceinline__ s16x4 tr_read(int vb) {
    s16x4 r; asm volatile("ds_read_b64_tr_b16 %0, %1 offset:%2" : "=&v"(r) : "v"(vb), "i"(OFF) : "memory"); return r;
}
template <int D0> __device__ __forceinline__ void pv_one(f32x16& od, int vb, bf16x8 pa0, bf16x8 pa1, bf16x8 pa2, bf16x8 pa3) {
    const s16x4 l0 = tr_read<v_rd_off(D0, 0, 0)>(vb), h0 = tr_read<v_rd_off(D0, 0, 1)>(vb), l1 = tr_read<v_rd_off(D0, 1, 0)>(vb), h1 = tr_read<v_rd_off(D0, 1, 1)>(vb);
    const s16x4 l2 = tr_read<v_rd_off(D0, 2, 0)>(vb), h2 = tr_read<v_rd_off(D0, 2, 1)>(vb), l3 = tr_read<v_rd_off(D0, 3, 0)>(vb), h3 = tr_read<v_rd_off(D0, 3, 1)>(vb);
    asm volatile("s_waitcnt lgkmcnt(0)" ::: "memory"); SBAR();
#define PK(L, H) (bf16x8){L[0], L[1], L[2], L[3], H[0], H[1], H[2], H[3]}
    od = __builtin_amdgcn_mfma_f32_32x32x16_bf16(pa0, PK(l0, h0), od, 0, 0, 0);
    od = __builtin_amdgcn_mfma_f32_32x32x16_bf16(pa1, PK(l1, h1), od, 0, 0, 0);
    od = __builtin_amdgcn_mfma_f32_32x32x16_bf16(pa2, PK(l2, h2), od, 0, 0, 0);
    od = __builtin_amdgcn_mfma_f32_32x32x16_bf16(pa3, PK(l3, h3), od, 0, 0, 0);
#undef PK
}
__device__ __forceinline__ void pv_d0(f32x16* o, int vb, bf16x8 pa0, bf16x8 pa1, bf16x8 pa2, bf16x8 pa3) {
    pv_one<0>(o[0], vb, pa0, pa1, pa2, pa3); pv_one<1>(o[1], vb, pa0, pa1, pa2, pa3); pv_one<2>(o[2], vb, pa0, pa1, pa2, pa3); pv_one<3>(o[3], vb, pa0, pa1, pa2, pa3);
}
#define PK4(P, BASE, OUT) do { unsigned a0 = cvtpk(P[BASE + 0], P[BASE + 1]), a1 = cvtpk(P[BASE + 2], P[BASE + 3]);   \
    unsigned b0 = cvtpk(P[BASE + 4], P[BASE + 5]), b1 = cvtpk(P[BASE + 6], P[BASE + 7]);                              \
    auto r0 = __builtin_amdgcn_permlane32_swap(a0, b0, false, false); auto r1 = __builtin_amdgcn_permlane32_swap(a1, b1, false, false); \
    u32x4 w = {r0[0], r1[0], r0[1], r1[1]}; OUT = *reinterpret_cast<bf16x8*>(&w); } while (0)
__device__ __forceinline__ float halfswap_add(float v) {
    auto rr = __builtin_amdgcn_permlane32_swap(__float_as_uint(v), __float_as_uint(v), false, false);
    return __uint_as_float(rr[0]) + __uint_as_float(rr[1]);
}

__device__ __forceinline__ void ada_phase(const Params& p, unsigned char* lds) {
    float* sc = (float*)lds;
    float* red = (float*)(lds + 40960);
    float* mod = (float*)(p.ws + WS_MOD);
    const int tid = threadIdx.x;
    for (int j = blockIdx.x; j < 192; j += gridDim.x) {
        const int l = j / 96, n0 = (j % 96) * 64;
        for (int i = tid; i < 9 * 1024; i += NTHREADS) { const int r = i >> 10, k = i & 1023; const float v = r < 8 ? p.c[r * 1024 + k] : p.c_ctx[k]; sc[i] = v / (1.f + expf(-v)); }
        __syncthreads();
        const int col = tid & 63, ks = tid >> 6;
        float acc[9];
#pragma unroll
        for (int r = 0; r < 9; ++r) acc[r] = 0.f;
        const float* wp = p.ada_w + ((size_t)l * 1024 + ks * 128) * 6144 + n0 + col;
#pragma unroll 8
        for (int kk = 0; kk < 128; ++kk) { const float w = wp[(size_t)kk * 6144];
#pragma unroll
            for (int r = 0; r < 9; ++r) acc[r] += sc[r * 1024 + ks * 128 + kk] * w; }
#pragma unroll
        for (int r = 0; r < 9; ++r) red[(ks * 9 + r) * 64 + col] = acc[r];
        __syncthreads();
        for (int i = tid; i < 576; i += NTHREADS) { const int r = i >> 6, cc = i & 63; float s = p.ada_b[l * 6144 + n0 + cc];
            for (int k2 = 0; k2 < 8; ++k2) s += red[(k2 * 9 + r) * 64 + cc];
            mod[(size_t)(l * 9 + r) * 6144 + n0 + cc] = s; }
        __syncthreads();
    }
}
__device__ __forceinline__ void wconv_phase(const Params& p, unsigned char* lds) {
    float* tl = (float*)lds;
    const int tid = threadIdx.x;
    const int T0 = 16 * 60, T1 = T0 + 16 * 16, T2 = T1 + 16 * 48, T3 = T2 + 16 * 16, T4 = T3 + 16 * 88, T5 = T4 + 16 * 88, T6 = T5 + 44 * 16, T7 = T6 + 44 * 16;
#define WC_DECODE(t) \
        const float* src; bf16_t* dst; int K, N, NP, mode = 0, tt; \
        if ((t) < T0) { src = p.even_w_in; dst = (bf16_t*)(p.ws + WS_W_EVIN); K = 1024; N = EV_N; NP = EV_NP; tt = (t); } \
        else if ((t) < T1) { src = p.even_w_out; dst = (bf16_t*)(p.ws + WS_W_EVOUT); K = 1024; N = 1024; NP = 1024; tt = (t) - T0; } \
        else if ((t) < T2) { src = p.odd_w_in; dst = (bf16_t*)(p.ws + WS_W_ODIN); K = 1024; N = OD_N; NP = OD_N; tt = (t) - T1; } \
        else if ((t) < T3) { src = p.odd_w_out; dst = (bf16_t*)(p.ws + WS_W_ODOUT); K = 1024; N = 1024; NP = 1024; tt = (t) - T2; } \
        else if ((t) < T4) { src = p.ffn_w_in; dst = (bf16_t*)(p.ws + WS_W_FFIN); K = 1024; N = 2 * FF; NP = 2 * FF; mode = 1; tt = (t) - T3; } \
        else if ((t) < T5) { src = p.ffn_w_in + (size_t)1024 * 2 * FF; dst = (bf16_t*)(p.ws + WS_W_FFIN) + (size_t)2 * FF * 1024; K = 1024; N = 2 * FF; NP = 2 * FF; mode = 1; tt = (t) - T4; } \
        else if ((t) < T6) { src = p.ffn_w_out; dst = (bf16_t*)(p.ws + WS_W_FFOUT); K = FF; N = 1024; NP = 1024; tt = (t) - T5; } \
        else { src = p.ffn_w_out + (size_t)FF * 1024; dst = (bf16_t*)(p.ws + WS_W_FFOUT) + (size_t)1024 * FF; K = FF; N = 1024; NP = 1024; tt = (t) - T6; } \
        const int nnt = NP / 64; const int k0 = (tt / nnt) * 64, n0 = (tt % nnt) * 64; \
        int sn0; if (mode == 1) { const int tb = n0 >> 8, bj = (n0 >> 7) & 1, i0 = n0 & 127; sn0 = bj * FF + tb * 128 + i0; } else sn0 = n0;
    float rg[8];
#define WC_LOAD(t) do { WC_DECODE(t) (void)dst; _Pragma("unroll") for (int i = 0; i < 8; ++i) { const int e = tid + NTHREADS * i, kk = e >> 6, nn = e & 63; const int sn = sn0 + nn; \
        rg[i] = (sn < N) ? src[(size_t)(k0 + kk) * N + sn] : 0.f; } } while (0)
    int t = blockIdx.x;
    if (t < T7) WC_LOAD(t);
    for (; t < T7; t += gridDim.x) {
#pragma unroll
        for (int i = 0; i < 8; ++i) { const int e = tid + NTHREADS * i; tl[(e >> 6) * 65 + (e & 63)] = rg[i]; }
        __syncthreads();
        { WC_DECODE(t) (void)src; (void)N; (void)sn0;
          if (t + (int)gridDim.x < T7) WC_LOAD(t + (int)gridDim.x);
          for (int e = tid; e < 2048; e += NTHREADS) { const int nn = e >> 5, k2 = (e & 31) * 2;
              *(unsigned*)(dst + (size_t)(n0 + nn) * K + k0 + k2) = cvtpk(tl[k2 * 65 + nn], tl[(k2 + 1) * 65 + nn]); } }
        __syncthreads();
    }
#undef WC_DECODE
#undef WC_LOAD
}

__device__ __forceinline__ void norm_phase(const Params& p, const float* xlat, const float* xctx, int l, int which, int nrows) {
    const int lane = threadIdx.x & 63, wid = threadIdx.x >> 6;
    bf16_t* h = (bf16_t*)(p.ws + WS_H);
    const float* mod = (const float*)(p.ws + WS_MOD) + (size_t)l * 9 * 6144;
    const float* gain = (which ? p.norm_ffn : p.norm_mix) + l * 1024;
    const int shoff = which ? 3072 : 0, scoff = which ? 4096 : 1024;
    const int stride = gridDim.x * 8;
    f32x4 gn[4];
#pragma unroll
    for (int i = 0; i < 4; ++i) gn[i] = *(const f32x4*)(gain + lane * 4 + 256 * i);
    for (int row = blockIdx.x * 8 + wid; row < nrows; row += 2 * stride) {
        const int rowB = row + stride; const bool hasB = rowB < nrows; const int rB = hasB ? rowB : row;
        const float* srcA = row < NLAT ? xlat + (size_t)row * DM : xctx + (size_t)(row - NLAT) * DM;
        const float* srcB = rB < NLAT ? xlat + (size_t)rB * DM : xctx + (size_t)(rB - NLAT) * DM;
        const float* mrA = mod + (size_t)(row < NLAT ? (row >> 13) : 8) * 6144;
        const float* mrB = mod + (size_t)(rB < NLAT ? (rB >> 13) : 8) * 6144;
        f32x4 va[4], vb[4], sa[4], ha[4], sb[4], hb[4];
#pragma unroll
        for (int i = 0; i < 4; ++i) { const int c0 = lane * 4 + 256 * i;
            va[i] = *(const f32x4*)(srcA + c0); vb[i] = *(const f32x4*)(srcB + c0);
            sa[i] = *(const f32x4*)(mrA + scoff + c0); ha[i] = *(const f32x4*)(mrA + shoff + c0);
            sb[i] = *(const f32x4*)(mrB + scoff + c0); hb[i] = *(const f32x4*)(mrB + shoff + c0); }
#pragma unroll
        for (int rr = 0; rr < 2; ++rr) {
            if (rr == 1 && !hasB) break;
            const int r = rr ? rowB : row;
            float ss = 0.f;
#pragma unroll
            for (int i = 0; i < 4; ++i) { const f32x4 v = rr ? vb[i] : va[i]; ss += v[0] * v[0] + v[1] * v[1] + v[2] * v[2] + v[3] * v[3]; }
#pragma unroll
            for (int o = 1; o < 64; o <<= 1) ss += __shfl_xor(ss, o);
            const float rstd = rsqrtf(ss * (1.f / 1024.f) + 1e-6f);
#pragma unroll
            for (int i = 0; i < 4; ++i) { const int c0 = lane * 4 + 256 * i; const f32x4 v = rr ? vb[i] : va[i], s1 = rr ? sb[i] : sa[i], sh = rr ? hb[i] : ha[i];
                float y[4];
#pragma unroll
                for (int j = 0; j < 4; ++j) y[j] = v[j] * rstd * gn[i][j] * (1.f + s1[j]) + sh[j];
                u32x2 w; w.x = cvtpk(y[0], y[1]); w.y = cvtpk(y[2], y[3]);
                *(u32x2*)(h + (size_t)r * DM + c0) = w; }
        }
    }
}

template <int RB>
__device__ __forceinline__ void prep0_block(const Params& p, const int row0, const int lane0) {
    bf16_t* proj = (bf16_t*)(p.ws + WS_PROJ);
    bf16_t* qkvp = (bf16_t*)p.out;
    float* gbuf = (float*)(p.ws + WS_GATES);
    const float* ropec = (const float*)(p.ws + WS_ROPE); const float* ropes = ropec + SEQ * 32;
    {
        int lane = lane0; asm volatile("" : "+v"(lane));
        const bool lat = row0 < NLAT; const int t0 = lat ? (row0 & 8191) : ((row0 - NLAT) & 255); const int len = lat ? SEQ : CTXL;
        const int dsub = (lane & 7) * 8;
        {
            float gq[8], gk[8];
#pragma unroll
            for (int i = 0; i < 8; ++i) { gq[i] = p.diff_qk_gain[dsub + i] * (0.125f * 1.4426950408889634f); gk[i] = p.diff_qk_gain[64 + dsub + i]; }
            constexpr int DB = RB < 4 ? RB : 4;
#pragma unroll
            for (int i0 = 0; i0 < RB; i0 += DB) {
                bf16x8 raw[DB][2]; f32x4 c4[DB], s4[DB];
#pragma unroll
                for (int i = 0; i < DB; ++i) { const bf16_t* P = proj + (size_t)(row0 + i0 + i) * EV_NP;
                    raw[i][0] = *(const bf16x8*)(P + lane * 8); raw[i][1] = *(const bf16x8*)(P + 512 + lane * 8);
                    c4[i] = (f32x4){1.f, 1.f, 1.f, 1.f}; s4[i] = (f32x4){0.f, 0.f, 0.f, 0.f};
                    if (lat) { c4[i] = *(const f32x4*)(ropec + (t0 + i0 + i) * 32 + (lane & 7) * 4); s4[i] = *(const f32x4*)(ropes + (t0 + i0 + i) * 32 + (lane & 7) * 4); } }
#pragma unroll
                for (int i = 0; i < DB; ++i) { bf16_t* P = proj + (size_t)(row0 + i0 + i) * EV_NP;
#pragma unroll
                    for (int which = 0; which < 2; ++which) {
                        float v[8]; unpack8(raw[i][which], v);
                        float ss = 0.f;
#pragma unroll
                        for (int e = 0; e < 8; ++e) ss += v[e] * v[e];
                        ss += __shfl_xor(ss, 1); ss += __shfl_xor(ss, 2); ss += __shfl_xor(ss, 4);
                        const float rstd = rsqrtf(ss * (1.f / 64.f) + 1e-6f);
#pragma unroll
                        for (int e = 0; e < 8; ++e) v[e] = v[e] * rstd * (which ? gk[e] : gq[e]);
#pragma unroll
                        for (int e = 0; e < 4; ++e) { const float x0 = v[2 * e], x1 = v[2 * e + 1]; v[2 * e] = x0 * c4[i][e] - x1 * s4[i][e]; v[2 * e + 1] = x0 * s4[i][e] + x1 * c4[i][e]; }
                        *(bf16x8*)(P + which * 512 + lane * 8) = pack8(v);
                    } }
            }
        }
#pragma unroll 1
        for (int g = 0; g < 3; ++g) {
            const int c0 = g * 512 + lane * 8;
            float w[5][8];
#pragma unroll
            for (int j = 0; j < 5; ++j) { const f32x4 w0 = *(const f32x4*)(p.gdn_conv + j * 1536 + c0), w1 = *(const f32x4*)(p.gdn_conv + j * 1536 + c0 + 4);
#pragma unroll
                for (int e = 0; e < 4; ++e) { w[j][e] = w0[e]; w[j][4 + e] = w1[e]; } }
            const bf16_t* src = proj + (size_t)row0 * EV_NP + 1536 + c0;
            bf16x8 raw[RB + 4];
#pragma unroll
            for (int k = 0; k < RB + 4; ++k) { const int dt = k - 2; raw[k] = (bf16x8){0, 0, 0, 0, 0, 0, 0, 0};
                if (t0 + dt >= 0 && t0 + dt < len) raw[k] = *(const bf16x8*)(src + (ptrdiff_t)dt * EV_NP); }
            const float nsc = g == 0 ? 0.08838834764831845f : 1.f;
#pragma unroll
            for (int i = 0; i < RB; ++i) {
                float xm2[8], xm1[8], x0[8], xp1[8], xp2[8];
                unpack8(raw[i], xm2); unpack8(raw[i + 1], xm1); unpack8(raw[i + 2], x0); unpack8(raw[i + 3], xp1); unpack8(raw[i + 4], xp2);
                float y[8];
#pragma unroll
                for (int e = 0; e < 8; ++e) { y[e] = w[0][e] * xm2[e] + w[1][e] * xm1[e] + w[2][e] * x0[e] + w[3][e] * xp1[e] + w[4][e] * xp2[e]; y[e] = y[e] * __builtin_amdgcn_rcpf(1.f + __expf(-y[e])); }
                if (g < 2) { float ss = 0.f;
#pragma unroll
                    for (int e = 0; e < 8; ++e) ss += y[e] * y[e];
                    ss += __shfl_xor(ss, 1); ss += __shfl_xor(ss, 2); ss += __shfl_xor(ss, 4); ss += __shfl_xor(ss, 8);
                    const float sc_ = rsqrtf(ss + 1e-6f) * nsc;
#pragma unroll
                    for (int e = 0; e < 8; ++e) y[e] *= sc_; }
                *(bf16x8*)(qkvp + (size_t)(row0 + i) * 1536 + c0) = pack8(y);
            }
        }
#pragma unroll
        for (int k = 0; k < (RB * 16 + 63) / 64; ++k) { const int idx = lane + 64 * k, i = idx >> 4, gi = idx & 15; if (idx >= RB * 16) break;
            const float gvv = bf2f(proj[(size_t)(row0 + i) * EV_NP + 3584 + gi]); float o;
            if (gi < 8) o = 1.f / (1.f + expf(-gvv));
            else { const float z = gvv + p.gdn_dt_bias[gi - 8]; const float sp = z > 20.f ? z : log1pf(expf(z)); o = -expf(p.gdn_a_log[gi - 8]) * sp; }
            gbuf[(size_t)(row0 + i) * 16 + gi] = o; }
    }
}
__device__ __forceinline__ void prep0_phase(const Params& p) {
    const int lane0 = threadIdx.x & 63, wid = threadIdx.x >> 6;
    for (int blk = blockIdx.x * 8 + wid; blk < NLAT / 8; blk += gridDim.x * 8) prep0_block<8>(p, blk * 8, lane0);
    for (int r = blockIdx.x * 8 + wid; r < NCTX; r += gridDim.x * 8) prep0_block<1>(p, NLAT + r, lane0);
}

__device__ __forceinline__ int gdn_row(int b, int pc, int tau, int dir) {
    const int tt = dir ? 63 - tau : tau;
    return pc < 4 ? NLAT + b * CTXL + pc * 64 + tt : b * SEQ + (pc - 4) * 64 + tt;
}
__device__ __forceinline__ void gdn_pre_phase(const Params& p, unsigned char* lds) {
    const int lane = threadIdx.x & 63, wid = threadIdx.x >> 6;
    float* Lw = (float*)(lds + wid * 16896);
    float* gs = Lw + 4096; float* bs = gs + 64;
    const bf16_t* qkvp = (const bf16_t*)p.out;
    const float* gbuf = (const float*)(p.ws + WS_GATES);
    bf16_t* Tb = (bf16_t*)(p.ws + WS_T); bf16_t* Ab = (bf16_t*)(p.ws + WS_AQK);
    float* gv = (float*)(p.ws + WS_GV); float* bv = (float*)(p.ws + WS_BV);
    const int lane0 = lane;
    for (int cp = blockIdx.x * 8 + wid; cp < NCHUNKP; cp += gridDim.x * 8) {
        int lane = lane0; asm volatile("" : "+v"(lane));
        const int r32 = lane & 31, hi = lane >> 5;
        const int pc = cp % 132, ch = cp / 132, dir = ch & 1, h = (ch >> 1) & 3, b = ch >> 3;
        float g_keep, be_keep;
        { const int R = gdn_row(b, pc, lane, dir);
          float g = gbuf[(size_t)R * 16 + 8 + dir * 4 + h]; const float be = gbuf[(size_t)R * 16 + dir * 4 + h];
#pragma unroll
          for (int o = 1; o < 64; o <<= 1) { const float t = __shfl_up(g, o); if (lane >= o) g += t; }
          gs[lane] = g; bs[lane] = be; g_keep = g; be_keep = be; }
        bf16x8 kf[2][8], qf[2][8];
#pragma unroll
        for (int mi = 0; mi < 2; ++mi) { const size_t R = (size_t)gdn_row(b, pc, 32 * mi + r32, dir);
#pragma unroll
            for (int d0 = 0; d0 < 8; ++d0) { kf[mi][d0] = *(const bf16x8*)(qkvp + R * 1536 + 512 + h * 128 + d0 * 16 + hi * 8);
                                             qf[mi][d0] = *(const bf16x8*)(qkvp + R * 1536 + h * 128 + d0 * 16 + hi * 8); } }
        { const float gl_ = __shfl(g_keep, 63); gv[(size_t)cp * 64 + lane] = expf(g_keep); bv[(size_t)cp * 64 + lane] = be_keep; ((float*)(p.ws + WS_EL))[(size_t)cp * 64 + lane] = expf(gl_ - g_keep); }
        bf16_t* Ao = Ab + (size_t)cp * 4096;
#pragma unroll
        for (int mi = 0; mi < 2; ++mi) {
#pragma unroll
            for (int ni = 0; ni <= mi; ++ni) {
                f32x16 ckk = {}, cqk = {};
#pragma unroll
                for (int d0 = 0; d0 < 8; ++d0) { ckk = __builtin_amdgcn_mfma_f32_32x32x16_bf16(kf[mi][d0], kf[ni][d0], ckk, 0, 0, 0);
                                                 cqk = __builtin_amdgcn_mfma_f32_32x32x16_bf16(qf[mi][d0], kf[ni][d0], cqk, 0, 0, 0); }
                const int sg = 32 * ni + r32; const float gsg = gs[sg];
#pragma unroll
                for (int r = 0; r < 16; ++r) { const int tau = 32 * mi + crow(r, hi);
                    const float dec = tau >= sg ? __expf(gs[tau] - gsg) : 0.f;
                    Lw[tau * 64 + sg] = tau > sg ? bs[tau] * dec * ckk[r] : 0.f;
                    Ao[tau * 64 + sg] = f2bf(cqk[r] * dec); }
                asm volatile("" ::: "memory");
            }
        }
#pragma unroll
        for (int r = 0; r < 16; ++r) Ao[crow(r, hi) * 64 + 32 + r32] = 0;
        float Tc[64];
#pragma unroll
        for (int i = 0; i < 64; ++i) { float a = (i == lane) ? 1.f : 0.f;
#pragma unroll
            for (int j = 0; j < i; ++j) a -= Lw[i * 64 + j] * Tc[j];
            Tc[i] = a; asm volatile("" ::: "memory"); }
        bf16_t* To = Tb + (size_t)cp * 4096;
#pragma unroll
        for (int i = 0; i < 64; ++i) To[i * 64 + lane] = f2bf(Tc[i]);
    }
}

constexpr int G_KV = 0, G_QA = 16384, G_TT = 32768, G_AQ = G_TT + 9216, G_RT = G_AQ + 9216, G_UT = G_RT + 4608, G_UP = G_UT + 4608,
              G_ST = G_UP + 4608, G_VS = G_ST + 8704, G_GS = G_VS + 4096, G_BS = G_GS + 256, G_EL = G_BS + 256, G_END = G_EL + 256;
__device__ __forceinline__ void gdn_scan_phase(const Params& p, unsigned char* lds) {
    const int tid = threadIdx.x, lane0 = tid & 63, wid = tid >> 6;
    const bf16_t* qkvp = (const bf16_t*)p.out;
    const bf16_t* Tb = (const bf16_t*)(p.ws + WS_T); const bf16_t* Ab = (const bf16_t*)(p.ws + WS_AQK);
    const float* gv = (const float*)(p.ws + WS_GV); const float* bv = (const float*)(p.ws + WS_BV);
    bf16_t* obuf = (bf16_t*)(p.ws + WS_H);
    const float* gsl = (const float*)(lds + G_GS); const float* bsl = (const float*)(lds + G_BS); const float* esl = (const float*)(lds + G_EL);
    const int sr = tid >> 4, sc = (tid & 15) * 8;
    const int vblk = (gridDim.x % 8 == 0) ? (int)((blockIdx.x & 7) * (gridDim.x >> 3) + (blockIdx.x >> 3)) : (int)blockIdx.x;
    for (int wi = vblk; wi < 256; wi += gridDim.x) {
        const int chain = wi >> 2, cs = wi & 3, b = chain >> 3, h = (chain >> 1) & 3, dir = chain & 1;
        f32x16 Sacc = {};
        for (int i = tid; i < 8704 / 4; i += NTHREADS) ((unsigned*)(lds + G_ST))[i] = 0u;
        bf16x8 sk0, sk1, sq0, sq1, sT, sA, sV; float sg = 0.f;
#define GLOAD(step) do { const int pc_ = dir == 0 ? (step) : ((step) < 4 ? 3 - (step) : 4 + 127 - ((step) - 4)); \
        const size_t cp_ = (size_t)chain * 132 + pc_; \
        const size_t R0_ = (size_t)gdn_row(b, pc_, sr, dir), R1_ = (size_t)gdn_row(b, pc_, 32 + sr, dir); \
        sk0 = *(const bf16x8*)(qkvp + R0_ * 1536 + 512 + h * 128 + sc); sk1 = *(const bf16x8*)(qkvp + R1_ * 1536 + 512 + h * 128 + sc); \
        sq0 = *(const bf16x8*)(qkvp + R0_ * 1536 + h * 128 + sc); sq1 = *(const bf16x8*)(qkvp + R1_ * 1536 + h * 128 + sc); \
        sT = *(const bf16x8*)(Tb + cp_ * 4096 + tid * 8); sA = *(const bf16x8*)(Ab + cp_ * 4096 + tid * 8); \
        if (tid < 256) { const size_t Rv_ = (size_t)gdn_row(b, pc_, tid >> 2, dir); sV = *(const bf16x8*)(qkvp + Rv_ * 1536 + 1024 + h * 128 + cs * 32 + (tid & 3) * 8); } \
        if (tid < 64) sg = gv[cp_ * 64 + tid]; else if (tid < 128) sg = bv[cp_ * 64 + tid - 64]; else if (tid < 192) sg = ((const float*)(p.ws + WS_EL))[cp_ * 64 + tid - 128]; } while (0)
#define GWRITE() do { *(bf16x8*)(lds + G_KV + v_st(sr, sc)) = sk0; *(bf16x8*)(lds + G_KV + v_st(32 + sr, sc)) = sk1; \
        *(bf16x8*)(lds + G_QA + KSWZ(sr, sc * 2)) = sq0; *(bf16x8*)(lds + G_QA + KSWZ(32 + sr, sc * 2)) = sq1; \
        *(bf16x8*)(lds + G_TT + (tid >> 3) * 144 + (tid & 7) * 16) = sT; *(bf16x8*)(lds + G_AQ + (tid >> 3) * 144 + (tid & 7) * 16) = sA; \
        if (tid < 256) *(bf16x8*)(lds + G_VS + (tid >> 2) * 64 + (tid & 3) * 16) = sV; \
        if (tid < 192) ((float*)(lds + G_GS))[tid] = sg; } while (0)
        GLOAD(0);
        for (int step = 0; step < 132; ++step) {
            GWRITE();
            __syncthreads();
            if (step + 1 < 132) GLOAD(step + 1);
            int lane = lane0; asm volatile("" : "+v"(lane));
            const int r32 = lane & 31, hi = lane >> 5;
            const int vb0 = (int)(uintptr_t)(lds + G_KV) + v_rd_base(lane);
            const int pc = dir == 0 ? step : (step < 4 ? 3 - step : 4 + 127 - (step - 4));
            f32x16 acc = {};
            const int mi = wid & 1;
            if (wid < 4) {
                f32x16 acc2 = {};
                if (wid < 2) {
#pragma unroll
                    for (int d0 = 0; d0 < 8; d0 += 2) {
                        const bf16x8 a0 = *(const bf16x8*)(lds + G_KV + v_st(32 * mi + r32, d0 * 16 + hi * 8)), a1 = *(const bf16x8*)(lds + G_KV + v_st(32 * mi + r32, d0 * 16 + 16 + hi * 8));
                        const bf16x8 b0 = *(const bf16x8*)(lds + G_ST + r32 * 272 + (d0 * 16 + hi * 8) * 2), b1 = *(const bf16x8*)(lds + G_ST + r32 * 272 + (d0 * 16 + 16 + hi * 8) * 2);
                        acc = __builtin_amdgcn_mfma_f32_32x32x16_bf16(a0, b0, acc, 0, 0, 0);
                        acc2 = __builtin_amdgcn_mfma_f32_32x32x16_bf16(a1, b1, acc2, 0, 0, 0); }
                } else {
#pragma unroll
                    for (int d0 = 0; d0 < 8; d0 += 2) {
                        const bf16x8 a0 = *(const bf16x8*)(lds + G_QA + KSWZ(32 * mi + r32, (d0 * 16 + hi * 8) * 2)), a1 = *(const bf16x8*)(lds + G_QA + KSWZ(32 * mi + r32, (d0 * 16 + 16 + hi * 8) * 2));
                        const bf16x8 b0 = *(const bf16x8*)(lds + G_ST + r32 * 272 + (d0 * 16 + hi * 8) * 2), b1 = *(const bf16x8*)(lds + G_ST + r32 * 272 + (d0 * 16 + 16 + hi * 8) * 2);
                        acc = __builtin_amdgcn_mfma_f32_32x32x16_bf16(a0, b0, acc, 0, 0, 0);
                        acc2 = __builtin_amdgcn_mfma_f32_32x32x16_bf16(a1, b1, acc2, 0, 0, 0); }
                }
#pragma unroll
                for (int r = 0; r < 16; ++r) acc[r] += acc2[r];
                if (wid < 2) {
#pragma unroll
                    for (int g4 = 0; g4 < 4; ++g4) { float rv[4];
#pragma unroll
                        for (int j = 0; j < 4; ++j) { const int tau = 32 * mi + 8 * g4 + 4 * hi + j;
                            const float vv = bf2f(*(const bf16_t*)(lds + G_VS + tau * 64 + r32 * 2));
                            rv[j] = bsl[tau] * (vv - gsl[tau] * acc[g4 * 4 + j]); }
                        u32x2 w; w.x = cvtpk(rv[0], rv[1]); w.y = cvtpk(rv[2], rv[3]);
                        *(u32x2*)(lds + G_RT + r32 * 144 + (32 * mi + 8 * g4 + 4 * hi) * 2) = w; }
                } else {
#pragma unroll
                    for (int r = 0; r < 16; ++r) acc[r] *= gsl[32 * mi + crow(r, hi)];
                }
            }
            __syncthreads();
            if (wid < 2) {
                f32x16 u = {}, u2 = {};
#pragma unroll
                for (int s = 0; s < 4; s += 2) {
                    const bf16x8 a0 = *(const bf16x8*)(lds + G_TT + (32 * mi + r32) * 144 + (16 * s + hi * 8) * 2), a1 = *(const bf16x8*)(lds + G_TT + (32 * mi + r32) * 144 + (16 * s + 16 + hi * 8) * 2);
                    const bf16x8 b0 = *(const bf16x8*)(lds + G_RT + r32 * 144 + (16 * s + hi * 8) * 2), b1 = *(const bf16x8*)(lds + G_RT + r32 * 144 + (16 * s + 16 + hi * 8) * 2);
                    u = __builtin_amdgcn_mfma_f32_32x32x16_bf16(a0, b0, u, 0, 0, 0);
                    u2 = __builtin_amdgcn_mfma_f32_32x32x16_bf16(a1, b1, u2, 0, 0, 0); }
#pragma unroll
                for (int r = 0; r < 16; ++r) u[r] += u2[r];
#pragma unroll
                for (int g4 = 0; g4 < 4; ++g4) { float uv[4], up[4];
#pragma unroll
                    for (int j = 0; j < 4; ++j) { const int tau = 32 * mi + 8 * g4 + 4 * hi + j; uv[j] = u[g4 * 4 + j]; up[j] = uv[j] * esl[tau]; }
                    u32x2 w; w.x = cvtpk(uv[0], uv[1]); w.y = cvtpk(uv[2], uv[3]);
                    *(u32x2*)(lds + G_UT + r32 * 144 + (32 * mi + 8 * g4 + 4 * hi) * 2) = w;
                    u32x2 w2; w2.x = cvtpk(up[0], up[1]); w2.y = cvtpk(up[2], up[3]);
                    *(u32x2*)(lds + G_UP + r32 * 144 + (32 * mi + 8 * g4 + 4 * hi) * 2) = w2; }
            }
            __syncthreads();
            if (wid == 2 || wid == 3) {
#pragma unroll
                for (int s = 0; s < 4; ++s) {
                    const bf16x8 a = *(const bf16x8*)(lds + G_AQ + (32 * mi + r32) * 144 + (16 * s + hi * 8) * 2);
                    const bf16x8 bb = *(const bf16x8*)(lds + G_UT + r32 * 144 + (16 * s + hi * 8) * 2);
                    acc = __builtin_amdgcn_mfma_f32_32x32x16_bf16(a, bb, acc, 0, 0, 0); }
#pragma unroll
                for (int r = 0; r < 16; ++r) { const size_t R = (size_t)gdn_row(b, pc, 32 * mi + crow(r, hi), dir);
                    obuf[((size_t)dir * MTOT + R) * 512 + h * 128 + cs * 32 + r32] = f2bf(acc[r]); }
            } else if (wid >= 4) {
                const float gl = gsl[63];
#pragma unroll
                for (int r = 0; r < 16; ++r) Sacc[r] *= gl;
                const bf16x8 pa0 = *(const bf16x8*)(lds + G_UP + r32 * 144 + (0 + hi * 8) * 2), pa1 = *(const bf16x8*)(lds + G_UP + r32 * 144 + (16 + hi * 8) * 2),
                             pa2 = *(const bf16x8*)(lds + G_UP + r32 * 144 + (32 + hi * 8) * 2), pa3 = *(const bf16x8*)(lds + G_UP + r32 * 144 + (48 + hi * 8) * 2);
                const int d0 = wid - 4;
                if (d0 == 0) pv_one<0>(Sacc, vb0, pa0, pa1, pa2, pa3); else if (d0 == 1) pv_one<1>(Sacc, vb0, pa0, pa1, pa2, pa3);
                else if (d0 == 2) pv_one<2>(Sacc, vb0, pa0, pa1, pa2, pa3); else pv_one<3>(Sacc, vb0, pa0, pa1, pa2, pa3);
#pragma unroll
                for (int r = 0; r < 16; ++r) *(bf16_t*)(lds + G_ST + crow(r, hi) * 272 + (32 * d0 + r32) * 2) = f2bf(Sacc[r]);
            }
            __syncthreads();
        }
#undef GLOAD
#undef GWRITE
    }
}

__device__ __forceinline__ void gdn_post_phase(const Params& p) {
    const int lane = threadIdx.x & 63, wid = threadIdx.x >> 6;
    const bf16_t* obuf = (const bf16_t*)(p.ws + WS_H);
    const bf16_t* proj = (const bf16_t*)(p.ws + WS_PROJ);
    bf16_t* mix = (bf16_t*)(p.ws + WS_MIX);
    const int d = (lane & 15) * 8;
    for (int row = blockIdx.x * 8 + wid; row < MTOT; row += gridDim.x * 8) {
        float a[8], bb[8], g[8], y[8];
        unpack8(*(const bf16x8*)(obuf + (size_t)row * 512 + lane * 8), a);
        unpack8(*(const bf16x8*)(obuf + ((size_t)MTOT + row) * 512 + lane * 8), bb);
        unpack8(*(const bf16x8*)(proj + (size_t)row * EV_NP + 3072 + lane * 8), g);
        float ss = 0.f;
#pragma unroll
        for (int i = 0; i < 8; ++i) { a[i] += bb[i]; ss += a[i] * a[i]; }
        ss += __shfl_xor(ss, 1); ss += __shfl_xor(ss, 2); ss += __shfl_xor(ss, 4); ss += __shfl_xor(ss, 8);
        const float rstd = rsqrtf(ss * (1.f / 128.f) + 1e-6f);
#pragma unroll
        for (int i = 0; i < 8; ++i) y[i] = a[i] * rstd * p.gdn_norm[d + i] * (g[i] * __builtin_amdgcn_rcpf(1.f + __expf(-g[i])));
        *(bf16x8*)(mix + (size_t)row * DM + 512 + lane * 8) = pack8(y);
    }
}

__device__ __forceinline__ void diffattn_phase(const Params& p, unsigned char* lds) {
    const int tid = threadIdx.x, wid = tid >> 6, lane = tid & 63, r32 = lane & 31, hi = lane >> 5;
    const bf16_t* proj = (const bf16_t*)(p.ws + WS_PROJ);
    bf16_t* mix = (bf16_t*)(p.ws + WS_MIX);
    float s01 = 0.f, s23 = 0.f;
    for (int i = 0; i < 64; ++i) { s01 += p.diff_lambda[i] * p.diff_lambda[64 + i]; s23 += p.diff_lambda[128 + i] * p.diff_lambda[192 + i]; }
    const float lam = expf(s01) - expf(s23) + 0.2f;
    float* X = (float*)lds; float* li = (float*)(lds + 131072) + wid * 64;
    LAS unsigned char* ldsl = (LAS unsigned char*)lds;
    int koff[2], voff[2];
#pragma unroll
    for (int i = 0; i < 2; ++i) {
        const int g = i * 512 + tid;
        { const int row = g >> 4, cg = (g & 15) ^ (row & 7); koff[i] = row * EV_NP + cg * 8; }
        { const int o = g * 16, st = o >> 9, w = o & 511, kk = (st >> 2) * 8 + (w >> 6);
          const int k = (kk & ~0xC) | ((kk & 4) << 1) | ((kk & 8) >> 1), cc = (st & 3) * 32 + ((w & 63) >> 4) * 8; voff[i] = k * EV_NP + cc; }
    }
    const int vbase = (int)(uintptr_t)lds + v_rd_base(lane);
    const int map = wid >> 2, wq = wid & 3;
    unsigned char* Qs = lds + 98304 + wid * 4096 + lane * 16;
    const int vblk = (gridDim.x % 8 == 0) ? (int)((blockIdx.x & 7) * (gridDim.x >> 3) + (blockIdx.x >> 3)) : (int)blockIdx.x;
    bool prefetched = false;
    for (int it = vblk; it < 2112; it += gridDim.x) {
        int b, h, NT, qrow0;
        if (it < 2048) { b = it >> 8; h = (it >> 6) & 3; const int qb = it & 63; NT = 132; qrow0 = b * SEQ + qb * 128; }
        else { const int j = it - 2048; b = j >> 3; h = (j >> 1) & 3; NT = 4; qrow0 = NLAT + b * CTXL + (j & 1) * 128; }
        bf16x8 qr[4];
        { const bf16_t* qp = proj + (size_t)(qrow0 + 32 * wq + r32) * EV_NP + h * 128 + map * 64 + hi * 8;
#pragma unroll
          for (int d0 = 0; d0 < 4; ++d0) qr[d0] = *(const bf16x8*)(qp + d0 * 16); }
        f32x16 o[4] = {}; float lsum = 0.f;
#define DDMA(j, bo) DDMA_BH(j, bo, b, h)
#define DDMA_BH(j, bo, bb_, hh_) do { const bf16_t* pp_ = proj + (size_t)((j) < 4 ? NLAT + (bb_) * CTXL + 64 * (j) : (bb_) * SEQ + 64 * ((j) - 4)) * EV_NP + (hh_) * 128; \
        _Pragma("unroll") for (int i_ = 0; i_ < 2; ++i_) { \
            __builtin_amdgcn_global_load_lds((const unsigned*)(pp_ + 1024 + voff[i_]), (LAS unsigned*)(ldsl + (bo) + i_ * 8192 + wid * 1024), 16, 0, 0); \
            __builtin_amdgcn_global_load_lds((const unsigned*)(pp_ + 512 + koff[i_]), (LAS unsigned*)(ldsl + (bo) + 16384 + i_ * 8192 + wid * 1024), 16, 0, 0); } } while (0)
#define DQK(P0, P1, bo) do { P0 = (f32x16){}; P1 = (f32x16){}; const unsigned char* Ks_ = lds + (bo) + 16384; \
        _Pragma("unroll") for (int d0 = 0; d0 < 4; ++d0) { const int cb_ = (map * 64 + d0 * 16 + hi * 8) * 2; \
            const bf16x8 b0_ = *(const bf16x8*)(Ks_ + KSWZ(r32, cb_)), b1_ = *(const bf16x8*)(Ks_ + KSWZ(32 + r32, cb_)); \
            P0 = __builtin_amdgcn_mfma_f32_32x32x16_bf16(b0_, qr[d0], P0, 0, 0, 0); \
            P1 = __builtin_amdgcn_mfma_f32_32x32x16_bf16(b1_, qr[d0], P1, 0, 0, 0); } } while (0)
#define DSM(P0, P1) do { _Pragma("unroll") for (int r = 0; r < 16; ++r) { P0[r] = __builtin_amdgcn_exp2f(P0[r]); P1[r] = __builtin_amdgcn_exp2f(P1[r]); lsum += P0[r] + P1[r]; } \
        PK4(P0, 0, pa0); PK4(P0, 8, pa1); PK4(P1, 0, pa2); PK4(P1, 8, pa3); } while (0)
#define DTAIL_() asm volatile("s_waitcnt vmcnt(0)" ::: "memory"); __syncthreads(); { const int t_ = bprev; bprev = bcur; bcur = bnext; bnext = t_; }
#define DSTEP_A(N0, N1, O0, O1, j) do { if ((j) + 1 < NT) DDMA((j) + 1, bnext); \
        DQK(N0, N1, bcur); DSM(O0, O1); pv_d0(o, vbase + bprev, pa0, pa1, pa2, pa3); DTAIL_() } while (0)
#define DSTEP_B(N0, N1, O0, O1, j) do { if ((j) + 1 < NT) DDMA((j) + 1, bnext); \
        DSM(O0, O1); pv_d0(o, vbase + bprev, pa0, pa1, pa2, pa3); SBAR(); DQK(N0, N1, bcur); DTAIL_() } while (0)
        f32x16 pA0, pA1, pB0, pB1; bf16x8 pa0, pa1, pa2, pa3;
        if (!prefetched) { DDMA(0, 65536); DDMA(1, 98304); }
        asm volatile("s_waitcnt vmcnt(0)" ::: "memory"); __syncthreads();
        DQK(pA0, pA1, 65536);
        int bprev = 65536, bcur = 98304, bnext = 0;
        if (map == 0) {
            for (int j = 1; j + 1 < NT; j += 2) { DSTEP_A(pB0, pB1, pA0, pA1, j); DSTEP_A(pA0, pA1, pB0, pB1, j + 1); }
            DSTEP_A(pB0, pB1, pA0, pA1, NT - 1);
        } else {
            for (int j = 1; j + 1 < NT; j += 2) { DSTEP_B(pB0, pB1, pA0, pA1, j); DSTEP_B(pA0, pA1, pB0, pB1, j + 1); }
            DSTEP_B(pB0, pB1, pA0, pA1, NT - 1);
        }
        DSM(pB0, pB1); pv_d0(o, vbase + bprev, pa0, pa1, pa2, pa3);
        __syncthreads();
        { const int itn = it + (int)gridDim.x; prefetched = itn < 2112;
          if (prefetched) { int b2, h2; if (itn < 2048) { b2 = itn >> 8; h2 = (itn >> 6) & 3; } else { const int j2 = itn - 2048; b2 = j2 >> 3; h2 = (j2 >> 1) & 3; }
              DDMA_BH(0, 65536, b2, h2); DDMA_BH(1, 98304, b2, h2); } }
#undef DDMA
#undef DDMA_BH
#undef DQK
#undef DSM
#undef DSTEP_A
#undef DSTEP_B
#undef DTAIL_
        const float lt = halfswap_add(lsum);
        if (hi == 0) li[r32] = lt;
        asm volatile("s_waitcnt lgkmcnt(0)" ::: "memory");
        float rli[16];
#pragma unroll
        for (int r = 0; r < 16; ++r) rli[r] = __builtin_amdgcn_rcpf(li[crow(r, hi)]);
        if (map == 1) {
#pragma unroll
            for (int d0 = 0; d0 < 4; ++d0)
#pragma unroll
                for (int r = 0; r < 16; ++r) X[(wq * 64 + d0 * 16 + r) * 64 + lane] = o[d0][r] * rli[r] * lam;
        }
        __syncthreads();
        if (map == 0) {
#pragma unroll
            for (int d0 = 0; d0 < 4; ++d0)
#pragma unroll
                for (int r = 0; r < 16; ++r) o[d0][r] = o[d0][r] * rli[r] - X[(wq * 64 + d0 * 16 + r) * 64 + lane];
#pragma unroll
            for (int r = 0; r < 16; ++r) {
                float ss = o[0][r] * o[0][r] + o[1][r] * o[1][r] + o[2][r] * o[2][r] + o[3][r] * o[3][r];
                ss += __shfl_xor(ss, 1); ss += __shfl_xor(ss, 2); ss += __shfl_xor(ss, 4); ss += __shfl_xor(ss, 8); ss += __shfl_xor(ss, 16);
                const float rstd = rsqrtf(ss * (1.f / 128.f) + 1e-6f) * 0.8f;
                bf16_t* mp = mix + (size_t)(qrow0 + 32 * wq + crow(r, hi)) * DM + h * 128 + r32;
#pragma unroll
                for (int d0 = 0; d0 < 4; ++d0) mp[32 * d0] = f2bf(o[d0][r] * rstd * p.diff_subln[32 * d0 + r32]);
            }
        }
        __syncthreads();
    }
}

__device__ __forceinline__ void natten_phase(const Params& p, unsigned char* lds) {
    const int tid = threadIdx.x, wid = tid >> 6, lane = tid & 63, r32 = lane & 31, hi = lane >> 5;
    const bf16_t* proj = (const bf16_t*)(p.ws + WS_PROJ);
    bf16_t* mix = (bf16_t*)(p.ws + WS_MIX);
    constexpr float L2E = 1.4426950408889634f;
    unsigned char* Vl = lds; unsigned char* Kl = lds + 32768;
    float* rpbs = (float*)(lds + 65536);
    float* li = (float*)(lds + 133120) + wid * 64;
    unsigned char* Qs = lds + 67584 + wid * 8192 + lane * 16;
    const int sr = tid >> 4, sc = (tid & 15) * 8, vst0 = v_st(sr, sc), vst1 = v_st(32 + sr, sc);
    const int vb0 = (int)(uintptr_t)Vl + v_rd_base(lane);
    const float* gkp = p.na_qk_gain + 128 + sc;
    const int vblk = (gridDim.x % 8 == 0) ? (int)((blockIdx.x & 7) * (gridDim.x >> 3) + (blockIdx.x >> 3)) : (int)blockIdx.x;
    for (int it = vblk; it < 2048; it += gridDim.x) {
        const int b = it >> 8, h = (it >> 5) & 7, rq = it & 31;
        const int grow = 4 * rq + (wid >> 1), qc = (wid & 1) * 32 + r32;
        const size_t qR = (size_t)b * SEQ + grow * 64 + qc;
        for (int i = tid; i < 465; i += NTHREADS) rpbs[i] = p.na_rpb[h * 465 + i] * L2E;
        { float ss = 0.f;
#pragma unroll
          for (int d0 = 0; d0 < 8; ++d0) { float qv[8]; unpack8(*(const bf16x8*)(proj + qR * OD_N + h * 128 + d0 * 16 + hi * 8), qv);
#pragma unroll
              for (int i = 0; i < 8; ++i) ss += qv[i] * qv[i]; }
          ss = halfswap_add(ss);
          const float rs = rsqrtf(ss * (1.f / 128.f) + 1e-6f) * 0.08838834764831845f * L2E;
#pragma unroll
          for (int d0 = 0; d0 < 8; ++d0) { float qv[8]; unpack8(*(const bf16x8*)(proj + qR * OD_N + h * 128 + d0 * 16 + hi * 8), qv);
#pragma unroll
              for (int i = 0; i < 8; ++i) qv[i] *= rs * p.na_qk_gain[d0 * 16 + hi * 8 + i];
              *(bf16x8*)(Qs + d0 * 1024) = pack8(qv); } }
        int lo = 4 * rq - 4; lo = lo < 0 ? 0 : (lo > 120 ? 120 : lo);
        int hi_r = 4 * rq + 3 - 4; hi_r = hi_r < 0 ? 0 : (hi_r > 120 ? 120 : hi_r); hi_r += 7;
        const int nlat = hi_r - lo + 1, NT = nlat + 4;
        int wsr = grow - 4; wsr = wsr < 0 ? 0 : (wsr > 120 ? 120 : wsr);
        int cst = qc - 8; cst = cst < 0 ? 0 : (cst > 48 ? 48 : cst);
        f32x16 o[4] = {}; float lsum = 0.f;
        bf16x8 vs0, vs1, ks0, ks1;
#define NLOAD(j) do { const size_t R0_ = (size_t)((j) < nlat ? b * SEQ + (lo + (j)) * 64 : NLAT + b * CTXL + 64 * ((j) - nlat)) + sr; \
        const bf16_t* pp_ = proj + R0_ * OD_N + h * 128 + sc; \
        vs0 = *(const bf16x8*)(pp_ + 2048); vs1 = *(const bf16x8*)(pp_ + 2048 + (size_t)32 * OD_N); \
        ks0 = *(const bf16x8*)(pp_ + 1024); ks1 = *(const bf16x8*)(pp_ + 1024 + (size_t)32 * OD_N); } while (0)
#define KNORM(kx) do { float f_[8]; unpack8(kx, f_); float ss_ = 0.f; _Pragma("unroll") for (int i_ = 0; i_ < 8; ++i_) ss_ += f_[i_] * f_[i_]; \
        ss_ += __shfl_xor(ss_, 1); ss_ += __shfl_xor(ss_, 2); ss_ += __shfl_xor(ss_, 4); ss_ += __shfl_xor(ss_, 8); \
        const float rs_ = rsqrtf(ss_ * (1.f / 128.f) + 1e-6f); _Pragma("unroll") for (int i_ = 0; i_ < 8; ++i_) f_[i_] *= rs_ * gkp[i_]; kx = pack8(f_); } while (0)
#define NWRITE(bf) do { KNORM(ks0); KNORM(ks1); *(bf16x8*)(Vl + (bf) * 16384 + vst0) = vs0; *(bf16x8*)(Vl + (bf) * 16384 + vst1) = vs1; \
        *(bf16x8*)(Kl + (bf) * 16384 + KSWZ(sr, sc * 2)) = ks0; *(bf16x8*)(Kl + (bf) * 16384 + KSWZ(32 + sr, sc * 2)) = ks1; } while (0)
        NLOAD(0); NWRITE(0); __syncthreads();
        for (int j = 0; j < NT; ++j) {
            if (j + 1 < NT) NLOAD(j + 1);
            const int bf = j & 1;
            const bool islat = j < nlat; const int kr = lo + j;
            const bool active = !islat || (kr >= wsr && kr <= wsr + 7);
            if (active) {
                f32x16 p0 = {}, p1 = {};
                const unsigned char* Ks = Kl + bf * 16384;
#pragma unroll
                for (int d0 = 0; d0 < 8; ++d0) { const int cb = (d0 * 16 + hi * 8) * 2;
                    const bf16x8 b0 = *(const bf16x8*)(Ks + KSWZ(r32, cb)), b1 = *(const bf16x8*)(Ks + KSWZ(32 + r32, cb));
                    const bf16x8 qd = *(const bf16x8*)(Qs + d0 * 1024);
                    p0 = __builtin_amdgcn_mfma_f32_32x32x16_bf16(b0, qd, p0, 0, 0, 0);
                    p1 = __builtin_amdgcn_mfma_f32_32x32x16_bf16(b1, qd, p1, 0, 0, 0); }
                if (islat) {
                    const float* rb = rpbs + (kr - grow + 7) * 31 + 15 - qc + 4 * hi;
                    const int mofs = 4 * hi - cst;
#pragma unroll
                    for (int r = 0; r < 16; ++r) {
                        const int kb = (r & 3) + 8 * (r >> 2);
                        const float e0 = __builtin_amdgcn_exp2f(p0[r] + rb[kb]), e1 = __builtin_amdgcn_exp2f(p1[r] + rb[32 + kb]);
                        p0[r] = ((unsigned)(kb + mofs) < 16u) ? e0 : 0.f; p1[r] = ((unsigned)(32 + kb + mofs) < 16u) ? e1 : 0.f;
                        lsum += p0[r] + p1[r]; }
                } else {
#pragma unroll
                    for (int r = 0; r < 16; ++r) { p0[r] = __builtin_amdgcn_exp2f(p0[r]); p1[r] = __builtin_amdgcn_exp2f(p1[r]); lsum += p0[r] + p1[r]; }
                }
                bf16x8 pa0, pa1, pa2, pa3;
                PK4(p0, 0, pa0); PK4(p0, 8, pa1); PK4(p1, 0, pa2); PK4(p1, 8, pa3);
                pv_d0(o, vb0 + bf * 16384, pa0, pa1, pa2, pa3);
            }
            if (j + 1 < NT) NWRITE((j + 1) & 1);
            __syncthreads();
        }
#undef NLOAD
#undef KNORM
#undef NWRITE
        const float lt = halfswap_add(lsum);
        if (hi == 0) li[r32] = lt;
        asm volatile("s_waitcnt lgkmcnt(0)" ::: "memory");
#pragma unroll
        for (int r = 0; r < 16; ++r) { const float rl = __builtin_amdgcn_rcpf(li[crow(r, hi)]);
            bf16_t* mp = mix + ((size_t)b * SEQ + grow * 64 + (wid & 1) * 32 + crow(r, hi)) * DM + h * 128 + r32;
#pragma unroll
            for (int d0 = 0; d0 < 4; ++d0) mp[32 * d0] = f2bf(o[d0][r] * rl); }
        __syncthreads();
    }
}

#define XB_TMO      128
#define XB_XCNT(j)  (256  + 64 * (j))
#define XB_XSUB(j)  (1280 + 64 * (j))
#define XB_XGEN(j)  (2304 + 64 * (j))
#define XB_TOP      3328
#define XB_TOPGEN   3392
#define XCD_BAR_WORDS 3456
#define XB_SPIN_CAP (1u << 22)
__device__ __forceinline__ unsigned xb_ld(unsigned* p)              { return __hip_atomic_load(p, __ATOMIC_RELAXED, __HIP_MEMORY_SCOPE_AGENT); }
__device__ __forceinline__ unsigned xb_add(unsigned* p, unsigned v) { return __hip_atomic_fetch_add(p, v, __ATOMIC_RELAXED, __HIP_MEMORY_SCOPE_AGENT); }
__device__ __forceinline__ unsigned xb_xcc_id() { return (unsigned)__builtin_amdgcn_s_getreg((3 << 11) | 20) & 0xFu; }
#define XB_SPIN(cond, bar) do { unsigned _sp = 0; while (cond) { __builtin_amdgcn_s_sleep(1); \
    if ((++_sp & 255u) == 0u) { if (xb_ld(&(bar)[XB_TMO])) break; if (_sp > XB_SPIN_CAP) { atomicAdd(&(bar)[XB_TMO], 1u); break; } } } } while (0)
struct XcdBarrier { unsigned* bar; unsigned x; volatile LAS unsigned* st; };
__device__ __forceinline__ XcdBarrier xcd_barrier_post(unsigned* bar, volatile LAS unsigned* st) {
    XcdBarrier b; b.bar = bar; b.x = xb_xcc_id(); b.st = st;
    if (threadIdx.x == 0) (void)xb_add(&bar[XB_XCNT(b.x)], 1u);
    return b;
}
__device__ __forceinline__ void xcd_barrier_complete(unsigned* bar, unsigned x, unsigned& nloc, unsigned& nx) {
    const unsigned G = gridDim.x * gridDim.y * gridDim.z;
    unsigned sum, cnt, mine, sp = 0u;
    for (;;) {
        sum = 0u; cnt = 0u; mine = 0u;
#pragma unroll
        for (unsigned j = 0; j < 16; ++j) { const unsigned c = xb_ld(&bar[XB_XCNT(j)]); sum += c; cnt += (c > 0u) ? 1u : 0u; mine = (j == x) ? c : mine; }
        if (sum == G) break;
        __builtin_amdgcn_s_sleep(1);
        if ((++sp & 255u) == 0u) { if (xb_ld(&bar[XB_TMO])) break; if (sp > XB_SPIN_CAP) { atomicAdd(&bar[XB_TMO], 1u); break; } }
    }
    nloc = mine > 0u ? mine : 1u; nx = cnt > 0u ? cnt : 1u;
}
__device__ __forceinline__ void xcd_barrier(const XcdBarrier& b) {
    asm volatile("s_waitcnt vmcnt(0)" ::: "memory");
    __syncthreads();
    if (threadIdx.x == 0) {
        unsigned* bar = b.bar;
        __builtin_amdgcn_s_waitcnt(0);
        unsigned nloc = b.st[0], nx = b.st[1];
        if (nloc == 0u) { xcd_barrier_complete(bar, b.x, nloc, nx); b.st[0] = nloc; b.st[1] = nx; }
        const unsigned old = xb_add(&bar[XB_XSUB(b.x)], 1u);
        const unsigned gen = old / nloc;
        if (old + 1u == (gen + 1u) * nloc) {
            __builtin_amdgcn_fence(__ATOMIC_RELEASE, "agent");
            asm volatile("s_waitcnt vmcnt(0)" ::: "memory");
            const unsigned og = xb_add(&bar[XB_TOP], 1u);
            const unsigned tg = og / nx;
            if (og + 1u == (tg + 1u) * nx) xb_add(&bar[XB_TOPGEN], 1u);
            else XB_SPIN(xb_ld(&bar[XB_TOPGEN]) == tg, bar);
            __builtin_amdgcn_fence(__ATOMIC_ACQUIRE, "agent");
            xb_add(&bar[XB_XGEN(b.x)], 1u);
            asm volatile("s_waitcnt vmcnt(0)" ::: "memory");
        } else {
            XB_SPIN(xb_ld(&bar[XB_XGEN(b.x)]) == gen, bar);
            __builtin_amdgcn_fence(__ATOMIC_ACQUIRE, "agent");
            asm volatile("s_waitcnt vmcnt(0)" ::: "memory");
        }
    }
    __syncthreads();
}

#ifndef PROBE_REP
#define PROBE_REP 0
#endif
#define REP(k) for (int rep_ = 0; rep_ < (((PROBE_REP >> (k)) & 1) ? 2 : 1); ++rep_)
constexpr int NPH = 18;
__global__ void __launch_bounds__(NTHREADS, 2) fwd_megakernel(Params p) {
    extern __shared__ __attribute__((aligned(16))) unsigned char lds[];
    cg::grid_group grid = cg::this_grid();
    LAS unsigned char* ldsl = (LAS unsigned char*)lds;
    const int lo = p.ph_lo, hi = p.ph_hi;
#ifdef ONLY_PH
#define IN(k) (((ONLY_PH >> (k)) & 1) && lo <= (k) && (k) < hi)
#else
#define IN(k) (lo <= (k) && (k) < hi)
#endif
#define SEAM(k) do { if (IN(k) && IN((k) + 1)) { if (p.ph_lo < 0) grid.sync();   { XcdBarrier xb_; xb_.bar = (unsigned*)(p.ws + WS_BAR); xb_.x = xb_xcc_id(); xb_.st = (volatile LAS unsigned*)(ldsl + 135168); xcd_barrier(xb_); } } } while (0)
    unsigned char* ws = p.ws;
    const bf16_t* H = (const bf16_t*)(ws + WS_H);
    bf16_t* PROJ = (bf16_t*)(ws + WS_PROJ);
    const bf16_t* MIX = (const bf16_t*)(ws + WS_MIX);
    float* CTXRES = (float*)(ws + WS_CTXRES);
    const float* MOD = (const float*)(ws + WS_MOD);
    const int G = gridDim.x, c = blockIdx.x;
    if (threadIdx.x < 4) ((volatile LAS unsigned*)(ldsl + 135168))[threadIdx.x] = 0u;
    __syncthreads();
    (void)xcd_barrier_post((unsigned*)(ws + WS_BAR), (volatile LAS unsigned*)(ldsl + 135168));

    if (IN(0)) REP(0) { ada_phase(p, lds); wconv_phase(p, lds);
        { float* rc = (float*)(ws + WS_ROPE); float* rs = rc + SEQ * 32;
          for (int e = blockIdx.x * NTHREADS + threadIdx.x; e < SEQ * 32; e += gridDim.x * NTHREADS) { const int t = e >> 5, pp = e & 31;
              const float inv = powf(10000.f, -(float)(pp & 15) / 16.f); const float ang = (pp < 16 ? (float)(t >> 6) : (float)(t & 63)) * inv;
              rc[e] = cosf(ang); rs[e] = sinf(ang); } } }
    SEAM(0);
    if (IN(1)) REP(1) norm_phase(p, p.x, p.ctx, 0, 0, MTOT);
    SEAM(1);
    if (IN(2)) REP(2) { pg8::Gemm g{H, (const bf16_t*)(ws + WS_W_EVIN), MTOT, EV_NP, DM}; pg8::StaticOrderT<264, 15> S; S.init(MTOT, EV_NP, G, c);
        pg8::EpiBf16 E{PROJ, EV_NP, EV_N}; pg8::gemm_phase(ldsl, g, S, E); }
    SEAM(2);
    if (IN(3)) prep0_phase(p);
    SEAM(3);
    if (IN(4)) REP(4) gdn_pre_phase(p, lds);
    SEAM(4);
    if (IN(5)) {
#ifndef SKIP_SCAN
        REP(20) { gdn_scan_phase(p, lds); __syncthreads(); }
#endif
#ifndef SKIP_DA
        REP(5) { diffattn_phase(p, lds); __syncthreads(); }
#endif
    }
    SEAM(5);
    if (IN(6)) REP(6) gdn_post_phase(p);
    SEAM(6);
    if (IN(7)) REP(7) { pg8::Gemm g{MIX, (const bf16_t*)(ws + WS_W_EVOUT), MTOT, DM, DM}; pg8::StaticOrderT<264, 4> S; S.init(MTOT, DM, G, c);
        pg8::EpiResid E{p.x, p.ctx, p.out, CTXRES, MOD, 2048}; pg8::gemm_phase(ldsl, g, S, E); }
    SEAM(7);
    if (IN(8)) norm_phase(p, p.out, CTXRES, 0, 1, MTOT);
    SEAM(8);
    if (IN(9)) REP(9) { pg8::Gemm g{H, (const bf16_t*)(ws + WS_W_FFIN), MTOT, 2 * FF, DM}; pg8::StaticOrderT<264, 22> S; S.init(MTOT, 2 * FF, G, c);
        pg8::EpiSwiglu E{PROJ, FF}; pg8::gemm_phase(ldsl, g, S, E); }
    SEAM(9);
    if (IN(10)) { pg8::Gemm g{PROJ, (const bf16_t*)(ws + WS_W_FFOUT), MTOT, DM, FF}; pg8::StaticOrderT<264, 4> S; S.init(MTOT, DM, G, c);
        pg8::EpiResid E{p.out, CTXRES, p.out, CTXRES, MOD, 5120}; pg8::gemm_phase(ldsl, g, S, E); }
    SEAM(10);
    if (IN(11)) norm_phase(p, p.out, CTXRES, 1, 0, MTOT);
    SEAM(11);
    if (IN(12)) { pg8::Gemm g{H, (const bf16_t*)(ws + WS_W_ODIN), MTOT, OD_N, DM}; pg8::StaticOrderT<264, 12> S; S.init(MTOT, OD_N, G, c);
        pg8::EpiBf16 E{PROJ, OD_N, OD_N}; pg8::gemm_phase(ldsl, g, S, E); }
    SEAM(12);
    if (IN(13)) { natten_phase(p, lds); if ((PROBE_REP >> 13) & 1) { __syncthreads(); natten_phase(p, lds); } }
    SEAM(13);
    if (IN(14)) { pg8::Gemm g{MIX, (const bf16_t*)(ws + WS_W_ODOUT), NLAT, DM, DM}; pg8::StaticOrderT<256, 4> S; S.init(NLAT, DM, G, c);
        pg8::EpiResid E{p.out, CTXRES, p.out, CTXRES, MOD + 9 * 6144, 2048}; pg8::gemm_phase(ldsl, g, S, E); }
    SEAM(14);
    if (IN(15)) norm_phase(p, p.out, CTXRES, 1, 1, NLAT);
    SEAM(15);
    if (IN(16)) { pg8::Gemm g{H, (const bf16_t*)(ws + WS_W_FFIN) + (size_t)2 * FF * DM, NLAT, 2 * FF, DM}; pg8::StaticOrderT<256, 22> S; S.init(NLAT, 2 * FF, G, c);
        pg8::EpiSwiglu E{PROJ, FF}; pg8::gemm_phase(ldsl, g, S, E); }
    SEAM(16);
    if (IN(17)) { pg8::Gemm g{PROJ, (const bf16_t*)(ws + WS_W_FFOUT) + (size_t)DM * FF, NLAT, DM, FF}; pg8::StaticOrderT<256, 4> S; S.init(NLAT, DM, G, c);
        pg8::EpiResid E{p.out, CTXRES, p.out, CTXRES, MOD + 9 * 6144, 5120}; pg8::gemm_phase(ldsl, g, S, E); }
#undef IN
#undef SEAM
}

extern "C" void kernel_launch(void* const* d_in, const int* in_sizes, int n_in, void* d_out, int out_size, void* d_ws, size_t ws_size, hipStream_t stream) {
    static int grid = 0;
    if (grid == 0) {
        if (n_in != 23 || ws_size < WS_END) { fprintf(stderr, "kernel_launch: n_in %d ws %zu (need %zu)\n", n_in, ws_size, (size_t)WS_END); grid = -1; return; }
        int dev = 0, cus = 0, per_cu = 0;
        hipGetDevice(&dev); hipDeviceGetAttribute(&cus, hipDeviceAttributeMultiprocessorCount, dev);
        if (hipFuncSetAttribute((const void*)fwd_megakernel, hipFuncAttributeMaxDynamicSharedMemorySize, LDS_BYTES) != hipSuccess) { fprintf(stderr, "hipFuncSetAttribute failed\n"); grid = -1; return; }
        if (hipOccupancyMaxActiveBlocksPerMultiprocessor(&per_cu, (const void*)fwd_megakernel, NTHREADS, LDS_BYTES) != hipSuccess || per_cu < 1) per_cu = 1;
        (void)hipGetLastError();
        grid = cus * 1;
    }
    if (grid < 0) return;
    if (hipMemsetAsync((char*)d_ws + WS_BAR, 0, 16384, stream) != hipSuccess) { fprintf(stderr, "memset failed\n"); return; }
    Params p{};
    const float** pp = (const float**)&p;
    for (int i = 0; i < 23; ++i) pp[i] = (const float*)d_in[i];
    p.out = (float*)d_out; p.ws = (unsigned char*)d_ws;
#if N_LAUNCH_MODE == 1
    p.ph_lo = 0; p.ph_hi = NPH;
    void* args[] = {&p};
    hipError_t e = hipLaunchCooperativeKernel((void*)fwd_megakernel, dim3(grid), dim3(NTHREADS), args, LDS_BYTES, stream);
    if (e != hipSuccess) fprintf(stderr, "cooperative launch failed: %s (grid %d)\n", hipGetErrorString(e), grid);
#else
    for (int k = 0; k < NPH; ++k) { p.ph_lo = k; p.ph_hi = k + 1;
        hipLaunchKernelGGL(fwd_megakernel, dim3(grid), dim3(NTHREADS), LDS_BYTES, stream, p); }
#endif
}
```
